# Optimizing an MI355X kernel written in HIP

```python
import math
import jax
import jax.numpy as jnp
from jax import lax
import numpy as np

D_MODEL = 2048
BATCH = 4
SEQ = 4096
DEPTH = 1

HEAD_DIM = 64
N_MIX_HEADS = D_MODEL // HEAD_DIM
SB_HEADS = N_MIX_HEADS // 2
SWA_Q_HEADS = N_MIX_HEADS - SB_HEADS
SWA_KV_HEADS = SWA_Q_HEADS // 4
SWA_GROUP = SWA_Q_HEADS // SWA_KV_HEADS
SB_WIDTH = SB_HEADS * HEAD_DIM
SWA_WIDTH = SWA_Q_HEADS * HEAD_DIM
SWA_KV_WIDTH = SWA_KV_HEADS * HEAD_DIM
MIX_WIDTH = SB_WIDTH + SWA_WIDTH
IN_SPLITS = (SB_WIDTH, SB_WIDTH, SB_WIDTH, SWA_WIDTH, SWA_KV_WIDTH, SWA_KV_WIDTH)
IN_PROJ_WIDTH = 3 * SB_WIDTH + SWA_WIDTH + 2 * SWA_KV_WIDTH
BLOCK = 128
WINDOW = 128
N_META = 16
META_PAD = BLOCK - N_META
NUM_BUCKETS = 32
MAX_DISTANCE = 128
N_GROUPS = 8
EXPERTS_PER_GROUP = 8
N_EXPERTS = N_GROUPS * EXPERTS_PER_GROUP
TOP_K_IN_GROUP = 2
D_EXPERT = D_MODEL // 4
DISPATCH_BLOCK = 128
RMS_EPS = 1e-6

kernel_name = 'hybrid_stickbreak_swa_hier_moe'


def rms_norm(x, gain):
    xf = x.astype(jnp.float32)
    var = jnp.mean(xf * xf, axis=-1, keepdims=True)
    return (xf * lax.rsqrt(var + RMS_EPS)).astype(x.dtype) * gain


def t5_bucket(dist):
    max_exact = NUM_BUCKETS // 2
    d = jnp.maximum(dist, 0)
    large = max_exact + (jnp.log(jnp.maximum(d, 1).astype(jnp.float32) / max_exact)
                         / math.log(MAX_DISTANCE / max_exact)
                         * (NUM_BUCKETS - max_exact)).astype(jnp.int32)
    large = jnp.minimum(large, NUM_BUCKETS - 1)
    return jnp.where(d < max_exact, d, large)


def stick_breaking_attention(q, k, v):
    P = q.shape[2]
    scale = HEAD_DIM ** -0.5
    outs = []
    for i in range(P // BLOCK):
        lo, hi = i * BLOCK, (i + 1) * BLOCK
        qb = q[:, :, lo:hi]
        kb = k[:, :, :hi]
        vb = v[:, :, :hi]
        z = jnp.einsum('bhqd,bhkd->bhqk', qb, kb).astype(jnp.float32) * scale
        q_pos = lo + jnp.arange(BLOCK)[:, None]
        k_pos = jnp.arange(hi)[None, :]
        valid = (k_pos < q_pos) & (k_pos >= META_PAD)
        log_keep = jnp.where(valid, -jax.nn.softplus(z), 0.0)
        rev = lax.cumsum(log_keep, axis=3, reverse=True)
        suffix = jnp.concatenate([rev[..., 1:], jnp.zeros_like(rev[..., :1])], axis=-1)
        log_w = jax.nn.log_sigmoid(z) + suffix
        w = jnp.where(valid, jnp.exp(log_w), 0.0)
        outs.append(jnp.einsum('bhqk,bhkd->bhqd', w.astype(v.dtype), vb))
    return jnp.concatenate(outs, axis=2)


def swa_sink_attention(q, k, v, sinks, rel_bias):
    B, P = q.shape[0], q.shape[1]
    nb = P // BLOCK
    scale = HEAD_DIM ** -0.5
    qb = q.reshape(B, nb, BLOCK, SWA_KV_HEADS, SWA_GROUP, HEAD_DIM)

    def band(t):
        tb = t.reshape(B, nb, BLOCK, SWA_KV_HEADS, HEAD_DIM)
        prev = jnp.concatenate([jnp.zeros_like(tb[:, :1]), tb[:, :-1]], axis=1)
        return jnp.concatenate([prev, tb], axis=2)

    kb, vb = band(k), band(v)
    k_meta = k[:, META_PAD:BLOCK]
    v_meta = v[:, META_PAD:BLOCK]
    q_pos = jnp.arange(nb)[:, None] * BLOCK + jnp.arange(BLOCK)[None, :]
    kb_pos = (jnp.arange(nb)[:, None] - 1) * BLOCK + jnp.arange(2 * BLOCK)[None, :]
    km_pos = jnp.arange(META_PAD, BLOCK)
    d_band = q_pos[:, :, None] - kb_pos[:, None, :]
    ok_band = (d_band >= 0) & (d_band < WINDOW) & (kb_pos[:, None, :] >= BLOCK)
    d_meta = q_pos[:, :, None] - km_pos[None, None, :]
    ok_meta = d_meta >= 0
    dist = jnp.concatenate([d_band, d_meta], axis=-1)
    ok = jnp.concatenate([ok_band, ok_meta], axis=-1)
    bias = rel_bias[t5_bucket(dist)].astype(jnp.float32)
    bias = bias.transpose(3, 0, 1, 2).reshape(SWA_KV_HEADS, SWA_GROUP, nb, BLOCK, -1)
    s_band = jnp.einsum('bnqhgd,bnshd->bhgnqs', qb, kb)
    s_meta = jnp.einsum('bnqhgd,bmhd->bhgnqm', qb, k_meta)
    s = jnp.concatenate([s_band, s_meta], axis=-1).astype(jnp.float32) * scale + bias
    s = jnp.where(ok, s, -jnp.inf)
    sink = sinks.astype(jnp.float32).reshape(SWA_KV_HEADS, SWA_GROUP, 1, 1, 1)
    m = jnp.maximum(jnp.max(s, axis=-1, keepdims=True), sink)
    p = jnp.exp(s - m)
    p = (p / (jnp.sum(p, axis=-1, keepdims=True) + jnp.exp(sink - m))).astype(v.dtype)
    o = (jnp.einsum('bhgnqs,bnshd->bnqhgd', p[..., :2 * BLOCK], vb)
         + jnp.einsum('bhgnqm,bmhd->bnqhgd', p[..., 2 * BLOCK:], v_meta))
    return o.reshape(B, P, SWA_Q_HEADS, HEAD_DIM)


def hierarchical_moe(x, w_rg, b_rg, w_re, b_re, w_gate, w_up, w_down):
    T = x.shape[0]
    g_prob = jax.nn.softmax((x @ w_rg).astype(jnp.float32) + b_rg.astype(jnp.float32), axis=-1)
    g_val, g_idx = lax.top_k(g_prob, 1)
    e_logits = ((x @ w_re).astype(jnp.float32) + b_re.astype(jnp.float32)).reshape(T, N_GROUPS, EXPERTS_PER_GROUP)
    e_logits = e_logits[jnp.arange(T), g_idx[:, 0]]
    e_val, e_idx = lax.top_k(jax.nn.softmax(e_logits, axis=-1), TOP_K_IN_GROUP)
    gate = g_val * e_val / jnp.sum(e_val, axis=-1, keepdims=True)
    expert = g_idx * EXPERTS_PER_GROUP + e_idx
    n_assign = T * TOP_K_IN_GROUP
    a_expert = expert.reshape(-1)
    a_token = jnp.repeat(jnp.arange(T, dtype=jnp.int32), TOP_K_IN_GROUP)
    a_gate = gate.reshape(-1)
    onehot = jax.nn.one_hot(a_expert, N_EXPERTS, dtype=jnp.int32)
    rank = jnp.sum(jnp.cumsum(onehot, axis=0) * onehot, axis=1) - 1
    counts = jnp.sum(onehot, axis=0)
    padded = (counts + DISPATCH_BLOCK - 1) // DISPATCH_BLOCK * DISPATCH_BLOCK
    seg_end = jnp.cumsum(padded)
    seg_start = seg_end - padded
    n_blocks = -(-n_assign // DISPATCH_BLOCK) + N_EXPERTS
    slots = n_blocks * DISPATCH_BLOCK
    dest = seg_start[a_expert] + rank
    slot_token = jnp.full((slots,), T, jnp.int32).at[dest].set(a_token)
    slot_gate = jnp.zeros((slots,), a_gate.dtype).at[dest].set(a_gate)
    block_expert = jnp.minimum(
        jnp.searchsorted(seg_end, jnp.arange(n_blocks) * DISPATCH_BLOCK, side='right'), N_EXPERTS - 1)
    x_pad = jnp.concatenate([x, jnp.zeros_like(x[:1])], axis=0)

    def run_block(args):
        tok, e = args
        xb = x_pad[tok]
        hdn = jax.nn.silu(xb @ w_gate[e]) * (xb @ w_up[e])
        return hdn @ w_down[e]

    y = lax.map(run_block, (slot_token.reshape(n_blocks, DISPATCH_BLOCK), block_expert))
    y = y.reshape(slots, -1) * slot_gate[:, None].astype(y.dtype)
    out = jnp.zeros_like(x_pad).at[slot_token].add(y)
    return out[:T]


def setup_inputs(seed: int = 0) -> dict:
    key = jax.random.key(seed)
    ks = jax.random.split(key, 20)
    f32 = jnp.float32

    def nrm(k, shape, scale):
        return jax.random.normal(k, shape, f32) * scale

    L = DEPTH
    return {
        'x': nrm(ks[0], (BATCH, SEQ, D_MODEL), 1.0),
        'meta_tokens': nrm(ks[1], (N_META, D_MODEL), 1.0),
        'rel_bias': nrm(ks[2], (NUM_BUCKETS, SWA_Q_HEADS), 0.1),
        'ln_mix': 1.0 + nrm(ks[3], (L, D_MODEL), 0.02),
        'w_in': nrm(ks[4], (L, D_MODEL, IN_PROJ_WIDTH), D_MODEL ** -0.5),
        'q_norm': 1.0 + nrm(ks[5], (L, HEAD_DIM), 0.02),
        'k_norm': 1.0 + nrm(ks[6], (L, HEAD_DIM), 0.02),
        'sinks': nrm(ks[7], (L, SWA_Q_HEADS), 0.5),
        'out_norm_sb': 1.0 + nrm(ks[8], (L, SB_WIDTH), 0.02),
        'out_norm_swa': 1.0 + nrm(ks[9], (L, SWA_WIDTH), 0.02),
        'w_out': nrm(ks[10], (L, MIX_WIDTH, D_MODEL), MIX_WIDTH ** -0.5),
        'ln_ffn': 1.0 + nrm(ks[11], (L, D_MODEL), 0.02),
        'w_router_group': nrm(ks[12], (L, D_MODEL, N_GROUPS), D_MODEL ** -0.5),
        'b_router_group': nrm(ks[13], (L, N_GROUPS), 0.01),
        'w_router_expert': nrm(ks[14], (L, D_MODEL, N_EXPERTS), D_MODEL ** -0.5),
        'b_router_expert': nrm(ks[15], (L, N_EXPERTS), 0.01),
        'w_gate': nrm(ks[16], (L, N_EXPERTS, D_MODEL, D_EXPERT), D_MODEL ** -0.5),
        'w_up': nrm(ks[17], (L, N_EXPERTS, D_MODEL, D_EXPERT), D_MODEL ** -0.5),
        'w_down': nrm(ks[18], (L, N_EXPERTS, D_EXPERT, D_MODEL), D_EXPERT ** -0.5),
    }


def reference(x, meta_tokens, rel_bias, ln_mix, w_in, q_norm, k_norm, sinks, out_norm_sb,
              out_norm_swa, w_out, ln_ffn, w_router_group, b_router_group, w_router_expert,
              b_router_expert, w_gate, w_up, w_down):
    B = x.shape[0]
    pad = jnp.zeros((B, META_PAD, D_MODEL), x.dtype)
    meta = jnp.broadcast_to(meta_tokens.astype(x.dtype)[None], (B, N_META, D_MODEL))
    h = jnp.concatenate([pad, meta, x], axis=1)
    P = h.shape[1]
    split_at = [int(i) for i in np.cumsum(IN_SPLITS)[:-1]]
    for l in range(DEPTH):
        hn = rms_norm(h, ln_mix[l])
        proj = hn @ w_in[l]
        q_sb, k_sb, v_sb, q_sw, k_sw, v_sw = jnp.split(proj, split_at, axis=-1)

        def heads_first(t):
            return t.reshape(B, P, SB_HEADS, HEAD_DIM).transpose(0, 2, 1, 3)

        o_sb = stick_breaking_attention(heads_first(q_sb), heads_first(k_sb), heads_first(v_sb))
        o_sb = o_sb.transpose(0, 2, 1, 3).reshape(B, P, SB_WIDTH)
        qs = rms_norm(q_sw.reshape(B, P, SWA_Q_HEADS, HEAD_DIM), q_norm[l])
        ksw = rms_norm(k_sw.reshape(B, P, SWA_KV_HEADS, HEAD_DIM), k_norm[l])
        vsw = v_sw.reshape(B, P, SWA_KV_HEADS, HEAD_DIM)
        o_sw = swa_sink_attention(qs, ksw, vsw, sinks[l], rel_bias).reshape(B, P, SWA_WIDTH)
        mixed = jnp.concatenate([rms_norm(o_sb, out_norm_sb[l]), rms_norm(o_sw, out_norm_swa[l])], axis=-1)
        h = h + mixed @ w_out[l]
        hf = rms_norm(h, ln_ffn[l]).reshape(B * P, D_MODEL)
        y = hierarchical_moe(hf, w_router_group[l], b_router_group[l], w_router_expert[l],
                             b_router_expert[l], w_gate[l], w_up[l], w_down[l])
        h = h + y.reshape(B, P, D_MODEL)
    return h[:, BLOCK:]
```

```cpp
#include <hip/hip_runtime.h>
#include <cstdio>
#include <cstdint>
namespace pg8 {
#define PG8_LAS __attribute__((address_space(3)))
typedef unsigned short bf16_t;
typedef short bf16x8 __attribute__((ext_vector_type(8)));
typedef float f32x4 __attribute__((ext_vector_type(4)));
typedef unsigned u32x4 __attribute__((ext_vector_type(4)));
constexpr int BM = 256, BK = 64, HALF = 128, HTB = HALF * BK * 2  , STAGE_BYTES = 8 * HTB, NXCD = 8, WGM = 8;

__host__ __device__ __forceinline__ int lds_byte(int r, int c) { const int st = (r >> 4) * 2 + (c >> 5), rr = r & 15, cc = c & 31, ob = rr * 64 + cc * 2; return st * 1024 + (ob ^ (((ob >> 9) & 1) << 5)); }
__host__ __device__ __forceinline__ void stage_rc(int b, int& R, int& C) { const int st = b / 1024, sb = b % 1024, swz = sb ^ (((sb >> 9) & 1) << 5); R = (st >> 1) * 16 + swz / 64; C = (st & 1) * 32 + (swz % 64) / 2; }
__host__ __device__ __forceinline__ int perm32(int rho) { const int n = rho >> 4, i = rho & 15; return 8 * (i >> 2) + 4 * n + (i & 3); }

struct Unit { int pm, pn; };
struct Gemm { const bf16_t* A; const bf16_t* Bt; int M, N, K; };

struct StaticOrder {
    int nM, nN, nwg, G, c;
    __host__ __device__ void init(int M, int N, int G_, int c_) { nM = M / BM; nN = N / BM; nwg = nM * nN; G = G_; c = c_; }
    __host__ __device__ bool next(int i, Unit& u) const {
        const long L = (long)i * G + c; if (L >= nwg) return false;
        int wgid = (int)L; { const int q = nwg / NXCD, r = nwg % NXCD, xcd = wgid % NXCD, off = wgid / NXCD; wgid = (xcd < r ? xcd * (q + 1) : r * (q + 1) + (xcd - r) * q) + off; }
        const int nig = WGM * nN, gid = wgid / nig, fm = gid * WGM, gsz = (nM - fm) < WGM ? (nM - fm) : WGM;
        u.pm = fm + ((wgid % nig) % gsz); u.pn = (wgid % nig) / gsz; return true;
    }
    __device__ __forceinline__ void a_ready(const Unit&) const {}
    __device__ __forceinline__ void done(const Unit&) const {}
};

__device__ __forceinline__ unsigned cvt_pk_bf16(float lo, float hi) { unsigned r; asm volatile("v_cvt_pk_bf16_f32 %0, %1, %2" : "=v"(r) : "v"(lo), "v"(hi)); return r; }
typedef float f32x2 __attribute__((ext_vector_type(2)));
__device__ __forceinline__ f32x2 gelu_pk(f32x2 v) {
    const f32x2 av = __builtin_elementwise_abs(v), d = av * 0.2316418882f + 1.0f;
    f32x2 t; t.x = __builtin_amdgcn_rcpf(d.x); t.y = __builtin_amdgcn_rcpf(d.y);
    f32x2 q = t * 0.5307027145f + (-0.7265760135f); q = q * t + 0.7107068705f; q = q * t + (-0.142248368f); q = q * t + 0.127414796f; q = q * t;
    const f32x2 s = (v * v) * (-0.72134752044f);
    f32x2 e; e.x = __builtin_amdgcn_exp2f(s.x); e.y = __builtin_amdgcn_exp2f(s.y);
    const f32x2 m = v * (q * e), r = v - m;
    f32x2 o; o.x = v.x < 0.f ? m.x : r.x; o.y = v.y < 0.f ? m.y : r.y; return o;
}

template <int ACT  > struct EpiBf16 {
    static constexpr bool PERM = true, AFTER_DRAIN = false; static_assert(ACT == 0 || ACT == 1, "EpiBf16: ACT is 0 (none) or 1 (gelu_pk)");
    bf16_t* O; int ldc; const float* bias; int split_cols; size_t split_stride; float scale0;
    __device__ __forceinline__ void operator()(const f32x4 (&acc)[2][2][4][2], const Unit& u, int wr, int wc, int fr, int fq) const {
        const int row0 = u.pm * BM + wr * 64 + fr; int colt = u.pn * BM; bf16_t* base = O;
        float sc = 1.f; if (split_cols) { const int t = colt / split_cols; base += (size_t)t * split_stride; colt -= t * split_cols; if (t == 0) sc = scale0; }
        const int col0 = colt + wc * 32 + 8 * fq, bcol0 = u.pn * BM + wc * 32 + 8 * fq;
        f32x4 bv[2][2];
#pragma unroll
        for (int bj = 0; bj < 2; ++bj)
#pragma unroll
            for (int n = 0; n < 2; ++n) bv[bj][n] = bias ? *(const f32x4*)(bias + bcol0 + bj * HALF + 4 * n) : (f32x4){0.f, 0.f, 0.f, 0.f};
#pragma unroll
        for (int ai = 0; ai < 2; ++ai)
#pragma unroll
            for (int m = 0; m < 4; ++m) { bf16_t* rowp = base + (size_t)(row0 + ai * HALF + m * 16) * ldc + col0;
#pragma unroll
                for (int bj = 0; bj < 2; ++bj) { f32x4 v0 = acc[ai][bj][m][0] + bv[bj][0], v1 = acc[ai][bj][m][1] + bv[bj][1];
                    if (ACT == 1) { f32x2 a = gelu_pk((f32x2){v0[0], v0[1]}), b = gelu_pk((f32x2){v0[2], v0[3]}), c = gelu_pk((f32x2){v1[0], v1[1]}), d = gelu_pk((f32x2){v1[2], v1[3]});
                        v0 = (f32x4){a.x, a.y, b.x, b.y}; v1 = (f32x4){c.x, c.y, d.x, d.y}; }
                    v0 = v0 * sc; v1 = v1 * sc; u32x4 w; w.x = cvt_pk_bf16(v0[0], v0[1]); w.y = cvt_pk_bf16(v0[2], v0[3]); w.z = cvt_pk_bf16(v1[0], v1[1]); w.w = cvt_pk_bf16(v1[2], v1[3]);
                    *(u32x4*)(rowp + bj * HALF) = w; } }
    }
};

struct PanelStats {
    unsigned* xbuf;
    unsigned* cnt;
    unsigned* tmo;
    int ntn; float eps;
    unsigned code;
    __device__ __forceinline__ bool run(const f32x4 (&v)[2][2][4][2], const Unit& u, int wr, int wc, int fr, int fq, PG8_LAS unsigned char* lds, int wid, int lane) const {
        typedef float f32x2v __attribute__((ext_vector_type(2)));
        PG8_LAS f32x2v* P = (PG8_LAS f32x2v*)lds;
        PG8_LAS f32x2v* S = (PG8_LAS f32x2v*)(lds + 8192);
        PG8_LAS unsigned* flag = (PG8_LAS unsigned*)(lds + 8192 + 2048);
#pragma unroll
        for (int ai = 0; ai < 2; ++ai)
#pragma unroll
            for (int m = 0; m < 4; ++m) {
                float s = 0.f;
#pragma unroll
                for (int bj = 0; bj < 2; ++bj)
#pragma unroll
                    for (int n = 0; n < 2; ++n) { const f32x4 x = v[ai][bj][m][n]; s += (x[0] + x[1]) + (x[2] + x[3]); }
                s += __shfl_xor(s, 16); s += __shfl_xor(s, 32);
                const float mw = s * (1.0f / 64.0f); float q = 0.f;
#pragma unroll
                for (int bj = 0; bj < 2; ++bj)
#pragma unroll
                    for (int n = 0; n < 2; ++n) { const f32x4 d = v[ai][bj][m][n] - mw; q += (d[0] * d[0] + d[1] * d[1]) + (d[2] * d[2] + d[3] * d[3]); }
                q += __shfl_xor(q, 16); q += __shfl_xor(q, 32);
                if (fq == 0) P[(ai * HALF + wr * 64 + m * 16 + fr) * 4 + wc] = (f32x2v){mw, q};
            }
        asm volatile("s_waitcnt lgkmcnt(0)" ::: "memory"); __builtin_amdgcn_s_barrier(); asm volatile("" ::: "memory");
#if defined(BROKEN_EXCHANGE_NO_WAIT)
#warning BROKEN CONTROL BUILD: the row-statistics exchange does not wait; results are wrong by design
        if (blockIdx.x >= 64) { const long long t0_ = clock64(); while (clock64() - t0_ < 60000) __builtin_amdgcn_s_sleep(8); }
#endif
        const int row = wid * 32 + (lane & 31);
        if (lane < 32) {
            const f32x2v a = P[row * 4 + 0], b = P[row * 4 + 1], c = P[row * 4 + 2], d = P[row * 4 + 3];
            const float mt = (a.x + b.x + c.x + d.x) * 0.25f;
            const float da = a.x - mt, db = b.x - mt, dc = c.x - mt, dd = d.x - mt;
            const float m2 = (a.y + b.y) + (c.y + d.y) + 64.0f * ((da * da + db * db) + (dc * dc + dd * dd));
            unsigned long long* slot = (unsigned long long*)xbuf + ((size_t)(u.pm * BM + row) * 4 + u.pn);
            __hip_atomic_store(slot, ((unsigned long long)__float_as_uint(m2) << 32) | __float_as_uint(mt), __ATOMIC_RELAXED, __HIP_MEMORY_SCOPE_AGENT);
        }
        asm volatile("s_waitcnt vmcnt(0)" ::: "memory");
        if (lane == 0) __hip_atomic_fetch_add(cnt + 64 * u.pm, 1u, __ATOMIC_RELAXED, __HIP_MEMORY_SCOPE_AGENT);
        if (wid == 0) {
            bool dead = false; const unsigned long long t0 = __builtin_amdgcn_s_memrealtime(); const unsigned want = 8u * (unsigned)ntn;
            for (;;) {
#if defined(BROKEN_EXCHANGE_NO_WAIT)
                break;
#endif
                if ((unsigned)__builtin_amdgcn_readfirstlane(__hip_atomic_load(cnt + 64 * u.pm, __ATOMIC_RELAXED, __HIP_MEMORY_SCOPE_AGENT)) >= want) break;
                if (__builtin_amdgcn_s_memrealtime() - t0 > 2000000ull) {
                    if (lane == 0) { unsigned expect = 0u; __hip_atomic_compare_exchange_strong(tmo + 1, &expect, code | (unsigned)(u.pm & 0xff), __ATOMIC_RELAXED, __ATOMIC_RELAXED, __HIP_MEMORY_SCOPE_AGENT);
                                     __hip_atomic_store(tmo, 1u, __ATOMIC_RELAXED, __HIP_MEMORY_SCOPE_AGENT); }
                    dead = true; break; }
                __builtin_amdgcn_s_sleep(2);
            }
            __builtin_amdgcn_fence(__ATOMIC_ACQUIRE, "agent");
            if (lane == 0) flag[0] = dead ? 1u : 0u;
        }
        asm volatile("s_waitcnt vmcnt(0) lgkmcnt(0)" ::: "memory"); __builtin_amdgcn_s_barrier(); asm volatile("" ::: "memory");
        const bool bad = flag[0] != 0u;
        if (lane < 32) {
            const unsigned long long* slot = (const unsigned long long*)xbuf + (size_t)(u.pm * BM + row) * 4; float mt[4], m2[4]; float ms = 0.f;
#pragma unroll
            for (int t = 0; t < 4; ++t) { if (t < ntn) { const unsigned long long w = __hip_atomic_load(slot + t, __ATOMIC_RELAXED, __HIP_MEMORY_SCOPE_AGENT); mt[t] = __uint_as_float((unsigned)w); m2[t] = __uint_as_float((unsigned)(w >> 32)); } else { mt[t] = 0.f; m2[t] = 0.f; } ms += mt[t]; }
            const float mean = ms / (float)ntn; float q = 0.f;
#pragma unroll
            for (int t = 0; t < 4; ++t) if (t < ntn) { const float dm = mt[t] - mean; q += m2[t] + 256.0f * dm * dm; }
            S[row] = (f32x2v){mean, 1.0f / sqrtf(q / (256.0f * (float)ntn) + eps)};
        }
        asm volatile("s_waitcnt lgkmcnt(0)" ::: "memory"); __builtin_amdgcn_s_barrier(); asm volatile("" ::: "memory");
        return bad;
    }
};
struct EpiLnRes {
    static constexpr bool PERM = false, AFTER_DRAIN = true;
    const float* base; float* out; int ldc; const float* bias; PanelStats st; unsigned poison;
    __device__ __forceinline__ void fused(f32x4 (&acc)[2][2][4][2], const Unit& u, int wr, int wc, int fr, int fq, PG8_LAS unsigned char* lds, int wid, int lane) const {
        typedef float f32x2v __attribute__((ext_vector_type(2)));
        const PG8_LAS f32x2v* S = (const PG8_LAS f32x2v*)(lds + 8192);
        const int col0 = u.pn * BM + wc * 32 + 4 * fq;
#pragma unroll
        for (int bj = 0; bj < 2; ++bj)
#pragma unroll
            for (int n = 0; n < 2; ++n) { const f32x4 bv = bias ? *(const f32x4*)(bias + col0 + bj * HALF + n * 16) : (f32x4){0.f, 0.f, 0.f, 0.f};
#pragma unroll
                for (int ai = 0; ai < 2; ++ai)
#pragma unroll
                    for (int m = 0; m < 4; ++m) acc[ai][bj][m][n] += bv; }
        f32x4 pre[4][2][2];
#pragma unroll
        for (int m = 0; m < 4; ++m) { const size_t off = (size_t)(u.pm * BM + wr * 64 + m * 16 + fr) * ldc + col0;
#pragma unroll
            for (int bj = 0; bj < 2; ++bj)
#pragma unroll
                for (int n = 0; n < 2; ++n) pre[m][bj][n] = *(const f32x4*)(base + off + bj * HALF + n * 16); }
        const bool bad = st.run(acc, u, wr, wc, fr, fq, lds, wid, lane) || poison != 0u;
        const float qnan = __builtin_nanf("");
#pragma unroll
        for (int ai = 0; ai < 2; ++ai)
#pragma unroll
            for (int m = 0; m < 4; ++m) { const int r = ai * HALF + wr * 64 + m * 16 + fr; const f32x2v sr = S[r]; const size_t off = (size_t)(u.pm * BM + r) * ldc + col0;
#pragma unroll
                for (int bj = 0; bj < 2; ++bj)
#pragma unroll
                    for (int n = 0; n < 2; ++n) { const f32x4 bs = ai == 0 ? pre[m][bj][n] : *(const f32x4*)(base + off + bj * HALF + n * 16); f32x4 o = bs + (acc[ai][bj][m][n] - sr.x) * sr.y;
                        if (bad) o = (f32x4){qnan, qnan, qnan, qnan}; *(f32x4*)(out + off + bj * HALF + n * 16) = o; }
                if (m & 1) asm volatile("" ::: "memory"); }
    }
};
struct EpiLnResLn {
    static constexpr bool PERM = false, AFTER_DRAIN = true;
    const float* base; float* out; bf16_t* xn; int ldc; const float* bias; PanelStats st1, st2; unsigned poison;
    __device__ __forceinline__ void fused(f32x4 (&acc)[2][2][4][2], const Unit& u, int wr, int wc, int fr, int fq, PG8_LAS unsigned char* lds, int wid, int lane) const {
        typedef float f32x2v __attribute__((ext_vector_type(2))); typedef unsigned u32x2v __attribute__((ext_vector_type(2)));
        const PG8_LAS f32x2v* S = (const PG8_LAS f32x2v*)(lds + 8192);
        const int col0 = u.pn * BM + wc * 32 + 4 * fq;
#pragma unroll
        for (int bj = 0; bj < 2; ++bj)
#pragma unroll
            for (int n = 0; n < 2; ++n) { const f32x4 bv = bias ? *(const f32x4*)(bias + col0 + bj * HALF + n * 16) : (f32x4){0.f, 0.f, 0.f, 0.f};
#pragma unroll
                for (int ai = 0; ai < 2; ++ai)
#pragma unroll
                    for (int m = 0; m < 4; ++m) acc[ai][bj][m][n] += bv; }
        bool bad = st1.run(acc, u, wr, wc, fr, fq, lds, wid, lane) || poison != 0u;
        const float qnan = __builtin_nanf("");
#pragma unroll
        for (int ai = 0; ai < 2; ++ai)
#pragma unroll
            for (int m = 0; m < 4; ++m) { const int r = ai * HALF + wr * 64 + m * 16 + fr; const f32x2v sr = S[r]; const size_t off = (size_t)(u.pm * BM + r) * ldc + col0;
#pragma unroll
                for (int bj = 0; bj < 2; ++bj)
#pragma unroll
                    for (int n = 0; n < 2; ++n) { const f32x4 bs = *(const f32x4*)(base + off + bj * HALF + n * 16); acc[ai][bj][m][n] = bs + (acc[ai][bj][m][n] - sr.x) * sr.y; }
                asm volatile("" : "+v"(acc[ai][0][m][0]), "+v"(acc[ai][0][m][1]), "+v"(acc[ai][1][m][0]), "+v"(acc[ai][1][m][1]));
                if (m & 1) asm volatile("" ::: "memory"); }
        const bool bad1 = bad;
        bad = st2.run(acc, u, wr, wc, fr, fq, lds, wid, lane) || bad;
#pragma unroll
        for (int ai = 0; ai < 2; ++ai)
#pragma unroll
            for (int m = 0; m < 4; ++m) { const int r = ai * HALF + wr * 64 + m * 16 + fr; const f32x2v sr = S[r]; const size_t off = (size_t)(u.pm * BM + r) * ldc + col0;
#pragma unroll
                for (int bj = 0; bj < 2; ++bj)
#pragma unroll
                    for (int n = 0; n < 2; ++n) { const f32x4 x1 = acc[ai][bj][m][n]; *(f32x4*)(out + off + bj * HALF + n * 16) = bad1 ? (f32x4){qnan, qnan, qnan, qnan} : x1;
                        const f32x4 o = (x1 - sr.x) * sr.y; u32x2v w; w.x = cvt_pk_bf16(o[0], o[1]); w.y = cvt_pk_bf16(o[2], o[3]);
                        if (bad) { w.x = 0x7fc07fc0u; w.y = 0x7fc07fc0u; } *(u32x2v*)(xn + off + bj * HALF + n * 16) = w; }
                asm volatile("" ::: "memory"); }
    }
};

template <class Epi, class Sched, bool ALIGN_EPI = false, bool SP2 = false>
__device__ __forceinline__ void gemm_phase(PG8_LAS unsigned char* lds, const Gemm g, const Sched& S, const Epi& E) {
    const int tid = threadIdx.x, wid = __builtin_amdgcn_readfirstlane(tid >> 6), lane = tid & 63, wr = wid >> 2, wc = wid & 3, fr = lane & 15, fq = lane >> 4;
    const int K = g.K, nt = K / BK;
    unsigned voffA[2], voffB[2];
#pragma unroll
    for (int i = 0; i < 2; ++i) { int R, C; stage_rc(tid * 16 + i * 8192, R, C); const int Rb = Epi::PERM ? ((R & ~31) + perm32(R & 31)) : R;
        voffA[i] = (unsigned)(R * K + C) * 2u; voffB[i] = (unsigned)(Rb * K + C) * 2u; }
    const size_t kstep = (size_t)(BK * 2);
    const size_t hstep = (size_t)HALF * K * 2;
    const size_t tstep = 2 * hstep;
    const unsigned ldsw = (unsigned)wid * 1024u;
    const int aoff = lds_byte(wr * 64 + fr, fq * 8), boff = lds_byte(wc * 32 + fr, fq * 8);
#define PG8_SA(b, h) (((b) * 2 + (h)) * HTB)
#define PG8_SB(b, h) ((4 + (b) * 2 + (h)) * HTB)
#define PG8_STAGE(bufoff, gbase, voff) do { _Pragma("unroll") for (int _i = 0; _i < 2; ++_i) \
        __builtin_amdgcn_global_load_lds((const unsigned*)((const char*)(gbase) + (voff)[_i]), (PG8_LAS unsigned*)(lds + (bufoff) + ldsw + _i * 8192), 16, 0, 0); } while (0)
#define PG8_LDA(dst, b, h) do { _Pragma("unroll") for (int m = 0; m < 4; ++m) _Pragma("unroll") for (int k = 0; k < 2; ++k) dst[m][k] = *(const PG8_LAS bf16x8*)(lds + PG8_SA(b, h) + aoff + m * 2048 + k * 1024); } while (0)
#define PG8_LDB(dst, b, h) do { _Pragma("unroll") for (int n = 0; n < 2; ++n) _Pragma("unroll") for (int k = 0; k < 2; ++k) dst[n][k] = *(const PG8_LAS bf16x8*)(lds + PG8_SB(b, h) + boff + n * 2048 + k * 1024); } while (0)
#define PG8_MMA(ai, bj, At, Bt) do { __builtin_amdgcn_s_setprio(1); _Pragma("unroll") for (int m = 0; m < 4; ++m) _Pragma("unroll") for (int n = 0; n < 2; ++n) _Pragma("unroll") for (int k = 0; k < 2; ++k) \
        acc[ai][bj][m][n] = __builtin_amdgcn_mfma_f32_16x16x32_bf16(Bt[n][k], At[m][k], acc[ai][bj][m][n], 0, 0, 0); __builtin_amdgcn_s_setprio(0); } while (0)
#define PG8_WAIT_V(n) asm volatile("s_waitcnt vmcnt(" #n ")" ::: "memory")
#define PG8_WAIT_L(n) asm volatile("s_waitcnt lgkmcnt(" #n ")" ::: "memory")
#define PG8_BAR __builtin_amdgcn_s_barrier()
#define PG8_SCHED __builtin_amdgcn_sched_barrier(0)
    Unit cur, nxt; int ui = 0;
    if (!S.next(0, cur)) return;
    f32x4 acc[2][2][4][2];
#pragma unroll
    for (int a = 0; a < 2; ++a)
#pragma unroll
        for (int b = 0; b < 2; ++b)
#pragma unroll
            for (int m = 0; m < 4; ++m)
#pragma unroll
                for (int n = 0; n < 2; ++n) acc[a][b][m][n] = (f32x4){0.f, 0.f, 0.f, 0.f};
    bf16x8 At[4][2], B0[2][2], B1[2][2];
    const char* cA = (const char*)g.A + (size_t)cur.pm * tstep; const char* cB = (const char*)g.Bt + (size_t)cur.pn * tstep;
    S.a_ready(cur);
    if constexpr (SP2) {
        PG8_STAGE(PG8_SB(0, 0), cB, voffB); PG8_STAGE(PG8_SB(0, 1), cB + hstep, voffB); PG8_STAGE(PG8_SA(0, 0), cA, voffA); PG8_STAGE(PG8_SA(0, 1), cA + hstep, voffA);
        if (wr == 1) PG8_BAR;
        PG8_WAIT_V(2); PG8_BAR;
        PG8_STAGE(PG8_SB(1, 0), cB + kstep, voffB); PG8_STAGE(PG8_SA(1, 0), cA + kstep, voffA); PG8_STAGE(PG8_SB(1, 1), cB + hstep + kstep, voffB);
        PG8_WAIT_V(6); PG8_BAR;
    } else {
        PG8_STAGE(PG8_SB(0, 0), cB, voffB); PG8_STAGE(PG8_SA(0, 0), cA, voffA); PG8_STAGE(PG8_SB(0, 1), cB + hstep, voffB); PG8_STAGE(PG8_SA(0, 1), cA + hstep, voffA);
        if (wr == 1) PG8_BAR;
        PG8_WAIT_V(4); PG8_BAR;
        PG8_STAGE(PG8_SB(1, 0), cB + kstep, voffB); PG8_STAGE(PG8_SA(1, 0), cA + kstep, voffA); PG8_STAGE(PG8_SB(1, 1), cB + hstep + kstep, voffB);
        PG8_WAIT_V(6); PG8_BAR;
    }
    for (;;) {
        const bool has_next = S.next(ui + 1, nxt);
        const char* nA = has_next ? (const char*)g.A + (size_t)nxt.pm * tstep : cA; const char* nB = has_next ? (const char*)g.Bt + (size_t)nxt.pn * tstep : cB;
        for (int t = 0; t < nt; t += 2) {
            const bool last = (t == nt - 2);
            const char* a1 = cA + (size_t)(t + 1) * kstep;
            const char* a2 = last ? nA : cA + (size_t)(t + 2) * kstep; const char* b2 = last ? nB : cB + (size_t)(t + 2) * kstep;
            const char* a3 = a2 + kstep; const char* b3 = b2 + kstep;
            if (last && has_next) S.a_ready(nxt);
            if constexpr (SP2) {
            PG8_LDB(B0, 0, 0); PG8_LDB(B1, 0, 1); PG8_SCHED; PG8_LDA(At, 0, 0); PG8_STAGE(PG8_SA(1, 1), a1 + hstep, voffA);
            PG8_WAIT_V(8); PG8_WAIT_L(0); PG8_BAR; PG8_MMA(0, 0, At, B0); PG8_MMA(0, 1, At, B1); PG8_BAR; PG8_SCHED;
            PG8_LDA(At, 0, 1); PG8_STAGE(PG8_SB(0, 0), b2, voffB); PG8_STAGE(PG8_SB(0, 1), b2 + hstep, voffB); PG8_STAGE(PG8_SA(0, 0), a2, voffA);
            PG8_WAIT_V(8); PG8_WAIT_L(0); PG8_BAR; PG8_MMA(1, 0, At, B0); PG8_MMA(1, 1, At, B1); PG8_BAR; PG8_SCHED;
            PG8_LDB(B0, 1, 0); PG8_LDB(B1, 1, 1); PG8_SCHED; PG8_LDA(At, 1, 0); PG8_STAGE(PG8_SA(0, 1), a2 + hstep, voffA);
            PG8_WAIT_V(8); PG8_WAIT_L(0); PG8_BAR; PG8_MMA(0, 0, At, B0); PG8_MMA(0, 1, At, B1); PG8_BAR; PG8_SCHED;
            PG8_LDA(At, 1, 1); PG8_STAGE(PG8_SB(1, 0), b3, voffB); PG8_STAGE(PG8_SB(1, 1), b3 + hstep, voffB); PG8_STAGE(PG8_SA(1, 0), a3, voffA);
            PG8_WAIT_V(8); PG8_WAIT_L(0); PG8_BAR; PG8_MMA(1, 0, At, B0); PG8_MMA(1, 1, At, B1); PG8_BAR; PG8_SCHED;
            } else {
            PG8_LDB(B0, 0, 0); PG8_SCHED; PG8_LDA(At, 0, 0); PG8_STAGE(PG8_SA(1, 1), a1 + hstep, voffA);
            PG8_WAIT_L(8); PG8_BAR; PG8_WAIT_L(0); PG8_MMA(0, 0, At, B0); PG8_BAR; PG8_SCHED;
            PG8_LDB(B1, 0, 1); PG8_STAGE(PG8_SB(0, 0), b2, voffB);
            PG8_BAR; PG8_WAIT_L(0); PG8_MMA(0, 1, At, B1); PG8_BAR;
            PG8_LDA(At, 0, 1); PG8_STAGE(PG8_SA(0, 0), a2, voffA);
            PG8_BAR; PG8_WAIT_L(0); PG8_MMA(1, 0, At, B0); PG8_BAR; PG8_SCHED;
            PG8_STAGE(PG8_SB(0, 1), b2 + hstep, voffB);
            PG8_WAIT_V(6); PG8_BAR; PG8_MMA(1, 1, At, B1); PG8_BAR;
            PG8_LDB(B0, 1, 0); PG8_SCHED; PG8_LDA(At, 1, 0); PG8_STAGE(PG8_SA(0, 1), a2 + hstep, voffA);
            PG8_WAIT_L(8); PG8_BAR; PG8_WAIT_L(0); PG8_MMA(0, 0, At, B0); PG8_BAR; PG8_SCHED;
            PG8_LDB(B1, 1, 1); PG8_STAGE(PG8_SB(1, 0), b3, voffB);
            PG8_BAR; PG8_WAIT_L(0); PG8_MMA(0, 1, At, B1); PG8_BAR;
            PG8_LDA(At, 1, 1); PG8_STAGE(PG8_SA(1, 0), a3, voffA);
            PG8_BAR; PG8_WAIT_L(0); PG8_MMA(1, 0, At, B0); PG8_BAR; PG8_SCHED;
            PG8_STAGE(PG8_SB(1, 1), b3 + hstep, voffB);
            PG8_WAIT_V(6); PG8_BAR; PG8_MMA(1, 1, At, B1); PG8_BAR;
            }
        }
        if constexpr (ALIGN_EPI) { if (wr == 0) PG8_BAR; }
        if constexpr (!Epi::AFTER_DRAIN) { E(acc, cur, wr, wc, fr, fq); S.done(cur); }
        if (!has_next) break;
#pragma unroll
        for (int a = 0; a < 2; ++a)
#pragma unroll
            for (int b = 0; b < 2; ++b)
#pragma unroll
                for (int m = 0; m < 4; ++m)
#pragma unroll
                    for (int n = 0; n < 2; ++n) acc[a][b][m][n] = (f32x4){0.f, 0.f, 0.f, 0.f};
        cur = nxt; cA = nA; cB = nB; ++ui;
        if constexpr (ALIGN_EPI) { if (wr == 1) PG8_BAR; }
    }
    PG8_WAIT_V(0);
    if constexpr (!ALIGN_EPI) { if (wr == 0) PG8_BAR; }
    PG8_BAR;
    if constexpr (Epi::AFTER_DRAIN) { E.fused(acc, cur, wr, wc, fr, fq, lds, wid, lane); S.done(cur); }
#undef PG8_SA
#undef PG8_SB
#undef PG8_STAGE
#undef PG8_LDA
#undef PG8_LDB
#undef PG8_MMA
#undef PG8_WAIT_V
#undef PG8_WAIT_L
#undef PG8_BAR
#undef PG8_SCHED
}
}


#ifndef MK_N_LAUNCHES
#define MK_N_LAUNCHES 1
#endif
constexpr int N_PHASES = 9;
constexpr int NWAVES = 8;

constexpr int DM = 2048, BATCH = 4, SEQ = 4096, NTOK = BATCH * SEQ, NMETA = 16;
constexpr int MPAD = 16640, NTILE_X = MPAD / 256;
constexpr int N_QK = 3328, NT_QK = N_QK / 256;
constexpr int N_V = 1280, NT_V = N_V / 256;
constexpr int NT_W = NT_QK + NT_V;
constexpr int P1_UNITS_A = NTILE_X * NT_QK, P1_UNITS = P1_UNITS_A + NT_V * NTILE_X;
constexpr int NEXP = 64, DEXP = 512, MAXTILES = 192, SPAD = MAXTILES * 256;
constexpr float RMS_EPS = 1e-6f;
constexpr float LOG2E = 1.4426950408889634f;
constexpr float C2 = 0.125f * LOG2E;
constexpr float SB_EXIT = -150.0f;

constexpr size_t MiB = 1u << 20;
constexpr size_t WS_CTL = 0, CTL_ZERO_BYTES = 1 * MiB;
constexpr size_t WS_BIG = 1 * MiB;
constexpr size_t WS_QS = 84 * MiB, WS_KS = WS_QS + (size_t)MPAD * 1024 * 2, WS_QW = WS_KS + (size_t)MPAD * 1024 * 2, WS_KW = WS_QW + (size_t)MPAD * 1024 * 2;
constexpr size_t WS_VT = 190 * MiB;
constexpr size_t WS_ASORT = 1 * MiB;
constexpr size_t WS_MIXED = 231 * MiB, WS_HB = 295 * MiB;
constexpr size_t WS_Y = 231 * MiB;
constexpr size_t WS_HDN = 423 * MiB;
constexpr size_t WS_WOUT = 471 * MiB, WS_WR = 479 * MiB;
constexpr size_t WS_WGU = 480 * MiB, WS_WD = 736 * MiB;
constexpr size_t WS_LIST = 864 * MiB, WS_GATEW = 868 * MiB, WS_TOKINFO = 872 * MiB, WS_RSTD = 873 * MiB, WS_RSORT = 874 * MiB, WS_GSORT = 875 * MiB;
constexpr size_t WS_END = 880 * MiB;
static_assert(WS_KW + (size_t)MPAD * 256 * 2 <= WS_VT && WS_VT + (size_t)N_V * MPAD * 2 <= WS_MIXED && WS_ASORT + (size_t)SPAD * 2048 * 2 <= WS_MIXED, "ws map 1");
static_assert(WS_Y + (size_t)SPAD * 2048 * 2 <= WS_HDN && WS_HDN + (size_t)SPAD * 512 * 2 <= WS_WOUT, "ws map 2");
static_assert(WS_BIG + (size_t)(NTILE_X + NT_W) * 256 * 2048 * 2 <= WS_QS, "ws map 3");
constexpr int CW_TMO = 0, CW_BAR = 4096, CW_CNT = 8192;

constexpr int RING_OFF = 0, RING_BYTES = 131072;
constexpr int MISC_OFF = RING_BYTES;
constexpr int TBL_OFF = MISC_OFF + 256;
constexpr int TBL_TSTART = 0, TBL_NT = 65, TBL_TE = 66, TBL_WORDS = 66 + MAXTILES;
constexpr int LDS_BYTES = 147456;
static_assert(TBL_OFF + TBL_WORDS * 4 <= LDS_BYTES, "LDS map");

#define LAS __attribute__((address_space(3)))
typedef unsigned short bf16;
typedef unsigned v4u __attribute__((ext_vector_type(4)));
typedef unsigned v2u __attribute__((ext_vector_type(2)));
typedef float f32x4 __attribute__((ext_vector_type(4)));
typedef float f32x16 __attribute__((ext_vector_type(16)));
typedef short bf16x8 __attribute__((ext_vector_type(8)));
typedef _Float16 f16x8 __attribute__((ext_vector_type(8)));
typedef _Float16 f16x2 __attribute__((ext_vector_type(2)));
typedef float f32x2 __attribute__((ext_vector_type(2)));
typedef __bf16 bf16x2_t __attribute__((ext_vector_type(2)));
#define LDS_WAIT() asm volatile("s_waitcnt lgkmcnt(0)" ::: "memory")
#define VM_WAIT() asm volatile("s_waitcnt vmcnt(0)" ::: "memory")
__device__ __forceinline__ unsigned pk2(float lo, float hi) { f32x2 v = {lo, hi}; bf16x2_t b = __builtin_convertvector(v, bf16x2_t); return __builtin_bit_cast(unsigned, b); }
__device__ __forceinline__ float bf_lo(unsigned u) { return __uint_as_float(u << 16); }
__device__ __forceinline__ float bf_hi(unsigned u) { return __uint_as_float(u & 0xffff0000u); }
__device__ __forceinline__ float wave_sum(float v) {
#pragma unroll
    for (int o = 1; o < 64; o <<= 1) v += __shfl_xor(v, o);
    return v;
}
__device__ __forceinline__ int crow(int reg, int h) { return (reg & 3) + 8 * (reg >> 2) + 4 * h; }

#define XB_TMO      128
#define XB_XCNT(j)  (256  + 64 * (j))
#define XB_XSUB(j)  (1280 + 64 * (j))
#define XB_XGEN(j)  (2304 + 64 * (j))
#define XB_TOP      3328
#define XB_TOPGEN   3392
#define XCD_BAR_WORDS 3456
#define XB_SPIN_CAP (1u << 18)

__device__ __forceinline__ unsigned xb_ld(unsigned* p)              { return __hip_atomic_load(p, __ATOMIC_RELAXED, __HIP_MEMORY_SCOPE_AGENT); }
__device__ __forceinline__ unsigned xb_add(unsigned* p, unsigned v) { return __hip_atomic_fetch_add(p, v, __ATOMIC_RELAXED, __HIP_MEMORY_SCOPE_AGENT); }
__device__ __forceinline__ unsigned xb_xcc_id() { return (unsigned)__builtin_amdgcn_s_getreg((3 << 11) | 20) & 0xFu; }
#define XB_SPIN(cond, bar) do { unsigned _sp = 0; while (cond) { __builtin_amdgcn_s_sleep(1); \
    if ((++_sp & 255u) == 0u) { if (xb_ld(&(bar)[XB_TMO])) break; if (_sp > XB_SPIN_CAP) { atomicAdd(&(bar)[XB_TMO], 1u); break; } } } } while (0)

struct XcdBarrier {
    unsigned* bar; unsigned x;
    volatile LAS unsigned* st;
};

__device__ __forceinline__ XcdBarrier xcd_barrier_post(unsigned* bar, volatile LAS unsigned* st) {
    XcdBarrier b; b.bar = bar; b.x = xb_xcc_id(); b.st = st;
    if (threadIdx.x == 0) (void)xb_add(&bar[XB_XCNT(b.x)], 1u);
    return b;
}
__device__ __forceinline__ void xcd_barrier_complete(unsigned* bar, unsigned x, unsigned& nloc, unsigned& nx) {
    const unsigned G = gridDim.x * gridDim.y * gridDim.z;
    unsigned sum, cnt, mine, sp = 0u;
    for (;;) {
        sum = 0u; cnt = 0u; mine = 0u;
#pragma unroll
        for (unsigned j = 0; j < 16; ++j) { const unsigned c = xb_ld(&bar[XB_XCNT(j)]); sum += c; cnt += (c > 0u) ? 1u : 0u; mine = (j == x) ? c : mine; }
        if (sum == G) break;
        __builtin_amdgcn_s_sleep(1);
        if ((++sp & 255u) == 0u) { if (xb_ld(&bar[XB_TMO])) break; if (sp > XB_SPIN_CAP) { atomicAdd(&bar[XB_TMO], 1u); break; } }
    }
    nloc = mine > 0u ? mine : 1u; nx = cnt > 0u ? cnt : 1u;
}

__device__ __forceinline__ void xcd_barrier(const XcdBarrier& b) {
    asm volatile("s_waitcnt vmcnt(0)" ::: "memory");
    __syncthreads();
    if (threadIdx.x == 0) {
        unsigned* bar = b.bar;
        __builtin_amdgcn_s_waitcnt(0);
        unsigned nloc = b.st[0], nx = b.st[1];
        if (nloc == 0u) { xcd_barrier_complete(bar, b.x, nloc, nx); b.st[0] = nloc; b.st[1] = nx; }
        const unsigned old = xb_add(&bar[XB_XSUB(b.x)], 1u);
        const unsigned gen = old / nloc;
        if (old + 1u == (gen + 1u) * nloc) {
            __builtin_amdgcn_fence(__ATOMIC_RELEASE, "agent");
            asm volatile("s_waitcnt vmcnt(0)" ::: "memory");
            const unsigned og = xb_add(&bar[XB_TOP], 1u);
            const unsigned tg = og / nx;
            if (og + 1u == (tg + 1u) * nx) xb_add(&bar[XB_TOPGEN], 1u);
            else XB_SPIN(xb_ld(&bar[XB_TOPGEN]) == tg, bar);
            __builtin_amdgcn_fence(__ATOMIC_ACQUIRE, "agent");
            xb_add(&bar[XB_XGEN(b.x)], 1u);
            asm volatile("s_waitcnt vmcnt(0)" ::: "memory");
        } else {
            XB_SPIN(xb_ld(&bar[XB_XGEN(b.x)]) == gen, bar);
            __builtin_amdgcn_fence(__ATOMIC_ACQUIRE, "agent");
            asm volatile("s_waitcnt vmcnt(0)" ::: "memory");
        }
    }
    __syncthreads();
}


struct Args { const float* in[19]; float* out; unsigned char* ws; int ph_lo, ph_hi; };
struct Frame {
    LAS unsigned char* lds; unsigned* ctl; unsigned char* ws;
    int tid, lane, wave, vcu, G;
    const float* in[19]; float* out;
};

__device__ __forceinline__ void tr_item(const float* src, int ldsrc, int scol0, const float* gain, bf16* dst, size_t drow0, int ldd, int k0, LAS float* scr, int lane) {
#pragma unroll 8
    for (int i = 0; i < 32; ++i) { const int kk = 2 * i + (lane >> 5); float v = src[(size_t)(k0 + kk) * ldsrc + scol0 + (lane & 31)]; if (gain) v *= gain[k0 + kk]; scr[kk * 33 + (lane & 31)] = v; }
    LDS_WAIT(); asm volatile("" ::: "memory");
    const int c = lane & 7;
#pragma unroll
    for (int j = 0; j < 4; ++j) { const int n = (lane >> 3) + 8 * j; const LAS float* s = scr + (8 * c) * 33 + n;
        v4u o; o.x = pk2(s[0 * 33], s[1 * 33]); o.y = pk2(s[2 * 33], s[3 * 33]); o.z = pk2(s[4 * 33], s[5 * 33]); o.w = pk2(s[6 * 33], s[7 * 33]);
        *(v4u*)(dst + (drow0 + n) * (size_t)ldd + k0 + 8 * c) = o; }
    LDS_WAIT(); asm volatile("" ::: "memory");
}
__device__ __forceinline__ int win_src_col(int P) {
    if (P < 2048) return P;
    if (P < 3328) { const int p = P - 2048, t = p >> 8, pp = p & 255, bj = pp >> 7, wc = (pp & 127) >> 5, i = pp & 31; return (t < 4 ? 3072 + t * 256 : 4096) + 64 * wc + 32 * bj + i; }
    if (P < 4352) return 2048 + (P - 3328);
    return P;
}
__device__ __forceinline__ void rms_row_to_bf16(const float* xrow, bf16* orow, int lane) {
    const f32x4* xr = (const f32x4*)xrow + lane;
    f32x4 v[8]; float s = 0.f;
#pragma unroll
    for (int j = 0; j < 8; ++j) { v[j] = xr[64 * j]; s += (v[j].x * v[j].x + v[j].y * v[j].y) + (v[j].z * v[j].z + v[j].w * v[j].w); }
    const float rstd = 1.0f / sqrtf(wave_sum(s) * (1.f / DM) + RMS_EPS);
    v2u* o8 = (v2u*)orow + lane;
#pragma unroll
    for (int j = 0; j < 8; ++j) { v2u w; w.x = pk2(v[j].x * rstd, v[j].y * rstd); w.y = pk2(v[j].z * rstd, v[j].w * rstd); o8[64 * j] = w; }
}
__device__ __forceinline__ void p0_prologue(Frame& F) {
    LAS float* scr = (LAS float*)(F.lds + RING_OFF + F.wave * 16384);
    const int gw = F.vcu * NWAVES + F.wave, NGW = F.G * NWAVES;
    bf16* BIG = (bf16*)(F.ws + WS_BIG);
    bf16* WIN = BIG + (size_t)MPAD * DM;
    const float* x = F.in[0]; const float* meta = F.in[1]; const float* ln_mix = F.in[3]; const float* w_in = F.in[4];
    const float* on_sb = F.in[8]; const float* on_sw = F.in[9]; const float* w_out = F.in[10]; const float* ln_ffn = F.in[11];
    const float* w_rg = F.in[12]; const float* w_re = F.in[14]; const float* w_gate = F.in[16]; const float* w_up = F.in[17]; const float* w_down = F.in[18];
    for (int m = gw; m < MPAD; m += NGW) {
        bf16* orow = BIG + (size_t)m * DM;
        if (m < NTOK) rms_row_to_bf16(x + (size_t)m * DM, orow, F.lane);
        else if (m < NTOK + NMETA) rms_row_to_bf16(meta + (size_t)(m - NTOK) * DM, orow, F.lane);
        else { v4u z = {0u, 0u, 0u, 0u}; v4u* o = (v4u*)orow + F.lane;
#pragma unroll
            for (int j = 0; j < 4; ++j) o[64 * j] = z; }
    }
    constexpr int I_IN = 32 * 144, I_OUT = 32 * 64, I_GU = NEXP * 32 * 32, I_D = NEXP * 8 * 64;
    constexpr int NITEMS = I_IN + I_OUT + I_GU + I_D;
    bf16* WOUT = (bf16*)(F.ws + WS_WOUT); bf16* WGU = (bf16*)(F.ws + WS_WGU); bf16* WD = (bf16*)(F.ws + WS_WD);
    for (int it = gw; it < NITEMS; it += NGW) {
        int r = it;
        if (r < I_IN) { const int kb = r / 144, nb = r % 144; tr_item(w_in, 4608, win_src_col(32 * nb), ln_mix, WIN, (size_t)32 * nb, DM, 64 * kb, scr, F.lane); continue; } r -= I_IN;
        if (r < I_OUT) { const int kb = r / 64, nb = r % 64; tr_item(w_out, DM, 32 * nb, (64 * kb < 1024) ? on_sb : (on_sw - 1024), WOUT, (size_t)32 * nb, DM, 64 * kb, scr, F.lane); continue; } r -= I_OUT;
        if (r < I_GU) { const int e = r >> 10, q = r & 1023, kb = q >> 5, nb = q & 31;
            const int nt = nb >> 3, bj = (nb >> 2) & 1, j0 = (nb & 3) * 32;
            tr_item((bj ? w_up : w_gate) + (size_t)e * DM * DEXP, DEXP, nt * 128 + j0, ln_ffn, WGU, (size_t)e * 1024 + 32 * nb, DM, 64 * kb, scr, F.lane); continue; } r -= I_GU;
        { const int e = r >> 9, q = r & 511, kb = q >> 6, nb = q & 63;
            tr_item(w_down + (size_t)e * DEXP * DM, DM, 32 * nb, nullptr, WD, (size_t)e * 2048 + 32 * nb, DEXP, 64 * kb, scr, F.lane); }
    }
    bf16* WRH = (bf16*)(F.ws + WS_WR); bf16* WRL = WRH + 96 * DM;
    for (int idx = (F.vcu * NWAVES * 64 + F.tid); idx < 96 * DM; idx += F.G * NWAVES * 64) {
        const int c = idx / DM, k = idx % DM;
        float v = 0.f; if (c < 8) v = w_rg[k * 8 + c]; else if (c < 72) v = w_re[k * 64 + (c - 8)];
        v *= ln_ffn[k];
        const unsigned hi = pk2(v, 0.f) & 0xffffu; const float lo = v - __uint_as_float(hi << 16);
        WRH[idx] = (bf16)hi; WRL[idx] = (bf16)(pk2(lo, 0.f) & 0xffffu);
    }
}

struct P1Order {
    int G, c;
    __device__ bool next(int i, pg8::Unit& u) const {
        const int L = i * G + c; if (L >= P1_UNITS) return false;
        if (L < P1_UNITS_A) { u.pm = L / NT_QK; u.pn = NTILE_X + (L % NT_QK); }
        else { const int l = L - P1_UNITS_A; u.pm = NTILE_X + NT_QK + l / NTILE_X; u.pn = l % NTILE_X; }
        return true;
    }
    __device__ __forceinline__ void a_ready(const pg8::Unit&) const {}
    __device__ __forceinline__ void done(const pg8::Unit&) const {}
};
struct EpiQKV {
    static constexpr bool PERM = true, AFTER_DRAIN = false;
    bf16 *QS, *KS, *QW, *KW, *VT; const float *q_norm, *k_norm;
    __device__ __forceinline__ void operator()(const pg8::f32x4 (&acc)[2][2][4][2], const pg8::Unit& u, int wr, int wc, int fr, int fq) const {
        using pg8::HALF;
        if (u.pm < NTILE_X) {
            const int t = u.pn - NTILE_X; const int row0 = u.pm * 256 + wr * 64 + fr;
            if (t < 8) {
                bf16* base = (t < 4) ? QS : KS; const float sc = (t < 4) ? C2 : 1.0f; const int col0 = (t & 3) * 256 + wc * 32 + 8 * fq;
#pragma unroll
                for (int ai = 0; ai < 2; ++ai)
#pragma unroll
                    for (int m = 0; m < 4; ++m) { bf16* rowp = base + (size_t)(row0 + ai * HALF + m * 16) * 1024 + col0;
#pragma unroll
                        for (int bj = 0; bj < 2; ++bj) { const pg8::f32x4 v0 = acc[ai][bj][m][0] * sc, v1 = acc[ai][bj][m][1] * sc;
                            v4u w; w.x = pk2(v0[0], v0[1]); w.y = pk2(v0[2], v0[3]); w.z = pk2(v1[0], v1[1]); w.w = pk2(v1[2], v1[3]); *(v4u*)(rowp + bj * HALF) = w; } }
            } else {
                const bool isq = t < 12; const float* gain = isq ? q_norm : k_norm; const float sc = isq ? C2 : 1.0f;
                bf16* base = isq ? (QW + (t - 8) * 256 + wc * 64) : (KW + wc * 64); const int ld = isq ? 1024 : 256;
                pg8::f32x4 g[2][2];
#pragma unroll
                for (int bj = 0; bj < 2; ++bj)
#pragma unroll
                    for (int n = 0; n < 2; ++n) g[bj][n] = *(const pg8::f32x4*)(gain + 32 * bj + 8 * fq + 4 * n) * sc;
#pragma unroll
                for (int ai = 0; ai < 2; ++ai)
#pragma unroll
                    for (int m = 0; m < 4; ++m) {
                        float ss = 0.f;
#pragma unroll
                        for (int bj = 0; bj < 2; ++bj)
#pragma unroll
                            for (int n = 0; n < 2; ++n) { const pg8::f32x4 v = acc[ai][bj][m][n]; ss += (v[0] * v[0] + v[1] * v[1]) + (v[2] * v[2] + v[3] * v[3]); }
                        ss += __shfl_xor(ss, 16); ss += __shfl_xor(ss, 32);
                        const float rstd = 1.0f / sqrtf(ss * (1.0f / 64.0f) + RMS_EPS);
                        bf16* rowp = base + (size_t)(row0 + ai * HALF + m * 16) * ld + 8 * fq;
#pragma unroll
                        for (int bj = 0; bj < 2; ++bj) { const pg8::f32x4 v0 = acc[ai][bj][m][0] * rstd * g[bj][0], v1 = acc[ai][bj][m][1] * rstd * g[bj][1];
                            v4u w; w.x = pk2(v0[0], v0[1]); w.y = pk2(v0[2], v0[3]); w.z = pk2(v1[0], v1[1]); w.w = pk2(v1[2], v1[3]); *(v4u*)(rowp + 32 * bj) = w; } }
            }
        } else {
            const int vrow0 = (u.pm - NTILE_X - NT_QK) * 256 + wr * 64 + fr;
#pragma unroll
            for (int ai = 0; ai < 2; ++ai)
#pragma unroll
                for (int m = 0; m < 4; ++m) { bf16* rowp = VT + (size_t)(vrow0 + ai * HALF + m * 16) * MPAD + u.pn * 256 + wc * 32 + 16 * (fq >> 1) + 4 * (fq & 1);
#pragma unroll
                    for (int bj = 0; bj < 2; ++bj)
#pragma unroll
                        for (int n = 0; n < 2; ++n) { const pg8::f32x4 v = acc[ai][bj][m][n]; v2u w; w.x = pk2(v[0], v[1]); w.y = pk2(v[2], v[3]); *(v2u*)(rowp + bj * HALF + 8 * n) = w; } }
        }
    }
};

namespace att {
__device__ __forceinline__ f32x16 mfma_bf(bf16x8 a, bf16x8 b, f32x16 c) { return __builtin_amdgcn_mfma_f32_32x32x16_bf16(a, b, c, 0, 0, 0); }
__device__ __forceinline__ f32x16 mfma_h(f16x8 a, f16x8 b, f32x16 c) { return __builtin_amdgcn_mfma_f32_32x32x16_f16(a, b, c, 0, 0, 0); }
__device__ __forceinline__ bf16x8 ld8(const bf16* p) { return *(const bf16x8*)p; }
__device__ __forceinline__ bf16x8 pack8(const float* w) { v4u o; o.x = pk2(w[0], w[1]); o.y = pk2(w[2], w[3]); o.z = pk2(w[4], w[5]); o.w = pk2(w[6], w[7]); return __builtin_bit_cast(bf16x8, o); }

struct KT { bf16x8 k[4]; };
__device__ __forceinline__ void load_k(KT& t, const bf16* Kb, int ldk, int b, int j, int r, int h) {
    const int krow = (j >= 0) ? (b * SEQ + 32 * j + r) : (NTOK + (r & 15));
    const bf16* kp = Kb + (size_t)krow * ldk + 8 * h;
#pragma unroll
    for (int s = 0; s < 4; ++s) t.k[s] = ld8(kp + 16 * s);
}
__device__ __forceinline__ void load_v(bf16x8 (&v)[4], const bf16* Vrow  , int b, int j, int h) {
    const int col0 = (j >= 0) ? (b * SEQ + 32 * j) : NTOK; const int s1 = (j >= 0) ? 16 : 0;
    const bf16* vp = Vrow + col0 + 8 * h;
    v[0] = ld8(vp); v[1] = ld8(vp + s1); v[2] = ld8(vp + (size_t)32 * MPAD); v[3] = ld8(vp + (size_t)32 * MPAD + s1);
}

struct SbState { f32x16 o0, o1; float R; };
template <int KIND>
__device__ __forceinline__ void sb_tile(SbState& S, const KT& t, const bf16* Vrow, int b, int j, const bf16x8 (&qf)[4], const f16x8& U0, const f16x8& U1, int r, int h) {
    bf16x8 tv[4]; load_v(tv, Vrow, b, j, h);
    f32x16 z = {0.f, 0.f, 0.f, 0.f, 0.f, 0.f, 0.f, 0.f, 0.f, 0.f, 0.f, 0.f, 0.f, 0.f, 0.f, 0.f};
#pragma unroll
    for (int s = 0; s < 4; ++s) z = mfma_bf(t.k[s], qf[s], z);
    f32x16 init; float L[16];
#pragma unroll
    for (int g = 0; g < 16; ++g) {
        const float zz = z[g];
        const float e = __builtin_amdgcn_exp2f(-__builtin_fabsf(zz));
        const float sp = __builtin_fmaxf(zz, 0.f) + __builtin_amdgcn_logf(1.0f + e);
        float Lv = -sp;
        if (KIND == 1) Lv = (crow(g, h) < r) ? Lv : 0.f;
        if (KIND == 2) Lv = (crow(g, h) < 16) ? Lv : 0.f;
        L[g] = Lv; init[g] = zz + Lv + S.R;
    }
    f16x8 lb0, lb1;
#pragma unroll
    for (int j = 0; j < 8; ++j) { lb0[j] = (_Float16)L[j]; lb1[j] = (_Float16)L[8 + j]; }
    f32x16 lw = mfma_h(U0, lb0, init); lw = mfma_h(U1, lb1, lw);
    float Rn = lw[0] - z[0];
    Rn = __shfl(Rn, r);
    float w[16];
#pragma unroll
    for (int g = 0; g < 16; ++g) {
        float wv = __builtin_amdgcn_exp2f(lw[g]);
        if (KIND == 1) wv = (crow(g, h) < r) ? wv : 0.f;
        if (KIND == 2) wv = (crow(g, h) < 16) ? wv : 0.f;
        w[g] = wv;
    }
    const bf16x8 wb0 = pack8(w), wb1 = pack8(w + 8);
    S.o0 = mfma_bf(tv[0], wb0, S.o0); S.o0 = mfma_bf(tv[1], wb1, S.o0);
    S.o1 = mfma_bf(tv[2], wb0, S.o1); S.o1 = mfma_bf(tv[3], wb1, S.o1);
    S.R = Rn;
}

struct SwState { f32x16 o0, o1; float m, l; };
template <int KIND>
__device__ __forceinline__ void sw_tile(SwState& S, const KT& t, const bf16* Vrow, int b, int j, const bf16x8 (&qf)[4], const LAS float* tb, int r, int h) {
    bf16x8 tv[4]; load_v(tv, Vrow, b, j, h);
    f32x16 z = {0.f, 0.f, 0.f, 0.f, 0.f, 0.f, 0.f, 0.f, 0.f, 0.f, 0.f, 0.f, 0.f, 0.f, 0.f, 0.f};
#pragma unroll
    for (int s = 0; s < 4; ++s) z = mfma_bf(t.k[s], qf[s], z);
    float sc[16]; float mx = -1e30f;
#pragma unroll
    for (int g = 0; g < 16; ++g) {
        float v = z[g] + tb[(g & 3) + 8 * (g >> 2)];
        if (KIND == 1) v = (crow(g, h) <= r) ? v : -1e30f;
        if (KIND == 2) v = (crow(g, h) < 16) ? v : -1e30f;
        if (KIND == 3) v = (crow(g, h) > r) ? v : -1e30f;
        sc[g] = v; mx = __builtin_fmaxf(mx, v);
    }
    mx = __builtin_fmaxf(mx, __shfl_xor(mx, 32));
    const float mn = __builtin_fmaxf(S.m, mx);
    const float alpha = __builtin_amdgcn_exp2f(S.m - mn);
    S.l *= alpha; S.o0 *= alpha; S.o1 *= alpha;
    float p[16]; float ls = 0.f;
#pragma unroll
    for (int g = 0; g < 16; ++g) { p[g] = __builtin_amdgcn_exp2f(sc[g] - mn); ls += p[g]; }
    S.l += ls; S.m = mn;
    const bf16x8 wb0 = pack8(p), wb1 = pack8(p + 8);
    S.o0 = mfma_bf(tv[0], wb0, S.o0); S.o0 = mfma_bf(tv[1], wb1, S.o0);
    S.o1 = mfma_bf(tv[2], wb0, S.o1); S.o1 = mfma_bf(tv[3], wb1, S.o1);
}
__device__ __forceinline__ float store_o(bf16* orow, const f32x16& o0, const f32x16& o1, float scale, int h) {
    float ss = 0.f;
#pragma unroll
    for (int q = 0; q < 4; ++q) {
        const float a0 = o0[4 * q] * scale, a1 = o0[4 * q + 1] * scale, a2 = o0[4 * q + 2] * scale, a3 = o0[4 * q + 3] * scale;
        const float b0 = o1[4 * q] * scale, b1 = o1[4 * q + 1] * scale, b2 = o1[4 * q + 2] * scale, b3 = o1[4 * q + 3] * scale;
        ss += ((a0 * a0 + a1 * a1) + (a2 * a2 + a3 * a3)) + ((b0 * b0 + b1 * b1) + (b2 * b2 + b3 * b3));
        v2u w; w.x = pk2(a0, a1); w.y = pk2(a2, a3); *(v2u*)(orow + 8 * q + 4 * h) = w;
        v2u x; x.x = pk2(b0, b1); x.y = pk2(b2, b3); *(v2u*)(orow + 32 + 8 * q + 4 * h) = x;
    }
    return ss;
}
}

__device__ __forceinline__ void p2_attention(Frame& F) {
    using namespace att;
    const int lane = F.lane, r = lane & 31, h = lane >> 5, w = F.wave;
    const bf16* VT = (const bf16*)(F.ws + WS_VT); bf16* MIX = (bf16*)(F.ws + WS_MIXED);
    LAS float* tbr = (LAS float*)(F.lds + RING_OFF);
    LAS float* ssx = (LAS float*)(F.lds + RING_OFF + 16384);
    LAS float* rsx = (LAS float*)(F.lds + RING_OFF + 16384 + 2048);
    { const float* rel_bias = F.in[2];
      for (int idx = F.tid; idx < 16 * 192; idx += NWAVES * 64) {
        const int hq = idx / 192, x = idx % 192, d = 159 - x; float v = 0.f;
        if (d >= 0) { int bkt = d; if (d >= 16) { bkt = 16 + (int)(logf((float)d / 16.0f) / logf(8.0f) * 16.0f); bkt = bkt > 31 ? 31 : bkt; } v = rel_bias[bkt * 16 + hq] * LOG2E; }
        tbr[idx] = v;
      } }
    __syncthreads();
    for (int unit = F.vcu; unit < NTOK / 32; unit += F.G) {
        const int b = unit >> 7, a = unit & 127;
        const size_t qrow = (size_t)b * SEQ + 32 * a + r;
        {
            const bf16* QS = (const bf16*)(F.ws + WS_QS); const bf16* KS = (const bf16*)(F.ws + WS_KS);
            f16x8 U0, U1;
#pragma unroll
            for (int j = 0; j < 8; ++j) { const int c0 = 8 * (j >> 2) + 4 * h + (j & 3); U0[j] = (c0 > r) ? (_Float16)1.0f : (_Float16)0.0f; U1[j] = (16 + c0 > r) ? (_Float16)1.0f : (_Float16)0.0f; }
            float ssl = 0.f;
#pragma unroll 1
            for (int hh = 0; hh < 2; ++hh) {
                const int head = 2 * w + hh;
                bf16x8 qf[4];
#pragma unroll
                for (int s = 0; s < 4; ++s) qf[s] = ld8(QS + qrow * 1024 + head * 64 + 16 * s + 8 * h);
                const bf16* Kb = KS + head * 64; const bf16* Vrow = VT + (size_t)(head * 64 + r) * MPAD;
                SbState S; S.R = 0.f;
#pragma unroll
                for (int g = 0; g < 16; ++g) { S.o0[g] = 0.f; S.o1[g] = 0.f; }
                KT cur; load_k(cur, Kb, 1024, b, a, r, h);
                int jt = a;
                for (;;) {
                    KT nxt; const bool has_next = jt >= 0;
                    if (has_next) load_k(nxt, Kb, 1024, b, jt - 1, r, h);
                    if (jt == a) sb_tile<1>(S, cur, Vrow, b, jt, qf, U0, U1, r, h);
                    else if (jt >= 0) sb_tile<0>(S, cur, Vrow, b, jt, qf, U0, U1, r, h);
                    else sb_tile<2>(S, cur, Vrow, b, jt, qf, U0, U1, r, h);
                    if (!has_next || __all(S.R < SB_EXIT)) break;
                    cur = nxt; --jt;
                }
                ssl += store_o(MIX + qrow * DM + head * 64, S.o0, S.o1, 1.0f, h);
            }
            ssl += __shfl_xor(ssl, 32);
            if (h == 0) ssx[w * 32 + r] = ssl;
        }
        {
            const bf16* QW = (const bf16*)(F.ws + WS_QW); const bf16* KW = (const bf16*)(F.ws + WS_KW);
            float ssl = 0.f;
#pragma unroll 1
            for (int hh = 0; hh < 2; ++hh) {
                const int hq = 2 * w + hh, kvh = w >> 1;
                bf16x8 qf[4];
#pragma unroll
                for (int s = 0; s < 4; ++s) qf[s] = ld8(QW + qrow * 1024 + hq * 64 + 16 * s + 8 * h);
                const bf16* Kb = KW + kvh * 64; const bf16* Vrow = VT + (size_t)(1024 + kvh * 64 + r) * MPAD;
                const float sink2 = F.in[7][hq] * LOG2E;
                SwState S; S.m = sink2; S.l = 0.f;
#pragma unroll
                for (int g = 0; g < 16; ++g) { S.o0[g] = 0.f; S.o1[g] = 0.f; }
                const LAS float* tbh = tbr + hq * 192 + 4 * h;
                const int jlo = (a >= 4) ? a - 4 : 0;
                KT cur; load_k(cur, Kb, 256, b, a, r, h);
#pragma unroll 1
                for (int jt = a; jt >= jlo; --jt) {
                    KT nxt; load_k(nxt, Kb, 256, b, (jt > jlo) ? jt - 1 : -1, r, h);
                    const LAS float* tb = tbh + (159 - (32 * (a - jt) + r));
                    if (jt == a) sw_tile<1>(S, cur, Vrow, b, jt, qf, tb, r, h);
                    else if (jt == a - 4) sw_tile<3>(S, cur, Vrow, b, jt, qf, tb, r, h);
                    else sw_tile<0>(S, cur, Vrow, b, jt, qf, tb, r, h);
                    cur = nxt;
                }
                { const int dq = 32 * a + r + 16; sw_tile<2>(S, cur, Vrow, b, -1, qf, tbh + (159 - (dq < 159 ? dq : 159)), r, h); }
                const float lt = S.l + __shfl_xor(S.l, 32) + __builtin_amdgcn_exp2f(sink2 - S.m);
                ssl += store_o(MIX + qrow * DM + 1024 + hq * 64, S.o0, S.o1, 1.0f / lt, h);
            }
            ssl += __shfl_xor(ssl, 32);
            if (h == 0) ssx[256 + w * 32 + r] = ssl;
        }
        VM_WAIT(); __syncthreads();
        if (F.tid < 64) { float tot = 0.f;
#pragma unroll
            for (int i = 0; i < 8; ++i) tot += ssx[(F.tid >> 5) * 256 + i * 32 + (F.tid & 31)];
            rsx[F.tid] = 1.0f / sqrtf(tot * (1.0f / 1024.0f) + RMS_EPS); }
        __syncthreads();
        {
            bf16* blk = MIX + ((size_t)b * SEQ + 32 * a) * DM;
#pragma unroll 4
            for (int i = 0; i < 16; ++i) { const int c = F.tid + 512 * i, row = c >> 8, ch = c & 255; const float rs = rsx[(ch >> 7) * 32 + row];
                v4u* pp = (v4u*)(blk + (size_t)row * DM) + ch; v4u v = *pp;
                v.x = pk2(bf_lo(v.x) * rs, bf_hi(v.x) * rs); v.y = pk2(bf_lo(v.y) * rs, bf_hi(v.y) * rs); v.z = pk2(bf_lo(v.z) * rs, bf_hi(v.z) * rs); v.w = pk2(bf_lo(v.w) * rs, bf_hi(v.w) * rs);
                *pp = v; }
        }
    }
}

struct EpiRes {
    static constexpr bool PERM = false, AFTER_DRAIN = false;
    const float* x; float* out;
    __device__ __forceinline__ void operator()(const pg8::f32x4 (&acc)[2][2][4][2], const pg8::Unit& u, int wr, int wc, int fr, int fq) const {
        const int col0 = u.pn * 256 + wc * 32 + 4 * fq;
#pragma unroll
        for (int ai = 0; ai < 2; ++ai)
#pragma unroll
            for (int m = 0; m < 4; ++m) { const size_t off = (size_t)(u.pm * 256 + ai * 128 + wr * 64 + m * 16 + fr) * DM + col0;
#pragma unroll
                for (int bj = 0; bj < 2; ++bj)
#pragma unroll
                    for (int n = 0; n < 2; ++n) { const pg8::f32x4 xv = *(const pg8::f32x4*)(x + off + bj * 128 + n * 16); *(pg8::f32x4*)(out + off + bj * 128 + n * 16) = xv + acc[ai][bj][m][n]; } }
    }
};

__device__ __forceinline__ void p4_router(Frame& F) {
    using namespace att;
    const int lane = F.lane, r = lane & 31, h = lane >> 5, w = F.wave;
    const float* hmid = F.out; bf16* HB = (bf16*)(F.ws + WS_HB);
    const bf16* WRH = (const bf16*)(F.ws + WS_WR); const bf16* WRL = WRH + 96 * DM;
    const float* b_rg = F.in[13]; const float* b_re = F.in[15];
    int* LIST = (int*)(F.ws + WS_LIST); float* GATEW = (float*)(F.ws + WS_GATEW); int* TOKINFO = (int*)(F.ws + WS_TOKINFO); float* RSTD = (float*)(F.ws + WS_RSTD);
    LAS float* part = (LAS float*)(F.lds + RING_OFF);
    LAS float* ssp = (LAS float*)(F.lds + RING_OFF + 98304);
    LAS float* lg = (LAS float*)(F.lds + RING_OFF + 98304 + 1024);
    LAS float* rsl = (LAS float*)(F.lds + RING_OFF + 98304 + 1024 + 9216);
    for (int unit = F.vcu; unit < NTOK / 32; unit += F.G) {
        const size_t row = (size_t)unit * 32 + r; const int kb = 256 * w + 8 * h;
        const float* hp = hmid + row * DM + kb; bf16* hbp = HB + row * DM + kb;
        f32x16 acc[3];
#pragma unroll
        for (int nt = 0; nt < 3; ++nt)
#pragma unroll
            for (int g = 0; g < 16; ++g) acc[nt][g] = 0.f;
        float ss = 0.f;
#pragma unroll 4
        for (int s = 0; s < 16; ++s) {
            const f32x4 a0 = *(const f32x4*)(hp + 16 * s), a1 = *(const f32x4*)(hp + 16 * s + 4);
            ss += (a0[0] * a0[0] + a0[1] * a0[1]) + (a0[2] * a0[2] + a0[3] * a0[3]) + (a1[0] * a1[0] + a1[1] * a1[1]) + (a1[2] * a1[2] + a1[3] * a1[3]);
            v4u hi; hi.x = pk2(a0[0], a0[1]); hi.y = pk2(a0[2], a0[3]); hi.z = pk2(a1[0], a1[1]); hi.w = pk2(a1[2], a1[3]);
            v4u lo; lo.x = pk2(a0[0] - bf_lo(hi.x), a0[1] - bf_hi(hi.x)); lo.y = pk2(a0[2] - bf_lo(hi.y), a0[3] - bf_hi(hi.y));
            lo.z = pk2(a1[0] - bf_lo(hi.z), a1[1] - bf_hi(hi.z)); lo.w = pk2(a1[2] - bf_lo(hi.w), a1[3] - bf_hi(hi.w));
            *(v4u*)(hbp + 16 * s) = hi;
            const bf16x8 ahi = __builtin_bit_cast(bf16x8, hi), alo = __builtin_bit_cast(bf16x8, lo);
#pragma unroll
            for (int nt = 0; nt < 3; ++nt) {
                const bf16x8 bh = ld8(WRH + (size_t)(nt * 32 + r) * DM + kb + 16 * s), bl = ld8(WRL + (size_t)(nt * 32 + r) * DM + kb + 16 * s);
                acc[nt] = mfma_bf(ahi, bh, acc[nt]); acc[nt] = mfma_bf(alo, bh, acc[nt]); acc[nt] = mfma_bf(ahi, bl, acc[nt]);
            }
        }
        ss += __shfl_xor(ss, 32);
        if (h == 0) ssp[w * 32 + r] = ss;
#pragma unroll
        for (int nt = 0; nt < 3; ++nt)
#pragma unroll
            for (int g = 0; g < 16; ++g) part[(w * 32 + crow(g, h)) * 96 + nt * 32 + r] = acc[nt][g];
        __syncthreads();
        for (int idx = F.tid; idx < 32 * 72; idx += NWAVES * 64) { const int tk = idx / 72, c = idx % 72; float v = 0.f;
#pragma unroll
            for (int i = 0; i < 8; ++i) v += part[(i * 32 + tk) * 96 + c];
            lg[idx] = v; }
        if (F.tid < 32) { float t = 0.f;
#pragma unroll
            for (int i = 0; i < 8; ++i) t += ssp[i * 32 + F.tid];
            const float rs = 1.0f / sqrtf(t * (1.0f / DM) + RMS_EPS); rsl[F.tid] = rs; RSTD[unit * 32 + F.tid] = rs; }
        __syncthreads();
        if (F.tid < 32) {
            const int tok = unit * 32 + F.tid; const float rs = rsl[F.tid]; const LAS float* l = lg + F.tid * 72;
            float gl[8]; int gi = 0; float gm = -3.0e38f;
#pragma unroll
            for (int i = 0; i < 8; ++i) { gl[i] = l[i] * rs + b_rg[i]; if (gl[i] > gm) { gm = gl[i]; gi = i; } }
            float gs = 0.f;
#pragma unroll
            for (int i = 0; i < 8; ++i) gs += expf(gl[i] - gm);
            const float gval = 1.0f / gs;
            float el[8]; int i0 = 0; float m0 = -3.0e38f;
#pragma unroll
            for (int i = 0; i < 8; ++i) { el[i] = l[8 + gi * 8 + i] * rs + b_re[gi * 8 + i]; if (el[i] > m0) { m0 = el[i]; i0 = i; } }
            int i1 = 0; float m1 = -3.0e38f;
#pragma unroll
            for (int i = 0; i < 8; ++i) if (i != i0 && el[i] > m1) { m1 = el[i]; i1 = i; }
            const float p1 = expf(m1 - m0); const float g0 = gval / (1.0f + p1), g1 = gval * p1 / (1.0f + p1);
            const int e0 = gi * 8 + i0, e1 = gi * 8 + i1;
            const int pos0 = (int)atomicAdd(F.ctl + CW_CNT + 16 * e0, 1u), pos1 = (int)atomicAdd(F.ctl + CW_CNT + 16 * e1, 1u);
            LIST[e0 * NTOK + pos0] = tok; LIST[e1 * NTOK + pos1] = tok; GATEW[e0 * NTOK + pos0] = g0; GATEW[e1 * NTOK + pos1] = g1;
            *(int4*)(TOKINFO + 4 * tok) = make_int4(e0, pos0, e1, pos1);
        }
        __syncthreads();
    }
}

__device__ __forceinline__ void build_tables(Frame& F) {
    LAS int* T = (LAS int*)(F.lds + TBL_OFF);
    __syncthreads();
    if (F.tid == 0) {
        int acc = 0;
        for (int e = 0; e < NEXP; ++e) { const int c = (int)__hip_atomic_load(F.ctl + CW_CNT + 16 * e, __ATOMIC_RELAXED, __HIP_MEMORY_SCOPE_AGENT); const int mt = (c + 255) >> 8;
            T[TBL_TSTART + e] = acc; for (int i = 0; i < mt; ++i) T[TBL_TE + acc + i] = e; acc += mt; }
        T[TBL_TSTART + NEXP] = acc; T[TBL_NT] = acc;
    }
    __syncthreads();
}
__device__ __forceinline__ void p5_gather(Frame& F) {
    const LAS int* T = (const LAS int*)(F.lds + TBL_OFF);
    const int gw = F.vcu * NWAVES + F.wave, NGW = F.G * NWAVES; const int nrows = T[TBL_NT] * 256;
    const bf16* HB = (const bf16*)(F.ws + WS_HB); bf16* AS = (bf16*)(F.ws + WS_ASORT);
    const int* LIST = (const int*)(F.ws + WS_LIST); const float* GATEW = (const float*)(F.ws + WS_GATEW); const float* RSTD = (const float*)(F.ws + WS_RSTD);
    float* RSORT = (float*)(F.ws + WS_RSORT); float* GSORT = (float*)(F.ws + WS_GSORT);
    for (int s = gw; s < nrows; s += NGW) {
        const int e = T[TBL_TE + (s >> 8)], rr = s - T[TBL_TSTART + e] * 256;
        const int cnt = (int)__hip_atomic_load(F.ctl + CW_CNT + 16 * e, __ATOMIC_RELAXED, __HIP_MEMORY_SCOPE_AGENT);
        v4u* dst = (v4u*)(AS + (size_t)s * DM) + F.lane;
        if (rr < cnt) { const int tok = LIST[e * NTOK + rr]; const v4u* src = (const v4u*)(HB + (size_t)tok * DM) + F.lane;
#pragma unroll
            for (int j = 0; j < 4; ++j) dst[64 * j] = src[64 * j];
            if (F.lane == 0) { RSORT[s] = RSTD[tok]; GSORT[s] = GATEW[e * NTOK + rr]; } }
        else { const v4u z = {0u, 0u, 0u, 0u};
#pragma unroll
            for (int j = 0; j < 4; ++j) dst[64 * j] = z;
            if (F.lane == 0) { RSORT[s] = 0.f; GSORT[s] = 0.f; } }
    }
}
struct MoeOrder {
    const LAS int* T; int NT, G, c;
    __device__ bool next(int i, pg8::Unit& u) const {
        const int L = i * G + c; if (L >= T[TBL_NT] * NT) return false;
        const int mt = L / NT; u.pm = mt; u.pn = T[TBL_TE + mt] * NT + (L % NT); return true;
    }
    __device__ __forceinline__ void a_ready(const pg8::Unit&) const {}
    __device__ __forceinline__ void done(const pg8::Unit&) const {}
};
struct EpiSwiGLU {
    static constexpr bool PERM = true, AFTER_DRAIN = false;
    bf16* HDN; const float* RSORT; const float* GSORT;
    __device__ __forceinline__ void operator()(const pg8::f32x4 (&acc)[2][2][4][2], const pg8::Unit& u, int wr, int wc, int fr, int fq) const {
        const int col0 = (u.pn & 3) * 128 + wc * 32 + 8 * fq;
#pragma unroll
        for (int ai = 0; ai < 2; ++ai)
#pragma unroll
            for (int m = 0; m < 4; ++m) { const int row = u.pm * 256 + ai * 128 + wr * 64 + m * 16 + fr; const float rs = RSORT[row], gw = GSORT[row];
                float o[8];
#pragma unroll
                for (int n = 0; n < 2; ++n)
#pragma unroll
                    for (int e = 0; e < 4; ++e) { const float g = acc[ai][0][m][n][e] * rs, up = acc[ai][1][m][n][e] * rs;
                        const float sg = g * __builtin_amdgcn_rcpf(1.0f + __builtin_amdgcn_exp2f(-g * LOG2E)); o[4 * n + e] = sg * up * gw; }
                v4u wv; wv.x = pk2(o[0], o[1]); wv.y = pk2(o[2], o[3]); wv.z = pk2(o[4], o[5]); wv.w = pk2(o[6], o[7]);
                *(v4u*)(HDN + (size_t)row * DEXP + col0) = wv; }
    }
};
struct EpiY {
    static constexpr bool PERM = true, AFTER_DRAIN = false;
    bf16* Y;
    __device__ __forceinline__ void operator()(const pg8::f32x4 (&acc)[2][2][4][2], const pg8::Unit& u, int wr, int wc, int fr, int fq) const {
        const int col0 = (u.pn & 7) * 256 + wc * 32 + 8 * fq;
#pragma unroll
        for (int ai = 0; ai < 2; ++ai)
#pragma unroll
            for (int m = 0; m < 4; ++m) { bf16* rowp = Y + (size_t)(u.pm * 256 + ai * 128 + wr * 64 + m * 16 + fr) * DM + col0;
#pragma unroll
                for (int bj = 0; bj < 2; ++bj) { const pg8::f32x4 v0 = acc[ai][bj][m][0], v1 = acc[ai][bj][m][1];
                    v4u w; w.x = pk2(v0[0], v0[1]); w.y = pk2(v0[2], v0[3]); w.z = pk2(v1[0], v1[1]); w.w = pk2(v1[2], v1[3]); *(v4u*)(rowp + bj * 128) = w; } }
    }
};
__device__ __forceinline__ void p8_combine(Frame& F) {
    const LAS int* T = (const LAS int*)(F.lds + TBL_OFF);
    const int gw = F.vcu * NWAVES + F.wave, NGW = F.G * NWAVES;
    const bf16* Y = (const bf16*)(F.ws + WS_Y); const int* TOKINFO = (const int*)(F.ws + WS_TOKINFO);
    for (int t = gw; t < NTOK; t += NGW) {
        const int4 ti = *(const int4*)(TOKINFO + 4 * t);
        const size_t s0 = (size_t)T[TBL_TSTART + ti.x] * 256 + ti.y, s1 = (size_t)T[TBL_TSTART + ti.z] * 256 + ti.w;
        f32x4* o = (f32x4*)(F.out + (size_t)t * DM) + 2 * F.lane; const v4u* y0 = (const v4u*)(Y + s0 * DM) + F.lane; const v4u* y1 = (const v4u*)(Y + s1 * DM) + F.lane;
#pragma unroll
        for (int j = 0; j < 4; ++j) {
            const v4u a = y0[64 * j], b = y1[64 * j]; f32x4 v0 = o[128 * j], v1 = o[128 * j + 1];
            v0[0] += bf_lo(a.x) + bf_lo(b.x); v0[1] += bf_hi(a.x) + bf_hi(b.x); v0[2] += bf_lo(a.y) + bf_lo(b.y); v0[3] += bf_hi(a.y) + bf_hi(b.y);
            v1[0] += bf_lo(a.z) + bf_lo(b.z); v1[1] += bf_hi(a.z) + bf_hi(b.z); v1[2] += bf_lo(a.w) + bf_lo(b.w); v1[3] += bf_hi(a.w) + bf_hi(b.w);
            o[128 * j] = v0; o[128 * j + 1] = v1;
        }
    }
}

__global__ void __launch_bounds__(NWAVES * 64, 2) mk_fwd(Args args) {
    extern __shared__ __attribute__((aligned(16))) unsigned char lds[];
    Frame F;
    F.lds = (LAS unsigned char*)lds; F.ws = args.ws; F.ctl = (unsigned*)(args.ws + WS_CTL);
    F.tid = threadIdx.x; F.lane = F.tid & 63; F.wave = __builtin_amdgcn_readfirstlane(F.tid >> 6);
    F.G = gridDim.x; { const int bx = blockIdx.x; F.vcu = (F.G % 8 == 0) ? (bx % 8) * (F.G / 8) + bx / 8 : bx; }
#pragma unroll
    for (int i = 0; i < 19; ++i) F.in[i] = args.in[i];
    F.out = args.out;
    volatile LAS unsigned* MISC = (volatile LAS unsigned*)(F.lds + MISC_OFF);
    if (F.tid < 64) MISC[F.tid] = 0u;
    __syncthreads();
    const int lo = args.ph_lo, hi = args.ph_hi;
    const bool use_bar = (hi - lo) > 1;
    XcdBarrier bar; bar.bar = F.ctl + CW_BAR; bar.x = 0; bar.st = nullptr;
    if (use_bar) bar = xcd_barrier_post(F.ctl + CW_BAR, MISC + 8);
#ifndef PHMASK
#define PHMASK 0x1ff
#endif
#define IN(k) (((PHMASK >> (k)) & 1) && lo <= (k) && (k) < hi)
#define SEAM(k) do { if (IN(k) && IN((k) + 1)) xcd_barrier(bar); } while (0)
    bf16* BIG = (bf16*)(F.ws + WS_BIG);

    if (IN(0)) { p0_prologue(F); SEAM(0); }
    if (IN(1)) {
        pg8::Gemm g{BIG, BIG, 0, 0, DM}; P1Order S{F.G, F.vcu};
        EpiQKV E{(bf16*)(F.ws + WS_QS), (bf16*)(F.ws + WS_KS), (bf16*)(F.ws + WS_QW), (bf16*)(F.ws + WS_KW), (bf16*)(F.ws + WS_VT), F.in[5], F.in[6]};
        pg8::gemm_phase<EpiQKV, P1Order, true, true>(F.lds + RING_OFF, g, S, E);
        SEAM(1);
    }
    if (IN(2)) { p2_attention(F); SEAM(2); }
    if (IN(3)) {
        pg8::Gemm g{(const bf16*)(F.ws + WS_MIXED), (const bf16*)(F.ws + WS_WOUT), NTOK, DM, DM}; pg8::StaticOrder S; S.init(NTOK, DM, F.G, (int)blockIdx.x);
        EpiRes E{F.in[0], F.out};
        pg8::gemm_phase<EpiRes, pg8::StaticOrder, true, true>(F.lds + RING_OFF, g, S, E);
        SEAM(3);
    }
    if (IN(4)) { p4_router(F); SEAM(4); }
    if (IN(5) || IN(6) || IN(7) || IN(8)) build_tables(F);
    if (IN(5)) { p5_gather(F); SEAM(5); }
    if (IN(6)) {
        pg8::Gemm g{(const bf16*)(F.ws + WS_ASORT), (const bf16*)(F.ws + WS_WGU), 0, 0, DM}; MoeOrder S{(const LAS int*)(F.lds + TBL_OFF), 4, F.G, F.vcu};
        EpiSwiGLU E{(bf16*)(F.ws + WS_HDN), (const float*)(F.ws + WS_RSORT), (const float*)(F.ws + WS_GSORT)};
        pg8::gemm_phase<EpiSwiGLU, MoeOrder, true, true>(F.lds + RING_OFF, g, S, E);
        SEAM(6);
    }
    if (IN(7)) {
        pg8::Gemm g{(const bf16*)(F.ws + WS_HDN), (const bf16*)(F.ws + WS_WD), 0, 0, DEXP}; MoeOrder S{(const LAS int*)(F.lds + TBL_OFF), 8, F.G, F.vcu};
        EpiY E{(bf16*)(F.ws + WS_Y)};
        pg8::gemm_phase<EpiY, MoeOrder, true, true>(F.lds + RING_OFF, g, S, E);
        SEAM(7);
    }
    if (IN(8)) { p8_combine(F); }
#undef IN
#undef SEAM
}

extern "C" void kernel_launch(void* const* d_in, const int* in_sizes, int n_in, void* d_out, int out_size, void* d_ws, size_t ws_size, hipStream_t stream) {
    static int grid = 0;
    if (grid == 0) {
        if (n_in != 19 || out_size != NTOK * DM || ws_size < WS_END) { fprintf(stderr, "kernel_launch: unexpected shapes (n_in %d out %d ws %zu)\n", n_in, out_size, ws_size); grid = -1; return; }
        int dev = 0, cus = 0, per_cu = 0;
        if (hipGetDevice(&dev) != hipSuccess || hipDeviceGetAttribute(&cus, hipDeviceAttributeMultiprocessorCount, dev) != hipSuccess) { grid = -1; return; }
        if (hipFuncSetAttribute((const void*)mk_fwd, hipFuncAttributeMaxDynamicSharedMemorySize, LDS_BYTES) != hipSuccess) { fprintf(stderr, "kernel_launch: hipFuncSetAttribute failed\n"); grid = -1; return; }
        if (hipOccupancyMaxActiveBlocksPerMultiprocessor(&per_cu, (const void*)mk_fwd, NWAVES * 64, LDS_BYTES) != hipSuccess || per_cu < 1) { fprintf(stderr, "kernel_launch: occupancy query reports %d\n", per_cu); }
        (void)hipGetLastError();
        grid = cus;
    }
    if (grid < 0) return;
    (void)hipMemsetAsync((char*)d_ws + WS_CTL, 0, CTL_ZERO_BYTES, stream);
    Args a{};
    for (int i = 0; i < 19; ++i) a.in[i] = (const float*)d_in[i];
    a.out = (float*)d_out; a.ws = (unsigned char*)d_ws;
#if MK_N_LAUNCHES == 1
    a.ph_lo = 0; a.ph_hi = N_PHASES;
    hipLaunchKernelGGL(mk_fwd, dim3(grid), dim3(NWAVES * 64), LDS_BYTES, stream, a);
#else
    for (int p = 0; p < N_PHASES; ++p) { a.ph_lo = p; a.ph_hi = p + 1; hipLaunchKernelGGL(mk_fwd, dim3(grid), dim3(NWAVES * 64), LDS_BYTES, stream, a); }
#endif
}
```

```cpp
#include <hip/hip_runtime.h>
#include <cstdio>
#include <cstdint>
namespace pg8 {
#define PG8_LAS __attribute__((address_space(3)))
typedef unsigned short bf16_t;
typedef short bf16x8 __attribute__((ext_vector_type(8)));
typedef float f32x4 __attribute__((ext_vector_type(4)));
typedef unsigned u32x4 __attribute__((ext_vector_type(4)));
constexpr int BM = 256, BK = 64, HALF = 128, HTB = HALF * BK * 2  , STAGE_BYTES = 8 * HTB, NXCD = 8, WGM = 8;

__host__ __device__ __forceinline__ int lds_byte(int r, int c) { const int st = (r >> 4) * 2 + (c >> 5), rr = r & 15, cc = c & 31, ob = rr * 64 + cc * 2; return st * 1024 + (ob ^ (((ob >> 9) & 1) << 5)); }
__host__ __device__ __forceinline__ void stage_rc(int b, int& R, int& C) { const int st = b / 1024, sb = b % 1024, swz = sb ^ (((sb >> 9) & 1) << 5); R = (st >> 1) * 16 + swz / 64; C = (st & 1) * 32 + (swz % 64) / 2; }
__host__ __device__ __forceinline__ int perm32(int rho) { const int n = rho >> 4, i = rho & 15; return 8 * (i >> 2) + 4 * n + (i & 3); }

struct Unit { int pm, pn; };
struct Gemm { const bf16_t* A; const bf16_t* Bt; int M, N, K; };

struct StaticOrder {
    int nM, nN, nwg, G, c;
    __host__ __device__ void init(int M, int N, int G_, int c_) { nM = M / BM; nN = N / BM; nwg = nM * nN; G = G_; c = c_; }
    __host__ __device__ bool next(int i, Unit& u) const {
        const long L = (long)i * G + c; if (L >= nwg) return false;
        int wgid = (int)L; { const int q = nwg / NXCD, r = nwg % NXCD, xcd = wgid % NXCD, off = wgid / NXCD; wgid = (xcd < r ? xcd * (q + 1) : r * (q + 1) + (xcd - r) * q) + off; }
        const int nig = WGM * nN, gid = wgid / nig, fm = gid * WGM, gsz = (nM - fm) < WGM ? (nM - fm) : WGM;
        u.pm = fm + ((wgid % nig) % gsz); u.pn = (wgid % nig) / gsz; return true;
    }
    __device__ __forceinline__ void a_ready(const Unit&) const {}
    __device__ __forceinline__ void done(const Unit&) const {}
};

__device__ __forceinline__ unsigned cvt_pk_bf16(float lo, float hi) { unsigned r; asm volatile("v_cvt_pk_bf16_f32 %0, %1, %2" : "=v"(r) : "v"(lo), "v"(hi)); return r; }
typedef float f32x2 __attribute__((ext_vector_type(2)));
__device__ __forceinline__ f32x2 gelu_pk(f32x2 v) {
    const f32x2 av = __builtin_elementwise_abs(v), d = av * 0.2316418882f + 1.0f;
    f32x2 t; t.x = __builtin_amdgcn_rcpf(d.x); t.y = __builtin_amdgcn_rcpf(d.y);
    f32x2 q = t * 0.5307027145f + (-0.7265760135f); q = q * t + 0.7107068705f; q = q * t + (-0.142248368f); q = q * t + 0.127414796f; q = q * t;
    const f32x2 s = (v * v) * (-0.72134752044f);
    f32x2 e; e.x = __builtin_amdgcn_exp2f(s.x); e.y = __builtin_amdgcn_exp2f(s.y);
    const f32x2 m = v * (q * e), r = v - m;
    f32x2 o; o.x = v.x < 0.f ? m.x : r.x; o.y = v.y < 0.f ? m.y : r.y; return o;
}

template <int ACT  > struct EpiBf16 {
    static constexpr bool PERM = true, AFTER_DRAIN = false; static_assert(ACT == 0 || ACT == 1, "EpiBf16: ACT is 0 (none) or 1 (gelu_pk)");
    bf16_t* O; int ldc; const float* bias; int split_cols; size_t split_stride; float scale0;
    __device__ __forceinline__ void operator()(const f32x4 (&acc)[2][2][4][2], const Unit& u, int wr, int wc, int fr, int fq) const {
        const int row0 = u.pm * BM + wr * 64 + fr; int colt = u.pn * BM; bf16_t* base = O;
        float sc = 1.f; if (split_cols) { const int t = colt / split_cols; base += (size_t)t * split_stride; colt -= t * split_cols; if (t == 0) sc = scale0; }
        const int col0 = colt + wc * 32 + 8 * fq, bcol0 = u.pn * BM + wc * 32 + 8 * fq;
        f32x4 bv[2][2];
#pragma unroll
        for (int bj = 0; bj < 2; ++bj)
#pragma unroll
            for (int n = 0; n < 2; ++n) bv[bj][n] = bias ? *(const f32x4*)(bias + bcol0 + bj * HALF + 4 * n) : (f32x4){0.f, 0.f, 0.f, 0.f};
#pragma unroll
        for (int ai = 0; ai < 2; ++ai)
#pragma unroll
            for (int m = 0; m < 4; ++m) { bf16_t* rowp = base + (size_t)(row0 + ai * HALF + m * 16) * ldc + col0;
#pragma unroll
                for (int bj = 0; bj < 2; ++bj) { f32x4 v0 = acc[ai][bj][m][0] + bv[bj][0], v1 = acc[ai][bj][m][1] + bv[bj][1];
                    if (ACT == 1) { f32x2 a = gelu_pk((f32x2){v0[0], v0[1]}), b = gelu_pk((f32x2){v0[2], v0[3]}), c = gelu_pk((f32x2){v1[0], v1[1]}), d = gelu_pk((f32x2){v1[2], v1[3]});
                        v0 = (f32x4){a.x, a.y, b.x, b.y}; v1 = (f32x4){c.x, c.y, d.x, d.y}; }
                    v0 = v0 * sc; v1 = v1 * sc; u32x4 w; w.x = cvt_pk_bf16(v0[0], v0[1]); w.y = cvt_pk_bf16(v0[2], v0[3]); w.z = cvt_pk_bf16(v1[0], v1[1]); w.w = cvt_pk_bf16(v1[2], v1[3]);
                    *(u32x4*)(rowp + bj * HALF) = w; } }
    }
};

struct PanelStats {
    unsigned* xbuf;
    unsigned* cnt;
    unsigned* tmo;
    int ntn; float eps;
    unsigned code;
    __device__ __forceinline__ bool run(const f32x4 (&v)[2][2][4][2], const Unit& u, int wr, int wc, int fr, int fq, PG8_LAS unsigned char* lds, int wid, int lane) const {
        typedef float f32x2v __attribute__((ext_vector_type(2)));
        PG8_LAS f32x2v* P = (PG8_LAS f32x2v*)lds;
        PG8_LAS f32x2v* S = (PG8_LAS f32x2v*)(lds + 8192);
        PG8_LAS unsigned* flag = (PG8_LAS unsigned*)(lds + 8192 + 2048);
#pragma unroll
        for (int ai = 0; ai < 2; ++ai)
#pragma unroll
            for (int m = 0; m < 4; ++m) {
                float s = 0.f;
#pragma unroll
                for (int bj = 0; bj < 2; ++bj)
#pragma unroll
                    for (int n = 0; n < 2; ++n) { const f32x4 x = v[ai][bj][m][n]; s += (x[0] + x[1]) + (x[2] + x[3]); }
                s += __shfl_xor(s, 16); s += __shfl_xor(s, 32);
                const float mw = s * (1.0f / 64.0f); float q = 0.f;
#pragma unroll
                for (int bj = 0; bj < 2; ++bj)
#pragma unroll
                    for (int n = 0; n < 2; ++n) { const f32x4 d = v[ai][bj][m][n] - mw; q += (d[0] * d[0] + d[1] * d[1]) + (d[2] * d[2] + d[3] * d[3]); }
                q += __shfl_xor(q, 16); q += __shfl_xor(q, 32);
                if (fq == 0) P[(ai * HALF + wr * 64 + m * 16 + fr) * 4 + wc] = (f32x2v){mw, q};
            }
        asm volatile("s_waitcnt lgkmcnt(0)" ::: "memory"); __builtin_amdgcn_s_barrier(); asm volatile("" ::: "memory");
#if defined(BROKEN_EXCHANGE_NO_WAIT)
#warning BROKEN CONTROL BUILD: the row-statistics exchange does not wait; results are wrong by design
        if (blockIdx.x >= 64) { const long long t0_ = clock64(); while (clock64() - t0_ < 60000) __builtin_amdgcn_s_sleep(8); }
#endif
        const int row = wid * 32 + (lane & 31);
        if (lane < 32) {
            const f32x2v a = P[row * 4 + 0], b = P[row * 4 + 1], c = P[row * 4 + 2], d = P[row * 4 + 3];
            const float mt = (a.x + b.x + c.x + d.x) * 0.25f;
            const float da = a.x - mt, db = b.x - mt, dc = c.x - mt, dd = d.x - mt;
            const float m2 = (a.y + b.y) + (c.y + d.y) + 64.0f * ((da * da + db * db) + (dc * dc + dd * dd));
            unsigned long long* slot = (unsigned long long*)xbuf + ((size_t)(u.pm * BM + row) * 4 + u.pn);
            __hip_atomic_store(slot, ((unsigned long long)__float_as_uint(m2) << 32) | __float_as_uint(mt), __ATOMIC_RELAXED, __HIP_MEMORY_SCOPE_AGENT);
        }
        asm volatile("s_waitcnt vmcnt(0)" ::: "memory");
        if (lane == 0) __hip_atomic_fetch_add(cnt + 64 * u.pm, 1u, __ATOMIC_RELAXED, __HIP_MEMORY_SCOPE_AGENT);
        if (wid == 0) {
            bool dead = false; const unsigned long long t0 = __builtin_amdgcn_s_memrealtime(); const unsigned want = 8u * (unsigned)ntn;
            for (;;) {
#if defined(BROKEN_EXCHANGE_NO_WAIT)
                break;
#endif
                if ((unsigned)__builtin_amdgcn_readfirstlane(__hip_atomic_load(cnt + 64 * u.pm, __ATOMIC_RELAXED, __HIP_MEMORY_SCOPE_AGENT)) >= want) break;
                if (__builtin_amdgcn_s_memrealtime() - t0 > 2000000ull) {
                    if (lane == 0) { unsigned expect = 0u; __hip_atomic_compare_exchange_strong(tmo + 1, &expect, code | (unsigned)(u.pm & 0xff), __ATOMIC_RELAXED, __ATOMIC_RELAXED, __HIP_MEMORY_SCOPE_AGENT);
                                     __hip_atomic_store(tmo, 1u, __ATOMIC_RELAXED, __HIP_MEMORY_SCOPE_AGENT); }
                    dead = true; break; }
                __builtin_amdgcn_s_sleep(2);
            }
            __builtin_amdgcn_fence(__ATOMIC_ACQUIRE, "agent");
            if (lane == 0) flag[0] = dead ? 1u : 0u;
        }
        asm volatile("s_waitcnt vmcnt(0) lgkmcnt(0)" ::: "memory"); __builtin_amdgcn_s_barrier(); asm volatile("" ::: "memory");
        const bool bad = flag[0] != 0u;
        if (lane < 32) {
            const unsigned long long* slot = (const unsigned long long*)xbuf + (size_t)(u.pm * BM + row) * 4; float mt[4], m2[4]; float ms = 0.f;
#pragma unroll
            for (int t = 0; t < 4; ++t) { if (t < ntn) { const unsigned long long w = __hip_atomic_load(slot + t, __ATOMIC_RELAXED, __HIP_MEMORY_SCOPE_AGENT); mt[t] = __uint_as_float((unsigned)w); m2[t] = __uint_as_float((unsigned)(w >> 32)); } else { mt[t] = 0.f; m2[t] = 0.f; } ms += mt[t]; }
            const float mean = ms / (float)ntn; float q = 0.f;
#pragma unroll
            for (int t = 0; t < 4; ++t) if (t < ntn) { const float dm = mt[t] - mean; q += m2[t] + 256.0f * dm * dm; }
            S[row] = (f32x2v){mean, 1.0f / sqrtf(q / (256.0f * (float)ntn) + eps)};
        }
        asm volatile("s_waitcnt lgkmcnt(0)" ::: "memory"); __builtin_amdgcn_s_barrier(); asm volatile("" ::: "memory");
        return bad;
    }
};
struct EpiLnRes {
    static constexpr bool PERM = false, AFTER_DRAIN = true;
    const float* base; float* out; int ldc; const float* bias; PanelStats st; unsigned poison;
    __device__ __forceinline__ void fused(f32x4 (&acc)[2][2][4][2], const Unit& u, int wr, int wc, int fr, int fq, PG8_LAS unsigned char* lds, int wid, int lane) const {
        typedef float f32x2v __attribute__((ext_vector_type(2)));
        const PG8_LAS f32x2v* S = (const PG8_LAS f32x2v*)(lds + 8192);
        const int col0 = u.pn * BM + wc * 32 + 4 * fq;
#pragma unroll
        for (int bj = 0; bj < 2; ++bj)
#pragma unroll
            for (int n = 0; n < 2; ++n) { const f32x4 bv = bias ? *(const f32x4*)(bias + col0 + bj * HALF + n * 16) : (f32x4){0.f, 0.f, 0.f, 0.f};
#pragma unroll
                for (int ai = 0; ai < 2; ++ai)
#pragma unroll
                    for (int m = 0; m < 4; ++m) acc[ai][bj][m][n] += bv; }
        f32x4 pre[4][2][2];
#pragma unroll
        for (int m = 0; m < 4; ++m) { const size_t off = (size_t)(u.pm * BM + wr * 64 + m * 16 + fr) * ldc + col0;
#pragma unroll
            for (int bj = 0; bj < 2; ++bj)
#pragma unroll
                for (int n = 0; n < 2; ++n) pre[m][bj][n] = *(const f32x4*)(base + off + bj * HALF + n * 16); }
        const bool bad = st.run(acc, u, wr, wc, fr, fq, lds, wid, lane) || poison != 0u;
        const float qnan = __builtin_nanf("");
#pragma unroll
        for (int ai = 0; ai < 2; ++ai)
#pragma unroll
            for (int m = 0; m < 4; ++m) { const int r = ai * HALF + wr * 64 + m * 16 + fr; const f32x2v sr = S[r]; const size_t off = (size_t)(u.pm * BM + r) * ldc + col0;
#pragma unroll
                for (int bj = 0; bj < 2; ++bj)
#pragma unroll
                    for (int n = 0; n < 2; ++n) { const f32x4 bs = ai == 0 ? pre[m][bj][n] : *(const f32x4*)(base + off + bj * HALF + n * 16); f32x4 o = bs + (acc[ai][bj][m][n] - sr.x) * sr.y;
                        if (bad) o = (f32x4){qnan, qnan, qnan, qnan}; *(f32x4*)(out + off + bj * HALF + n * 16) = o; }
                if (m & 1) asm volatile("" ::: "memory"); }
    }
};
struct EpiLnResLn {
    static constexpr bool PERM = false, AFTER_DRAIN = true;
    const float* base; float* out; bf16_t* xn; int ldc; const float* bias; PanelStats st1, st2; unsigned poison;
    __device__ __forceinline__ void fused(f32x4 (&acc)[2][2][4][2], const Unit& u, int wr, int wc, int fr, int fq, PG8_LAS unsigned char* lds, int wid, int lane) const {
        typedef float f32x2v __attribute__((ext_vector_type(2))); typedef unsigned u32x2v __attribute__((ext_vector_type(2)));
        const PG8_LAS f32x2v* S = (const PG8_LAS f32x2v*)(lds + 8192);
        const int col0 = u.pn * BM + wc * 32 + 4 * fq;
#pragma unroll
        for (int bj = 0; bj < 2; ++bj)
#pragma unroll
            for (int n = 0; n < 2; ++n) { const f32x4 bv = bias ? *(const f32x4*)(bias + col0 + bj * HALF + n * 16) : (f32x4){0.f, 0.f, 0.f, 0.f};
#pragma unroll
                for (int ai = 0; ai < 2; ++ai)
#pragma unroll
                    for (int m = 0; m < 4; ++m) acc[ai][bj][m][n] += bv; }
        bool bad = st1.run(acc, u, wr, wc, fr, fq, lds, wid, lane) || poison != 0u;
        const float qnan = __builtin_nanf("");
#pragma unroll
        for (int ai = 0; ai < 2; ++ai)
#pragma unroll
            for (int m = 0; m < 4; ++m) { const int r = ai * HALF + wr * 64 + m * 16 + fr; const f32x2v sr = S[r]; const size_t off = (size_t)(u.pm * BM + r) * ldc + col0;
#pragma unroll
                for (int bj = 0; bj < 2; ++bj)
#pragma unroll
                    for (int n = 0; n < 2; ++n) { const f32x4 bs = *(const f32x4*)(base + off + bj * HALF + n * 16); acc[ai][bj][m][n] = bs + (acc[ai][bj][m][n] - sr.x) * sr.y; }
                asm volatile("" : "+v"(acc[ai][0][m][0]), "+v"(acc[ai][0][m][1]), "+v"(acc[ai][1][m][0]), "+v"(acc[ai][1][m][1]));
                if (m & 1) asm volatile("" ::: "memory"); }
        const bool bad1 = bad;
        bad = st2.run(acc, u, wr, wc, fr, fq, lds, wid, lane) || bad;
#pragma unroll
        for (int ai = 0; ai < 2; ++ai)
#pragma unroll
            for (int m = 0; m < 4; ++m) { const int r = ai * HALF + wr * 64 + m * 16 + fr; const f32x2v sr = S[r]; const size_t off = (size_t)(u.pm * BM + r) * ldc + col0;
#pragma unroll
                for (int bj = 0; bj < 2; ++bj)
#pragma unroll
                    for (int n = 0; n < 2; ++n) { const f32x4 x1 = acc[ai][bj][m][n]; *(f32x4*)(out + off + bj * HALF + n * 16) = bad1 ? (f32x4){qnan, qnan, qnan, qnan} : x1;
                        const f32x4 o = (x1 - sr.x) * sr.y; u32x2v w; w.x = cvt_pk_bf16(o[0], o[1]); w.y = cvt_pk_bf16(o[2], o[3]);
                        if (bad) { w.x = 0x7fc07fc0u; w.y = 0x7fc07fc0u; } *(u32x2v*)(xn + off + bj * HALF + n * 16) = w; }
                asm volatile("" ::: "memory"); }
    }
};

template <class Epi, class Sched, bool ALIGN_EPI = false, bool SP2 = false>
__device__ __forceinline__ void gemm_phase(PG8_LAS unsigned char* lds, const Gemm g, const Sched& S, const Epi& E) {
    const int tid = threadIdx.x, wid = __builtin_amdgcn_readfirstlane(tid >> 6), lane = tid & 63, wr = wid >> 2, wc = wid & 3, fr = lane & 15, fq = lane >> 4;
    const int K = g.K, nt = K / BK;
    unsigned voffA[2], voffB[2];
#pragma unroll
    for (int i = 0; i < 2; ++i) { int R, C; stage_rc(tid * 16 + i * 8192, R, C); const int Rb = Epi::PERM ? ((R & ~31) + perm32(R & 31)) : R;
        voffA[i] = (unsigned)(R * K + C) * 2u; voffB[i] = (unsigned)(Rb * K + C) * 2u; }
    const size_t kstep = (size_t)(BK * 2);
    const size_t hstep = (size_t)HALF * K * 2;
    const size_t tstep = 2 * hstep;
    const unsigned ldsw = (unsigned)wid * 1024u;
    const int aoff = lds_byte(wr * 64 + fr, fq * 8), boff = lds_byte(wc * 32 + fr, fq * 8);
#define PG8_SA(b, h) (((b) * 2 + (h)) * HTB)
#define PG8_SB(b, h) ((4 + (b) * 2 + (h)) * HTB)
#define PG8_STAGE(bufoff, gbase, voff) do { _Pragma("unroll") for (int _i = 0; _i < 2; ++_i) \
        __builtin_amdgcn_global_load_lds((const unsigned*)((const char*)(gbase) + (voff)[_i]), (PG8_LAS unsigned*)(lds + (bufoff) + ldsw + _i * 8192), 16, 0, 0); } while (0)
#define PG8_LDA(dst, b, h) do { _Pragma("unroll") for (int m = 0; m < 4; ++m) _Pragma("unroll") for (int k = 0; k < 2; ++k) dst[m][k] = *(const PG8_LAS bf16x8*)(lds + PG8_SA(b, h) + aoff + m * 2048 + k * 1024); } while (0)
#define PG8_LDB(dst, b, h) do { _Pragma("unroll") for (int n = 0; n < 2; ++n) _Pragma("unroll") for (int k = 0; k < 2; ++k) dst[n][k] = *(const PG8_LAS bf16x8*)(lds + PG8_SB(b, h) + boff + n * 2048 + k * 1024); } while (0)
#define PG8_MMA(ai, bj, At, Bt) do { __builtin_amdgcn_s_setprio(1); _Pragma("unroll") for (int m = 0; m < 4; ++m) _Pragma("unroll") for (int n = 0; n < 2; ++n) _Pragma("unroll") for (int k = 0; k < 2; ++k) \
        acc[ai][bj][m][n] = __builtin_amdgcn_mfma_f32_16x16x32_bf16(Bt[n][k], At[m][k], acc[ai][bj][m][n], 0, 0, 0); __builtin_amdgcn_s_setprio(0); } while (0)
#define PG8_WAIT_V(n) asm volatile("s_waitcnt vmcnt(" #n ")" ::: "memory")
#define PG8_WAIT_L(n) asm volatile("s_waitcnt lgkmcnt(" #n ")" ::: "memory")
#define PG8_BAR __builtin_amdgcn_s_barrier()
#define PG8_SCHED __builtin_amdgcn_sched_barrier(0)
    Unit cur, nxt; int ui = 0;
    if (!S.next(0, cur)) return;
    f32x4 acc[2][2][4][2];
#pragma unroll
    for (int a = 0; a < 2; ++a)
#pragma unroll
        for (int b = 0; b < 2; ++b)
#pragma unroll
            for (int m = 0; m < 4; ++m)
#pragma unroll
                for (int n = 0; n < 2; ++n) acc[a][b][m][n] = (f32x4){0.f, 0.f, 0.f, 0.f};
    bf16x8 At[4][2], B0[2][2], B1[2][2];
    const char* cA = (const char*)g.A + (size_t)cur.pm * tstep; const char* cB = (const char*)g.Bt + (size_t)cur.pn * tstep;
    S.a_ready(cur);
    if constexpr (SP2) {
        PG8_STAGE(PG8_SB(0, 0), cB, voffB); PG8_STAGE(PG8_SB(0, 1), cB + hstep, voffB); PG8_STAGE(PG8_SA(0, 0), cA, voffA); PG8_STAGE(PG8_SA(0, 1), cA + hstep, voffA);
        if (wr == 1) PG8_BAR;
        PG8_WAIT_V(2); PG8_BAR;
        PG8_STAGE(PG8_SB(1, 0), cB + kstep, voffB); PG8_STAGE(PG8_SA(1, 0), cA + kstep, voffA); PG8_STAGE(PG8_SB(1, 1), cB + hstep + kstep, voffB);
        PG8_WAIT_V(6); PG8_BAR;
    } else {
        PG8_STAGE(PG8_SB(0, 0), cB, voffB); PG8_STAGE(PG8_SA(0, 0), cA, voffA); PG8_STAGE(PG8_SB(0, 1), cB + hstep, voffB); PG8_STAGE(PG8_SA(0, 1), cA + hstep, voffA);
        if (wr == 1) PG8_BAR;
        PG8_WAIT_V(4); PG8_BAR;
        PG8_STAGE(PG8_SB(1, 0), cB + kstep, voffB); PG8_STAGE(PG8_SA(1, 0), cA + kstep, voffA); PG8_STAGE(PG8_SB(1, 1), cB + hstep + kstep, voffB);
        PG8_WAIT_V(6); PG8_BAR;
    }
    int t_mid = nt >> 1; if constexpr (Epi::MIDK) asm volatile("" : "+s"(t_mid));
    for (;;) {
        const bool has_next = S.next(ui + 1, nxt);
        const char* nA = has_next ? (const char*)g.A + (size_t)nxt.pm * tstep : cA; const char* nB = has_next ? (const char*)g.Bt + (size_t)nxt.pn * tstep : cB;
        for (int t = 0; t < nt; t += 2) {
            const bool last = (t == nt - 2);
            if constexpr (Epi::MIDK) { if (t == t_mid) E.midk(acc, cur, wr, fr); }
            const char* a1 = cA + (size_t)(t + 1) * kstep;
            const char* a2 = last ? nA : cA + (size_t)(t + 2) * kstep; const char* b2 = last ? nB : cB + (size_t)(t + 2) * kstep;
            const char* a3 = a2 + kstep; const char* b3 = b2 + kstep;
            if (last && has_next) S.a_ready(nxt);
            if constexpr (SP2) {
            PG8_LDB(B0, 0, 0); PG8_LDB(B1, 0, 1); PG8_SCHED; PG8_LDA(At, 0, 0); PG8_STAGE(PG8_SA(1, 1), a1 + hstep, voffA);
            PG8_WAIT_V(8); PG8_WAIT_L(0); PG8_BAR; PG8_MMA(0, 0, At, B0); PG8_MMA(0, 1, At, B1); PG8_BAR; PG8_SCHED;
            PG8_LDA(At, 0, 1); PG8_STAGE(PG8_SB(0, 0), b2, voffB); PG8_STAGE(PG8_SB(0, 1), b2 + hstep, voffB); PG8_STAGE(PG8_SA(0, 0), a2, voffA);
            PG8_WAIT_V(8); PG8_WAIT_L(0); PG8_BAR; PG8_MMA(1, 0, At, B0); PG8_MMA(1, 1, At, B1); PG8_BAR; PG8_SCHED;
            PG8_LDB(B0, 1, 0); PG8_LDB(B1, 1, 1); PG8_SCHED; PG8_LDA(At, 1, 0); PG8_STAGE(PG8_SA(0, 1), a2 + hstep, voffA);
            PG8_WAIT_V(8); PG8_WAIT_L(0); PG8_BAR; PG8_MMA(0, 0, At, B0); PG8_MMA(0, 1, At, B1); PG8_BAR; PG8_SCHED;
            PG8_LDA(At, 1, 1); PG8_STAGE(PG8_SB(1, 0), b3, voffB); PG8_STAGE(PG8_SB(1, 1), b3 + hstep, voffB); PG8_STAGE(PG8_SA(1, 0), a3, voffA);
            PG8_WAIT_V(8); PG8_WAIT_L(0); PG8_BAR; PG8_MMA(1, 0, At, B0); PG8_MMA(1, 1, At, B1); PG8_BAR; PG8_SCHED;
            } else {
            PG8_LDB(B0, 0, 0); PG8_SCHED; PG8_LDA(At, 0, 0); PG8_STAGE(PG8_SA(1, 1), a1 + hstep, voffA);
            PG8_WAIT_L(8); PG8_BAR; PG8_WAIT_L(0); PG8_MMA(0, 0, At, B0); PG8_BAR; PG8_SCHED;
            PG8_LDB(B1, 0, 1); PG8_STAGE(PG8_SB(0, 0), b2, voffB);
            PG8_BAR; PG8_WAIT_L(0); PG8_MMA(0, 1, At, B1); PG8_BAR;
            PG8_LDA(At, 0, 1); PG8_STAGE(PG8_SA(0, 0), a2, voffA);
            PG8_BAR; PG8_WAIT_L(0); PG8_MMA(1, 0, At, B0); PG8_BAR; PG8_SCHED;
            PG8_STAGE(PG8_SB(0, 1), b2 + hstep, voffB);
            PG8_WAIT_V(6); PG8_BAR; PG8_MMA(1, 1, At, B1); PG8_BAR;
            PG8_LDB(B0, 1, 0); PG8_SCHED; PG8_LDA(At, 1, 0); PG8_STAGE(PG8_SA(0, 1), a2 + hstep, voffA);
            PG8_WAIT_L(8); PG8_BAR; PG8_WAIT_L(0); PG8_MMA(0, 0, At, B0); PG8_BAR; PG8_SCHED;
            PG8_LDB(B1, 1, 1); PG8_STAGE(PG8_SB(1, 0), b3, voffB);
            PG8_BAR; PG8_WAIT_L(0); PG8_MMA(0, 1, At, B1); PG8_BAR;
            PG8_LDA(At, 1, 1); PG8_STAGE(PG8_SA(1, 0), a3, voffA);
            PG8_BAR; PG8_WAIT_L(0); PG8_MMA(1, 0, At, B0); PG8_BAR; PG8_SCHED;
            PG8_STAGE(PG8_SB(1, 1), b3 + hstep, voffB);
            PG8_WAIT_V(6); PG8_BAR; PG8_MMA(1, 1, At, B1); PG8_BAR;
            }
        }
        if constexpr (ALIGN_EPI) { if (wr == 0) PG8_BAR; }
        if constexpr (!Epi::AFTER_DRAIN) { E(acc, cur, wr, wc, fr, fq); S.done(cur); }
        if (!has_next) break;
#pragma unroll
        for (int a = 0; a < 2; ++a)
#pragma unroll
            for (int b = 0; b < 2; ++b)
#pragma unroll
                for (int m = 0; m < 4; ++m)
#pragma unroll
                    for (int n = 0; n < 2; ++n) acc[a][b][m][n] = (f32x4){0.f, 0.f, 0.f, 0.f};
        cur = nxt; cA = nA; cB = nB; ++ui;
        if constexpr (ALIGN_EPI) { if (wr == 1) PG8_BAR; }
    }
    PG8_WAIT_V(0);
    if constexpr (!ALIGN_EPI) { if (wr == 0) PG8_BAR; }
    PG8_BAR;
    if constexpr (Epi::AFTER_DRAIN) { E.fused(acc, cur, wr, wc, fr, fq, lds, wid, lane); S.done(cur); }
#undef PG8_SA
#undef PG8_SB
#undef PG8_STAGE
#undef PG8_LDA
#undef PG8_LDB
#undef PG8_MMA
#undef PG8_WAIT_V
#undef PG8_WAIT_L
#undef PG8_BAR
#undef PG8_SCHED
}
}


#ifndef MK_N_LAUNCHES
#define MK_N_LAUNCHES 1
#endif
constexpr int N_PHASES = 9;
constexpr int NWAVES = 8;

constexpr int DM = 2048, BATCH = 4, SEQ = 4096, NTOK = BATCH * SEQ, NMETA = 16;
constexpr int MPAD = 16640, NTILE_X = MPAD / 256;
constexpr int N_QK = 3328, NT_QK = N_QK / 256;
constexpr int N_V = 1280, NT_V = N_V / 256;
constexpr int NT_W = NT_QK + NT_V;
constexpr int P1_UNITS_A = NTILE_X * NT_QK, P1_UNITS = P1_UNITS_A + NT_V * NTILE_X;
constexpr int NEXP = 64, DEXP = 512, MAXTILES = 192, SPAD = MAXTILES * 256;
constexpr float RMS_EPS = 1e-6f;
constexpr float LOG2E = 1.4426950408889634f;
constexpr float C2 = 0.125f * LOG2E;
constexpr float SB_EXIT = -150.0f;

constexpr size_t MiB = 1u << 20;
constexpr size_t WS_CTL = 0, CTL_ZERO_BYTES = 128 * 1024;
constexpr size_t WS_BIG = 1 * MiB;
constexpr size_t WS_QS = 84 * MiB, WS_KS = WS_QS + (size_t)MPAD * 1024 * 2, WS_QW = WS_KS + (size_t)MPAD * 1024 * 2, WS_KW = WS_QW + (size_t)MPAD * 1024 * 2;
constexpr size_t WS_VT = 190 * MiB;
constexpr size_t WS_MIXED = 231 * MiB, WS_HB = 295 * MiB;
constexpr size_t WS_Y = 1 * MiB;
constexpr size_t WS_PROJ = 359 * MiB;
constexpr size_t WS_HDN = 423 * MiB;
constexpr size_t WS_WOUT = 471 * MiB, WS_WR = 479 * MiB;
constexpr size_t WS_WGU = 480 * MiB, WS_WD = 736 * MiB;
constexpr size_t WS_LIST = 864 * MiB, WS_GATEW = 868 * MiB, WS_TOKINFO = 872 * MiB, WS_RSTD = 873 * MiB, WS_RSTDW = 874 * MiB;
constexpr size_t WS_RINV = 877 * MiB;
constexpr size_t WS_SSQ = 878 * MiB;
constexpr size_t WS_END = 880 * MiB;
static_assert(WS_RSTDW + (size_t)NEXP * NTOK * 4 <= WS_END, "ws map 4");
static_assert(WS_KW + (size_t)MPAD * 256 * 2 <= WS_VT && WS_VT + (size_t)N_V * MPAD * 2 <= WS_MIXED , "ws map 1");
static_assert(WS_Y + (size_t)SPAD * 2048 * 2 <= WS_MIXED && WS_HDN + (size_t)SPAD * 512 * 2 <= WS_WOUT && WS_HB + (size_t)NTOK * 2048 * 2 <= WS_HDN, "ws map 2");
static_assert(WS_BIG + (size_t)(NTILE_X + NT_W) * 256 * 2048 * 2 <= WS_QS, "ws map 3");
constexpr int CW_TMO = 0, CW_BAR = 4096, CW_CNT = 16384;

constexpr int RING_OFF = 0, RING_BYTES = 131072;
constexpr int MISC_OFF = RING_BYTES;
constexpr int TBL_OFF = MISC_OFF + 256;
constexpr int TBL_TSTART = 0, TBL_NT = 65, TBL_TE = 66, TBL_CNTS = 66 + MAXTILES, TBL_WORDS = 66 + MAXTILES + 64;
constexpr int TOKBUF_OFF = MISC_OFF + 4096;
constexpr int ATT_TBR_OFF = TOKBUF_OFF + 6144, ATT_SSX_OFF = ATT_TBR_OFF + 16 * 192 * 4, ATT_RSX_OFF = ATT_SSX_OFF + 2048;
constexpr int LDS_BYTES = 163840;
static_assert(TBL_OFF + TBL_WORDS * 4 <= TOKBUF_OFF && TOKBUF_OFF + 6144 <= LDS_BYTES && ATT_RSX_OFF + 256 <= LDS_BYTES, "LDS map");

#define LAS __attribute__((address_space(3)))
typedef unsigned short bf16;
typedef unsigned v4u __attribute__((ext_vector_type(4)));
typedef unsigned v2u __attribute__((ext_vector_type(2)));
typedef float f32x4 __attribute__((ext_vector_type(4)));
typedef float f32x16 __attribute__((ext_vector_type(16)));
typedef short bf16x8 __attribute__((ext_vector_type(8)));
typedef _Float16 f16x8 __attribute__((ext_vector_type(8)));
typedef _Float16 f16x2 __attribute__((ext_vector_type(2)));
typedef float f32x2 __attribute__((ext_vector_type(2)));
typedef __bf16 bf16x2_t __attribute__((ext_vector_type(2)));
#define LDS_WAIT() asm volatile("s_waitcnt lgkmcnt(0)" ::: "memory")
#define VM_WAIT() asm volatile("s_waitcnt vmcnt(0)" ::: "memory")
__device__ __forceinline__ unsigned pk2(float lo, float hi) { f32x2 v = {lo, hi}; bf16x2_t b = __builtin_convertvector(v, bf16x2_t); return __builtin_bit_cast(unsigned, b); }
__device__ __forceinline__ float bf_lo(unsigned u) { return __uint_as_float(u << 16); }
__device__ __forceinline__ float bf_hi(unsigned u) { return __uint_as_float(u & 0xffff0000u); }
__device__ __forceinline__ float wave_sum(float v) {
#pragma unroll
    for (int o = 1; o < 64; o <<= 1) v += __shfl_xor(v, o);
    return v;
}
__device__ __forceinline__ int crow(int reg, int h) { return (reg & 3) + 8 * (reg >> 2) + 4 * h; }

#define XB_TMO      128
#define XB_XCNT(j)  (256  + 64 * (j))
#define XB_XSUB(j)  (1280 + 64 * (j))
#define XB_XGEN(j)  (2304 + 64 * (j))
#define XB_TOP      3328
#define XB_TOPGEN   3392
#define XCD_BAR_WORDS 3456
#define XB_SPIN_CAP (1u << 18)

__device__ __forceinline__ unsigned xb_ld(unsigned* p)              { return __hip_atomic_load(p, __ATOMIC_RELAXED, __HIP_MEMORY_SCOPE_AGENT); }
__device__ __forceinline__ unsigned xb_add(unsigned* p, unsigned v) { return __hip_atomic_fetch_add(p, v, __ATOMIC_RELAXED, __HIP_MEMORY_SCOPE_AGENT); }
__device__ __forceinline__ unsigned xb_xcc_id() { return (unsigned)__builtin_amdgcn_s_getreg((3 << 11) | 20) & 0xFu; }
#define XB_SPIN(cond, bar) do { unsigned _sp = 0; while (cond) { __builtin_amdgcn_s_sleep(1); \
    if ((++_sp & 255u) == 0u) { if (xb_ld(&(bar)[XB_TMO])) break; if (_sp > XB_SPIN_CAP) { atomicAdd(&(bar)[XB_TMO], 1u); break; } } } } while (0)

struct XcdBarrier {
    unsigned* bar; unsigned x;
    volatile LAS unsigned* st;
};

__device__ __forceinline__ XcdBarrier xcd_barrier_post(unsigned* bar, volatile LAS unsigned* st) {
    XcdBarrier b; b.bar = bar; b.x = xb_xcc_id(); b.st = st;
    if (threadIdx.x == 0) (void)xb_add(&bar[XB_XCNT(b.x)], 1u);
    return b;
}
__device__ __forceinline__ void xcd_barrier_complete(unsigned* bar, unsigned x, unsigned& nloc, unsigned& nx) {
    const unsigned G = gridDim.x * gridDim.y * gridDim.z;
    unsigned sum, cnt, mine, sp = 0u;
    for (;;) {
        sum = 0u; cnt = 0u; mine = 0u;
#pragma unroll
        for (unsigned j = 0; j < 16; ++j) { const unsigned c = xb_ld(&bar[XB_XCNT(j)]); sum += c; cnt += (c > 0u) ? 1u : 0u; mine = (j == x) ? c : mine; }
        if (sum == G) break;
        __builtin_amdgcn_s_sleep(1);
        if ((++sp & 255u) == 0u) { if (xb_ld(&bar[XB_TMO])) break; if (sp > XB_SPIN_CAP) { atomicAdd(&bar[XB_TMO], 1u); break; } }
    }
    nloc = mine > 0u ? mine : 1u; nx = cnt > 0u ? cnt : 1u;
}

__device__ __forceinline__ void xcd_barrier(const XcdBarrier& b) {
    asm volatile("s_waitcnt vmcnt(0)" ::: "memory");
    __syncthreads();
    if (threadIdx.x == 0) {
        unsigned* bar = b.bar;
        __builtin_amdgcn_s_waitcnt(0);
        unsigned nloc = b.st[0], nx = b.st[1];
        if (nloc == 0u) { xcd_barrier_complete(bar, b.x, nloc, nx); b.st[0] = nloc; b.st[1] = nx; }
        const unsigned old = xb_add(&bar[XB_XSUB(b.x)], 1u);
        const unsigned gen = old / nloc;
        if (old + 1u == (gen + 1u) * nloc) {
            __builtin_amdgcn_fence(__ATOMIC_RELEASE, "agent");
            asm volatile("s_waitcnt vmcnt(0)" ::: "memory");
            const unsigned og = xb_add(&bar[XB_TOP], 1u);
            const unsigned tg = og / nx;
            if (og + 1u == (tg + 1u) * nx) xb_add(&bar[XB_TOPGEN], 1u);
            else XB_SPIN(xb_ld(&bar[XB_TOPGEN]) == tg, bar);
            __builtin_amdgcn_fence(__ATOMIC_ACQUIRE, "agent");
            xb_add(&bar[XB_XGEN(b.x)], 1u);
            asm volatile("s_waitcnt vmcnt(0)" ::: "memory");
        } else {
            XB_SPIN(xb_ld(&bar[XB_XGEN(b.x)]) == gen, bar);
            __builtin_amdgcn_fence(__ATOMIC_ACQUIRE, "agent");
            asm volatile("s_waitcnt vmcnt(0)" ::: "memory");
        }
    }
    __syncthreads();
}


struct Args { const float* in[19]; float* out; unsigned char* ws; int ph_lo, ph_hi, li, pad; };
struct Frame {
    LAS unsigned char* lds; unsigned* ctl; unsigned char* ws;
    int tid, lane, wave, vcu, G;
    const float* const* in; float* out;
};

struct TrItem { f32x4 v[16]; f32x4 g[4]; };
__device__ __forceinline__ void tr_load(TrItem& t, const float* srcp, int ldsrc, const float* gp) {
#pragma unroll
    for (int i = 0; i < 16; ++i) t.v[i] = __builtin_nontemporal_load((const f32x4*)(srcp + (size_t)i * ldsrc));
    if (gp) {
#pragma unroll
        for (int i = 0; i < 4; ++i) t.g[i] = *(const f32x4*)(gp + 4 * i);
    } else {
#pragma unroll
        for (int i = 0; i < 4; ++i) t.g[i] = (f32x4){1.f, 1.f, 1.f, 1.f};
    }
}
__device__ __forceinline__ void tr_store(const TrItem& t, bf16* dstp, int ldd) {
#pragma unroll
    for (int j = 0; j < 4; ++j)
#pragma unroll
        for (int c = 0; c < 2; ++c) {
            v4u o;
            o.x = pk2(t.v[8 * c + 0][j] * t.g[2 * c][0], t.v[8 * c + 1][j] * t.g[2 * c][1]); o.y = pk2(t.v[8 * c + 2][j] * t.g[2 * c][2], t.v[8 * c + 3][j] * t.g[2 * c][3]);
            o.z = pk2(t.v[8 * c + 4][j] * t.g[2 * c + 1][0], t.v[8 * c + 5][j] * t.g[2 * c + 1][1]); o.w = pk2(t.v[8 * c + 6][j] * t.g[2 * c + 1][2], t.v[8 * c + 7][j] * t.g[2 * c + 1][3]);
            *(v4u*)(dstp + (size_t)j * ldd + 8 * c) = o;
        }
}
__device__ __forceinline__ int win_src_col(int P) {
    if (P < 2048) return P;
    if (P < 3328) { const int p = P - 2048, t = p >> 8, pp = p & 255, bj = pp >> 7, wc = (pp & 127) >> 5, i = pp & 31; return (t < 4 ? 3072 + t * 256 : 4096) + 64 * wc + 32 * bj + i; }
    if (P < 4352) return 2048 + (P - 3328);
    return P;
}
__device__ __forceinline__ float rms_row_to_bf16(const float* xrow, bf16* orow, int lane) {
    const f32x4* xr = (const f32x4*)xrow + lane;
    f32x4 v[8]; float s = 0.f;
#pragma unroll
    for (int j = 0; j < 8; ++j) { v[j] = xr[64 * j]; s += (v[j].x * v[j].x + v[j].y * v[j].y) + (v[j].z * v[j].z + v[j].w * v[j].w); }
    const float rinv = sqrtf(wave_sum(s) * (1.f / DM) + RMS_EPS), rstd = 1.0f / rinv;
    v2u* o8 = (v2u*)orow + lane;
#pragma unroll
    for (int j = 0; j < 8; ++j) { v2u w; w.x = pk2(v[j].x * rstd, v[j].y * rstd); w.y = pk2(v[j].z * rstd, v[j].w * rstd); o8[64 * j] = w; }
    return rinv;
}
constexpr int I_IN = 32 * 72, I_OUT = 32 * 32, I_GU = NEXP * 32 * 16, I_D = NEXP * 8 * 32;
constexpr int NITEMS = I_IN + I_OUT + I_GU + I_D;
constexpr int TAIL1_PER_WAVE = 8, TAIL6_PER_WAVE = 9, TAIL6_ITEMS = 9216;
#ifndef P2_ITEMS_DEF
#define P2_ITEMS_DEF 32896
#endif
constexpr int P2_ITEMS = P2_ITEMS_DEF;
#ifndef ATT_WAVES_DEF
#define ATT_WAVES_DEF 4
#endif
constexpr int ATT_WAVES = ATT_WAVES_DEF;
__device__ __forceinline__ void conv_range(Frame& F, int it0, int step, int end) {
    bf16* WIN = (bf16*)(F.ws + WS_BIG) + (size_t)MPAD * DM;
    const float* ln_mix = F.in[3]; const float* w_in = F.in[4];
    const float* on_sb = F.in[8]; const float* on_sw = F.in[9]; const float* w_out = F.in[10]; const float* ln_ffn = F.in[11];
    const float* w_gate = F.in[16]; const float* w_up = F.in[17]; const float* w_down = F.in[18];
    bf16* WOUT = (bf16*)(F.ws + WS_WOUT); bf16* WGU = (bf16*)(F.ws + WS_WGU); bf16* WD = (bf16*)(F.ws + WS_WD);
    const int kr = F.lane >> 4, nq = F.lane & 15;
#define P0_ITEM(it, SRCP, LDS_, GP, DSTP, LDD) do { int r_ = (it); \
        if (r_ < I_IN) { const int kb = r_ / 72, nb = r_ % 72, k0 = 64 * kb + 16 * kr; SRCP = w_in + (size_t)k0 * 4608 + win_src_col(64 * nb + 4 * nq); LDS_ = 4608; GP = ln_mix + k0; DSTP = WIN + (size_t)(64 * nb + 4 * nq) * DM + k0; LDD = DM; } \
        else if ((r_ -= I_IN) < I_OUT) { const int kb = r_ >> 5, nb = r_ & 31, k0 = 64 * kb + 16 * kr; SRCP = w_out + (size_t)k0 * DM + 64 * nb + 4 * nq; LDS_ = DM; GP = (k0 < 1024 ? on_sb + k0 : on_sw + (k0 - 1024)); DSTP = WOUT + (size_t)(64 * nb + 4 * nq) * DM + k0; LDD = DM; } \
        else if ((r_ -= I_OUT) < I_GU) { const int e = r_ >> 9, q = r_ & 511, kb = q >> 4, nb = q & 15, k0 = 64 * kb + 16 * kr, nt = nb >> 2, bj = (nb >> 1) & 1, j0 = (nb & 1) * 64; \
            SRCP = (bj ? w_up : w_gate) + (size_t)e * DM * DEXP + (size_t)k0 * DEXP + nt * 128 + j0 + 4 * nq; LDS_ = DEXP; GP = ln_ffn + k0; DSTP = WGU + ((size_t)e * 1024 + 64 * nb + 4 * nq) * DM + k0; LDD = DM; } \
        else { r_ -= I_GU; const int e = r_ >> 8, q = r_ & 255, kb = q >> 5, nb = q & 31, k0 = 64 * kb + 16 * kr; \
            SRCP = w_down + (size_t)e * DEXP * DM + (size_t)k0 * DM + 64 * nb + 4 * nq; LDS_ = DM; GP = nullptr; DSTP = WD + ((size_t)e * 2048 + 64 * nb + 4 * nq) * DEXP + k0; LDD = DEXP; } } while (0)
    {
        TrItem cur; const float* sp; const float* gp; bf16* dp; int lds_, ldd; bf16* dpn; int lddn;
        int it = it0;
        if (it < end) { P0_ITEM(it, sp, lds_, gp, dp, ldd); tr_load(cur, sp, lds_, gp); }
        while (it < end) {
            const int itn = it + step; TrItem nxt;
            if (itn < end) { P0_ITEM(itn, sp, lds_, gp, dpn, lddn); tr_load(nxt, sp, lds_, gp); }
            tr_store(cur, dp, ldd);
            if (itn < end) { cur = nxt; dp = dpn; ldd = lddn; }
            it = itn;
        }
    }
#undef P0_ITEM
}
__device__ __forceinline__ void conv_range3(Frame& F, int it0, int step, int end) {
    bf16* WIN = (bf16*)(F.ws + WS_BIG) + (size_t)MPAD * DM;
    const float* ln_mix = F.in[3]; const float* w_in = F.in[4];
    const float* on_sb = F.in[8]; const float* on_sw = F.in[9]; const float* w_out = F.in[10]; const float* ln_ffn = F.in[11];
    const float* w_gate = F.in[16]; const float* w_up = F.in[17]; const float* w_down = F.in[18];
    bf16* WOUT = (bf16*)(F.ws + WS_WOUT); bf16* WGU = (bf16*)(F.ws + WS_WGU); bf16* WD = (bf16*)(F.ws + WS_WD);
    const int kr = F.lane >> 4, nq = F.lane & 15;
#define P0_ITEM(it, SRCP, LDS_, GP, DSTP, LDD) do { int r_ = (it); \
        if (r_ < I_IN) { const int kb = r_ / 72, nb = r_ % 72, k0 = 64 * kb + 16 * kr; SRCP = w_in + (size_t)k0 * 4608 + win_src_col(64 * nb + 4 * nq); LDS_ = 4608; GP = ln_mix + k0; DSTP = WIN + (size_t)(64 * nb + 4 * nq) * DM + k0; LDD = DM; } \
        else if ((r_ -= I_IN) < I_OUT) { const int kb = r_ >> 5, nb = r_ & 31, k0 = 64 * kb + 16 * kr; SRCP = w_out + (size_t)k0 * DM + 64 * nb + 4 * nq; LDS_ = DM; GP = (k0 < 1024 ? on_sb + k0 : on_sw + (k0 - 1024)); DSTP = WOUT + (size_t)(64 * nb + 4 * nq) * DM + k0; LDD = DM; } \
        else if ((r_ -= I_OUT) < I_GU) { const int e = r_ >> 9, q = r_ & 511, kb = q >> 4, nb = q & 15, k0 = 64 * kb + 16 * kr, nt = nb >> 2, bj = (nb >> 1) & 1, j0 = (nb & 1) * 64; \
            SRCP = (bj ? w_up : w_gate) + (size_t)e * DM * DEXP + (size_t)k0 * DEXP + nt * 128 + j0 + 4 * nq; LDS_ = DEXP; GP = ln_ffn + k0; DSTP = WGU + ((size_t)e * 1024 + 64 * nb + 4 * nq) * DM + k0; LDD = DM; } \
        else { r_ -= I_GU; const int e = r_ >> 8, q = r_ & 255, kb = q >> 5, nb = q & 31, k0 = 64 * kb + 16 * kr; \
            SRCP = w_down + (size_t)e * DEXP * DM + (size_t)k0 * DM + 64 * nb + 4 * nq; LDS_ = DM; GP = nullptr; DSTP = WD + ((size_t)e * 2048 + 64 * nb + 4 * nq) * DEXP + k0; LDD = DEXP; } } while (0)
    struct V16 { f32x4 v[16]; };
#define C3_LOAD(B, it) do { if ((it) < end) { const float* sp_; const float* gp_; bf16* dp_; int ls_, ld_; P0_ITEM((it), sp_, ls_, gp_, dp_, ld_); (void)gp_; (void)dp_; (void)ld_; \
        _Pragma("unroll") for (int i_ = 0; i_ < 16; ++i_) B.v[i_] = __builtin_nontemporal_load((const f32x4*)(sp_ + (size_t)i_ * ls_)); } } while (0)
#define C3_STORE(B, it) do { if ((it) < end) { const float* sp_; const float* gp_; bf16* dp_; int ls_, ld_; P0_ITEM((it), sp_, ls_, gp_, dp_, ld_); (void)sp_; (void)ls_; \
        f32x4 g_[4]; _Pragma("unroll") for (int i_ = 0; i_ < 4; ++i_) g_[i_] = gp_ ? *(const f32x4*)(gp_ + 4 * i_) : (f32x4){1.f, 1.f, 1.f, 1.f}; \
        _Pragma("unroll") for (int j_ = 0; j_ < 4; ++j_) _Pragma("unroll") for (int c_ = 0; c_ < 2; ++c_) { v4u o_; \
            o_.x = pk2(B.v[8 * c_ + 0][j_] * g_[2 * c_][0], B.v[8 * c_ + 1][j_] * g_[2 * c_][1]); o_.y = pk2(B.v[8 * c_ + 2][j_] * g_[2 * c_][2], B.v[8 * c_ + 3][j_] * g_[2 * c_][3]); \
            o_.z = pk2(B.v[8 * c_ + 4][j_] * g_[2 * c_ + 1][0], B.v[8 * c_ + 5][j_] * g_[2 * c_ + 1][1]); o_.w = pk2(B.v[8 * c_ + 6][j_] * g_[2 * c_ + 1][2], B.v[8 * c_ + 7][j_] * g_[2 * c_ + 1][3]); \
            *(v4u*)(dp_ + (size_t)j_ * ld_ + 8 * c_) = o_; } } } while (0)
    {
        V16 A, B, C; int it = it0;
        C3_LOAD(A, it); C3_LOAD(B, it + step);
        while (it < end) {
            C3_LOAD(C, it + 2 * step); C3_STORE(A, it);
            C3_LOAD(A, it + 3 * step); C3_STORE(B, it + step);
            C3_LOAD(B, it + 4 * step); C3_STORE(C, it + 2 * step);
            it += 3 * step;
        }
    }
#undef C3_LOAD
#undef C3_STORE
#undef P0_ITEM
}
__device__ __forceinline__ int tail1_items(int G) { const int rounds = (P1_UNITS + G - 1) / G, nidle = rounds * G - P1_UNITS; return nidle * NWAVES * TAIL1_PER_WAVE; }
__device__ __forceinline__ void p0_prologue(Frame& F) {
    const int gw = F.vcu * NWAVES + F.wave, NGW = F.G * NWAVES;
    if (blockIdx.x == 0 && F.tid < NEXP) __hip_atomic_store(F.ctl + CW_CNT + 16 * F.tid, 0u, __ATOMIC_RELAXED, __HIP_MEMORY_SCOPE_AGENT);
    bf16* BIG = (bf16*)(F.ws + WS_BIG);
    bf16* WIN = BIG + (size_t)MPAD * DM;
    const float* x = F.in[0]; const float* meta = F.in[1]; const float* ln_mix = F.in[3]; const float* w_in = F.in[4];
    const float* on_sb = F.in[8]; const float* on_sw = F.in[9]; const float* w_out = F.in[10]; const float* ln_ffn = F.in[11];
    const float* w_rg = F.in[12]; const float* w_re = F.in[14]; const float* w_gate = F.in[16]; const float* w_up = F.in[17]; const float* w_down = F.in[18];
    for (int m = gw; m < MPAD; m += NGW) {
        bf16* orow = BIG + (size_t)m * DM;
        if (m < NTOK) { const float ri = rms_row_to_bf16(x + (size_t)m * DM, orow, F.lane); if (F.lane == 0) ((float*)(F.ws + WS_RINV))[m] = ri; }
        else if (m < NTOK + NMETA) (void)rms_row_to_bf16(meta + (size_t)(m - NTOK) * DM, orow, F.lane);
        else { v4u z = {0u, 0u, 0u, 0u}; v4u* o = (v4u*)orow + F.lane;
#pragma unroll
            for (int j = 0; j < 4; ++j) o[64 * j] = z; }
    }
    conv_range(F, gw, NGW, NITEMS - TAIL6_ITEMS - tail1_items(F.G) - P2_ITEMS);
    bf16* WRH = (bf16*)(F.ws + WS_WR); bf16* WRL = WRH + 96 * DM;
    for (int idx = (F.vcu * NWAVES * 64 + F.tid); idx < 96 * DM; idx += F.G * NWAVES * 64) {
        const int c = idx / DM, k = idx % DM;
        float v = 0.f; if (c < 8) v = w_rg[k * 8 + c]; else if (c < 72) v = w_re[k * 64 + (c - 8)];
        v *= ln_ffn[k];
        const unsigned hi = pk2(v, 0.f) & 0xffffu; const float lo = v - __uint_as_float(hi << 16);
        const int fidx = ((((k >> 4) * 3 + (c >> 5)) * 64 + (((k >> 3) & 1) * 32 + (c & 31))) << 3) + (k & 7);
        WRH[fidx] = (bf16)hi; WRL[fidx] = (bf16)(pk2(lo, 0.f) & 0xffffu);
    }
}

struct P1Order {
    int G, c;
    __device__ bool next(int i, pg8::Unit& u) const {
        const int L = i * G + c; if (L >= P1_UNITS) return false;
        if (L < P1_UNITS_A) { u.pm = L / NT_QK; u.pn = NTILE_X + (L % NT_QK); }
        else { const int l = L - P1_UNITS_A; u.pm = NTILE_X + NT_QK + l / NTILE_X; u.pn = l % NTILE_X; }
        return true;
    }
    __device__ __forceinline__ void a_ready(const pg8::Unit&) const {}
    __device__ __forceinline__ void done(const pg8::Unit&) const {}
};
struct EpiQKV {
    static constexpr bool PERM = true, AFTER_DRAIN = false, MIDK = false;
    bf16 *QS, *KS, *QW, *KW, *VT; const float *q_norm, *k_norm;
    __device__ __forceinline__ void operator()(const pg8::f32x4 (&acc)[2][2][4][2], const pg8::Unit& u, int wr, int wc, int fr, int fq) const {
        using pg8::HALF;
        if (u.pm < NTILE_X) {
            const int t = u.pn - NTILE_X; const int row0 = u.pm * 256 + wr * 64 + fr;
            if (t < 8) {
                bf16* base = (t < 4) ? QS : KS; const float sc = (t < 4) ? C2 : 1.0f; const int col0 = (t & 3) * 256 + wc * 32 + 8 * fq;
#pragma unroll
                for (int ai = 0; ai < 2; ++ai)
#pragma unroll
                    for (int m = 0; m < 4; ++m) { bf16* rowp = base + (size_t)(row0 + ai * HALF + m * 16) * 1024 + col0;
#pragma unroll
                        for (int bj = 0; bj < 2; ++bj) { const pg8::f32x4 v0 = acc[ai][bj][m][0] * sc, v1 = acc[ai][bj][m][1] * sc;
                            v4u w; w.x = pk2(v0[0], v0[1]); w.y = pk2(v0[2], v0[3]); w.z = pk2(v1[0], v1[1]); w.w = pk2(v1[2], v1[3]); *(v4u*)(rowp + bj * HALF) = w; } }
            } else {
                const bool isq = t < 12; const float* gain = isq ? q_norm : k_norm; const float sc = isq ? C2 : 1.0f;
                bf16* base = isq ? (QW + (t - 8) * 256 + wc * 64) : (KW + wc * 64); const int ld = isq ? 1024 : 256;
                pg8::f32x4 g[2][2];
#pragma unroll
                for (int bj = 0; bj < 2; ++bj)
#pragma unroll
                    for (int n = 0; n < 2; ++n) g[bj][n] = *(const pg8::f32x4*)(gain + 32 * bj + 8 * fq + 4 * n) * sc;
#pragma unroll
                for (int ai = 0; ai < 2; ++ai)
#pragma unroll
                    for (int m = 0; m < 4; ++m) {
                        float ss = 0.f;
#pragma unroll
                        for (int bj = 0; bj < 2; ++bj)
#pragma unroll
                            for (int n = 0; n < 2; ++n) { const pg8::f32x4 v = acc[ai][bj][m][n]; ss += (v[0] * v[0] + v[1] * v[1]) + (v[2] * v[2] + v[3] * v[3]); }
                        ss += __shfl_xor(ss, 16); ss += __shfl_xor(ss, 32);
                        const float rstd = 1.0f / sqrtf(ss * (1.0f / 64.0f) + RMS_EPS);
                        bf16* rowp = base + (size_t)(row0 + ai * HALF + m * 16) * ld + 8 * fq;
#pragma unroll
                        for (int bj = 0; bj < 2; ++bj) { const pg8::f32x4 v0 = acc[ai][bj][m][0] * rstd * g[bj][0], v1 = acc[ai][bj][m][1] * rstd * g[bj][1];
                            v4u w; w.x = pk2(v0[0], v0[1]); w.y = pk2(v0[2], v0[3]); w.z = pk2(v1[0], v1[1]); w.w = pk2(v1[2], v1[3]); *(v4u*)(rowp + 32 * bj) = w; } }
            }
        } else {
            const int vrow0 = (u.pm - NTILE_X - NT_QK) * 256 + wr * 64 + fr;
#pragma unroll
            for (int ai = 0; ai < 2; ++ai)
#pragma unroll
                for (int m = 0; m < 4; ++m) { bf16* rowp = VT + (size_t)(vrow0 + ai * HALF + m * 16) * MPAD + u.pn * 256 + wc * 32 + 16 * (fq >> 1) + 4 * (fq & 1);
#pragma unroll
                    for (int bj = 0; bj < 2; ++bj)
#pragma unroll
                        for (int n = 0; n < 2; ++n) { const pg8::f32x4 v = acc[ai][bj][m][n]; v2u w; w.x = pk2(v[0], v[1]); w.y = pk2(v[2], v[3]); *(v2u*)(rowp + bj * HALF + 8 * n) = w; } }
        }
    }
};

namespace att {
__device__ __forceinline__ f32x16 mfma_bf(bf16x8 a, bf16x8 b, f32x16 c) { return __builtin_amdgcn_mfma_f32_32x32x16_bf16(a, b, c, 0, 0, 0); }
__device__ __forceinline__ f32x16 mfma_h(f16x8 a, f16x8 b, f32x16 c) { return __builtin_amdgcn_mfma_f32_32x32x16_f16(a, b, c, 0, 0, 0); }
__device__ __forceinline__ bf16x8 ld8(const bf16* p) { return *(const bf16x8*)p; }
__device__ __forceinline__ bf16x8 pack8(const float* w) { v4u o; o.x = pk2(w[0], w[1]); o.y = pk2(w[2], w[3]); o.z = pk2(w[4], w[5]); o.w = pk2(w[6], w[7]); return __builtin_bit_cast(bf16x8, o); }

struct KT { bf16x8 k[4]; bf16x8 v[4]; };
__device__ __forceinline__ void glds16(const void* gsrc, unsigned lds_dst) { unsigned keep;
    asm volatile("s_mov_b32 %0, m0\n\ts_mov_b32 m0, %2\n\ts_nop 0\n\tglobal_load_lds_dwordx4 %1, off\n\ts_mov_b32 m0, %0" : "=&s"(keep) : "v"(gsrc), "s"(lds_dst) : "memory"); }
__device__ __forceinline__ void dma_tile(unsigned slot, const bf16* Kb, int ldk, const bf16* Vt, int b, int j, int lane) {
#pragma unroll
    for (int i = 0; i < 4; ++i) { const int row = 8 * i + (lane >> 3), ch = (lane & 7) ^ (row & 7);
        const int krow = (j >= 0) ? (b * SEQ + 32 * j + row) : (NTOK + (row & 15));
        glds16(Kb + (size_t)krow * ldk + ch * 8, (unsigned)__builtin_amdgcn_readfirstlane(slot + i * 1024)); }
    const int col0 = (j >= 0) ? (b * SEQ + 32 * j) : NTOK;
#pragma unroll
    for (int i = 0; i < 4; ++i) { const int row = 16 * i + (lane >> 2), c = (lane & 3) ^ ((row >> 2) & 3); const int cc = (j >= 0) ? c : (c & 1);
        glds16(Vt + (size_t)row * MPAD + col0 + cc * 8, (unsigned)__builtin_amdgcn_readfirstlane(slot + 4096 + i * 1024)); }
}
__device__ __forceinline__ void lds_frags(KT& t, const LAS unsigned char* slot, int r, int h) {
#pragma unroll
    for (int s = 0; s < 4; ++s) { const int c = 2 * s + h; t.k[s] = *(const LAS bf16x8*)(slot + (r >> 3) * 1024 + ((r & 7) * 8 + (c ^ (r & 7))) * 16); }
#pragma unroll
    for (int dh = 0; dh < 2; ++dh)
#pragma unroll
        for (int s = 0; s < 2; ++s) { const int row = 32 * dh + r, c = 2 * s + h; t.v[dh * 2 + s] = *(const LAS bf16x8*)(slot + 4096 + row * 64 + (c ^ ((row >> 2) & 3)) * 16); }
}
#define ATT_WAITV(n) asm volatile("s_waitcnt vmcnt(" #n ")" ::: "memory")

struct SbState { f32x16 o0, o1; float R; };
template <int KIND>
__device__ __forceinline__ void sb_tile(SbState& S, const KT& t, const bf16x8 (&qf)[4], const f16x8& U0, const f16x8& U1, int r, int h) {
    f32x16 z = {0.f, 0.f, 0.f, 0.f, 0.f, 0.f, 0.f, 0.f, 0.f, 0.f, 0.f, 0.f, 0.f, 0.f, 0.f, 0.f};
#pragma unroll
    for (int s = 0; s < 4; ++s) z = mfma_bf(t.k[s], qf[s], z);
    f32x16 init; float L[16];
#pragma unroll
    for (int g = 0; g < 16; ++g) {
        const float zz = z[g];
        const float e = __builtin_amdgcn_exp2f(-__builtin_fabsf(zz));
        const float zp = __builtin_amdgcn_fmed3f(zz, 0.f, 3.0e38f);
        const float sp = zp + __builtin_amdgcn_logf(1.0f + e);
        float Lv = -sp;
        if (KIND == 1) Lv = (crow(g, h) < r) ? Lv : 0.f;
        if (KIND == 2) Lv = (crow(g, h) < 16) ? Lv : 0.f;
        L[g] = Lv; init[g] = zz + Lv + S.R;
    }
    f16x8 lb0, lb1;
#pragma unroll
    for (int j = 0; j < 8; ++j) { lb0[j] = (_Float16)L[j]; lb1[j] = (_Float16)L[8 + j]; }
    f32x16 lw = mfma_h(U0, lb0, init); lw = mfma_h(U1, lb1, lw);
    float Rn = lw[0] - z[0];
    Rn = __shfl(Rn, r);
    float w[16];
#pragma unroll
    for (int g = 0; g < 16; ++g) {
        float wv = __builtin_amdgcn_exp2f(lw[g]);
        if (KIND == 1) wv = (crow(g, h) < r) ? wv : 0.f;
        if (KIND == 2) wv = (crow(g, h) < 16) ? wv : 0.f;
        w[g] = wv;
    }
    const bf16x8 wb0 = pack8(w), wb1 = pack8(w + 8);
    S.o0 = mfma_bf(t.v[0], wb0, S.o0); S.o0 = mfma_bf(t.v[1], wb1, S.o0);
    S.o1 = mfma_bf(t.v[2], wb0, S.o1); S.o1 = mfma_bf(t.v[3], wb1, S.o1);
    S.R = Rn;
}

struct SwState { f32x16 o0, o1; float m, l; };
template <int KIND>
__device__ __forceinline__ void sw_tile(SwState& S, const KT& t, const bf16x8 (&qf)[4], const LAS float* tb, int r, int h) {
    f32x16 z = {0.f, 0.f, 0.f, 0.f, 0.f, 0.f, 0.f, 0.f, 0.f, 0.f, 0.f, 0.f, 0.f, 0.f, 0.f, 0.f};
#pragma unroll
    for (int s = 0; s < 4; ++s) z = mfma_bf(t.k[s], qf[s], z);
    float sc[16]; float mx = -1e30f;
#pragma unroll
    for (int g = 0; g < 16; ++g) {
        float v = z[g] + tb[(g & 3) + 8 * (g >> 2)];
        if (KIND == 1) v = (crow(g, h) <= r) ? v : -1e30f;
        if (KIND == 2) v = (crow(g, h) < 16) ? v : -1e30f;
        if (KIND == 3) v = (crow(g, h) > r) ? v : -1e30f;
        sc[g] = v; mx = __builtin_fmaxf(mx, v);
    }
    mx = __builtin_fmaxf(mx, __shfl_xor(mx, 32));
    const float mn = __builtin_fmaxf(S.m, mx);
    const float alpha = __builtin_amdgcn_exp2f(S.m - mn);
    S.l *= alpha; S.o0 *= alpha; S.o1 *= alpha;
    float p[16]; float ls = 0.f;
#pragma unroll
    for (int g = 0; g < 16; ++g) { p[g] = __builtin_amdgcn_exp2f(sc[g] - mn); ls += p[g]; }
    S.l += ls; S.m = mn;
    const bf16x8 wb0 = pack8(p), wb1 = pack8(p + 8);
    S.o0 = mfma_bf(t.v[0], wb0, S.o0); S.o0 = mfma_bf(t.v[1], wb1, S.o0);
    S.o1 = mfma_bf(t.v[2], wb0, S.o1); S.o1 = mfma_bf(t.v[3], wb1, S.o1);
}
__device__ __forceinline__ float store_o(bf16* orow, const f32x16& o0, const f32x16& o1, float scale, int h) {
    float ss = 0.f;
#pragma unroll
    for (int q = 0; q < 4; ++q) {
        const float a0 = o0[4 * q] * scale, a1 = o0[4 * q + 1] * scale, a2 = o0[4 * q + 2] * scale, a3 = o0[4 * q + 3] * scale;
        const float b0 = o1[4 * q] * scale, b1 = o1[4 * q + 1] * scale, b2 = o1[4 * q + 2] * scale, b3 = o1[4 * q + 3] * scale;
        ss += ((a0 * a0 + a1 * a1) + (a2 * a2 + a3 * a3)) + ((b0 * b0 + b1 * b1) + (b2 * b2 + b3 * b3));
        v2u w; w.x = pk2(a0, a1); w.y = pk2(a2, a3); *(v2u*)(orow + 8 * q + 4 * h) = w;
        v2u x; x.x = pk2(b0, b1); x.y = pk2(b2, b3); *(v2u*)(orow + 32 + 8 * q + 4 * h) = x;
    }
    return ss;
}
}

__device__ __forceinline__ void p2_attention(Frame& F) {
    using namespace att;
    const int lane = F.lane, r = lane & 31, h = lane >> 5, w = F.wave;
    const bf16* VT = (const bf16*)(F.ws + WS_VT); bf16* MIX = (bf16*)(F.ws + WS_MIXED); float* SSQ = (float*)(F.ws + WS_SSQ);
    LAS float* tbr = (LAS float*)(F.lds + ATT_TBR_OFF);
    const LAS unsigned char* area = F.lds + RING_OFF + w * 16384;
    const unsigned slot0 = (unsigned)(uintptr_t)area;
    LAS float* ssx = (LAS float*)(F.lds + ATT_SSX_OFF);
    LAS float* rsx = (LAS float*)(F.lds + ATT_RSX_OFF);
    { const float* rel_bias = F.in[2];
      for (int idx = F.tid; idx < 16 * 192; idx += NWAVES * 64) {
        const int hq = idx / 192, x = idx % 192, d = 159 - x; float v = 0.f;
        if (d >= 0) { int bkt = d; if (d >= 16) { bkt = 16 + (int)(logf((float)d / 16.0f) / logf(8.0f) * 16.0f); bkt = bkt > 31 ? 31 : bkt; } v = rel_bias[bkt * 16 + hq] * LOG2E; }
        tbr[idx] = v;
      } }
    __syncthreads();
    if (w >= ATT_WAVES) {
        const int p2_end = NITEMS - TAIL6_ITEMS - tail1_items(F.G);
        conv_range3(F, p2_end - P2_ITEMS + F.vcu * (NWAVES - ATT_WAVES) + (w - ATT_WAVES), F.G * (NWAVES - ATT_WAVES), p2_end);
        return;
    }
    __builtin_amdgcn_s_setprio(3);
    for (int unit = F.vcu; unit < NTOK / 32; unit += F.G) {
        const int b = unit >> 7, a = unit & 127;
        const size_t qrow = (size_t)b * SEQ + 32 * a + r;
#pragma unroll 1
        for (int bi = 0; bi < 2; ++bi) {
            const int branch = bi;
            if (branch == 0) {
            const bf16* KS = (const bf16*)(F.ws + WS_KS); const bf16* QS = (const bf16*)(F.ws + WS_QS);
            f16x8 U0, U1;
#pragma unroll
            for (int j = 0; j < 8; ++j) { const int c0 = 8 * (j >> 2) + 4 * h + (j & 3); U0[j] = (c0 > r) ? (_Float16)1.0f : (_Float16)0.0f; U1[j] = (16 + c0 > r) ? (_Float16)1.0f : (_Float16)0.0f; }
            float ssl = 0.f;
#pragma unroll 1
            for (int hh = 0; hh < 16 / ATT_WAVES; ++hh) {
                const int head = (16 / ATT_WAVES) * w + hh;
                ATT_WAITV(0);
                const bf16* Kb = KS + head * 64;
                bf16x8 ql[4];
#pragma unroll
                for (int s = 0; s < 4; ++s) ql[s] = ld8(QS + qrow * 1024 + head * 64 + 16 * s + 8 * h);
                SbState S; S.R = 0.f;
#pragma unroll
                for (int g = 0; g < 16; ++g) { S.o0[g] = 0.f; S.o1[g] = 0.f; }
                const bf16* Vt = VT + (size_t)(head * 64) * MPAD;
                unsigned sl_cur = slot0, sl_nxt = slot0 + 8192;
                int jt = a;
                dma_tile(sl_cur, Kb, 1024, Vt, b, jt, lane); dma_tile(sl_nxt, Kb, 1024, Vt, b, jt - 1, lane);
                ATT_WAITV(8);
                KT T; lds_frags(T, area + (sl_cur - slot0), r, h);
                sb_tile<1>(S, T, ql, U0, U1, r, h);
                if (!__all(S.R < SB_EXIT)) {
                    --jt;
                    for (;;) {
                        { const unsigned t_ = sl_cur; sl_cur = sl_nxt; sl_nxt = t_; }
                        const bool has_next = jt >= 0;
                        if (has_next) { dma_tile(sl_nxt, Kb, 1024, Vt, b, jt - 1, lane); ATT_WAITV(8); } else ATT_WAITV(0);
                        lds_frags(T, area + (sl_cur - slot0), r, h);
                        if (jt >= 0) sb_tile<0>(S, T, ql, U0, U1, r, h); else sb_tile<2>(S, T, ql, U0, U1, r, h);
                        if (!has_next || __all(S.R < SB_EXIT)) break;
                        --jt;
                    }
                }
                ssl += store_o(MIX + qrow * DM + head * 64, S.o0, S.o1, 1.0f, h);
            }
            ssl += __shfl_xor(ssl, 32);
            if (h == 0) SSQ[qrow * 16 + w] = ssl;
        }
            else {
            const bf16* KW = (const bf16*)(F.ws + WS_KW); const bf16* QW = (const bf16*)(F.ws + WS_QW);
            float ssl = 0.f;
#pragma unroll 1
            for (int hh = 0; hh < 16 / ATT_WAVES; ++hh) {
                const int hq = (16 / ATT_WAVES) * w + hh, kvh = hq >> 2;
                ATT_WAITV(0);
                const bf16* Kb = KW + kvh * 64;
                bf16x8 ql[4];
#pragma unroll
                for (int s = 0; s < 4; ++s) ql[s] = ld8(QW + qrow * 1024 + hq * 64 + 16 * s + 8 * h);
                const float sink2 = F.in[7][hq] * LOG2E;
                SwState S; S.m = sink2; S.l = 0.f;
#pragma unroll
                for (int g = 0; g < 16; ++g) { S.o0[g] = 0.f; S.o1[g] = 0.f; }
                const LAS float* tbh = tbr + hq * 192 + 4 * h;
                const int jlo = (a >= 4) ? a - 4 : 0;
                const bf16* Vt = VT + (size_t)(1024 + kvh * 64) * MPAD;
                unsigned sl_cur = slot0, sl_nxt = slot0 + 8192;
                int jt = a;
#define SW_NEXT(j) (((j) > jlo) ? (j) - 1 : -1)
                dma_tile(sl_cur, Kb, 256, Vt, b, jt, lane); dma_tile(sl_nxt, Kb, 256, Vt, b, SW_NEXT(jt), lane);
                ATT_WAITV(8);
                KT T; lds_frags(T, area + (sl_cur - slot0), r, h);
                sw_tile<1>(S, T, ql, tbh + (159 - r), r, h);
                jt = SW_NEXT(jt);
                for (;;) {
                    { const unsigned t_ = sl_cur; sl_cur = sl_nxt; sl_nxt = t_; }
                    if (jt >= 0) { dma_tile(sl_nxt, Kb, 256, Vt, b, SW_NEXT(jt), lane); ATT_WAITV(8); } else ATT_WAITV(0);
                    lds_frags(T, area + (sl_cur - slot0), r, h);
                    if (jt < 0) { const int dq = 32 * a + r + 16; sw_tile<2>(S, T, ql, tbh + (159 - (dq < 159 ? dq : 159)), r, h); break; }
                    const LAS float* tb = tbh + (159 - (32 * (a - jt) + r));
                    if (jt == a - 4) sw_tile<3>(S, T, ql, tb, r, h); else sw_tile<0>(S, T, ql, tb, r, h);
                    jt = SW_NEXT(jt);
                }
#undef SW_NEXT
                const float lt = S.l + __shfl_xor(S.l, 32) + __builtin_amdgcn_exp2f(sink2 - S.m);
                ssl += store_o(MIX + qrow * DM + 1024 + hq * 64, S.o0, S.o1, 1.0f / lt, h);
            }
            ssl += __shfl_xor(ssl, 32);
            if (h == 0) SSQ[qrow * 16 + 8 + w] = ssl;
        }
        }
    }
    __builtin_amdgcn_s_setprio(0);
}

struct EpiRes {
    static constexpr bool PERM = true, AFTER_DRAIN = false, MIDK = true;
    bf16* P; const LAS float* RS; mutable int ui;
    __device__ __forceinline__ void midk(pg8::f32x4 (&acc)[2][2][4][2], const pg8::Unit& u, int wr, int fr) const {
#pragma unroll
        for (int ai = 0; ai < 2; ++ai)
#pragma unroll
            for (int m = 0; m < 4; ++m) { const LAS float* q = RS + (ui * 256 + ai * 128 + wr * 64 + m * 16 + fr) * 2; const float ratio = q[0] / q[1];
#pragma unroll
                for (int bj = 0; bj < 2; ++bj)
#pragma unroll
                    for (int n = 0; n < 2; ++n) acc[ai][bj][m][n] *= ratio; }
    }
    __device__ __forceinline__ void operator()(const pg8::f32x4 (&acc)[2][2][4][2], const pg8::Unit& u, int wr, int wc, int fr, int fq) const {
        const int col0 = u.pn * 256 + wc * 32 + 8 * fq;
#pragma unroll
        for (int ai = 0; ai < 2; ++ai)
#pragma unroll
            for (int m = 0; m < 4; ++m) { const int rl = ai * 128 + wr * 64 + m * 16 + fr; bf16* rowp = P + (size_t)(u.pm * 256 + rl) * DM + col0; const float rw = RS[(ui * 256 + rl) * 2 + 1];
#pragma unroll
                for (int bj = 0; bj < 2; ++bj) { const pg8::f32x4 v0 = acc[ai][bj][m][0] * rw, v1 = acc[ai][bj][m][1] * rw;
                    v4u w; w.x = pk2(v0[0], v0[1]); w.y = pk2(v0[2], v0[3]); w.z = pk2(v1[0], v1[1]); w.w = pk2(v1[2], v1[3]); *(v4u*)(rowp + bj * 128) = w; } }
        ++ui;
    }
};

__device__ __forceinline__ void p4_router(Frame& F) {
    using namespace att;
    const int lane = F.lane, r = lane & 31, h = lane >> 5, w = F.wave;
    const bf16* proj = (const bf16*)(F.ws + WS_PROJ); const bf16* xnb = (const bf16*)(F.ws + WS_BIG); const float* rinv = (const float*)(F.ws + WS_RINV); bf16* HB = (bf16*)(F.ws + WS_HB);
    const bf16* WRH = (const bf16*)(F.ws + WS_WR); const bf16* WRL = WRH + 96 * DM;
    const float* b_rg = F.in[13]; const float* b_re = F.in[15];
    unsigned* CNT = F.ctl + CW_CNT;
    int* LIST = (int*)(F.ws + WS_LIST); float* GATEW = (float*)(F.ws + WS_GATEW); int* TOKINFO = (int*)(F.ws + WS_TOKINFO); float* RSTD = (float*)(F.ws + WS_RSTD); float* RSTDW = (float*)(F.ws + WS_RSTDW);
    LAS float* part = (LAS float*)(F.lds + RING_OFF);
    LAS float* ssp = (LAS float*)(F.lds + RING_OFF + 98304);
    LAS float* lg = (LAS float*)(F.lds + RING_OFF + 98304 + 2048);
    LAS float* rsl = (LAS float*)(F.lds + RING_OFF + 98304 + 2048 + 18432);
    LAS unsigned char* sthi = F.lds + RING_OFF; LAS unsigned char* stlo = F.lds + RING_OFF + 65536;
    for (int unit = F.vcu; unit < NTOK / 64; unit += F.G) {
        f32x16 acc[2][3];
#pragma unroll
        for (int t = 0; t < 2; ++t)
#pragma unroll
            for (int nt = 0; nt < 3; ++nt)
#pragma unroll
                for (int g = 0; g < 16; ++g) acc[t][nt][g] = 0.f;
        float ss0 = 0.f, ss1 = 0.f;
#pragma unroll 1
        for (int q = 0; q < 4; ++q) {
#pragma unroll 1
            for (int hb = 0; hb < 2; ++hb) {
                f32x4 xv[8]; v2u pv[8];
#pragma unroll
                for (int i = 0; i < 8; ++i) { const int id = (hb * 8 + i) * 512 + F.tid, row = id >> 7, g = id & 127; const size_t off = ((size_t)unit * 64 + row) * DM + 512 * q + 4 * g;
                    const v2u xb = *(const v2u*)(xnb + off); const float ri = rinv[unit * 64 + row]; xv[i] = (f32x4){bf_lo(xb.x) * ri, bf_hi(xb.x) * ri, bf_lo(xb.y) * ri, bf_hi(xb.y) * ri}; pv[i] = *(const v2u*)(proj + off); }
#pragma unroll
                for (int i = 0; i < 8; ++i) { const int id = (hb * 8 + i) * 512 + F.tid, row = id >> 7, g = id & 127; const size_t off = ((size_t)unit * 64 + row) * DM + 512 * q + 4 * g;
                    const float a0 = xv[i][0] + bf_lo(pv[i].x), a1 = xv[i][1] + bf_hi(pv[i].x), a2 = xv[i][2] + bf_lo(pv[i].y), a3 = xv[i][3] + bf_hi(pv[i].y);
                    v2u hi; hi.x = pk2(a0, a1); hi.y = pk2(a2, a3);
                    v2u lo; lo.x = pk2(a0 - bf_lo(hi.x), a1 - bf_hi(hi.x)); lo.y = pk2(a2 - bf_lo(hi.y), a3 - bf_hi(hi.y));
                    *(v2u*)(HB + off) = hi;
                    const int lofs = row * 1024 + ((((g >> 1) ^ (row & 15))) << 4) + ((g & 1) << 3);
                    *(LAS v2u*)(sthi + lofs) = hi; *(LAS v2u*)(stlo + lofs) = lo; }
            }
            __syncthreads();
#pragma unroll 2
            for (int s4 = 0; s4 < 4; ++s4) {
                const int ks = w + 8 * s4, ksg = 32 * q + ks;
                const int fo0 = r * 1024 + ((((2 * ks + h) ^ (r & 15))) << 4), fo1 = fo0 + 32 * 1024;
                const v4u h0 = *(const LAS v4u*)(sthi + fo0), l0 = *(const LAS v4u*)(stlo + fo0), h1 = *(const LAS v4u*)(sthi + fo1), l1 = *(const LAS v4u*)(stlo + fo1);
#define P4_SS(SS, HV, LV) { const float e0 = bf_lo(HV.x) + bf_lo(LV.x), e1 = bf_hi(HV.x) + bf_hi(LV.x), e2 = bf_lo(HV.y) + bf_lo(LV.y), e3 = bf_hi(HV.y) + bf_hi(LV.y), \
                    e4 = bf_lo(HV.z) + bf_lo(LV.z), e5 = bf_hi(HV.z) + bf_hi(LV.z), e6 = bf_lo(HV.w) + bf_lo(LV.w), e7 = bf_hi(HV.w) + bf_hi(LV.w); \
                    SS += ((e0 * e0 + e1 * e1) + (e2 * e2 + e3 * e3)) + ((e4 * e4 + e5 * e5) + (e6 * e6 + e7 * e7)); }
                P4_SS(ss0, h0, l0) P4_SS(ss1, h1, l1)
#undef P4_SS
                const bf16x8 ahi0 = __builtin_bit_cast(bf16x8, h0), alo0 = __builtin_bit_cast(bf16x8, l0), ahi1 = __builtin_bit_cast(bf16x8, h1), alo1 = __builtin_bit_cast(bf16x8, l1);
#pragma unroll
                for (int nt = 0; nt < 3; ++nt) {
                    const int fo = (((ksg * 3 + nt) * 64 + lane) << 3);
                    const bf16x8 bh = ld8(WRH + fo), bl = ld8(WRL + fo);
                    acc[0][nt] = mfma_bf(ahi0, bh, acc[0][nt]); acc[0][nt] = mfma_bf(alo0, bh, acc[0][nt]); acc[0][nt] = mfma_bf(ahi0, bl, acc[0][nt]);
                    acc[1][nt] = mfma_bf(ahi1, bh, acc[1][nt]); acc[1][nt] = mfma_bf(alo1, bh, acc[1][nt]); acc[1][nt] = mfma_bf(ahi1, bl, acc[1][nt]);
                }
            }
            __syncthreads();
        }
        ss0 += __shfl_xor(ss0, 32); ss1 += __shfl_xor(ss1, 32);
        if (h == 0) { ssp[w * 32 + r] = ss0; ssp[256 + w * 32 + r] = ss1; }
#pragma unroll
        for (int t = 0; t < 2; ++t) {
#pragma unroll
            for (int nt = 0; nt < 3; ++nt)
#pragma unroll
                for (int g = 0; g < 16; ++g) part[(w * 32 + crow(g, h)) * 96 + nt * 32 + r] = acc[t][nt][g];
            __syncthreads();
            for (int idx = F.tid; idx < 32 * 72; idx += NWAVES * 64) { const int tk = idx / 72, c = idx % 72; float v = 0.f;
#pragma unroll
                for (int i = 0; i < 8; ++i) v += part[(i * 32 + tk) * 96 + c];
                lg[t * 32 * 72 + idx] = v; }
            __syncthreads();
        }
        LAS unsigned* hist = (LAS unsigned*)rsl + 64;
        if (F.tid < 128) hist[F.tid] = 0u;
        __syncthreads();
        int tok = 0, e0 = 0, e1 = 0; unsigned r0 = 0, r1 = 0; float g0 = 0.f, g1 = 0.f, rs = 0.f;
        if (F.tid < 64) {
            tok = unit * 64 + F.tid; float tsum = 0.f;
#pragma unroll
            for (int i = 0; i < 8; ++i) tsum += ssp[(F.tid >> 5) * 256 + i * 32 + (F.tid & 31)];
            rs = 1.0f / sqrtf(tsum * (1.0f / DM) + RMS_EPS); RSTD[tok] = rs;
            const LAS float* l = lg + F.tid * 72;
            float gl[8]; int gi = 0; float gm = -3.0e38f;
#pragma unroll
            for (int i = 0; i < 8; ++i) { gl[i] = l[i] * rs + b_rg[i]; if (gl[i] > gm) { gm = gl[i]; gi = i; } }
            float gs = 0.f;
#pragma unroll
            for (int i = 0; i < 8; ++i) gs += expf(gl[i] - gm);
            const float gval = 1.0f / gs;
            float el[8]; int i0 = 0; float m0 = -3.0e38f;
#pragma unroll
            for (int i = 0; i < 8; ++i) { el[i] = l[8 + gi * 8 + i] * rs + b_re[gi * 8 + i]; if (el[i] > m0) { m0 = el[i]; i0 = i; } }
            int i1 = 0; float m1 = -3.0e38f;
#pragma unroll
            for (int i = 0; i < 8; ++i) if (i != i0 && el[i] > m1) { m1 = el[i]; i1 = i; }
            const float p1 = expf(m1 - m0); g0 = gval / (1.0f + p1); g1 = gval * p1 / (1.0f + p1);
            e0 = gi * 8 + i0; e1 = gi * 8 + i1;
            r0 = atomicAdd((unsigned*)(hist + e0), 1u); r1 = atomicAdd((unsigned*)(hist + e1), 1u);
        }
        __syncthreads();
        if (F.tid < 64) { const unsigned n = hist[F.tid]; if (n) hist[64 + F.tid] = atomicAdd(CNT + 16 * F.tid, n); }
        __syncthreads();
        if (F.tid < 64) {
            const int pos0 = (int)(hist[64 + e0] + r0), pos1 = (int)(hist[64 + e1] + r1);
            LIST[e0 * NTOK + pos0] = tok; LIST[e1 * NTOK + pos1] = tok; GATEW[e0 * NTOK + pos0] = g0; GATEW[e1 * NTOK + pos1] = g1; RSTDW[e0 * NTOK + pos0] = rs; RSTDW[e1 * NTOK + pos1] = rs;
            *(int4*)(TOKINFO + 4 * tok) = make_int4(e0, pos0, e1, pos1);
        }
        __syncthreads();
    }
}

__device__ __forceinline__ void build_tables(Frame& F) {
    LAS int* T = (LAS int*)(F.lds + TBL_OFF);
    __syncthreads();
    if (F.tid < NEXP) {
        const int c = (int)__hip_atomic_load(F.ctl + CW_CNT + 16 * F.tid, __ATOMIC_RELAXED, __HIP_MEMORY_SCOPE_AGENT); const int mt = (c + 255) >> 8;
        int incl = mt;
#pragma unroll
        for (int o = 1; o < 64; o <<= 1) { const int v = __shfl_up(incl, o); if (F.tid >= o) incl += v; }
        const int st = incl - mt;
        T[TBL_TSTART + F.tid] = st; T[TBL_CNTS + F.tid] = c;
        for (int i = 0; i < mt; ++i) T[TBL_TE + st + i] = F.tid;
        if (F.tid == NEXP - 1) { T[TBL_TSTART + NEXP] = incl; T[TBL_NT] = incl; }
    }
    __syncthreads();
}
struct MoeGather {
    const int* list; const LAS int* T; LAS int* tokbuf; int NT; const float* rstdw; const float* gatew;
    __device__ __forceinline__ void info(const pg8::Unit& u, int& e, int& base, int& cnt) const { e = u.pn / NT; base = (u.pm - T[TBL_TSTART + e]) * 256; cnt = T[TBL_CNTS + e]; }
    __device__ __forceinline__ unsigned tok_direct(const pg8::Unit& u, int row) const { int e, base, cnt; info(u, e, base, cnt); const int idx = base + row; return idx < cnt ? (unsigned)list[e * NTOK + idx] : 0u; }
    __device__ __forceinline__ void issue(const pg8::Unit& u, int par, int lane) const { int e, base, cnt; info(u, e, base, cnt);
        __builtin_amdgcn_global_load_lds((const unsigned*)(list + e * NTOK + base + 4 * lane), (LAS unsigned*)(tokbuf + par * 256), 16, 0, 0);
        __builtin_amdgcn_global_load_lds((const unsigned*)(rstdw + e * NTOK + base + 4 * lane), (LAS unsigned*)(tokbuf + 512 + par * 256), 16, 0, 0);
        __builtin_amdgcn_global_load_lds((const unsigned*)(gatew + e * NTOK + base + 4 * lane), (LAS unsigned*)(tokbuf + 1024 + par * 256), 16, 0, 0); }
    __device__ __forceinline__ void direct_rg(const pg8::Unit& u, int row, float& rs, float& gw) const { int e, base, cnt; info(u, e, base, cnt); rs = rstdw[e * NTOK + base + row]; gw = gatew[e * NTOK + base + row]; }
    __device__ __forceinline__ unsigned tok_lds(const pg8::Unit& u, int par, int row) const { int e, base, cnt; info(u, e, base, cnt); const unsigned t = (unsigned)tokbuf[par * 256 + row]; return (base + row) < cnt ? t : 0u; }
};
namespace pg8 {
template <class Epi, class Sched>
__device__ __forceinline__ void gemm_phase_g(PG8_LAS unsigned char* lds, const Gemm g, const Sched& S, const Epi& E, const MoeGather& GA) {
    const int tid = threadIdx.x, wid = __builtin_amdgcn_readfirstlane(tid >> 6), lane = tid & 63, wr = wid >> 2, wc = wid & 3, fr = lane & 15, fq = lane >> 4;
    const int K = g.K, nt = K / BK;
    unsigned voffB[2], cofA[2]; int rowA[2];
#pragma unroll
    for (int i = 0; i < 2; ++i) { int R, C; stage_rc(tid * 16 + i * 8192, R, C); const int Rb = Epi::PERM ? ((R & ~31) + perm32(R & 31)) : R;
        rowA[i] = R; cofA[i] = (unsigned)C * 2u; voffB[i] = (unsigned)(Rb * K + C) * 2u; }
    const unsigned rowbytes = (unsigned)K * 2u;
    const size_t kstep = (size_t)(BK * 2);
    const size_t hstep = (size_t)HALF * K * 2;
    const size_t tstep = 2 * hstep;
    const unsigned ldsw = (unsigned)wid * 1024u;
    const int aoff = lds_byte(wr * 64 + fr, fq * 8), boff = lds_byte(wc * 32 + fr, fq * 8);
#define PG8_SA(b, h) (((b) * 2 + (h)) * HTB)
#define PG8_SB(b, h) ((4 + (b) * 2 + (h)) * HTB)
#define PG8_STAGE(bufoff, gbase, voff) do { _Pragma("unroll") for (int _i = 0; _i < 2; ++_i) \
        __builtin_amdgcn_global_load_lds((const unsigned*)((const char*)(gbase) + (voff)[_i]), (PG8_LAS unsigned*)(lds + (bufoff) + ldsw + _i * 8192), 16, 0, 0); } while (0)
#define PG8_LDA(dst, b, h) do { _Pragma("unroll") for (int m = 0; m < 4; ++m) _Pragma("unroll") for (int k = 0; k < 2; ++k) dst[m][k] = *(const PG8_LAS bf16x8*)(lds + PG8_SA(b, h) + aoff + m * 2048 + k * 1024); } while (0)
#define PG8_LDB(dst, b, h) do { _Pragma("unroll") for (int n = 0; n < 2; ++n) _Pragma("unroll") for (int k = 0; k < 2; ++k) dst[n][k] = *(const PG8_LAS bf16x8*)(lds + PG8_SB(b, h) + boff + n * 2048 + k * 1024); } while (0)
#define PG8_MMA(ai, bj, At, Bt) do { __builtin_amdgcn_s_setprio(1); _Pragma("unroll") for (int m = 0; m < 4; ++m) _Pragma("unroll") for (int n = 0; n < 2; ++n) _Pragma("unroll") for (int k = 0; k < 2; ++k) \
        acc[ai][bj][m][n] = __builtin_amdgcn_mfma_f32_16x16x32_bf16(Bt[n][k], At[m][k], acc[ai][bj][m][n], 0, 0, 0); __builtin_amdgcn_s_setprio(0); } while (0)
#define PG8_WAIT_V(n) asm volatile("s_waitcnt vmcnt(" #n ")" ::: "memory")
#define PG8_WAIT_L(n) asm volatile("s_waitcnt lgkmcnt(" #n ")" ::: "memory")
#define PG8_BAR __builtin_amdgcn_s_barrier()
#define PG8_SCHED __builtin_amdgcn_sched_barrier(0)
    Unit cur, nxt; int ui = 0;
    if (!S.next(0, cur)) return;
    f32x4 acc[2][2][4][2];
#pragma unroll
    for (int a = 0; a < 2; ++a)
#pragma unroll
        for (int b = 0; b < 2; ++b)
#pragma unroll
            for (int m = 0; m < 4; ++m)
#pragma unroll
                for (int n = 0; n < 2; ++n) acc[a][b][m][n] = (f32x4){0.f, 0.f, 0.f, 0.f};
    bf16x8 At[4][2], B0[2][2], B1[2][2];
    const char* A0 = (const char*)g.A; const char* cB = (const char*)g.Bt + (size_t)cur.pn * tstep;
    PG8_LAS int* tb = GA.tokbuf;
    if (tid < 256) { tb[tid] = (int)GA.tok_direct(cur, tid); float rs_, gw_; GA.direct_rg(cur, tid, rs_, gw_); ((PG8_LAS float*)tb)[512 + tid] = rs_; ((PG8_LAS float*)tb)[1024 + tid] = gw_; }
    PG8_WAIT_L(0); PG8_BAR;
#define PG8_OFFS(dst, par, half) do { _Pragma("unroll") for (int _i = 0; _i < 2; ++_i) dst[_i] = (unsigned)tb[(par) * 256 + (half) * HALF + rowA[_i]] * rowbytes + cofA[_i]; } while (0)
    {
        unsigned c0[2], c1[2]; PG8_OFFS(c0, 0, 0); PG8_OFFS(c1, 0, 1);
        PG8_STAGE(PG8_SB(0, 0), cB, voffB); PG8_STAGE(PG8_SB(0, 1), cB + hstep, voffB); PG8_STAGE(PG8_SA(0, 0), A0, c0); PG8_STAGE(PG8_SA(0, 1), A0, c1);
        if (wr == 1) PG8_BAR;
        PG8_WAIT_V(2); PG8_BAR;
        PG8_STAGE(PG8_SB(1, 0), cB + kstep, voffB); PG8_STAGE(PG8_SA(1, 0), A0 + kstep, c0); PG8_STAGE(PG8_SB(1, 1), cB + hstep + kstep, voffB);
        PG8_WAIT_V(6); PG8_BAR;
    }
    int t_issue = 2, t_fix = 6; asm volatile("" : "+s"(t_issue), "+s"(t_fix));
    for (;;) {
        const bool has_next = S.next(ui + 1, nxt);
        const char* nB = has_next ? (const char*)g.Bt + (size_t)nxt.pn * tstep : cB;
        const int pc = ui & 1, pnx = (ui + 1) & 1;
        for (int t = 0; t < nt; t += 2) {
            const bool last = (t == nt - 2);
            const char* a1 = A0 + (size_t)(t + 1) * kstep;
            const char* a2 = last ? A0 : A0 + (size_t)(t + 2) * kstep; const char* b2 = last ? nB : cB + (size_t)(t + 2) * kstep;
            const char* a3 = a2 + kstep; const char* b3 = b2 + kstep;
            if (t == t_fix && has_next && tid < 256) { int e_, base_, cnt_; GA.info(nxt, e_, base_, cnt_); if (base_ + tid >= cnt_) tb[pnx * 256 + tid] = 0; }
            const int ps = (last && has_next) ? pnx : pc;
            unsigned c1[2], s0[2], s1[2]; PG8_OFFS(c1, pc, 1); PG8_OFFS(s0, ps, 0); PG8_OFFS(s1, ps, 1);
            PG8_LDB(B0, 0, 0); PG8_LDB(B1, 0, 1); PG8_SCHED; PG8_LDA(At, 0, 0); PG8_STAGE(PG8_SA(1, 1), a1, c1);
            if (t == t_issue && has_next && wid == 0) GA.issue(nxt, pnx, lane);
            PG8_WAIT_V(8); PG8_WAIT_L(0); PG8_BAR; PG8_MMA(0, 0, At, B0); PG8_MMA(0, 1, At, B1); PG8_BAR; PG8_SCHED;
            PG8_LDA(At, 0, 1); PG8_STAGE(PG8_SB(0, 0), b2, voffB); PG8_STAGE(PG8_SB(0, 1), b2 + hstep, voffB); PG8_STAGE(PG8_SA(0, 0), a2, s0);
            PG8_WAIT_V(8); PG8_WAIT_L(0); PG8_BAR; PG8_MMA(1, 0, At, B0); PG8_MMA(1, 1, At, B1); PG8_BAR; PG8_SCHED;
            PG8_LDB(B0, 1, 0); PG8_LDB(B1, 1, 1); PG8_SCHED; PG8_LDA(At, 1, 0); PG8_STAGE(PG8_SA(0, 1), a2, s1);
            PG8_WAIT_V(8); PG8_WAIT_L(0); PG8_BAR; PG8_MMA(0, 0, At, B0); PG8_MMA(0, 1, At, B1); PG8_BAR; PG8_SCHED;
            PG8_LDA(At, 1, 1); PG8_STAGE(PG8_SB(1, 0), b3, voffB); PG8_STAGE(PG8_SB(1, 1), b3 + hstep, voffB); PG8_STAGE(PG8_SA(1, 0), a3, s0);
            PG8_WAIT_V(8); PG8_WAIT_L(0); PG8_BAR; PG8_MMA(1, 0, At, B0); PG8_MMA(1, 1, At, B1); PG8_BAR; PG8_SCHED;
        }
        if (wr == 0) PG8_BAR;
        E.par = pc; E(acc, cur, wr, wc, fr, fq); S.done(cur);
        if (!has_next) break;
#pragma unroll
        for (int a = 0; a < 2; ++a)
#pragma unroll
            for (int b = 0; b < 2; ++b)
#pragma unroll
                for (int m = 0; m < 4; ++m)
#pragma unroll
                    for (int n = 0; n < 2; ++n) acc[a][b][m][n] = (f32x4){0.f, 0.f, 0.f, 0.f};
        cur = nxt; cB = nB; ++ui;
        if (wr == 1) PG8_BAR;
    }
    PG8_WAIT_V(0);
    PG8_BAR;
#undef PG8_SA
#undef PG8_SB
#undef PG8_STAGE
#undef PG8_LDA
#undef PG8_LDB
#undef PG8_MMA
#undef PG8_WAIT_V
#undef PG8_WAIT_L
#undef PG8_BAR
#undef PG8_SCHED
#undef PG8_OFFS
}
}
struct MoeOrder {
    const LAS int* T; int NT, G, c;
    __device__ bool next(int i, pg8::Unit& u) const {
        const int L = i * G + c; if (L >= T[TBL_NT] * NT) return false;
        const int mt = L / NT; u.pm = mt; u.pn = T[TBL_TE + mt] * NT + (L % NT); return true;
    }
    __device__ __forceinline__ void a_ready(const pg8::Unit&) const {}
    __device__ __forceinline__ void done(const pg8::Unit&) const {}
};
struct EpiSwiGLU {
    static constexpr bool PERM = true, AFTER_DRAIN = false, MIDK = false;
    bf16* HDN; const LAS float* RG; const LAS int* T; mutable int par;
    __device__ __forceinline__ void operator()(const pg8::f32x4 (&acc)[2][2][4][2], const pg8::Unit& u, int wr, int wc, int fr, int fq) const {
        const int col0 = (u.pn & 3) * 128 + wc * 32 + 8 * fq; const int e = u.pn >> 2; const int base = (u.pm - T[TBL_TSTART + e]) * 256, cnt = T[TBL_CNTS + e];
#pragma unroll
        for (int ai = 0; ai < 2; ++ai)
#pragma unroll
            for (int m = 0; m < 4; ++m) { const int rl = ai * 128 + wr * 64 + m * 16 + fr; const int row = u.pm * 256 + rl; const bool ok = (base + rl) < cnt;
                const float rsr = RG[par * 256 + rl], gwr = RG[512 + par * 256 + rl];
                const float rs = ok ? rsr : 0.f, gw = ok ? gwr : 0.f;
                float o[8];
#pragma unroll
                for (int n = 0; n < 2; ++n)
#pragma unroll
                    for (int q = 0; q < 4; ++q) { const float g = acc[ai][0][m][n][q] * rs, up = acc[ai][1][m][n][q] * rs;
                        const float sg = g * __builtin_amdgcn_rcpf(1.0f + __builtin_amdgcn_exp2f(-g * LOG2E)); o[4 * n + q] = sg * up * gw; }
                v4u wv; wv.x = pk2(o[0], o[1]); wv.y = pk2(o[2], o[3]); wv.z = pk2(o[4], o[5]); wv.w = pk2(o[6], o[7]);
                *(v4u*)(HDN + (size_t)row * DEXP + col0) = wv; }
    }
};
struct EpiY {
    static constexpr bool PERM = true, AFTER_DRAIN = false, MIDK = false;
    bf16* Y;
    __device__ __forceinline__ void operator()(const pg8::f32x4 (&acc)[2][2][4][2], const pg8::Unit& u, int wr, int wc, int fr, int fq) const {
        const int col0 = (u.pn & 7) * 256 + wc * 32 + 8 * fq;
#pragma unroll
        for (int ai = 0; ai < 2; ++ai)
#pragma unroll
            for (int m = 0; m < 4; ++m) { bf16* rowp = Y + (size_t)(u.pm * 256 + ai * 128 + wr * 64 + m * 16 + fr) * DM + col0;
#pragma unroll
                for (int bj = 0; bj < 2; ++bj) { const pg8::f32x4 v0 = acc[ai][bj][m][0], v1 = acc[ai][bj][m][1];
                    v4u w; w.x = pk2(v0[0], v0[1]); w.y = pk2(v0[2], v0[3]); w.z = pk2(v1[0], v1[1]); w.w = pk2(v1[2], v1[3]); *(v4u*)(rowp + bj * 128) = w; } }
    }
};
struct P8Row { v4u h[4], a[4], b[4]; };
__device__ __forceinline__ void p8_load(P8Row& r, const bf16* HB, const bf16* Y, const LAS int* T, int4 ti, int t, int lane) {
    const size_t s0 = (size_t)T[TBL_TSTART + ti.x] * 256 + ti.y, s1 = (size_t)T[TBL_TSTART + ti.z] * 256 + ti.w;
    const v4u* hp = (const v4u*)(HB + (size_t)t * DM) + lane; const v4u* y0 = (const v4u*)(Y + s0 * DM) + lane; const v4u* y1 = (const v4u*)(Y + s1 * DM) + lane;
#pragma unroll
    for (int j = 0; j < 4; ++j) { r.h[j] = hp[64 * j]; r.a[j] = y0[64 * j]; r.b[j] = y1[64 * j]; }
}
__device__ __forceinline__ void p8_combine(Frame& F) {
    const LAS int* T = (const LAS int*)(F.lds + TBL_OFF);
    const int gw = F.vcu * NWAVES + F.wave, NGW = F.G * NWAVES;
    const bf16* Y = (const bf16*)(F.ws + WS_Y); const bf16* HB = (const bf16*)(F.ws + WS_HB); const int* TOKINFO = (const int*)(F.ws + WS_TOKINFO);
    constexpr int RPW = 8;
    int4 ti[RPW];
#pragma unroll
    for (int k = 0; k < RPW; ++k) { const int t = gw + k * NGW; ti[k] = (t < NTOK) ? *(const int4*)(TOKINFO + 4 * t) : make_int4(0, 0, 0, 0); }
    P8Row cur; if (gw < NTOK) p8_load(cur, HB, Y, T, ti[0], gw, F.lane);
#pragma unroll
    for (int k = 0; k < RPW; ++k) {
        const int t = gw + k * NGW; if (t >= NTOK) break;
        P8Row nxt; const int tn = t + NGW;
        if (k + 1 < RPW && tn < NTOK) p8_load(nxt, HB, Y, T, ti[k + 1 < RPW ? k + 1 : k], tn, F.lane);
        f32x4* od = (f32x4*)(F.out + (size_t)t * DM) + 2 * F.lane;
#pragma unroll
        for (int j = 0; j < 4; ++j) {
            const v4u h = cur.h[j], a = cur.a[j], b = cur.b[j]; f32x4 v0, v1;
            v0[0] = bf_lo(h.x) + bf_lo(a.x) + bf_lo(b.x); v0[1] = bf_hi(h.x) + bf_hi(a.x) + bf_hi(b.x); v0[2] = bf_lo(h.y) + bf_lo(a.y) + bf_lo(b.y); v0[3] = bf_hi(h.y) + bf_hi(a.y) + bf_hi(b.y);
            v1[0] = bf_lo(h.z) + bf_lo(a.z) + bf_lo(b.z); v1[1] = bf_hi(h.z) + bf_hi(a.z) + bf_hi(b.z); v1[2] = bf_lo(h.w) + bf_lo(a.w) + bf_lo(b.w); v1[3] = bf_hi(h.w) + bf_hi(a.w) + bf_hi(b.w);
            od[128 * j] = v0; od[128 * j + 1] = v1;
        }
        cur = nxt;
    }
    for (int t = gw + RPW * NGW; t < NTOK; t += NGW) {
        const int4 tj = *(const int4*)(TOKINFO + 4 * t); P8Row r; p8_load(r, HB, Y, T, tj, t, F.lane);
        f32x4* od = (f32x4*)(F.out + (size_t)t * DM) + 2 * F.lane;
#pragma unroll
        for (int j = 0; j < 4; ++j) {
            const v4u h = r.h[j], a = r.a[j], b = r.b[j]; f32x4 v0, v1;
            v0[0] = bf_lo(h.x) + bf_lo(a.x) + bf_lo(b.x); v0[1] = bf_hi(h.x) + bf_hi(a.x) + bf_hi(b.x); v0[2] = bf_lo(h.y) + bf_lo(a.y) + bf_lo(b.y); v0[3] = bf_hi(h.y) + bf_hi(a.y) + bf_hi(b.y);
            v1[0] = bf_lo(h.z) + bf_lo(a.z) + bf_lo(b.z); v1[1] = bf_hi(h.z) + bf_hi(a.z) + bf_hi(b.z); v1[2] = bf_lo(h.w) + bf_lo(a.w) + bf_lo(b.w); v1[3] = bf_hi(h.w) + bf_hi(a.w) + bf_hi(b.w);
            od[128 * j] = v0; od[128 * j + 1] = v1;
        }
    }
}

__global__ void __launch_bounds__(NWAVES * 64, 2) mk_fwd(Args args) {
    extern __shared__ __attribute__((aligned(16))) unsigned char lds[];
    Frame F;
    F.lds = (LAS unsigned char*)lds; F.ws = args.ws; F.ctl = (unsigned*)(args.ws + WS_CTL);
    F.tid = threadIdx.x; F.lane = F.tid & 63; F.wave = __builtin_amdgcn_readfirstlane(F.tid >> 6);
    F.G = gridDim.x; { const int bx = blockIdx.x; F.vcu = (F.G % 8 == 0) ? (bx % 8) * (F.G / 8) + bx / 8 : bx; }
    F.in = args.in; F.out = args.out;
    volatile LAS unsigned* MISC = (volatile LAS unsigned*)(F.lds + MISC_OFF);
    if (F.tid < 64) MISC[F.tid] = 0u;
    __syncthreads();
    const int lo = args.ph_lo, hi = args.ph_hi;
    const bool use_bar = (hi - lo) > 1;
    XcdBarrier bar; bar.bar = F.ctl + CW_BAR + args.li * XCD_BAR_WORDS; bar.x = 0; bar.st = nullptr;
    if (use_bar) bar = xcd_barrier_post(F.ctl + CW_BAR + args.li * XCD_BAR_WORDS, MISC + 8);
#define IN(k) (lo <= (k) && (k) < hi)
#define SEAM(k) do { if (IN(k) && (IN((k) + 1) || ((k) == 4 && IN(6)))) xcd_barrier(bar); } while (0)
    bf16* BIG = (bf16*)(F.ws + WS_BIG);

    if (IN(0)) { p0_prologue(F); SEAM(0); }
    if (IN(1)) {
        pg8::Gemm g{BIG, BIG, 0, 0, DM}; P1Order S{F.G, F.vcu};
        EpiQKV E{(bf16*)(F.ws + WS_QS), (bf16*)(F.ws + WS_KS), (bf16*)(F.ws + WS_QW), (bf16*)(F.ws + WS_KW), (bf16*)(F.ws + WS_VT), F.in[5], F.in[6]};
        pg8::gemm_phase<EpiQKV, P1Order, true, true>(F.lds + RING_OFF, g, S, E);
        {
            const int rounds = (P1_UNITS + F.G - 1) / F.G, first_idle = P1_UNITS - (rounds - 1) * F.G, nidle = F.G - first_idle;
            const int base = NITEMS - TAIL6_ITEMS - tail1_items(F.G);
            if (F.vcu >= first_idle) conv_range(F, base + (F.vcu - first_idle) * NWAVES + F.wave, nidle * NWAVES, NITEMS - TAIL6_ITEMS);
        }
        SEAM(1);
    }
    if (IN(2)) { p2_attention(F); SEAM(2); }
    if (IN(3)) {
        pg8::Gemm g{(const bf16*)(F.ws + WS_MIXED), (const bf16*)(F.ws + WS_WOUT), NTOK, DM, DM}; pg8::StaticOrder S; S.init(NTOK, DM, F.G, (int)blockIdx.x);
        LAS float* RS = (LAS float*)(F.lds + ATT_TBR_OFF);
        {   const float* SSQ = (const float*)(F.ws + WS_SSQ);
            for (int i = 0; i < 4; ++i) { pg8::Unit u; if (!S.next(i, u)) break;
                if (F.tid < 256) { const pg8::f32x4* q = (const pg8::f32x4*)(SSQ + (size_t)(u.pm * 256 + F.tid) * 16); const pg8::f32x4 a = q[0], b = q[1], c = q[2], d = q[3];
                    float sb = 0.f, sw = 0.f;
#pragma unroll
                    for (int q_ = 0; q_ < ATT_WAVES; ++q_) { sb += (q_ < 4 ? a[q_ & 3] : b[q_ & 3]); sw += (q_ < 4 ? c[q_ & 3] : d[q_ & 3]); }
                    RS[(i * 256 + F.tid) * 2] = 1.0f / sqrtf(sb * (1.0f / 1024.0f) + RMS_EPS); RS[(i * 256 + F.tid) * 2 + 1] = 1.0f / sqrtf(sw * (1.0f / 1024.0f) + RMS_EPS); } }
            __syncthreads(); }
        EpiRes E{(bf16*)(F.ws + WS_PROJ), RS, 0};
        pg8::gemm_phase<EpiRes, pg8::StaticOrder, true, true>(F.lds + RING_OFF, g, S, E);
        SEAM(3);
    }
    if (IN(4)) { p4_router(F); SEAM(4); }
    if (IN(5) || IN(6) || IN(7) || IN(8)) build_tables(F);
    if (IN(6)) {
        pg8::Gemm g{(const bf16*)(F.ws + WS_HB), (const bf16*)(F.ws + WS_WGU), 0, 0, DM}; MoeOrder S{(const LAS int*)(F.lds + TBL_OFF), 4, F.G, F.vcu};
        MoeGather GA{(const int*)(F.ws + WS_LIST), (const LAS int*)(F.lds + TBL_OFF), (LAS int*)(F.lds + TOKBUF_OFF), 4, (const float*)(F.ws + WS_RSTDW), (const float*)(F.ws + WS_GATEW)};
        EpiSwiGLU E{(bf16*)(F.ws + WS_HDN), (const LAS float*)(F.lds + TOKBUF_OFF + 2048), (const LAS int*)(F.lds + TBL_OFF), 0};
        pg8::gemm_phase_g<EpiSwiGLU, MoeOrder>(F.lds + RING_OFF, g, S, E, GA);
        {
            const int units = S.T[TBL_NT] * 4, rounds = (units + F.G - 1) / F.G, first_idle = units - (rounds - 1) * F.G, nidle = F.G - first_idle;
            const int base = NITEMS - TAIL6_ITEMS; int mid = base + nidle * NWAVES * TAIL6_PER_WAVE; if (mid > NITEMS) mid = NITEMS;
            if (nidle > 0 && F.vcu >= first_idle) conv_range(F, base + (F.vcu - first_idle) * NWAVES + F.wave, nidle * NWAVES, mid);
            conv_range(F, mid + F.vcu * NWAVES + F.wave, F.G * NWAVES, NITEMS);
        }
        SEAM(6);
    }
    if (IN(7)) {
        pg8::Gemm g{(const bf16*)(F.ws + WS_HDN), (const bf16*)(F.ws + WS_WD), 0, 0, DEXP}; MoeOrder S{(const LAS int*)(F.lds + TBL_OFF), 8, F.G, F.vcu};
        EpiY E{(bf16*)(F.ws + WS_Y)};
        pg8::gemm_phase<EpiY, MoeOrder, true, true>(F.lds + RING_OFF, g, S, E);
        SEAM(7);
    }
    if (IN(8)) p8_combine(F);
#undef IN
#undef SEAM
}

extern "C" void kernel_launch(void* const* d_in, const int* in_sizes, int n_in, void* d_out, int out_size, void* d_ws, size_t ws_size, hipStream_t stream) {
    static int grid = 0;
    if (grid == 0) {
        if (n_in != 19 || out_size != NTOK * DM || ws_size < WS_END) { fprintf(stderr, "kernel_launch: unexpected shapes (n_in %d out %d ws %zu)\n", n_in, out_size, ws_size); grid = -1; return; }
        int dev = 0, cus = 0, per_cu = 0;
        if (hipGetDevice(&dev) != hipSuccess || hipDeviceGetAttribute(&cus, hipDeviceAttributeMultiprocessorCount, dev) != hipSuccess) { grid = -1; return; }
        if (hipFuncSetAttribute((const void*)mk_fwd, hipFuncAttributeMaxDynamicSharedMemorySize, LDS_BYTES) != hipSuccess) { fprintf(stderr, "kernel_launch: hipFuncSetAttribute failed\n"); grid = -1; return; }
        if (hipOccupancyMaxActiveBlocksPerMultiprocessor(&per_cu, (const void*)mk_fwd, NWAVES * 64, LDS_BYTES) != hipSuccess || per_cu < 1) { fprintf(stderr, "kernel_launch: occupancy query reports %d\n", per_cu); }
        (void)hipGetLastError();
        grid = cus;
    }
    if (grid < 0) return;
    (void)hipMemsetAsync((char*)d_ws + WS_CTL, 0, CTL_ZERO_BYTES, stream);
    Args a{};
    for (int i = 0; i < 19; ++i) a.in[i] = (const float*)d_in[i];
    a.out = (float*)d_out; a.ws = (unsigned char*)d_ws;
#if MK_N_LAUNCHES == 1
    a.ph_lo = 0; a.ph_hi = N_PHASES; a.li = 0;
    hipLaunchKernelGGL(mk_fwd, dim3(grid), dim3(NWAVES * 64), LDS_BYTES, stream, a);
#else
    a.li = 0;
    for (int p = 0; p < N_PHASES; ++p) { a.ph_lo = p; a.ph_hi = p + 1; hipLaunchKernelGGL(mk_fwd, dim3(grid), dim3(NWAVES * 64), LDS_BYTES, stream, a); }
#endif
}
```

```cpp
#include <hip/hip_runtime.h>
#include <cstdio>
#include <cstdint>
namespace pg8 {
#define PG8_LAS __attribute__((address_space(3)))
typedef unsigned short bf16_t;
typedef short bf16x8 __attribute__((ext_vector_type(8)));
typedef float f32x4 __attribute__((ext_vector_type(4)));
typedef unsigned u32x4 __attribute__((ext_vector_type(4)));
constexpr int BM = 256, BK = 64, HALF = 128, HTB = HALF * BK * 2  , STAGE_BYTES = 8 * HTB, NXCD = 8, WGM = 8;

__host__ __device__ __forceinline__ int lds_byte(int r, int c) { const int st = (r >> 4) * 2 + (c >> 5), rr = r & 15, cc = c & 31, ob = rr * 64 + cc * 2; return st * 1024 + (ob ^ (((ob >> 9) & 1) << 5)); }
__host__ __device__ __forceinline__ void stage_rc(int b, int& R, int& C) { const int st = b / 1024, sb = b % 1024, swz = sb ^ (((sb >> 9) & 1) << 5); R = (st >> 1) * 16 + swz / 64; C = (st & 1) * 32 + (swz % 64) / 2; }
__host__ __device__ __forceinline__ int perm32(int rho) { const int n = rho >> 4, i = rho & 15; return 8 * (i >> 2) + 4 * n + (i & 3); }

struct Unit { int pm, pn; };
struct Gemm { const bf16_t* A; const bf16_t* Bt; int M, N, K; };

struct StaticOrder {
    int nM, nN, nwg, G, c;
    __host__ __device__ void init(int M, int N, int G_, int c_) { nM = M / BM; nN = N / BM; nwg = nM * nN; G = G_; c = c_; }
    __host__ __device__ bool next(int i, Unit& u) const {
        const long L = (long)i * G + c; if (L >= nwg) return false;
        int wgid = (int)L; { const int q = nwg / NXCD, r = nwg % NXCD, xcd = wgid % NXCD, off = wgid / NXCD; wgid = (xcd < r ? xcd * (q + 1) : r * (q + 1) + (xcd - r) * q) + off; }
        const int nig = WGM * nN, gid = wgid / nig, fm = gid * WGM, gsz = (nM - fm) < WGM ? (nM - fm) : WGM;
        u.pm = fm + ((wgid % nig) % gsz); u.pn = (wgid % nig) / gsz; return true;
    }
    __device__ __forceinline__ void a_ready(const Unit&) const {}
    __device__ __forceinline__ void done(const Unit&) const {}
};

__device__ __forceinline__ unsigned cvt_pk_bf16(float lo, float hi) { unsigned r; asm volatile("v_cvt_pk_bf16_f32 %0, %1, %2" : "=v"(r) : "v"(lo), "v"(hi)); return r; }
typedef float f32x2 __attribute__((ext_vector_type(2)));
__device__ __forceinline__ f32x2 gelu_pk(f32x2 v) {
    const f32x2 av = __builtin_elementwise_abs(v), d = av * 0.2316418882f + 1.0f;
    f32x2 t; t.x = __builtin_amdgcn_rcpf(d.x); t.y = __builtin_amdgcn_rcpf(d.y);
    f32x2 q = t * 0.5307027145f + (-0.7265760135f); q = q * t + 0.7107068705f; q = q * t + (-0.142248368f); q = q * t + 0.127414796f; q = q * t;
    const f32x2 s = (v * v) * (-0.72134752044f);
    f32x2 e; e.x = __builtin_amdgcn_exp2f(s.x); e.y = __builtin_amdgcn_exp2f(s.y);
    const f32x2 m = v * (q * e), r = v - m;
    f32x2 o; o.x = v.x < 0.f ? m.x : r.x; o.y = v.y < 0.f ? m.y : r.y; return o;
}

template <int ACT  > struct EpiBf16 {
    static constexpr bool PERM = true, AFTER_DRAIN = false; static_assert(ACT == 0 || ACT == 1, "EpiBf16: ACT is 0 (none) or 1 (gelu_pk)");
    bf16_t* O; int ldc; const float* bias; int split_cols; size_t split_stride; float scale0;
    __device__ __forceinline__ void operator()(const f32x4 (&acc)[2][2][4][2], const Unit& u, int wr, int wc, int fr, int fq) const {
        const int row0 = u.pm * BM + wr * 64 + fr; int colt = u.pn * BM; bf16_t* base = O;
        float sc = 1.f; if (split_cols) { const int t = colt / split_cols; base += (size_t)t * split_stride; colt -= t * split_cols; if (t == 0) sc = scale0; }
        const int col0 = colt + wc * 32 + 8 * fq, bcol0 = u.pn * BM + wc * 32 + 8 * fq;
        f32x4 bv[2][2];
#pragma unroll
        for (int bj = 0; bj < 2; ++bj)
#pragma unroll
            for (int n = 0; n < 2; ++n) bv[bj][n] = bias ? *(const f32x4*)(bias + bcol0 + bj * HALF + 4 * n) : (f32x4){0.f, 0.f, 0.f, 0.f};
#pragma unroll
        for (int ai = 0; ai < 2; ++ai)
#pragma unroll
            for (int m = 0; m < 4; ++m) { bf16_t* rowp = base + (size_t)(row0 + ai * HALF + m * 16) * ldc + col0;
#pragma unroll
                for (int bj = 0; bj < 2; ++bj) { f32x4 v0 = acc[ai][bj][m][0] + bv[bj][0], v1 = acc[ai][bj][m][1] + bv[bj][1];
                    if (ACT == 1) { f32x2 a = gelu_pk((f32x2){v0[0], v0[1]}), b = gelu_pk((f32x2){v0[2], v0[3]}), c = gelu_pk((f32x2){v1[0], v1[1]}), d = gelu_pk((f32x2){v1[2], v1[3]});
                        v0 = (f32x4){a.x, a.y, b.x, b.y}; v1 = (f32x4){c.x, c.y, d.x, d.y}; }
                    v0 = v0 * sc; v1 = v1 * sc; u32x4 w; w.x = cvt_pk_bf16(v0[0], v0[1]); w.y = cvt_pk_bf16(v0[2], v0[3]); w.z = cvt_pk_bf16(v1[0], v1[1]); w.w = cvt_pk_bf16(v1[2], v1[3]);
                    *(u32x4*)(rowp + bj * HALF) = w; } }
    }
};

struct PanelStats {
    unsigned* xbuf;
    unsigned* cnt;
    unsigned* tmo;
    int ntn; float eps;
    unsigned code;
    __device__ __forceinline__ bool run(const f32x4 (&v)[2][2][4][2], const Unit& u, int wr, int wc, int fr, int fq, PG8_LAS unsigned char* lds, int wid, int lane) const {
        typedef float f32x2v __attribute__((ext_vector_type(2)));
        PG8_LAS f32x2v* P = (PG8_LAS f32x2v*)lds;
        PG8_LAS f32x2v* S = (PG8_LAS f32x2v*)(lds + 8192);
        PG8_LAS unsigned* flag = (PG8_LAS unsigned*)(lds + 8192 + 2048);
#pragma unroll
        for (int ai = 0; ai < 2; ++ai)
#pragma unroll
            for (int m = 0; m < 4; ++m) {
                float s = 0.f;
#pragma unroll
                for (int bj = 0; bj < 2; ++bj)
#pragma unroll
                    for (int n = 0; n < 2; ++n) { const f32x4 x = v[ai][bj][m][n]; s += (x[0] + x[1]) + (x[2] + x[3]); }
                s += __shfl_xor(s, 16); s += __shfl_xor(s, 32);
                const float mw = s * (1.0f / 64.0f); float q = 0.f;
#pragma unroll
                for (int bj = 0; bj < 2; ++bj)
#pragma unroll
                    for (int n = 0; n < 2; ++n) { const f32x4 d = v[ai][bj][m][n] - mw; q += (d[0] * d[0] + d[1] * d[1]) + (d[2] * d[2] + d[3] * d[3]); }
                q += __shfl_xor(q, 16); q += __shfl_xor(q, 32);
                if (fq == 0) P[(ai * HALF + wr * 64 + m * 16 + fr) * 4 + wc] = (f32x2v){mw, q};
            }
        asm volatile("s_waitcnt lgkmcnt(0)" ::: "memory"); __builtin_amdgcn_s_barrier(); asm volatile("" ::: "memory");
#if defined(BROKEN_EXCHANGE_NO_WAIT)
#warning BROKEN CONTROL BUILD: the row-statistics exchange does not wait; results are wrong by design
        if (blockIdx.x >= 64) { const long long t0_ = clock64(); while (clock64() - t0_ < 60000) __builtin_amdgcn_s_sleep(8); }
#endif
        const int row = wid * 32 + (lane & 31);
        if (lane < 32) {
            const f32x2v a = P[row * 4 + 0], b = P[row * 4 + 1], c = P[row * 4 + 2], d = P[row * 4 + 3];
            const float mt = (a.x + b.x + c.x + d.x) * 0.25f;
            const float da = a.x - mt, db = b.x - mt, dc = c.x - mt, dd = d.x - mt;
            const float m2 = (a.y + b.y) + (c.y + d.y) + 64.0f * ((da * da + db * db) + (dc * dc + dd * dd));
            unsigned long long* slot = (unsigned long long*)xbuf + ((size_t)(u.pm * BM + row) * 4 + u.pn);
            __hip_atomic_store(slot, ((unsigned long long)__float_as_uint(m2) << 32) | __float_as_uint(mt), __ATOMIC_RELAXED, __HIP_MEMORY_SCOPE_AGENT);
        }
        asm volatile("s_waitcnt vmcnt(0)" ::: "memory");
        if (lane == 0) __hip_atomic_fetch_add(cnt + 64 * u.pm, 1u, __ATOMIC_RELAXED, __HIP_MEMORY_SCOPE_AGENT);
        if (wid == 0) {
            bool dead = false; const unsigned long long t0 = __builtin_amdgcn_s_memrealtime(); const unsigned want = 8u * (unsigned)ntn;
            for (;;) {
#if defined(BROKEN_EXCHANGE_NO_WAIT)
                break;
#endif
                if ((unsigned)__builtin_amdgcn_readfirstlane(__hip_atomic_load(cnt + 64 * u.pm, __ATOMIC_RELAXED, __HIP_MEMORY_SCOPE_AGENT)) >= want) break;
                if (__builtin_amdgcn_s_memrealtime() - t0 > 2000000ull) {
                    if (lane == 0) { unsigned expect = 0u; __hip_atomic_compare_exchange_strong(tmo + 1, &expect, code | (unsigned)(u.pm & 0xff), __ATOMIC_RELAXED, __ATOMIC_RELAXED, __HIP_MEMORY_SCOPE_AGENT);
                                     __hip_atomic_store(tmo, 1u, __ATOMIC_RELAXED, __HIP_MEMORY_SCOPE_AGENT); }
                    dead = true; break; }
                __builtin_amdgcn_s_sleep(2);
            }
            __builtin_amdgcn_fence(__ATOMIC_ACQUIRE, "agent");
            if (lane == 0) flag[0] = dead ? 1u : 0u;
        }
        asm volatile("s_waitcnt vmcnt(0) lgkmcnt(0)" ::: "memory"); __builtin_amdgcn_s_barrier(); asm volatile("" ::: "memory");
        const bool bad = flag[0] != 0u;
        if (lane < 32) {
            const unsigned long long* slot = (const unsigned long long*)xbuf + (size_t)(u.pm * BM + row) * 4; float mt[4], m2[4]; float ms = 0.f;
#pragma unroll
            for (int t = 0; t < 4; ++t) { if (t < ntn) { const unsigned long long w = __hip_atomic_load(slot + t, __ATOMIC_RELAXED, __HIP_MEMORY_SCOPE_AGENT); mt[t] = __uint_as_float((unsigned)w); m2[t] = __uint_as_float((unsigned)(w >> 32)); } else { mt[t] = 0.f; m2[t] = 0.f; } ms += mt[t]; }
            const float mean = ms / (float)ntn; float q = 0.f;
#pragma unroll
            for (int t = 0; t < 4; ++t) if (t < ntn) { const float dm = mt[t] - mean; q += m2[t] + 256.0f * dm * dm; }
            S[row] = (f32x2v){mean, 1.0f / sqrtf(q / (256.0f * (float)ntn) + eps)};
        }
        asm volatile("s_waitcnt lgkmcnt(0)" ::: "memory"); __builtin_amdgcn_s_barrier(); asm volatile("" ::: "memory");
        return bad;
    }
};
struct EpiLnRes {
    static constexpr bool PERM = false, AFTER_DRAIN = true;
    const float* base; float* out; int ldc; const float* bias; PanelStats st; unsigned poison;
    __device__ __forceinline__ void fused(f32x4 (&acc)[2][2][4][2], const Unit& u, int wr, int wc, int fr, int fq, PG8_LAS unsigned char* lds, int wid, int lane) const {
        typedef float f32x2v __attribute__((ext_vector_type(2)));
        const PG8_LAS f32x2v* S = (const PG8_LAS f32x2v*)(lds + 8192);
        const int col0 = u.pn * BM + wc * 32 + 4 * fq;
#pragma unroll
        for (int bj = 0; bj < 2; ++bj)
#pragma unroll
            for (int n = 0; n < 2; ++n) { const f32x4 bv = bias ? *(const f32x4*)(bias + col0 + bj * HALF + n * 16) : (f32x4){0.f, 0.f, 0.f, 0.f};
#pragma unroll
                for (int ai = 0; ai < 2; ++ai)
#pragma unroll
                    for (int m = 0; m < 4; ++m) acc[ai][bj][m][n] += bv; }
        f32x4 pre[4][2][2];
#pragma unroll
        for (int m = 0; m < 4; ++m) { const size_t off = (size_t)(u.pm * BM + wr * 64 + m * 16 + fr) * ldc + col0;
#pragma unroll
            for (int bj = 0; bj < 2; ++bj)
#pragma unroll
                for (int n = 0; n < 2; ++n) pre[m][bj][n] = *(const f32x4*)(base + off + bj * HALF + n * 16); }
        const bool bad = st.run(acc, u, wr, wc, fr, fq, lds, wid, lane) || poison != 0u;
        const float qnan = __builtin_nanf("");
#pragma unroll
        for (int ai = 0; ai < 2; ++ai)
#pragma unroll
            for (int m = 0; m < 4; ++m) { const int r = ai * HALF + wr * 64 + m * 16 + fr; const f32x2v sr = S[r]; const size_t off = (size_t)(u.pm * BM + r) * ldc + col0;
#pragma unroll
                for (int bj = 0; bj < 2; ++bj)
#pragma unroll
                    for (int n = 0; n < 2; ++n) { const f32x4 bs = ai == 0 ? pre[m][bj][n] : *(const f32x4*)(base + off + bj * HALF + n * 16); f32x4 o = bs + (acc[ai][bj][m][n] - sr.x) * sr.y;
                        if (bad) o = (f32x4){qnan, qnan, qnan, qnan}; *(f32x4*)(out + off + bj * HALF + n * 16) = o; }
                if (m & 1) asm volatile("" ::: "memory"); }
    }
};
struct EpiLnResLn {
    static constexpr bool PERM = false, AFTER_DRAIN = true;
    const float* base; float* out; bf16_t* xn; int ldc; const float* bias; PanelStats st1, st2; unsigned poison;
    __device__ __forceinline__ void fused(f32x4 (&acc)[2][2][4][2], const Unit& u, int wr, int wc, int fr, int fq, PG8_LAS unsigned char* lds, int wid, int lane) const {
        typedef float f32x2v __attribute__((ext_vector_type(2))); typedef unsigned u32x2v __attribute__((ext_vector_type(2)));
        const PG8_LAS f32x2v* S = (const PG8_LAS f32x2v*)(lds + 8192);
        const int col0 = u.pn * BM + wc * 32 + 4 * fq;
#pragma unroll
        for (int bj = 0; bj < 2; ++bj)
#pragma unroll
            for (int n = 0; n < 2; ++n) { const f32x4 bv = bias ? *(const f32x4*)(bias + col0 + bj * HALF + n * 16) : (f32x4){0.f, 0.f, 0.f, 0.f};
#pragma unroll
                for (int ai = 0; ai < 2; ++ai)
#pragma unroll
                    for (int m = 0; m < 4; ++m) acc[ai][bj][m][n] += bv; }
        bool bad = st1.run(acc, u, wr, wc, fr, fq, lds, wid, lane) || poison != 0u;
        const float qnan = __builtin_nanf("");
#pragma unroll
        for (int ai = 0; ai < 2; ++ai)
#pragma unroll
            for (int m = 0; m < 4; ++m) { const int r = ai * HALF + wr * 64 + m * 16 + fr; const f32x2v sr = S[r]; const size_t off = (size_t)(u.pm * BM + r) * ldc + col0;
#pragma unroll
                for (int bj = 0; bj < 2; ++bj)
#pragma unroll
                    for (int n = 0; n < 2; ++n) { const f32x4 bs = *(const f32x4*)(base + off + bj * HALF + n * 16); acc[ai][bj][m][n] = bs + (acc[ai][bj][m][n] - sr.x) * sr.y; }
                asm volatile("" : "+v"(acc[ai][0][m][0]), "+v"(acc[ai][0][m][1]), "+v"(acc[ai][1][m][0]), "+v"(acc[ai][1][m][1]));
                if (m & 1) asm volatile("" ::: "memory"); }
        const bool bad1 = bad;
        bad = st2.run(acc, u, wr, wc, fr, fq, lds, wid, lane) || bad;
#pragma unroll
        for (int ai = 0; ai < 2; ++ai)
#pragma unroll
            for (int m = 0; m < 4; ++m) { const int r = ai * HALF + wr * 64 + m * 16 + fr; const f32x2v sr = S[r]; const size_t off = (size_t)(u.pm * BM + r) * ldc + col0;
#pragma unroll
                for (int bj = 0; bj < 2; ++bj)
#pragma unroll
                    for (int n = 0; n < 2; ++n) { const f32x4 x1 = acc[ai][bj][m][n]; *(f32x4*)(out + off + bj * HALF + n * 16) = bad1 ? (f32x4){qnan, qnan, qnan, qnan} : x1;
                        const f32x4 o = (x1 - sr.x) * sr.y; u32x2v w; w.x = cvt_pk_bf16(o[0], o[1]); w.y = cvt_pk_bf16(o[2], o[3]);
                        if (bad) { w.x = 0x7fc07fc0u; w.y = 0x7fc07fc0u; } *(u32x2v*)(xn + off + bj * HALF + n * 16) = w; }
                asm volatile("" ::: "memory"); }
    }
};

template <class Epi, class Sched, bool ALIGN_EPI = false, bool SP2 = false>
__device__ __forceinline__ void gemm_phase(PG8_LAS unsigned char* lds, const Gemm g, const Sched& S, const Epi& E) {
    const int tid = threadIdx.x, wid = __builtin_amdgcn_readfirstlane(tid >> 6), lane = tid & 63, wr = wid >> 2, wc = wid & 3, fr = lane & 15, fq = lane >> 4;
    const int K = g.K, nt = K / BK;
    unsigned voffA[2], voffB[2];
#pragma unroll
    for (int i = 0; i < 2; ++i) { int R, C; stage_rc(tid * 16 + i * 8192, R, C); const int Rb = Epi::PERM ? ((R & ~31) + perm32(R & 31)) : R;
        voffA[i] = (unsigned)(R * K + C) * 2u; voffB[i] = (unsigned)(Rb * K + C) * 2u; }
    const size_t kstep = (size_t)(BK * 2);
    const size_t hstep = (size_t)HALF * K * 2;
    const size_t tstep = 2 * hstep;
    const unsigned ldsw = (unsigned)wid * 1024u;
    const int aoff = lds_byte(wr * 64 + fr, fq * 8), boff = lds_byte(wc * 32 + fr, fq * 8);
#define PG8_SA(b, h) (((b) * 2 + (h)) * HTB)
#define PG8_SB(b, h) ((4 + (b) * 2 + (h)) * HTB)
#define PG8_STAGE(bufoff, gbase, voff) do { _Pragma("unroll") for (int _i = 0; _i < 2; ++_i) \
        __builtin_amdgcn_global_load_lds((const unsigned*)((const char*)(gbase) + (voff)[_i]), (PG8_LAS unsigned*)(lds + (bufoff) + ldsw + _i * 8192), 16, 0, 0); } while (0)
#define PG8_LDA(dst, b, h) do { _Pragma("unroll") for (int m = 0; m < 4; ++m) _Pragma("unroll") for (int k = 0; k < 2; ++k) dst[m][k] = *(const PG8_LAS bf16x8*)(lds + PG8_SA(b, h) + aoff + m * 2048 + k * 1024); } while (0)
#define PG8_LDB(dst, b, h) do { _Pragma("unroll") for (int n = 0; n < 2; ++n) _Pragma("unroll") for (int k = 0; k < 2; ++k) dst[n][k] = *(const PG8_LAS bf16x8*)(lds + PG8_SB(b, h) + boff + n * 2048 + k * 1024); } while (0)
#define PG8_MMA(ai, bj, At, Bt) do { __builtin_amdgcn_s_setprio(1); _Pragma("unroll") for (int m = 0; m < 4; ++m) _Pragma("unroll") for (int n = 0; n < 2; ++n) _Pragma("unroll") for (int k = 0; k < 2; ++k) \
        acc[ai][bj][m][n] = __builtin_amdgcn_mfma_f32_16x16x32_bf16(Bt[n][k], At[m][k], acc[ai][bj][m][n], 0, 0, 0); __builtin_amdgcn_s_setprio(0); } while (0)
#define PG8_WAIT_V(n) asm volatile("s_waitcnt vmcnt(" #n ")" ::: "memory")
#define PG8_WAIT_L(n) asm volatile("s_waitcnt lgkmcnt(" #n ")" ::: "memory")
#define PG8_BAR __builtin_amdgcn_s_barrier()
#define PG8_SCHED __builtin_amdgcn_sched_barrier(0)
    Unit cur, nxt; int ui = 0;
    if (!S.next(0, cur)) return;
    f32x4 acc[2][2][4][2];
#pragma unroll
    for (int a = 0; a < 2; ++a)
#pragma unroll
        for (int b = 0; b < 2; ++b)
#pragma unroll
            for (int m = 0; m < 4; ++m)
#pragma unroll
                for (int n = 0; n < 2; ++n) acc[a][b][m][n] = (f32x4){0.f, 0.f, 0.f, 0.f};
    bf16x8 At[4][2], B0[2][2], B1[2][2];
    const char* cA = (const char*)g.A + (size_t)cur.pm * tstep; const char* cB = (const char*)g.Bt + (size_t)cur.pn * tstep;
    S.a_ready(cur);
    if constexpr (SP2) {
        PG8_STAGE(PG8_SB(0, 0), cB, voffB); PG8_STAGE(PG8_SB(0, 1), cB + hstep, voffB); PG8_STAGE(PG8_SA(0, 0), cA, voffA); PG8_STAGE(PG8_SA(0, 1), cA + hstep, voffA);
        if (wr == 1) PG8_BAR;
        PG8_WAIT_V(2); PG8_BAR;
        PG8_STAGE(PG8_SB(1, 0), cB + kstep, voffB); PG8_STAGE(PG8_SA(1, 0), cA + kstep, voffA); PG8_STAGE(PG8_SB(1, 1), cB + hstep + kstep, voffB);
        PG8_WAIT_V(6); PG8_BAR;
    } else {
        PG8_STAGE(PG8_SB(0, 0), cB, voffB); PG8_STAGE(PG8_SA(0, 0), cA, voffA); PG8_STAGE(PG8_SB(0, 1), cB + hstep, voffB); PG8_STAGE(PG8_SA(0, 1), cA + hstep, voffA);
        if (wr == 1) PG8_BAR;
        PG8_WAIT_V(4); PG8_BAR;
        PG8_STAGE(PG8_SB(1, 0), cB + kstep, voffB); PG8_STAGE(PG8_SA(1, 0), cA + kstep, voffA); PG8_STAGE(PG8_SB(1, 1), cB + hstep + kstep, voffB);
        PG8_WAIT_V(6); PG8_BAR;
    }
    int t_mid = nt >> 1; if constexpr (Epi::MIDK) asm volatile("" : "+s"(t_mid));
    for (;;) {
        const bool has_next = S.next(ui + 1, nxt);
        const char* nA = has_next ? (const char*)g.A + (size_t)nxt.pm * tstep : cA; const char* nB = has_next ? (const char*)g.Bt + (size_t)nxt.pn * tstep : cB;
        for (int t = 0; t < nt; t += 2) {
            const bool last = (t == nt - 2);
            if constexpr (Epi::MIDK) { if (t == t_mid) E.midk(acc, cur, wr, fr); }
            const char* a1 = cA + (size_t)(t + 1) * kstep;
            const char* a2 = last ? nA : cA + (size_t)(t + 2) * kstep; const char* b2 = last ? nB : cB + (size_t)(t + 2) * kstep;
            const char* a3 = a2 + kstep; const char* b3 = b2 + kstep;
            if (last && has_next) S.a_ready(nxt);
            if constexpr (SP2) {
            PG8_LDB(B0, 0, 0); PG8_LDB(B1, 0, 1); PG8_SCHED; PG8_LDA(At, 0, 0); PG8_STAGE(PG8_SA(1, 1), a1 + hstep, voffA);
            PG8_WAIT_V(8); PG8_WAIT_L(0); PG8_BAR; PG8_MMA(0, 0, At, B0); PG8_MMA(0, 1, At, B1); PG8_BAR; PG8_SCHED;
            PG8_LDA(At, 0, 1); PG8_STAGE(PG8_SB(0, 0), b2, voffB); PG8_STAGE(PG8_SB(0, 1), b2 + hstep, voffB); PG8_STAGE(PG8_SA(0, 0), a2, voffA);
            PG8_WAIT_V(8); PG8_WAIT_L(0); PG8_BAR; PG8_MMA(1, 0, At, B0); PG8_MMA(1, 1, At, B1); PG8_BAR; PG8_SCHED;
            PG8_LDB(B0, 1, 0); PG8_LDB(B1, 1, 1); PG8_SCHED; PG8_LDA(At, 1, 0); PG8_STAGE(PG8_SA(0, 1), a2 + hstep, voffA);
            PG8_WAIT_V(8); PG8_WAIT_L(0); PG8_BAR; PG8_MMA(0, 0, At, B0); PG8_MMA(0, 1, At, B1); PG8_BAR; PG8_SCHED;
            PG8_LDA(At, 1, 1); PG8_STAGE(PG8_SB(1, 0), b3, voffB); PG8_STAGE(PG8_SB(1, 1), b3 + hstep, voffB); PG8_STAGE(PG8_SA(1, 0), a3, voffA);
            PG8_WAIT_V(8); PG8_WAIT_L(0); PG8_BAR; PG8_MMA(1, 0, At, B0); PG8_MMA(1, 1, At, B1); PG8_BAR; PG8_SCHED;
            } else {
            PG8_LDB(B0, 0, 0); PG8_SCHED; PG8_LDA(At, 0, 0); PG8_STAGE(PG8_SA(1, 1), a1 + hstep, voffA);
            PG8_WAIT_L(8); PG8_BAR; PG8_WAIT_L(0); PG8_MMA(0, 0, At, B0); PG8_BAR; PG8_SCHED;
            PG8_LDB(B1, 0, 1); PG8_STAGE(PG8_SB(0, 0), b2, voffB);
            PG8_BAR; PG8_WAIT_L(0); PG8_MMA(0, 1, At, B1); PG8_BAR;
            PG8_LDA(At, 0, 1); PG8_STAGE(PG8_SA(0, 0), a2, voffA);
            PG8_BAR; PG8_WAIT_L(0); PG8_MMA(1, 0, At, B0); PG8_BAR; PG8_SCHED;
            PG8_STAGE(PG8_SB(0, 1), b2 + hstep, voffB);
            PG8_WAIT_V(6); PG8_BAR; PG8_MMA(1, 1, At, B1); PG8_BAR;
            PG8_LDB(B0, 1, 0); PG8_SCHED; PG8_LDA(At, 1, 0); PG8_STAGE(PG8_SA(0, 1), a2 + hstep, voffA);
            PG8_WAIT_L(8); PG8_BAR; PG8_WAIT_L(0); PG8_MMA(0, 0, At, B0); PG8_BAR; PG8_SCHED;
            PG8_LDB(B1, 1, 1); PG8_STAGE(PG8_SB(1, 0), b3, voffB);
            PG8_BAR; PG8_WAIT_L(0); PG8_MMA(0, 1, At, B1); PG8_BAR;
            PG8_LDA(At, 1, 1); PG8_STAGE(PG8_SA(1, 0), a3, voffA);
            PG8_BAR; PG8_WAIT_L(0); PG8_MMA(1, 0, At, B0); PG8_BAR; PG8_SCHED;
            PG8_STAGE(PG8_SB(1, 1), b3 + hstep, voffB);
            PG8_WAIT_V(6); PG8_BAR; PG8_MMA(1, 1, At, B1); PG8_BAR;
            }
        }
        if constexpr (ALIGN_EPI) { if (wr == 0) PG8_BAR; }
        if constexpr (!Epi::AFTER_DRAIN) { E(acc, cur, wr, wc, fr, fq); S.done(cur); }
        if (!has_next) break;
#pragma unroll
        for (int a = 0; a < 2; ++a)
#pragma unroll
            for (int b = 0; b < 2; ++b)
#pragma unroll
                for (int m = 0; m < 4; ++m)
#pragma unroll
                    for (int n = 0; n < 2; ++n) acc[a][b][m][n] = (f32x4){0.f, 0.f, 0.f, 0.f};
        cur = nxt; cA = nA; cB = nB; ++ui;
        if constexpr (ALIGN_EPI) { if (wr == 1) PG8_BAR; }
    }
    PG8_WAIT_V(0);
    if constexpr (!ALIGN_EPI) { if (wr == 0) PG8_BAR; }
    PG8_BAR;
    if constexpr (Epi::AFTER_DRAIN) { E.fused(acc, cur, wr, wc, fr, fq, lds, wid, lane); S.done(cur); }
#undef PG8_SA
#undef PG8_SB
#undef PG8_STAGE
#undef PG8_LDA
#undef PG8_LDB
#undef PG8_MMA
#undef PG8_WAIT_V
#undef PG8_WAIT_L
#undef PG8_BAR
#undef PG8_SCHED
}
}


#ifndef MK_N_LAUNCHES
#define MK_N_LAUNCHES 1
#endif
constexpr int N_PHASES = 9;
constexpr int NWAVES = 8;

constexpr int DM = 2048, BATCH = 4, SEQ = 4096, NTOK = BATCH * SEQ, NMETA = 16;
constexpr int MPAD = 16640, NTILE_X = MPAD / 256;
constexpr int N_QK = 3328, NT_QK = N_QK / 256;
constexpr int N_V = 1280, NT_V = N_V / 256;
constexpr int NT_W = NT_QK + NT_V;
constexpr int P1_UNITS_A = NTILE_X * NT_QK, P1_UNITS = P1_UNITS_A + NT_V * NTILE_X;
constexpr int NEXP = 64, DEXP = 512, MAXTILES = 192, SPAD = MAXTILES * 256;
constexpr float RMS_EPS = 1e-6f;
constexpr float LOG2E = 1.4426950408889634f;
constexpr float C2 = 0.125f * LOG2E;
constexpr float SB_EXIT = -150.0f;

constexpr size_t MiB = 1u << 20;
constexpr size_t WS_CTL = 0, CTL_ZERO_BYTES = 128 * 1024;
constexpr size_t WS_BIG = 1 * MiB;
constexpr size_t WS_QS = 84 * MiB, WS_KS = WS_QS + (size_t)MPAD * 1024 * 2, WS_QW = WS_KS + (size_t)MPAD * 1024 * 2, WS_KW = WS_QW + (size_t)MPAD * 1024 * 2;
constexpr size_t WS_VT = 190 * MiB;
constexpr size_t WS_MIXED = 231 * MiB, WS_HB = 295 * MiB;
constexpr size_t WS_Y = 1 * MiB;
constexpr size_t WS_PROJ = 359 * MiB;
constexpr size_t WS_HDN = 423 * MiB;
constexpr size_t WS_WOUT = 471 * MiB, WS_WR = 479 * MiB;
constexpr size_t WS_WGU = 480 * MiB, WS_WD = 736 * MiB;
constexpr size_t WS_LIST = 864 * MiB, WS_GATEW = 868 * MiB, WS_TOKINFO = 872 * MiB, WS_RSTD = 873 * MiB, WS_RSTDW = 874 * MiB;
constexpr size_t WS_RINV = 877 * MiB;
constexpr size_t WS_SSQ = 878 * MiB;
constexpr size_t WS_END = 880 * MiB;
static_assert(WS_RSTDW + (size_t)NEXP * NTOK * 4 <= WS_END, "ws map 4");
static_assert(WS_KW + (size_t)MPAD * 256 * 2 <= WS_VT && WS_VT + (size_t)N_V * MPAD * 2 <= WS_MIXED , "ws map 1");
static_assert(WS_Y + (size_t)SPAD * 2048 * 2 <= WS_MIXED && WS_HDN + (size_t)SPAD * 512 * 2 <= WS_WOUT && WS_HB + (size_t)NTOK * 2048 * 2 <= WS_HDN, "ws map 2");
static_assert(WS_BIG + (size_t)(NTILE_X + NT_W) * 256 * 2048 * 2 <= WS_QS, "ws map 3");
constexpr int CW_TMO = 0, CW_BAR = 4096, CW_CNT = 16384;

constexpr int RING_OFF = 0, RING_BYTES = 131072;
constexpr int MISC_OFF = RING_BYTES;
constexpr int TBL_OFF = MISC_OFF + 256;
constexpr int TBL_TSTART = 0, TBL_NT = 65, TBL_TE = 66, TBL_CNTS = 66 + MAXTILES, TBL_WORDS = 66 + MAXTILES + 64;
constexpr int TOKBUF_OFF = MISC_OFF + 4096;
constexpr int ATT_TBR_OFF = TOKBUF_OFF + 6144, ATT_SSX_OFF = ATT_TBR_OFF + 16 * 192 * 4, ATT_RSX_OFF = ATT_SSX_OFF + 2048;
constexpr int LDS_BYTES = 163840;
static_assert(TBL_OFF + TBL_WORDS * 4 <= TOKBUF_OFF && TOKBUF_OFF + 6144 <= LDS_BYTES && ATT_RSX_OFF + 256 <= LDS_BYTES, "LDS map");

#define LAS __attribute__((address_space(3)))
typedef unsigned short bf16;
typedef unsigned v4u __attribute__((ext_vector_type(4)));
typedef unsigned v2u __attribute__((ext_vector_type(2)));
typedef float f32x4 __attribute__((ext_vector_type(4)));
typedef float f32x16 __attribute__((ext_vector_type(16)));
typedef short bf16x8 __attribute__((ext_vector_type(8)));
typedef _Float16 f16x8 __attribute__((ext_vector_type(8)));
typedef _Float16 f16x2 __attribute__((ext_vector_type(2)));
typedef float f32x2 __attribute__((ext_vector_type(2)));
typedef __bf16 bf16x2_t __attribute__((ext_vector_type(2)));
#define LDS_WAIT() asm volatile("s_waitcnt lgkmcnt(0)" ::: "memory")
#define VM_WAIT() asm volatile("s_waitcnt vmcnt(0)" ::: "memory")
__device__ __forceinline__ unsigned pk2(float lo, float hi) { f32x2 v = {lo, hi}; bf16x2_t b = __builtin_convertvector(v, bf16x2_t); return __builtin_bit_cast(unsigned, b); }
__device__ __forceinline__ float bf_lo(unsigned u) { return __uint_as_float(u << 16); }
__device__ __forceinline__ float bf_hi(unsigned u) { return __uint_as_float(u & 0xffff0000u); }
__device__ __forceinline__ float wave_sum(float v) {
#pragma unroll
    for (int o = 1; o < 64; o <<= 1) v += __shfl_xor(v, o);
    return v;
}
__device__ __forceinline__ int crow(int reg, int h) { return (reg & 3) + 8 * (reg >> 2) + 4 * h; }

#define XB_TMO      128
#define XB_XCNT(j)  (256  + 64 * (j))
#define XB_XSUB(j)  (1280 + 64 * (j))
#define XB_XGEN(j)  (2304 + 64 * (j))
#define XB_TOP      3328
#define XB_TOPGEN   3392
#define XCD_BAR_WORDS 3456
#define XB_SPIN_CAP (1u << 18)

__device__ __forceinline__ unsigned xb_ld(unsigned* p)              { return __hip_atomic_load(p, __ATOMIC_RELAXED, __HIP_MEMORY_SCOPE_AGENT); }
__device__ __forceinline__ unsigned xb_add(unsigned* p, unsigned v) { return __hip_atomic_fetch_add(p, v, __ATOMIC_RELAXED, __HIP_MEMORY_SCOPE_AGENT); }
__device__ __forceinline__ unsigned xb_xcc_id() { return (unsigned)__builtin_amdgcn_s_getreg((3 << 11) | 20) & 0xFu; }
#define XB_SPIN(cond, bar) do { unsigned _sp = 0; while (cond) { __builtin_amdgcn_s_sleep(1); \
    if ((++_sp & 255u) == 0u) { if (xb_ld(&(bar)[XB_TMO])) break; if (_sp > XB_SPIN_CAP) { atomicAdd(&(bar)[XB_TMO], 1u); break; } } } } while (0)

struct XcdBarrier {
    unsigned* bar; unsigned x;
    volatile LAS unsigned* st;
};

__device__ __forceinline__ XcdBarrier xcd_barrier_post(unsigned* bar, volatile LAS unsigned* st) {
    XcdBarrier b; b.bar = bar; b.x = xb_xcc_id(); b.st = st;
    if (threadIdx.x == 0) (void)xb_add(&bar[XB_XCNT(b.x)], 1u);
    return b;
}
__device__ __forceinline__ void xcd_barrier_complete(unsigned* bar, unsigned x, unsigned& nloc, unsigned& nx) {
    const unsigned G = gridDim.x * gridDim.y * gridDim.z;
    unsigned sum, cnt, mine, sp = 0u;
    for (;;) {
        sum = 0u; cnt = 0u; mine = 0u;
#pragma unroll
        for (unsigned j = 0; j < 16; ++j) { const unsigned c = xb_ld(&bar[XB_XCNT(j)]); sum += c; cnt += (c > 0u) ? 1u : 0u; mine = (j == x) ? c : mine; }
        if (sum == G) break;
        __builtin_amdgcn_s_sleep(1);
        if ((++sp & 255u) == 0u) { if (xb_ld(&bar[XB_TMO])) break; if (sp > XB_SPIN_CAP) { atomicAdd(&bar[XB_TMO], 1u); break; } }
    }
    nloc = mine > 0u ? mine : 1u; nx = cnt > 0u ? cnt : 1u;
}

__device__ __forceinline__ void xcd_barrier(const XcdBarrier& b) {
    asm volatile("s_waitcnt vmcnt(0)" ::: "memory");
    __syncthreads();
    if (threadIdx.x == 0) {
        unsigned* bar = b.bar;
        __builtin_amdgcn_s_waitcnt(0);
        unsigned nloc = b.st[0], nx = b.st[1];
        if (nloc == 0u) { xcd_barrier_complete(bar, b.x, nloc, nx); b.st[0] = nloc; b.st[1] = nx; }
        const unsigned old = xb_add(&bar[XB_XSUB(b.x)], 1u);
        const unsigned gen = old / nloc;
        if (old + 1u == (gen + 1u) * nloc) {
            __builtin_amdgcn_fence(__ATOMIC_RELEASE, "agent");
            asm volatile("s_waitcnt vmcnt(0)" ::: "memory");
            const unsigned og = xb_add(&bar[XB_TOP], 1u);
            const unsigned tg = og / nx;
            if (og + 1u == (tg + 1u) * nx) xb_add(&bar[XB_TOPGEN], 1u);
            else XB_SPIN(xb_ld(&bar[XB_TOPGEN]) == tg, bar);
            __builtin_amdgcn_fence(__ATOMIC_ACQUIRE, "agent");
            xb_add(&bar[XB_XGEN(b.x)], 1u);
            asm volatile("s_waitcnt vmcnt(0)" ::: "memory");
        } else {
            XB_SPIN(xb_ld(&bar[XB_XGEN(b.x)]) == gen, bar);
            __builtin_amdgcn_fence(__ATOMIC_ACQUIRE, "agent");
            asm volatile("s_waitcnt vmcnt(0)" ::: "memory");
        }
    }
    __syncthreads();
}


struct Args { const float* in[19]; float* out; unsigned char* ws; int ph_lo, ph_hi, li, pad; };
struct Frame {
    LAS unsigned char* lds; unsigned* ctl; unsigned char* ws;
    int tid, lane, wave, vcu, G;
    const float* const* in; float* out;
};

struct TrItem { f32x4 v[16]; f32x4 g[4]; };
__device__ __forceinline__ void tr_load(TrItem& t, const float* srcp, int ldsrc, const float* gp) {
#pragma unroll
    for (int i = 0; i < 16; ++i) t.v[i] = __builtin_nontemporal_load((const f32x4*)(srcp + (size_t)i * ldsrc));
    if (gp) {
#pragma unroll
        for (int i = 0; i < 4; ++i) t.g[i] = *(const f32x4*)(gp + 4 * i);
    } else {
#pragma unroll
        for (int i = 0; i < 4; ++i) t.g[i] = (f32x4){1.f, 1.f, 1.f, 1.f};
    }
}
__device__ __forceinline__ void tr_store(const TrItem& t, bf16* dstp, int ldd) {
#pragma unroll
    for (int j = 0; j < 4; ++j)
#pragma unroll
        for (int c = 0; c < 2; ++c) {
            v4u o;
            o.x = pk2(t.v[8 * c + 0][j] * t.g[2 * c][0], t.v[8 * c + 1][j] * t.g[2 * c][1]); o.y = pk2(t.v[8 * c + 2][j] * t.g[2 * c][2], t.v[8 * c + 3][j] * t.g[2 * c][3]);
            o.z = pk2(t.v[8 * c + 4][j] * t.g[2 * c + 1][0], t.v[8 * c + 5][j] * t.g[2 * c + 1][1]); o.w = pk2(t.v[8 * c + 6][j] * t.g[2 * c + 1][2], t.v[8 * c + 7][j] * t.g[2 * c + 1][3]);
            *(v4u*)(dstp + (size_t)j * ldd + 8 * c) = o;
        }
}
__device__ __forceinline__ int win_src_col(int P) {
    if (P < 2048) return P;
    if (P < 3328) { const int p = P - 2048, t = p >> 8, pp = p & 255, bj = pp >> 7, wc = (pp & 127) >> 5, i = pp & 31; return (t < 4 ? 3072 + t * 256 : 4096) + 64 * wc + 32 * bj + i; }
    if (P < 4352) return 2048 + (P - 3328);
    return P;
}
__device__ __forceinline__ float rms_row_to_bf16(const float* xrow, bf16* orow, int lane) {
    const f32x4* xr = (const f32x4*)xrow + lane;
    f32x4 v[8]; float s = 0.f;
#pragma unroll
    for (int j = 0; j < 8; ++j) { v[j] = xr[64 * j]; s += (v[j].x * v[j].x + v[j].y * v[j].y) + (v[j].z * v[j].z + v[j].w * v[j].w); }
    const float rinv = sqrtf(wave_sum(s) * (1.f / DM) + RMS_EPS), rstd = 1.0f / rinv;
    v2u* o8 = (v2u*)orow + lane;
#pragma unroll
    for (int j = 0; j < 8; ++j) { v2u w; w.x = pk2(v[j].x * rstd, v[j].y * rstd); w.y = pk2(v[j].z * rstd, v[j].w * rstd); o8[64 * j] = w; }
    return rinv;
}
constexpr int I_IN = 32 * 72, I_OUT = 32 * 32, I_GU = NEXP * 32 * 16, I_D = NEXP * 8 * 32;
constexpr int NITEMS = I_IN + I_OUT + I_GU + I_D;
constexpr int TAIL1_PER_WAVE = 8, TAIL6_PER_WAVE = 9, TAIL6_ITEMS = 9216;
#ifndef P2_ITEMS_DEF
#define P2_ITEMS_DEF 32896
#endif
constexpr int P2_ITEMS = P2_ITEMS_DEF;
#ifndef ATT_WAVES_DEF
#define ATT_WAVES_DEF 4
#endif
constexpr int ATT_WAVES = ATT_WAVES_DEF;
__device__ __forceinline__ void conv_range(Frame& F, int it0, int step, int end) {
    bf16* WIN = (bf16*)(F.ws + WS_BIG) + (size_t)MPAD * DM;
    const float* ln_mix = F.in[3]; const float* w_in = F.in[4];
    const float* on_sb = F.in[8]; const float* on_sw = F.in[9]; const float* w_out = F.in[10]; const float* ln_ffn = F.in[11];
    const float* w_gate = F.in[16]; const float* w_up = F.in[17]; const float* w_down = F.in[18];
    bf16* WOUT = (bf16*)(F.ws + WS_WOUT); bf16* WGU = (bf16*)(F.ws + WS_WGU); bf16* WD = (bf16*)(F.ws + WS_WD);
    const int kr = F.lane >> 4, nq = F.lane & 15;
#define P0_ITEM(it, SRCP, LDS_, GP, DSTP, LDD) do { int r_ = (it); \
        if (r_ < I_IN) { const int kb = r_ / 72, nb = r_ % 72, k0 = 64 * kb + 16 * kr; SRCP = w_in + (size_t)k0 * 4608 + win_src_col(64 * nb + 4 * nq); LDS_ = 4608; GP = ln_mix + k0; DSTP = WIN + (size_t)(64 * nb + 4 * nq) * DM + k0; LDD = DM; } \
        else if ((r_ -= I_IN) < I_OUT) { const int kb = r_ >> 5, nb = r_ & 31, k0 = 64 * kb + 16 * kr; SRCP = w_out + (size_t)k0 * DM + 64 * nb + 4 * nq; LDS_ = DM; GP = (k0 < 1024 ? on_sb + k0 : on_sw + (k0 - 1024)); DSTP = WOUT + (size_t)(64 * nb + 4 * nq) * DM + k0; LDD = DM; } \
        else if ((r_ -= I_OUT) < I_GU) { const int e = r_ >> 9, q = r_ & 511, kb = q >> 4, nb = q & 15, k0 = 64 * kb + 16 * kr, nt = nb >> 2, bj = (nb >> 1) & 1, j0 = (nb & 1) * 64; \
            SRCP = (bj ? w_up : w_gate) + (size_t)e * DM * DEXP + (size_t)k0 * DEXP + nt * 128 + j0 + 4 * nq; LDS_ = DEXP; GP = ln_ffn + k0; DSTP = WGU + ((size_t)e * 1024 + 64 * nb + 4 * nq) * DM + k0; LDD = DM; } \
        else { r_ -= I_GU; const int e = r_ >> 8, q = r_ & 255, kb = q >> 5, nb = q & 31, k0 = 64 * kb + 16 * kr; \
            SRCP = w_down + (size_t)e * DEXP * DM + (size_t)k0 * DM + 64 * nb + 4 * nq; LDS_ = DM; GP = nullptr; DSTP = WD + ((size_t)e * 2048 + 64 * nb + 4 * nq) * DEXP + k0; LDD = DEXP; } } while (0)
    {
        TrItem cur; const float* sp; const float* gp; bf16* dp; int lds_, ldd; bf16* dpn; int lddn;
        int it = it0;
        if (it < end) { P0_ITEM(it, sp, lds_, gp, dp, ldd); tr_load(cur, sp, lds_, gp); }
        while (it < end) {
            const int itn = it + step; TrItem nxt;
            if (itn < end) { P0_ITEM(itn, sp, lds_, gp, dpn, lddn); tr_load(nxt, sp, lds_, gp); }
            tr_store(cur, dp, ldd);
            if (itn < end) { cur = nxt; dp = dpn; ldd = lddn; }
            it = itn;
        }
    }
#undef P0_ITEM
}
__device__ __forceinline__ void conv_range3(Frame& F, int it0, int step, int end) {
    bf16* WIN = (bf16*)(F.ws + WS_BIG) + (size_t)MPAD * DM;
    const float* ln_mix = F.in[3]; const float* w_in = F.in[4];
    const float* on_sb = F.in[8]; const float* on_sw = F.in[9]; const float* w_out = F.in[10]; const float* ln_ffn = F.in[11];
    const float* w_gate = F.in[16]; const float* w_up = F.in[17]; const float* w_down = F.in[18];
    bf16* WOUT = (bf16*)(F.ws + WS_WOUT); bf16* WGU = (bf16*)(F.ws + WS_WGU); bf16* WD = (bf16*)(F.ws + WS_WD);
    const int kr = F.lane >> 4, nq = F.lane & 15;
#define P0_ITEM(it, SRCP, LDS_, GP, DSTP, LDD) do { int r_ = (it); \
        if (r_ < I_IN) { const int kb = r_ / 72, nb = r_ % 72, k0 = 64 * kb + 16 * kr; SRCP = w_in + (size_t)k0 * 4608 + win_src_col(64 * nb + 4 * nq); LDS_ = 4608; GP = ln_mix + k0; DSTP = WIN + (size_t)(64 * nb + 4 * nq) * DM + k0; LDD = DM; } \
        else if ((r_ -= I_IN) < I_OUT) { const int kb = r_ >> 5, nb = r_ & 31, k0 = 64 * kb + 16 * kr; SRCP = w_out + (size_t)k0 * DM + 64 * nb + 4 * nq; LDS_ = DM; GP = (k0 < 1024 ? on_sb + k0 : on_sw + (k0 - 1024)); DSTP = WOUT + (size_t)(64 * nb + 4 * nq) * DM + k0; LDD = DM; } \
        else if ((r_ -= I_OUT) < I_GU) { const int e = r_ >> 9, q = r_ & 511, kb = q >> 4, nb = q & 15, k0 = 64 * kb + 16 * kr, nt = nb >> 2, bj = (nb >> 1) & 1, j0 = (nb & 1) * 64; \
            SRCP = (bj ? w_up : w_gate) + (size_t)e * DM * DEXP + (size_t)k0 * DEXP + nt * 128 + j0 + 4 * nq; LDS_ = DEXP; GP = ln_ffn + k0; DSTP = WGU + ((size_t)e * 1024 + 64 * nb + 4 * nq) * DM + k0; LDD = DM; } \
        else { r_ -= I_GU; const int e = r_ >> 8, q = r_ & 255, kb = q >> 5, nb = q & 31, k0 = 64 * kb + 16 * kr; \
            SRCP = w_down + (size_t)e * DEXP * DM + (size_t)k0 * DM + 64 * nb + 4 * nq; LDS_ = DM; GP = nullptr; DSTP = WD + ((size_t)e * 2048 + 64 * nb + 4 * nq) * DEXP + k0; LDD = DEXP; } } while (0)
    struct V16 { f32x4 v[16]; };
#define C3_LOAD(B, it) do { if ((it) < end) { const float* sp_; const float* gp_; bf16* dp_; int ls_, ld_; P0_ITEM((it), sp_, ls_, gp_, dp_, ld_); (void)gp_; (void)dp_; (void)ld_; \
        _Pragma("unroll") for (int i_ = 0; i_ < 16; ++i_) B.v[i_] = __builtin_nontemporal_load((const f32x4*)(sp_ + (size_t)i_ * ls_)); } } while (0)
#define C3_STORE(B, it) do { if ((it) < end) { const float* sp_; const float* gp_; bf16* dp_; int ls_, ld_; P0_ITEM((it), sp_, ls_, gp_, dp_, ld_); (void)sp_; (void)ls_; \
        f32x4 g_[4]; _Pragma("unroll") for (int i_ = 0; i_ < 4; ++i_) g_[i_] = gp_ ? *(const f32x4*)(gp_ + 4 * i_) : (f32x4){1.f, 1.f, 1.f, 1.f}; \
        _Pragma("unroll") for (int j_ = 0; j_ < 4; ++j_) _Pragma("unroll") for (int c_ = 0; c_ < 2; ++c_) { v4u o_; \
            o_.x = pk2(B.v[8 * c_ + 0][j_] * g_[2 * c_][0], B.v[8 * c_ + 1][j_] * g_[2 * c_][1]); o_.y = pk2(B.v[8 * c_ + 2][j_] * g_[2 * c_][2], B.v[8 * c_ + 3][j_] * g_[2 * c_][3]); \
            o_.z = pk2(B.v[8 * c_ + 4][j_] * g_[2 * c_ + 1][0], B.v[8 * c_ + 5][j_] * g_[2 * c_ + 1][1]); o_.w = pk2(B.v[8 * c_ + 6][j_] * g_[2 * c_ + 1][2], B.v[8 * c_ + 7][j_] * g_[2 * c_ + 1][3]); \
            *(v4u*)(dp_ + (size_t)j_ * ld_ + 8 * c_) = o_; } } } while (0)
    {
        V16 A, B, C; int it = it0;
        C3_LOAD(A, it); C3_LOAD(B, it + step);
        while (it < end) {
            C3_LOAD(C, it + 2 * step); C3_STORE(A, it);
            C3_LOAD(A, it + 3 * step); C3_STORE(B, it + step);
            C3_LOAD(B, it + 4 * step); C3_STORE(C, it + 2 * step);
            it += 3 * step;
        }
    }
#undef C3_LOAD
#undef C3_STORE
#undef P0_ITEM
}
__device__ __forceinline__ int tail1_items(int G) { const int rounds = (P1_UNITS + G - 1) / G, nidle = rounds * G - P1_UNITS; return nidle * NWAVES * TAIL1_PER_WAVE; }
__device__ __forceinline__ void p0_prologue(Frame& F) {
    const int gw = F.vcu * NWAVES + F.wave, NGW = F.G * NWAVES;
    if (blockIdx.x == 0 && F.tid < NEXP) __hip_atomic_store(F.ctl + CW_CNT + 16 * F.tid, 0u, __ATOMIC_RELAXED, __HIP_MEMORY_SCOPE_AGENT);
    bf16* BIG = (bf16*)(F.ws + WS_BIG);
    bf16* WIN = BIG + (size_t)MPAD * DM;
    const float* x = F.in[0]; const float* meta = F.in[1]; const float* ln_mix = F.in[3]; const float* w_in = F.in[4];
    const float* on_sb = F.in[8]; const float* on_sw = F.in[9]; const float* w_out = F.in[10]; const float* ln_ffn = F.in[11];
    const float* w_rg = F.in[12]; const float* w_re = F.in[14]; const float* w_gate = F.in[16]; const float* w_up = F.in[17]; const float* w_down = F.in[18];
    for (int m = gw; m < MPAD; m += NGW) {
        bf16* orow = BIG + (size_t)m * DM;
        if (m < NTOK) { const float ri = rms_row_to_bf16(x + (size_t)m * DM, orow, F.lane); if (F.lane == 0) ((float*)(F.ws + WS_RINV))[m] = ri; }
        else if (m < NTOK + NMETA) (void)rms_row_to_bf16(meta + (size_t)(m - NTOK) * DM, orow, F.lane);
        else { v4u z = {0u, 0u, 0u, 0u}; v4u* o = (v4u*)orow + F.lane;
#pragma unroll
            for (int j = 0; j < 4; ++j) o[64 * j] = z; }
    }
    conv_range(F, gw, NGW, NITEMS - TAIL6_ITEMS - tail1_items(F.G) - P2_ITEMS);
    bf16* WRH = (bf16*)(F.ws + WS_WR); bf16* WRL = WRH + 96 * DM;
    for (int idx = (F.vcu * NWAVES * 64 + F.tid); idx < 96 * DM; idx += F.G * NWAVES * 64) {
        const int c = idx / DM, k = idx % DM;
        float v = 0.f; if (c < 8) v = w_rg[k * 8 + c]; else if (c < 72) v = w_re[k * 64 + (c - 8)];
        v *= ln_ffn[k];
        const unsigned hi = pk2(v, 0.f) & 0xffffu; const float lo = v - __uint_as_float(hi << 16);
        const int fidx = ((((k >> 4) * 3 + (c >> 5)) * 64 + (((k >> 3) & 1) * 32 + (c & 31))) << 3) + (k & 7);
        WRH[fidx] = (bf16)hi; WRL[fidx] = (bf16)(pk2(lo, 0.f) & 0xffffu);
    }
}

struct P1Order {
    int G, c;
    __device__ bool next(int i, pg8::Unit& u) const {
        const int L = i * G + c; if (L >= P1_UNITS) return false;
        if (L < P1_UNITS_A) { u.pm = L / NT_QK; u.pn = NTILE_X + (L % NT_QK); }
        else { const int l = L - P1_UNITS_A; u.pm = NTILE_X + NT_QK + l / NTILE_X; u.pn = l % NTILE_X; }
        return true;
    }
    __device__ __forceinline__ void a_ready(const pg8::Unit&) const {}
    __device__ __forceinline__ void done(const pg8::Unit&) const {}
};
struct EpiQKV {
    static constexpr bool PERM = true, AFTER_DRAIN = false, MIDK = false;
    bf16 *QS, *KS, *QW, *KW, *VT; const float *q_norm, *k_norm;
    __device__ __forceinline__ void operator()(const pg8::f32x4 (&acc)[2][2][4][2], const pg8::Unit& u, int wr, int wc, int fr, int fq) const {
        using pg8::HALF;
        if (u.pm < NTILE_X) {
            const int t = u.pn - NTILE_X; const int row0 = u.pm * 256 + wr * 64 + fr;
            if (t < 8) {
                bf16* base = (t < 4) ? QS : KS; const float sc = (t < 4) ? C2 : 1.0f; const int col0 = (t & 3) * 256 + wc * 32 + 8 * fq;
#pragma unroll
                for (int ai = 0; ai < 2; ++ai)
#pragma unroll
                    for (int m = 0; m < 4; ++m) { bf16* rowp = base + (size_t)(row0 + ai * HALF + m * 16) * 1024 + col0;
#pragma unroll
                        for (int bj = 0; bj < 2; ++bj) { const pg8::f32x4 v0 = acc[ai][bj][m][0] * sc, v1 = acc[ai][bj][m][1] * sc;
                            v4u w; w.x = pk2(v0[0], v0[1]); w.y = pk2(v0[2], v0[3]); w.z = pk2(v1[0], v1[1]); w.w = pk2(v1[2], v1[3]); *(v4u*)(rowp + bj * HALF) = w; } }
            } else {
                const bool isq = t < 12; const float* gain = isq ? q_norm : k_norm; const float sc = isq ? C2 : 1.0f;
                bf16* base = isq ? (QW + (t - 8) * 256 + wc * 64) : (KW + wc * 64); const int ld = isq ? 1024 : 256;
                pg8::f32x4 g[2][2];
#pragma unroll
                for (int bj = 0; bj < 2; ++bj)
#pragma unroll
                    for (int n = 0; n < 2; ++n) g[bj][n] = *(const pg8::f32x4*)(gain + 32 * bj + 8 * fq + 4 * n) * sc;
#pragma unroll
                for (int ai = 0; ai < 2; ++ai)
#pragma unroll
                    for (int m = 0; m < 4; ++m) {
                        float ss = 0.f;
#pragma unroll
                        for (int bj = 0; bj < 2; ++bj)
#pragma unroll
                            for (int n = 0; n < 2; ++n) { const pg8::f32x4 v = acc[ai][bj][m][n]; ss += (v[0] * v[0] + v[1] * v[1]) + (v[2] * v[2] + v[3] * v[3]); }
                        ss += __shfl_xor(ss, 16); ss += __shfl_xor(ss, 32);
                        const float rstd = 1.0f / sqrtf(ss * (1.0f / 64.0f) + RMS_EPS);
                        bf16* rowp = base + (size_t)(row0 + ai * HALF + m * 16) * ld + 8 * fq;
#pragma unroll
                        for (int bj = 0; bj < 2; ++bj) { const pg8::f32x4 v0 = acc[ai][bj][m][0] * rstd * g[bj][0], v1 = acc[ai][bj][m][1] * rstd * g[bj][1];
                            v4u w; w.x = pk2(v0[0], v0[1]); w.y = pk2(v0[2], v0[3]); w.z = pk2(v1[0], v1[1]); w.w = pk2(v1[2], v1[3]); *(v4u*)(rowp + 32 * bj) = w; } }
            }
        } else {
            const int vrow0 = (u.pm - NTILE_X - NT_QK) * 256 + wr * 64 + fr;
#pragma unroll
            for (int ai = 0; ai < 2; ++ai)
#pragma unroll
                for (int m = 0; m < 4; ++m) { bf16* rowp = VT + (size_t)(vrow0 + ai * HALF + m * 16) * MPAD + u.pn * 256 + wc * 32 + 16 * (fq >> 1) + 4 * (fq & 1);
#pragma unroll
                    for (int bj = 0; bj < 2; ++bj)
#pragma unroll
                        for (int n = 0; n < 2; ++n) { const pg8::f32x4 v = acc[ai][bj][m][n]; v2u w; w.x = pk2(v[0], v[1]); w.y = pk2(v[2], v[3]); *(v2u*)(rowp + bj * HALF + 8 * n) = w; } }
        }
    }
};

namespace att {
__device__ __forceinline__ f32x16 mfma_bf(bf16x8 a, bf16x8 b, f32x16 c) { return __builtin_amdgcn_mfma_f32_32x32x16_bf16(a, b, c, 0, 0, 0); }
__device__ __forceinline__ f32x16 mfma_h(f16x8 a, f16x8 b, f32x16 c) { return __builtin_amdgcn_mfma_f32_32x32x16_f16(a, b, c, 0, 0, 0); }
__device__ __forceinline__ bf16x8 ld8(const bf16* p) { return *(const bf16x8*)p; }
__device__ __forceinline__ bf16x8 pack8(const float* w) { v4u o; o.x = pk2(w[0], w[1]); o.y = pk2(w[2], w[3]); o.z = pk2(w[4], w[5]); o.w = pk2(w[6], w[7]); return __builtin_bit_cast(bf16x8, o); }

struct KT { bf16x8 k[4]; bf16x8 v[4]; };
__device__ __forceinline__ void glds16(const void* gsrc, unsigned lds_dst) { unsigned keep;
    asm volatile("s_mov_b32 %0, m0\n\ts_mov_b32 m0, %2\n\ts_nop 0\n\tglobal_load_lds_dwordx4 %1, off\n\ts_mov_b32 m0, %0" : "=&s"(keep) : "v"(gsrc), "s"(lds_dst) : "memory"); }
__device__ __forceinline__ void dma_tile(unsigned slot, const bf16* Kb, int ldk, const bf16* Vt, int b, int j, int lane) {
#pragma unroll
    for (int i = 0; i < 4; ++i) { const int row = 8 * i + (lane >> 3), ch = (lane & 7) ^ (row & 7);
        const int krow = (j >= 0) ? (b * SEQ + 32 * j + row) : (NTOK + (row & 15));
        glds16(Kb + (size_t)krow * ldk + ch * 8, (unsigned)__builtin_amdgcn_readfirstlane(slot + i * 1024)); }
    const int col0 = (j >= 0) ? (b * SEQ + 32 * j) : NTOK;
#pragma unroll
    for (int i = 0; i < 4; ++i) { const int row = 16 * i + (lane >> 2), c = (lane & 3) ^ ((row >> 2) & 3); const int cc = (j >= 0) ? c : (c & 1);
        glds16(Vt + (size_t)row * MPAD + col0 + cc * 8, (unsigned)__builtin_amdgcn_readfirstlane(slot + 4096 + i * 1024)); }
}
__device__ __forceinline__ void lds_frags(KT& t, const LAS unsigned char* slot, int r, int h) {
#pragma unroll
    for (int s = 0; s < 4; ++s) { const int c = 2 * s + h; t.k[s] = *(const LAS bf16x8*)(slot + (r >> 3) * 1024 + ((r & 7) * 8 + (c ^ (r & 7))) * 16); }
#pragma unroll
    for (int dh = 0; dh < 2; ++dh)
#pragma unroll
        for (int s = 0; s < 2; ++s) { const int row = 32 * dh + r, c = 2 * s + h; t.v[dh * 2 + s] = *(const LAS bf16x8*)(slot + 4096 + row * 64 + (c ^ ((row >> 2) & 3)) * 16); }
}
#define ATT_WAITV(n) asm volatile("s_waitcnt vmcnt(" #n ")" ::: "memory")

struct SbState { f32x16 o0, o1; float R; };
template <int KIND>
__device__ __forceinline__ void sb_tile(SbState& S, const KT& t, const bf16x8 (&qf)[4], const f16x8& U0, const f16x8& U1, int r, int h) {
    f32x16 z = {0.f, 0.f, 0.f, 0.f, 0.f, 0.f, 0.f, 0.f, 0.f, 0.f, 0.f, 0.f, 0.f, 0.f, 0.f, 0.f};
#pragma unroll
    for (int s = 0; s < 4; ++s) z = mfma_bf(t.k[s], qf[s], z);
    f32x16 init; float L[16];
#pragma unroll
    for (int g = 0; g < 16; ++g) {
        const float zz = z[g];
        const float e = __builtin_amdgcn_exp2f(-__builtin_fabsf(zz));
        const float zp = __builtin_amdgcn_fmed3f(zz, 0.f, 3.0e38f);
        const float sp = zp + __builtin_amdgcn_logf(1.0f + e);
        float Lv = -sp;
        if (KIND == 1) Lv = (crow(g, h) < r) ? Lv : 0.f;
        if (KIND == 2) Lv = (crow(g, h) < 16) ? Lv : 0.f;
        L[g] = Lv; init[g] = zz + Lv + S.R;
    }
    f16x8 lb0, lb1;
#pragma unroll
    for (int j = 0; j < 8; ++j) { lb0[j] = (_Float16)L[j]; lb1[j] = (_Float16)L[8 + j]; }
    f32x16 lw = mfma_h(U0, lb0, init); lw = mfma_h(U1, lb1, lw);
    float Rn = lw[0] - z[0];
    Rn = __shfl(Rn, r);
    float w[16];
#pragma unroll
    for (int g = 0; g < 16; ++g) {
        float wv = __builtin_amdgcn_exp2f(lw[g]);
        if (KIND == 1) wv = (crow(g, h) < r) ? wv : 0.f;
        if (KIND == 2) wv = (crow(g, h) < 16) ? wv : 0.f;
        w[g] = wv;
    }
    const bf16x8 wb0 = pack8(w), wb1 = pack8(w + 8);
    S.o0 = mfma_bf(t.v[0], wb0, S.o0); S.o0 = mfma_bf(t.v[1], wb1, S.o0);
    S.o1 = mfma_bf(t.v[2], wb0, S.o1); S.o1 = mfma_bf(t.v[3], wb1, S.o1);
    S.R = Rn;
}

struct SwState { f32x16 o0, o1; float m, l; };
template <int KIND>
__device__ __forceinline__ void sw_tile(SwState& S, const KT& t, const bf16x8 (&qf)[4], const LAS float* tb, int r, int h) {
    f32x16 z = {0.f, 0.f, 0.f, 0.f, 0.f, 0.f, 0.f, 0.f, 0.f, 0.f, 0.f, 0.f, 0.f, 0.f, 0.f, 0.f};
#pragma unroll
    for (int s = 0; s < 4; ++s) z = mfma_bf(t.k[s], qf[s], z);
    float sc[16]; float mx = -1e30f;
#pragma unroll
    for (int g = 0; g < 16; ++g) {
        float v = z[g] + tb[(g & 3) + 8 * (g >> 2)];
        if (KIND == 1) v = (crow(g, h) <= r) ? v : -1e30f;
        if (KIND == 2) v = (crow(g, h) < 16) ? v : -1e30f;
        if (KIND == 3) v = (crow(g, h) > r) ? v : -1e30f;
        sc[g] = v; mx = __builtin_fmaxf(mx, v);
    }
    mx = __builtin_fmaxf(mx, __shfl_xor(mx, 32));
    const float mn = __builtin_fmaxf(S.m, mx);
    const float alpha = __builtin_amdgcn_exp2f(S.m - mn);
    S.l *= alpha; S.o0 *= alpha; S.o1 *= alpha;
    float p[16]; float ls = 0.f;
#pragma unroll
    for (int g = 0; g < 16; ++g) { p[g] = __builtin_amdgcn_exp2f(sc[g] - mn); ls += p[g]; }
    S.l += ls; S.m = mn;
    const bf16x8 wb0 = pack8(p), wb1 = pack8(p + 8);
    S.o0 = mfma_bf(t.v[0], wb0, S.o0); S.o0 = mfma_bf(t.v[1], wb1, S.o0);
    S.o1 = mfma_bf(t.v[2], wb0, S.o1); S.o1 = mfma_bf(t.v[3], wb1, S.o1);
}
__device__ __forceinline__ float store_o(bf16* orow, const f32x16& o0, const f32x16& o1, float scale, int h) {
    float ss = 0.f;
#pragma unroll
    for (int q = 0; q < 4; ++q) {
        const float a0 = o0[4 * q] * scale, a1 = o0[4 * q + 1] * scale, a2 = o0[4 * q + 2] * scale, a3 = o0[4 * q + 3] * scale;
        const float b0 = o1[4 * q] * scale, b1 = o1[4 * q + 1] * scale, b2 = o1[4 * q + 2] * scale, b3 = o1[4 * q + 3] * scale;
        ss += ((a0 * a0 + a1 * a1) + (a2 * a2 + a3 * a3)) + ((b0 * b0 + b1 * b1) + (b2 * b2 + b3 * b3));
        v2u w; w.x = pk2(a0, a1); w.y = pk2(a2, a3); *(v2u*)(orow + 8 * q + 4 * h) = w;
        v2u x; x.x = pk2(b0, b1); x.y = pk2(b2, b3); *(v2u*)(orow + 32 + 8 * q + 4 * h) = x;
    }
    return ss;
}
}

__device__ __forceinline__ void p2_attention(Frame& F) {
    using namespace att;
    const int lane = F.lane, r = lane & 31, h = lane >> 5, w = F.wave;
    const bf16* VT = (const bf16*)(F.ws + WS_VT); bf16* MIX = (bf16*)(F.ws + WS_MIXED); float* SSQ = (float*)(F.ws + WS_SSQ);
    LAS float* tbr = (LAS float*)(F.lds + ATT_TBR_OFF);
    const LAS unsigned char* area = F.lds + RING_OFF + w * 16384;
    const unsigned slot0 = (unsigned)(uintptr_t)area;
    LAS float* ssx = (LAS float*)(F.lds + ATT_SSX_OFF);
    LAS float* rsx = (LAS float*)(F.lds + ATT_RSX_OFF);
    { const float* rel_bias = F.in[2];
      for (int idx = F.tid; idx < 16 * 192; idx += NWAVES * 64) {
        const int hq = idx / 192, x = idx % 192, d = 159 - x; float v = 0.f;
        if (d >= 0) { int bkt = d; if (d >= 16) { bkt = 16 + (int)(logf((float)d / 16.0f) / logf(8.0f) * 16.0f); bkt = bkt > 31 ? 31 : bkt; } v = rel_bias[bkt * 16 + hq] * LOG2E; }
        tbr[idx] = v;
      } }
    __syncthreads();
    if (w >= ATT_WAVES) {
        const int p2_end = NITEMS - TAIL6_ITEMS - tail1_items(F.G);
        conv_range3(F, p2_end - P2_ITEMS + F.vcu * (NWAVES - ATT_WAVES) + (w - ATT_WAVES), F.G * (NWAVES - ATT_WAVES), p2_end);
        return;
    }
    __builtin_amdgcn_s_setprio(3);
    for (int unit = F.vcu; unit < NTOK / 32; unit += F.G) {
        const int b = unit >> 7, a = unit & 127;
        const size_t qrow = (size_t)b * SEQ + 32 * a + r;
#pragma unroll 1
        for (int bi = 0; bi < 2; ++bi) {
            const int branch = bi;
            if (branch == 0) {
            const bf16* KS = (const bf16*)(F.ws + WS_KS); const bf16* QS = (const bf16*)(F.ws + WS_QS);
            f16x8 U0, U1;
#pragma unroll
            for (int j = 0; j < 8; ++j) { const int c0 = 8 * (j >> 2) + 4 * h + (j & 3); U0[j] = (c0 > r) ? (_Float16)1.0f : (_Float16)0.0f; U1[j] = (16 + c0 > r) ? (_Float16)1.0f : (_Float16)0.0f; }
            float ssl = 0.f;
#pragma unroll 1
            for (int hh = 0; hh < 16 / ATT_WAVES; ++hh) {
                const int head = (16 / ATT_WAVES) * w + hh;
                ATT_WAITV(0);
                const bf16* Kb = KS + head * 64;
                bf16x8 ql[4];
#pragma unroll
                for (int s = 0; s < 4; ++s) ql[s] = ld8(QS + qrow * 1024 + head * 64 + 16 * s + 8 * h);
                SbState S; S.R = 0.f;
#pragma unroll
                for (int g = 0; g < 16; ++g) { S.o0[g] = 0.f; S.o1[g] = 0.f; }
                const bf16* Vt = VT + (size_t)(head * 64) * MPAD;
                unsigned sl_cur = slot0, sl_nxt = slot0 + 8192;
                int jt = a;
                dma_tile(sl_cur, Kb, 1024, Vt, b, jt, lane); dma_tile(sl_nxt, Kb, 1024, Vt, b, jt - 1, lane);
                ATT_WAITV(8);
                KT T; lds_frags(T, area + (sl_cur - slot0), r, h);
                sb_tile<1>(S, T, ql, U0, U1, r, h);
                if (!__all(S.R < SB_EXIT)) {
                    --jt;
                    for (;;) {
                        { const unsigned t_ = sl_cur; sl_cur = sl_nxt; sl_nxt = t_; }
                        const bool has_next = jt >= 0;
                        if (has_next) { dma_tile(sl_nxt, Kb, 1024, Vt, b, jt - 1, lane); ATT_WAITV(8); } else ATT_WAITV(0);
                        lds_frags(T, area + (sl_cur - slot0), r, h);
                        if (jt >= 0) sb_tile<0>(S, T, ql, U0, U1, r, h); else sb_tile<2>(S, T, ql, U0, U1, r, h);
                        if (!has_next || __all(S.R < SB_EXIT)) break;
                        --jt;
                    }
                }
                ssl += store_o(MIX + qrow * DM + head * 64, S.o0, S.o1, 1.0f, h);
            }
            ssl += __shfl_xor(ssl, 32);
            if (h == 0) SSQ[qrow * 16 + w] = ssl;
        }
            else {
            const bf16* KW = (const bf16*)(F.ws + WS_KW); const bf16* QW = (const bf16*)(F.ws + WS_QW);
            float ssl = 0.f;
#pragma unroll 1
            for (int hh = 0; hh < 16 / ATT_WAVES; ++hh) {
                const int hq = (16 / ATT_WAVES) * w + hh, kvh = hq >> 2;
                ATT_WAITV(0);
                const bf16* Kb = KW + kvh * 64;
                bf16x8 ql[4];
#pragma unroll
                for (int s = 0; s < 4; ++s) ql[s] = ld8(QW + qrow * 1024 + hq * 64 + 16 * s + 8 * h);
                const float sink2 = F.in[7][hq] * LOG2E;
                SwState S; S.m = sink2; S.l = 0.f;
#pragma unroll
                for (int g = 0; g < 16; ++g) { S.o0[g] = 0.f; S.o1[g] = 0.f; }
                const LAS float* tbh = tbr + hq * 192 + 4 * h;
                const int jlo = (a >= 4) ? a - 4 : 0;
                const bf16* Vt = VT + (size_t)(1024 + kvh * 64) * MPAD;
                unsigned sl_cur = slot0, sl_nxt = slot0 + 8192;
                int jt = a;
#define SW_NEXT(j) (((j) > jlo) ? (j) - 1 : -1)
                dma_tile(sl_cur, Kb, 256, Vt, b, jt, lane); dma_tile(sl_nxt, Kb, 256, Vt, b, SW_NEXT(jt), lane);
                ATT_WAITV(8);
                KT T; lds_frags(T, area + (sl_cur - slot0), r, h);
                sw_tile<1>(S, T, ql, tbh + (159 - r), r, h);
                jt = SW_NEXT(jt);
                for (;;) {
                    { const unsigned t_ = sl_cur; sl_cur = sl_nxt; sl_nxt = t_; }
                    if (jt >= 0) { dma_tile(sl_nxt, Kb, 256, Vt, b, SW_NEXT(jt), lane); ATT_WAITV(8); } else ATT_WAITV(0);
                    lds_frags(T, area + (sl_cur - slot0), r, h);
                    if (jt < 0) { const int dq = 32 * a + r + 16; sw_tile<2>(S, T, ql, tbh + (159 - (dq < 159 ? dq : 159)), r, h); break; }
                    const LAS float* tb = tbh + (159 - (32 * (a - jt) + r));
                    if (jt == a - 4) sw_tile<3>(S, T, ql, tb, r, h); else sw_tile<0>(S, T, ql, tb, r, h);
                    jt = SW_NEXT(jt);
                }
#undef SW_NEXT
                const float lt = S.l + __shfl_xor(S.l, 32) + __builtin_amdgcn_exp2f(sink2 - S.m);
                ssl += store_o(MIX + qrow * DM + 1024 + hq * 64, S.o0, S.o1, 1.0f / lt, h);
            }
            ssl += __shfl_xor(ssl, 32);
            if (h == 0) SSQ[qrow * 16 + 8 + w] = ssl;
        }
        }
    }
    __builtin_amdgcn_s_setprio(0);
}

struct EpiRes {
    static constexpr bool PERM = true, AFTER_DRAIN = false, MIDK = true;
    bf16* P; const LAS float* RS; mutable int ui;
    __device__ __forceinline__ void midk(pg8::f32x4 (&acc)[2][2][4][2], const pg8::Unit& u, int wr, int fr) const {
#pragma unroll
        for (int ai = 0; ai < 2; ++ai)
#pragma unroll
            for (int m = 0; m < 4; ++m) { const LAS float* q = RS + (ui * 256 + ai * 128 + wr * 64 + m * 16 + fr) * 2; const float ratio = q[0] / q[1];
#pragma unroll
                for (int bj = 0; bj < 2; ++bj)
#pragma unroll
                    for (int n = 0; n < 2; ++n) acc[ai][bj][m][n] *= ratio; }
    }
    __device__ __forceinline__ void operator()(const pg8::f32x4 (&acc)[2][2][4][2], const pg8::Unit& u, int wr, int wc, int fr, int fq) const {
        const int col0 = u.pn * 256 + wc * 32 + 8 * fq;
#pragma unroll
        for (int ai = 0; ai < 2; ++ai)
#pragma unroll
            for (int m = 0; m < 4; ++m) { const int rl = ai * 128 + wr * 64 + m * 16 + fr; bf16* rowp = P + (size_t)(u.pm * 256 + rl) * DM + col0; const float rw = RS[(ui * 256 + rl) * 2 + 1];
#pragma unroll
                for (int bj = 0; bj < 2; ++bj) { const pg8::f32x4 v0 = acc[ai][bj][m][0] * rw, v1 = acc[ai][bj][m][1] * rw;
                    v4u w; w.x = pk2(v0[0], v0[1]); w.y = pk2(v0[2], v0[3]); w.z = pk2(v1[0], v1[1]); w.w = pk2(v1[2], v1[3]); *(v4u*)(rowp + bj * 128) = w; } }
        ++ui;
    }
};

__device__ __forceinline__ void p4_router(Frame& F) {
    using namespace att;
    const int lane = F.lane, r = lane & 31, h = lane >> 5, w = F.wave;
    const bf16* proj = (const bf16*)(F.ws + WS_PROJ); const bf16* xnb = (const bf16*)(F.ws + WS_BIG); const float* rinv = (const float*)(F.ws + WS_RINV); bf16* HB = (bf16*)(F.ws + WS_HB);
    const bf16* WRH = (const bf16*)(F.ws + WS_WR); const bf16* WRL = WRH + 96 * DM;
    const float* b_rg = F.in[13]; const float* b_re = F.in[15];
    unsigned* CNT = F.ctl + CW_CNT;
    int* LIST = (int*)(F.ws + WS_LIST); float* GATEW = (float*)(F.ws + WS_GATEW); int* TOKINFO = (int*)(F.ws + WS_TOKINFO); float* RSTD = (float*)(F.ws + WS_RSTD); float* RSTDW = (float*)(F.ws + WS_RSTDW);
    LAS float* part = (LAS float*)(F.lds + RING_OFF);
    LAS float* ssp = (LAS float*)(F.lds + RING_OFF + 98304);
    LAS float* lg = (LAS float*)(F.lds + RING_OFF + 98304 + 2048);
    LAS float* rsl = (LAS float*)(F.lds + RING_OFF + 98304 + 2048 + 18432);
    LAS unsigned char* sthi = F.lds + RING_OFF; LAS unsigned char* stlo = F.lds + RING_OFF + 65536;
    for (int unit = F.vcu; unit < NTOK / 64; unit += F.G) {
        f32x16 acc[2][3];
#pragma unroll
        for (int t = 0; t < 2; ++t)
#pragma unroll
            for (int nt = 0; nt < 3; ++nt)
#pragma unroll
                for (int g = 0; g < 16; ++g) acc[t][nt][g] = 0.f;
        float ss0 = 0.f, ss1 = 0.f;
#pragma unroll 1
        for (int q = 0; q < 4; ++q) {
#pragma unroll 1
            for (int hb = 0; hb < 2; ++hb) {
                f32x4 xv[8]; v2u pv[8];
#pragma unroll
                for (int i = 0; i < 8; ++i) { const int id = (hb * 8 + i) * 512 + F.tid, row = id >> 7, g = id & 127; const size_t off = ((size_t)unit * 64 + row) * DM + 512 * q + 4 * g;
                    const v2u xb = *(const v2u*)(xnb + off); const float ri = rinv[unit * 64 + row]; xv[i] = (f32x4){bf_lo(xb.x) * ri, bf_hi(xb.x) * ri, bf_lo(xb.y) * ri, bf_hi(xb.y) * ri}; pv[i] = *(const v2u*)(proj + off); }
#pragma unroll
                for (int i = 0; i < 8; ++i) { const int id = (hb * 8 + i) * 512 + F.tid, row = id >> 7, g = id & 127; const size_t off = ((size_t)unit * 64 + row) * DM + 512 * q + 4 * g;
                    const float a0 = xv[i][0] + bf_lo(pv[i].x), a1 = xv[i][1] + bf_hi(pv[i].x), a2 = xv[i][2] + bf_lo(pv[i].y), a3 = xv[i][3] + bf_hi(pv[i].y);
                    v2u hi; hi.x = pk2(a0, a1); hi.y = pk2(a2, a3);
                    v2u lo; lo.x = pk2(a0 - bf_lo(hi.x), a1 - bf_hi(hi.x)); lo.y = pk2(a2 - bf_lo(hi.y), a3 - bf_hi(hi.y));
                    *(v2u*)(HB + off) = hi;
                    const int lofs = row * 1024 + ((((g >> 1) ^ (row & 15))) << 4) + ((g & 1) << 3);
                    *(LAS v2u*)(sthi + lofs) = hi; *(LAS v2u*)(stlo + lofs) = lo; }
            }
            __syncthreads();
#pragma unroll 2
            for (int s4 = 0; s4 < 4; ++s4) {
                const int ks = w + 8 * s4, ksg = 32 * q + ks;
                const int fo0 = r * 1024 + ((((2 * ks + h) ^ (r & 15))) << 4), fo1 = fo0 + 32 * 1024;
                const v4u h0 = *(const LAS v4u*)(sthi + fo0), l0 = *(const LAS v4u*)(stlo + fo0), h1 = *(const LAS v4u*)(sthi + fo1), l1 = *(const LAS v4u*)(stlo + fo1);
#define P4_SS(SS, HV, LV) { const float e0 = bf_lo(HV.x) + bf_lo(LV.x), e1 = bf_hi(HV.x) + bf_hi(LV.x), e2 = bf_lo(HV.y) + bf_lo(LV.y), e3 = bf_hi(HV.y) + bf_hi(LV.y), \
                    e4 = bf_lo(HV.z) + bf_lo(LV.z), e5 = bf_hi(HV.z) + bf_hi(LV.z), e6 = bf_lo(HV.w) + bf_lo(LV.w), e7 = bf_hi(HV.w) + bf_hi(LV.w); \
                    SS += ((e0 * e0 + e1 * e1) + (e2 * e2 + e3 * e3)) + ((e4 * e4 + e5 * e5) + (e6 * e6 + e7 * e7)); }
                P4_SS(ss0, h0, l0) P4_SS(ss1, h1, l1)
#undef P4_SS
                const bf16x8 ahi0 = __builtin_bit_cast(bf16x8, h0), alo0 = __builtin_bit_cast(bf16x8, l0), ahi1 = __builtin_bit_cast(bf16x8, h1), alo1 = __builtin_bit_cast(bf16x8, l1);
#pragma unroll
                for (int nt = 0; nt < 3; ++nt) {
                    const int fo = (((ksg * 3 + nt) * 64 + lane) << 3);
                    const bf16x8 bh = ld8(WRH + fo), bl = ld8(WRL + fo);
                    acc[0][nt] = mfma_bf(ahi0, bh, acc[0][nt]); acc[0][nt] = mfma_bf(alo0, bh, acc[0][nt]); acc[0][nt] = mfma_bf(ahi0, bl, acc[0][nt]);
                    acc[1][nt] = mfma_bf(ahi1, bh, acc[1][nt]); acc[1][nt] = mfma_bf(alo1, bh, acc[1][nt]); acc[1][nt] = mfma_bf(ahi1, bl, acc[1][nt]);
                }
            }
            __syncthreads();
        }
        ss0 += __shfl_xor(ss0, 32); ss1 += __shfl_xor(ss1, 32);
        if (h == 0) { ssp[w * 32 + r] = ss0; ssp[256 + w * 32 + r] = ss1; }
#pragma unroll
        for (int t = 0; t < 2; ++t) {
#pragma unroll
            for (int nt = 0; nt < 3; ++nt)
#pragma unroll
                for (int g = 0; g < 16; ++g) part[(w * 32 + crow(g, h)) * 96 + nt * 32 + r] = acc[t][nt][g];
            __syncthreads();
            for (int idx = F.tid; idx < 32 * 72; idx += NWAVES * 64) { const int tk = idx / 72, c = idx % 72; float v = 0.f;
#pragma unroll
                for (int i = 0; i < 8; ++i) v += part[(i * 32 + tk) * 96 + c];
                lg[t * 32 * 72 + idx] = v; }
            __syncthreads();
        }
        LAS unsigned* hist = (LAS unsigned*)rsl + 64;
        if (F.tid < 128) hist[F.tid] = 0u;
        __syncthreads();
        int tok = 0, e0 = 0, e1 = 0; unsigned r0 = 0, r1 = 0; float g0 = 0.f, g1 = 0.f, rs = 0.f;
        if (F.tid < 64) {
            tok = unit * 64 + F.tid; float tsum = 0.f;
#pragma unroll
            for (int i = 0; i < 8; ++i) tsum += ssp[(F.tid >> 5) * 256 + i * 32 + (F.tid & 31)];
            rs = 1.0f / sqrtf(tsum * (1.0f / DM) + RMS_EPS); RSTD[tok] = rs;
            const LAS float* l = lg + F.tid * 72;
            float gl[8]; int gi = 0; float gm = -3.0e38f;
#pragma unroll
            for (int i = 0; i < 8; ++i) { gl[i] = l[i] * rs + b_rg[i]; if (gl[i] > gm) { gm = gl[i]; gi = i; } }
            float gs = 0.f;
#pragma unroll
            for (int i = 0; i < 8; ++i) gs += expf(gl[i] - gm);
            const float gval = 1.0f / gs;
            float el[8]; int i0 = 0; float m0 = -3.0e38f;
#pragma unroll
            for (int i = 0; i < 8; ++i) { el[i] = l[8 + gi * 8 + i] * rs + b_re[gi * 8 + i]; if (el[i] > m0) { m0 = el[i]; i0 = i; } }
            int i1 = 0; float m1 = -3.0e38f;
#pragma unroll
            for (int i = 0; i < 8; ++i) if (i != i0 && el[i] > m1) { m1 = el[i]; i1 = i; }
            const float p1 = expf(m1 - m0); g0 = gval / (1.0f + p1); g1 = gval * p1 / (1.0f + p1);
            e0 = gi * 8 + i0; e1 = gi * 8 + i1;
            r0 = atomicAdd((unsigned*)(hist + e0), 1u); r1 = atomicAdd((unsigned*)(hist + e1), 1u);
        }
        __syncthreads();
        if (F.tid < 64) { const unsigned n = hist[F.tid]; if (n) hist[64 + F.tid] = atomicAdd(CNT + 16 * F.tid, n); }
        __syncthreads();
        if (F.tid < 64) {
            const int pos0 = (int)(hist[64 + e0] + r0), pos1 = (int)(hist[64 + e1] + r1);
            LIST[e0 * NTOK + pos0] = tok; LIST[e1 * NTOK + pos1] = tok; GATEW[e0 * NTOK + pos0] = g0; GATEW[e1 * NTOK + pos1] = g1; RSTDW[e0 * NTOK + pos0] = rs; RSTDW[e1 * NTOK + pos1] = rs;
            *(int4*)(TOKINFO + 4 * tok) = make_int4(e0, pos0, e1, pos1);
        }
        __syncthreads();
    }
}

__device__ __forceinline__ void build_tables(Frame& F) {
    LAS int* T = (LAS int*)(F.lds + TBL_OFF);
    __syncthreads();
    if (F.tid < NEXP) {
        const int c = (int)__hip_atomic_load(F.ctl + CW_CNT + 16 * F.tid, __ATOMIC_RELAXED, __HIP_MEMORY_SCOPE_AGENT); const int mt = (c + 255) >> 8;
        int incl = mt;
#pragma unroll
        for (int o = 1; o < 64; o <<= 1) { const int v = __shfl_up(incl, o); if (F.tid >= o) incl += v; }
        const int st = incl - mt;
        T[TBL_TSTART + F.tid] = st; T[TBL_CNTS + F.tid] = c;
        for (int i = 0; i < mt; ++i) T[TBL_TE + st + i] = F.tid;
        if (F.tid == NEXP - 1) { T[TBL_TSTART + NEXP] = incl; T[TBL_NT] = incl; }
    }
    __syncthreads();
}
struct MoeGather {
    const int* list; const LAS int* T; LAS int* tokbuf; int NT; const float* rstdw; const float* gatew;
    __device__ __forceinline__ void info(const pg8::Unit& u, int& e, int& base, int& cnt) const { e = u.pn / NT; base = (u.pm - T[TBL_TSTART + e]) * 256; cnt = T[TBL_CNTS + e]; }
    __device__ __forceinline__ unsigned tok_direct(const pg8::Unit& u, int row) const { int e, base, cnt; info(u, e, base, cnt); const int idx = base + row; return idx < cnt ? (unsigned)list[e * NTOK + idx] : 0u; }
    __device__ __forceinline__ void issue(const pg8::Unit& u, int par, int lane) const { int e, base, cnt; info(u, e, base, cnt);
        __builtin_amdgcn_global_load_lds((const unsigned*)(list + e * NTOK + base + 4 * lane), (LAS unsigned*)(tokbuf + par * 256), 16, 0, 0);
        __builtin_amdgcn_global_load_lds((const unsigned*)(rstdw + e * NTOK + base + 4 * lane), (LAS unsigned*)(tokbuf + 512 + par * 256), 16, 0, 0);
        __builtin_amdgcn_global_load_lds((const unsigned*)(gatew + e * NTOK + base + 4 * lane), (LAS unsigned*)(tokbuf + 1024 + par * 256), 16, 0, 0); }
    __device__ __forceinline__ void direct_rg(const pg8::Unit& u, int row, float& rs, float& gw) const { int e, base, cnt; info(u, e, base, cnt); rs = rstdw[e * NTOK + base + row]; gw = gatew[e * NTOK + base + row]; }
    __device__ __forceinline__ unsigned tok_lds(const pg8::Unit& u, int par, int row) const { int e, base, cnt; info(u, e, base, cnt); const unsigned t = (unsigned)tokbuf[par * 256 + row]; return (base + row) < cnt ? t : 0u; }
};
namespace pg8 {
template <class Epi, class Sched>
__device__ __forceinline__ void gemm_phase_g(PG8_LAS unsigned char* lds, const Gemm g, const Sched& S, const Epi& E, const MoeGather& GA) {
    const int tid = threadIdx.x, wid = __builtin_amdgcn_readfirstlane(tid >> 6), lane = tid & 63, wr = wid >> 2, wc = wid & 3, fr = lane & 15, fq = lane >> 4;
    const int K = g.K, nt = K / BK;
    unsigned voffB[2], cofA[2]; int rowA[2];
#pragma unroll
    for (int i = 0; i < 2; ++i) { int R, C; stage_rc(tid * 16 + i * 8192, R, C); const int Rb = Epi::PERM ? ((R & ~31) + perm32(R & 31)) : R;
        rowA[i] = R; cofA[i] = (unsigned)C * 2u; voffB[i] = (unsigned)(Rb * K + C) * 2u; }
    const unsigned rowbytes = (unsigned)K * 2u;
    const size_t kstep = (size_t)(BK * 2);
    const size_t hstep = (size_t)HALF * K * 2;
    const size_t tstep = 2 * hstep;
    const unsigned ldsw = (unsigned)wid * 1024u;
    const int aoff = lds_byte(wr * 64 + fr, fq * 8), boff = lds_byte(wc * 32 + fr, fq * 8);
#define PG8_SA(b, h) (((b) * 2 + (h)) * HTB)
#define PG8_SB(b, h) ((4 + (b) * 2 + (h)) * HTB)
#define PG8_STAGE(bufoff, gbase, voff) do { _Pragma("unroll") for (int _i = 0; _i < 2; ++_i) \
        __builtin_amdgcn_global_load_lds((const unsigned*)((const char*)(gbase) + (voff)[_i]), (PG8_LAS unsigned*)(lds + (bufoff) + ldsw + _i * 8192), 16, 0, 0); } while (0)
#define PG8_LDA(dst, b, h) do { _Pragma("unroll") for (int m = 0; m < 4; ++m) _Pragma("unroll") for (int k = 0; k < 2; ++k) dst[m][k] = *(const PG8_LAS bf16x8*)(lds + PG8_SA(b, h) + aoff + m * 2048 + k * 1024); } while (0)
#define PG8_LDB(dst, b, h) do { _Pragma("unroll") for (int n = 0; n < 2; ++n) _Pragma("unroll") for (int k = 0; k < 2; ++k) dst[n][k] = *(const PG8_LAS bf16x8*)(lds + PG8_SB(b, h) + boff + n * 2048 + k * 1024); } while (0)
#define PG8_MMA(ai, bj, At, Bt) do { __builtin_amdgcn_s_setprio(1); _Pragma("unroll") for (int m = 0; m < 4; ++m) _Pragma("unroll") for (int n = 0; n < 2; ++n) _Pragma("unroll") for (int k = 0; k < 2; ++k) \
        acc[ai][bj][m][n] = __builtin_amdgcn_mfma_f32_16x16x32_bf16(Bt[n][k], At[m][k], acc[ai][bj][m][n], 0, 0, 0); __builtin_amdgcn_s_setprio(0); } while (0)
#define PG8_WAIT_V(n) asm volatile("s_waitcnt vmcnt(" #n ")" ::: "memory")
#define PG8_WAIT_L(n) asm volatile("s_waitcnt lgkmcnt(" #n ")" ::: "memory")
#define PG8_BAR __builtin_amdgcn_s_barrier()
#define PG8_SCHED __builtin_amdgcn_sched_barrier(0)
    Unit cur, nxt; int ui = 0;
    if (!S.next(0, cur)) return;
    f32x4 acc[2][2][4][2];
#pragma unroll
    for (int a = 0; a < 2; ++a)
#pragma unroll
        for (int b = 0; b < 2; ++b)
#pragma unroll
            for (int m = 0; m < 4; ++m)
#pragma unroll
                for (int n = 0; n < 2; ++n) acc[a][b][m][n] = (f32x4){0.f, 0.f, 0.f, 0.f};
    bf16x8 At[4][2], B0[2][2], B1[2][2];
    const char* A0 = (const char*)g.A; const char* cB = (const char*)g.Bt + (size_t)cur.pn * tstep;
    PG8_LAS int* tb = GA.tokbuf;
    if (tid < 256) { tb[tid] = (int)GA.tok_direct(cur, tid); float rs_, gw_; GA.direct_rg(cur, tid, rs_, gw_); ((PG8_LAS float*)tb)[512 + tid] = rs_; ((PG8_LAS float*)tb)[1024 + tid] = gw_; }
    PG8_WAIT_L(0); PG8_BAR;
#define PG8_OFFS(dst, par, half) do { _Pragma("unroll") for (int _i = 0; _i < 2; ++_i) dst[_i] = (unsigned)tb[(par) * 256 + (half) * HALF + rowA[_i]] * rowbytes + cofA[_i]; } while (0)
    {
        unsigned c0[2], c1[2]; PG8_OFFS(c0, 0, 0); PG8_OFFS(c1, 0, 1);
        PG8_STAGE(PG8_SB(0, 0), cB, voffB); PG8_STAGE(PG8_SB(0, 1), cB + hstep, voffB); PG8_STAGE(PG8_SA(0, 0), A0, c0); PG8_STAGE(PG8_SA(0, 1), A0, c1);
        if (wr == 1) PG8_BAR;
        PG8_WAIT_V(2); PG8_BAR;
        PG8_STAGE(PG8_SB(1, 0), cB + kstep, voffB); PG8_STAGE(PG8_SA(1, 0), A0 + kstep, c0); PG8_STAGE(PG8_SB(1, 1), cB + hstep + kstep, voffB);
        PG8_WAIT_V(6); PG8_BAR;
    }
    int t_issue = 2, t_fix = 6; asm volatile("" : "+s"(t_issue), "+s"(t_fix));
    for (;;) {
        const bool has_next = S.next(ui + 1, nxt);
        const char* nB = has_next ? (const char*)g.Bt + (size_t)nxt.pn * tstep : cB;
        const int pc = ui & 1, pnx = (ui + 1) & 1;
        for (int t = 0; t < nt; t += 2) {
            const bool last = (t == nt - 2);
            const char* a1 = A0 + (size_t)(t + 1) * kstep;
            const char* a2 = last ? A0 : A0 + (size_t)(t + 2) * kstep; const char* b2 = last ? nB : cB + (size_t)(t + 2) * kstep;
            const char* a3 = a2 + kstep; const char* b3 = b2 + kstep;
            if (t == t_fix && has_next && tid < 256) { int e_, base_, cnt_; GA.info(nxt, e_, base_, cnt_); if (base_ + tid >= cnt_) tb[pnx * 256 + tid] = 0; }
            const int ps = (last && has_next) ? pnx : pc;
            unsigned c1[2], s0[2], s1[2]; PG8_OFFS(c1, pc, 1); PG8_OFFS(s0, ps, 0); PG8_OFFS(s1, ps, 1);
            PG8_LDB(B0, 0, 0); PG8_LDB(B1, 0, 1); PG8_SCHED; PG8_LDA(At, 0, 0); PG8_STAGE(PG8_SA(1, 1), a1, c1);
            if (t == t_issue && has_next && wid == 0) GA.issue(nxt, pnx, lane);
            PG8_WAIT_V(8); PG8_WAIT_L(0); PG8_BAR; PG8_MMA(0, 0, At, B0); PG8_MMA(0, 1, At, B1); PG8_BAR; PG8_SCHED;
            PG8_LDA(At, 0, 1); PG8_STAGE(PG8_SB(0, 0), b2, voffB); PG8_STAGE(PG8_SB(0, 1), b2 + hstep, voffB); PG8_STAGE(PG8_SA(0, 0), a2, s0);
            PG8_WAIT_V(8); PG8_WAIT_L(0); PG8_BAR; PG8_MMA(1, 0, At, B0); PG8_MMA(1, 1, At, B1); PG8_BAR; PG8_SCHED;
            PG8_LDB(B0, 1, 0); PG8_LDB(B1, 1, 1); PG8_SCHED; PG8_LDA(At, 1, 0); PG8_STAGE(PG8_SA(0, 1), a2, s1);
            PG8_WAIT_V(8); PG8_WAIT_L(0); PG8_BAR; PG8_MMA(0, 0, At, B0); PG8_MMA(0, 1, At, B1); PG8_BAR; PG8_SCHED;
            PG8_LDA(At, 1, 1); PG8_STAGE(PG8_SB(1, 0), b3, voffB); PG8_STAGE(PG8_SB(1, 1), b3 + hstep, voffB); PG8_STAGE(PG8_SA(1, 0), a3, s0);
            PG8_WAIT_V(8); PG8_WAIT_L(0); PG8_BAR; PG8_MMA(1, 0, At, B0); PG8_MMA(1, 1, At, B1); PG8_BAR; PG8_SCHED;
        }
        if (wr == 0) PG8_BAR;
        E.par = pc; E(acc, cur, wr, wc, fr, fq); S.done(cur);
        if (!has_next) break;
#pragma unroll
        for (int a = 0; a < 2; ++a)
#pragma unroll
            for (int b = 0; b < 2; ++b)
#pragma unroll
                for (int m = 0; m < 4; ++m)
#pragma unroll
                    for (int n = 0; n < 2; ++n) acc[a][b][m][n] = (f32x4){0.f, 0.f, 0.f, 0.f};
        cur = nxt; cB = nB; ++ui;
        if (wr == 1) PG8_BAR;
    }
    PG8_WAIT_V(0);
    PG8_BAR;
#undef PG8_SA
#undef PG8_SB
#undef PG8_STAGE
#undef PG8_LDA
#undef PG8_LDB
#undef PG8_MMA
#undef PG8_WAIT_V
#undef PG8_WAIT_L
#undef PG8_BAR
#undef PG8_SCHED
#undef PG8_OFFS
}
}
struct MoeOrder {
    const LAS int* T; int NT, G, c;
    __device__ bool next(int i, pg8::Unit& u) const {
        const int L = i * G + c; if (L >= T[TBL_NT] * NT) return false;
        const int mt = L / NT; u.pm = mt; u.pn = T[TBL_TE + mt] * NT + (L % NT); return true;
    }
    __device__ __forceinline__ void a_ready(const pg8::Unit&) const {}
    __device__ __forceinline__ void done(const pg8::Unit&) const {}
};
struct EpiSwiGLU {
    static constexpr bool PERM = true, AFTER_DRAIN = false, MIDK = false;
    bf16* HDN; const LAS float* RG; const LAS int* T; mutable int par;
    __device__ __forceinline__ void operator()(const pg8::f32x4 (&acc)[2][2][4][2], const pg8::Unit& u, int wr, int wc, int fr, int fq) const {
        const int col0 = (u.pn & 3) * 128 + wc * 32 + 8 * fq; const int e = u.pn >> 2; const int base = (u.pm - T[TBL_TSTART + e]) * 256, cnt = T[TBL_CNTS + e];
#pragma unroll
        for (int ai = 0; ai < 2; ++ai)
#pragma unroll
            for (int m = 0; m < 4; ++m) { const int rl = ai * 128 + wr * 64 + m * 16 + fr; const int row = u.pm * 256 + rl; const bool ok = (base + rl) < cnt;
                const float rsr = RG[par * 256 + rl], gwr = RG[512 + par * 256 + rl];
                const float rs = ok ? rsr : 0.f, gw = ok ? gwr : 0.f;
                float o[8];
#pragma unroll
                for (int n = 0; n < 2; ++n)
#pragma unroll
                    for (int q = 0; q < 4; ++q) { const float g = acc[ai][0][m][n][q] * rs, up = acc[ai][1][m][n][q] * rs;
                        const float sg = g * __builtin_amdgcn_rcpf(1.0f + __builtin_amdgcn_exp2f(-g * LOG2E)); o[4 * n + q] = sg * up * gw; }
                v4u wv; wv.x = pk2(o[0], o[1]); wv.y = pk2(o[2], o[3]); wv.z = pk2(o[4], o[5]); wv.w = pk2(o[6], o[7]);
                *(v4u*)(HDN + (size_t)row * DEXP + col0) = wv; }
    }
};
struct EpiY {
    static constexpr bool PERM = true, AFTER_DRAIN = false, MIDK = false;
    bf16* Y;
    __device__ __forceinline__ void operator()(const pg8::f32x4 (&acc)[2][2][4][2], const pg8::Unit& u, int wr, int wc, int fr, int fq) const {
        const int col0 = (u.pn & 7) * 256 + wc * 32 + 8 * fq;
#pragma unroll
        for (int ai = 0; ai < 2; ++ai)
#pragma unroll
            for (int m = 0; m < 4; ++m) { bf16* rowp = Y + (size_t)(u.pm * 256 + ai * 128 + wr * 64 + m * 16 + fr) * DM + col0;
#pragma unroll
                for (int bj = 0; bj < 2; ++bj) { const pg8::f32x4 v0 = acc[ai][bj][m][0], v1 = acc[ai][bj][m][1];
                    v4u w; w.x = pk2(v0[0], v0[1]); w.y = pk2(v0[2], v0[3]); w.z = pk2(v1[0], v1[1]); w.w = pk2(v1[2], v1[3]); *(v4u*)(rowp + bj * 128) = w; } }
    }
};
struct P8Row { v4u h[4], a[4], b[4]; };
__device__ __forceinline__ void p8_load(P8Row& r, const bf16* HB, const bf16* Y, const LAS int* T, int4 ti, int t, int lane) {
    const size_t s0 = (size_t)T[TBL_TSTART + ti.x] * 256 + ti.y, s1 = (size_t)T[TBL_TSTART + ti.z] * 256 + ti.w;
    const v4u* hp = (const v4u*)(HB + (size_t)t * DM) + lane; const v4u* y0 = (const v4u*)(Y + s0 * DM) + lane; const v4u* y1 = (const v4u*)(Y + s1 * DM) + lane;
#pragma unroll
    for (int j = 0; j < 4; ++j) { r.h[j] = __builtin_nontemporal_load(hp + 64 * j); r.a[j] = __builtin_nontemporal_load(y0 + 64 * j); r.b[j] = __builtin_nontemporal_load(y1 + 64 * j); }
}
__device__ __forceinline__ void p8_combine(Frame& F) {
    const LAS int* T = (const LAS int*)(F.lds + TBL_OFF);
    const int gw = F.vcu * NWAVES + F.wave, NGW = F.G * NWAVES;
    const bf16* Y = (const bf16*)(F.ws + WS_Y); const bf16* HB = (const bf16*)(F.ws + WS_HB); const int* TOKINFO = (const int*)(F.ws + WS_TOKINFO);
    constexpr int RPW = 8;
    int4 ti[RPW];
#pragma unroll
    for (int k = 0; k < RPW; ++k) { const int t = gw + k * NGW; ti[k] = (t < NTOK) ? *(const int4*)(TOKINFO + 4 * t) : make_int4(0, 0, 0, 0); }
    P8Row cur; if (gw < NTOK) p8_load(cur, HB, Y, T, ti[0], gw, F.lane);
#pragma unroll
    for (int k = 0; k < RPW; ++k) {
        const int t = gw + k * NGW; if (t >= NTOK) break;
        P8Row nxt; const int tn = t + NGW;
        if (k + 1 < RPW && tn < NTOK) p8_load(nxt, HB, Y, T, ti[k + 1 < RPW ? k + 1 : k], tn, F.lane);
        f32x4* od = (f32x4*)(F.out + (size_t)t * DM) + 2 * F.lane;
#pragma unroll
        for (int j = 0; j < 4; ++j) {
            const v4u h = cur.h[j], a = cur.a[j], b = cur.b[j]; f32x4 v0, v1;
            v0[0] = bf_lo(h.x) + bf_lo(a.x) + bf_lo(b.x); v0[1] = bf_hi(h.x) + bf_hi(a.x) + bf_hi(b.x); v0[2] = bf_lo(h.y) + bf_lo(a.y) + bf_lo(b.y); v0[3] = bf_hi(h.y) + bf_hi(a.y) + bf_hi(b.y);
            v1[0] = bf_lo(h.z) + bf_lo(a.z) + bf_lo(b.z); v1[1] = bf_hi(h.z) + bf_hi(a.z) + bf_hi(b.z); v1[2] = bf_lo(h.w) + bf_lo(a.w) + bf_lo(b.w); v1[3] = bf_hi(h.w) + bf_hi(a.w) + bf_hi(b.w);
            od[128 * j] = v0; od[128 * j + 1] = v1;
        }
        cur = nxt;
    }
    for (int t = gw + RPW * NGW; t < NTOK; t += NGW) {
        const int4 tj = *(const int4*)(TOKINFO + 4 * t); P8Row r; p8_load(r, HB, Y, T, tj, t, F.lane);
        f32x4* od = (f32x4*)(F.out + (size_t)t * DM) + 2 * F.lane;
#pragma unroll
        for (int j = 0; j < 4; ++j) {
            const v4u h = r.h[j], a = r.a[j], b = r.b[j]; f32x4 v0, v1;
            v0[0] = bf_lo(h.x) + bf_lo(a.x) + bf_lo(b.x); v0[1] = bf_hi(h.x) + bf_hi(a.x) + bf_hi(b.x); v0[2] = bf_lo(h.y) + bf_lo(a.y) + bf_lo(b.y); v0[3] = bf_hi(h.y) + bf_hi(a.y) + bf_hi(b.y);
            v1[0] = bf_lo(h.z) + bf_lo(a.z) + bf_lo(b.z); v1[1] = bf_hi(h.z) + bf_hi(a.z) + bf_hi(b.z); v1[2] = bf_lo(h.w) + bf_lo(a.w) + bf_lo(b.w); v1[3] = bf_hi(h.w) + bf_hi(a.w) + bf_hi(b.w);
            od[128 * j] = v0; od[128 * j + 1] = v1;
        }
    }
}

__global__ void __launch_bounds__(NWAVES * 64, 2) mk_fwd(Args args) {
    extern __shared__ __attribute__((aligned(16))) unsigned char lds[];
    Frame F;
    F.lds = (LAS unsigned char*)lds; F.ws = args.ws; F.ctl = (unsigned*)(args.ws + WS_CTL);
    F.tid = threadIdx.x; F.lane = F.tid & 63; F.wave = __builtin_amdgcn_readfirstlane(F.tid >> 6);
    F.G = gridDim.x; { const int bx = blockIdx.x; F.vcu = (F.G % 8 == 0) ? (bx % 8) * (F.G / 8) + bx / 8 : bx; }
    F.in = args.in; F.out = args.out;
    volatile LAS unsigned* MISC = (volatile LAS unsigned*)(F.lds + MISC_OFF);
    if (F.tid < 64) MISC[F.tid] = 0u;
    __syncthreads();
    const int lo = args.ph_lo, hi = args.ph_hi;
    const bool use_bar = (hi - lo) > 1;
    XcdBarrier bar; bar.bar = F.ctl + CW_BAR + args.li * XCD_BAR_WORDS; bar.x = 0; bar.st = nullptr;
    if (use_bar) bar = xcd_barrier_post(F.ctl + CW_BAR + args.li * XCD_BAR_WORDS, MISC + 8);
#define IN(k) (lo <= (k) && (k) < hi)
#define SEAM(k) do { if (IN(k) && (IN((k) + 1) || ((k) == 4 && IN(6)))) xcd_barrier(bar); } while (0)
    bf16* BIG = (bf16*)(F.ws + WS_BIG);

    if (IN(0)) { p0_prologue(F); SEAM(0); }
    if (IN(1)) {
        pg8::Gemm g{BIG, BIG, 0, 0, DM}; P1Order S{F.G, F.vcu};
        EpiQKV E{(bf16*)(F.ws + WS_QS), (bf16*)(F.ws + WS_KS), (bf16*)(F.ws + WS_QW), (bf16*)(F.ws + WS_KW), (bf16*)(F.ws + WS_VT), F.in[5], F.in[6]};
        pg8::gemm_phase<EpiQKV, P1Order, true, true>(F.lds + RING_OFF, g, S, E);
        {
            const int rounds = (P1_UNITS + F.G - 1) / F.G, first_idle = P1_UNITS - (rounds - 1) * F.G, nidle = F.G - first_idle;
            const int base = NITEMS - TAIL6_ITEMS - tail1_items(F.G);
            if (F.vcu >= first_idle) conv_range(F, base + (F.vcu - first_idle) * NWAVES + F.wave, nidle * NWAVES, NITEMS - TAIL6_ITEMS);
        }
        SEAM(1);
    }
    if (IN(2)) { p2_attention(F); SEAM(2); }
    if (IN(3)) {
        pg8::Gemm g{(const bf16*)(F.ws + WS_MIXED), (const bf16*)(F.ws + WS_WOUT), NTOK, DM, DM}; pg8::StaticOrder S; S.init(NTOK, DM, F.G, (int)blockIdx.x);
        LAS float* RS = (LAS float*)(F.lds + ATT_TBR_OFF);
        {   const float* SSQ = (const float*)(F.ws + WS_SSQ);
            for (int i = 0; i < 4; ++i) { pg8::Unit u; if (!S.next(i, u)) break;
                if (F.tid < 256) { const pg8::f32x4* q = (const pg8::f32x4*)(SSQ + (size_t)(u.pm * 256 + F.tid) * 16); const pg8::f32x4 a = q[0], b = q[1], c = q[2], d = q[3];
                    float sb = 0.f, sw = 0.f;
#pragma unroll
                    for (int q_ = 0; q_ < ATT_WAVES; ++q_) { sb += (q_ < 4 ? a[q_ & 3] : b[q_ & 3]); sw += (q_ < 4 ? c[q_ & 3] : d[q_ & 3]); }
                    RS[(i * 256 + F.tid) * 2] = 1.0f / sqrtf(sb * (1.0f / 1024.0f) + RMS_EPS); RS[(i * 256 + F.tid) * 2 + 1] = 1.0f / sqrtf(sw * (1.0f / 1024.0f) + RMS_EPS); } }
            __syncthreads(); }
        EpiRes E{(bf16*)(F.ws + WS_PROJ), RS, 0};
        pg8::gemm_phase<EpiRes, pg8::StaticOrder, true, true>(F.lds + RING_OFF, g, S, E);
        SEAM(3);
    }
    if (IN(4)) { p4_router(F); SEAM(4); }
    if (IN(5) || IN(6) || IN(7) || IN(8)) build_tables(F);
    if (IN(6)) {
        pg8::Gemm g{(const bf16*)(F.ws + WS_HB), (const bf16*)(F.ws + WS_WGU), 0, 0, DM}; MoeOrder S{(const LAS int*)(F.lds + TBL_OFF), 4, F.G, F.vcu};
        MoeGather GA{(const int*)(F.ws + WS_LIST), (const LAS int*)(F.lds + TBL_OFF), (LAS int*)(F.lds + TOKBUF_OFF), 4, (const float*)(F.ws + WS_RSTDW), (const float*)(F.ws + WS_GATEW)};
        EpiSwiGLU E{(bf16*)(F.ws + WS_HDN), (const LAS float*)(F.lds + TOKBUF_OFF + 2048), (const LAS int*)(F.lds + TBL_OFF), 0};
        pg8::gemm_phase_g<EpiSwiGLU, MoeOrder>(F.lds + RING_OFF, g, S, E, GA);
        {
            const int units = S.T[TBL_NT] * 4, rounds = (units + F.G - 1) / F.G, first_idle = units - (rounds - 1) * F.G, nidle = F.G - first_idle;
            const int base = NITEMS - TAIL6_ITEMS; int mid = base + nidle * NWAVES * TAIL6_PER_WAVE; if (mid > NITEMS) mid = NITEMS;
            if (nidle > 0 && F.vcu >= first_idle) conv_range(F, base + (F.vcu - first_idle) * NWAVES + F.wave, nidle * NWAVES, mid);
            conv_range(F, mid + F.vcu * NWAVES + F.wave, F.G * NWAVES, NITEMS);
        }
        SEAM(6);
    }
    if (IN(7)) {
        pg8::Gemm g{(const bf16*)(F.ws + WS_HDN), (const bf16*)(F.ws + WS_WD), 0, 0, DEXP}; MoeOrder S{(const LAS int*)(F.lds + TBL_OFF), 8, F.G, F.vcu};
        EpiY E{(bf16*)(F.ws + WS_Y)};
        pg8::gemm_phase<EpiY, MoeOrder, true, true>(F.lds + RING_OFF, g, S, E);
        SEAM(7);
    }
    if (IN(8)) p8_combine(F);
#undef IN
#undef SEAM
}

extern "C" void kernel_launch(void* const* d_in, const int* in_sizes, int n_in, void* d_out, int out_size, void* d_ws, size_t ws_size, hipStream_t stream) {
    static int grid = 0;
    if (grid == 0) {
        if (n_in != 19 || out_size != NTOK * DM || ws_size < WS_END) { fprintf(stderr, "kernel_launch: unexpected shapes (n_in %d out %d ws %zu)\n", n_in, out_size, ws_size); grid = -1; return; }
        int dev = 0, cus = 0, per_cu = 0;
        if (hipGetDevice(&dev) != hipSuccess || hipDeviceGetAttribute(&cus, hipDeviceAttributeMultiprocessorCount, dev) != hipSuccess) { grid = -1; return; }
        if (hipFuncSetAttribute((const void*)mk_fwd, hipFuncAttributeMaxDynamicSharedMemorySize, LDS_BYTES) != hipSuccess) { fprintf(stderr, "kernel_launch: hipFuncSetAttribute failed\n"); grid = -1; return; }
        if (hipOccupancyMaxActiveBlocksPerMultiprocessor(&per_cu, (const void*)mk_fwd, NWAVES * 64, LDS_BYTES) != hipSuccess || per_cu < 1) { fprintf(stderr, "kernel_launch: occupancy query reports %d\n", per_cu); }
        (void)hipGetLastError();
        grid = cus;
    }
    if (grid < 0) return;
    (void)hipMemsetAsync((char*)d_ws + WS_CTL, 0, CTL_ZERO_BYTES, stream);
    Args a{};
    for (int i = 0; i < 19; ++i) a.in[i] = (const float*)d_in[i];
    a.out = (float*)d_out; a.ws = (unsigned char*)d_ws;
#if MK_N_LAUNCHES == 1
    a.ph_lo = 0; a.ph_hi = N_PHASES; a.li = 0;
    hipLaunchKernelGGL(mk_fwd, dim3(grid), dim3(NWAVES * 64), LDS_BYTES, stream, a);
#else
    a.li = 0;
    for (int p = 0; p < N_PHASES; ++p) { a.ph_lo = p; a.ph_hi = p + 1; hipLaunchKernelGGL(mk_fwd, dim3(grid), dim3(NWAVES * 64), LDS_BYTES, stream, a); }
#endif
}
```

```cpp
#include <hip/hip_runtime.h>
#include <cstdio>
#include <cstdint>
namespace pg8 {
#define PG8_LAS __attribute__((address_space(3)))
typedef unsigned short bf16_t;
typedef short bf16x8 __attribute__((ext_vector_type(8)));
typedef float f32x4 __attribute__((ext_vector_type(4)));
typedef unsigned u32x4 __attribute__((ext_vector_type(4)));
constexpr int BM = 256, BK = 64, HALF = 128, HTB = HALF * BK * 2  , STAGE_BYTES = 8 * HTB, NXCD = 8, WGM = 8;

__host__ __device__ __forceinline__ int lds_byte(int r, int c) { const int st = (r >> 4) * 2 + (c >> 5), rr = r & 15, cc = c & 31, ob = rr * 64 + cc * 2; return st * 1024 + (ob ^ (((ob >> 9) & 1) << 5)); }
__host__ __device__ __forceinline__ void stage_rc(int b, int& R, int& C) { const int st = b / 1024, sb = b % 1024, swz = sb ^ (((sb >> 9) & 1) << 5); R = (st >> 1) * 16 + swz / 64; C = (st & 1) * 32 + (swz % 64) / 2; }
__host__ __device__ __forceinline__ int perm32(int rho) { const int n = rho >> 4, i = rho & 15; return 8 * (i >> 2) + 4 * n + (i & 3); }

struct Unit { int pm, pn; };
struct Gemm { const bf16_t* A; const bf16_t* Bt; int M, N, K; };

struct StaticOrder {
    int nM, nN, nwg, G, c;
    __host__ __device__ void init(int M, int N, int G_, int c_) { nM = M / BM; nN = N / BM; nwg = nM * nN; G = G_; c = c_; }
    __host__ __device__ bool next(int i, Unit& u) const {
        const long L = (long)i * G + c; if (L >= nwg) return false;
        int wgid = (int)L; { const int q = nwg / NXCD, r = nwg % NXCD, xcd = wgid % NXCD, off = wgid / NXCD; wgid = (xcd < r ? xcd * (q + 1) : r * (q + 1) + (xcd - r) * q) + off; }
        const int nig = WGM * nN, gid = wgid / nig, fm = gid * WGM, gsz = (nM - fm) < WGM ? (nM - fm) : WGM;
        u.pm = fm + ((wgid % nig) % gsz); u.pn = (wgid % nig) / gsz; return true;
    }
    __device__ __forceinline__ void a_ready(const Unit&) const {}
    __device__ __forceinline__ void done(const Unit&) const {}
};

__device__ __forceinline__ unsigned cvt_pk_bf16(float lo, float hi) { unsigned r; asm volatile("v_cvt_pk_bf16_f32 %0, %1, %2" : "=v"(r) : "v"(lo), "v"(hi)); return r; }
typedef float f32x2 __attribute__((ext_vector_type(2)));
__device__ __forceinline__ f32x2 gelu_pk(f32x2 v) {
    const f32x2 av = __builtin_elementwise_abs(v), d = av * 0.2316418882f + 1.0f;
    f32x2 t; t.x = __builtin_amdgcn_rcpf(d.x); t.y = __builtin_amdgcn_rcpf(d.y);
    f32x2 q = t * 0.5307027145f + (-0.7265760135f); q = q * t + 0.7107068705f; q = q * t + (-0.142248368f); q = q * t + 0.127414796f; q = q * t;
    const f32x2 s = (v * v) * (-0.72134752044f);
    f32x2 e; e.x = __builtin_amdgcn_exp2f(s.x); e.y = __builtin_amdgcn_exp2f(s.y);
    const f32x2 m = v * (q * e), r = v - m;
    f32x2 o; o.x = v.x < 0.f ? m.x : r.x; o.y = v.y < 0.f ? m.y : r.y; return o;
}

template <int ACT  > struct EpiBf16 {
    static constexpr bool PERM = true, AFTER_DRAIN = false; static_assert(ACT == 0 || ACT == 1, "EpiBf16: ACT is 0 (none) or 1 (gelu_pk)");
    bf16_t* O; int ldc; const float* bias; int split_cols; size_t split_stride; float scale0;
    __device__ __forceinline__ void operator()(const f32x4 (&acc)[2][2][4][2], const Unit& u, int wr, int wc, int fr, int fq) const {
        const int row0 = u.pm * BM + wr * 64 + fr; int colt = u.pn * BM; bf16_t* base = O;
        float sc = 1.f; if (split_cols) { const int t = colt / split_cols; base += (size_t)t * split_stride; colt -= t * split_cols; if (t == 0) sc = scale0; }
        const int col0 = colt + wc * 32 + 8 * fq, bcol0 = u.pn * BM + wc * 32 + 8 * fq;
        f32x4 bv[2][2];
#pragma unroll
        for (int bj = 0; bj < 2; ++bj)
#pragma unroll
            for (int n = 0; n < 2; ++n) bv[bj][n] = bias ? *(const f32x4*)(bias + bcol0 + bj * HALF + 4 * n) : (f32x4){0.f, 0.f, 0.f, 0.f};
#pragma unroll
        for (int ai = 0; ai < 2; ++ai)
#pragma unroll
            for (int m = 0; m < 4; ++m) { bf16_t* rowp = base + (size_t)(row0 + ai * HALF + m * 16) * ldc + col0;
#pragma unroll
                for (int bj = 0; bj < 2; ++bj) { f32x4 v0 = acc[ai][bj][m][0] + bv[bj][0], v1 = acc[ai][bj][m][1] + bv[bj][1];
                    if (ACT == 1) { f32x2 a = gelu_pk((f32x2){v0[0], v0[1]}), b = gelu_pk((f32x2){v0[2], v0[3]}), c = gelu_pk((f32x2){v1[0], v1[1]}), d = gelu_pk((f32x2){v1[2], v1[3]});
                        v0 = (f32x4){a.x, a.y, b.x, b.y}; v1 = (f32x4){c.x, c.y, d.x, d.y}; }
                    v0 = v0 * sc; v1 = v1 * sc; u32x4 w; w.x = cvt_pk_bf16(v0[0], v0[1]); w.y = cvt_pk_bf16(v0[2], v0[3]); w.z = cvt_pk_bf16(v1[0], v1[1]); w.w = cvt_pk_bf16(v1[2], v1[3]);
                    *(u32x4*)(rowp + bj * HALF) = w; } }
    }
};

struct PanelStats {
    unsigned* xbuf;
    unsigned* cnt;
    unsigned* tmo;
    int ntn; float eps;
    unsigned code;
    __device__ __forceinline__ bool run(const f32x4 (&v)[2][2][4][2], const Unit& u, int wr, int wc, int fr, int fq, PG8_LAS unsigned char* lds, int wid, int lane) const {
        typedef float f32x2v __attribute__((ext_vector_type(2)));
        PG8_LAS f32x2v* P = (PG8_LAS f32x2v*)lds;
        PG8_LAS f32x2v* S = (PG8_LAS f32x2v*)(lds + 8192);
        PG8_LAS unsigned* flag = (PG8_LAS unsigned*)(lds + 8192 + 2048);
#pragma unroll
        for (int ai = 0; ai < 2; ++ai)
#pragma unroll
            for (int m = 0; m < 4; ++m) {
                float s = 0.f;
#pragma unroll
                for (int bj = 0; bj < 2; ++bj)
#pragma unroll
                    for (int n = 0; n < 2; ++n) { const f32x4 x = v[ai][bj][m][n]; s += (x[0] + x[1]) + (x[2] + x[3]); }
                s += __shfl_xor(s, 16); s += __shfl_xor(s, 32);
                const float mw = s * (1.0f / 64.0f); float q = 0.f;
#pragma unroll
                for (int bj = 0; bj < 2; ++bj)
#pragma unroll
                    for (int n = 0; n < 2; ++n) { const f32x4 d = v[ai][bj][m][n] - mw; q += (d[0] * d[0] + d[1] * d[1]) + (d[2] * d[2] + d[3] * d[3]); }
                q += __shfl_xor(q, 16); q += __shfl_xor(q, 32);
                if (fq == 0) P[(ai * HALF + wr * 64 + m * 16 + fr) * 4 + wc] = (f32x2v){mw, q};
            }
        asm volatile("s_waitcnt lgkmcnt(0)" ::: "memory"); __builtin_amdgcn_s_barrier(); asm volatile("" ::: "memory");
#if defined(BROKEN_EXCHANGE_NO_WAIT)
#warning BROKEN CONTROL BUILD: the row-statistics exchange does not wait; results are wrong by design
        if (blockIdx.x >= 64) { const long long t0_ = clock64(); while (clock64() - t0_ < 60000) __builtin_amdgcn_s_sleep(8); }
#endif
        const int row = wid * 32 + (lane & 31);
        if (lane < 32) {
            const f32x2v a = P[row * 4 + 0], b = P[row * 4 + 1], c = P[row * 4 + 2], d = P[row * 4 + 3];
            const float mt = (a.x + b.x + c.x + d.x) * 0.25f;
            const float da = a.x - mt, db = b.x - mt, dc = c.x - mt, dd = d.x - mt;
            const float m2 = (a.y + b.y) + (c.y + d.y) + 64.0f * ((da * da + db * db) + (dc * dc + dd * dd));
            unsigned long long* slot = (unsigned long long*)xbuf + ((size_t)(u.pm * BM + row) * 4 + u.pn);
            __hip_atomic_store(slot, ((unsigned long long)__float_as_uint(m2) << 32) | __float_as_uint(mt), __ATOMIC_RELAXED, __HIP_MEMORY_SCOPE_AGENT);
        }
        asm volatile("s_waitcnt vmcnt(0)" ::: "memory");
        if (lane == 0) __hip_atomic_fetch_add(cnt + 64 * u.pm, 1u, __ATOMIC_RELAXED, __HIP_MEMORY_SCOPE_AGENT);
        if (wid == 0) {
            bool dead = false; const unsigned long long t0 = __builtin_amdgcn_s_memrealtime(); const unsigned want = 8u * (unsigned)ntn;
            for (;;) {
#if defined(BROKEN_EXCHANGE_NO_WAIT)
                break;
#endif
                if ((unsigned)__builtin_amdgcn_readfirstlane(__hip_atomic_load(cnt + 64 * u.pm, __ATOMIC_RELAXED, __HIP_MEMORY_SCOPE_AGENT)) >= want) break;
                if (__builtin_amdgcn_s_memrealtime() - t0 > 2000000ull) {
                    if (lane == 0) { unsigned expect = 0u; __hip_atomic_compare_exchange_strong(tmo + 1, &expect, code | (unsigned)(u.pm & 0xff), __ATOMIC_RELAXED, __ATOMIC_RELAXED, __HIP_MEMORY_SCOPE_AGENT);
                                     __hip_atomic_store(tmo, 1u, __ATOMIC_RELAXED, __HIP_MEMORY_SCOPE_AGENT); }
                    dead = true; break; }
                __builtin_amdgcn_s_sleep(2);
            }
            __builtin_amdgcn_fence(__ATOMIC_ACQUIRE, "agent");
            if (lane == 0) flag[0] = dead ? 1u : 0u;
        }
        asm volatile("s_waitcnt vmcnt(0) lgkmcnt(0)" ::: "memory"); __builtin_amdgcn_s_barrier(); asm volatile("" ::: "memory");
        const bool bad = flag[0] != 0u;
        if (lane < 32) {
            const unsigned long long* slot = (const unsigned long long*)xbuf + (size_t)(u.pm * BM + row) * 4; float mt[4], m2[4]; float ms = 0.f;
#pragma unroll
            for (int t = 0; t < 4; ++t) { if (t < ntn) { const unsigned long long w = __hip_atomic_load(slot + t, __ATOMIC_RELAXED, __HIP_MEMORY_SCOPE_AGENT); mt[t] = __uint_as_float((unsigned)w); m2[t] = __uint_as_float((unsigned)(w >> 32)); } else { mt[t] = 0.f; m2[t] = 0.f; } ms += mt[t]; }
            const float mean = ms / (float)ntn; float q = 0.f;
#pragma unroll
            for (int t = 0; t < 4; ++t) if (t < ntn) { const float dm = mt[t] - mean; q += m2[t] + 256.0f * dm * dm; }
            S[row] = (f32x2v){mean, 1.0f / sqrtf(q / (256.0f * (float)ntn) + eps)};
        }
        asm volatile("s_waitcnt lgkmcnt(0)" ::: "memory"); __builtin_amdgcn_s_barrier(); asm volatile("" ::: "memory");
        return bad;
    }
};
struct EpiLnRes {
    static constexpr bool PERM = false, AFTER_DRAIN = true;
    const float* base; float* out; int ldc; const float* bias; PanelStats st; unsigned poison;
    __device__ __forceinline__ void fused(f32x4 (&acc)[2][2][4][2], const Unit& u, int wr, int wc, int fr, int fq, PG8_LAS unsigned char* lds, int wid, int lane) const {
        typedef float f32x2v __attribute__((ext_vector_type(2)));
        const PG8_LAS f32x2v* S = (const PG8_LAS f32x2v*)(lds + 8192);
        const int col0 = u.pn * BM + wc * 32 + 4 * fq;
#pragma unroll
        for (int bj = 0; bj < 2; ++bj)
#pragma unroll
            for (int n = 0; n < 2; ++n) { const f32x4 bv = bias ? *(const f32x4*)(bias + col0 + bj * HALF + n * 16) : (f32x4){0.f, 0.f, 0.f, 0.f};
#pragma unroll
                for (int ai = 0; ai < 2; ++ai)
#pragma unroll
                    for (int m = 0; m < 4; ++m) acc[ai][bj][m][n] += bv; }
        f32x4 pre[4][2][2];
#pragma unroll
        for (int m = 0; m < 4; ++m) { const size_t off = (size_t)(u.pm * BM + wr * 64 + m * 16 + fr) * ldc + col0;
#pragma unroll
            for (int bj = 0; bj < 2; ++bj)
#pragma unroll
                for (int n = 0; n < 2; ++n) pre[m][bj][n] = *(const f32x4*)(base + off + bj * HALF + n * 16); }
        const bool bad = st.run(acc, u, wr, wc, fr, fq, lds, wid, lane) || poison != 0u;
        const float qnan = __builtin_nanf("");
#pragma unroll
        for (int ai = 0; ai < 2; ++ai)
#pragma unroll
            for (int m = 0; m < 4; ++m) { const int r = ai * HALF + wr * 64 + m * 16 + fr; const f32x2v sr = S[r]; const size_t off = (size_t)(u.pm * BM + r) * ldc + col0;
#pragma unroll
                for (int bj = 0; bj < 2; ++bj)
#pragma unroll
                    for (int n = 0; n < 2; ++n) { const f32x4 bs = ai == 0 ? pre[m][bj][n] : *(const f32x4*)(base + off + bj * HALF + n * 16); f32x4 o = bs + (acc[ai][bj][m][n] - sr.x) * sr.y;
                        if (bad) o = (f32x4){qnan, qnan, qnan, qnan}; *(f32x4*)(out + off + bj * HALF + n * 16) = o; }
                if (m & 1) asm volatile("" ::: "memory"); }
    }
};
struct EpiLnResLn {
    static constexpr bool PERM = false, AFTER_DRAIN = true;
    const float* base; float* out; bf16_t* xn; int ldc; const float* bias; PanelStats st1, st2; unsigned poison;
    __device__ __forceinline__ void fused(f32x4 (&acc)[2][2][4][2], const Unit& u, int wr, int wc, int fr, int fq, PG8_LAS unsigned char* lds, int wid, int lane) const {
        typedef float f32x2v __attribute__((ext_vector_type(2))); typedef unsigned u32x2v __attribute__((ext_vector_type(2)));
        const PG8_LAS f32x2v* S = (const PG8_LAS f32x2v*)(lds + 8192);
        const int col0 = u.pn * BM + wc * 32 + 4 * fq;
#pragma unroll
        for (int bj = 0; bj < 2; ++bj)
#pragma unroll
            for (int n = 0; n < 2; ++n) { const f32x4 bv = bias ? *(const f32x4*)(bias + col0 + bj * HALF + n * 16) : (f32x4){0.f, 0.f, 0.f, 0.f};
#pragma unroll
                for (int ai = 0; ai < 2; ++ai)
#pragma unroll
                    for (int m = 0; m < 4; ++m) acc[ai][bj][m][n] += bv; }
        bool bad = st1.run(acc, u, wr, wc, fr, fq, lds, wid, lane) || poison != 0u;
        const float qnan = __builtin_nanf("");
#pragma unroll
        for (int ai = 0; ai < 2; ++ai)
#pragma unroll
            for (int m = 0; m < 4; ++m) { const int r = ai * HALF + wr * 64 + m * 16 + fr; const f32x2v sr = S[r]; const size_t off = (size_t)(u.pm * BM + r) * ldc + col0;
#pragma unroll
                for (int bj = 0; bj < 2; ++bj)
#pragma unroll
                    for (int n = 0; n < 2; ++n) { const f32x4 bs = *(const f32x4*)(base + off + bj * HALF + n * 16); acc[ai][bj][m][n] = bs + (acc[ai][bj][m][n] - sr.x) * sr.y; }
                asm volatile("" : "+v"(acc[ai][0][m][0]), "+v"(acc[ai][0][m][1]), "+v"(acc[ai][1][m][0]), "+v"(acc[ai][1][m][1]));
                if (m & 1) asm volatile("" ::: "memory"); }
        const bool bad1 = bad;
        bad = st2.run(acc, u, wr, wc, fr, fq, lds, wid, lane) || bad;
#pragma unroll
        for (int ai = 0; ai < 2; ++ai)
#pragma unroll
            for (int m = 0; m < 4; ++m) { const int r = ai * HALF + wr * 64 + m * 16 + fr; const f32x2v sr = S[r]; const size_t off = (size_t)(u.pm * BM + r) * ldc + col0;
#pragma unroll
                for (int bj = 0; bj < 2; ++bj)
#pragma unroll
                    for (int n = 0; n < 2; ++n) { const f32x4 x1 = acc[ai][bj][m][n]; *(f32x4*)(out + off + bj * HALF + n * 16) = bad1 ? (f32x4){qnan, qnan, qnan, qnan} : x1;
                        const f32x4 o = (x1 - sr.x) * sr.y; u32x2v w; w.x = cvt_pk_bf16(o[0], o[1]); w.y = cvt_pk_bf16(o[2], o[3]);
                        if (bad) { w.x = 0x7fc07fc0u; w.y = 0x7fc07fc0u; } *(u32x2v*)(xn + off + bj * HALF + n * 16) = w; }
                asm volatile("" ::: "memory"); }
    }
};

template <class Epi, class Sched, bool ALIGN_EPI = false, bool SP2 = false>
__device__ __forceinline__ void gemm_phase(PG8_LAS unsigned char* lds, const Gemm g, const Sched& S, const Epi& E) {
    const int tid = threadIdx.x, wid = __builtin_amdgcn_readfirstlane(tid >> 6), lane = tid & 63, wr = wid >> 2, wc = wid & 3, fr = lane & 15, fq = lane >> 4;
    const int K = g.K, nt = K / BK;
    unsigned voffA[2], voffB[2];
#pragma unroll
    for (int i = 0; i < 2; ++i) { int R, C; stage_rc(tid * 16 + i * 8192, R, C); const int Rb = Epi::PERM ? ((R & ~31) + perm32(R & 31)) : R;
        voffA[i] = (unsigned)(R * K + C) * 2u; voffB[i] = (unsigned)(Rb * K + C) * 2u; }
    const size_t kstep = (size_t)(BK * 2);
    const size_t hstep = (size_t)HALF * K * 2;
    const size_t tstep = 2 * hstep;
    const unsigned ldsw = (unsigned)wid * 1024u;
    const int aoff = lds_byte(wr * 64 + fr, fq * 8), boff = lds_byte(wc * 32 + fr, fq * 8);
#define PG8_SA(b, h) (((b) * 2 + (h)) * HTB)
#define PG8_SB(b, h) ((4 + (b) * 2 + (h)) * HTB)
#define PG8_STAGE(bufoff, gbase, voff) do { _Pragma("unroll") for (int _i = 0; _i < 2; ++_i) \
        __builtin_amdgcn_global_load_lds((const unsigned*)((const char*)(gbase) + (voff)[_i]), (PG8_LAS unsigned*)(lds + (bufoff) + ldsw + _i * 8192), 16, 0, 0); } while (0)
#define PG8_LDA(dst, b, h) do { _Pragma("unroll") for (int m = 0; m < 4; ++m) _Pragma("unroll") for (int k = 0; k < 2; ++k) dst[m][k] = *(const PG8_LAS bf16x8*)(lds + PG8_SA(b, h) + aoff + m * 2048 + k * 1024); } while (0)
#define PG8_LDB(dst, b, h) do { _Pragma("unroll") for (int n = 0; n < 2; ++n) _Pragma("unroll") for (int k = 0; k < 2; ++k) dst[n][k] = *(const PG8_LAS bf16x8*)(lds + PG8_SB(b, h) + boff + n * 2048 + k * 1024); } while (0)
#define PG8_MMA(ai, bj, At, Bt) do { __builtin_amdgcn_s_setprio(1); _Pragma("unroll") for (int m = 0; m < 4; ++m) _Pragma("unroll") for (int n = 0; n < 2; ++n) _Pragma("unroll") for (int k = 0; k < 2; ++k) \
        acc[ai][bj][m][n] = __builtin_amdgcn_mfma_f32_16x16x32_bf16(Bt[n][k], At[m][k], acc[ai][bj][m][n], 0, 0, 0); __builtin_amdgcn_s_setprio(0); } while (0)
#define PG8_WAIT_V(n) asm volatile("s_waitcnt vmcnt(" #n ")" ::: "memory")
#define PG8_WAIT_L(n) asm volatile("s_waitcnt lgkmcnt(" #n ")" ::: "memory")
#define PG8_BAR __builtin_amdgcn_s_barrier()
#define PG8_SCHED __builtin_amdgcn_sched_barrier(0)
    Unit cur, nxt; int ui = 0;
    if (!S.next(0, cur)) return;
    f32x4 acc[2][2][4][2];
#pragma unroll
    for (int a = 0; a < 2; ++a)
#pragma unroll
        for (int b = 0; b < 2; ++b)
#pragma unroll
            for (int m = 0; m < 4; ++m)
#pragma unroll
                for (int n = 0; n < 2; ++n) acc[a][b][m][n] = (f32x4){0.f, 0.f, 0.f, 0.f};
    bf16x8 At[4][2], B0[2][2], B1[2][2];
    const char* cA = (const char*)g.A + (size_t)cur.pm * tstep; const char* cB = (const char*)g.Bt + (size_t)cur.pn * tstep;
    S.a_ready(cur);
    if constexpr (SP2) {
        PG8_STAGE(PG8_SB(0, 0), cB, voffB); PG8_STAGE(PG8_SB(0, 1), cB + hstep, voffB); PG8_STAGE(PG8_SA(0, 0), cA, voffA); PG8_STAGE(PG8_SA(0, 1), cA + hstep, voffA);
        if (wr == 1) PG8_BAR;
        PG8_WAIT_V(2); PG8_BAR;
        PG8_STAGE(PG8_SB(1, 0), cB + kstep, voffB); PG8_STAGE(PG8_SA(1, 0), cA + kstep, voffA); PG8_STAGE(PG8_SB(1, 1), cB + hstep + kstep, voffB);
        PG8_WAIT_V(6); PG8_BAR;
    } else {
        PG8_STAGE(PG8_SB(0, 0), cB, voffB); PG8_STAGE(PG8_SA(0, 0), cA, voffA); PG8_STAGE(PG8_SB(0, 1), cB + hstep, voffB); PG8_STAGE(PG8_SA(0, 1), cA + hstep, voffA);
        if (wr == 1) PG8_BAR;
        PG8_WAIT_V(4); PG8_BAR;
        PG8_STAGE(PG8_SB(1, 0), cB + kstep, voffB); PG8_STAGE(PG8_SA(1, 0), cA + kstep, voffA); PG8_STAGE(PG8_SB(1, 1), cB + hstep + kstep, voffB);
        PG8_WAIT_V(6); PG8_BAR;
    }
    int t_mid = nt >> 1; if constexpr (Epi::MIDK) asm volatile("" : "+s"(t_mid));
    for (;;) {
        const bool has_next = S.next(ui + 1, nxt);
        const char* nA = has_next ? (const char*)g.A + (size_t)nxt.pm * tstep : cA; const char* nB = has_next ? (const char*)g.Bt + (size_t)nxt.pn * tstep : cB;
        for (int t = 0; t < nt; t += 2) {
            const bool last = (t == nt - 2);
            if constexpr (Epi::MIDK) { if (t == t_mid) E.midk(acc, cur, wr, fr); }
            const char* a1 = cA + (size_t)(t + 1) * kstep;
            const char* a2 = last ? nA : cA + (size_t)(t + 2) * kstep; const char* b2 = last ? nB : cB + (size_t)(t + 2) * kstep;
            const char* a3 = a2 + kstep; const char* b3 = b2 + kstep;
            if (last && has_next) S.a_ready(nxt);
            if constexpr (SP2) {
            PG8_LDB(B0, 0, 0); PG8_LDB(B1, 0, 1); PG8_SCHED; PG8_LDA(At, 0, 0); PG8_STAGE(PG8_SA(1, 1), a1 + hstep, voffA);
            PG8_WAIT_V(8); PG8_WAIT_L(0); PG8_BAR; PG8_MMA(0, 0, At, B0); PG8_MMA(0, 1, At, B1); PG8_BAR; PG8_SCHED;
            PG8_LDA(At, 0, 1); PG8_STAGE(PG8_SB(0, 0), b2, voffB); PG8_STAGE(PG8_SB(0, 1), b2 + hstep, voffB); PG8_STAGE(PG8_SA(0, 0), a2, voffA);
            PG8_WAIT_V(8); PG8_WAIT_L(0); PG8_BAR; PG8_MMA(1, 0, At, B0); PG8_MMA(1, 1, At, B1); PG8_BAR; PG8_SCHED;
            PG8_LDB(B0, 1, 0); PG8_LDB(B1, 1, 1); PG8_SCHED; PG8_LDA(At, 1, 0); PG8_STAGE(PG8_SA(0, 1), a2 + hstep, voffA);
            PG8_WAIT_V(8); PG8_WAIT_L(0); PG8_BAR; PG8_MMA(0, 0, At, B0); PG8_MMA(0, 1, At, B1); PG8_BAR; PG8_SCHED;
            PG8_LDA(At, 1, 1); PG8_STAGE(PG8_SB(1, 0), b3, voffB); PG8_STAGE(PG8_SB(1, 1), b3 + hstep, voffB); PG8_STAGE(PG8_SA(1, 0), a3, voffA);
            PG8_WAIT_V(8); PG8_WAIT_L(0); PG8_BAR; PG8_MMA(1, 0, At, B0); PG8_MMA(1, 1, At, B1); PG8_BAR; PG8_SCHED;
            } else {
            PG8_LDB(B0, 0, 0); PG8_SCHED; PG8_LDA(At, 0, 0); PG8_STAGE(PG8_SA(1, 1), a1 + hstep, voffA);
            PG8_WAIT_L(8); PG8_BAR; PG8_WAIT_L(0); PG8_MMA(0, 0, At, B0); PG8_BAR; PG8_SCHED;
            PG8_LDB(B1, 0, 1); PG8_STAGE(PG8_SB(0, 0), b2, voffB);
            PG8_BAR; PG8_WAIT_L(0); PG8_MMA(0, 1, At, B1); PG8_BAR;
            PG8_LDA(At, 0, 1); PG8_STAGE(PG8_SA(0, 0), a2, voffA);
            PG8_BAR; PG8_WAIT_L(0); PG8_MMA(1, 0, At, B0); PG8_BAR; PG8_SCHED;
            PG8_STAGE(PG8_SB(0, 1), b2 + hstep, voffB);
            PG8_WAIT_V(6); PG8_BAR; PG8_MMA(1, 1, At, B1); PG8_BAR;
            PG8_LDB(B0, 1, 0); PG8_SCHED; PG8_LDA(At, 1, 0); PG8_STAGE(PG8_SA(0, 1), a2 + hstep, voffA);
            PG8_WAIT_L(8); PG8_BAR; PG8_WAIT_L(0); PG8_MMA(0, 0, At, B0); PG8_BAR; PG8_SCHED;
            PG8_LDB(B1, 1, 1); PG8_STAGE(PG8_SB(1, 0), b3, voffB);
            PG8_BAR; PG8_WAIT_L(0); PG8_MMA(0, 1, At, B1); PG8_BAR;
            PG8_LDA(At, 1, 1); PG8_STAGE(PG8_SA(1, 0), a3, voffA);
            PG8_BAR; PG8_WAIT_L(0); PG8_MMA(1, 0, At, B0); PG8_BAR; PG8_SCHED;
            PG8_STAGE(PG8_SB(1, 1), b3 + hstep, voffB);
            PG8_WAIT_V(6); PG8_BAR; PG8_MMA(1, 1, At, B1); PG8_BAR;
            }
        }
        if constexpr (ALIGN_EPI) { if (wr == 0) PG8_BAR; }
        if constexpr (!Epi::AFTER_DRAIN) { E(acc, cur, wr, wc, fr, fq); S.done(cur); }
        if (!has_next) break;
#pragma unroll
        for (int a = 0; a < 2; ++a)
#pragma unroll
            for (int b = 0; b < 2; ++b)
#pragma unroll
                for (int m = 0; m < 4; ++m)
#pragma unroll
                    for (int n = 0; n < 2; ++n) acc[a][b][m][n] = (f32x4){0.f, 0.f, 0.f, 0.f};
        cur = nxt; cA = nA; cB = nB; ++ui;
        if constexpr (ALIGN_EPI) { if (wr == 1) PG8_BAR; }
    }
    PG8_WAIT_V(0);
    if constexpr (!ALIGN_EPI) { if (wr == 0) PG8_BAR; }
    PG8_BAR;
    if constexpr (Epi::AFTER_DRAIN) { E.fused(acc, cur, wr, wc, fr, fq, lds, wid, lane); S.done(cur); }
#undef PG8_SA
#undef PG8_SB
#undef PG8_STAGE
#undef PG8_LDA
#undef PG8_LDB
#undef PG8_MMA
#undef PG8_WAIT_V
#undef PG8_WAIT_L
#undef PG8_BAR
#undef PG8_SCHED
}
}


#ifndef MK_N_LAUNCHES
#define MK_N_LAUNCHES 1
#endif
constexpr int N_PHASES = 9;
constexpr int NWAVES = 8;

constexpr int DM = 2048, BATCH = 4, SEQ = 4096, NTOK = BATCH * SEQ, NMETA = 16;
constexpr int MPAD = 16640, NTILE_X = MPAD / 256;
constexpr int N_QK = 3328, NT_QK = N_QK / 256;
constexpr int N_V = 1280, NT_V = N_V / 256;
constexpr int NT_W = NT_QK + NT_V;
constexpr int P1_UNITS_A = NTILE_X * NT_QK, P1_UNITS = P1_UNITS_A + NT_V * NTILE_X;
constexpr int NEXP = 64, DEXP = 512, MAXTILES = 192, SPAD = MAXTILES * 256;
constexpr float RMS_EPS = 1e-6f;
constexpr float LOG2E = 1.4426950408889634f;
constexpr float C2 = 0.125f * LOG2E;
constexpr float SB_EXIT = -150.0f;

constexpr size_t MiB = 1u << 20;
constexpr size_t WS_CTL = 0, CTL_ZERO_BYTES = 128 * 1024;
constexpr size_t WS_BIG = 1 * MiB;
constexpr size_t WS_QS = 84 * MiB, WS_KS = WS_QS + (size_t)MPAD * 1024 * 2, WS_QW = WS_KS + (size_t)MPAD * 1024 * 2, WS_KW = WS_QW + (size_t)MPAD * 1024 * 2;
constexpr size_t WS_VT = 190 * MiB;
constexpr size_t WS_MIXED = 231 * MiB, WS_HB = 295 * MiB;
constexpr size_t WS_Y = 1 * MiB;
constexpr size_t WS_PROJ = 359 * MiB;
constexpr size_t WS_HDN = 423 * MiB;
constexpr size_t WS_WOUT = 471 * MiB, WS_WR = 479 * MiB;
constexpr size_t WS_WGU = 480 * MiB, WS_WD = 736 * MiB;
constexpr size_t WS_LIST = 864 * MiB, WS_GATEW = 868 * MiB, WS_TOKINFO = 872 * MiB, WS_RSTD = 873 * MiB, WS_RSTDW = 874 * MiB;
constexpr size_t WS_RINV = 877 * MiB;
constexpr size_t WS_SSQ = 878 * MiB;
constexpr size_t WS_END = 880 * MiB;
static_assert(WS_RSTDW + (size_t)NEXP * NTOK * 4 <= WS_END, "ws map 4");
static_assert(WS_KW + (size_t)MPAD * 256 * 2 <= WS_VT && WS_VT + (size_t)N_V * MPAD * 2 <= WS_MIXED , "ws map 1");
static_assert(WS_Y + (size_t)SPAD * 2048 * 2 <= WS_MIXED && WS_HDN + (size_t)SPAD * 512 * 2 <= WS_WOUT && WS_HB + (size_t)NTOK * 2048 * 2 <= WS_HDN, "ws map 2");
static_assert(WS_BIG + (size_t)(NTILE_X + NT_W) * 256 * 2048 * 2 <= WS_QS, "ws map 3");
constexpr int CW_TMO = 0, CW_BAR = 4096, CW_CNT = 16384;

constexpr int RING_OFF = 0, RING_BYTES = 131072;
constexpr int MISC_OFF = RING_BYTES;
constexpr int TBL_OFF = MISC_OFF + 256;
constexpr int TBL_TSTART = 0, TBL_NT = 65, TBL_TE = 66, TBL_CNTS = 66 + MAXTILES, TBL_WORDS = 66 + MAXTILES + 64;
constexpr int TOKBUF_OFF = MISC_OFF + 4096;
constexpr int ATT_TBR_OFF = TOKBUF_OFF + 6144;
constexpr int LDS_BYTES = 163840;
static_assert(TBL_OFF + TBL_WORDS * 4 <= TOKBUF_OFF && TOKBUF_OFF + 6144 <= LDS_BYTES && ATT_TBR_OFF + 16 * 192 * 4 <= LDS_BYTES, "LDS map");

#define LAS __attribute__((address_space(3)))
typedef unsigned short bf16;
typedef unsigned v4u __attribute__((ext_vector_type(4)));
typedef unsigned v2u __attribute__((ext_vector_type(2)));
typedef float f32x4 __attribute__((ext_vector_type(4)));
typedef float f32x16 __attribute__((ext_vector_type(16)));
typedef short bf16x8 __attribute__((ext_vector_type(8)));
typedef _Float16 f16x8 __attribute__((ext_vector_type(8)));
typedef _Float16 f16x2 __attribute__((ext_vector_type(2)));
typedef float f32x2 __attribute__((ext_vector_type(2)));
typedef __bf16 bf16x2_t __attribute__((ext_vector_type(2)));
#define LDS_WAIT() asm volatile("s_waitcnt lgkmcnt(0)" ::: "memory")
#define VM_WAIT() asm volatile("s_waitcnt vmcnt(0)" ::: "memory")
__device__ __forceinline__ unsigned pk2(float lo, float hi) { f32x2 v = {lo, hi}; bf16x2_t b = __builtin_convertvector(v, bf16x2_t); return __builtin_bit_cast(unsigned, b); }
__device__ __forceinline__ float bf_lo(unsigned u) { return __uint_as_float(u << 16); }
__device__ __forceinline__ float bf_hi(unsigned u) { return __uint_as_float(u & 0xffff0000u); }
__device__ __forceinline__ float wave_sum(float v) {
#pragma unroll
    for (int o = 1; o < 64; o <<= 1) v += __shfl_xor(v, o);
    return v;
}
__device__ __forceinline__ int crow(int reg, int h) { return (reg & 3) + 8 * (reg >> 2) + 4 * h; }

#define XB_TMO      128
#define XB_XCNT(j)  (256  + 64 * (j))
#define XB_XSUB(j)  (1280 + 64 * (j))
#define XB_XGEN(j)  (2304 + 64 * (j))
#define XB_TOP      3328
#define XB_TOPGEN   3392
#define XCD_BAR_WORDS 3456
#define XB_SPIN_CAP (1u << 18)

__device__ __forceinline__ unsigned xb_ld(unsigned* p)              { return __hip_atomic_load(p, __ATOMIC_RELAXED, __HIP_MEMORY_SCOPE_AGENT); }
__device__ __forceinline__ unsigned xb_add(unsigned* p, unsigned v) { return __hip_atomic_fetch_add(p, v, __ATOMIC_RELAXED, __HIP_MEMORY_SCOPE_AGENT); }
__device__ __forceinline__ unsigned xb_xcc_id() { return (unsigned)__builtin_amdgcn_s_getreg((3 << 11) | 20) & 0xFu; }
#define XB_SPIN(cond, bar) do { unsigned _sp = 0; while (cond) { __builtin_amdgcn_s_sleep(1); \
    if ((++_sp & 255u) == 0u) { if (xb_ld(&(bar)[XB_TMO])) break; if (_sp > XB_SPIN_CAP) { atomicAdd(&(bar)[XB_TMO], 1u); break; } } } } while (0)

struct XcdBarrier {
    unsigned* bar; unsigned x;
    volatile LAS unsigned* st;
};

__device__ __forceinline__ XcdBarrier xcd_barrier_post(unsigned* bar, volatile LAS unsigned* st) {
    XcdBarrier b; b.bar = bar; b.x = xb_xcc_id(); b.st = st;
    if (threadIdx.x == 0) (void)xb_add(&bar[XB_XCNT(b.x)], 1u);
    return b;
}
__device__ __forceinline__ void xcd_barrier_complete(unsigned* bar, unsigned x, unsigned& nloc, unsigned& nx) {
    const unsigned G = gridDim.x * gridDim.y * gridDim.z;
    unsigned sum, cnt, mine, sp = 0u;
    for (;;) {
        sum = 0u; cnt = 0u; mine = 0u;
#pragma unroll
        for (unsigned j = 0; j < 16; ++j) { const unsigned c = xb_ld(&bar[XB_XCNT(j)]); sum += c; cnt += (c > 0u) ? 1u : 0u; mine = (j == x) ? c : mine; }
        if (sum == G) break;
        __builtin_amdgcn_s_sleep(1);
        if ((++sp & 255u) == 0u) { if (xb_ld(&bar[XB_TMO])) break; if (sp > XB_SPIN_CAP) { atomicAdd(&bar[XB_TMO], 1u); break; } }
    }
    nloc = mine > 0u ? mine : 1u; nx = cnt > 0u ? cnt : 1u;
}

__device__ __forceinline__ void xcd_barrier(const XcdBarrier& b) {
    asm volatile("s_waitcnt vmcnt(0)" ::: "memory");
    __syncthreads();
    if (threadIdx.x == 0) {
        unsigned* bar = b.bar;
        __builtin_amdgcn_s_waitcnt(0);
        unsigned nloc = b.st[0], nx = b.st[1];
        if (nloc == 0u) { xcd_barrier_complete(bar, b.x, nloc, nx); b.st[0] = nloc; b.st[1] = nx; }
        const unsigned old = xb_add(&bar[XB_XSUB(b.x)], 1u);
        const unsigned gen = old / nloc;
        if (old + 1u == (gen + 1u) * nloc) {
            __builtin_amdgcn_fence(__ATOMIC_RELEASE, "agent");
            asm volatile("s_waitcnt vmcnt(0)" ::: "memory");
            const unsigned og = xb_add(&bar[XB_TOP], 1u);
            const unsigned tg = og / nx;
            if (og + 1u == (tg + 1u) * nx) xb_add(&bar[XB_TOPGEN], 1u);
            else XB_SPIN(xb_ld(&bar[XB_TOPGEN]) == tg, bar);
            __builtin_amdgcn_fence(__ATOMIC_ACQUIRE, "agent");
            xb_add(&bar[XB_XGEN(b.x)], 1u);
            asm volatile("s_waitcnt vmcnt(0)" ::: "memory");
        } else {
            XB_SPIN(xb_ld(&bar[XB_XGEN(b.x)]) == gen, bar);
            __builtin_amdgcn_fence(__ATOMIC_ACQUIRE, "agent");
            asm volatile("s_waitcnt vmcnt(0)" ::: "memory");
        }
    }
    __syncthreads();
}


struct Args { const float* in[19]; float* out; unsigned char* ws; int ph_lo, ph_hi, li, pad; };
struct Frame {
    LAS unsigned char* lds; unsigned* ctl; unsigned char* ws;
    int tid, lane, wave, vcu, G;
    const float* const* in; float* out;
};

struct TrItem { f32x4 v[16]; f32x4 g[4]; };
__device__ __forceinline__ void tr_load(TrItem& t, const float* srcp, int ldsrc, const float* gp) {
#pragma unroll
    for (int i = 0; i < 16; ++i) t.v[i] = __builtin_nontemporal_load((const f32x4*)(srcp + (size_t)i * ldsrc));
    if (gp) {
#pragma unroll
        for (int i = 0; i < 4; ++i) t.g[i] = *(const f32x4*)(gp + 4 * i);
    } else {
#pragma unroll
        for (int i = 0; i < 4; ++i) t.g[i] = (f32x4){1.f, 1.f, 1.f, 1.f};
    }
}
__device__ __forceinline__ void tr_store(const TrItem& t, bf16* dstp, int ldd) {
#pragma unroll
    for (int j = 0; j < 4; ++j)
#pragma unroll
        for (int c = 0; c < 2; ++c) {
            v4u o;
            o.x = pk2(t.v[8 * c + 0][j] * t.g[2 * c][0], t.v[8 * c + 1][j] * t.g[2 * c][1]); o.y = pk2(t.v[8 * c + 2][j] * t.g[2 * c][2], t.v[8 * c + 3][j] * t.g[2 * c][3]);
            o.z = pk2(t.v[8 * c + 4][j] * t.g[2 * c + 1][0], t.v[8 * c + 5][j] * t.g[2 * c + 1][1]); o.w = pk2(t.v[8 * c + 6][j] * t.g[2 * c + 1][2], t.v[8 * c + 7][j] * t.g[2 * c + 1][3]);
            *(v4u*)(dstp + (size_t)j * ldd + 8 * c) = o;
        }
}
__device__ __forceinline__ int win_src_col(int P) {
    if (P < 2048) return P;
    if (P < 3328) { const int p = P - 2048, t = p >> 8, pp = p & 255, bj = pp >> 7, wc = (pp & 127) >> 5, i = pp & 31; return (t < 4 ? 3072 + t * 256 : 4096) + 64 * wc + 32 * bj + i; }
    if (P < 4352) return 2048 + (P - 3328);
    return P;
}
__device__ __forceinline__ float rms_row_to_bf16(const float* xrow, bf16* orow, int lane) {
    const f32x4* xr = (const f32x4*)xrow + lane;
    f32x4 v[8]; float s = 0.f;
#pragma unroll
    for (int j = 0; j < 8; ++j) { v[j] = xr[64 * j]; s += (v[j].x * v[j].x + v[j].y * v[j].y) + (v[j].z * v[j].z + v[j].w * v[j].w); }
    const float rinv = sqrtf(wave_sum(s) * (1.f / DM) + RMS_EPS), rstd = 1.0f / rinv;
    v2u* o8 = (v2u*)orow + lane;
#pragma unroll
    for (int j = 0; j < 8; ++j) { v2u w; w.x = pk2(v[j].x * rstd, v[j].y * rstd); w.y = pk2(v[j].z * rstd, v[j].w * rstd); o8[64 * j] = w; }
    return rinv;
}
constexpr int I_IN = 32 * 72, I_OUT = 32 * 32, I_GU = NEXP * 32 * 16, I_D = NEXP * 8 * 32;
constexpr int NITEMS = I_IN + I_OUT + I_GU + I_D;
constexpr int TAIL1_PER_WAVE = 8, TAIL6_PER_WAVE = 9, TAIL6_ITEMS = 9216;
#ifndef P2_ITEMS_DEF
#define P2_ITEMS_DEF 32896
#endif
constexpr int P2_ITEMS = P2_ITEMS_DEF;
#ifndef ATT_WAVES_DEF
#define ATT_WAVES_DEF 4
#endif
constexpr int ATT_WAVES = ATT_WAVES_DEF;
__device__ __forceinline__ void conv_range(Frame& F, int it0, int step, int end) {
    bf16* WIN = (bf16*)(F.ws + WS_BIG) + (size_t)MPAD * DM;
    const float* ln_mix = F.in[3]; const float* w_in = F.in[4];
    const float* on_sb = F.in[8]; const float* on_sw = F.in[9]; const float* w_out = F.in[10]; const float* ln_ffn = F.in[11];
    const float* w_gate = F.in[16]; const float* w_up = F.in[17]; const float* w_down = F.in[18];
    bf16* WOUT = (bf16*)(F.ws + WS_WOUT); bf16* WGU = (bf16*)(F.ws + WS_WGU); bf16* WD = (bf16*)(F.ws + WS_WD);
    const int kr = F.lane >> 4, nq = F.lane & 15;
#define P0_ITEM(it, SRCP, LDS_, GP, DSTP, LDD) do { int r_ = (it); \
        if (r_ < I_IN) { const int kb = r_ / 72, nb = r_ % 72, k0 = 64 * kb + 16 * kr; SRCP = w_in + (size_t)k0 * 4608 + win_src_col(64 * nb + 4 * nq); LDS_ = 4608; GP = ln_mix + k0; DSTP = WIN + (size_t)(64 * nb + 4 * nq) * DM + k0; LDD = DM; } \
        else if ((r_ -= I_IN) < I_OUT) { const int kb = r_ >> 5, nb = r_ & 31, k0 = 64 * kb + 16 * kr; SRCP = w_out + (size_t)k0 * DM + 64 * nb + 4 * nq; LDS_ = DM; GP = (k0 < 1024 ? on_sb + k0 : on_sw + (k0 - 1024)); DSTP = WOUT + (size_t)(64 * nb + 4 * nq) * DM + k0; LDD = DM; } \
        else if ((r_ -= I_OUT) < I_GU) { const int e = r_ >> 9, q = r_ & 511, kb = q >> 4, nb = q & 15, k0 = 64 * kb + 16 * kr, nt = nb >> 2, bj = (nb >> 1) & 1, j0 = (nb & 1) * 64; \
            SRCP = (bj ? w_up : w_gate) + (size_t)e * DM * DEXP + (size_t)k0 * DEXP + nt * 128 + j0 + 4 * nq; LDS_ = DEXP; GP = ln_ffn + k0; DSTP = WGU + ((size_t)e * 1024 + 64 * nb + 4 * nq) * DM + k0; LDD = DM; } \
        else { r_ -= I_GU; const int e = r_ >> 8, q = r_ & 255, kb = q >> 5, nb = q & 31, k0 = 64 * kb + 16 * kr; \
            SRCP = w_down + (size_t)e * DEXP * DM + (size_t)k0 * DM + 64 * nb + 4 * nq; LDS_ = DM; GP = nullptr; DSTP = WD + ((size_t)e * 2048 + 64 * nb + 4 * nq) * DEXP + k0; LDD = DEXP; } } while (0)
    {
        TrItem cur; const float* sp; const float* gp; bf16* dp; int lds_, ldd; bf16* dpn; int lddn;
        int it = it0;
        if (it < end) { P0_ITEM(it, sp, lds_, gp, dp, ldd); tr_load(cur, sp, lds_, gp); }
        while (it < end) {
            const int itn = it + step; TrItem nxt;
            if (itn < end) { P0_ITEM(itn, sp, lds_, gp, dpn, lddn); tr_load(nxt, sp, lds_, gp); }
            tr_store(cur, dp, ldd);
            if (itn < end) { cur = nxt; dp = dpn; ldd = lddn; }
            it = itn;
        }
    }
#undef P0_ITEM
}
__device__ __forceinline__ void conv_range3(Frame& F, int it0, int step, int end) {
    bf16* WIN = (bf16*)(F.ws + WS_BIG) + (size_t)MPAD * DM;
    const float* ln_mix = F.in[3]; const float* w_in = F.in[4];
    const float* on_sb = F.in[8]; const float* on_sw = F.in[9]; const float* w_out = F.in[10]; const float* ln_ffn = F.in[11];
    const float* w_gate = F.in[16]; const float* w_up = F.in[17]; const float* w_down = F.in[18];
    bf16* WOUT = (bf16*)(F.ws + WS_WOUT); bf16* WGU = (bf16*)(F.ws + WS_WGU); bf16* WD = (bf16*)(F.ws + WS_WD);
    const int kr = F.lane >> 4, nq = F.lane & 15;
#define P0_ITEM(it, SRCP, LDS_, GP, DSTP, LDD) do { int r_ = (it); \
        if (r_ < I_IN) { const int kb = r_ / 72, nb = r_ % 72, k0 = 64 * kb + 16 * kr; SRCP = w_in + (size_t)k0 * 4608 + win_src_col(64 * nb + 4 * nq); LDS_ = 4608; GP = ln_mix + k0; DSTP = WIN + (size_t)(64 * nb + 4 * nq) * DM + k0; LDD = DM; } \
        else if ((r_ -= I_IN) < I_OUT) { const int kb = r_ >> 5, nb = r_ & 31, k0 = 64 * kb + 16 * kr; SRCP = w_out + (size_t)k0 * DM + 64 * nb + 4 * nq; LDS_ = DM; GP = (k0 < 1024 ? on_sb + k0 : on_sw + (k0 - 1024)); DSTP = WOUT + (size_t)(64 * nb + 4 * nq) * DM + k0; LDD = DM; } \
        else if ((r_ -= I_OUT) < I_GU) { const int e = r_ >> 9, q = r_ & 511, kb = q >> 4, nb = q & 15, k0 = 64 * kb + 16 * kr, nt = nb >> 2, bj = (nb >> 1) & 1, j0 = (nb & 1) * 64; \
            SRCP = (bj ? w_up : w_gate) + (size_t)e * DM * DEXP + (size_t)k0 * DEXP + nt * 128 + j0 + 4 * nq; LDS_ = DEXP; GP = ln_ffn + k0; DSTP = WGU + ((size_t)e * 1024 + 64 * nb + 4 * nq) * DM + k0; LDD = DM; } \
        else { r_ -= I_GU; const int e = r_ >> 8, q = r_ & 255, kb = q >> 5, nb = q & 31, k0 = 64 * kb + 16 * kr; \
            SRCP = w_down + (size_t)e * DEXP * DM + (size_t)k0 * DM + 64 * nb + 4 * nq; LDS_ = DM; GP = nullptr; DSTP = WD + ((size_t)e * 2048 + 64 * nb + 4 * nq) * DEXP + k0; LDD = DEXP; } } while (0)
    struct V16 { f32x4 v[16]; };
#define C3_LOAD(B, it) do { if ((it) < end) { const float* sp_; const float* gp_; bf16* dp_; int ls_, ld_; P0_ITEM((it), sp_, ls_, gp_, dp_, ld_); (void)gp_; (void)dp_; (void)ld_; \
        _Pragma("unroll") for (int i_ = 0; i_ < 16; ++i_) B.v[i_] = __builtin_nontemporal_load((const f32x4*)(sp_ + (size_t)i_ * ls_)); } } while (0)
#define C3_STORE(B, it) do { if ((it) < end) { const float* sp_; const float* gp_; bf16* dp_; int ls_, ld_; P0_ITEM((it), sp_, ls_, gp_, dp_, ld_); (void)sp_; (void)ls_; \
        f32x4 g_[4]; _Pragma("unroll") for (int i_ = 0; i_ < 4; ++i_) g_[i_] = gp_ ? *(const f32x4*)(gp_ + 4 * i_) : (f32x4){1.f, 1.f, 1.f, 1.f}; \
        _Pragma("unroll") for (int j_ = 0; j_ < 4; ++j_) _Pragma("unroll") for (int c_ = 0; c_ < 2; ++c_) { v4u o_; \
            o_.x = pk2(B.v[8 * c_ + 0][j_] * g_[2 * c_][0], B.v[8 * c_ + 1][j_] * g_[2 * c_][1]); o_.y = pk2(B.v[8 * c_ + 2][j_] * g_[2 * c_][2], B.v[8 * c_ + 3][j_] * g_[2 * c_][3]); \
            o_.z = pk2(B.v[8 * c_ + 4][j_] * g_[2 * c_ + 1][0], B.v[8 * c_ + 5][j_] * g_[2 * c_ + 1][1]); o_.w = pk2(B.v[8 * c_ + 6][j_] * g_[2 * c_ + 1][2], B.v[8 * c_ + 7][j_] * g_[2 * c_ + 1][3]); \
            *(v4u*)(dp_ + (size_t)j_ * ld_ + 8 * c_) = o_; } } } while (0)
    {
        V16 A, B, C; int it = it0;
        C3_LOAD(A, it); C3_LOAD(B, it + step);
        while (it < end) {
            C3_LOAD(C, it + 2 * step); C3_STORE(A, it);
            C3_LOAD(A, it + 3 * step); C3_STORE(B, it + step);
            C3_LOAD(B, it + 4 * step); C3_STORE(C, it + 2 * step);
            it += 3 * step;
        }
    }
#undef C3_LOAD
#undef C3_STORE
#undef P0_ITEM
}
__device__ __forceinline__ int tail1_items(int G) { const int rounds = (P1_UNITS + G - 1) / G, nidle = rounds * G - P1_UNITS; return nidle * NWAVES * TAIL1_PER_WAVE; }
__device__ __forceinline__ void p0_prologue(Frame& F) {
    const int gw = F.vcu * NWAVES + F.wave, NGW = F.G * NWAVES;
    if (blockIdx.x == 0 && F.tid < NEXP) __hip_atomic_store(F.ctl + CW_CNT + 16 * F.tid, 0u, __ATOMIC_RELAXED, __HIP_MEMORY_SCOPE_AGENT);
    bf16* BIG = (bf16*)(F.ws + WS_BIG);
    bf16* WIN = BIG + (size_t)MPAD * DM;
    const float* x = F.in[0]; const float* meta = F.in[1]; const float* ln_mix = F.in[3]; const float* w_in = F.in[4];
    const float* on_sb = F.in[8]; const float* on_sw = F.in[9]; const float* w_out = F.in[10]; const float* ln_ffn = F.in[11];
    const float* w_rg = F.in[12]; const float* w_re = F.in[14]; const float* w_gate = F.in[16]; const float* w_up = F.in[17]; const float* w_down = F.in[18];
    for (int m = gw; m < MPAD; m += NGW) {
        bf16* orow = BIG + (size_t)m * DM;
        if (m < NTOK) { const float ri = rms_row_to_bf16(x + (size_t)m * DM, orow, F.lane); if (F.lane == 0) ((float*)(F.ws + WS_RINV))[m] = ri; }
        else if (m < NTOK + NMETA) (void)rms_row_to_bf16(meta + (size_t)(m - NTOK) * DM, orow, F.lane);
        else { v4u z = {0u, 0u, 0u, 0u}; v4u* o = (v4u*)orow + F.lane;
#pragma unroll
            for (int j = 0; j < 4; ++j) o[64 * j] = z; }
    }
    conv_range(F, gw, NGW, NITEMS - TAIL6_ITEMS - tail1_items(F.G) - P2_ITEMS);
    bf16* WRH = (bf16*)(F.ws + WS_WR); bf16* WRL = WRH + 96 * DM;
    for (int idx = (F.vcu * NWAVES * 64 + F.tid); idx < 96 * DM; idx += F.G * NWAVES * 64) {
        const int c = idx / DM, k = idx % DM;
        float v = 0.f; if (c < 8) v = w_rg[k * 8 + c]; else if (c < 72) v = w_re[k * 64 + (c - 8)];
        v *= ln_ffn[k];
        const unsigned hi = pk2(v, 0.f) & 0xffffu; const float lo = v - __uint_as_float(hi << 16);
        const int fidx = ((((k >> 4) * 3 + (c >> 5)) * 64 + (((k >> 3) & 1) * 32 + (c & 31))) << 3) + (k & 7);
        WRH[fidx] = (bf16)hi; WRL[fidx] = (bf16)(pk2(lo, 0.f) & 0xffffu);
    }
}

struct P1Order {
    int G, c;
    __device__ bool next(int i, pg8::Unit& u) const {
        const int L = i * G + c; if (L >= P1_UNITS) return false;
        if (L < P1_UNITS_A) { u.pm = L / NT_QK; u.pn = NTILE_X + (L % NT_QK); }
        else { const int l = L - P1_UNITS_A; u.pm = NTILE_X + NT_QK + l / NTILE_X; u.pn = l % NTILE_X; }
        return true;
    }
    __device__ __forceinline__ void a_ready(const pg8::Unit&) const {}
    __device__ __forceinline__ void done(const pg8::Unit&) const {}
};
struct EpiQKV {
    static constexpr bool PERM = true, AFTER_DRAIN = false, MIDK = false;
    bf16 *QS, *KS, *QW, *KW, *VT; const float *q_norm, *k_norm;
    __device__ __forceinline__ void operator()(const pg8::f32x4 (&acc)[2][2][4][2], const pg8::Unit& u, int wr, int wc, int fr, int fq) const {
        using pg8::HALF;
        if (u.pm < NTILE_X) {
            const int t = u.pn - NTILE_X; const int row0 = u.pm * 256 + wr * 64 + fr;
            if (t < 8) {
                bf16* base = (t < 4) ? QS : KS; const float sc = (t < 4) ? C2 : 1.0f; const int col0 = (t & 3) * 256 + wc * 32 + 8 * fq;
#pragma unroll
                for (int ai = 0; ai < 2; ++ai)
#pragma unroll
                    for (int m = 0; m < 4; ++m) { bf16* rowp = base + (size_t)(row0 + ai * HALF + m * 16) * 1024 + col0;
#pragma unroll
                        for (int bj = 0; bj < 2; ++bj) { const pg8::f32x4 v0 = acc[ai][bj][m][0] * sc, v1 = acc[ai][bj][m][1] * sc;
                            v4u w; w.x = pk2(v0[0], v0[1]); w.y = pk2(v0[2], v0[3]); w.z = pk2(v1[0], v1[1]); w.w = pk2(v1[2], v1[3]); *(v4u*)(rowp + bj * HALF) = w; } }
            } else {
                const bool isq = t < 12; const float* gain = isq ? q_norm : k_norm; const float sc = isq ? C2 : 1.0f;
                bf16* base = isq ? (QW + (t - 8) * 256 + wc * 64) : (KW + wc * 64); const int ld = isq ? 1024 : 256;
                pg8::f32x4 g[2][2];
#pragma unroll
                for (int bj = 0; bj < 2; ++bj)
#pragma unroll
                    for (int n = 0; n < 2; ++n) g[bj][n] = *(const pg8::f32x4*)(gain + 32 * bj + 8 * fq + 4 * n) * sc;
#pragma unroll
                for (int ai = 0; ai < 2; ++ai)
#pragma unroll
                    for (int m = 0; m < 4; ++m) {
                        float ss = 0.f;
#pragma unroll
                        for (int bj = 0; bj < 2; ++bj)
#pragma unroll
                            for (int n = 0; n < 2; ++n) { const pg8::f32x4 v = acc[ai][bj][m][n]; ss += (v[0] * v[0] + v[1] * v[1]) + (v[2] * v[2] + v[3] * v[3]); }
                        ss += __shfl_xor(ss, 16); ss += __shfl_xor(ss, 32);
                        const float rstd = 1.0f / sqrtf(ss * (1.0f / 64.0f) + RMS_EPS);
                        bf16* rowp = base + (size_t)(row0 + ai * HALF + m * 16) * ld + 8 * fq;
#pragma unroll
                        for (int bj = 0; bj < 2; ++bj) { const pg8::f32x4 v0 = acc[ai][bj][m][0] * rstd * g[bj][0], v1 = acc[ai][bj][m][1] * rstd * g[bj][1];
                            v4u w; w.x = pk2(v0[0], v0[1]); w.y = pk2(v0[2], v0[3]); w.z = pk2(v1[0], v1[1]); w.w = pk2(v1[2], v1[3]); *(v4u*)(rowp + 32 * bj) = w; } }
            }
        } else {
            const int vrow0 = (u.pm - NTILE_X - NT_QK) * 256 + wr * 64 + fr;
#pragma unroll
            for (int ai = 0; ai < 2; ++ai)
#pragma unroll
                for (int m = 0; m < 4; ++m) { bf16* rowp = VT + (size_t)(vrow0 + ai * HALF + m * 16) * MPAD + u.pn * 256 + wc * 32 + 16 * (fq >> 1) + 4 * (fq & 1);
#pragma unroll
                    for (int bj = 0; bj < 2; ++bj)
#pragma unroll
                        for (int n = 0; n < 2; ++n) { const pg8::f32x4 v = acc[ai][bj][m][n]; v2u w; w.x = pk2(v[0], v[1]); w.y = pk2(v[2], v[3]); *(v2u*)(rowp + bj * HALF + 8 * n) = w; } }
        }
    }
};

namespace att {
__device__ __forceinline__ f32x16 mfma_bf(bf16x8 a, bf16x8 b, f32x16 c) { return __builtin_amdgcn_mfma_f32_32x32x16_bf16(a, b, c, 0, 0, 0); }
__device__ __forceinline__ f32x16 mfma_h(f16x8 a, f16x8 b, f32x16 c) { return __builtin_amdgcn_mfma_f32_32x32x16_f16(a, b, c, 0, 0, 0); }
__device__ __forceinline__ bf16x8 ld8(const bf16* p) { return *(const bf16x8*)p; }
__device__ __forceinline__ bf16x8 pack8(const float* w) { v4u o; o.x = pk2(w[0], w[1]); o.y = pk2(w[2], w[3]); o.z = pk2(w[4], w[5]); o.w = pk2(w[6], w[7]); return __builtin_bit_cast(bf16x8, o); }

struct KT { bf16x8 k[4]; bf16x8 v[4]; };
__device__ __forceinline__ void glds16(const void* gsrc, unsigned lds_dst) { unsigned keep;
    asm volatile("s_mov_b32 %0, m0\n\ts_mov_b32 m0, %2\n\ts_nop 0\n\tglobal_load_lds_dwordx4 %1, off\n\ts_mov_b32 m0, %0" : "=&s"(keep) : "v"(gsrc), "s"(lds_dst) : "memory"); }
__device__ __forceinline__ void dma_tile(unsigned slot, const bf16* Kb, int ldk, const bf16* Vt, int b, int j, int lane) {
#pragma unroll
    for (int i = 0; i < 4; ++i) { const int row = 8 * i + (lane >> 3), ch = (lane & 7) ^ (row & 7);
        const int krow = (j >= 0) ? (b * SEQ + 32 * j + row) : (NTOK + (row & 15));
        glds16(Kb + (size_t)krow * ldk + ch * 8, (unsigned)__builtin_amdgcn_readfirstlane(slot + i * 1024)); }
    const int col0 = (j >= 0) ? (b * SEQ + 32 * j) : NTOK;
#pragma unroll
    for (int i = 0; i < 4; ++i) { const int row = 16 * i + (lane >> 2), c = (lane & 3) ^ ((row >> 2) & 3); const int cc = (j >= 0) ? c : (c & 1);
        glds16(Vt + (size_t)row * MPAD + col0 + cc * 8, (unsigned)__builtin_amdgcn_readfirstlane(slot + 4096 + i * 1024)); }
}
__device__ __forceinline__ void lds_frags(KT& t, const LAS unsigned char* slot, int r, int h) {
#pragma unroll
    for (int s = 0; s < 4; ++s) { const int c = 2 * s + h; t.k[s] = *(const LAS bf16x8*)(slot + (r >> 3) * 1024 + ((r & 7) * 8 + (c ^ (r & 7))) * 16); }
#pragma unroll
    for (int dh = 0; dh < 2; ++dh)
#pragma unroll
        for (int s = 0; s < 2; ++s) { const int row = 32 * dh + r, c = 2 * s + h; t.v[dh * 2 + s] = *(const LAS bf16x8*)(slot + 4096 + row * 64 + (c ^ ((row >> 2) & 3)) * 16); }
}
#define ATT_WAITV(n) asm volatile("s_waitcnt vmcnt(" #n ")" ::: "memory")

struct SbState { f32x16 o0, o1; float R; };
template <int KIND>
__device__ __forceinline__ void sb_tile(SbState& S, const KT& t, const bf16x8 (&qf)[4], const f16x8& U0, const f16x8& U1, int r, int h) {
    f32x16 z = {0.f, 0.f, 0.f, 0.f, 0.f, 0.f, 0.f, 0.f, 0.f, 0.f, 0.f, 0.f, 0.f, 0.f, 0.f, 0.f};
#pragma unroll
    for (int s = 0; s < 4; ++s) z = mfma_bf(t.k[s], qf[s], z);
    f32x16 init; float L[16];
#pragma unroll
    for (int g = 0; g < 16; ++g) {
        const float zz = z[g];
        const float e = __builtin_amdgcn_exp2f(-__builtin_fabsf(zz));
        const float zp = __builtin_amdgcn_fmed3f(zz, 0.f, 3.0e38f);
        const float sp = zp + __builtin_amdgcn_logf(1.0f + e);
        float Lv = -sp;
        if (KIND == 1) Lv = (crow(g, h) < r) ? Lv : 0.f;
        if (KIND == 2) Lv = (crow(g, h) < 16) ? Lv : 0.f;
        L[g] = Lv; init[g] = zz + Lv + S.R;
    }
    f16x8 lb0, lb1;
#pragma unroll
    for (int j = 0; j < 8; ++j) { lb0[j] = (_Float16)L[j]; lb1[j] = (_Float16)L[8 + j]; }
    f32x16 lw = mfma_h(U0, lb0, init); lw = mfma_h(U1, lb1, lw);
    float Rn = lw[0] - z[0];
    Rn = __shfl(Rn, r);
    float w[16];
#pragma unroll
    for (int g = 0; g < 16; ++g) {
        float wv = __builtin_amdgcn_exp2f(lw[g]);
        if (KIND == 1) wv = (crow(g, h) < r) ? wv : 0.f;
        if (KIND == 2) wv = (crow(g, h) < 16) ? wv : 0.f;
        w[g] = wv;
    }
    const bf16x8 wb0 = pack8(w), wb1 = pack8(w + 8);
    S.o0 = mfma_bf(t.v[0], wb0, S.o0); S.o0 = mfma_bf(t.v[1], wb1, S.o0);
    S.o1 = mfma_bf(t.v[2], wb0, S.o1); S.o1 = mfma_bf(t.v[3], wb1, S.o1);
    S.R = Rn;
}

struct SwState { f32x16 o0, o1; float m, l; };
template <int KIND>
__device__ __forceinline__ void sw_tile(SwState& S, const KT& t, const bf16x8 (&qf)[4], const LAS float* tb, int r, int h) {
    f32x16 z = {0.f, 0.f, 0.f, 0.f, 0.f, 0.f, 0.f, 0.f, 0.f, 0.f, 0.f, 0.f, 0.f, 0.f, 0.f, 0.f};
#pragma unroll
    for (int s = 0; s < 4; ++s) z = mfma_bf(t.k[s], qf[s], z);
    float sc[16]; float mx = -1e30f;
#pragma unroll
    for (int g = 0; g < 16; ++g) {
        float v = z[g] + tb[(g & 3) + 8 * (g >> 2)];
        if (KIND == 1) v = (crow(g, h) <= r) ? v : -1e30f;
        if (KIND == 2) v = (crow(g, h) < 16) ? v : -1e30f;
        if (KIND == 3) v = (crow(g, h) > r) ? v : -1e30f;
        sc[g] = v; mx = __builtin_fmaxf(mx, v);
    }
    mx = __builtin_fmaxf(mx, __shfl_xor(mx, 32));
    const float mn = __builtin_fmaxf(S.m, mx);
    const float alpha = __builtin_amdgcn_exp2f(S.m - mn);
    S.l *= alpha; S.o0 *= alpha; S.o1 *= alpha;
    float p[16]; float ls = 0.f;
#pragma unroll
    for (int g = 0; g < 16; ++g) { p[g] = __builtin_amdgcn_exp2f(sc[g] - mn); ls += p[g]; }
    S.l += ls; S.m = mn;
    const bf16x8 wb0 = pack8(p), wb1 = pack8(p + 8);
    S.o0 = mfma_bf(t.v[0], wb0, S.o0); S.o0 = mfma_bf(t.v[1], wb1, S.o0);
    S.o1 = mfma_bf(t.v[2], wb0, S.o1); S.o1 = mfma_bf(t.v[3], wb1, S.o1);
}
__device__ __forceinline__ float store_o(bf16* orow, const f32x16& o0, const f32x16& o1, float scale, int h) {
    float ss = 0.f;
#pragma unroll
    for (int q = 0; q < 4; ++q) {
        const float a0 = o0[4 * q] * scale, a1 = o0[4 * q + 1] * scale, a2 = o0[4 * q + 2] * scale, a3 = o0[4 * q + 3] * scale;
        const float b0 = o1[4 * q] * scale, b1 = o1[4 * q + 1] * scale, b2 = o1[4 * q + 2] * scale, b3 = o1[4 * q + 3] * scale;
        ss += ((a0 * a0 + a1 * a1) + (a2 * a2 + a3 * a3)) + ((b0 * b0 + b1 * b1) + (b2 * b2 + b3 * b3));
        v2u w; w.x = pk2(a0, a1); w.y = pk2(a2, a3); *(v2u*)(orow + 8 * q + 4 * h) = w;
        v2u x; x.x = pk2(b0, b1); x.y = pk2(b2, b3); *(v2u*)(orow + 32 + 8 * q + 4 * h) = x;
    }
    return ss;
}
}

__device__ __forceinline__ void p2_attention(Frame& F) {
    using namespace att;
    const int lane = F.lane, r = lane & 31, h = lane >> 5, w = F.wave;
    const bf16* VT = (const bf16*)(F.ws + WS_VT); bf16* MIX = (bf16*)(F.ws + WS_MIXED); float* SSQ = (float*)(F.ws + WS_SSQ);
    LAS float* tbr = (LAS float*)(F.lds + ATT_TBR_OFF);
    const LAS unsigned char* area = F.lds + RING_OFF + w * 16384;
    const unsigned slot0 = (unsigned)(uintptr_t)area;
    { const float* rel_bias = F.in[2];
      for (int idx = F.tid; idx < 16 * 192; idx += NWAVES * 64) {
        const int hq = idx / 192, x = idx % 192, d = 159 - x; float v = 0.f;
        if (d >= 0) { int bkt = d; if (d >= 16) { bkt = 16 + (int)(logf((float)d / 16.0f) / logf(8.0f) * 16.0f); bkt = bkt > 31 ? 31 : bkt; } v = rel_bias[bkt * 16 + hq] * LOG2E; }
        tbr[idx] = v;
      } }
    __syncthreads();
    if (w >= ATT_WAVES) {
        const int p2_end = NITEMS - TAIL6_ITEMS - tail1_items(F.G);
        conv_range3(F, p2_end - P2_ITEMS + F.vcu * (NWAVES - ATT_WAVES) + (w - ATT_WAVES), F.G * (NWAVES - ATT_WAVES), p2_end);
        return;
    }
    __builtin_amdgcn_s_setprio(3);
    for (int unit = F.vcu; unit < NTOK / 32; unit += F.G) {
        const int b = unit >> 7, a = unit & 127;
        const size_t qrow = (size_t)b * SEQ + 32 * a + r;
#pragma unroll 1
        for (int bi = 0; bi < 2; ++bi) {
            const int branch = bi;
            if (branch == 0) {
            const bf16* KS = (const bf16*)(F.ws + WS_KS); const bf16* QS = (const bf16*)(F.ws + WS_QS);
            f16x8 U0, U1;
#pragma unroll
            for (int j = 0; j < 8; ++j) { const int c0 = 8 * (j >> 2) + 4 * h + (j & 3); U0[j] = (c0 > r) ? (_Float16)1.0f : (_Float16)0.0f; U1[j] = (16 + c0 > r) ? (_Float16)1.0f : (_Float16)0.0f; }
            float ssl = 0.f;
#pragma unroll 1
            for (int hh = 0; hh < 16 / ATT_WAVES; ++hh) {
                const int head = (16 / ATT_WAVES) * w + hh;
                ATT_WAITV(0);
                const bf16* Kb = KS + head * 64;
                bf16x8 ql[4];
#pragma unroll
                for (int s = 0; s < 4; ++s) ql[s] = ld8(QS + qrow * 1024 + head * 64 + 16 * s + 8 * h);
                SbState S; S.R = 0.f;
#pragma unroll
                for (int g = 0; g < 16; ++g) { S.o0[g] = 0.f; S.o1[g] = 0.f; }
                const bf16* Vt = VT + (size_t)(head * 64) * MPAD;
                unsigned sl_cur = slot0, sl_nxt = slot0 + 8192;
                int jt = a;
                dma_tile(sl_cur, Kb, 1024, Vt, b, jt, lane); dma_tile(sl_nxt, Kb, 1024, Vt, b, jt - 1, lane);
                ATT_WAITV(8);
                KT T; lds_frags(T, area + (sl_cur - slot0), r, h);
                sb_tile<1>(S, T, ql, U0, U1, r, h);
                if (!__all(S.R < SB_EXIT)) {
                    --jt;
                    for (;;) {
                        { const unsigned t_ = sl_cur; sl_cur = sl_nxt; sl_nxt = t_; }
                        const bool has_next = jt >= 0;
                        if (has_next) { dma_tile(sl_nxt, Kb, 1024, Vt, b, jt - 1, lane); ATT_WAITV(8); } else ATT_WAITV(0);
                        lds_frags(T, area + (sl_cur - slot0), r, h);
                        if (jt >= 0) sb_tile<0>(S, T, ql, U0, U1, r, h); else sb_tile<2>(S, T, ql, U0, U1, r, h);
                        if (!has_next || __all(S.R < SB_EXIT)) break;
                        --jt;
                    }
                }
                ssl += store_o(MIX + qrow * DM + head * 64, S.o0, S.o1, 1.0f, h);
            }
            ssl += __shfl_xor(ssl, 32);
            if (h == 0) SSQ[qrow * 16 + w] = ssl;
        }
            else {
            const bf16* KW = (const bf16*)(F.ws + WS_KW); const bf16* QW = (const bf16*)(F.ws + WS_QW);
            float ssl = 0.f;
#pragma unroll 1
            for (int hh = 0; hh < 16 / ATT_WAVES; ++hh) {
                const int hq = (16 / ATT_WAVES) * w + hh, kvh = hq >> 2;
                ATT_WAITV(0);
                const bf16* Kb = KW + kvh * 64;
                bf16x8 ql[4];
#pragma unroll
                for (int s = 0; s < 4; ++s) ql[s] = ld8(QW + qrow * 1024 + hq * 64 + 16 * s + 8 * h);
                const float sink2 = F.in[7][hq] * LOG2E;
                SwState S; S.m = sink2; S.l = 0.f;
#pragma unroll
                for (int g = 0; g < 16; ++g) { S.o0[g] = 0.f; S.o1[g] = 0.f; }
                const LAS float* tbh = tbr + hq * 192 + 4 * h;
                const int jlo = (a >= 4) ? a - 4 : 0;
                const bf16* Vt = VT + (size_t)(1024 + kvh * 64) * MPAD;
                unsigned sl_cur = slot0, sl_nxt = slot0 + 8192;
                int jt = a;
#define SW_NEXT(j) (((j) > jlo) ? (j) - 1 : -1)
                dma_tile(sl_cur, Kb, 256, Vt, b, jt, lane); dma_tile(sl_nxt, Kb, 256, Vt, b, SW_NEXT(jt), lane);
                ATT_WAITV(8);
                KT T; lds_frags(T, area + (sl_cur - slot0), r, h);
                sw_tile<1>(S, T, ql, tbh + (159 - r), r, h);
                jt = SW_NEXT(jt);
                for (;;) {
                    { const unsigned t_ = sl_cur; sl_cur = sl_nxt; sl_nxt = t_; }
                    if (jt >= 0) { dma_tile(sl_nxt, Kb, 256, Vt, b, SW_NEXT(jt), lane); ATT_WAITV(8); } else ATT_WAITV(0);
                    lds_frags(T, area + (sl_cur - slot0), r, h);
                    if (jt < 0) { const int dq = 32 * a + r + 16; sw_tile<2>(S, T, ql, tbh + (159 - (dq < 159 ? dq : 159)), r, h); break; }
                    const LAS float* tb = tbh + (159 - (32 * (a - jt) + r));
                    if (jt == a - 4) sw_tile<3>(S, T, ql, tb, r, h); else sw_tile<0>(S, T, ql, tb, r, h);
                    jt = SW_NEXT(jt);
                }
#undef SW_NEXT
                const float lt = S.l + __shfl_xor(S.l, 32) + __builtin_amdgcn_exp2f(sink2 - S.m);
                ssl += store_o(MIX + qrow * DM + 1024 + hq * 64, S.o0, S.o1, 1.0f / lt, h);
            }
            ssl += __shfl_xor(ssl, 32);
            if (h == 0) SSQ[qrow * 16 + 8 + w] = ssl;
        }
        }
    }
    __builtin_amdgcn_s_setprio(0);
}

struct EpiRes {
    static constexpr bool PERM = true, AFTER_DRAIN = false, MIDK = true;
    bf16* P; const LAS float* RS; mutable int ui;
    __device__ __forceinline__ void midk(pg8::f32x4 (&acc)[2][2][4][2], const pg8::Unit& u, int wr, int fr) const {
#pragma unroll
        for (int ai = 0; ai < 2; ++ai)
#pragma unroll
            for (int m = 0; m < 4; ++m) { const LAS float* q = RS + (ui * 256 + ai * 128 + wr * 64 + m * 16 + fr) * 2; const float ratio = q[0] / q[1];
#pragma unroll
                for (int bj = 0; bj < 2; ++bj)
#pragma unroll
                    for (int n = 0; n < 2; ++n) acc[ai][bj][m][n] *= ratio; }
    }
    __device__ __forceinline__ void operator()(const pg8::f32x4 (&acc)[2][2][4][2], const pg8::Unit& u, int wr, int wc, int fr, int fq) const {
        const int col0 = u.pn * 256 + wc * 32 + 8 * fq;
#pragma unroll
        for (int ai = 0; ai < 2; ++ai)
#pragma unroll
            for (int m = 0; m < 4; ++m) { const int rl = ai * 128 + wr * 64 + m * 16 + fr; bf16* rowp = P + (size_t)(u.pm * 256 + rl) * DM + col0; const float rw = RS[(ui * 256 + rl) * 2 + 1];
#pragma unroll
                for (int bj = 0; bj < 2; ++bj) { const pg8::f32x4 v0 = acc[ai][bj][m][0] * rw, v1 = acc[ai][bj][m][1] * rw;
                    v4u w; w.x = pk2(v0[0], v0[1]); w.y = pk2(v0[2], v0[3]); w.z = pk2(v1[0], v1[1]); w.w = pk2(v1[2], v1[3]); *(v4u*)(rowp + bj * 128) = w; } }
        ++ui;
    }
};

__device__ __forceinline__ void p4_router(Frame& F) {
    using namespace att;
    const int lane = F.lane, r = lane & 31, h = lane >> 5, w = F.wave;
    const bf16* proj = (const bf16*)(F.ws + WS_PROJ); const bf16* xnb = (const bf16*)(F.ws + WS_BIG); const float* rinv = (const float*)(F.ws + WS_RINV); bf16* HB = (bf16*)(F.ws + WS_HB);
    const bf16* WRH = (const bf16*)(F.ws + WS_WR); const bf16* WRL = WRH + 96 * DM;
    const float* b_rg = F.in[13]; const float* b_re = F.in[15];
    unsigned* CNT = F.ctl + CW_CNT;
    int* LIST = (int*)(F.ws + WS_LIST); float* GATEW = (float*)(F.ws + WS_GATEW); int* TOKINFO = (int*)(F.ws + WS_TOKINFO); float* RSTD = (float*)(F.ws + WS_RSTD); float* RSTDW = (float*)(F.ws + WS_RSTDW);
    LAS float* part = (LAS float*)(F.lds + RING_OFF);
    LAS float* ssp = (LAS float*)(F.lds + RING_OFF + 98304);
    LAS float* lg = (LAS float*)(F.lds + RING_OFF + 98304 + 2048);
    LAS float* rsl = (LAS float*)(F.lds + RING_OFF + 98304 + 2048 + 18432);
    LAS unsigned char* sthi = F.lds + RING_OFF; LAS unsigned char* stlo = F.lds + RING_OFF + 65536;
    for (int unit = F.vcu; unit < NTOK / 64; unit += F.G) {
        f32x16 acc[2][3];
#pragma unroll
        for (int t = 0; t < 2; ++t)
#pragma unroll
            for (int nt = 0; nt < 3; ++nt)
#pragma unroll
                for (int g = 0; g < 16; ++g) acc[t][nt][g] = 0.f;
        float ss0 = 0.f, ss1 = 0.f;
#pragma unroll 1
        for (int q = 0; q < 4; ++q) {
#pragma unroll 1
            for (int hb = 0; hb < 2; ++hb) {
                f32x4 xv[8]; v2u pv[8];
#pragma unroll
                for (int i = 0; i < 8; ++i) { const int id = (hb * 8 + i) * 512 + F.tid, row = id >> 7, g = id & 127; const size_t off = ((size_t)unit * 64 + row) * DM + 512 * q + 4 * g;
                    const v2u xb = *(const v2u*)(xnb + off); const float ri = rinv[unit * 64 + row]; xv[i] = (f32x4){bf_lo(xb.x) * ri, bf_hi(xb.x) * ri, bf_lo(xb.y) * ri, bf_hi(xb.y) * ri}; pv[i] = *(const v2u*)(proj + off); }
#pragma unroll
                for (int i = 0; i < 8; ++i) { const int id = (hb * 8 + i) * 512 + F.tid, row = id >> 7, g = id & 127; const size_t off = ((size_t)unit * 64 + row) * DM + 512 * q + 4 * g;
                    const float a0 = xv[i][0] + bf_lo(pv[i].x), a1 = xv[i][1] + bf_hi(pv[i].x), a2 = xv[i][2] + bf_lo(pv[i].y), a3 = xv[i][3] + bf_hi(pv[i].y);
                    v2u hi; hi.x = pk2(a0, a1); hi.y = pk2(a2, a3);
                    v2u lo; lo.x = pk2(a0 - bf_lo(hi.x), a1 - bf_hi(hi.x)); lo.y = pk2(a2 - bf_lo(hi.y), a3 - bf_hi(hi.y));
                    *(v2u*)(HB + off) = hi;
                    const int lofs = row * 1024 + ((((g >> 1) ^ (row & 15))) << 4) + ((g & 1) << 3);
                    *(LAS v2u*)(sthi + lofs) = hi; *(LAS v2u*)(stlo + lofs) = lo; }
            }
            __syncthreads();
#pragma unroll 2
            for (int s4 = 0; s4 < 4; ++s4) {
                const int ks = w + 8 * s4, ksg = 32 * q + ks;
                const int fo0 = r * 1024 + ((((2 * ks + h) ^ (r & 15))) << 4), fo1 = fo0 + 32 * 1024;
                const v4u h0 = *(const LAS v4u*)(sthi + fo0), l0 = *(const LAS v4u*)(stlo + fo0), h1 = *(const LAS v4u*)(sthi + fo1), l1 = *(const LAS v4u*)(stlo + fo1);
#define P4_SS(SS, HV, LV) { const float e0 = bf_lo(HV.x) + bf_lo(LV.x), e1 = bf_hi(HV.x) + bf_hi(LV.x), e2 = bf_lo(HV.y) + bf_lo(LV.y), e3 = bf_hi(HV.y) + bf_hi(LV.y), \
                    e4 = bf_lo(HV.z) + bf_lo(LV.z), e5 = bf_hi(HV.z) + bf_hi(LV.z), e6 = bf_lo(HV.w) + bf_lo(LV.w), e7 = bf_hi(HV.w) + bf_hi(LV.w); \
                    SS += ((e0 * e0 + e1 * e1) + (e2 * e2 + e3 * e3)) + ((e4 * e4 + e5 * e5) + (e6 * e6 + e7 * e7)); }
                P4_SS(ss0, h0, l0) P4_SS(ss1, h1, l1)
#undef P4_SS
                const bf16x8 ahi0 = __builtin_bit_cast(bf16x8, h0), alo0 = __builtin_bit_cast(bf16x8, l0), ahi1 = __builtin_bit_cast(bf16x8, h1), alo1 = __builtin_bit_cast(bf16x8, l1);
#pragma unroll
                for (int nt = 0; nt < 3; ++nt) {
                    const int fo = (((ksg * 3 + nt) * 64 + lane) << 3);
                    const bf16x8 bh = ld8(WRH + fo), bl = ld8(WRL + fo);
                    acc[0][nt] = mfma_bf(ahi0, bh, acc[0][nt]); acc[0][nt] = mfma_bf(alo0, bh, acc[0][nt]); acc[0][nt] = mfma_bf(ahi0, bl, acc[0][nt]);
                    acc[1][nt] = mfma_bf(ahi1, bh, acc[1][nt]); acc[1][nt] = mfma_bf(alo1, bh, acc[1][nt]); acc[1][nt] = mfma_bf(ahi1, bl, acc[1][nt]);
                }
            }
            __syncthreads();
        }
        ss0 += __shfl_xor(ss0, 32); ss1 += __shfl_xor(ss1, 32);
        if (h == 0) { ssp[w * 32 + r] = ss0; ssp[256 + w * 32 + r] = ss1; }
#pragma unroll
        for (int t = 0; t < 2; ++t) {
#pragma unroll
            for (int nt = 0; nt < 3; ++nt)
#pragma unroll
                for (int g = 0; g < 16; ++g) part[(w * 32 + crow(g, h)) * 96 + nt * 32 + r] = acc[t][nt][g];
            __syncthreads();
            for (int idx = F.tid; idx < 32 * 72; idx += NWAVES * 64) { const int tk = idx / 72, c = idx % 72; float v = 0.f;
#pragma unroll
                for (int i = 0; i < 8; ++i) v += part[(i * 32 + tk) * 96 + c];
                lg[t * 32 * 72 + idx] = v; }
            __syncthreads();
        }
        LAS unsigned* hist = (LAS unsigned*)rsl + 64;
        if (F.tid < 128) hist[F.tid] = 0u;
        __syncthreads();
        int tok = 0, e0 = 0, e1 = 0; unsigned r0 = 0, r1 = 0; float g0 = 0.f, g1 = 0.f, rs = 0.f;
        if (F.tid < 64) {
            tok = unit * 64 + F.tid; float tsum = 0.f;
#pragma unroll
            for (int i = 0; i < 8; ++i) tsum += ssp[(F.tid >> 5) * 256 + i * 32 + (F.tid & 31)];
            rs = 1.0f / sqrtf(tsum * (1.0f / DM) + RMS_EPS); RSTD[tok] = rs;
            const LAS float* l = lg + F.tid * 72;
            float gl[8]; int gi = 0; float gm = -3.0e38f;
#pragma unroll
            for (int i = 0; i < 8; ++i) { gl[i] = l[i] * rs + b_rg[i]; if (gl[i] > gm) { gm = gl[i]; gi = i; } }
            float gs = 0.f;
#pragma unroll
            for (int i = 0; i < 8; ++i) gs += expf(gl[i] - gm);
            const float gval = 1.0f / gs;
            float el[8]; int i0 = 0; float m0 = -3.0e38f;
#pragma unroll
            for (int i = 0; i < 8; ++i) { el[i] = l[8 + gi * 8 + i] * rs + b_re[gi * 8 + i]; if (el[i] > m0) { m0 = el[i]; i0 = i; } }
            int i1 = 0; float m1 = -3.0e38f;
#pragma unroll
            for (int i = 0; i < 8; ++i) if (i != i0 && el[i] > m1) { m1 = el[i]; i1 = i; }
            const float p1 = expf(m1 - m0); g0 = gval / (1.0f + p1); g1 = gval * p1 / (1.0f + p1);
            e0 = gi * 8 + i0; e1 = gi * 8 + i1;
            r0 = atomicAdd((unsigned*)(hist + e0), 1u); r1 = atomicAdd((unsigned*)(hist + e1), 1u);
        }
        __syncthreads();
        if (F.tid < 64) { const unsigned n = hist[F.tid]; if (n) hist[64 + F.tid] = atomicAdd(CNT + 16 * F.tid, n); }
        __syncthreads();
        if (F.tid < 64) {
            const int pos0 = (int)(hist[64 + e0] + r0), pos1 = (int)(hist[64 + e1] + r1);
            LIST[e0 * NTOK + pos0] = tok; LIST[e1 * NTOK + pos1] = tok; GATEW[e0 * NTOK + pos0] = g0; GATEW[e1 * NTOK + pos1] = g1; RSTDW[e0 * NTOK + pos0] = rs; RSTDW[e1 * NTOK + pos1] = rs;
            *(int4*)(TOKINFO + 4 * tok) = make_int4(e0, pos0, e1, pos1);
        }
        __syncthreads();
    }
}

__device__ __forceinline__ void build_tables(Frame& F) {
    LAS int* T = (LAS int*)(F.lds + TBL_OFF);
    __syncthreads();
    if (F.tid < NEXP) {
        const int c = (int)__hip_atomic_load(F.ctl + CW_CNT + 16 * F.tid, __ATOMIC_RELAXED, __HIP_MEMORY_SCOPE_AGENT); const int mt = (c + 255) >> 8;
        int incl = mt;
#pragma unroll
        for (int o = 1; o < 64; o <<= 1) { const int v = __shfl_up(incl, o); if (F.tid >= o) incl += v; }
        const int st = incl - mt;
        T[TBL_TSTART + F.tid] = st; T[TBL_CNTS + F.tid] = c;
        for (int i = 0; i < mt; ++i) T[TBL_TE + st + i] = F.tid;
        if (F.tid == NEXP - 1) { T[TBL_TSTART + NEXP] = incl; T[TBL_NT] = incl; }
    }
    __syncthreads();
}
struct MoeGather {
    const int* list; const LAS int* T; LAS int* tokbuf; int NT; const float* rstdw; const float* gatew;
    __device__ __forceinline__ void info(const pg8::Unit& u, int& e, int& base, int& cnt) const { e = u.pn / NT; base = (u.pm - T[TBL_TSTART + e]) * 256; cnt = T[TBL_CNTS + e]; }
    __device__ __forceinline__ unsigned tok_direct(const pg8::Unit& u, int row) const { int e, base, cnt; info(u, e, base, cnt); const int idx = base + row; return idx < cnt ? (unsigned)list[e * NTOK + idx] : 0u; }
    __device__ __forceinline__ void issue(const pg8::Unit& u, int par, int lane) const { int e, base, cnt; info(u, e, base, cnt);
        __builtin_amdgcn_global_load_lds((const unsigned*)(list + e * NTOK + base + 4 * lane), (LAS unsigned*)(tokbuf + par * 256), 16, 0, 0);
        __builtin_amdgcn_global_load_lds((const unsigned*)(rstdw + e * NTOK + base + 4 * lane), (LAS unsigned*)(tokbuf + 512 + par * 256), 16, 0, 0);
        __builtin_amdgcn_global_load_lds((const unsigned*)(gatew + e * NTOK + base + 4 * lane), (LAS unsigned*)(tokbuf + 1024 + par * 256), 16, 0, 0); }
    __device__ __forceinline__ void direct_rg(const pg8::Unit& u, int row, float& rs, float& gw) const { int e, base, cnt; info(u, e, base, cnt); rs = rstdw[e * NTOK + base + row]; gw = gatew[e * NTOK + base + row]; }
    __device__ __forceinline__ unsigned tok_lds(const pg8::Unit& u, int par, int row) const { int e, base, cnt; info(u, e, base, cnt); const unsigned t = (unsigned)tokbuf[par * 256 + row]; return (base + row) < cnt ? t : 0u; }
};
namespace pg8 {
template <class Epi, class Sched>
__device__ __forceinline__ void gemm_phase_g(PG8_LAS unsigned char* lds, const Gemm g, const Sched& S, const Epi& E, const MoeGather& GA) {
    const int tid = threadIdx.x, wid = __builtin_amdgcn_readfirstlane(tid >> 6), lane = tid & 63, wr = wid >> 2, wc = wid & 3, fr = lane & 15, fq = lane >> 4;
    const int K = g.K, nt = K / BK;
    unsigned voffB[2], cofA[2]; int rowA[2];
#pragma unroll
    for (int i = 0; i < 2; ++i) { int R, C; stage_rc(tid * 16 + i * 8192, R, C); const int Rb = Epi::PERM ? ((R & ~31) + perm32(R & 31)) : R;
        rowA[i] = R; cofA[i] = (unsigned)C * 2u; voffB[i] = (unsigned)(Rb * K + C) * 2u; }
    const unsigned rowbytes = (unsigned)K * 2u;
    const size_t kstep = (size_t)(BK * 2);
    const size_t hstep = (size_t)HALF * K * 2;
    const size_t tstep = 2 * hstep;
    const unsigned ldsw = (unsigned)wid * 1024u;
    const int aoff = lds_byte(wr * 64 + fr, fq * 8), boff = lds_byte(wc * 32 + fr, fq * 8);
#define PG8_SA(b, h) (((b) * 2 + (h)) * HTB)
#define PG8_SB(b, h) ((4 + (b) * 2 + (h)) * HTB)
#define PG8_STAGE(bufoff, gbase, voff) do { _Pragma("unroll") for (int _i = 0; _i < 2; ++_i) \
        __builtin_amdgcn_global_load_lds((const unsigned*)((const char*)(gbase) + (voff)[_i]), (PG8_LAS unsigned*)(lds + (bufoff) + ldsw + _i * 8192), 16, 0, 0); } while (0)
#define PG8_LDA(dst, b, h) do { _Pragma("unroll") for (int m = 0; m < 4; ++m) _Pragma("unroll") for (int k = 0; k < 2; ++k) dst[m][k] = *(const PG8_LAS bf16x8*)(lds + PG8_SA(b, h) + aoff + m * 2048 + k * 1024); } while (0)
#define PG8_LDB(dst, b, h) do { _Pragma("unroll") for (int n = 0; n < 2; ++n) _Pragma("unroll") for (int k = 0; k < 2; ++k) dst[n][k] = *(const PG8_LAS bf16x8*)(lds + PG8_SB(b, h) + boff + n * 2048 + k * 1024); } while (0)
#define PG8_MMA(ai, bj, At, Bt) do { __builtin_amdgcn_s_setprio(1); _Pragma("unroll") for (int m = 0; m < 4; ++m) _Pragma("unroll") for (int n = 0; n < 2; ++n) _Pragma("unroll") for (int k = 0; k < 2; ++k) \
        acc[ai][bj][m][n] = __builtin_amdgcn_mfma_f32_16x16x32_bf16(Bt[n][k], At[m][k], acc[ai][bj][m][n], 0, 0, 0); __builtin_amdgcn_s_setprio(0); } while (0)
#define PG8_WAIT_V(n) asm volatile("s_waitcnt vmcnt(" #n ")" ::: "memory")
#define PG8_WAIT_L(n) asm volatile("s_waitcnt lgkmcnt(" #n ")" ::: "memory")
#define PG8_BAR __builtin_amdgcn_s_barrier()
#define PG8_SCHED __builtin_amdgcn_sched_barrier(0)
    Unit cur, nxt; int ui = 0;
    if (!S.next(0, cur)) return;
    f32x4 acc[2][2][4][2];
#pragma unroll
    for (int a = 0; a < 2; ++a)
#pragma unroll
        for (int b = 0; b < 2; ++b)
#pragma unroll
            for (int m = 0; m < 4; ++m)
#pragma unroll
                for (int n = 0; n < 2; ++n) acc[a][b][m][n] = (f32x4){0.f, 0.f, 0.f, 0.f};
    bf16x8 At[4][2], B0[2][2], B1[2][2];
    const char* A0 = (const char*)g.A; const char* cB = (const char*)g.Bt + (size_t)cur.pn * tstep;
    PG8_LAS int* tb = GA.tokbuf;
    if (tid < 256) { tb[tid] = (int)GA.tok_direct(cur, tid); float rs_, gw_; GA.direct_rg(cur, tid, rs_, gw_); ((PG8_LAS float*)tb)[512 + tid] = rs_; ((PG8_LAS float*)tb)[1024 + tid] = gw_; }
    PG8_WAIT_L(0); PG8_BAR;
#define PG8_OFFS(dst, par, half) do { _Pragma("unroll") for (int _i = 0; _i < 2; ++_i) dst[_i] = (unsigned)tb[(par) * 256 + (half) * HALF + rowA[_i]] * rowbytes + cofA[_i]; } while (0)
    {
        unsigned c0[2], c1[2]; PG8_OFFS(c0, 0, 0); PG8_OFFS(c1, 0, 1);
        PG8_STAGE(PG8_SB(0, 0), cB, voffB); PG8_STAGE(PG8_SB(0, 1), cB + hstep, voffB); PG8_STAGE(PG8_SA(0, 0), A0, c0); PG8_STAGE(PG8_SA(0, 1), A0, c1);
        if (wr == 1) PG8_BAR;
        PG8_WAIT_V(2); PG8_BAR;
        PG8_STAGE(PG8_SB(1, 0), cB + kstep, voffB); PG8_STAGE(PG8_SA(1, 0), A0 + kstep, c0); PG8_STAGE(PG8_SB(1, 1), cB + hstep + kstep, voffB);
        PG8_WAIT_V(6); PG8_BAR;
    }
    int t_issue = 2, t_fix = 6; asm volatile("" : "+s"(t_issue), "+s"(t_fix));
    for (;;) {
        const bool has_next = S.next(ui + 1, nxt);
        const char* nB = has_next ? (const char*)g.Bt + (size_t)nxt.pn * tstep : cB;
        const int pc = ui & 1, pnx = (ui + 1) & 1;
        for (int t = 0; t < nt; t += 2) {
            const bool last = (t == nt - 2);
            const char* a1 = A0 + (size_t)(t + 1) * kstep;
            const char* a2 = last ? A0 : A0 + (size_t)(t + 2) * kstep; const char* b2 = last ? nB : cB + (size_t)(t + 2) * kstep;
            const char* a3 = a2 + kstep; const char* b3 = b2 + kstep;
            if (t == t_fix && has_next && tid < 256) { int e_, base_, cnt_; GA.info(nxt, e_, base_, cnt_); if (base_ + tid >= cnt_) tb[pnx * 256 + tid] = 0; }
            const int ps = (last && has_next) ? pnx : pc;
            unsigned c1[2], s0[2], s1[2]; PG8_OFFS(c1, pc, 1); PG8_OFFS(s0, ps, 0); PG8_OFFS(s1, ps, 1);
            PG8_LDB(B0, 0, 0); PG8_LDB(B1, 0, 1); PG8_SCHED; PG8_LDA(At, 0, 0); PG8_STAGE(PG8_SA(1, 1), a1, c1);
            if (t == t_issue && has_next && wid == 0) GA.issue(nxt, pnx, lane);
            PG8_WAIT_V(8); PG8_WAIT_L(0); PG8_BAR; PG8_MMA(0, 0, At, B0); PG8_MMA(0, 1, At, B1); PG8_BAR; PG8_SCHED;
            PG8_LDA(At, 0, 1); PG8_STAGE(PG8_SB(0, 0), b2, voffB); PG8_STAGE(PG8_SB(0, 1), b2 + hstep, voffB); PG8_STAGE(PG8_SA(0, 0), a2, s0);
            PG8_WAIT_V(8); PG8_WAIT_L(0); PG8_BAR; PG8_MMA(1, 0, At, B0); PG8_MMA(1, 1, At, B1); PG8_BAR; PG8_SCHED;
            PG8_LDB(B0, 1, 0); PG8_LDB(B1, 1, 1); PG8_SCHED; PG8_LDA(At, 1, 0); PG8_STAGE(PG8_SA(0, 1), a2, s1);
            PG8_WAIT_V(8); PG8_WAIT_L(0); PG8_BAR; PG8_MMA(0, 0, At, B0); PG8_MMA(0, 1, At, B1); PG8_BAR; PG8_SCHED;
            PG8_LDA(At, 1, 1); PG8_STAGE(PG8_SB(1, 0), b3, voffB); PG8_STAGE(PG8_SB(1, 1), b3 + hstep, voffB); PG8_STAGE(PG8_SA(1, 0), a3, s0);
            PG8_WAIT_V(8); PG8_WAIT_L(0); PG8_BAR; PG8_MMA(1, 0, At, B0); PG8_MMA(1, 1, At, B1); PG8_BAR; PG8_SCHED;
        }
        if (wr == 0) PG8_BAR;
        E.par = pc; E(acc, cur, wr, wc, fr, fq); S.done(cur);
        if (!has_next) break;
#pragma unroll
        for (int a = 0; a < 2; ++a)
#pragma unroll
            for (int b = 0; b < 2; ++b)
#pragma unroll
                for (int m = 0; m < 4; ++m)
#pragma unroll
                    for (int n = 0; n < 2; ++n) acc[a][b][m][n] = (f32x4){0.f, 0.f, 0.f, 0.f};
        cur = nxt; cB = nB; ++ui;
        if (wr == 1) PG8_BAR;
    }
    PG8_WAIT_V(0);
    PG8_BAR;
#undef PG8_SA
#undef PG8_SB
#undef PG8_STAGE
#undef PG8_LDA
#undef PG8_LDB
#undef PG8_MMA
#undef PG8_WAIT_V
#undef PG8_WAIT_L
#undef PG8_BAR
#undef PG8_SCHED
#undef PG8_OFFS
}
}
struct MoeOrder {
    const LAS int* T; int NT, G, c;
    __device__ bool next(int i, pg8::Unit& u) const {
        const int L = i * G + c; if (L >= T[TBL_NT] * NT) return false;
        const int mt = L / NT; u.pm = mt; u.pn = T[TBL_TE + mt] * NT + (L % NT); return true;
    }
    __device__ __forceinline__ void a_ready(const pg8::Unit&) const {}
    __device__ __forceinline__ void done(const pg8::Unit&) const {}
};
struct EpiSwiGLU {
    static constexpr bool PERM = true, AFTER_DRAIN = false, MIDK = false;
    bf16* HDN; const LAS float* RG; const LAS int* T; mutable int par;
    __device__ __forceinline__ void operator()(const pg8::f32x4 (&acc)[2][2][4][2], const pg8::Unit& u, int wr, int wc, int fr, int fq) const {
        const int col0 = (u.pn & 3) * 128 + wc * 32 + 8 * fq; const int e = u.pn >> 2; const int base = (u.pm - T[TBL_TSTART + e]) * 256, cnt = T[TBL_CNTS + e];
#pragma unroll
        for (int ai = 0; ai < 2; ++ai)
#pragma unroll
            for (int m = 0; m < 4; ++m) { const int rl = ai * 128 + wr * 64 + m * 16 + fr; const int row = u.pm * 256 + rl; const bool ok = (base + rl) < cnt;
                const float rsr = RG[par * 256 + rl], gwr = RG[512 + par * 256 + rl];
                const float rs = ok ? rsr : 0.f, gw = ok ? gwr : 0.f;
                float o[8];
#pragma unroll
                for (int n = 0; n < 2; ++n)
#pragma unroll
                    for (int q = 0; q < 4; ++q) { const float g = acc[ai][0][m][n][q] * rs, up = acc[ai][1][m][n][q] * rs;
                        const float sg = g * __builtin_amdgcn_rcpf(1.0f + __builtin_amdgcn_exp2f(-g * LOG2E)); o[4 * n + q] = sg * up * gw; }
                v4u wv; wv.x = pk2(o[0], o[1]); wv.y = pk2(o[2], o[3]); wv.z = pk2(o[4], o[5]); wv.w = pk2(o[6], o[7]);
                *(v4u*)(HDN + (size_t)row * DEXP + col0) = wv; }
    }
};
struct EpiY {
    static constexpr bool PERM = true, AFTER_DRAIN = false, MIDK = false;
    bf16* Y;
    __device__ __forceinline__ void operator()(const pg8::f32x4 (&acc)[2][2][4][2], const pg8::Unit& u, int wr, int wc, int fr, int fq) const {
        const int col0 = (u.pn & 7) * 256 + wc * 32 + 8 * fq;
#pragma unroll
        for (int ai = 0; ai < 2; ++ai)
#pragma unroll
            for (int m = 0; m < 4; ++m) { bf16* rowp = Y + (size_t)(u.pm * 256 + ai * 128 + wr * 64 + m * 16 + fr) * DM + col0;
#pragma unroll
                for (int bj = 0; bj < 2; ++bj) { const pg8::f32x4 v0 = acc[ai][bj][m][0], v1 = acc[ai][bj][m][1];
                    v4u w; w.x = pk2(v0[0], v0[1]); w.y = pk2(v0[2], v0[3]); w.z = pk2(v1[0], v1[1]); w.w = pk2(v1[2], v1[3]); *(v4u*)(rowp + bj * 128) = w; } }
    }
};
struct P8Row { v4u h[4], a[4], b[4]; };
__device__ __forceinline__ void p8_load(P8Row& r, const bf16* HB, const bf16* Y, const LAS int* T, int4 ti, int t, int lane) {
    const size_t s0 = (size_t)T[TBL_TSTART + ti.x] * 256 + ti.y, s1 = (size_t)T[TBL_TSTART + ti.z] * 256 + ti.w;
    const v4u* hp = (const v4u*)(HB + (size_t)t * DM) + lane; const v4u* y0 = (const v4u*)(Y + s0 * DM) + lane; const v4u* y1 = (const v4u*)(Y + s1 * DM) + lane;
#pragma unroll
    for (int j = 0; j < 4; ++j) { r.h[j] = __builtin_nontemporal_load(hp + 64 * j); r.a[j] = __builtin_nontemporal_load(y0 + 64 * j); r.b[j] = __builtin_nontemporal_load(y1 + 64 * j); }
}
__device__ __forceinline__ void p8_combine(Frame& F) {
    const LAS int* T = (const LAS int*)(F.lds + TBL_OFF);
    const int gw = F.vcu * NWAVES + F.wave, NGW = F.G * NWAVES;
    const bf16* Y = (const bf16*)(F.ws + WS_Y); const bf16* HB = (const bf16*)(F.ws + WS_HB); const int* TOKINFO = (const int*)(F.ws + WS_TOKINFO);
    constexpr int RPW = 8;
    int4 ti[RPW];
#pragma unroll
    for (int k = 0; k < RPW; ++k) { const int t = gw + k * NGW; ti[k] = (t < NTOK) ? *(const int4*)(TOKINFO + 4 * t) : make_int4(0, 0, 0, 0); }
    P8Row cur; if (gw < NTOK) p8_load(cur, HB, Y, T, ti[0], gw, F.lane);
#pragma unroll
    for (int k = 0; k < RPW; ++k) {
        const int t = gw + k * NGW; if (t >= NTOK) break;
        P8Row nxt; const int tn = t + NGW;
        if (k + 1 < RPW && tn < NTOK) p8_load(nxt, HB, Y, T, ti[k + 1 < RPW ? k + 1 : k], tn, F.lane);
        f32x4* od = (f32x4*)(F.out + (size_t)t * DM) + 2 * F.lane;
#pragma unroll
        for (int j = 0; j < 4; ++j) {
            const v4u h = cur.h[j], a = cur.a[j], b = cur.b[j]; f32x4 v0, v1;
            v0[0] = bf_lo(h.x) + bf_lo(a.x) + bf_lo(b.x); v0[1] = bf_hi(h.x) + bf_hi(a.x) + bf_hi(b.x); v0[2] = bf_lo(h.y) + bf_lo(a.y) + bf_lo(b.y); v0[3] = bf_hi(h.y) + bf_hi(a.y) + bf_hi(b.y);
            v1[0] = bf_lo(h.z) + bf_lo(a.z) + bf_lo(b.z); v1[1] = bf_hi(h.z) + bf_hi(a.z) + bf_hi(b.z); v1[2] = bf_lo(h.w) + bf_lo(a.w) + bf_lo(b.w); v1[3] = bf_hi(h.w) + bf_hi(a.w) + bf_hi(b.w);
            od[128 * j] = v0; od[128 * j + 1] = v1;
        }
        cur = nxt;
    }
    for (int t = gw + RPW * NGW; t < NTOK; t += NGW) {
        const int4 tj = *(const int4*)(TOKINFO + 4 * t); P8Row r; p8_load(r, HB, Y, T, tj, t, F.lane);
        f32x4* od = (f32x4*)(F.out + (size_t)t * DM) + 2 * F.lane;
#pragma unroll
        for (int j = 0; j < 4; ++j) {
            const v4u h = r.h[j], a = r.a[j], b = r.b[j]; f32x4 v0, v1;
            v0[0] = bf_lo(h.x) + bf_lo(a.x) + bf_lo(b.x); v0[1] = bf_hi(h.x) + bf_hi(a.x) + bf_hi(b.x); v0[2] = bf_lo(h.y) + bf_lo(a.y) + bf_lo(b.y); v0[3] = bf_hi(h.y) + bf_hi(a.y) + bf_hi(b.y);
            v1[0] = bf_lo(h.z) + bf_lo(a.z) + bf_lo(b.z); v1[1] = bf_hi(h.z) + bf_hi(a.z) + bf_hi(b.z); v1[2] = bf_lo(h.w) + bf_lo(a.w) + bf_lo(b.w); v1[3] = bf_hi(h.w) + bf_hi(a.w) + bf_hi(b.w);
            od[128 * j] = v0; od[128 * j + 1] = v1;
        }
    }
}

__global__ void __launch_bounds__(NWAVES * 64, 2) mk_fwd(Args args) {
    extern __shared__ __attribute__((aligned(16))) unsigned char lds[];
    Frame F;
    F.lds = (LAS unsigned char*)lds; F.ws = args.ws; F.ctl = (unsigned*)(args.ws + WS_CTL);
    F.tid = threadIdx.x; F.lane = F.tid & 63; F.wave = __builtin_amdgcn_readfirstlane(F.tid >> 6);
    F.G = gridDim.x; { const int bx = blockIdx.x; F.vcu = (F.G % 8 == 0) ? (bx % 8) * (F.G / 8) + bx / 8 : bx; }
    F.in = args.in; F.out = args.out;
    volatile LAS unsigned* MISC = (volatile LAS unsigned*)(F.lds + MISC_OFF);
    if (F.tid < 64) MISC[F.tid] = 0u;
    __syncthreads();
    const int lo = args.ph_lo, hi = args.ph_hi;
    const bool use_bar = (hi - lo) > 1;
    XcdBarrier bar; bar.bar = F.ctl + CW_BAR + args.li * XCD_BAR_WORDS; bar.x = 0; bar.st = nullptr;
    if (use_bar) bar = xcd_barrier_post(F.ctl + CW_BAR + args.li * XCD_BAR_WORDS, MISC + 8);
#define IN(k) (lo <= (k) && (k) < hi)
#define SEAM(k) do { if (IN(k) && (IN((k) + 1) || ((k) == 4 && IN(6)))) xcd_barrier(bar); } while (0)
    bf16* BIG = (bf16*)(F.ws + WS_BIG);

    if (IN(0)) { p0_prologue(F); SEAM(0); }
    if (IN(1)) {
        pg8::Gemm g{BIG, BIG, 0, 0, DM}; P1Order S{F.G, F.vcu};
        EpiQKV E{(bf16*)(F.ws + WS_QS), (bf16*)(F.ws + WS_KS), (bf16*)(F.ws + WS_QW), (bf16*)(F.ws + WS_KW), (bf16*)(F.ws + WS_VT), F.in[5], F.in[6]};
        pg8::gemm_phase<EpiQKV, P1Order, true, true>(F.lds + RING_OFF, g, S, E);
        {
            const int rounds = (P1_UNITS + F.G - 1) / F.G, first_idle = P1_UNITS - (rounds - 1) * F.G, nidle = F.G - first_idle;
            const int base = NITEMS - TAIL6_ITEMS - tail1_items(F.G);
            if (F.vcu >= first_idle) conv_range(F, base + (F.vcu - first_idle) * NWAVES + F.wave, nidle * NWAVES, NITEMS - TAIL6_ITEMS);
        }
        SEAM(1);
    }
    if (IN(2)) { p2_attention(F); SEAM(2); }
    if (IN(3)) {
        pg8::Gemm g{(const bf16*)(F.ws + WS_MIXED), (const bf16*)(F.ws + WS_WOUT), NTOK, DM, DM}; pg8::StaticOrder S; S.init(NTOK, DM, F.G, (int)blockIdx.x);
        LAS float* RS = (LAS float*)(F.lds + ATT_TBR_OFF);
        {   const float* SSQ = (const float*)(F.ws + WS_SSQ);
            for (int i = 0; i < 4; ++i) { pg8::Unit u; if (!S.next(i, u)) break;
                if (F.tid < 256) { const pg8::f32x4* q = (const pg8::f32x4*)(SSQ + (size_t)(u.pm * 256 + F.tid) * 16); const pg8::f32x4 a = q[0], b = q[1], c = q[2], d = q[3];
                    float sb = 0.f, sw = 0.f;
#pragma unroll
                    for (int q_ = 0; q_ < ATT_WAVES; ++q_) { sb += (q_ < 4 ? a[q_ & 3] : b[q_ & 3]); sw += (q_ < 4 ? c[q_ & 3] : d[q_ & 3]); }
                    RS[(i * 256 + F.tid) * 2] = 1.0f / sqrtf(sb * (1.0f / 1024.0f) + RMS_EPS); RS[(i * 256 + F.tid) * 2 + 1] = 1.0f / sqrtf(sw * (1.0f / 1024.0f) + RMS_EPS); } }
            __syncthreads(); }
        EpiRes E{(bf16*)(F.ws + WS_PROJ), RS, 0};
        pg8::gemm_phase<EpiRes, pg8::StaticOrder, true, true>(F.lds + RING_OFF, g, S, E);
        SEAM(3);
    }
    if (IN(4)) { p4_router(F); SEAM(4); }
    if (IN(5) || IN(6) || IN(7) || IN(8)) build_tables(F);
    if (IN(6)) {
        pg8::Gemm g{(const bf16*)(F.ws + WS_HB), (const bf16*)(F.ws + WS_WGU), 0, 0, DM}; MoeOrder S{(const LAS int*)(F.lds + TBL_OFF), 4, F.G, F.vcu};
        MoeGather GA{(const int*)(F.ws + WS_LIST), (const LAS int*)(F.lds + TBL_OFF), (LAS int*)(F.lds + TOKBUF_OFF), 4, (const float*)(F.ws + WS_RSTDW), (const float*)(F.ws + WS_GATEW)};
        EpiSwiGLU E{(bf16*)(F.ws + WS_HDN), (const LAS float*)(F.lds + TOKBUF_OFF + 2048), (const LAS int*)(F.lds + TBL_OFF), 0};
        pg8::gemm_phase_g<EpiSwiGLU, MoeOrder>(F.lds + RING_OFF, g, S, E, GA);
        {
            const int units = S.T[TBL_NT] * 4, rounds = (units + F.G - 1) / F.G, first_idle = units - (rounds - 1) * F.G, nidle = F.G - first_idle;
            const int base = NITEMS - TAIL6_ITEMS; int mid = base + nidle * NWAVES * TAIL6_PER_WAVE; if (mid > NITEMS) mid = NITEMS;
            if (nidle > 0 && F.vcu >= first_idle) conv_range(F, base + (F.vcu - first_idle) * NWAVES + F.wave, nidle * NWAVES, mid);
            conv_range(F, mid + F.vcu * NWAVES + F.wave, F.G * NWAVES, NITEMS);
        }
        SEAM(6);
    }
    if (IN(7)) {
        pg8::Gemm g{(const bf16*)(F.ws + WS_HDN), (const bf16*)(F.ws + WS_WD), 0, 0, DEXP}; MoeOrder S{(const LAS int*)(F.lds + TBL_OFF), 8, F.G, F.vcu};
        EpiY E{(bf16*)(F.ws + WS_Y)};
        pg8::gemm_phase<EpiY, MoeOrder, true, true>(F.lds + RING_OFF, g, S, E);
        SEAM(7);
    }
    if (IN(8)) p8_combine(F);
#undef IN
#undef SEAM
}

extern "C" void kernel_launch(void* const* d_in, const int* in_sizes, int n_in, void* d_out, int out_size, void* d_ws, size_t ws_size, hipStream_t stream) {
    static int grid = 0;
    if (grid == 0) {
        if (n_in != 19 || out_size != NTOK * DM || ws_size < WS_END) { fprintf(stderr, "kernel_launch: unexpected shapes (n_in %d out %d ws %zu)\n", n_in, out_size, ws_size); grid = -1; return; }
        int dev = 0, cus = 0, per_cu = 0;
        if (hipGetDevice(&dev) != hipSuccess || hipDeviceGetAttribute(&cus, hipDeviceAttributeMultiprocessorCount, dev) != hipSuccess) { grid = -1; return; }
        if (hipFuncSetAttribute((const void*)mk_fwd, hipFuncAttributeMaxDynamicSharedMemorySize, LDS_BYTES) != hipSuccess) { fprintf(stderr, "kernel_launch: hipFuncSetAttribute failed\n"); grid = -1; return; }
        if (hipOccupancyMaxActiveBlocksPerMultiprocessor(&per_cu, (const void*)mk_fwd, NWAVES * 64, LDS_BYTES) != hipSuccess || per_cu < 1) { fprintf(stderr, "kernel_launch: occupancy query reports %d\n", per_cu); }
        (void)hipGetLastError();
        grid = cus;
    }
    if (grid < 0) return;
    (void)hipMemsetAsync((char*)d_ws + WS_CTL, 0, CTL_ZERO_BYTES, stream);
    Args a{};
    for (int i = 0; i < 19; ++i) a.in[i] = (const float*)d_in[i];
    a.out = (float*)d_out; a.ws = (unsigned char*)d_ws;
#if MK_N_LAUNCHES == 1
    a.ph_lo = 0; a.ph_hi = N_PHASES; a.li = 0;
    hipLaunchKernelGGL(mk_fwd, dim3(grid), dim3(NWAVES * 64), LDS_BYTES, stream, a);
#else
    a.li = 0;
    for (int p = 0; p < N_PHASES; ++p) { a.ph_lo = p; a.ph_hi = p + 1; hipLaunchKernelGGL(mk_fwd, dim3(grid), dim3(NWAVES * 64), LDS_BYTES, stream, a); }
#endif
}
```

```cpp
#include <hip/hip_runtime.h>
#include <cstdio>
#include <cstdint>
namespace pg8 {
#define PG8_LAS __attribute__((address_space(3)))
typedef unsigned short bf16_t;
typedef short bf16x8 __attribute__((ext_vector_type(8)));
typedef float f32x4 __attribute__((ext_vector_type(4)));
typedef unsigned u32x4 __attribute__((ext_vector_type(4)));
constexpr int BM = 256, BK = 64, HALF = 128, HTB = HALF * BK * 2  , STAGE_BYTES = 8 * HTB, NXCD = 8, WGM = 8;

__host__ __device__ __forceinline__ int lds_byte(int r, int c) { const int st = (r >> 4) * 2 + (c >> 5), rr = r & 15, cc = c & 31, ob = rr * 64 + cc * 2; return st * 1024 + (ob ^ (((ob >> 9) & 1) << 5)); }
__host__ __device__ __forceinline__ void stage_rc(int b, int& R, int& C) { const int st = b / 1024, sb = b % 1024, swz = sb ^ (((sb >> 9) & 1) << 5); R = (st >> 1) * 16 + swz / 64; C = (st & 1) * 32 + (swz % 64) / 2; }
__host__ __device__ __forceinline__ int perm32(int rho) { const int n = rho >> 4, i = rho & 15; return 8 * (i >> 2) + 4 * n + (i & 3); }

struct Unit { int pm, pn; };
struct Gemm { const bf16_t* A; const bf16_t* Bt; int M, N, K; };

struct StaticOrder {
    int nM, nN, nwg, G, c;
    __host__ __device__ void init(int M, int N, int G_, int c_) { nM = M / BM; nN = N / BM; nwg = nM * nN; G = G_; c = c_; }
    __host__ __device__ bool next(int i, Unit& u) const {
        const long L = (long)i * G + c; if (L >= nwg) return false;
        int wgid = (int)L; { const int q = nwg / NXCD, r = nwg % NXCD, xcd = wgid % NXCD, off = wgid / NXCD; wgid = (xcd < r ? xcd * (q + 1) : r * (q + 1) + (xcd - r) * q) + off; }
        const int nig = WGM * nN, gid = wgid / nig, fm = gid * WGM, gsz = (nM - fm) < WGM ? (nM - fm) : WGM;
        u.pm = fm + ((wgid % nig) % gsz); u.pn = (wgid % nig) / gsz; return true;
    }
    __device__ __forceinline__ void a_ready(const Unit&) const {}
    __device__ __forceinline__ void done(const Unit&) const {}
};

__device__ __forceinline__ unsigned cvt_pk_bf16(float lo, float hi) { unsigned r; asm volatile("v_cvt_pk_bf16_f32 %0, %1, %2" : "=v"(r) : "v"(lo), "v"(hi)); return r; }
typedef float f32x2 __attribute__((ext_vector_type(2)));
__device__ __forceinline__ f32x2 gelu_pk(f32x2 v) {
    const f32x2 av = __builtin_elementwise_abs(v), d = av * 0.2316418882f + 1.0f;
    f32x2 t; t.x = __builtin_amdgcn_rcpf(d.x); t.y = __builtin_amdgcn_rcpf(d.y);
    f32x2 q = t * 0.5307027145f + (-0.7265760135f); q = q * t + 0.7107068705f; q = q * t + (-0.142248368f); q = q * t + 0.127414796f; q = q * t;
    const f32x2 s = (v * v) * (-0.72134752044f);
    f32x2 e; e.x = __builtin_amdgcn_exp2f(s.x); e.y = __builtin_amdgcn_exp2f(s.y);
    const f32x2 m = v * (q * e), r = v - m;
    f32x2 o; o.x = v.x < 0.f ? m.x : r.x; o.y = v.y < 0.f ? m.y : r.y; return o;
}

template <int ACT  > struct EpiBf16 {
    static constexpr bool PERM = true, AFTER_DRAIN = false; static_assert(ACT == 0 || ACT == 1, "EpiBf16: ACT is 0 (none) or 1 (gelu_pk)");
    bf16_t* O; int ldc; const float* bias; int split_cols; size_t split_stride; float scale0;
    __device__ __forceinline__ void operator()(const f32x4 (&acc)[2][2][4][2], const Unit& u, int wr, int wc, int fr, int fq) const {
        const int row0 = u.pm * BM + wr * 64 + fr; int colt = u.pn * BM; bf16_t* base = O;
        float sc = 1.f; if (split_cols) { const int t = colt / split_cols; base += (size_t)t * split_stride; colt -= t * split_cols; if (t == 0) sc = scale0; }
        const int col0 = colt + wc * 32 + 8 * fq, bcol0 = u.pn * BM + wc * 32 + 8 * fq;
        f32x4 bv[2][2];
#pragma unroll
        for (int bj = 0; bj < 2; ++bj)
#pragma unroll
            for (int n = 0; n < 2; ++n) bv[bj][n] = bias ? *(const f32x4*)(bias + bcol0 + bj * HALF + 4 * n) : (f32x4){0.f, 0.f, 0.f, 0.f};
#pragma unroll
        for (int ai = 0; ai < 2; ++ai)
#pragma unroll
            for (int m = 0; m < 4; ++m) { bf16_t* rowp = base + (size_t)(row0 + ai * HALF + m * 16) * ldc + col0;
#pragma unroll
                for (int bj = 0; bj < 2; ++bj) { f32x4 v0 = acc[ai][bj][m][0] + bv[bj][0], v1 = acc[ai][bj][m][1] + bv[bj][1];
                    if (ACT == 1) { f32x2 a = gelu_pk((f32x2){v0[0], v0[1]}), b = gelu_pk((f32x2){v0[2], v0[3]}), c = gelu_pk((f32x2){v1[0], v1[1]}), d = gelu_pk((f32x2){v1[2], v1[3]});
                        v0 = (f32x4){a.x, a.y, b.x, b.y}; v1 = (f32x4){c.x, c.y, d.x, d.y}; }
                    v0 = v0 * sc; v1 = v1 * sc; u32x4 w; w.x = cvt_pk_bf16(v0[0], v0[1]); w.y = cvt_pk_bf16(v0[2], v0[3]); w.z = cvt_pk_bf16(v1[0], v1[1]); w.w = cvt_pk_bf16(v1[2], v1[3]);
                    *(u32x4*)(rowp + bj * HALF) = w; } }
    }
};

struct PanelStats {
    unsigned* xbuf;
    unsigned* cnt;
    unsigned* tmo;
    int ntn; float eps;
    unsigned code;
    __device__ __forceinline__ bool run(const f32x4 (&v)[2][2][4][2], const Unit& u, int wr, int wc, int fr, int fq, PG8_LAS unsigned char* lds, int wid, int lane) const {
        typedef float f32x2v __attribute__((ext_vector_type(2)));
        PG8_LAS f32x2v* P = (PG8_LAS f32x2v*)lds;
        PG8_LAS f32x2v* S = (PG8_LAS f32x2v*)(lds + 8192);
        PG8_LAS unsigned* flag = (PG8_LAS unsigned*)(lds + 8192 + 2048);
#pragma unroll
        for (int ai = 0; ai < 2; ++ai)
#pragma unroll
            for (int m = 0; m < 4; ++m) {
                float s = 0.f;
#pragma unroll
                for (int bj = 0; bj < 2; ++bj)
#pragma unroll
                    for (int n = 0; n < 2; ++n) { const f32x4 x = v[ai][bj][m][n]; s += (x[0] + x[1]) + (x[2] + x[3]); }
                s += __shfl_xor(s, 16); s += __shfl_xor(s, 32);
                const float mw = s * (1.0f / 64.0f); float q = 0.f;
#pragma unroll
                for (int bj = 0; bj < 2; ++bj)
#pragma unroll
                    for (int n = 0; n < 2; ++n) { const f32x4 d = v[ai][bj][m][n] - mw; q += (d[0] * d[0] + d[1] * d[1]) + (d[2] * d[2] + d[3] * d[3]); }
                q += __shfl_xor(q, 16); q += __shfl_xor(q, 32);
                if (fq == 0) P[(ai * HALF + wr * 64 + m * 16 + fr) * 4 + wc] = (f32x2v){mw, q};
            }
        asm volatile("s_waitcnt lgkmcnt(0)" ::: "memory"); __builtin_amdgcn_s_barrier(); asm volatile("" ::: "memory");
#if defined(BROKEN_EXCHANGE_NO_WAIT)
#warning BROKEN CONTROL BUILD: the row-statistics exchange does not wait; results are wrong by design
        if (blockIdx.x >= 64) { const long long t0_ = clock64(); while (clock64() - t0_ < 60000) __builtin_amdgcn_s_sleep(8); }
#endif
        const int row = wid * 32 + (lane & 31);
        if (lane < 32) {
            const f32x2v a = P[row * 4 + 0], b = P[row * 4 + 1], c = P[row * 4 + 2], d = P[row * 4 + 3];
            const float mt = (a.x + b.x + c.x + d.x) * 0.25f;
            const float da = a.x - mt, db = b.x - mt, dc = c.x - mt, dd = d.x - mt;
            const float m2 = (a.y + b.y) + (c.y + d.y) + 64.0f * ((da * da + db * db) + (dc * dc + dd * dd));
            unsigned long long* slot = (unsigned long long*)xbuf + ((size_t)(u.pm * BM + row) * 4 + u.pn);
            __hip_atomic_store(slot, ((unsigned long long)__float_as_uint(m2) << 32) | __float_as_uint(mt), __ATOMIC_RELAXED, __HIP_MEMORY_SCOPE_AGENT);
        }
        asm volatile("s_waitcnt vmcnt(0)" ::: "memory");
        if (lane == 0) __hip_atomic_fetch_add(cnt + 64 * u.pm, 1u, __ATOMIC_RELAXED, __HIP_MEMORY_SCOPE_AGENT);
        if (wid == 0) {
            bool dead = false; const unsigned long long t0 = __builtin_amdgcn_s_memrealtime(); const unsigned want = 8u * (unsigned)ntn;
            for (;;) {
#if defined(BROKEN_EXCHANGE_NO_WAIT)
                break;
#endif
                if ((unsigned)__builtin_amdgcn_readfirstlane(__hip_atomic_load(cnt + 64 * u.pm, __ATOMIC_RELAXED, __HIP_MEMORY_SCOPE_AGENT)) >= want) break;
                if (__builtin_amdgcn_s_memrealtime() - t0 > 2000000ull) {
                    if (lane == 0) { unsigned expect = 0u; __hip_atomic_compare_exchange_strong(tmo + 1, &expect, code | (unsigned)(u.pm & 0xff), __ATOMIC_RELAXED, __ATOMIC_RELAXED, __HIP_MEMORY_SCOPE_AGENT);
                                     __hip_atomic_store(tmo, 1u, __ATOMIC_RELAXED, __HIP_MEMORY_SCOPE_AGENT); }
                    dead = true; break; }
                __builtin_amdgcn_s_sleep(2);
            }
            __builtin_amdgcn_fence(__ATOMIC_ACQUIRE, "agent");
            if (lane == 0) flag[0] = dead ? 1u : 0u;
        }
        asm volatile("s_waitcnt vmcnt(0) lgkmcnt(0)" ::: "memory"); __builtin_amdgcn_s_barrier(); asm volatile("" ::: "memory");
        const bool bad = flag[0] != 0u;
        if (lane < 32) {
            const unsigned long long* slot = (const unsigned long long*)xbuf + (size_t)(u.pm * BM + row) * 4; float mt[4], m2[4]; float ms = 0.f;
#pragma unroll
            for (int t = 0; t < 4; ++t) { if (t < ntn) { const unsigned long long w = __hip_atomic_load(slot + t, __ATOMIC_RELAXED, __HIP_MEMORY_SCOPE_AGENT); mt[t] = __uint_as_float((unsigned)w); m2[t] = __uint_as_float((unsigned)(w >> 32)); } else { mt[t] = 0.f; m2[t] = 0.f; } ms += mt[t]; }
            const float mean = ms / (float)ntn; float q = 0.f;
#pragma unroll
            for (int t = 0; t < 4; ++t) if (t < ntn) { const float dm = mt[t] - mean; q += m2[t] + 256.0f * dm * dm; }
            S[row] = (f32x2v){mean, 1.0f / sqrtf(q / (256.0f * (float)ntn) + eps)};
        }
        asm volatile("s_waitcnt lgkmcnt(0)" ::: "memory"); __builtin_amdgcn_s_barrier(); asm volatile("" ::: "memory");
        return bad;
    }
};
struct EpiLnRes {
    static constexpr bool PERM = false, AFTER_DRAIN = true;
    const float* base; float* out; int ldc; const float* bias; PanelStats st; unsigned poison;
    __device__ __forceinline__ void fused(f32x4 (&acc)[2][2][4][2], const Unit& u, int wr, int wc, int fr, int fq, PG8_LAS unsigned char* lds, int wid, int lane) const {
        typedef float f32x2v __attribute__((ext_vector_type(2)));
        const PG8_LAS f32x2v* S = (const PG8_LAS f32x2v*)(lds + 8192);
        const int col0 = u.pn * BM + wc * 32 + 4 * fq;
#pragma unroll
        for (int bj = 0; bj < 2; ++bj)
#pragma unroll
            for (int n = 0; n < 2; ++n) { const f32x4 bv = bias ? *(const f32x4*)(bias + col0 + bj * HALF + n * 16) : (f32x4){0.f, 0.f, 0.f, 0.f};
#pragma unroll
                for (int ai = 0; ai < 2; ++ai)
#pragma unroll
                    for (int m = 0; m < 4; ++m) acc[ai][bj][m][n] += bv; }
        f32x4 pre[4][2][2];
#pragma unroll
        for (int m = 0; m < 4; ++m) { const size_t off = (size_t)(u.pm * BM + wr * 64 + m * 16 + fr) * ldc + col0;
#pragma unroll
            for (int bj = 0; bj < 2; ++bj)
#pragma unroll
                for (int n = 0; n < 2; ++n) pre[m][bj][n] = *(const f32x4*)(base + off + bj * HALF + n * 16); }
        const bool bad = st.run(acc, u, wr, wc, fr, fq, lds, wid, lane) || poison != 0u;
        const float qnan = __builtin_nanf("");
#pragma unroll
        for (int ai = 0; ai < 2; ++ai)
#pragma unroll
            for (int m = 0; m < 4; ++m) { const int r = ai * HALF + wr * 64 + m * 16 + fr; const f32x2v sr = S[r]; const size_t off = (size_t)(u.pm * BM + r) * ldc + col0;
#pragma unroll
                for (int bj = 0; bj < 2; ++bj)
#pragma unroll
                    for (int n = 0; n < 2; ++n) { const f32x4 bs = ai == 0 ? pre[m][bj][n] : *(const f32x4*)(base + off + bj * HALF + n * 16); f32x4 o = bs + (acc[ai][bj][m][n] - sr.x) * sr.y;
                        if (bad) o = (f32x4){qnan, qnan, qnan, qnan}; *(f32x4*)(out + off + bj * HALF + n * 16) = o; }
                if (m & 1) asm volatile("" ::: "memory"); }
    }
};
struct EpiLnResLn {
    static constexpr bool PERM = false, AFTER_DRAIN = true;
    const float* base; float* out; bf16_t* xn; int ldc; const float* bias; PanelStats st1, st2; unsigned poison;
    __device__ __forceinline__ void fused(f32x4 (&acc)[2][2][4][2], const Unit& u, int wr, int wc, int fr, int fq, PG8_LAS unsigned char* lds, int wid, int lane) const {
        typedef float f32x2v __attribute__((ext_vector_type(2))); typedef unsigned u32x2v __attribute__((ext_vector_type(2)));
        const PG8_LAS f32x2v* S = (const PG8_LAS f32x2v*)(lds + 8192);
        const int col0 = u.pn * BM + wc * 32 + 4 * fq;
#pragma unroll
        for (int bj = 0; bj < 2; ++bj)
#pragma unroll
            for (int n = 0; n < 2; ++n) { const f32x4 bv = bias ? *(const f32x4*)(bias + col0 + bj * HALF + n * 16) : (f32x4){0.f, 0.f, 0.f, 0.f};
#pragma unroll
                for (int ai = 0; ai < 2; ++ai)
#pragma unroll
                    for (int m = 0; m < 4; ++m) acc[ai][bj][m][n] += bv; }
        bool bad = st1.run(acc, u, wr, wc, fr, fq, lds, wid, lane) || poison != 0u;
        const float qnan = __builtin_nanf("");
#pragma unroll
        for (int ai = 0; ai < 2; ++ai)
#pragma unroll
            for (int m = 0; m < 4; ++m) { const int r = ai * HALF + wr * 64 + m * 16 + fr; const f32x2v sr = S[r]; const size_t off = (size_t)(u.pm * BM + r) * ldc + col0;
#pragma unroll
                for (int bj = 0; bj < 2; ++bj)
#pragma unroll
                    for (int n = 0; n < 2; ++n) { const f32x4 bs = *(const f32x4*)(base + off + bj * HALF + n * 16); acc[ai][bj][m][n] = bs + (acc[ai][bj][m][n] - sr.x) * sr.y; }
                asm volatile("" : "+v"(acc[ai][0][m][0]), "+v"(acc[ai][0][m][1]), "+v"(acc[ai][1][m][0]), "+v"(acc[ai][1][m][1]));
                if (m & 1) asm volatile("" ::: "memory"); }
        const bool bad1 = bad;
        bad = st2.run(acc, u, wr, wc, fr, fq, lds, wid, lane) || bad;
#pragma unroll
        for (int ai = 0; ai < 2; ++ai)
#pragma unroll
            for (int m = 0; m < 4; ++m) { const int r = ai * HALF + wr * 64 + m * 16 + fr; const f32x2v sr = S[r]; const size_t off = (size_t)(u.pm * BM + r) * ldc + col0;
#pragma unroll
                for (int bj = 0; bj < 2; ++bj)
#pragma unroll
                    for (int n = 0; n < 2; ++n) { const f32x4 x1 = acc[ai][bj][m][n]; *(f32x4*)(out + off + bj * HALF + n * 16) = bad1 ? (f32x4){qnan, qnan, qnan, qnan} : x1;
                        const f32x4 o = (x1 - sr.x) * sr.y; u32x2v w; w.x = cvt_pk_bf16(o[0], o[1]); w.y = cvt_pk_bf16(o[2], o[3]);
                        if (bad) { w.x = 0x7fc07fc0u; w.y = 0x7fc07fc0u; } *(u32x2v*)(xn + off + bj * HALF + n * 16) = w; }
                asm volatile("" ::: "memory"); }
    }
};

template <class Epi, class Sched, bool ALIGN_EPI = false, bool SP2 = false>
__device__ __forceinline__ void gemm_phase(PG8_LAS unsigned char* lds, const Gemm g, const Sched& S, const Epi& E) {
    const int tid = threadIdx.x, wid = __builtin_amdgcn_readfirstlane(tid >> 6), lane = tid & 63, wr = wid >> 2, wc = wid & 3, fr = lane & 15, fq = lane >> 4;
    const int K = g.K, nt = K / BK;
    unsigned voffA[2], voffB[2];
#pragma unroll
    for (int i = 0; i < 2; ++i) { int R, C; stage_rc(tid * 16 + i * 8192, R, C); const int Rb = Epi::PERM ? ((R & ~31) + perm32(R & 31)) : R;
        voffA[i] = (unsigned)(R * K + C) * 2u; voffB[i] = (unsigned)(Rb * K + C) * 2u; }
    const size_t kstep = (size_t)(BK * 2);
    const size_t hstep = (size_t)HALF * K * 2;
    const size_t tstep = 2 * hstep;
    const unsigned ldsw = (unsigned)wid * 1024u;
    const int aoff = lds_byte(wr * 64 + fr, fq * 8), boff = lds_byte(wc * 32 + fr, fq * 8);
#define PG8_SA(b, h) (((b) * 2 + (h)) * HTB)
#define PG8_SB(b, h) ((4 + (b) * 2 + (h)) * HTB)
#define PG8_STAGE(bufoff, gbase, voff) do { _Pragma("unroll") for (int _i = 0; _i < 2; ++_i) \
        __builtin_amdgcn_global_load_lds((const unsigned*)((const char*)(gbase) + (voff)[_i]), (PG8_LAS unsigned*)(lds + (bufoff) + ldsw + _i * 8192), 16, 0, 0); } while (0)
#define PG8_LDA(dst, b, h) do { _Pragma("unroll") for (int m = 0; m < 4; ++m) _Pragma("unroll") for (int k = 0; k < 2; ++k) dst[m][k] = *(const PG8_LAS bf16x8*)(lds + PG8_SA(b, h) + aoff + m * 2048 + k * 1024); } while (0)
#define PG8_LDB(dst, b, h) do { _Pragma("unroll") for (int n = 0; n < 2; ++n) _Pragma("unroll") for (int k = 0; k < 2; ++k) dst[n][k] = *(const PG8_LAS bf16x8*)(lds + PG8_SB(b, h) + boff + n * 2048 + k * 1024); } while (0)
#define PG8_MMA(ai, bj, At, Bt) do { __builtin_amdgcn_s_setprio(1); _Pragma("unroll") for (int m = 0; m < 4; ++m) _Pragma("unroll") for (int n = 0; n < 2; ++n) _Pragma("unroll") for (int k = 0; k < 2; ++k) \
        acc[ai][bj][m][n] = __builtin_amdgcn_mfma_f32_16x16x32_bf16(Bt[n][k], At[m][k], acc[ai][bj][m][n], 0, 0, 0); __builtin_amdgcn_s_setprio(0); } while (0)
#define PG8_WAIT_V(n) asm volatile("s_waitcnt vmcnt(" #n ")" ::: "memory")
#define PG8_WAIT_L(n) asm volatile("s_waitcnt lgkmcnt(" #n ")" ::: "memory")
#define PG8_BAR __builtin_amdgcn_s_barrier()
#define PG8_SCHED __builtin_amdgcn_sched_barrier(0)
    Unit cur, nxt; int ui = 0;
    if (!S.next(0, cur)) return;
    f32x4 acc[2][2][4][2];
#pragma unroll
    for (int a = 0; a < 2; ++a)
#pragma unroll
        for (int b = 0; b < 2; ++b)
#pragma unroll
            for (int m = 0; m < 4; ++m)
#pragma unroll
                for (int n = 0; n < 2; ++n) acc[a][b][m][n] = (f32x4){0.f, 0.f, 0.f, 0.f};
    bf16x8 At[4][2], B0[2][2], B1[2][2];
    const char* cA = (const char*)g.A + (size_t)cur.pm * tstep; const char* cB = (const char*)g.Bt + (size_t)cur.pn * tstep;
    S.a_ready(cur);
    if constexpr (SP2) {
        PG8_STAGE(PG8_SB(0, 0), cB, voffB); PG8_STAGE(PG8_SB(0, 1), cB + hstep, voffB); PG8_STAGE(PG8_SA(0, 0), cA, voffA); PG8_STAGE(PG8_SA(0, 1), cA + hstep, voffA);
        if (wr == 1) PG8_BAR;
        PG8_WAIT_V(2); PG8_BAR;
        PG8_STAGE(PG8_SB(1, 0), cB + kstep, voffB); PG8_STAGE(PG8_SA(1, 0), cA + kstep, voffA); PG8_STAGE(PG8_SB(1, 1), cB + hstep + kstep, voffB);
        PG8_WAIT_V(6); PG8_BAR;
    } else {
        PG8_STAGE(PG8_SB(0, 0), cB, voffB); PG8_STAGE(PG8_SA(0, 0), cA, voffA); PG8_STAGE(PG8_SB(0, 1), cB + hstep, voffB); PG8_STAGE(PG8_SA(0, 1), cA + hstep, voffA);
        if (wr == 1) PG8_BAR;
        PG8_WAIT_V(4); PG8_BAR;
        PG8_STAGE(PG8_SB(1, 0), cB + kstep, voffB); PG8_STAGE(PG8_SA(1, 0), cA + kstep, voffA); PG8_STAGE(PG8_SB(1, 1), cB + hstep + kstep, voffB);
        PG8_WAIT_V(6); PG8_BAR;
    }
    int t_mid = nt >> 1; if constexpr (Epi::MIDK) asm volatile("" : "+s"(t_mid));
    for (;;) {
        const bool has_next = S.next(ui + 1, nxt);
        const char* nA = has_next ? (const char*)g.A + (size_t)nxt.pm * tstep : cA; const char* nB = has_next ? (const char*)g.Bt + (size_t)nxt.pn * tstep : cB;
        for (int t = 0; t < nt; t += 2) {
            const bool last = (t == nt - 2);
            if constexpr (Epi::MIDK) { if (t == t_mid) E.midk(acc, cur, wr, fr); }
            const char* a1 = cA + (size_t)(t + 1) * kstep;
            const char* a2 = last ? nA : cA + (size_t)(t + 2) * kstep; const char* b2 = last ? nB : cB + (size_t)(t + 2) * kstep;
            const char* a3 = a2 + kstep; const char* b3 = b2 + kstep;
            if (last && has_next) S.a_ready(nxt);
            if constexpr (SP2) {
            PG8_LDB(B0, 0, 0); PG8_LDB(B1, 0, 1); PG8_SCHED; PG8_LDA(At, 0, 0); PG8_STAGE(PG8_SA(1, 1), a1 + hstep, voffA);
            PG8_WAIT_V(8); PG8_WAIT_L(0); PG8_BAR; PG8_MMA(0, 0, At, B0); PG8_MMA(0, 1, At, B1); PG8_BAR; PG8_SCHED;
            PG8_LDA(At, 0, 1); PG8_STAGE(PG8_SB(0, 0), b2, voffB); PG8_STAGE(PG8_SB(0, 1), b2 + hstep, voffB); PG8_STAGE(PG8_SA(0, 0), a2, voffA);
            PG8_WAIT_V(8); PG8_WAIT_L(0); PG8_BAR; PG8_MMA(1, 0, At, B0); PG8_MMA(1, 1, At, B1); PG8_BAR; PG8_SCHED;
            PG8_LDB(B0, 1, 0); PG8_LDB(B1, 1, 1); PG8_SCHED; PG8_LDA(At, 1, 0); PG8_STAGE(PG8_SA(0, 1), a2 + hstep, voffA);
            PG8_WAIT_V(8); PG8_WAIT_L(0); PG8_BAR; PG8_MMA(0, 0, At, B0); PG8_MMA(0, 1, At, B1); PG8_BAR; PG8_SCHED;
            PG8_LDA(At, 1, 1); PG8_STAGE(PG8_SB(1, 0), b3, voffB); PG8_STAGE(PG8_SB(1, 1), b3 + hstep, voffB); PG8_STAGE(PG8_SA(1, 0), a3, voffA);
            PG8_WAIT_V(8); PG8_WAIT_L(0); PG8_BAR; PG8_MMA(1, 0, At, B0); PG8_MMA(1, 1, At, B1); PG8_BAR; PG8_SCHED;
            } else {
            PG8_LDB(B0, 0, 0); PG8_SCHED; PG8_LDA(At, 0, 0); PG8_STAGE(PG8_SA(1, 1), a1 + hstep, voffA);
            PG8_WAIT_L(8); PG8_BAR; PG8_WAIT_L(0); PG8_MMA(0, 0, At, B0); PG8_BAR; PG8_SCHED;
            PG8_LDB(B1, 0, 1); PG8_STAGE(PG8_SB(0, 0), b2, voffB);
            PG8_BAR; PG8_WAIT_L(0); PG8_MMA(0, 1, At, B1); PG8_BAR;
            PG8_LDA(At, 0, 1); PG8_STAGE(PG8_SA(0, 0), a2, voffA);
            PG8_BAR; PG8_WAIT_L(0); PG8_MMA(1, 0, At, B0); PG8_BAR; PG8_SCHED;
            PG8_STAGE(PG8_SB(0, 1), b2 + hstep, voffB);
            PG8_WAIT_V(6); PG8_BAR; PG8_MMA(1, 1, At, B1); PG8_BAR;
            PG8_LDB(B0, 1, 0); PG8_SCHED; PG8_LDA(At, 1, 0); PG8_STAGE(PG8_SA(0, 1), a2 + hstep, voffA);
            PG8_WAIT_L(8); PG8_BAR; PG8_WAIT_L(0); PG8_MMA(0, 0, At, B0); PG8_BAR; PG8_SCHED;
            PG8_LDB(B1, 1, 1); PG8_STAGE(PG8_SB(1, 0), b3, voffB);
            PG8_BAR; PG8_WAIT_L(0); PG8_MMA(0, 1, At, B1); PG8_BAR;
            PG8_LDA(At, 1, 1); PG8_STAGE(PG8_SA(1, 0), a3, voffA);
            PG8_BAR; PG8_WAIT_L(0); PG8_MMA(1, 0, At, B0); PG8_BAR; PG8_SCHED;
            PG8_STAGE(PG8_SB(1, 1), b3 + hstep, voffB);
            PG8_WAIT_V(6); PG8_BAR; PG8_MMA(1, 1, At, B1); PG8_BAR;
            }
        }
        if constexpr (ALIGN_EPI) { if (wr == 0) PG8_BAR; }
        if constexpr (!Epi::AFTER_DRAIN) { E(acc, cur, wr, wc, fr, fq); S.done(cur); }
        if (!has_next) break;
#pragma unroll
        for (int a = 0; a < 2; ++a)
#pragma unroll
            for (int b = 0; b < 2; ++b)
#pragma unroll
                for (int m = 0; m < 4; ++m)
#pragma unroll
                    for (int n = 0; n < 2; ++n) acc[a][b][m][n] = (f32x4){0.f, 0.f, 0.f, 0.f};
        cur = nxt; cA = nA; cB = nB; ++ui;
        if constexpr (ALIGN_EPI) { if (wr == 1) PG8_BAR; }
    }
    PG8_WAIT_V(0);
    if constexpr (!ALIGN_EPI) { if (wr == 0) PG8_BAR; }
    PG8_BAR;
    if constexpr (Epi::AFTER_DRAIN) { E.fused(acc, cur, wr, wc, fr, fq, lds, wid, lane); S.done(cur); }
#undef PG8_SA
#undef PG8_SB
#undef PG8_STAGE
#undef PG8_LDA
#undef PG8_LDB
#undef PG8_MMA
#undef PG8_WAIT_V
#undef PG8_WAIT_L
#undef PG8_BAR
#undef PG8_SCHED
}
}


#ifndef MK_N_LAUNCHES
#define MK_N_LAUNCHES 1
#endif
constexpr int N_PHASES = 9;
constexpr int NWAVES = 8;

constexpr int DM = 2048, BATCH = 4, SEQ = 4096, NTOK = BATCH * SEQ, NMETA = 16;
constexpr int MPAD = 16640, NTILE_X = MPAD / 256;
constexpr int N_QK = 3328, NT_QK = N_QK / 256;
constexpr int N_V = 1280, NT_V = N_V / 256;
constexpr int NT_W = NT_QK + NT_V;
constexpr int P1_UNITS_A = NTILE_X * NT_QK, P1_UNITS = P1_UNITS_A + NT_V * NTILE_X;
constexpr int NEXP = 64, DEXP = 512, MAXTILES = 192, SPAD = MAXTILES * 256;
constexpr float RMS_EPS = 1e-6f;
constexpr float LOG2E = 1.4426950408889634f;
constexpr float C2 = 0.125f * LOG2E;
constexpr float SB_EXIT = -150.0f;

constexpr size_t MiB = 1u << 20;
constexpr size_t WS_CTL = 0, CTL_ZERO_BYTES = 128 * 1024;
constexpr size_t WS_BIG = 1 * MiB;
constexpr size_t WS_QS = 84 * MiB, WS_KS = WS_QS + (size_t)MPAD * 1024 * 2, WS_QW = WS_KS + (size_t)MPAD * 1024 * 2, WS_KW = WS_QW + (size_t)MPAD * 1024 * 2;
constexpr size_t WS_VT = 190 * MiB;
constexpr size_t WS_MIXED = 231 * MiB, WS_HB = 295 * MiB;
constexpr size_t WS_Y = 1 * MiB;
constexpr size_t WS_PROJ = 359 * MiB;
constexpr size_t WS_HDN = 423 * MiB;
constexpr size_t WS_WOUT = 471 * MiB, WS_WR = 479 * MiB;
constexpr size_t WS_WGU = 480 * MiB, WS_WD = 736 * MiB;
constexpr size_t WS_LIST = 864 * MiB, WS_GATEW = 868 * MiB, WS_TOKINFO = 872 * MiB, WS_RSTD = 873 * MiB, WS_RSTDW = 874 * MiB;
constexpr size_t WS_RINV = 877 * MiB;
constexpr size_t WS_SSQ = 878 * MiB;
constexpr size_t WS_END = 880 * MiB;
static_assert(WS_RSTDW + (size_t)NEXP * NTOK * 4 <= WS_END, "ws map 4");
static_assert(WS_KW + (size_t)MPAD * 256 * 2 <= WS_VT && WS_VT + (size_t)N_V * MPAD * 2 <= WS_MIXED , "ws map 1");
static_assert(WS_Y + (size_t)SPAD * 2048 * 2 <= WS_MIXED && WS_HDN + (size_t)SPAD * 512 * 2 <= WS_WOUT && WS_HB + (size_t)NTOK * 2048 * 2 <= WS_HDN, "ws map 2");
static_assert(WS_BIG + (size_t)(NTILE_X + NT_W) * 256 * 2048 * 2 <= WS_QS, "ws map 3");
constexpr int CW_TMO = 0, CW_BAR = 4096, CW_CNT = 16384;

constexpr int RING_OFF = 0, RING_BYTES = 131072;
constexpr int MISC_OFF = RING_BYTES;
constexpr int TBL_OFF = MISC_OFF + 256;
constexpr int TBL_TSTART = 0, TBL_NT = 65, TBL_TE = 66, TBL_CNTS = 66 + MAXTILES, TBL_WORDS = 66 + MAXTILES + 64;
constexpr int TOKBUF_OFF = MISC_OFF + 4096;
constexpr int ATT_TBR_OFF = TOKBUF_OFF + 6144;
constexpr int LDS_BYTES = 163840;
static_assert(TBL_OFF + TBL_WORDS * 4 <= TOKBUF_OFF && TOKBUF_OFF + 6144 <= LDS_BYTES && ATT_TBR_OFF + 16 * 192 * 4 <= LDS_BYTES, "LDS map");

#define LAS __attribute__((address_space(3)))
typedef unsigned short bf16;
typedef unsigned v4u __attribute__((ext_vector_type(4)));
typedef unsigned v2u __attribute__((ext_vector_type(2)));
typedef float f32x4 __attribute__((ext_vector_type(4)));
typedef float f32x16 __attribute__((ext_vector_type(16)));
typedef short bf16x8 __attribute__((ext_vector_type(8)));
typedef _Float16 f16x8 __attribute__((ext_vector_type(8)));
typedef _Float16 f16x2 __attribute__((ext_vector_type(2)));
typedef float f32x2 __attribute__((ext_vector_type(2)));
typedef __bf16 bf16x2_t __attribute__((ext_vector_type(2)));
#define LDS_WAIT() asm volatile("s_waitcnt lgkmcnt(0)" ::: "memory")
#define VM_WAIT() asm volatile("s_waitcnt vmcnt(0)" ::: "memory")
__device__ __forceinline__ unsigned pk2(float lo, float hi) { f32x2 v = {lo, hi}; bf16x2_t b = __builtin_convertvector(v, bf16x2_t); return __builtin_bit_cast(unsigned, b); }
__device__ __forceinline__ float bf_lo(unsigned u) { return __uint_as_float(u << 16); }
__device__ __forceinline__ float bf_hi(unsigned u) { return __uint_as_float(u & 0xffff0000u); }
__device__ __forceinline__ float wave_sum(float v) {
#pragma unroll
    for (int o = 1; o < 64; o <<= 1) v += __shfl_xor(v, o);
    return v;
}
__device__ __forceinline__ int crow(int reg, int h) { return (reg & 3) + 8 * (reg >> 2) + 4 * h; }

#define XB_TMO      128
#define XB_XCNT(j)  (256  + 64 * (j))
#define XB_XSUB(j)  (1280 + 64 * (j))
#define XB_XGEN(j)  (2304 + 64 * (j))
#define XB_TOP      3328
#define XB_TOPGEN   3392
#define XCD_BAR_WORDS 3456
#define XB_SPIN_CAP (1u << 18)

__device__ __forceinline__ unsigned xb_ld(unsigned* p)              { return __hip_atomic_load(p, __ATOMIC_RELAXED, __HIP_MEMORY_SCOPE_AGENT); }
__device__ __forceinline__ unsigned xb_add(unsigned* p, unsigned v) { return __hip_atomic_fetch_add(p, v, __ATOMIC_RELAXED, __HIP_MEMORY_SCOPE_AGENT); }
__device__ __forceinline__ unsigned xb_xcc_id() { return (unsigned)__builtin_amdgcn_s_getreg((3 << 11) | 20) & 0xFu; }
#define XB_SPIN(cond, bar) do { unsigned _sp = 0; while (cond) { __builtin_amdgcn_s_sleep(1); \
    if ((++_sp & 255u) == 0u) { if (xb_ld(&(bar)[XB_TMO])) break; if (_sp > XB_SPIN_CAP) { atomicAdd(&(bar)[XB_TMO], 1u); break; } } } } while (0)

struct XcdBarrier {
    unsigned* bar; unsigned x;
    volatile LAS unsigned* st;
};

__device__ __forceinline__ XcdBarrier xcd_barrier_post(unsigned* bar, volatile LAS unsigned* st) {
    XcdBarrier b; b.bar = bar; b.x = xb_xcc_id(); b.st = st;
    if (threadIdx.x == 0) (void)xb_add(&bar[XB_XCNT(b.x)], 1u);
    return b;
}
__device__ __forceinline__ void xcd_barrier_complete(unsigned* bar, unsigned x, unsigned& nloc, unsigned& nx) {
    const unsigned G = gridDim.x * gridDim.y * gridDim.z;
    unsigned sum, cnt, mine, sp = 0u;
    for (;;) {
        sum = 0u; cnt = 0u; mine = 0u;
#pragma unroll
        for (unsigned j = 0; j < 16; ++j) { const unsigned c = xb_ld(&bar[XB_XCNT(j)]); sum += c; cnt += (c > 0u) ? 1u : 0u; mine = (j == x) ? c : mine; }
        if (sum == G) break;
        __builtin_amdgcn_s_sleep(1);
        if ((++sp & 255u) == 0u) { if (xb_ld(&bar[XB_TMO])) break; if (sp > XB_SPIN_CAP) { atomicAdd(&bar[XB_TMO], 1u); break; } }
    }
    nloc = mine > 0u ? mine : 1u; nx = cnt > 0u ? cnt : 1u;
}

__device__ __forceinline__ void xcd_barrier(const XcdBarrier& b) {
    asm volatile("s_waitcnt vmcnt(0)" ::: "memory");
    __syncthreads();
    if (threadIdx.x == 0) {
        unsigned* bar = b.bar;
        __builtin_amdgcn_s_waitcnt(0);
        unsigned nloc = b.st[0], nx = b.st[1];
        if (nloc == 0u) { xcd_barrier_complete(bar, b.x, nloc, nx); b.st[0] = nloc; b.st[1] = nx; }
        const unsigned old = xb_add(&bar[XB_XSUB(b.x)], 1u);
        const unsigned gen = old / nloc;
        if (old + 1u == (gen + 1u) * nloc) {
            __builtin_amdgcn_fence(__ATOMIC_RELEASE, "agent");
            asm volatile("s_waitcnt vmcnt(0)" ::: "memory");
            const unsigned og = xb_add(&bar[XB_TOP], 1u);
            const unsigned tg = og / nx;
            if (og + 1u == (tg + 1u) * nx) xb_add(&bar[XB_TOPGEN], 1u);
            else XB_SPIN(xb_ld(&bar[XB_TOPGEN]) == tg, bar);
            __builtin_amdgcn_fence(__ATOMIC_ACQUIRE, "agent");
            xb_add(&bar[XB_XGEN(b.x)], 1u);
            asm volatile("s_waitcnt vmcnt(0)" ::: "memory");
        } else {
            XB_SPIN(xb_ld(&bar[XB_XGEN(b.x)]) == gen, bar);
            __builtin_amdgcn_fence(__ATOMIC_ACQUIRE, "agent");
            asm volatile("s_waitcnt vmcnt(0)" ::: "memory");
        }
    }
    __syncthreads();
}


struct Args { const float* in[19]; float* out; unsigned char* ws; int ph_lo, ph_hi, li, pad; };
struct Frame {
    LAS unsigned char* lds; unsigned* ctl; unsigned char* ws;
    int tid, lane, wave, vcu, G;
    const float* const* in; float* out;
};

struct TrItem { f32x4 v[16]; f32x4 g[4]; };
__device__ __forceinline__ void tr_load(TrItem& t, const float* srcp, int ldsrc, const float* gp) {
#pragma unroll
    for (int i = 0; i < 16; ++i) t.v[i] = __builtin_nontemporal_load((const f32x4*)(srcp + (size_t)i * ldsrc));
    if (gp) {
#pragma unroll
        for (int i = 0; i < 4; ++i) t.g[i] = *(const f32x4*)(gp + 4 * i);
    } else {
#pragma unroll
        for (int i = 0; i < 4; ++i) t.g[i] = (f32x4){1.f, 1.f, 1.f, 1.f};
    }
}
__device__ __forceinline__ void tr_store(const TrItem& t, bf16* dstp, int ldd) {
#pragma unroll
    for (int j = 0; j < 4; ++j)
#pragma unroll
        for (int c = 0; c < 2; ++c) {
            v4u o;
            o.x = pk2(t.v[8 * c + 0][j] * t.g[2 * c][0], t.v[8 * c + 1][j] * t.g[2 * c][1]); o.y = pk2(t.v[8 * c + 2][j] * t.g[2 * c][2], t.v[8 * c + 3][j] * t.g[2 * c][3]);
            o.z = pk2(t.v[8 * c + 4][j] * t.g[2 * c + 1][0], t.v[8 * c + 5][j] * t.g[2 * c + 1][1]); o.w = pk2(t.v[8 * c + 6][j] * t.g[2 * c + 1][2], t.v[8 * c + 7][j] * t.g[2 * c + 1][3]);
            *(v4u*)(dstp + (size_t)j * ldd + 8 * c) = o;
        }
}
__device__ __forceinline__ int win_src_col(int P) {
    if (P < 2048) return P;
    if (P < 3328) { const int p = P - 2048, t = p >> 8, pp = p & 255, bj = pp >> 7, wc = (pp & 127) >> 5, i = pp & 31; return (t < 4 ? 3072 + t * 256 : 4096) + 64 * wc + 32 * bj + i; }
    if (P < 4352) return 2048 + (P - 3328);
    return P;
}
__device__ __forceinline__ float rms_row_to_bf16(const float* xrow, bf16* orow, int lane) {
    const f32x4* xr = (const f32x4*)xrow + lane;
    f32x4 v[8]; float s = 0.f;
#pragma unroll
    for (int j = 0; j < 8; ++j) { v[j] = xr[64 * j]; s += (v[j].x * v[j].x + v[j].y * v[j].y) + (v[j].z * v[j].z + v[j].w * v[j].w); }
    const float rinv = sqrtf(wave_sum(s) * (1.f / DM) + RMS_EPS), rstd = 1.0f / rinv;
    v2u* o8 = (v2u*)orow + lane;
#pragma unroll
    for (int j = 0; j < 8; ++j) { v2u w; w.x = pk2(v[j].x * rstd, v[j].y * rstd); w.y = pk2(v[j].z * rstd, v[j].w * rstd); o8[64 * j] = w; }
    return rinv;
}
constexpr int I_IN = 32 * 72, I_OUT = 32 * 32, I_GU = NEXP * 32 * 16, I_D = NEXP * 8 * 32;
constexpr int NITEMS = I_IN + I_OUT + I_GU + I_D;
constexpr int TAIL1_PER_WAVE = 8, TAIL6_PER_WAVE = 9, TAIL6_ITEMS = 9216;
#ifndef P2_ITEMS_DEF
#define P2_ITEMS_DEF 32896
#endif
constexpr int P2_ITEMS = P2_ITEMS_DEF;
#ifndef ATT_WAVES_DEF
#define ATT_WAVES_DEF 4
#endif
constexpr int ATT_WAVES = ATT_WAVES_DEF;
__device__ __forceinline__ void conv_range(Frame& F, int it0, int step, int end) {
    bf16* WIN = (bf16*)(F.ws + WS_BIG) + (size_t)MPAD * DM;
    const float* ln_mix = F.in[3]; const float* w_in = F.in[4];
    const float* on_sb = F.in[8]; const float* on_sw = F.in[9]; const float* w_out = F.in[10]; const float* ln_ffn = F.in[11];
    const float* w_gate = F.in[16]; const float* w_up = F.in[17]; const float* w_down = F.in[18];
    bf16* WOUT = (bf16*)(F.ws + WS_WOUT); bf16* WGU = (bf16*)(F.ws + WS_WGU); bf16* WD = (bf16*)(F.ws + WS_WD);
    const int kr = F.lane >> 4, nq = F.lane & 15;
#define P0_ITEM(it, SRCP, LDS_, GP, DSTP, LDD) do { int r_ = (it); \
        if (r_ < I_IN) { const int kb = r_ / 72, nb = r_ % 72, k0 = 64 * kb + 16 * kr; SRCP = w_in + (size_t)k0 * 4608 + win_src_col(64 * nb + 4 * nq); LDS_ = 4608; GP = ln_mix + k0; DSTP = WIN + (size_t)(64 * nb + 4 * nq) * DM + k0; LDD = DM; } \
        else if ((r_ -= I_IN) < I_OUT) { const int kb = r_ >> 5, nb = r_ & 31, k0 = 64 * kb + 16 * kr; SRCP = w_out + (size_t)k0 * DM + 64 * nb + 4 * nq; LDS_ = DM; GP = (k0 < 1024 ? on_sb + k0 : on_sw + (k0 - 1024)); DSTP = WOUT + (size_t)(64 * nb + 4 * nq) * DM + k0; LDD = DM; } \
        else if ((r_ -= I_OUT) < I_GU) { const int e = r_ >> 9, q = r_ & 511, kb = q >> 4, nb = q & 15, k0 = 64 * kb + 16 * kr, nt = nb >> 2, bj = (nb >> 1) & 1, j0 = (nb & 1) * 64; \
            SRCP = (bj ? w_up : w_gate) + (size_t)e * DM * DEXP + (size_t)k0 * DEXP + nt * 128 + j0 + 4 * nq; LDS_ = DEXP; GP = ln_ffn + k0; DSTP = WGU + ((size_t)e * 1024 + 64 * nb + 4 * nq) * DM + k0; LDD = DM; } \
        else { r_ -= I_GU; const int e = r_ >> 8, q = r_ & 255, kb = q >> 5, nb = q & 31, k0 = 64 * kb + 16 * kr; \
            SRCP = w_down + (size_t)e * DEXP * DM + (size_t)k0 * DM + 64 * nb + 4 * nq; LDS_ = DM; GP = nullptr; DSTP = WD + ((size_t)e * 2048 + 64 * nb + 4 * nq) * DEXP + k0; LDD = DEXP; } } while (0)
    {
        TrItem cur; const float* sp; const float* gp; bf16* dp; int lds_, ldd; bf16* dpn; int lddn;
        int it = it0;
        if (it < end) { P0_ITEM(it, sp, lds_, gp, dp, ldd); tr_load(cur, sp, lds_, gp); }
        while (it < end) {
            const int itn = it + step; TrItem nxt;
            if (itn < end) { P0_ITEM(itn, sp, lds_, gp, dpn, lddn); tr_load(nxt, sp, lds_, gp); }
            tr_store(cur, dp, ldd);
            if (itn < end) { cur = nxt; dp = dpn; ldd = lddn; }
            it = itn;
        }
    }
#undef P0_ITEM
}
__device__ __forceinline__ void conv_range3(Frame& F, int it0, int step, int end) {
    bf16* WIN = (bf16*)(F.ws + WS_BIG) + (size_t)MPAD * DM;
    const float* ln_mix = F.in[3]; const float* w_in = F.in[4];
    const float* on_sb = F.in[8]; const float* on_sw = F.in[9]; const float* w_out = F.in[10]; const float* ln_ffn = F.in[11];
    const float* w_gate = F.in[16]; const float* w_up = F.in[17]; const float* w_down = F.in[18];
    bf16* WOUT = (bf16*)(F.ws + WS_WOUT); bf16* WGU = (bf16*)(F.ws + WS_WGU); bf16* WD = (bf16*)(F.ws + WS_WD);
    const int kr = F.lane >> 4, nq = F.lane & 15;
#define P0_ITEM(it, SRCP, LDS_, GP, DSTP, LDD) do { int r_ = (it); \
        if (r_ < I_IN) { const int kb = r_ / 72, nb = r_ % 72, k0 = 64 * kb + 16 * kr; SRCP = w_in + (size_t)k0 * 4608 + win_src_col(64 * nb + 4 * nq); LDS_ = 4608; GP = ln_mix + k0; DSTP = WIN + (size_t)(64 * nb + 4 * nq) * DM + k0; LDD = DM; } \
        else if ((r_ -= I_IN) < I_OUT) { const int kb = r_ >> 5, nb = r_ & 31, k0 = 64 * kb + 16 * kr; SRCP = w_out + (size_t)k0 * DM + 64 * nb + 4 * nq; LDS_ = DM; GP = (k0 < 1024 ? on_sb + k0 : on_sw + (k0 - 1024)); DSTP = WOUT + (size_t)(64 * nb + 4 * nq) * DM + k0; LDD = DM; } \
        else if ((r_ -= I_OUT) < I_GU) { const int e = r_ >> 9, q = r_ & 511, kb = q >> 4, nb = q & 15, k0 = 64 * kb + 16 * kr, nt = nb >> 2, bj = (nb >> 1) & 1, j0 = (nb & 1) * 64; \
            SRCP = (bj ? w_up : w_gate) + (size_t)e * DM * DEXP + (size_t)k0 * DEXP + nt * 128 + j0 + 4 * nq; LDS_ = DEXP; GP = ln_ffn + k0; DSTP = WGU + ((size_t)e * 1024 + 64 * nb + 4 * nq) * DM + k0; LDD = DM; } \
        else { r_ -= I_GU; const int e = r_ >> 8, q = r_ & 255, kb = q >> 5, nb = q & 31, k0 = 64 * kb + 16 * kr; \
            SRCP = w_down + (size_t)e * DEXP * DM + (size_t)k0 * DM + 64 * nb + 4 * nq; LDS_ = DM; GP = nullptr; DSTP = WD + ((size_t)e * 2048 + 64 * nb + 4 * nq) * DEXP + k0; LDD = DEXP; } } while (0)
    struct V16 { f32x4 v[16]; };
#define C3_LOAD(B, it) do { if ((it) < end) { const float* sp_; const float* gp_; bf16* dp_; int ls_, ld_; P0_ITEM((it), sp_, ls_, gp_, dp_, ld_); (void)gp_; (void)dp_; (void)ld_; \
        _Pragma("unroll") for (int i_ = 0; i_ < 16; ++i_) B.v[i_] = __builtin_nontemporal_load((const f32x4*)(sp_ + (size_t)i_ * ls_)); } } while (0)
#define C3_STORE(B, it) do { if ((it) < end) { const float* sp_; const float* gp_; bf16* dp_; int ls_, ld_; P0_ITEM((it), sp_, ls_, gp_, dp_, ld_); (void)sp_; (void)ls_; \
        f32x4 g_[4]; _Pragma("unroll") for (int i_ = 0; i_ < 4; ++i_) g_[i_] = gp_ ? *(const f32x4*)(gp_ + 4 * i_) : (f32x4){1.f, 1.f, 1.f, 1.f}; \
        _Pragma("unroll") for (int j_ = 0; j_ < 4; ++j_) _Pragma("unroll") for (int c_ = 0; c_ < 2; ++c_) { v4u o_; \
            o_.x = pk2(B.v[8 * c_ + 0][j_] * g_[2 * c_][0], B.v[8 * c_ + 1][j_] * g_[2 * c_][1]); o_.y = pk2(B.v[8 * c_ + 2][j_] * g_[2 * c_][2], B.v[8 * c_ + 3][j_] * g_[2 * c_][3]); \
            o_.z = pk2(B.v[8 * c_ + 4][j_] * g_[2 * c_ + 1][0], B.v[8 * c_ + 5][j_] * g_[2 * c_ + 1][1]); o_.w = pk2(B.v[8 * c_ + 6][j_] * g_[2 * c_ + 1][2], B.v[8 * c_ + 7][j_] * g_[2 * c_ + 1][3]); \
            *(v4u*)(dp_ + (size_t)j_ * ld_ + 8 * c_) = o_; } } } while (0)
    {
        V16 A, B, C; int it = it0;
        C3_LOAD(A, it); C3_LOAD(B, it + step);
        while (it < end) {
            C3_LOAD(C, it + 2 * step); C3_STORE(A, it);
            C3_LOAD(A, it + 3 * step); C3_STORE(B, it + step);
            C3_LOAD(B, it + 4 * step); C3_STORE(C, it + 2 * step);
            it += 3 * step;
        }
    }
#undef C3_LOAD
#undef C3_STORE
#undef P0_ITEM
}
__device__ __forceinline__ int tail1_items(int G) { const int rounds = (P1_UNITS + G - 1) / G, nidle = rounds * G - P1_UNITS; return nidle * NWAVES * TAIL1_PER_WAVE; }
__device__ __forceinline__ void p0_prologue(Frame& F) {
    const int gw = F.vcu * NWAVES + F.wave, NGW = F.G * NWAVES;
    if (blockIdx.x == 0 && F.tid < NEXP) __hip_atomic_store(F.ctl + CW_CNT + 16 * F.tid, 0u, __ATOMIC_RELAXED, __HIP_MEMORY_SCOPE_AGENT);
    bf16* BIG = (bf16*)(F.ws + WS_BIG);
    bf16* WIN = BIG + (size_t)MPAD * DM;
    const float* x = F.in[0]; const float* meta = F.in[1]; const float* ln_mix = F.in[3]; const float* w_in = F.in[4];
    const float* on_sb = F.in[8]; const float* on_sw = F.in[9]; const float* w_out = F.in[10]; const float* ln_ffn = F.in[11];
    const float* w_rg = F.in[12]; const float* w_re = F.in[14]; const float* w_gate = F.in[16]; const float* w_up = F.in[17]; const float* w_down = F.in[18];
    for (int m = gw; m < MPAD; m += NGW) {
        bf16* orow = BIG + (size_t)m * DM;
        if (m < NTOK) { const float ri = rms_row_to_bf16(x + (size_t)m * DM, orow, F.lane); if (F.lane == 0) ((float*)(F.ws + WS_RINV))[m] = ri; }
        else if (m < NTOK + NMETA) (void)rms_row_to_bf16(meta + (size_t)(m - NTOK) * DM, orow, F.lane);
        else { v4u z = {0u, 0u, 0u, 0u}; v4u* o = (v4u*)orow + F.lane;
#pragma unroll
            for (int j = 0; j < 4; ++j) o[64 * j] = z; }
    }
    conv_range(F, gw, NGW, NITEMS - TAIL6_ITEMS - tail1_items(F.G) - P2_ITEMS);
    bf16* WRH = (bf16*)(F.ws + WS_WR); bf16* WRL = WRH + 96 * DM;
    for (int idx = (F.vcu * NWAVES * 64 + F.tid); idx < 96 * DM; idx += F.G * NWAVES * 64) {
        const int c = idx / DM, k = idx % DM;
        float v = 0.f; if (c < 8) v = w_rg[k * 8 + c]; else if (c < 72) v = w_re[k * 64 + (c - 8)];
        v *= ln_ffn[k];
        const unsigned hi = pk2(v, 0.f) & 0xffffu; const float lo = v - __uint_as_float(hi << 16);
        const int fidx = ((((k >> 4) * 3 + (c >> 5)) * 64 + (((k >> 3) & 1) * 32 + (c & 31))) << 3) + (k & 7);
        WRH[fidx] = (bf16)hi; WRL[fidx] = (bf16)(pk2(lo, 0.f) & 0xffffu);
    }
}

struct P1Order {
    int G, c;
    __device__ bool next(int i, pg8::Unit& u) const {
        const int L = i * G + c; if (L >= P1_UNITS) return false;
        if (L < P1_UNITS_A) { u.pm = L / NT_QK; u.pn = NTILE_X + (L % NT_QK); }
        else { const int l = L - P1_UNITS_A; u.pm = NTILE_X + NT_QK + l / NTILE_X; u.pn = l % NTILE_X; }
        return true;
    }
    __device__ __forceinline__ void a_ready(const pg8::Unit&) const {}
    __device__ __forceinline__ void done(const pg8::Unit&) const {}
};
struct EpiQKV {
    static constexpr bool PERM = true, AFTER_DRAIN = false, MIDK = false;
    bf16 *QS, *KS, *QW, *KW, *VT; const float *q_norm, *k_norm;
    __device__ __forceinline__ void operator()(const pg8::f32x4 (&acc)[2][2][4][2], const pg8::Unit& u, int wr, int wc, int fr, int fq) const {
        using pg8::HALF;
        if (u.pm < NTILE_X) {
            const int t = u.pn - NTILE_X; const int row0 = u.pm * 256 + wr * 64 + fr;
            if (t < 8) {
                bf16* base = (t < 4) ? QS : KS; const float sc = (t < 4) ? C2 : 1.0f; const int col0 = (t & 3) * 256 + wc * 32 + 8 * fq;
#pragma unroll
                for (int ai = 0; ai < 2; ++ai)
#pragma unroll
                    for (int m = 0; m < 4; ++m) { bf16* rowp = base + (size_t)(row0 + ai * HALF + m * 16) * 1024 + col0;
#pragma unroll
                        for (int bj = 0; bj < 2; ++bj) { const pg8::f32x4 v0 = acc[ai][bj][m][0] * sc, v1 = acc[ai][bj][m][1] * sc;
                            v4u w; w.x = pk2(v0[0], v0[1]); w.y = pk2(v0[2], v0[3]); w.z = pk2(v1[0], v1[1]); w.w = pk2(v1[2], v1[3]); *(v4u*)(rowp + bj * HALF) = w; } }
            } else {
                const bool isq = t < 12; const float* gain = isq ? q_norm : k_norm; const float sc = isq ? C2 : 1.0f;
                bf16* base = isq ? (QW + (t - 8) * 256 + wc * 64) : (KW + wc * 64); const int ld = isq ? 1024 : 256;
                pg8::f32x4 g[2][2];
#pragma unroll
                for (int bj = 0; bj < 2; ++bj)
#pragma unroll
                    for (int n = 0; n < 2; ++n) g[bj][n] = *(const pg8::f32x4*)(gain + 32 * bj + 8 * fq + 4 * n) * sc;
#pragma unroll
                for (int ai = 0; ai < 2; ++ai)
#pragma unroll
                    for (int m = 0; m < 4; ++m) {
                        float ss = 0.f;
#pragma unroll
                        for (int bj = 0; bj < 2; ++bj)
#pragma unroll
                            for (int n = 0; n < 2; ++n) { const pg8::f32x4 v = acc[ai][bj][m][n]; ss += (v[0] * v[0] + v[1] * v[1]) + (v[2] * v[2] + v[3] * v[3]); }
                        ss += __shfl_xor(ss, 16); ss += __shfl_xor(ss, 32);
                        const float rstd = 1.0f / sqrtf(ss * (1.0f / 64.0f) + RMS_EPS);
                        bf16* rowp = base + (size_t)(row0 + ai * HALF + m * 16) * ld + 8 * fq;
#pragma unroll
                        for (int bj = 0; bj < 2; ++bj) { const pg8::f32x4 v0 = acc[ai][bj][m][0] * rstd * g[bj][0], v1 = acc[ai][bj][m][1] * rstd * g[bj][1];
                            v4u w; w.x = pk2(v0[0], v0[1]); w.y = pk2(v0[2], v0[3]); w.z = pk2(v1[0], v1[1]); w.w = pk2(v1[2], v1[3]); *(v4u*)(rowp + 32 * bj) = w; } }
            }
        } else {
            const int vrow0 = (u.pm - NTILE_X - NT_QK) * 256 + wr * 64 + fr;
#pragma unroll
            for (int ai = 0; ai < 2; ++ai)
#pragma unroll
                for (int m = 0; m < 4; ++m) { bf16* rowp = VT + (size_t)(vrow0 + ai * HALF + m * 16) * MPAD + u.pn * 256 + wc * 32 + 16 * (fq >> 1) + 4 * (fq & 1);
#pragma unroll
                    for (int bj = 0; bj < 2; ++bj)
#pragma unroll
                        for (int n = 0; n < 2; ++n) { const pg8::f32x4 v = acc[ai][bj][m][n]; v2u w; w.x = pk2(v[0], v[1]); w.y = pk2(v[2], v[3]); *(v2u*)(rowp + bj * HALF + 8 * n) = w; } }
        }
    }
};

namespace att {
__device__ __forceinline__ f32x16 mfma_bf(bf16x8 a, bf16x8 b, f32x16 c) { return __builtin_amdgcn_mfma_f32_32x32x16_bf16(a, b, c, 0, 0, 0); }
__device__ __forceinline__ f32x16 mfma_h(f16x8 a, f16x8 b, f32x16 c) { return __builtin_amdgcn_mfma_f32_32x32x16_f16(a, b, c, 0, 0, 0); }
__device__ __forceinline__ bf16x8 ld8(const bf16* p) { return *(const bf16x8*)p; }
__device__ __forceinline__ bf16x8 pack8(const float* w) { v4u o; o.x = pk2(w[0], w[1]); o.y = pk2(w[2], w[3]); o.z = pk2(w[4], w[5]); o.w = pk2(w[6], w[7]); return __builtin_bit_cast(bf16x8, o); }

struct KT { bf16x8 k[4]; bf16x8 v[4]; };
__device__ __forceinline__ void glds16(const void* gsrc, unsigned lds_dst) { unsigned keep;
    asm volatile("s_mov_b32 %0, m0\n\ts_mov_b32 m0, %2\n\ts_nop 0\n\tglobal_load_lds_dwordx4 %1, off\n\ts_mov_b32 m0, %0" : "=&s"(keep) : "v"(gsrc), "s"(lds_dst) : "memory"); }
__device__ __forceinline__ void dma_tile(unsigned slot, const bf16* Kb, int ldk, const bf16* Vt, int b, int j, int lane) {
#pragma unroll
    for (int i = 0; i < 4; ++i) { const int row = 8 * i + (lane >> 3), ch = (lane & 7) ^ (row & 7);
        const int krow = (j >= 0) ? (b * SEQ + 32 * j + row) : (NTOK + (row & 15));
        glds16(Kb + (size_t)krow * ldk + ch * 8, (unsigned)__builtin_amdgcn_readfirstlane(slot + i * 1024)); }
    const int col0 = (j >= 0) ? (b * SEQ + 32 * j) : NTOK;
#pragma unroll
    for (int i = 0; i < 4; ++i) { const int row = 16 * i + (lane >> 2), c = (lane & 3) ^ ((row >> 2) & 3); const int cc = (j >= 0) ? c : (c & 1);
        glds16(Vt + (size_t)row * MPAD + col0 + cc * 8, (unsigned)__builtin_amdgcn_readfirstlane(slot + 4096 + i * 1024)); }
}
__device__ __forceinline__ void lds_frags(KT& t, const LAS unsigned char* slot, int r, int h) {
#pragma unroll
    for (int s = 0; s < 4; ++s) { const int c = 2 * s + h; t.k[s] = *(const LAS bf16x8*)(slot + (r >> 3) * 1024 + ((r & 7) * 8 + (c ^ (r & 7))) * 16); }
#pragma unroll
    for (int dh = 0; dh < 2; ++dh)
#pragma unroll
        for (int s = 0; s < 2; ++s) { const int row = 32 * dh + r, c = 2 * s + h; t.v[dh * 2 + s] = *(const LAS bf16x8*)(slot + 4096 + row * 64 + (c ^ ((row >> 2) & 3)) * 16); }
}
#define ATT_WAITV(n) asm volatile("s_waitcnt vmcnt(" #n ")" ::: "memory")

struct SbState { f32x16 o0, o1; float R; };
template <int KIND>
__device__ __forceinline__ void sb_tile(SbState& S, const KT& t, const bf16x8 (&qf)[4], const f16x8& U0, const f16x8& U1, int r, int h) {
    f32x16 z = {0.f, 0.f, 0.f, 0.f, 0.f, 0.f, 0.f, 0.f, 0.f, 0.f, 0.f, 0.f, 0.f, 0.f, 0.f, 0.f};
#pragma unroll
    for (int s = 0; s < 4; ++s) z = mfma_bf(t.k[s], qf[s], z);
    f32x16 init; float L[16];
#pragma unroll
    for (int g = 0; g < 16; ++g) {
        const float zz = z[g];
        const float e = __builtin_amdgcn_exp2f(-__builtin_fabsf(zz));
        const float zp = __builtin_amdgcn_fmed3f(zz, 0.f, 3.0e38f);
        const float sp = zp + __builtin_amdgcn_logf(1.0f + e);
        float Lv = -sp;
        if (KIND == 1) Lv = (crow(g, h) < r) ? Lv : 0.f;
        if (KIND == 2) Lv = (crow(g, h) < 16) ? Lv : 0.f;
        L[g] = Lv; init[g] = zz + Lv + S.R;
    }
    f16x8 lb0, lb1;
#pragma unroll
    for (int j = 0; j < 8; ++j) { lb0[j] = (_Float16)L[j]; lb1[j] = (_Float16)L[8 + j]; }
    f32x16 lw = mfma_h(U0, lb0, init); lw = mfma_h(U1, lb1, lw);
    float Rn = lw[0] - z[0];
    Rn = __shfl(Rn, r);
    float w[16];
#pragma unroll
    for (int g = 0; g < 16; ++g) {
        float wv = __builtin_amdgcn_exp2f(lw[g]);
        if (KIND == 1) wv = (crow(g, h) < r) ? wv : 0.f;
        if (KIND == 2) wv = (crow(g, h) < 16) ? wv : 0.f;
        w[g] = wv;
    }
    const bf16x8 wb0 = pack8(w), wb1 = pack8(w + 8);
    S.o0 = mfma_bf(t.v[0], wb0, S.o0); S.o0 = mfma_bf(t.v[1], wb1, S.o0);
    S.o1 = mfma_bf(t.v[2], wb0, S.o1); S.o1 = mfma_bf(t.v[3], wb1, S.o1);
    S.R = Rn;
}

struct SwState { f32x16 o0, o1; float m, l; };
template <int KIND>
__device__ __forceinline__ void sw_tile(SwState& S, const KT& t, const bf16x8 (&qf)[4], const LAS float* tb, int r, int h) {
    f32x16 z = {0.f, 0.f, 0.f, 0.f, 0.f, 0.f, 0.f, 0.f, 0.f, 0.f, 0.f, 0.f, 0.f, 0.f, 0.f, 0.f};
#pragma unroll
    for (int s = 0; s < 4; ++s) z = mfma_bf(t.k[s], qf[s], z);
    float sc[16]; float mx = -1e30f;
#pragma unroll
    for (int g = 0; g < 16; ++g) {
        float v = z[g] + tb[(g & 3) + 8 * (g >> 2)];
        if (KIND == 1) v = (crow(g, h) <= r) ? v : -1e30f;
        if (KIND == 2) v = (crow(g, h) < 16) ? v : -1e30f;
        if (KIND == 3) v = (crow(g, h) > r) ? v : -1e30f;
        sc[g] = v; mx = __builtin_fmaxf(mx, v);
    }
    mx = __builtin_fmaxf(mx, __shfl_xor(mx, 32));
    const float mn = __builtin_fmaxf(S.m, mx);
    const float alpha = __builtin_amdgcn_exp2f(S.m - mn);
    S.l *= alpha; S.o0 *= alpha; S.o1 *= alpha;
    float p[16]; float ls = 0.f;
#pragma unroll
    for (int g = 0; g < 16; ++g) { p[g] = __builtin_amdgcn_exp2f(sc[g] - mn); ls += p[g]; }
    S.l += ls; S.m = mn;
    const bf16x8 wb0 = pack8(p), wb1 = pack8(p + 8);
    S.o0 = mfma_bf(t.v[0], wb0, S.o0); S.o0 = mfma_bf(t.v[1], wb1, S.o0);
    S.o1 = mfma_bf(t.v[2], wb0, S.o1); S.o1 = mfma_bf(t.v[3], wb1, S.o1);
}
__device__ __forceinline__ float store_o(bf16* orow, const f32x16& o0, const f32x16& o1, float scale, int h) {
    float ss = 0.f;
#pragma unroll
    for (int q = 0; q < 4; ++q) {
        const float a0 = o0[4 * q] * scale, a1 = o0[4 * q + 1] * scale, a2 = o0[4 * q + 2] * scale, a3 = o0[4 * q + 3] * scale;
        const float b0 = o1[4 * q] * scale, b1 = o1[4 * q + 1] * scale, b2 = o1[4 * q + 2] * scale, b3 = o1[4 * q + 3] * scale;
        ss += ((a0 * a0 + a1 * a1) + (a2 * a2 + a3 * a3)) + ((b0 * b0 + b1 * b1) + (b2 * b2 + b3 * b3));
        v2u w; w.x = pk2(a0, a1); w.y = pk2(a2, a3); *(v2u*)(orow + 8 * q + 4 * h) = w;
        v2u x; x.x = pk2(b0, b1); x.y = pk2(b2, b3); *(v2u*)(orow + 32 + 8 * q + 4 * h) = x;
    }
    return ss;
}
}

__device__ __forceinline__ void p2_attention(Frame& F) {
    using namespace att;
    const int lane = F.lane, r = lane & 31, h = lane >> 5, w = F.wave;
    const bf16* VT = (const bf16*)(F.ws + WS_VT); bf16* MIX = (bf16*)(F.ws + WS_MIXED); float* SSQ = (float*)(F.ws + WS_SSQ);
    LAS float* tbr = (LAS float*)(F.lds + ATT_TBR_OFF);
    const LAS unsigned char* area = F.lds + RING_OFF + w * 16384;
    const unsigned slot0 = (unsigned)(uintptr_t)area;
    { const float* rel_bias = F.in[2];
      for (int idx = F.tid; idx < 16 * 192; idx += NWAVES * 64) {
        const int hq = idx / 192, x = idx % 192, d = 159 - x; float v = 0.f;
        if (d >= 0) { int bkt = d; if (d >= 16) { bkt = 16 + (int)(logf((float)d / 16.0f) / logf(8.0f) * 16.0f); bkt = bkt > 31 ? 31 : bkt; } v = rel_bias[bkt * 16 + hq] * LOG2E; }
        tbr[idx] = v;
      } }
    __syncthreads();
    if (w >= ATT_WAVES) {
        const int p2_end = NITEMS - TAIL6_ITEMS - tail1_items(F.G);
        conv_range3(F, p2_end - P2_ITEMS + F.vcu * (NWAVES - ATT_WAVES) + (w - ATT_WAVES), F.G * (NWAVES - ATT_WAVES), p2_end);
        return;
    }
    __builtin_amdgcn_s_setprio(3);
    for (int unit = F.vcu; unit < NTOK / 32; unit += F.G) {
        const int b = unit >> 7, a = unit & 127;
        const size_t qrow = (size_t)b * SEQ + 32 * a + r;
#pragma unroll 1
        for (int bi = 0; bi < 2; ++bi) {
            const int branch = bi;
            if (branch == 0) {
            const bf16* KS = (const bf16*)(F.ws + WS_KS); const bf16* QS = (const bf16*)(F.ws + WS_QS);
            f16x8 U0, U1;
#pragma unroll
            for (int j = 0; j < 8; ++j) { const int c0 = 8 * (j >> 2) + 4 * h + (j & 3); U0[j] = (c0 > r) ? (_Float16)1.0f : (_Float16)0.0f; U1[j] = (16 + c0 > r) ? (_Float16)1.0f : (_Float16)0.0f; }
            float ssl = 0.f;
#pragma unroll 1
            for (int hh = 0; hh < 16 / ATT_WAVES; ++hh) {
                const int head = (16 / ATT_WAVES) * w + hh;
                ATT_WAITV(0);
                const bf16* Kb = KS + head * 64;
                bf16x8 ql[4];
#pragma unroll
                for (int s = 0; s < 4; ++s) ql[s] = ld8(QS + qrow * 1024 + head * 64 + 16 * s + 8 * h);
                SbState S; S.R = 0.f;
#pragma unroll
                for (int g = 0; g < 16; ++g) { S.o0[g] = 0.f; S.o1[g] = 0.f; }
                const bf16* Vt = VT + (size_t)(head * 64) * MPAD;
                unsigned sl_cur = slot0, sl_nxt = slot0 + 8192;
                int jt = a;
                dma_tile(sl_cur, Kb, 1024, Vt, b, jt, lane); dma_tile(sl_nxt, Kb, 1024, Vt, b, jt - 1, lane);
                ATT_WAITV(8);
                KT T; lds_frags(T, area + (sl_cur - slot0), r, h);
                sb_tile<1>(S, T, ql, U0, U1, r, h);
                if (!__all(S.R < SB_EXIT)) {
                    --jt;
                    for (;;) {
                        { const unsigned t_ = sl_cur; sl_cur = sl_nxt; sl_nxt = t_; }
                        const bool has_next = jt >= 0;
                        if (has_next) { dma_tile(sl_nxt, Kb, 1024, Vt, b, jt - 1, lane); ATT_WAITV(8); } else ATT_WAITV(0);
                        lds_frags(T, area + (sl_cur - slot0), r, h);
                        if (jt >= 0) sb_tile<0>(S, T, ql, U0, U1, r, h); else sb_tile<2>(S, T, ql, U0, U1, r, h);
                        if (!has_next || __all(S.R < SB_EXIT)) break;
                        --jt;
                    }
                }
                ssl += store_o(MIX + qrow * DM + head * 64, S.o0, S.o1, 1.0f, h);
            }
            ssl += __shfl_xor(ssl, 32);
            if (h == 0) SSQ[qrow * 16 + w] = ssl;
        }
            else {
            const bf16* KW = (const bf16*)(F.ws + WS_KW); const bf16* QW = (const bf16*)(F.ws + WS_QW);
            float ssl = 0.f;
#pragma unroll 1
            for (int hh = 0; hh < 16 / ATT_WAVES; ++hh) {
                const int hq = (16 / ATT_WAVES) * w + hh, kvh = hq >> 2;
                ATT_WAITV(0);
                const bf16* Kb = KW + kvh * 64;
                bf16x8 ql[4];
#pragma unroll
                for (int s = 0; s < 4; ++s) ql[s] = ld8(QW + qrow * 1024 + hq * 64 + 16 * s + 8 * h);
                const float sink2 = F.in[7][hq] * LOG2E;
                SwState S; S.m = sink2; S.l = 0.f;
#pragma unroll
                for (int g = 0; g < 16; ++g) { S.o0[g] = 0.f; S.o1[g] = 0.f; }
                const LAS float* tbh = tbr + hq * 192 + 4 * h;
                const int jlo = (a >= 4) ? a - 4 : 0;
                const bf16* Vt = VT + (size_t)(1024 + kvh * 64) * MPAD;
                unsigned sl_cur = slot0, sl_nxt = slot0 + 8192;
                int jt = a;
#define SW_NEXT(j) (((j) > jlo) ? (j) - 1 : -1)
                dma_tile(sl_cur, Kb, 256, Vt, b, jt, lane); dma_tile(sl_nxt, Kb, 256, Vt, b, SW_NEXT(jt), lane);
                ATT_WAITV(8);
                KT T; lds_frags(T, area + (sl_cur - slot0), r, h);
                sw_tile<1>(S, T, ql, tbh + (159 - r), r, h);
                jt = SW_NEXT(jt);
                for (;;) {
                    { const unsigned t_ = sl_cur; sl_cur = sl_nxt; sl_nxt = t_; }
                    if (jt >= 0) { dma_tile(sl_nxt, Kb, 256, Vt, b, SW_NEXT(jt), lane); ATT_WAITV(8); } else ATT_WAITV(0);
                    lds_frags(T, area + (sl_cur - slot0), r, h);
                    if (jt < 0) { const int dq = 32 * a + r + 16; sw_tile<2>(S, T, ql, tbh + (159 - (dq < 159 ? dq : 159)), r, h); break; }
                    const LAS float* tb = tbh + (159 - (32 * (a - jt) + r));
                    if (jt == a - 4) sw_tile<3>(S, T, ql, tb, r, h); else sw_tile<0>(S, T, ql, tb, r, h);
                    jt = SW_NEXT(jt);
                }
#undef SW_NEXT
                const float lt = S.l + __shfl_xor(S.l, 32) + __builtin_amdgcn_exp2f(sink2 - S.m);
                ssl += store_o(MIX + qrow * DM + 1024 + hq * 64, S.o0, S.o1, 1.0f / lt, h);
            }
            ssl += __shfl_xor(ssl, 32);
            if (h == 0) SSQ[qrow * 16 + 8 + w] = ssl;
        }
        }
    }
    __builtin_amdgcn_s_setprio(0);
}

struct EpiRes {
    static constexpr bool PERM = true, AFTER_DRAIN = false, MIDK = true;
    bf16* P; const LAS float* RS; mutable int ui;
    __device__ __forceinline__ void midk(pg8::f32x4 (&acc)[2][2][4][2], const pg8::Unit& u, int wr, int fr) const {
#pragma unroll
        for (int ai = 0; ai < 2; ++ai)
#pragma unroll
            for (int m = 0; m < 4; ++m) { const LAS float* q = RS + (ui * 256 + ai * 128 + wr * 64 + m * 16 + fr) * 2; const float ratio = q[0] / q[1];
#pragma unroll
                for (int bj = 0; bj < 2; ++bj)
#pragma unroll
                    for (int n = 0; n < 2; ++n) acc[ai][bj][m][n] *= ratio; }
    }
    __device__ __forceinline__ void operator()(const pg8::f32x4 (&acc)[2][2][4][2], const pg8::Unit& u, int wr, int wc, int fr, int fq) const {
        const int col0 = u.pn * 256 + wc * 32 + 8 * fq;
#pragma unroll
        for (int ai = 0; ai < 2; ++ai)
#pragma unroll
            for (int m = 0; m < 4; ++m) { const int rl = ai * 128 + wr * 64 + m * 16 + fr; bf16* rowp = P + (size_t)(u.pm * 256 + rl) * DM + col0; const float rw = RS[(ui * 256 + rl) * 2 + 1];
#pragma unroll
                for (int bj = 0; bj < 2; ++bj) { const pg8::f32x4 v0 = acc[ai][bj][m][0] * rw, v1 = acc[ai][bj][m][1] * rw;
                    v4u w; w.x = pk2(v0[0], v0[1]); w.y = pk2(v0[2], v0[3]); w.z = pk2(v1[0], v1[1]); w.w = pk2(v1[2], v1[3]); *(v4u*)(rowp + bj * 128) = w; } }
        ++ui;
    }
};

__device__ __forceinline__ void p4_router(Frame& F) {
    using namespace att;
    const int lane = F.lane, r = lane & 31, h = lane >> 5, w = F.wave;
    const bf16* proj = (const bf16*)(F.ws + WS_PROJ); const bf16* xnb = (const bf16*)(F.ws + WS_BIG); const float* rinv = (const float*)(F.ws + WS_RINV); bf16* HB = (bf16*)(F.ws + WS_HB);
    const bf16* WRH = (const bf16*)(F.ws + WS_WR); const bf16* WRL = WRH + 96 * DM;
    const float* b_rg = F.in[13]; const float* b_re = F.in[15];
    unsigned* CNT = F.ctl + CW_CNT;
    int* LIST = (int*)(F.ws + WS_LIST); float* GATEW = (float*)(F.ws + WS_GATEW); int* TOKINFO = (int*)(F.ws + WS_TOKINFO); float* RSTD = (float*)(F.ws + WS_RSTD); float* RSTDW = (float*)(F.ws + WS_RSTDW);
    LAS float* part = (LAS float*)(F.lds + RING_OFF);
    LAS float* ssp = (LAS float*)(F.lds + RING_OFF + 98304);
    LAS float* lg = (LAS float*)(F.lds + RING_OFF + 98304 + 2048);
    LAS float* rsl = (LAS float*)(F.lds + RING_OFF + 98304 + 2048 + 18432);
    LAS unsigned char* sthi = F.lds + RING_OFF; LAS unsigned char* stlo = F.lds + RING_OFF + 65536;
    for (int unit = F.vcu; unit < NTOK / 64; unit += F.G) {
        f32x16 acc[2][3];
#pragma unroll
        for (int t = 0; t < 2; ++t)
#pragma unroll
            for (int nt = 0; nt < 3; ++nt)
#pragma unroll
                for (int g = 0; g < 16; ++g) acc[t][nt][g] = 0.f;
        float ss0 = 0.f, ss1 = 0.f;
#pragma unroll 1
        for (int q = 0; q < 4; ++q) {
#pragma unroll 1
            for (int hb = 0; hb < 2; ++hb) {
                f32x4 xv[8]; v2u pv[8];
#pragma unroll
                for (int i = 0; i < 8; ++i) { const int id = (hb * 8 + i) * 512 + F.tid, row = id >> 7, g = id & 127; const size_t off = ((size_t)unit * 64 + row) * DM + 512 * q + 4 * g;
                    const v2u xb = *(const v2u*)(xnb + off); const float ri = rinv[unit * 64 + row]; xv[i] = (f32x4){bf_lo(xb.x) * ri, bf_hi(xb.x) * ri, bf_lo(xb.y) * ri, bf_hi(xb.y) * ri}; pv[i] = *(const v2u*)(proj + off); }
#pragma unroll
                for (int i = 0; i < 8; ++i) { const int id = (hb * 8 + i) * 512 + F.tid, row = id >> 7, g = id & 127; const size_t off = ((size_t)unit * 64 + row) * DM + 512 * q + 4 * g;
                    const float a0 = xv[i][0] + bf_lo(pv[i].x), a1 = xv[i][1] + bf_hi(pv[i].x), a2 = xv[i][2] + bf_lo(pv[i].y), a3 = xv[i][3] + bf_hi(pv[i].y);
                    v2u hi; hi.x = pk2(a0, a1); hi.y = pk2(a2, a3);
                    v2u lo; lo.x = pk2(a0 - bf_lo(hi.x), a1 - bf_hi(hi.x)); lo.y = pk2(a2 - bf_lo(hi.y), a3 - bf_hi(hi.y));
                    *(v2u*)(HB + off) = hi;
                    const int lofs = row * 1024 + ((((g >> 1) ^ (row & 15))) << 4) + ((g & 1) << 3);
                    *(LAS v2u*)(sthi + lofs) = hi; *(LAS v2u*)(stlo + lofs) = lo; }
            }
            __syncthreads();
#pragma unroll 2
            for (int s4 = 0; s4 < 4; ++s4) {
                const int ks = w + 8 * s4, ksg = 32 * q + ks;
                const int fo0 = r * 1024 + ((((2 * ks + h) ^ (r & 15))) << 4), fo1 = fo0 + 32 * 1024;
                const v4u h0 = *(const LAS v4u*)(sthi + fo0), l0 = *(const LAS v4u*)(stlo + fo0), h1 = *(const LAS v4u*)(sthi + fo1), l1 = *(const LAS v4u*)(stlo + fo1);
#define P4_SS(SS, HV, LV) { const float e0 = bf_lo(HV.x) + bf_lo(LV.x), e1 = bf_hi(HV.x) + bf_hi(LV.x), e2 = bf_lo(HV.y) + bf_lo(LV.y), e3 = bf_hi(HV.y) + bf_hi(LV.y), \
                    e4 = bf_lo(HV.z) + bf_lo(LV.z), e5 = bf_hi(HV.z) + bf_hi(LV.z), e6 = bf_lo(HV.w) + bf_lo(LV.w), e7 = bf_hi(HV.w) + bf_hi(LV.w); \
                    SS += ((e0 * e0 + e1 * e1) + (e2 * e2 + e3 * e3)) + ((e4 * e4 + e5 * e5) + (e6 * e6 + e7 * e7)); }
                P4_SS(ss0, h0, l0) P4_SS(ss1, h1, l1)
#undef P4_SS
                const bf16x8 ahi0 = __builtin_bit_cast(bf16x8, h0), alo0 = __builtin_bit_cast(bf16x8, l0), ahi1 = __builtin_bit_cast(bf16x8, h1), alo1 = __builtin_bit_cast(bf16x8, l1);
#pragma unroll
                for (int nt = 0; nt < 3; ++nt) {
                    const int fo = (((ksg * 3 + nt) * 64 + lane) << 3);
                    const bf16x8 bh = ld8(WRH + fo), bl = ld8(WRL + fo);
                    acc[0][nt] = mfma_bf(ahi0, bh, acc[0][nt]); acc[0][nt] = mfma_bf(alo0, bh, acc[0][nt]); acc[0][nt] = mfma_bf(ahi0, bl, acc[0][nt]);
                    acc[1][nt] = mfma_bf(ahi1, bh, acc[1][nt]); acc[1][nt] = mfma_bf(alo1, bh, acc[1][nt]); acc[1][nt] = mfma_bf(ahi1, bl, acc[1][nt]);
                }
            }
            __syncthreads();
        }
        ss0 += __shfl_xor(ss0, 32); ss1 += __shfl_xor(ss1, 32);
        if (h == 0) { ssp[w * 32 + r] = ss0; ssp[256 + w * 32 + r] = ss1; }
#pragma unroll
        for (int t = 0; t < 2; ++t) {
#pragma unroll
            for (int nt = 0; nt < 3; ++nt)
#pragma unroll
                for (int g = 0; g < 16; ++g) part[(w * 32 + crow(g, h)) * 96 + nt * 32 + r] = acc[t][nt][g];
            __syncthreads();
            for (int idx = F.tid; idx < 32 * 72; idx += NWAVES * 64) { const int tk = idx / 72, c = idx % 72; float v = 0.f;
#pragma unroll
                for (int i = 0; i < 8; ++i) v += part[(i * 32 + tk) * 96 + c];
                lg[t * 32 * 72 + idx] = v; }
            __syncthreads();
        }
        LAS unsigned* hist = (LAS unsigned*)rsl + 64;
        if (F.tid < 128) hist[F.tid] = 0u;
        __syncthreads();
        int tok = 0, e0 = 0, e1 = 0; unsigned r0 = 0, r1 = 0; float g0 = 0.f, g1 = 0.f, rs = 0.f;
        if (F.tid < 64) {
            tok = unit * 64 + F.tid; float tsum = 0.f;
#pragma unroll
            for (int i = 0; i < 8; ++i) tsum += ssp[(F.tid >> 5) * 256 + i * 32 + (F.tid & 31)];
            rs = 1.0f / sqrtf(tsum * (1.0f / DM) + RMS_EPS); RSTD[tok] = rs;
            const LAS float* l = lg + F.tid * 72;
            float gl[8]; int gi = 0; float gm = -3.0e38f;
#pragma unroll
            for (int i = 0; i < 8; ++i) { gl[i] = l[i] * rs + b_rg[i]; if (gl[i] > gm) { gm = gl[i]; gi = i; } }
            float gs = 0.f;
#pragma unroll
            for (int i = 0; i < 8; ++i) gs += expf(gl[i] - gm);
            const float gval = 1.0f / gs;
            float el[8]; int i0 = 0; float m0 = -3.0e38f;
#pragma unroll
            for (int i = 0; i < 8; ++i) { el[i] = l[8 + gi * 8 + i] * rs + b_re[gi * 8 + i]; if (el[i] > m0) { m0 = el[i]; i0 = i; } }
            int i1 = 0; float m1 = -3.0e38f;
#pragma unroll
            for (int i = 0; i < 8; ++i) if (i != i0 && el[i] > m1) { m1 = el[i]; i1 = i; }
            const float p1 = expf(m1 - m0); g0 = gval / (1.0f + p1); g1 = gval * p1 / (1.0f + p1);
            e0 = gi * 8 + i0; e1 = gi * 8 + i1;
            r0 = atomicAdd((unsigned*)(hist + e0), 1u); r1 = atomicAdd((unsigned*)(hist + e1), 1u);
        }
        __syncthreads();
        if (F.tid < 64) { const unsigned n = hist[F.tid]; if (n) hist[64 + F.tid] = atomicAdd(CNT + 16 * F.tid, n); }
        __syncthreads();
        if (F.tid < 64) {
            const int pos0 = (int)(hist[64 + e0] + r0), pos1 = (int)(hist[64 + e1] + r1);
            LIST[e0 * NTOK + pos0] = tok; LIST[e1 * NTOK + pos1] = tok; GATEW[e0 * NTOK + pos0] = g0; GATEW[e1 * NTOK + pos1] = g1; RSTDW[e0 * NTOK + pos0] = rs; RSTDW[e1 * NTOK + pos1] = rs;
            *(int4*)(TOKINFO + 4 * tok) = make_int4(e0, pos0, e1, pos1);
        }
        __syncthreads();
    }
}

__device__ __forceinline__ void build_tables(Frame& F) {
    LAS int* T = (LAS int*)(F.lds + TBL_OFF);
    __syncthreads();
    if (F.tid < NEXP) {
        const int c = (int)__hip_atomic_load(F.ctl + CW_CNT + 16 * F.tid, __ATOMIC_RELAXED, __HIP_MEMORY_SCOPE_AGENT); const int mt = (c + 255) >> 8;
        int incl = mt;
#pragma unroll
        for (int o = 1; o < 64; o <<= 1) { const int v = __shfl_up(incl, o); if (F.tid >= o) incl += v; }
        const int st = incl - mt;
        T[TBL_TSTART + F.tid] = st; T[TBL_CNTS + F.tid] = c;
        for (int i = 0; i < mt; ++i) T[TBL_TE + st + i] = F.tid;
        if (F.tid == NEXP - 1) { T[TBL_TSTART + NEXP] = incl; T[TBL_NT] = incl; }
    }
    __syncthreads();
}
struct MoeGather {
    const int* list; const LAS int* T; LAS int* tokbuf; int NT; const float* rstdw; const float* gatew;
    __device__ __forceinline__ void info(const pg8::Unit& u, int& e, int& base, int& cnt) const { e = u.pn / NT; base = (u.pm - T[TBL_TSTART + e]) * 256; cnt = T[TBL_CNTS + e]; }
    __device__ __forceinline__ unsigned tok_direct(const pg8::Unit& u, int row) const { int e, base, cnt; info(u, e, base, cnt); const int idx = base + row; return idx < cnt ? (unsigned)list[e * NTOK + idx] : 0u; }
    __device__ __forceinline__ void issue(const pg8::Unit& u, int par, int lane) const { int e, base, cnt; info(u, e, base, cnt);
        __builtin_amdgcn_global_load_lds((const unsigned*)(list + e * NTOK + base + 4 * lane), (LAS unsigned*)(tokbuf + par * 256), 16, 0, 0);
        __builtin_amdgcn_global_load_lds((const unsigned*)(rstdw + e * NTOK + base + 4 * lane), (LAS unsigned*)(tokbuf + 512 + par * 256), 16, 0, 0);
        __builtin_amdgcn_global_load_lds((const unsigned*)(gatew + e * NTOK + base + 4 * lane), (LAS unsigned*)(tokbuf + 1024 + par * 256), 16, 0, 0); }
    __device__ __forceinline__ void direct_rg(const pg8::Unit& u, int row, float& rs, float& gw) const { int e, base, cnt; info(u, e, base, cnt); rs = rstdw[e * NTOK + base + row]; gw = gatew[e * NTOK + base + row]; }
    __device__ __forceinline__ unsigned tok_lds(const pg8::Unit& u, int par, int row) const { int e, base, cnt; info(u, e, base, cnt); const unsigned t = (unsigned)tokbuf[par * 256 + row]; return (base + row) < cnt ? t : 0u; }
};
namespace pg8 {
template <class Epi, class Sched>
__device__ __forceinline__ void gemm_phase_g(PG8_LAS unsigned char* lds, const Gemm g, const Sched& S, const Epi& E, const MoeGather& GA) {
    const int tid = threadIdx.x, wid = __builtin_amdgcn_readfirstlane(tid >> 6), lane = tid & 63, wr = wid >> 2, wc = wid & 3, fr = lane & 15, fq = lane >> 4;
    const int K = g.K, nt = K / BK;
    unsigned voffB[2], cofA[2]; int rowA[2];
#pragma unroll
    for (int i = 0; i < 2; ++i) { int R, C; stage_rc(tid * 16 + i * 8192, R, C); const int Rb = Epi::PERM ? ((R & ~31) + perm32(R & 31)) : R;
        rowA[i] = R; cofA[i] = (unsigned)C * 2u; voffB[i] = (unsigned)(Rb * K + C) * 2u; }
    const unsigned rowbytes = (unsigned)K * 2u;
    const size_t kstep = (size_t)(BK * 2);
    const size_t hstep = (size_t)HALF * K * 2;
    const size_t tstep = 2 * hstep;
    const unsigned ldsw = (unsigned)wid * 1024u;
    const int aoff = lds_byte(wr * 64 + fr, fq * 8), boff = lds_byte(wc * 32 + fr, fq * 8);
#define PG8_SA(b, h) (((b) * 2 + (h)) * HTB)
#define PG8_SB(b, h) ((4 + (b) * 2 + (h)) * HTB)
#define PG8_STAGE(bufoff, gbase, voff) do { _Pragma("unroll") for (int _i = 0; _i < 2; ++_i) \
        __builtin_amdgcn_global_load_lds((const unsigned*)((const char*)(gbase) + (voff)[_i]), (PG8_LAS unsigned*)(lds + (bufoff) + ldsw + _i * 8192), 16, 0, 0); } while (0)
#define PG8_LDA(dst, b, h) do { _Pragma("unroll") for (int m = 0; m < 4; ++m) _Pragma("unroll") for (int k = 0; k < 2; ++k) dst[m][k] = *(const PG8_LAS bf16x8*)(lds + PG8_SA(b, h) + aoff + m * 2048 + k * 1024); } while (0)
#define PG8_LDB(dst, b, h) do { _Pragma("unroll") for (int n = 0; n < 2; ++n) _Pragma("unroll") for (int k = 0; k < 2; ++k) dst[n][k] = *(const PG8_LAS bf16x8*)(lds + PG8_SB(b, h) + boff + n * 2048 + k * 1024); } while (0)
#define PG8_MMA(ai, bj, At, Bt) do { __builtin_amdgcn_s_setprio(1); _Pragma("unroll") for (int m = 0; m < 4; ++m) _Pragma("unroll") for (int n = 0; n < 2; ++n) _Pragma("unroll") for (int k = 0; k < 2; ++k) \
        acc[ai][bj][m][n] = __builtin_amdgcn_mfma_f32_16x16x32_bf16(Bt[n][k], At[m][k], acc[ai][bj][m][n], 0, 0, 0); __builtin_amdgcn_s_setprio(0); } while (0)
#define PG8_WAIT_V(n) asm volatile("s_waitcnt vmcnt(" #n ")" ::: "memory")
#define PG8_WAIT_L(n) asm volatile("s_waitcnt lgkmcnt(" #n ")" ::: "memory")
#define PG8_BAR __builtin_amdgcn_s_barrier()
#define PG8_SCHED __builtin_amdgcn_sched_barrier(0)
    Unit cur, nxt; int ui = 0;
    if (!S.next(0, cur)) return;
    f32x4 acc[2][2][4][2];
#pragma unroll
    for (int a = 0; a < 2; ++a)
#pragma unroll
        for (int b = 0; b < 2; ++b)
#pragma unroll
            for (int m = 0; m < 4; ++m)
#pragma unroll
                for (int n = 0; n < 2; ++n) acc[a][b][m][n] = (f32x4){0.f, 0.f, 0.f, 0.f};
    bf16x8 At[4][2], B0[2][2], B1[2][2];
    const char* A0 = (const char*)g.A; const char* cB = (const char*)g.Bt + (size_t)cur.pn * tstep;
    PG8_LAS int* tb = GA.tokbuf;
    if (tid < 256) { tb[tid] = (int)GA.tok_direct(cur, tid); float rs_, gw_; GA.direct_rg(cur, tid, rs_, gw_); ((PG8_LAS float*)tb)[512 + tid] = rs_; ((PG8_LAS float*)tb)[1024 + tid] = gw_; }
    PG8_WAIT_L(0); PG8_BAR;
#define PG8_OFFS(dst, par, half) do { _Pragma("unroll") for (int _i = 0; _i < 2; ++_i) dst[_i] = (unsigned)tb[(par) * 256 + (half) * HALF + rowA[_i]] * rowbytes + cofA[_i]; } while (0)
    {
        unsigned c0[2], c1[2]; PG8_OFFS(c0, 0, 0); PG8_OFFS(c1, 0, 1);
        PG8_STAGE(PG8_SB(0, 0), cB, voffB); PG8_STAGE(PG8_SB(0, 1), cB + hstep, voffB); PG8_STAGE(PG8_SA(0, 0), A0, c0); PG8_STAGE(PG8_SA(0, 1), A0, c1);
        if (wr == 1) PG8_BAR;
        PG8_WAIT_V(2); PG8_BAR;
        PG8_STAGE(PG8_SB(1, 0), cB + kstep, voffB); PG8_STAGE(PG8_SA(1, 0), A0 + kstep, c0); PG8_STAGE(PG8_SB(1, 1), cB + hstep + kstep, voffB);
        PG8_WAIT_V(6); PG8_BAR;
    }
    int t_issue = 2, t_fix = 6; asm volatile("" : "+s"(t_issue), "+s"(t_fix));
    for (;;) {
        const bool has_next = S.next(ui + 1, nxt);
        const char* nB = has_next ? (const char*)g.Bt + (size_t)nxt.pn * tstep : cB;
        const int pc = ui & 1, pnx = (ui + 1) & 1;
        for (int t = 0; t < nt; t += 2) {
            const bool last = (t == nt - 2);
            const char* a1 = A0 + (size_t)(t + 1) * kstep;
            const char* a2 = last ? A0 : A0 + (size_t)(t + 2) * kstep; const char* b2 = last ? nB : cB + (size_t)(t + 2) * kstep;
            const char* a3 = a2 + kstep; const char* b3 = b2 + kstep;
            if (t == t_fix && has_next && tid < 256) { int e_, base_, cnt_; GA.info(nxt, e_, base_, cnt_); if (base_ + tid >= cnt_) tb[pnx * 256 + tid] = 0; }
            const int ps = (last && has_next) ? pnx : pc;
            unsigned c1[2], s0[2], s1[2]; PG8_OFFS(c1, pc, 1); PG8_OFFS(s0, ps, 0); PG8_OFFS(s1, ps, 1);
            PG8_LDB(B0, 0, 0); PG8_LDB(B1, 0, 1); PG8_SCHED; PG8_LDA(At, 0, 0); PG8_STAGE(PG8_SA(1, 1), a1, c1);
            if (t == t_issue && has_next && wid == 0) GA.issue(nxt, pnx, lane);
            PG8_WAIT_V(8); PG8_WAIT_L(0); PG8_BAR; PG8_MMA(0, 0, At, B0); PG8_MMA(0, 1, At, B1); PG8_BAR; PG8_SCHED;
            PG8_LDA(At, 0, 1); PG8_STAGE(PG8_SB(0, 0), b2, voffB); PG8_STAGE(PG8_SB(0, 1), b2 + hstep, voffB); PG8_STAGE(PG8_SA(0, 0), a2, s0);
            PG8_WAIT_V(8); PG8_WAIT_L(0); PG8_BAR; PG8_MMA(1, 0, At, B0); PG8_MMA(1, 1, At, B1); PG8_BAR; PG8_SCHED;
            PG8_LDB(B0, 1, 0); PG8_LDB(B1, 1, 1); PG8_SCHED; PG8_LDA(At, 1, 0); PG8_STAGE(PG8_SA(0, 1), a2, s1);
            PG8_WAIT_V(8); PG8_WAIT_L(0); PG8_BAR; PG8_MMA(0, 0, At, B0); PG8_MMA(0, 1, At, B1); PG8_BAR; PG8_SCHED;
            PG8_LDA(At, 1, 1); PG8_STAGE(PG8_SB(1, 0), b3, voffB); PG8_STAGE(PG8_SB(1, 1), b3 + hstep, voffB); PG8_STAGE(PG8_SA(1, 0), a3, s0);
            PG8_WAIT_V(8); PG8_WAIT_L(0); PG8_BAR; PG8_MMA(1, 0, At, B0); PG8_MMA(1, 1, At, B1); PG8_BAR; PG8_SCHED;
        }
        if (wr == 0) PG8_BAR;
        E.par = pc; E(acc, cur, wr, wc, fr, fq); S.done(cur);
        if (!has_next) break;
#pragma unroll
        for (int a = 0; a < 2; ++a)
#pragma unroll
            for (int b = 0; b < 2; ++b)
#pragma unroll
                for (int m = 0; m < 4; ++m)
#pragma unroll
                    for (int n = 0; n < 2; ++n) acc[a][b][m][n] = (f32x4){0.f, 0.f, 0.f, 0.f};
        cur = nxt; cB = nB; ++ui;
        if (wr == 1) PG8_BAR;
    }
    PG8_WAIT_V(0);
    PG8_BAR;
#undef PG8_SA
#undef PG8_SB
#undef PG8_STAGE
#undef PG8_LDA
#undef PG8_LDB
#undef PG8_MMA
#undef PG8_WAIT_V
#undef PG8_WAIT_L
#undef PG8_BAR
#undef PG8_SCHED
#undef PG8_OFFS
}
}
struct MoeOrder {
    const LAS int* T; int NT, G, c;
    __device__ bool next(int i, pg8::Unit& u) const {
        const int L = i * G + c; if (L >= T[TBL_NT] * NT) return false;
        const int mt = L / NT; u.pm = mt; u.pn = T[TBL_TE + mt] * NT + (L % NT); return true;
    }
    __device__ __forceinline__ void a_ready(const pg8::Unit&) const {}
    __device__ __forceinline__ void done(const pg8::Unit&) const {}
};
struct EpiSwiGLU {
    static constexpr bool PERM = true, AFTER_DRAIN = false, MIDK = false;
    bf16* HDN; const LAS float* RG; const LAS int* T; mutable int par;
    __device__ __forceinline__ void operator()(const pg8::f32x4 (&acc)[2][2][4][2], const pg8::Unit& u, int wr, int wc, int fr, int fq) const {
        const int col0 = (u.pn & 3) * 128 + wc * 32 + 8 * fq; const int e = u.pn >> 2; const int base = (u.pm - T[TBL_TSTART + e]) * 256, cnt = T[TBL_CNTS + e];
#pragma unroll
        for (int ai = 0; ai < 2; ++ai)
#pragma unroll
            for (int m = 0; m < 4; ++m) { const int rl = ai * 128 + wr * 64 + m * 16 + fr; const int row = u.pm * 256 + rl; const bool ok = (base + rl) < cnt;
                const float rsr = RG[par * 256 + rl], gwr = RG[512 + par * 256 + rl];
                const float rs = ok ? rsr : 0.f, gw = ok ? gwr : 0.f;
                float o[8];
#pragma unroll
                for (int n = 0; n < 2; ++n)
#pragma unroll
                    for (int q = 0; q < 4; ++q) { const float g = acc[ai][0][m][n][q] * rs, up = acc[ai][1][m][n][q] * rs;
                        const float sg = g * __builtin_amdgcn_rcpf(1.0f + __builtin_amdgcn_exp2f(-g * LOG2E)); o[4 * n + q] = sg * up * gw; }
                v4u wv; wv.x = pk2(o[0], o[1]); wv.y = pk2(o[2], o[3]); wv.z = pk2(o[4], o[5]); wv.w = pk2(o[6], o[7]);
                *(v4u*)(HDN + (size_t)row * DEXP + col0) = wv; }
    }
};
struct EpiY {
    static constexpr bool PERM = true, AFTER_DRAIN = false, MIDK = false;
    bf16* Y; const LAS int* T;
    __device__ __forceinline__ void operator()(const pg8::f32x4 (&acc)[2][2][4][2], const pg8::Unit& u, int wr, int wc, int fr, int fq) const {
        const int col0 = (u.pn & 7) * 256 + wc * 32 + 8 * fq; const int e = u.pn >> 3; const int nvalid = T[TBL_CNTS + e] - (u.pm - T[TBL_TSTART + e]) * 256;
#pragma unroll
        for (int ai = 0; ai < 2; ++ai)
#pragma unroll
            for (int m = 0; m < 4; ++m) { const int rl = ai * 128 + wr * 64 + m * 16 + fr; bf16* rowp = Y + (size_t)(u.pm * 256 + rl) * DM + col0;
                if (rl < nvalid) {
#pragma unroll
                    for (int bj = 0; bj < 2; ++bj) { const pg8::f32x4 v0 = acc[ai][bj][m][0], v1 = acc[ai][bj][m][1];
                        v4u w; w.x = pk2(v0[0], v0[1]); w.y = pk2(v0[2], v0[3]); w.z = pk2(v1[0], v1[1]); w.w = pk2(v1[2], v1[3]); *(v4u*)(rowp + bj * 128) = w; } } }
    }
};
struct P8Row { v4u h[4], a[4], b[4]; };
__device__ __forceinline__ void p8_load(P8Row& r, const bf16* HB, const bf16* Y, const LAS int* T, int4 ti, int t, int lane) {
    const size_t s0 = (size_t)T[TBL_TSTART + ti.x] * 256 + ti.y, s1 = (size_t)T[TBL_TSTART + ti.z] * 256 + ti.w;
    const v4u* hp = (const v4u*)(HB + (size_t)t * DM) + lane; const v4u* y0 = (const v4u*)(Y + s0 * DM) + lane; const v4u* y1 = (const v4u*)(Y + s1 * DM) + lane;
#pragma unroll
    for (int j = 0; j < 4; ++j) { r.h[j] = __builtin_nontemporal_load(hp + 64 * j); r.a[j] = __builtin_nontemporal_load(y0 + 64 * j); r.b[j] = __builtin_nontemporal_load(y1 + 64 * j); }
}
__device__ __forceinline__ void p8_combine(Frame& F) {
    const LAS int* T = (const LAS int*)(F.lds + TBL_OFF);
    const int gw = F.vcu * NWAVES + F.wave, NGW = F.G * NWAVES;
    const bf16* Y = (const bf16*)(F.ws + WS_Y); const bf16* HB = (const bf16*)(F.ws + WS_HB); const int* TOKINFO = (const int*)(F.ws + WS_TOKINFO);
    constexpr int RPW = 8;
    int4 ti[RPW];
#pragma unroll
    for (int k = 0; k < RPW; ++k) { const int t = gw + k * NGW; ti[k] = (t < NTOK) ? *(const int4*)(TOKINFO + 4 * t) : make_int4(0, 0, 0, 0); }
    P8Row cur; if (gw < NTOK) p8_load(cur, HB, Y, T, ti[0], gw, F.lane);
#pragma unroll
    for (int k = 0; k < RPW; ++k) {
        const int t = gw + k * NGW; if (t >= NTOK) break;
        P8Row nxt; const int tn = t + NGW;
        if (k + 1 < RPW && tn < NTOK) p8_load(nxt, HB, Y, T, ti[k + 1 < RPW ? k + 1 : k], tn, F.lane);
        f32x4* od = (f32x4*)(F.out + (size_t)t * DM) + 2 * F.lane;
#pragma unroll
        for (int j = 0; j < 4; ++j) {
            const v4u h = cur.h[j], a = cur.a[j], b = cur.b[j]; f32x4 v0, v1;
            v0[0] = bf_lo(h.x) + bf_lo(a.x) + bf_lo(b.x); v0[1] = bf_hi(h.x) + bf_hi(a.x) + bf_hi(b.x); v0[2] = bf_lo(h.y) + bf_lo(a.y) + bf_lo(b.y); v0[3] = bf_hi(h.y) + bf_hi(a.y) + bf_hi(b.y);
            v1[0] = bf_lo(h.z) + bf_lo(a.z) + bf_lo(b.z); v1[1] = bf_hi(h.z) + bf_hi(a.z) + bf_hi(b.z); v1[2] = bf_lo(h.w) + bf_lo(a.w) + bf_lo(b.w); v1[3] = bf_hi(h.w) + bf_hi(a.w) + bf_hi(b.w);
            od[128 * j] = v0; od[128 * j + 1] = v1;
        }
        cur = nxt;
    }
    for (int t = gw + RPW * NGW; t < NTOK; t += NGW) {
        const int4 tj = *(const int4*)(TOKINFO + 4 * t); P8Row r; p8_load(r, HB, Y, T, tj, t, F.lane);
        f32x4* od = (f32x4*)(F.out + (size_t)t * DM) + 2 * F.lane;
#pragma unroll
        for (int j = 0; j < 4; ++j) {
            const v4u h = r.h[j], a = r.a[j], b = r.b[j]; f32x4 v0, v1;
            v0[0] = bf_lo(h.x) + bf_lo(a.x) + bf_lo(b.x); v0[1] = bf_hi(h.x) + bf_hi(a.x) + bf_hi(b.x); v0[2] = bf_lo(h.y) + bf_lo(a.y) + bf_lo(b.y); v0[3] = bf_hi(h.y) + bf_hi(a.y) + bf_hi(b.y);
            v1[0] = bf_lo(h.z) + bf_lo(a.z) + bf_lo(b.z); v1[1] = bf_hi(h.z) + bf_hi(a.z) + bf_hi(b.z); v1[2] = bf_lo(h.w) + bf_lo(a.w) + bf_lo(b.w); v1[3] = bf_hi(h.w) + bf_hi(a.w) + bf_hi(b.w);
            od[128 * j] = v0; od[128 * j + 1] = v1;
        }
    }
}

__global__ void __launch_bounds__(NWAVES * 64, 2) mk_fwd(Args args) {
    extern __shared__ __attribute__((aligned(16))) unsigned char lds[];
    Frame F;
    F.lds = (LAS unsigned char*)lds; F.ws = args.ws; F.ctl = (unsigned*)(args.ws + WS_CTL);
    F.tid = threadIdx.x; F.lane = F.tid & 63; F.wave = __builtin_amdgcn_readfirstlane(F.tid >> 6);
    F.G = gridDim.x; { const int bx = blockIdx.x; F.vcu = (F.G % 8 == 0) ? (bx % 8) * (F.G / 8) + bx / 8 : bx; }
    F.in = args.in; F.out = args.out;
    volatile LAS unsigned* MISC = (volatile LAS unsigned*)(F.lds + MISC_OFF);
    if (F.tid < 64) MISC[F.tid] = 0u;
    __syncthreads();
    const int lo = args.ph_lo, hi = args.ph_hi;
    const bool use_bar = (hi - lo) > 1;
    XcdBarrier bar; bar.bar = F.ctl + CW_BAR + args.li * XCD_BAR_WORDS; bar.x = 0; bar.st = nullptr;
    if (use_bar) bar = xcd_barrier_post(F.ctl + CW_BAR + args.li * XCD_BAR_WORDS, MISC + 8);
#define IN(k) (lo <= (k) && (k) < hi)
#define SEAM(k) do { if (IN(k) && (IN((k) + 1) || ((k) == 4 && IN(6)))) xcd_barrier(bar); } while (0)
    bf16* BIG = (bf16*)(F.ws + WS_BIG);

    if (IN(0)) { p0_prologue(F); SEAM(0); }
    if (IN(1)) {
        pg8::Gemm g{BIG, BIG, 0, 0, DM}; P1Order S{F.G, F.vcu};
        EpiQKV E{(bf16*)(F.ws + WS_QS), (bf16*)(F.ws + WS_KS), (bf16*)(F.ws + WS_QW), (bf16*)(F.ws + WS_KW), (bf16*)(F.ws + WS_VT), F.in[5], F.in[6]};
        pg8::gemm_phase<EpiQKV, P1Order, true, true>(F.lds + RING_OFF, g, S, E);
        {
            const int rounds = (P1_UNITS + F.G - 1) / F.G, first_idle = P1_UNITS - (rounds - 1) * F.G, nidle = F.G - first_idle;
            const int base = NITEMS - TAIL6_ITEMS - tail1_items(F.G);
            if (F.vcu >= first_idle) conv_range(F, base + (F.vcu - first_idle) * NWAVES + F.wave, nidle * NWAVES, NITEMS - TAIL6_ITEMS);
        }
        SEAM(1);
    }
    if (IN(2)) { p2_attention(F); SEAM(2); }
    if (IN(3)) {
        pg8::Gemm g{(const bf16*)(F.ws + WS_MIXED), (const bf16*)(F.ws + WS_WOUT), NTOK, DM, DM}; pg8::StaticOrder S; S.init(NTOK, DM, F.G, (int)blockIdx.x);
        LAS float* RS = (LAS float*)(F.lds + ATT_TBR_OFF);
        {   const float* SSQ = (const float*)(F.ws + WS_SSQ);
            for (int i = 0; i < 4; ++i) { pg8::Unit u; if (!S.next(i, u)) break;
                if (F.tid < 256) { const pg8::f32x4* q = (const pg8::f32x4*)(SSQ + (size_t)(u.pm * 256 + F.tid) * 16); const pg8::f32x4 a = q[0], b = q[1], c = q[2], d = q[3];
                    float sb = 0.f, sw = 0.f;
#pragma unroll
                    for (int q_ = 0; q_ < ATT_WAVES; ++q_) { sb += (q_ < 4 ? a[q_ & 3] : b[q_ & 3]); sw += (q_ < 4 ? c[q_ & 3] : d[q_ & 3]); }
                    RS[(i * 256 + F.tid) * 2] = 1.0f / sqrtf(sb * (1.0f / 1024.0f) + RMS_EPS); RS[(i * 256 + F.tid) * 2 + 1] = 1.0f / sqrtf(sw * (1.0f / 1024.0f) + RMS_EPS); } }
            __syncthreads(); }
        EpiRes E{(bf16*)(F.ws + WS_PROJ), RS, 0};
        pg8::gemm_phase<EpiRes, pg8::StaticOrder, true, true>(F.lds + RING_OFF, g, S, E);
        SEAM(3);
    }
    if (IN(4)) { p4_router(F); SEAM(4); }
    if (IN(5) || IN(6) || IN(7) || IN(8)) build_tables(F);
    if (IN(6)) {
        pg8::Gemm g{(const bf16*)(F.ws + WS_HB), (const bf16*)(F.ws + WS_WGU), 0, 0, DM}; MoeOrder S{(const LAS int*)(F.lds + TBL_OFF), 4, F.G, F.vcu};
        MoeGather GA{(const int*)(F.ws + WS_LIST), (const LAS int*)(F.lds + TBL_OFF), (LAS int*)(F.lds + TOKBUF_OFF), 4, (const float*)(F.ws + WS_RSTDW), (const float*)(F.ws + WS_GATEW)};
        EpiSwiGLU E{(bf16*)(F.ws + WS_HDN), (const LAS float*)(F.lds + TOKBUF_OFF + 2048), (const LAS int*)(F.lds + TBL_OFF), 0};
        pg8::gemm_phase_g<EpiSwiGLU, MoeOrder>(F.lds + RING_OFF, g, S, E, GA);
        {
            const int units = S.T[TBL_NT] * 4, rounds = (units + F.G - 1) / F.G, first_idle = units - (rounds - 1) * F.G, nidle = F.G - first_idle;
            const int base = NITEMS - TAIL6_ITEMS; int mid = base + nidle * NWAVES * TAIL6_PER_WAVE; if (mid > NITEMS) mid = NITEMS;
            if (nidle > 0 && F.vcu >= first_idle) conv_range(F, base + (F.vcu - first_idle) * NWAVES + F.wave, nidle * NWAVES, mid);
            conv_range(F, mid + F.vcu * NWAVES + F.wave, F.G * NWAVES, NITEMS);
        }
        SEAM(6);
    }
    if (IN(7)) {
        pg8::Gemm g{(const bf16*)(F.ws + WS_HDN), (const bf16*)(F.ws + WS_WD), 0, 0, DEXP}; MoeOrder S{(const LAS int*)(F.lds + TBL_OFF), 8, F.G, F.vcu};
        EpiY E{(bf16*)(F.ws + WS_Y), (const LAS int*)(F.lds + TBL_OFF)};
        pg8::gemm_phase<EpiY, MoeOrder, true, true>(F.lds + RING_OFF, g, S, E);
        SEAM(7);
    }
    if (IN(8)) p8_combine(F);
#undef IN
#undef SEAM
}

extern "C" void kernel_launch(void* const* d_in, const int* in_sizes, int n_in, void* d_out, int out_size, void* d_ws, size_t ws_size, hipStream_t stream) {
    static int grid = 0;
    if (grid == 0) {
        if (n_in != 19 || out_size != NTOK * DM || ws_size < WS_END) { fprintf(stderr, "kernel_launch: unexpected shapes (n_in %d out %d ws %zu)\n", n_in, out_size, ws_size); grid = -1; return; }
        int dev = 0, cus = 0, per_cu = 0;
        if (hipGetDevice(&dev) != hipSuccess || hipDeviceGetAttribute(&cus, hipDeviceAttributeMultiprocessorCount, dev) != hipSuccess) { grid = -1; return; }
        if (hipFuncSetAttribute((const void*)mk_fwd, hipFuncAttributeMaxDynamicSharedMemorySize, LDS_BYTES) != hipSuccess) { fprintf(stderr, "kernel_launch: hipFuncSetAttribute failed\n"); grid = -1; return; }
        if (hipOccupancyMaxActiveBlocksPerMultiprocessor(&per_cu, (const void*)mk_fwd, NWAVES * 64, LDS_BYTES) != hipSuccess || per_cu < 1) { fprintf(stderr, "kernel_launch: occupancy query reports %d\n", per_cu); }
        (void)hipGetLastError();
        grid = cus;
    }
    if (grid < 0) return;
    (void)hipMemsetAsync((char*)d_ws + WS_CTL, 0, CTL_ZERO_BYTES, stream);
    Args a{};
    for (int i = 0; i < 19; ++i) a.in[i] = (const float*)d_in[i];
    a.out = (float*)d_out; a.ws = (unsigned char*)d_ws;
#if MK_N_LAUNCHES == 1
    a.ph_lo = 0; a.ph_hi = N_PHASES; a.li = 0;
    hipLaunchKernelGGL(mk_fwd, dim3(grid), dim3(NWAVES * 64), LDS_BYTES, stream, a);
#else
    a.li = 0;
    for (int p = 0; p < N_PHASES; ++p) { a.ph_lo = p; a.ph_hi = p + 1; hipLaunchKernelGGL(mk_fwd, dim3(grid), dim3(NWAVES * 64), LDS_BYTES, stream, a); }
#endif
}
```

```cpp
#include <hip/hip_runtime.h>
#include <cstdio>
#include <cstdint>
namespace pg8 {
#define PG8_LAS __attribute__((address_space(3)))
typedef unsigned short bf16_t;
typedef short bf16x8 __attribute__((ext_vector_type(8)));
typedef float f32x4 __attribute__((ext_vector_type(4)));
typedef unsigned u32x4 __attribute__((ext_vector_type(4)));
constexpr int BM = 256, BK = 64, HALF = 128, HTB = HALF * BK * 2  , STAGE_BYTES = 8 * HTB, NXCD = 8, WGM = 8;

__host__ __device__ __forceinline__ int lds_byte(int r, int c) { const int st = (r >> 4) * 2 + (c >> 5), rr = r & 15, cc = c & 31, ob = rr * 64 + cc * 2; return st * 1024 + (ob ^ (((ob >> 9) & 1) << 5)); }
__host__ __device__ __forceinline__ void stage_rc(int b, int& R, int& C) { const int st = b / 1024, sb = b % 1024, swz = sb ^ (((sb >> 9) & 1) << 5); R = (st >> 1) * 16 + swz / 64; C = (st & 1) * 32 + (swz % 64) / 2; }
__host__ __device__ __forceinline__ int perm32(int rho) { const int n = rho >> 4, i = rho & 15; return 8 * (i >> 2) + 4 * n + (i & 3); }

struct Unit { int pm, pn; };
struct Gemm { const bf16_t* A; const bf16_t* Bt; int M, N, K; };

struct StaticOrder {
    int nM, nN, nwg, G, c;
    __host__ __device__ void init(int M, int N, int G_, int c_) { nM = M / BM; nN = N / BM; nwg = nM * nN; G = G_; c = c_; }
    __host__ __device__ bool next(int i, Unit& u) const {
        const long L = (long)i * G + c; if (L >= nwg) return false;
        int wgid = (int)L; { const int q = nwg / NXCD, r = nwg % NXCD, xcd = wgid % NXCD, off = wgid / NXCD; wgid = (xcd < r ? xcd * (q + 1) : r * (q + 1) + (xcd - r) * q) + off; }
        const int nig = WGM * nN, gid = wgid / nig, fm = gid * WGM, gsz = (nM - fm) < WGM ? (nM - fm) : WGM;
        u.pm = fm + ((wgid % nig) % gsz); u.pn = (wgid % nig) / gsz; return true;
    }
    __device__ __forceinline__ void a_ready(const Unit&) const {}
    __device__ __forceinline__ void done(const Unit&) const {}
};

__device__ __forceinline__ unsigned cvt_pk_bf16(float lo, float hi) { unsigned r; asm volatile("v_cvt_pk_bf16_f32 %0, %1, %2" : "=v"(r) : "v"(lo), "v"(hi)); return r; }
typedef float f32x2 __attribute__((ext_vector_type(2)));
__device__ __forceinline__ f32x2 gelu_pk(f32x2 v) {
    const f32x2 av = __builtin_elementwise_abs(v), d = av * 0.2316418882f + 1.0f;
    f32x2 t; t.x = __builtin_amdgcn_rcpf(d.x); t.y = __builtin_amdgcn_rcpf(d.y);
    f32x2 q = t * 0.5307027145f + (-0.7265760135f); q = q * t + 0.7107068705f; q = q * t + (-0.142248368f); q = q * t + 0.127414796f; q = q * t;
    const f32x2 s = (v * v) * (-0.72134752044f);
    f32x2 e; e.x = __builtin_amdgcn_exp2f(s.x); e.y = __builtin_amdgcn_exp2f(s.y);
    const f32x2 m = v * (q * e), r = v - m;
    f32x2 o; o.x = v.x < 0.f ? m.x : r.x; o.y = v.y < 0.f ? m.y : r.y; return o;
}

template <int ACT  > struct EpiBf16 {
    static constexpr bool PERM = true, AFTER_DRAIN = false; static_assert(ACT == 0 || ACT == 1, "EpiBf16: ACT is 0 (none) or 1 (gelu_pk)");
    bf16_t* O; int ldc; const float* bias; int split_cols; size_t split_stride; float scale0;
    __device__ __forceinline__ void operator()(const f32x4 (&acc)[2][2][4][2], const Unit& u, int wr, int wc, int fr, int fq) const {
        const int row0 = u.pm * BM + wr * 64 + fr; int colt = u.pn * BM; bf16_t* base = O;
        float sc = 1.f; if (split_cols) { const int t = colt / split_cols; base += (size_t)t * split_stride; colt -= t * split_cols; if (t == 0) sc = scale0; }
        const int col0 = colt + wc * 32 + 8 * fq, bcol0 = u.pn * BM + wc * 32 + 8 * fq;
        f32x4 bv[2][2];
#pragma unroll
        for (int bj = 0; bj < 2; ++bj)
#pragma unroll
            for (int n = 0; n < 2; ++n) bv[bj][n] = bias ? *(const f32x4*)(bias + bcol0 + bj * HALF + 4 * n) : (f32x4){0.f, 0.f, 0.f, 0.f};
#pragma unroll
        for (int ai = 0; ai < 2; ++ai)
#pragma unroll
            for (int m = 0; m < 4; ++m) { bf16_t* rowp = base + (size_t)(row0 + ai * HALF + m * 16) * ldc + col0;
#pragma unroll
                for (int bj = 0; bj < 2; ++bj) { f32x4 v0 = acc[ai][bj][m][0] + bv[bj][0], v1 = acc[ai][bj][m][1] + bv[bj][1];
                    if (ACT == 1) { f32x2 a = gelu_pk((f32x2){v0[0], v0[1]}), b = gelu_pk((f32x2){v0[2], v0[3]}), c = gelu_pk((f32x2){v1[0], v1[1]}), d = gelu_pk((f32x2){v1[2], v1[3]});
                        v0 = (f32x4){a.x, a.y, b.x, b.y}; v1 = (f32x4){c.x, c.y, d.x, d.y}; }
                    v0 = v0 * sc; v1 = v1 * sc; u32x4 w; w.x = cvt_pk_bf16(v0[0], v0[1]); w.y = cvt_pk_bf16(v0[2], v0[3]); w.z = cvt_pk_bf16(v1[0], v1[1]); w.w = cvt_pk_bf16(v1[2], v1[3]);
                    *(u32x4*)(rowp + bj * HALF) = w; } }
    }
};

struct PanelStats {
    unsigned* xbuf;
    unsigned* cnt;
    unsigned* tmo;
    int ntn; float eps;
    unsigned code;
    __device__ __forceinline__ bool run(const f32x4 (&v)[2][2][4][2], const Unit& u, int wr, int wc, int fr, int fq, PG8_LAS unsigned char* lds, int wid, int lane) const {
        typedef float f32x2v __attribute__((ext_vector_type(2)));
        PG8_LAS f32x2v* P = (PG8_LAS f32x2v*)lds;
        PG8_LAS f32x2v* S = (PG8_LAS f32x2v*)(lds + 8192);
        PG8_LAS unsigned* flag = (PG8_LAS unsigned*)(lds + 8192 + 2048);
#pragma unroll
        for (int ai = 0; ai < 2; ++ai)
#pragma unroll
            for (int m = 0; m < 4; ++m) {
                float s = 0.f;
#pragma unroll
                for (int bj = 0; bj < 2; ++bj)
#pragma unroll
                    for (int n = 0; n < 2; ++n) { const f32x4 x = v[ai][bj][m][n]; s += (x[0] + x[1]) + (x[2] + x[3]); }
                s += __shfl_xor(s, 16); s += __shfl_xor(s, 32);
                const float mw = s * (1.0f / 64.0f); float q = 0.f;
#pragma unroll
                for (int bj = 0; bj < 2; ++bj)
#pragma unroll
                    for (int n = 0; n < 2; ++n) { const f32x4 d = v[ai][bj][m][n] - mw; q += (d[0] * d[0] + d[1] * d[1]) + (d[2] * d[2] + d[3] * d[3]); }
                q += __shfl_xor(q, 16); q += __shfl_xor(q, 32);
                if (fq == 0) P[(ai * HALF + wr * 64 + m * 16 + fr) * 4 + wc] = (f32x2v){mw, q};
            }
        asm volatile("s_waitcnt lgkmcnt(0)" ::: "memory"); __builtin_amdgcn_s_barrier(); asm volatile("" ::: "memory");
#if defined(BROKEN_EXCHANGE_NO_WAIT)
#warning BROKEN CONTROL BUILD: the row-statistics exchange does not wait; results are wrong by design
        if (blockIdx.x >= 64) { const long long t0_ = clock64(); while (clock64() - t0_ < 60000) __builtin_amdgcn_s_sleep(8); }
#endif
        const int row = wid * 32 + (lane & 31);
        if (lane < 32) {
            const f32x2v a = P[row * 4 + 0], b = P[row * 4 + 1], c = P[row * 4 + 2], d = P[row * 4 + 3];
            const float mt = (a.x + b.x + c.x + d.x) * 0.25f;
            const float da = a.x - mt, db = b.x - mt, dc = c.x - mt, dd = d.x - mt;
            const float m2 = (a.y + b.y) + (c.y + d.y) + 64.0f * ((da * da + db * db) + (dc * dc + dd * dd));
            unsigned long long* slot = (unsigned long long*)xbuf + ((size_t)(u.pm * BM + row) * 4 + u.pn);
            __hip_atomic_store(slot, ((unsigned long long)__float_as_uint(m2) << 32) | __float_as_uint(mt), __ATOMIC_RELAXED, __HIP_MEMORY_SCOPE_AGENT);
        }
        asm volatile("s_waitcnt vmcnt(0)" ::: "memory");
        if (lane == 0) __hip_atomic_fetch_add(cnt + 64 * u.pm, 1u, __ATOMIC_RELAXED, __HIP_MEMORY_SCOPE_AGENT);
        if (wid == 0) {
            bool dead = false; const unsigned long long t0 = __builtin_amdgcn_s_memrealtime(); const unsigned want = 8u * (unsigned)ntn;
            for (;;) {
#if defined(BROKEN_EXCHANGE_NO_WAIT)
                break;
#endif
                if ((unsigned)__builtin_amdgcn_readfirstlane(__hip_atomic_load(cnt + 64 * u.pm, __ATOMIC_RELAXED, __HIP_MEMORY_SCOPE_AGENT)) >= want) break;
                if (__builtin_amdgcn_s_memrealtime() - t0 > 2000000ull) {
                    if (lane == 0) { unsigned expect = 0u; __hip_atomic_compare_exchange_strong(tmo + 1, &expect, code | (unsigned)(u.pm & 0xff), __ATOMIC_RELAXED, __ATOMIC_RELAXED, __HIP_MEMORY_SCOPE_AGENT);
                                     __hip_atomic_store(tmo, 1u, __ATOMIC_RELAXED, __HIP_MEMORY_SCOPE_AGENT); }
                    dead = true; break; }
                __builtin_amdgcn_s_sleep(2);
            }
            __builtin_amdgcn_fence(__ATOMIC_ACQUIRE, "agent");
            if (lane == 0) flag[0] = dead ? 1u : 0u;
        }
        asm volatile("s_waitcnt vmcnt(0) lgkmcnt(0)" ::: "memory"); __builtin_amdgcn_s_barrier(); asm volatile("" ::: "memory");
        const bool bad = flag[0] != 0u;
        if (lane < 32) {
            const unsigned long long* slot = (const unsigned long long*)xbuf + (size_t)(u.pm * BM + row) * 4; float mt[4], m2[4]; float ms = 0.f;
#pragma unroll
            for (int t = 0; t < 4; ++t) { if (t < ntn) { const unsigned long long w = __hip_atomic_load(slot + t, __ATOMIC_RELAXED, __HIP_MEMORY_SCOPE_AGENT); mt[t] = __uint_as_float((unsigned)w); m2[t] = __uint_as_float((unsigned)(w >> 32)); } else { mt[t] = 0.f; m2[t] = 0.f; } ms += mt[t]; }
            const float mean = ms / (float)ntn; float q = 0.f;
#pragma unroll
            for (int t = 0; t < 4; ++t) if (t < ntn) { const float dm = mt[t] - mean; q += m2[t] + 256.0f * dm * dm; }
            S[row] = (f32x2v){mean, 1.0f / sqrtf(q / (256.0f * (float)ntn) + eps)};
        }
        asm volatile("s_waitcnt lgkmcnt(0)" ::: "memory"); __builtin_amdgcn_s_barrier(); asm volatile("" ::: "memory");
        return bad;
    }
};
struct EpiLnRes {
    static constexpr bool PERM = false, AFTER_DRAIN = true;
    const float* base; float* out; int ldc; const float* bias; PanelStats st; unsigned poison;
    __device__ __forceinline__ void fused(f32x4 (&acc)[2][2][4][2], const Unit& u, int wr, int wc, int fr, int fq, PG8_LAS unsigned char* lds, int wid, int lane) const {
        typedef float f32x2v __attribute__((ext_vector_type(2)));
        const PG8_LAS f32x2v* S = (const PG8_LAS f32x2v*)(lds + 8192);
        const int col0 = u.pn * BM + wc * 32 + 4 * fq;
#pragma unroll
        for (int bj = 0; bj < 2; ++bj)
#pragma unroll
            for (int n = 0; n < 2; ++n) { const f32x4 bv = bias ? *(const f32x4*)(bias + col0 + bj * HALF + n * 16) : (f32x4){0.f, 0.f, 0.f, 0.f};
#pragma unroll
                for (int ai = 0; ai < 2; ++ai)
#pragma unroll
                    for (int m = 0; m < 4; ++m) acc[ai][bj][m][n] += bv; }
        f32x4 pre[4][2][2];
#pragma unroll
        for (int m = 0; m < 4; ++m) { const size_t off = (size_t)(u.pm * BM + wr * 64 + m * 16 + fr) * ldc + col0;
#pragma unroll
            for (int bj = 0; bj < 2; ++bj)
#pragma unroll
                for (int n = 0; n < 2; ++n) pre[m][bj][n] = *(const f32x4*)(base + off + bj * HALF + n * 16); }
        const bool bad = st.run(acc, u, wr, wc, fr, fq, lds, wid, lane) || poison != 0u;
        const float qnan = __builtin_nanf("");
#pragma unroll
        for (int ai = 0; ai < 2; ++ai)
#pragma unroll
            for (int m = 0; m < 4; ++m) { const int r = ai * HALF + wr * 64 + m * 16 + fr; const f32x2v sr = S[r]; const size_t off = (size_t)(u.pm * BM + r) * ldc + col0;
#pragma unroll
                for (int bj = 0; bj < 2; ++bj)
#pragma unroll
                    for (int n = 0; n < 2; ++n) { const f32x4 bs = ai == 0 ? pre[m][bj][n] : *(const f32x4*)(base + off + bj * HALF + n * 16); f32x4 o = bs + (acc[ai][bj][m][n] - sr.x) * sr.y;
                        if (bad) o = (f32x4){qnan, qnan, qnan, qnan}; *(f32x4*)(out + off + bj * HALF + n * 16) = o; }
                if (m & 1) asm volatile("" ::: "memory"); }
    }
};
struct EpiLnResLn {
    static constexpr bool PERM = false, AFTER_DRAIN = true;
    const float* base; float* out; bf16_t* xn; int ldc; const float* bias; PanelStats st1, st2; unsigned poison;
    __device__ __forceinline__ void fused(f32x4 (&acc)[2][2][4][2], const Unit& u, int wr, int wc, int fr, int fq, PG8_LAS unsigned char* lds, int wid, int lane) const {
        typedef float f32x2v __attribute__((ext_vector_type(2))); typedef unsigned u32x2v __attribute__((ext_vector_type(2)));
        const PG8_LAS f32x2v* S = (const PG8_LAS f32x2v*)(lds + 8192);
        const int col0 = u.pn * BM + wc * 32 + 4 * fq;
#pragma unroll
        for (int bj = 0; bj < 2; ++bj)
#pragma unroll
            for (int n = 0; n < 2; ++n) { const f32x4 bv = bias ? *(const f32x4*)(bias + col0 + bj * HALF + n * 16) : (f32x4){0.f, 0.f, 0.f, 0.f};
#pragma unroll
                for (int ai = 0; ai < 2; ++ai)
#pragma unroll
                    for (int m = 0; m < 4; ++m) acc[ai][bj][m][n] += bv; }
        bool bad = st1.run(acc, u, wr, wc, fr, fq, lds, wid, lane) || poison != 0u;
        const float qnan = __builtin_nanf("");
#pragma unroll
        for (int ai = 0; ai < 2; ++ai)
#pragma unroll
            for (int m = 0; m < 4; ++m) { const int r = ai * HALF + wr * 64 + m * 16 + fr; const f32x2v sr = S[r]; const size_t off = (size_t)(u.pm * BM + r) * ldc + col0;
#pragma unroll
                for (int bj = 0; bj < 2; ++bj)
#pragma unroll
                    for (int n = 0; n < 2; ++n) { const f32x4 bs = *(const f32x4*)(base + off + bj * HALF + n * 16); acc[ai][bj][m][n] = bs + (acc[ai][bj][m][n] - sr.x) * sr.y; }
                asm volatile("" : "+v"(acc[ai][0][m][0]), "+v"(acc[ai][0][m][1]), "+v"(acc[ai][1][m][0]), "+v"(acc[ai][1][m][1]));
                if (m & 1) asm volatile("" ::: "memory"); }
        const bool bad1 = bad;
        bad = st2.run(acc, u, wr, wc, fr, fq, lds, wid, lane) || bad;
#pragma unroll
        for (int ai = 0; ai < 2; ++ai)
#pragma unroll
            for (int m = 0; m < 4; ++m) { const int r = ai * HALF + wr * 64 + m * 16 + fr; const f32x2v sr = S[r]; const size_t off = (size_t)(u.pm * BM + r) * ldc + col0;
#pragma unroll
                for (int bj = 0; bj < 2; ++bj)
#pragma unroll
                    for (int n = 0; n < 2; ++n) { const f32x4 x1 = acc[ai][bj][m][n]; *(f32x4*)(out + off + bj * HALF + n * 16) = bad1 ? (f32x4){qnan, qnan, qnan, qnan} : x1;
                        const f32x4 o = (x1 - sr.x) * sr.y; u32x2v w; w.x = cvt_pk_bf16(o[0], o[1]); w.y = cvt_pk_bf16(o[2], o[3]);
                        if (bad) { w.x = 0x7fc07fc0u; w.y = 0x7fc07fc0u; } *(u32x2v*)(xn + off + bj * HALF + n * 16) = w; }
                asm volatile("" ::: "memory"); }
    }
};

template <class Epi, class Sched, bool ALIGN_EPI = false, bool SP2 = false>
__device__ __forceinline__ void gemm_phase(PG8_LAS unsigned char* lds, const Gemm g, const Sched& S, const Epi& E) {
    const int tid = threadIdx.x, wid = __builtin_amdgcn_readfirstlane(tid >> 6), lane = tid & 63, wr = wid >> 2, wc = wid & 3, fr = lane & 15, fq = lane >> 4;
    const int K = g.K, nt = K / BK;
    unsigned voffA[2], voffB[2];
#pragma unroll
    for (int i = 0; i < 2; ++i) { int R, C; stage_rc(tid * 16 + i * 8192, R, C); const int Rb = Epi::PERM ? ((R & ~31) + perm32(R & 31)) : R;
        voffA[i] = (unsigned)(R * K + C) * 2u; voffB[i] = (unsigned)(Rb * K + C) * 2u; }
    const size_t kstep = (size_t)(BK * 2);
    const size_t hstep = (size_t)HALF * K * 2;
    const size_t tstep = 2 * hstep;
    const unsigned ldsw = (unsigned)wid * 1024u;
    const int aoff = lds_byte(wr * 64 + fr, fq * 8), boff = lds_byte(wc * 32 + fr, fq * 8);
#define PG8_SA(b, h) (((b) * 2 + (h)) * HTB)
#define PG8_SB(b, h) ((4 + (b) * 2 + (h)) * HTB)
#define PG8_STAGE(bufoff, gbase, voff) do { _Pragma("unroll") for (int _i = 0; _i < 2; ++_i) \
        __builtin_amdgcn_global_load_lds((const unsigned*)((const char*)(gbase) + (voff)[_i]), (PG8_LAS unsigned*)(lds + (bufoff) + ldsw + _i * 8192), 16, 0, 0); } while (0)
#define PG8_LDA(dst, b, h) do { _Pragma("unroll") for (int m = 0; m < 4; ++m) _Pragma("unroll") for (int k = 0; k < 2; ++k) dst[m][k] = *(const PG8_LAS bf16x8*)(lds + PG8_SA(b, h) + aoff + m * 2048 + k * 1024); } while (0)
#define PG8_LDB(dst, b, h) do { _Pragma("unroll") for (int n = 0; n < 2; ++n) _Pragma("unroll") for (int k = 0; k < 2; ++k) dst[n][k] = *(const PG8_LAS bf16x8*)(lds + PG8_SB(b, h) + boff + n * 2048 + k * 1024); } while (0)
#define PG8_MMA(ai, bj, At, Bt) do { __builtin_amdgcn_s_setprio(1); _Pragma("unroll") for (int m = 0; m < 4; ++m) _Pragma("unroll") for (int n = 0; n < 2; ++n) _Pragma("unroll") for (int k = 0; k < 2; ++k) \
        acc[ai][bj][m][n] = __builtin_amdgcn_mfma_f32_16x16x32_bf16(Bt[n][k], At[m][k], acc[ai][bj][m][n], 0, 0, 0); __builtin_amdgcn_s_setprio(0); } while (0)
#define PG8_WAIT_V(n) asm volatile("s_waitcnt vmcnt(" #n ")" ::: "memory")
#define PG8_WAIT_L(n) asm volatile("s_waitcnt lgkmcnt(" #n ")" ::: "memory")
#define PG8_BAR __builtin_amdgcn_s_barrier()
#define PG8_SCHED __builtin_amdgcn_sched_barrier(0)
    Unit cur, nxt; int ui = 0;
    if (!S.next(0, cur)) return;
    f32x4 acc[2][2][4][2];
#pragma unroll
    for (int a = 0; a < 2; ++a)
#pragma unroll
        for (int b = 0; b < 2; ++b)
#pragma unroll
            for (int m = 0; m < 4; ++m)
#pragma unroll
                for (int n = 0; n < 2; ++n) acc[a][b][m][n] = (f32x4){0.f, 0.f, 0.f, 0.f};
    bf16x8 At[4][2], B0[2][2], B1[2][2];
    const char* cA = (const char*)g.A + (size_t)cur.pm * tstep; const char* cB = (const char*)g.Bt + (size_t)cur.pn * tstep;
    S.a_ready(cur);
    if constexpr (SP2) {
        PG8_STAGE(PG8_SB(0, 0), cB, voffB); PG8_STAGE(PG8_SB(0, 1), cB + hstep, voffB); PG8_STAGE(PG8_SA(0, 0), cA, voffA); PG8_STAGE(PG8_SA(0, 1), cA + hstep, voffA);
        if (wr == 1) PG8_BAR;
        PG8_WAIT_V(2); PG8_BAR;
        PG8_STAGE(PG8_SB(1, 0), cB + kstep, voffB); PG8_STAGE(PG8_SA(1, 0), cA + kstep, voffA); PG8_STAGE(PG8_SB(1, 1), cB + hstep + kstep, voffB);
        PG8_WAIT_V(6); PG8_BAR;
    } else {
        PG8_STAGE(PG8_SB(0, 0), cB, voffB); PG8_STAGE(PG8_SA(0, 0), cA, voffA); PG8_STAGE(PG8_SB(0, 1), cB + hstep, voffB); PG8_STAGE(PG8_SA(0, 1), cA + hstep, voffA);
        if (wr == 1) PG8_BAR;
        PG8_WAIT_V(4); PG8_BAR;
        PG8_STAGE(PG8_SB(1, 0), cB + kstep, voffB); PG8_STAGE(PG8_SA(1, 0), cA + kstep, voffA); PG8_STAGE(PG8_SB(1, 1), cB + hstep + kstep, voffB);
        PG8_WAIT_V(6); PG8_BAR;
    }
    int t_mid = nt >> 1; if constexpr (Epi::MIDK) asm volatile("" : "+s"(t_mid));
    for (;;) {
        const bool has_next = S.next(ui + 1, nxt);
        const char* nA = has_next ? (const char*)g.A + (size_t)nxt.pm * tstep : cA; const char* nB = has_next ? (const char*)g.Bt + (size_t)nxt.pn * tstep : cB;
        for (int t = 0; t < nt; t += 2) {
            const bool last = (t == nt - 2);
            if constexpr (Epi::MIDK) { if (t == t_mid) E.midk(acc, cur, wr, fr); }
            const char* a1 = cA + (size_t)(t + 1) * kstep;
            const char* a2 = last ? nA : cA + (size_t)(t + 2) * kstep; const char* b2 = last ? nB : cB + (size_t)(t + 2) * kstep;
            const char* a3 = a2 + kstep; const char* b3 = b2 + kstep;
            if (last && has_next) S.a_ready(nxt);
            if constexpr (SP2) {
            PG8_LDB(B0, 0, 0); PG8_LDB(B1, 0, 1); PG8_SCHED; PG8_LDA(At, 0, 0); PG8_STAGE(PG8_SA(1, 1), a1 + hstep, voffA);
            PG8_WAIT_V(8); PG8_WAIT_L(0); PG8_BAR; PG8_MMA(0, 0, At, B0); PG8_MMA(0, 1, At, B1); PG8_BAR; PG8_SCHED;
            PG8_LDA(At, 0, 1); PG8_STAGE(PG8_SB(0, 0), b2, voffB); PG8_STAGE(PG8_SB(0, 1), b2 + hstep, voffB); PG8_STAGE(PG8_SA(0, 0), a2, voffA);
            PG8_WAIT_V(8); PG8_WAIT_L(0); PG8_BAR; PG8_MMA(1, 0, At, B0); PG8_MMA(1, 1, At, B1); PG8_BAR; PG8_SCHED;
            PG8_LDB(B0, 1, 0); PG8_LDB(B1, 1, 1); PG8_SCHED; PG8_LDA(At, 1, 0); PG8_STAGE(PG8_SA(0, 1), a2 + hstep, voffA);
            PG8_WAIT_V(8); PG8_WAIT_L(0); PG8_BAR; PG8_MMA(0, 0, At, B0); PG8_MMA(0, 1, At, B1); PG8_BAR; PG8_SCHED;
            PG8_LDA(At, 1, 1); PG8_STAGE(PG8_SB(1, 0), b3, voffB); PG8_STAGE(PG8_SB(1, 1), b3 + hstep, voffB); PG8_STAGE(PG8_SA(1, 0), a3, voffA);
            PG8_WAIT_V(8); PG8_WAIT_L(0); PG8_BAR; PG8_MMA(1, 0, At, B0); PG8_MMA(1, 1, At, B1); PG8_BAR; PG8_SCHED;
            } else {
            PG8_LDB(B0, 0, 0); PG8_SCHED; PG8_LDA(At, 0, 0); PG8_STAGE(PG8_SA(1, 1), a1 + hstep, voffA);
            PG8_WAIT_L(8); PG8_BAR; PG8_WAIT_L(0); PG8_MMA(0, 0, At, B0); PG8_BAR; PG8_SCHED;
            PG8_LDB(B1, 0, 1); PG8_STAGE(PG8_SB(0, 0), b2, voffB);
            PG8_BAR; PG8_WAIT_L(0); PG8_MMA(0, 1, At, B1); PG8_BAR;
            PG8_LDA(At, 0, 1); PG8_STAGE(PG8_SA(0, 0), a2, voffA);
            PG8_BAR; PG8_WAIT_L(0); PG8_MMA(1, 0, At, B0); PG8_BAR; PG8_SCHED;
            PG8_STAGE(PG8_SB(0, 1), b2 + hstep, voffB);
            PG8_WAIT_V(6); PG8_BAR; PG8_MMA(1, 1, At, B1); PG8_BAR;
            PG8_LDB(B0, 1, 0); PG8_SCHED; PG8_LDA(At, 1, 0); PG8_STAGE(PG8_SA(0, 1), a2 + hstep, voffA);
            PG8_WAIT_L(8); PG8_BAR; PG8_WAIT_L(0); PG8_MMA(0, 0, At, B0); PG8_BAR; PG8_SCHED;
            PG8_LDB(B1, 1, 1); PG8_STAGE(PG8_SB(1, 0), b3, voffB);
            PG8_BAR; PG8_WAIT_L(0); PG8_MMA(0, 1, At, B1); PG8_BAR;
            PG8_LDA(At, 1, 1); PG8_STAGE(PG8_SA(1, 0), a3, voffA);
            PG8_BAR; PG8_WAIT_L(0); PG8_MMA(1, 0, At, B0); PG8_BAR; PG8_SCHED;
            PG8_STAGE(PG8_SB(1, 1), b3 + hstep, voffB);
            PG8_WAIT_V(6); PG8_BAR; PG8_MMA(1, 1, At, B1); PG8_BAR;
            }
        }
        if constexpr (ALIGN_EPI) { if (wr == 0) PG8_BAR; }
        if constexpr (!Epi::AFTER_DRAIN) { E(acc, cur, wr, wc, fr, fq); S.done(cur); }
        if (!has_next) break;
#pragma unroll
        for (int a = 0; a < 2; ++a)
#pragma unroll
            for (int b = 0; b < 2; ++b)
#pragma unroll
                for (int m = 0; m < 4; ++m)
#pragma unroll
                    for (int n = 0; n < 2; ++n) acc[a][b][m][n] = (f32x4){0.f, 0.f, 0.f, 0.f};
        cur = nxt; cA = nA; cB = nB; ++ui;
        if constexpr (ALIGN_EPI) { if (wr == 1) PG8_BAR; }
    }
    PG8_WAIT_V(0);
    if constexpr (!ALIGN_EPI) { if (wr == 0) PG8_BAR; }
    PG8_BAR;
    if constexpr (Epi::AFTER_DRAIN) { E.fused(acc, cur, wr, wc, fr, fq, lds, wid, lane); S.done(cur); }
#undef PG8_SA
#undef PG8_SB
#undef PG8_STAGE
#undef PG8_LDA
#undef PG8_LDB
#undef PG8_MMA
#undef PG8_WAIT_V
#undef PG8_WAIT_L
#undef PG8_BAR
#undef PG8_SCHED
}
}


#ifndef MK_N_LAUNCHES
#define MK_N_LAUNCHES 1
#endif
constexpr int N_PHASES = 9;
constexpr int NWAVES = 8;

constexpr int DM = 2048, BATCH = 4, SEQ = 4096, NTOK = BATCH * SEQ, NMETA = 16;
constexpr int MPAD = 16640, NTILE_X = MPAD / 256;
constexpr int N_QK = 3328, NT_QK = N_QK / 256;
constexpr int N_V = 1280, NT_V = N_V / 256;
constexpr int NT_W = NT_QK + NT_V;
constexpr int P1_UNITS_A = NTILE_X * NT_QK, P1_UNITS = P1_UNITS_A + NT_V * NTILE_X;
constexpr int NEXP = 64, DEXP = 512, MAXTILES = 192, SPAD = MAXTILES * 256;
constexpr float RMS_EPS = 1e-6f;
constexpr float LOG2E = 1.4426950408889634f;
constexpr float C2 = 0.125f * LOG2E;
constexpr float SB_EXIT = -150.0f;

constexpr size_t MiB = 1u << 20;
constexpr size_t WS_CTL = 0, CTL_ZERO_BYTES = 128 * 1024;
constexpr size_t WS_BIG = 1 * MiB;
constexpr size_t WS_QS = 84 * MiB, WS_KS = WS_QS + (size_t)MPAD * 1024 * 2, WS_QW = WS_KS + (size_t)MPAD * 1024 * 2, WS_KW = WS_QW + (size_t)MPAD * 1024 * 2;
constexpr size_t WS_VT = 190 * MiB;
constexpr size_t WS_MIXED = 231 * MiB, WS_HB = 295 * MiB;
constexpr size_t WS_Y = 1 * MiB;
constexpr size_t WS_PROJ = 359 * MiB;
constexpr size_t WS_HDN = 423 * MiB;
constexpr size_t WS_WOUT = 471 * MiB, WS_WR = 479 * MiB;
constexpr size_t WS_WGU = 480 * MiB, WS_WD = 736 * MiB;
constexpr size_t WS_LIST = 864 * MiB, WS_GATEW = 868 * MiB, WS_TOKINFO = 872 * MiB, WS_RSTD = 873 * MiB, WS_RSTDW = 874 * MiB;
constexpr size_t WS_RINV = 877 * MiB;
constexpr size_t WS_SSQ = 878 * MiB;
constexpr size_t WS_END = 880 * MiB;
static_assert(WS_RSTDW + (size_t)NEXP * NTOK * 4 <= WS_END, "ws map 4");
static_assert(WS_KW + (size_t)MPAD * 256 * 2 <= WS_VT && WS_VT + (size_t)N_V * MPAD * 2 <= WS_MIXED , "ws map 1");
static_assert(WS_Y + (size_t)SPAD * 2048 * 2 <= WS_MIXED && WS_HDN + (size_t)SPAD * 512 * 2 <= WS_WOUT && WS_HB + (size_t)NTOK * 2048 * 2 <= WS_HDN, "ws map 2");
static_assert(WS_BIG + (size_t)(NTILE_X + NT_W) * 256 * 2048 * 2 <= WS_QS, "ws map 3");
constexpr int CW_TMO = 0, CW_BAR = 4096, CW_CNT = 16384;

constexpr int RING_OFF = 0, RING_BYTES = 131072;
constexpr int MISC_OFF = RING_BYTES;
constexpr int TBL_OFF = MISC_OFF + 256;
constexpr int TBL_TSTART = 0, TBL_NT = 65, TBL_TE = 66, TBL_CNTS = 66 + MAXTILES, TBL_WORDS = 66 + MAXTILES + 64;
constexpr int TOKBUF_OFF = MISC_OFF + 4096;
constexpr int ATT_TBR_OFF = TOKBUF_OFF + 6144;
constexpr int LDS_BYTES = 163840;
static_assert(TBL_OFF + TBL_WORDS * 4 <= TOKBUF_OFF && TOKBUF_OFF + 6144 <= LDS_BYTES && ATT_TBR_OFF + 16 * 192 * 4 <= LDS_BYTES, "LDS map");

#define LAS __attribute__((address_space(3)))
typedef unsigned short bf16;
typedef unsigned v4u __attribute__((ext_vector_type(4)));
typedef unsigned v2u __attribute__((ext_vector_type(2)));
typedef float f32x4 __attribute__((ext_vector_type(4)));
typedef float f32x16 __attribute__((ext_vector_type(16)));
typedef short bf16x8 __attribute__((ext_vector_type(8)));
typedef _Float16 f16x8 __attribute__((ext_vector_type(8)));
typedef _Float16 f16x2 __attribute__((ext_vector_type(2)));
typedef float f32x2 __attribute__((ext_vector_type(2)));
typedef __bf16 bf16x2_t __attribute__((ext_vector_type(2)));
#define LDS_WAIT() asm volatile("s_waitcnt lgkmcnt(0)" ::: "memory")
#define VM_WAIT() asm volatile("s_waitcnt vmcnt(0)" ::: "memory")
__device__ __forceinline__ unsigned pk2(float lo, float hi) { f32x2 v = {lo, hi}; bf16x2_t b = __builtin_convertvector(v, bf16x2_t); return __builtin_bit_cast(unsigned, b); }
__device__ __forceinline__ float bf_lo(unsigned u) { return __uint_as_float(u << 16); }
__device__ __forceinline__ float bf_hi(unsigned u) { return __uint_as_float(u & 0xffff0000u); }
__device__ __forceinline__ float wave_sum(float v) {
#pragma unroll
    for (int o = 1; o < 64; o <<= 1) v += __shfl_xor(v, o);
    return v;
}
__device__ __forceinline__ int crow(int reg, int h) { return (reg & 3) + 8 * (reg >> 2) + 4 * h; }

#define XB_TMO      128
#define XB_XCNT(j)  (256  + 64 * (j))
#define XB_XSUB(j)  (1280 + 64 * (j))
#define XB_XGEN(j)  (2304 + 64 * (j))
#define XB_TOP      3328
#define XB_TOPGEN   3392
#define XCD_BAR_WORDS 3456
#define XB_SPIN_CAP (1u << 18)

__device__ __forceinline__ unsigned xb_ld(unsigned* p)              { return __hip_atomic_load(p, __ATOMIC_RELAXED, __HIP_MEMORY_SCOPE_AGENT); }
__device__ __forceinline__ unsigned xb_add(unsigned* p, unsigned v) { return __hip_atomic_fetch_add(p, v, __ATOMIC_RELAXED, __HIP_MEMORY_SCOPE_AGENT); }
__device__ __forceinline__ unsigned xb_xcc_id() { return (unsigned)__builtin_amdgcn_s_getreg((3 << 11) | 20) & 0xFu; }
#define XB_SPIN(cond, bar) do { unsigned _sp = 0; while (cond) { __builtin_amdgcn_s_sleep(1); \
    if ((++_sp & 255u) == 0u) { if (xb_ld(&(bar)[XB_TMO])) break; if (_sp > XB_SPIN_CAP) { atomicAdd(&(bar)[XB_TMO], 1u); break; } } } } while (0)

struct XcdBarrier {
    unsigned* bar; unsigned x;
    volatile LAS unsigned* st;
};

__device__ __forceinline__ XcdBarrier xcd_barrier_post(unsigned* bar, volatile LAS unsigned* st) {
    XcdBarrier b; b.bar = bar; b.x = xb_xcc_id(); b.st = st;
    if (threadIdx.x == 0) (void)xb_add(&bar[XB_XCNT(b.x)], 1u);
    return b;
}
__device__ __forceinline__ void xcd_barrier_complete(unsigned* bar, unsigned x, unsigned& nloc, unsigned& nx) {
    const unsigned G = gridDim.x * gridDim.y * gridDim.z;
    unsigned sum, cnt, mine, sp = 0u;
    for (;;) {
        sum = 0u; cnt = 0u; mine = 0u;
#pragma unroll
        for (unsigned j = 0; j < 16; ++j) { const unsigned c = xb_ld(&bar[XB_XCNT(j)]); sum += c; cnt += (c > 0u) ? 1u : 0u; mine = (j == x) ? c : mine; }
        if (sum == G) break;
        __builtin_amdgcn_s_sleep(1);
        if ((++sp & 255u) == 0u) { if (xb_ld(&bar[XB_TMO])) break; if (sp > XB_SPIN_CAP) { atomicAdd(&bar[XB_TMO], 1u); break; } }
    }
    nloc = mine > 0u ? mine : 1u; nx = cnt > 0u ? cnt : 1u;
}

__device__ __forceinline__ void xcd_barrier(const XcdBarrier& b) {
    asm volatile("s_waitcnt vmcnt(0)" ::: "memory");
    __syncthreads();
    if (threadIdx.x == 0) {
        unsigned* bar = b.bar;
        __builtin_amdgcn_s_waitcnt(0);
        unsigned nloc = b.st[0], nx = b.st[1];
        if (nloc == 0u) { xcd_barrier_complete(bar, b.x, nloc, nx); b.st[0] = nloc; b.st[1] = nx; }
        const unsigned old = xb_add(&bar[XB_XSUB(b.x)], 1u);
        const unsigned gen = old / nloc;
        if (old + 1u == (gen + 1u) * nloc) {
            __builtin_amdgcn_fence(__ATOMIC_RELEASE, "agent");
            asm volatile("s_waitcnt vmcnt(0)" ::: "memory");
            const unsigned og = xb_add(&bar[XB_TOP], 1u);
            const unsigned tg = og / nx;
            if (og + 1u == (tg + 1u) * nx) xb_add(&bar[XB_TOPGEN], 1u);
            else XB_SPIN(xb_ld(&bar[XB_TOPGEN]) == tg, bar);
            __builtin_amdgcn_fence(__ATOMIC_ACQUIRE, "agent");
            xb_add(&bar[XB_XGEN(b.x)], 1u);
            asm volatile("s_waitcnt vmcnt(0)" ::: "memory");
        } else {
            XB_SPIN(xb_ld(&bar[XB_XGEN(b.x)]) == gen, bar);
            __builtin_amdgcn_fence(__ATOMIC_ACQUIRE, "agent");
            asm volatile("s_waitcnt vmcnt(0)" ::: "memory");
        }
    }
    __syncthreads();
}


struct Args { const float* in[19]; float* out; unsigned char* ws; int ph_lo, ph_hi, li, pad; };
struct Frame {
    LAS unsigned char* lds; unsigned* ctl; unsigned char* ws;
    int tid, lane, wave, vcu, G;
    const float* const* in; float* out;
};

struct TrItem { f32x4 v[16]; f32x4 g[4]; };
__device__ __forceinline__ void tr_load(TrItem& t, const float* srcp, int ldsrc, const float* gp) {
#pragma unroll
    for (int i = 0; i < 16; ++i) t.v[i] = __builtin_nontemporal_load((const f32x4*)(srcp + (size_t)i * ldsrc));
    if (gp) {
#pragma unroll
        for (int i = 0; i < 4; ++i) t.g[i] = *(const f32x4*)(gp + 4 * i);
    } else {
#pragma unroll
        for (int i = 0; i < 4; ++i) t.g[i] = (f32x4){1.f, 1.f, 1.f, 1.f};
    }
}
__device__ __forceinline__ void tr_store(const TrItem& t, bf16* dstp, int ldd) {
#pragma unroll
    for (int j = 0; j < 4; ++j)
#pragma unroll
        for (int c = 0; c < 2; ++c) {
            v4u o;
            o.x = pk2(t.v[8 * c + 0][j] * t.g[2 * c][0], t.v[8 * c + 1][j] * t.g[2 * c][1]); o.y = pk2(t.v[8 * c + 2][j] * t.g[2 * c][2], t.v[8 * c + 3][j] * t.g[2 * c][3]);
            o.z = pk2(t.v[8 * c + 4][j] * t.g[2 * c + 1][0], t.v[8 * c + 5][j] * t.g[2 * c + 1][1]); o.w = pk2(t.v[8 * c + 6][j] * t.g[2 * c + 1][2], t.v[8 * c + 7][j] * t.g[2 * c + 1][3]);
            *(v4u*)(dstp + (size_t)j * ldd + 8 * c) = o;
        }
}
__device__ __forceinline__ int win_src_col(int P) {
    if (P < 2048) return P;
    if (P < 3328) { const int p = P - 2048, t = p >> 8, pp = p & 255, bj = pp >> 7, wc = (pp & 127) >> 5, i = pp & 31; return (t < 4 ? 3072 + t * 256 : 4096) + 64 * wc + 32 * bj + i; }
    if (P < 4352) return 2048 + (P - 3328);
    return P;
}
__device__ __forceinline__ float rms_row_to_bf16(const float* xrow, bf16* orow, int lane) {
    const f32x4* xr = (const f32x4*)xrow + lane;
    f32x4 v[8]; float s = 0.f;
#pragma unroll
    for (int j = 0; j < 8; ++j) { v[j] = xr[64 * j]; s += (v[j].x * v[j].x + v[j].y * v[j].y) + (v[j].z * v[j].z + v[j].w * v[j].w); }
    const float rinv = sqrtf(wave_sum(s) * (1.f / DM) + RMS_EPS), rstd = 1.0f / rinv;
    v2u* o8 = (v2u*)orow + lane;
#pragma unroll
    for (int j = 0; j < 8; ++j) { v2u w; w.x = pk2(v[j].x * rstd, v[j].y * rstd); w.y = pk2(v[j].z * rstd, v[j].w * rstd); o8[64 * j] = w; }
    return rinv;
}
constexpr int I_IN = 32 * 72, I_OUT = 32 * 32, I_GU = NEXP * 32 * 16, I_D = NEXP * 8 * 32;
constexpr int NITEMS = I_IN + I_OUT + I_GU + I_D;
constexpr int TAIL1_PER_WAVE = 8, TAIL6_PER_WAVE = 9, TAIL6_ITEMS = 9216;
#ifndef P2_ITEMS_DEF
#define P2_ITEMS_DEF 32896
#endif
constexpr int P2_ITEMS = P2_ITEMS_DEF;
#ifndef ATT_WAVES_DEF
#define ATT_WAVES_DEF 4
#endif
constexpr int ATT_WAVES = ATT_WAVES_DEF;
__device__ __forceinline__ void conv_range(Frame& F, int it0, int step, int end) {
    bf16* WIN = (bf16*)(F.ws + WS_BIG) + (size_t)MPAD * DM;
    const float* ln_mix = F.in[3]; const float* w_in = F.in[4];
    const float* on_sb = F.in[8]; const float* on_sw = F.in[9]; const float* w_out = F.in[10]; const float* ln_ffn = F.in[11];
    const float* w_gate = F.in[16]; const float* w_up = F.in[17]; const float* w_down = F.in[18];
    bf16* WOUT = (bf16*)(F.ws + WS_WOUT); bf16* WGU = (bf16*)(F.ws + WS_WGU); bf16* WD = (bf16*)(F.ws + WS_WD);
    const int kr = F.lane >> 4, nq = F.lane & 15;
#define P0_ITEM(it, SRCP, LDS_, GP, DSTP, LDD) do { int r_ = (it); \
        if (r_ < I_IN) { const int kb = r_ / 72, nb = r_ % 72, k0 = 64 * kb + 16 * kr; SRCP = w_in + (size_t)k0 * 4608 + win_src_col(64 * nb + 4 * nq); LDS_ = 4608; GP = ln_mix + k0; DSTP = WIN + (size_t)(64 * nb + 4 * nq) * DM + k0; LDD = DM; } \
        else if ((r_ -= I_IN) < I_OUT) { const int kb = r_ >> 5, nb = r_ & 31, k0 = 64 * kb + 16 * kr; SRCP = w_out + (size_t)k0 * DM + 64 * nb + 4 * nq; LDS_ = DM; GP = (k0 < 1024 ? on_sb + k0 : on_sw + (k0 - 1024)); DSTP = WOUT + (size_t)(64 * nb + 4 * nq) * DM + k0; LDD = DM; } \
        else if ((r_ -= I_OUT) < I_GU) { const int e = r_ >> 9, q = r_ & 511, kb = q >> 4, nb = q & 15, k0 = 64 * kb + 16 * kr, nt = nb >> 2, bj = (nb >> 1) & 1, j0 = (nb & 1) * 64; \
            SRCP = (bj ? w_up : w_gate) + (size_t)e * DM * DEXP + (size_t)k0 * DEXP + nt * 128 + j0 + 4 * nq; LDS_ = DEXP; GP = ln_ffn + k0; DSTP = WGU + ((size_t)e * 1024 + 64 * nb + 4 * nq) * DM + k0; LDD = DM; } \
        else { r_ -= I_GU; const int e = r_ >> 8, q = r_ & 255, kb = q >> 5, nb = q & 31, k0 = 64 * kb + 16 * kr; \
            SRCP = w_down + (size_t)e * DEXP * DM + (size_t)k0 * DM + 64 * nb + 4 * nq; LDS_ = DM; GP = nullptr; DSTP = WD + ((size_t)e * 2048 + 64 * nb + 4 * nq) * DEXP + k0; LDD = DEXP; } } while (0)
    {
        TrItem cur; const float* sp; const float* gp; bf16* dp; int lds_, ldd; bf16* dpn; int lddn;
        int it = it0;
        if (it < end) { P0_ITEM(it, sp, lds_, gp, dp, ldd); tr_load(cur, sp, lds_, gp); }
        while (it < end) {
            const int itn = it + step; TrItem nxt;
            if (itn < end) { P0_ITEM(itn, sp, lds_, gp, dpn, lddn); tr_load(nxt, sp, lds_, gp); }
            tr_store(cur, dp, ldd);
            if (itn < end) { cur = nxt; dp = dpn; ldd = lddn; }
            it = itn;
        }
    }
#undef P0_ITEM
}
__device__ __forceinline__ void conv_range3(Frame& F, int it0, int step, int end) {
    bf16* WIN = (bf16*)(F.ws + WS_BIG) + (size_t)MPAD * DM;
    const float* ln_mix = F.in[3]; const float* w_in = F.in[4];
    const float* on_sb = F.in[8]; const float* on_sw = F.in[9]; const float* w_out = F.in[10]; const float* ln_ffn = F.in[11];
    const float* w_gate = F.in[16]; const float* w_up = F.in[17]; const float* w_down = F.in[18];
    bf16* WOUT = (bf16*)(F.ws + WS_WOUT); bf16* WGU = (bf16*)(F.ws + WS_WGU); bf16* WD = (bf16*)(F.ws + WS_WD);
    const int kr = F.lane >> 4, nq = F.lane & 15;
#define P0_ITEM(it, SRCP, LDS_, GP, DSTP, LDD) do { int r_ = (it); \
        if (r_ < I_IN) { const int kb = r_ / 72, nb = r_ % 72, k0 = 64 * kb + 16 * kr; SRCP = w_in + (size_t)k0 * 4608 + win_src_col(64 * nb + 4 * nq); LDS_ = 4608; GP = ln_mix + k0; DSTP = WIN + (size_t)(64 * nb + 4 * nq) * DM + k0; LDD = DM; } \
        else if ((r_ -= I_IN) < I_OUT) { const int kb = r_ >> 5, nb = r_ & 31, k0 = 64 * kb + 16 * kr; SRCP = w_out + (size_t)k0 * DM + 64 * nb + 4 * nq; LDS_ = DM; GP = (k0 < 1024 ? on_sb + k0 : on_sw + (k0 - 1024)); DSTP = WOUT + (size_t)(64 * nb + 4 * nq) * DM + k0; LDD = DM; } \
        else if ((r_ -= I_OUT) < I_GU) { const int e = r_ >> 9, q = r_ & 511, kb = q >> 4, nb = q & 15, k0 = 64 * kb + 16 * kr, nt = nb >> 2, bj = (nb >> 1) & 1, j0 = (nb & 1) * 64; \
            SRCP = (bj ? w_up : w_gate) + (size_t)e * DM * DEXP + (size_t)k0 * DEXP + nt * 128 + j0 + 4 * nq; LDS_ = DEXP; GP = ln_ffn + k0; DSTP = WGU + ((size_t)e * 1024 + 64 * nb + 4 * nq) * DM + k0; LDD = DM; } \
        else { r_ -= I_GU; const int e = r_ >> 8, q = r_ & 255, kb = q >> 5, nb = q & 31, k0 = 64 * kb + 16 * kr; \
            SRCP = w_down + (size_t)e * DEXP * DM + (size_t)k0 * DM + 64 * nb + 4 * nq; LDS_ = DM; GP = nullptr; DSTP = WD + ((size_t)e * 2048 + 64 * nb + 4 * nq) * DEXP + k0; LDD = DEXP; } } while (0)
    struct V16 { f32x4 v[16]; };
#define C3_LOAD(B, it) do { if ((it) < end) { const float* sp_; const float* gp_; bf16* dp_; int ls_, ld_; P0_ITEM((it), sp_, ls_, gp_, dp_, ld_); (void)gp_; (void)dp_; (void)ld_; \
        _Pragma("unroll") for (int i_ = 0; i_ < 16; ++i_) B.v[i_] = __builtin_nontemporal_load((const f32x4*)(sp_ + (size_t)i_ * ls_)); } } while (0)
#define C3_STORE(B, it) do { if ((it) < end) { const float* sp_; const float* gp_; bf16* dp_; int ls_, ld_; P0_ITEM((it), sp_, ls_, gp_, dp_, ld_); (void)sp_; (void)ls_; \
        f32x4 g_[4]; _Pragma("unroll") for (int i_ = 0; i_ < 4; ++i_) g_[i_] = gp_ ? *(const f32x4*)(gp_ + 4 * i_) : (f32x4){1.f, 1.f, 1.f, 1.f}; \
        _Pragma("unroll") for (int j_ = 0; j_ < 4; ++j_) _Pragma("unroll") for (int c_ = 0; c_ < 2; ++c_) { v4u o_; \
            o_.x = pk2(B.v[8 * c_ + 0][j_] * g_[2 * c_][0], B.v[8 * c_ + 1][j_] * g_[2 * c_][1]); o_.y = pk2(B.v[8 * c_ + 2][j_] * g_[2 * c_][2], B.v[8 * c_ + 3][j_] * g_[2 * c_][3]); \
            o_.z = pk2(B.v[8 * c_ + 4][j_] * g_[2 * c_ + 1][0], B.v[8 * c_ + 5][j_] * g_[2 * c_ + 1][1]); o_.w = pk2(B.v[8 * c_ + 6][j_] * g_[2 * c_ + 1][2], B.v[8 * c_ + 7][j_] * g_[2 * c_ + 1][3]); \
            *(v4u*)(dp_ + (size_t)j_ * ld_ + 8 * c_) = o_; } } } while (0)
    {
        V16 A, B, C; int it = it0;
        C3_LOAD(A, it); C3_LOAD(B, it + step);
        while (it < end) {
            C3_LOAD(C, it + 2 * step); C3_STORE(A, it);
            C3_LOAD(A, it + 3 * step); C3_STORE(B, it + step);
            C3_LOAD(B, it + 4 * step); C3_STORE(C, it + 2 * step);
            it += 3 * step;
        }
    }
#undef C3_LOAD
#undef C3_STORE
#undef P0_ITEM
}
__device__ __forceinline__ int tail1_items(int G) { const int rounds = (P1_UNITS + G - 1) / G, nidle = rounds * G - P1_UNITS; return nidle * NWAVES * TAIL1_PER_WAVE; }
__device__ __forceinline__ void p0_prologue(Frame& F) {
    const int gw = F.vcu * NWAVES + F.wave, NGW = F.G * NWAVES;
    if (blockIdx.x == 0 && F.tid < NEXP) __hip_atomic_store(F.ctl + CW_CNT + 16 * F.tid, 0u, __ATOMIC_RELAXED, __HIP_MEMORY_SCOPE_AGENT);
    bf16* BIG = (bf16*)(F.ws + WS_BIG);
    bf16* WIN = BIG + (size_t)MPAD * DM;
    const float* x = F.in[0]; const float* meta = F.in[1]; const float* ln_mix = F.in[3]; const float* w_in = F.in[4];
    const float* on_sb = F.in[8]; const float* on_sw = F.in[9]; const float* w_out = F.in[10]; const float* ln_ffn = F.in[11];
    const float* w_rg = F.in[12]; const float* w_re = F.in[14]; const float* w_gate = F.in[16]; const float* w_up = F.in[17]; const float* w_down = F.in[18];
    for (int m = gw; m < MPAD; m += NGW) {
        bf16* orow = BIG + (size_t)m * DM;
        if (m < NTOK) { const float ri = rms_row_to_bf16(x + (size_t)m * DM, orow, F.lane); if (F.lane == 0) ((float*)(F.ws + WS_RINV))[m] = ri; }
        else if (m < NTOK + NMETA) (void)rms_row_to_bf16(meta + (size_t)(m - NTOK) * DM, orow, F.lane);
        else { v4u z = {0u, 0u, 0u, 0u}; v4u* o = (v4u*)orow + F.lane;
#pragma unroll
            for (int j = 0; j < 4; ++j) o[64 * j] = z; }
    }
    conv_range(F, gw, NGW, NITEMS - TAIL6_ITEMS - tail1_items(F.G) - P2_ITEMS);
    bf16* WRH = (bf16*)(F.ws + WS_WR); bf16* WRL = WRH + 96 * DM;
    for (int idx = (F.vcu * NWAVES * 64 + F.tid); idx < 96 * DM; idx += F.G * NWAVES * 64) {
        const int c = idx / DM, k = idx % DM;
        float v = 0.f; if (c < 8) v = w_rg[k * 8 + c]; else if (c < 72) v = w_re[k * 64 + (c - 8)];
        v *= ln_ffn[k];
        const unsigned hi = pk2(v, 0.f) & 0xffffu; const float lo = v - __uint_as_float(hi << 16);
        const int fidx = ((((k >> 4) * 3 + (c >> 5)) * 64 + (((k >> 3) & 1) * 32 + (c & 31))) << 3) + (k & 7);
        WRH[fidx] = (bf16)hi; WRL[fidx] = (bf16)(pk2(lo, 0.f) & 0xffffu);
    }
}

struct P1Order {
    int G, c;
    __device__ bool next(int i, pg8::Unit& u) const {
        const int L = i * G + c; if (L >= P1_UNITS) return false;
        if (L < P1_UNITS_A) { u.pm = L / NT_QK; u.pn = NTILE_X + (L % NT_QK); }
        else { const int l = L - P1_UNITS_A; u.pm = NTILE_X + NT_QK + l / NTILE_X; u.pn = l % NTILE_X; }
        return true;
    }
    __device__ __forceinline__ void a_ready(const pg8::Unit&) const {}
    __device__ __forceinline__ void done(const pg8::Unit&) const {}
};
struct EpiQKV {
    static constexpr bool PERM = true, AFTER_DRAIN = false, MIDK = false;
    bf16 *QS, *KS, *QW, *KW, *VT; const float *q_norm, *k_norm;
    __device__ __forceinline__ void operator()(const pg8::f32x4 (&acc)[2][2][4][2], const pg8::Unit& u, int wr, int wc, int fr, int fq) const {
        using pg8::HALF;
        if (u.pm < NTILE_X) {
            const int t = u.pn - NTILE_X; const int row0 = u.pm * 256 + wr * 64 + fr;
            if (t < 8) {
                bf16* base = (t < 4) ? QS : KS; const float sc = (t < 4) ? C2 : 1.0f; const int col0 = (t & 3) * 256 + wc * 32 + 8 * fq;
#pragma unroll
                for (int ai = 0; ai < 2; ++ai)
#pragma unroll
                    for (int m = 0; m < 4; ++m) { bf16* rowp = base + (size_t)(row0 + ai * HALF + m * 16) * 1024 + col0;
#pragma unroll
                        for (int bj = 0; bj < 2; ++bj) { const pg8::f32x4 v0 = acc[ai][bj][m][0] * sc, v1 = acc[ai][bj][m][1] * sc;
                            v4u w; w.x = pk2(v0[0], v0[1]); w.y = pk2(v0[2], v0[3]); w.z = pk2(v1[0], v1[1]); w.w = pk2(v1[2], v1[3]); *(v4u*)(rowp + bj * HALF) = w; } }
            } else {
                const bool isq = t < 12; const float* gain = isq ? q_norm : k_norm; const float sc = isq ? C2 : 1.0f;
                bf16* base = isq ? (QW + (t - 8) * 256 + wc * 64) : (KW + wc * 64); const int ld = isq ? 1024 : 256;
                pg8::f32x4 g[2][2];
#pragma unroll
                for (int bj = 0; bj < 2; ++bj)
#pragma unroll
                    for (int n = 0; n < 2; ++n) g[bj][n] = *(const pg8::f32x4*)(gain + 32 * bj + 8 * fq + 4 * n) * sc;
#pragma unroll
                for (int ai = 0; ai < 2; ++ai)
#pragma unroll
                    for (int m = 0; m < 4; ++m) {
                        float ss = 0.f;
#pragma unroll
                        for (int bj = 0; bj < 2; ++bj)
#pragma unroll
                            for (int n = 0; n < 2; ++n) { const pg8::f32x4 v = acc[ai][bj][m][n]; ss += (v[0] * v[0] + v[1] * v[1]) + (v[2] * v[2] + v[3] * v[3]); }
                        ss += __shfl_xor(ss, 16); ss += __shfl_xor(ss, 32);
                        const float rstd = 1.0f / sqrtf(ss * (1.0f / 64.0f) + RMS_EPS);
                        bf16* rowp = base + (size_t)(row0 + ai * HALF + m * 16) * ld + 8 * fq;
#pragma unroll
                        for (int bj = 0; bj < 2; ++bj) { const pg8::f32x4 v0 = acc[ai][bj][m][0] * rstd * g[bj][0], v1 = acc[ai][bj][m][1] * rstd * g[bj][1];
                            v4u w; w.x = pk2(v0[0], v0[1]); w.y = pk2(v0[2], v0[3]); w.z = pk2(v1[0], v1[1]); w.w = pk2(v1[2], v1[3]); *(v4u*)(rowp + 32 * bj) = w; } }
            }
        } else {
            const int vrow0 = (u.pm - NTILE_X - NT_QK) * 256 + wr * 64 + fr;
#pragma unroll
            for (int ai = 0; ai < 2; ++ai)
#pragma unroll
                for (int m = 0; m < 4; ++m) { bf16* rowp = VT + (size_t)(vrow0 + ai * HALF + m * 16) * MPAD + u.pn * 256 + wc * 32 + 16 * (fq >> 1) + 4 * (fq & 1);
#pragma unroll
                    for (int bj = 0; bj < 2; ++bj)
#pragma unroll
                        for (int n = 0; n < 2; ++n) { const pg8::f32x4 v = acc[ai][bj][m][n]; v2u w; w.x = pk2(v[0], v[1]); w.y = pk2(v[2], v[3]); *(v2u*)(rowp + bj * HALF + 8 * n) = w; } }
        }
    }
};

namespace att {
__device__ __forceinline__ f32x16 mfma_bf(bf16x8 a, bf16x8 b, f32x16 c) { return __builtin_amdgcn_mfma_f32_32x32x16_bf16(a, b, c, 0, 0, 0); }
__device__ __forceinline__ f32x16 mfma_h(f16x8 a, f16x8 b, f32x16 c) { return __builtin_amdgcn_mfma_f32_32x32x16_f16(a, b, c, 0, 0, 0); }
__device__ __forceinline__ bf16x8 ld8(const bf16* p) { return *(const bf16x8*)p; }
__device__ __forceinline__ bf16x8 pack8(const float* w) { v4u o; o.x = pk2(w[0], w[1]); o.y = pk2(w[2], w[3]); o.z = pk2(w[4], w[5]); o.w = pk2(w[6], w[7]); return __builtin_bit_cast(bf16x8, o); }

struct KT { bf16x8 k[4]; bf16x8 v[4]; };
__device__ __forceinline__ void glds16(const void* gsrc, unsigned lds_dst) { unsigned keep;
    asm volatile("s_mov_b32 %0, m0\n\ts_mov_b32 m0, %2\n\ts_nop 0\n\tglobal_load_lds_dwordx4 %1, off\n\ts_mov_b32 m0, %0" : "=&s"(keep) : "v"(gsrc), "s"(lds_dst) : "memory"); }
__device__ __forceinline__ void dma_tile(unsigned slot, const bf16* Kb, int ldk, const bf16* Vt, int b, int j, int lane) {
#pragma unroll
    for (int i = 0; i < 4; ++i) { const int row = 8 * i + (lane >> 3), ch = (lane & 7) ^ (row & 7);
        const int krow = (j >= 0) ? (b * SEQ + 32 * j + row) : (NTOK + (row & 15));
        glds16(Kb + (size_t)krow * ldk + ch * 8, (unsigned)__builtin_amdgcn_readfirstlane(slot + i * 1024)); }
    const int col0 = (j >= 0) ? (b * SEQ + 32 * j) : NTOK;
#pragma unroll
    for (int i = 0; i < 4; ++i) { const int row = 16 * i + (lane >> 2), c = (lane & 3) ^ ((row >> 2) & 3); const int cc = (j >= 0) ? c : (c & 1);
        glds16(Vt + (size_t)row * MPAD + col0 + cc * 8, (unsigned)__builtin_amdgcn_readfirstlane(slot + 4096 + i * 1024)); }
}
__device__ __forceinline__ void lds_frags(KT& t, const LAS unsigned char* slot, int r, int h) {
#pragma unroll
    for (int s = 0; s < 4; ++s) { const int c = 2 * s + h; t.k[s] = *(const LAS bf16x8*)(slot + (r >> 3) * 1024 + ((r & 7) * 8 + (c ^ (r & 7))) * 16); }
#pragma unroll
    for (int dh = 0; dh < 2; ++dh)
#pragma unroll
        for (int s = 0; s < 2; ++s) { const int row = 32 * dh + r, c = 2 * s + h; t.v[dh * 2 + s] = *(const LAS bf16x8*)(slot + 4096 + row * 64 + (c ^ ((row >> 2) & 3)) * 16); }
}
#define ATT_WAITV(n) asm volatile("s_waitcnt vmcnt(" #n ")" ::: "memory")

struct SbState { f32x16 o0, o1; float R; };
template <int KIND>
__device__ __forceinline__ void sb_tile(SbState& S, const KT& t, const bf16x8 (&qf)[4], const f16x8& U0, const f16x8& U1, int r, int h) {
    f32x16 z = {0.f, 0.f, 0.f, 0.f, 0.f, 0.f, 0.f, 0.f, 0.f, 0.f, 0.f, 0.f, 0.f, 0.f, 0.f, 0.f};
#pragma unroll
    for (int s = 0; s < 4; ++s) z = mfma_bf(t.k[s], qf[s], z);
    f32x16 init; float L[16];
#pragma unroll
    for (int g = 0; g < 16; ++g) {
        const float zz = z[g];
        const float e = __builtin_amdgcn_exp2f(-__builtin_fabsf(zz));
        const float zp = __builtin_amdgcn_fmed3f(zz, 0.f, 3.0e38f);
        const float sp = zp + __builtin_amdgcn_logf(1.0f + e);
        float Lv = -sp;
        if (KIND == 1) Lv = (crow(g, h) < r) ? Lv : 0.f;
        if (KIND == 2) Lv = (crow(g, h) < 16) ? Lv : 0.f;
        L[g] = Lv; init[g] = zz + Lv + S.R;
    }
    f16x8 lb0, lb1;
#pragma unroll
    for (int j = 0; j < 8; ++j) { lb0[j] = (_Float16)L[j]; lb1[j] = (_Float16)L[8 + j]; }
    f32x16 lw = mfma_h(U0, lb0, init); lw = mfma_h(U1, lb1, lw);
    float Rn = lw[0] - z[0];
    Rn = __shfl(Rn, r);
    float w[16];
#pragma unroll
    for (int g = 0; g < 16; ++g) {
        float wv = __builtin_amdgcn_exp2f(lw[g]);
        if (KIND == 1) wv = (crow(g, h) < r) ? wv : 0.f;
        if (KIND == 2) wv = (crow(g, h) < 16) ? wv : 0.f;
        w[g] = wv;
    }
    const bf16x8 wb0 = pack8(w), wb1 = pack8(w + 8);
    S.o0 = mfma_bf(t.v[0], wb0, S.o0); S.o0 = mfma_bf(t.v[1], wb1, S.o0);
    S.o1 = mfma_bf(t.v[2], wb0, S.o1); S.o1 = mfma_bf(t.v[3], wb1, S.o1);
    S.R = Rn;
}

struct SwState { f32x16 o0, o1; float m, l; };
template <int KIND>
__device__ __forceinline__ void sw_tile(SwState& S, const KT& t, const bf16x8 (&qf)[4], const LAS float* tb, int r, int h) {
    f32x16 z = {0.f, 0.f, 0.f, 0.f, 0.f, 0.f, 0.f, 0.f, 0.f, 0.f, 0.f, 0.f, 0.f, 0.f, 0.f, 0.f};
#pragma unroll
    for (int s = 0; s < 4; ++s) z = mfma_bf(t.k[s], qf[s], z);
    float sc[16]; float mx = -1e30f;
#pragma unroll
    for (int g = 0; g < 16; ++g) {
        float v = z[g] + tb[(g & 3) + 8 * (g >> 2)];
        if (KIND == 1) v = (crow(g, h) <= r) ? v : -1e30f;
        if (KIND == 2) v = (crow(g, h) < 16) ? v : -1e30f;
        if (KIND == 3) v = (crow(g, h) > r) ? v : -1e30f;
        sc[g] = v; mx = __builtin_fmaxf(mx, v);
    }
    mx = __builtin_fmaxf(mx, __shfl_xor(mx, 32));
    const float mn = __builtin_fmaxf(S.m, mx);
    const float alpha = __builtin_amdgcn_exp2f(S.m - mn);
    S.l *= alpha; S.o0 *= alpha; S.o1 *= alpha;
    float p[16]; float ls = 0.f;
#pragma unroll
    for (int g = 0; g < 16; ++g) { p[g] = __builtin_amdgcn_exp2f(sc[g] - mn); ls += p[g]; }
    S.l += ls; S.m = mn;
    const bf16x8 wb0 = pack8(p), wb1 = pack8(p + 8);
    S.o0 = mfma_bf(t.v[0], wb0, S.o0); S.o0 = mfma_bf(t.v[1], wb1, S.o0);
    S.o1 = mfma_bf(t.v[2], wb0, S.o1); S.o1 = mfma_bf(t.v[3], wb1, S.o1);
}
__device__ __forceinline__ float store_o(bf16* orow, const f32x16& o0, const f32x16& o1, float scale, int h) {
    float ss = 0.f;
#pragma unroll
    for (int q = 0; q < 4; ++q) {
        const float a0 = o0[4 * q] * scale, a1 = o0[4 * q + 1] * scale, a2 = o0[4 * q + 2] * scale, a3 = o0[4 * q + 3] * scale;
        const float b0 = o1[4 * q] * scale, b1 = o1[4 * q + 1] * scale, b2 = o1[4 * q + 2] * scale, b3 = o1[4 * q + 3] * scale;
        ss += ((a0 * a0 + a1 * a1) + (a2 * a2 + a3 * a3)) + ((b0 * b0 + b1 * b1) + (b2 * b2 + b3 * b3));
        v2u w; w.x = pk2(a0, a1); w.y = pk2(a2, a3); *(v2u*)(orow + 8 * q + 4 * h) = w;
        v2u x; x.x = pk2(b0, b1); x.y = pk2(b2, b3); *(v2u*)(orow + 32 + 8 * q + 4 * h) = x;
    }
    return ss;
}
}

__device__ __forceinline__ void p2_attention(Frame& F) {
    using namespace att;
    const int lane = F.lane, r = lane & 31, h = lane >> 5, w = F.wave;
    const bf16* VT = (const bf16*)(F.ws + WS_VT); bf16* MIX = (bf16*)(F.ws + WS_MIXED); float* SSQ = (float*)(F.ws + WS_SSQ);
    LAS float* tbr = (LAS float*)(F.lds + ATT_TBR_OFF);
    const LAS unsigned char* area = F.lds + RING_OFF + w * 16384;
    const unsigned slot0 = (unsigned)(uintptr_t)area;
    { const float* rel_bias = F.in[2];
      for (int idx = F.tid; idx < 16 * 192; idx += NWAVES * 64) {
        const int hq = idx / 192, x = idx % 192, d = 159 - x; float v = 0.f;
        if (d >= 0) { int bkt = d; if (d >= 16) { bkt = 16 + (int)(logf((float)d / 16.0f) / logf(8.0f) * 16.0f); bkt = bkt > 31 ? 31 : bkt; } v = rel_bias[bkt * 16 + hq] * LOG2E; }
        tbr[idx] = v;
      } }
    __syncthreads();
    if (w >= ATT_WAVES) {
        const int p2_end = NITEMS - TAIL6_ITEMS - tail1_items(F.G);
        conv_range3(F, p2_end - P2_ITEMS + F.vcu * (NWAVES - ATT_WAVES) + (w - ATT_WAVES), F.G * (NWAVES - ATT_WAVES), p2_end);
        return;
    }
    __builtin_amdgcn_s_setprio(3);
    for (int unit = F.vcu; unit < NTOK / 32; unit += F.G) {
        const int b = unit >> 7, a = unit & 127;
        const size_t qrow = (size_t)b * SEQ + 32 * a + r;
#pragma unroll 1
        for (int bi = 0; bi < 2; ++bi) {
            const int branch = bi;
            if (branch == 0) {
            const bf16* KS = (const bf16*)(F.ws + WS_KS); const bf16* QS = (const bf16*)(F.ws + WS_QS);
            f16x8 U0, U1;
#pragma unroll
            for (int j = 0; j < 8; ++j) { const int c0 = 8 * (j >> 2) + 4 * h + (j & 3); U0[j] = (c0 > r) ? (_Float16)1.0f : (_Float16)0.0f; U1[j] = (16 + c0 > r) ? (_Float16)1.0f : (_Float16)0.0f; }
            float ssl = 0.f;
#pragma unroll 1
            for (int hh = 0; hh < 16 / ATT_WAVES; ++hh) {
                const int head = (16 / ATT_WAVES) * w + hh;
                ATT_WAITV(0);
                const bf16* Kb = KS + head * 64;
                bf16x8 ql[4];
#pragma unroll
                for (int s = 0; s < 4; ++s) ql[s] = ld8(QS + qrow * 1024 + head * 64 + 16 * s + 8 * h);
                SbState S; S.R = 0.f;
#pragma unroll
                for (int g = 0; g < 16; ++g) { S.o0[g] = 0.f; S.o1[g] = 0.f; }
                const bf16* Vt = VT + (size_t)(head * 64) * MPAD;
                unsigned sl_cur = slot0, sl_nxt = slot0 + 8192;
                int jt = a;
                dma_tile(sl_cur, Kb, 1024, Vt, b, jt, lane); dma_tile(sl_nxt, Kb, 1024, Vt, b, jt - 1, lane);
                ATT_WAITV(8);
                KT T; lds_frags(T, area + (sl_cur - slot0), r, h);
                sb_tile<1>(S, T, ql, U0, U1, r, h);
                if (!__all(S.R < SB_EXIT)) {
                    --jt;
                    for (;;) {
                        { const unsigned t_ = sl_cur; sl_cur = sl_nxt; sl_nxt = t_; }
                        const bool has_next = jt >= 0;
                        if (has_next) { dma_tile(sl_nxt, Kb, 1024, Vt, b, jt - 1, lane); ATT_WAITV(8); } else ATT_WAITV(0);
                        lds_frags(T, area + (sl_cur - slot0), r, h);
                        if (jt >= 0) sb_tile<0>(S, T, ql, U0, U1, r, h); else sb_tile<2>(S, T, ql, U0, U1, r, h);
                        if (!has_next || __all(S.R < SB_EXIT)) break;
                        --jt;
                    }
                }
                ssl += store_o(MIX + qrow * DM + head * 64, S.o0, S.o1, 1.0f, h);
            }
            ssl += __shfl_xor(ssl, 32);
            if (h == 0) SSQ[qrow * 16 + w] = ssl;
        }
            else {
            const bf16* KW = (const bf16*)(F.ws + WS_KW); const bf16* QW = (const bf16*)(F.ws + WS_QW);
            float ssl = 0.f;
#pragma unroll 1
            for (int hh = 0; hh < 16 / ATT_WAVES; ++hh) {
                const int hq = (16 / ATT_WAVES) * w + hh, kvh = hq >> 2;
                ATT_WAITV(0);
                const bf16* Kb = KW + kvh * 64;
                bf16x8 ql[4];
#pragma unroll
                for (int s = 0; s < 4; ++s) ql[s] = ld8(QW + qrow * 1024 + hq * 64 + 16 * s + 8 * h);
                const float sink2 = F.in[7][hq] * LOG2E;
                SwState S; S.m = sink2; S.l = 0.f;
#pragma unroll
                for (int g = 0; g < 16; ++g) { S.o0[g] = 0.f; S.o1[g] = 0.f; }
                const LAS float* tbh = tbr + hq * 192 + 4 * h;
                const int jlo = (a >= 4) ? a - 4 : 0;
                const bf16* Vt = VT + (size_t)(1024 + kvh * 64) * MPAD;
                unsigned sl_cur = slot0, sl_nxt = slot0 + 8192;
                int jt = a;
#define SW_NEXT(j) (((j) > jlo) ? (j) - 1 : -1)
                dma_tile(sl_cur, Kb, 256, Vt, b, jt, lane); dma_tile(sl_nxt, Kb, 256, Vt, b, SW_NEXT(jt), lane);
                ATT_WAITV(8);
                KT T; lds_frags(T, area + (sl_cur - slot0), r, h);
                sw_tile<1>(S, T, ql, tbh + (159 - r), r, h);
                jt = SW_NEXT(jt);
                for (;;) {
                    { const unsigned t_ = sl_cur; sl_cur = sl_nxt; sl_nxt = t_; }
                    if (jt >= 0) { dma_tile(sl_nxt, Kb, 256, Vt, b, SW_NEXT(jt), lane); ATT_WAITV(8); } else ATT_WAITV(0);
                    lds_frags(T, area + (sl_cur - slot0), r, h);
                    if (jt < 0) { const int dq = 32 * a + r + 16; sw_tile<2>(S, T, ql, tbh + (159 - (dq < 159 ? dq : 159)), r, h); break; }
                    const LAS float* tb = tbh + (159 - (32 * (a - jt) + r));
                    if (jt == a - 4) sw_tile<3>(S, T, ql, tb, r, h); else sw_tile<0>(S, T, ql, tb, r, h);
                    jt = SW_NEXT(jt);
                }
#undef SW_NEXT
                const float lt = S.l + __shfl_xor(S.l, 32) + __builtin_amdgcn_exp2f(sink2 - S.m);
                ssl += store_o(MIX + qrow * DM + 1024 + hq * 64, S.o0, S.o1, 1.0f / lt, h);
            }
            ssl += __shfl_xor(ssl, 32);
            if (h == 0) SSQ[qrow * 16 + 8 + w] = ssl;
        }
        }
    }
    __builtin_amdgcn_s_setprio(0);
}

struct EpiRes {
    static constexpr bool PERM = true, AFTER_DRAIN = false, MIDK = true;
    bf16* P; const LAS float* RS; const bf16* XN; mutable int ui;
    __device__ __forceinline__ void midk(pg8::f32x4 (&acc)[2][2][4][2], const pg8::Unit& u, int wr, int fr) const {
#pragma unroll
        for (int ai = 0; ai < 2; ++ai)
#pragma unroll
            for (int m = 0; m < 4; ++m) { const LAS float* q = RS + (ui * 256 + ai * 128 + wr * 64 + m * 16 + fr) * 2; const float ratio = q[0] / q[1];
#pragma unroll
                for (int bj = 0; bj < 2; ++bj)
#pragma unroll
                    for (int n = 0; n < 2; ++n) acc[ai][bj][m][n] *= ratio; }
    }
    __device__ __forceinline__ void operator()(const pg8::f32x4 (&acc)[2][2][4][2], const pg8::Unit& u, int wr, int wc, int fr, int fq) const {
        const int col0 = u.pn * 256 + wc * 32 + 8 * fq;
        v4u xr[2][4][2];
#pragma unroll
        for (int ai = 0; ai < 2; ++ai)
#pragma unroll
            for (int m = 0; m < 4; ++m) { const int rl = ai * 128 + wr * 64 + m * 16 + fr; const bf16* xp = XN + (size_t)(u.pm * 256 + rl) * DM + col0;
#pragma unroll
                for (int bj = 0; bj < 2; ++bj) xr[ai][m][bj] = *(const v4u*)(xp + bj * 128); }
#pragma unroll
        for (int ai = 0; ai < 2; ++ai)
#pragma unroll
            for (int m = 0; m < 4; ++m) { const int rl = ai * 128 + wr * 64 + m * 16 + fr; bf16* rowp = P + (size_t)(u.pm * 256 + rl) * DM + col0; const float rw = RS[(ui * 256 + rl) * 2 + 1], ri = RS[2048 + ui * 256 + rl];
#pragma unroll
                for (int bj = 0; bj < 2; ++bj) { const pg8::f32x4 v0 = acc[ai][bj][m][0] * rw, v1 = acc[ai][bj][m][1] * rw; const v4u x = xr[ai][m][bj];
                    v4u w; w.x = pk2(bf_lo(x.x) * ri + v0[0], bf_hi(x.x) * ri + v0[1]); w.y = pk2(bf_lo(x.y) * ri + v0[2], bf_hi(x.y) * ri + v0[3]);
                    w.z = pk2(bf_lo(x.z) * ri + v1[0], bf_hi(x.z) * ri + v1[1]); w.w = pk2(bf_lo(x.w) * ri + v1[2], bf_hi(x.w) * ri + v1[3]); *(v4u*)(rowp + bj * 128) = w; } }
        ++ui;
    }
};

__device__ __forceinline__ void p4_router(Frame& F) {
    using namespace att;
    const int lane = F.lane, r = lane & 31, h = lane >> 5, w = F.wave;
    const bf16* HB = (const bf16*)(F.ws + WS_HB);
    const bf16* WRH = (const bf16*)(F.ws + WS_WR); const bf16* WRL = WRH + 96 * DM;
    const float* b_rg = F.in[13]; const float* b_re = F.in[15];
    unsigned* CNT = F.ctl + CW_CNT;
    int* LIST = (int*)(F.ws + WS_LIST); float* GATEW = (float*)(F.ws + WS_GATEW); int* TOKINFO = (int*)(F.ws + WS_TOKINFO); float* RSTD = (float*)(F.ws + WS_RSTD); float* RSTDW = (float*)(F.ws + WS_RSTDW);
    LAS float* part = (LAS float*)(F.lds + RING_OFF);
    LAS float* ssp = (LAS float*)(F.lds + RING_OFF + 98304);
    LAS float* lg = (LAS float*)(F.lds + RING_OFF + 98304 + 2048);
    LAS float* rsl = (LAS float*)(F.lds + RING_OFF + 98304 + 2048 + 18432);
    const bool stager = __builtin_amdgcn_readfirstlane(w) < 4; const int mw = w & 3;
    const int crot = F.vcu & 3, krot = (F.vcu >> 2) & 7;
    for (int unit = F.vcu; unit < NTOK / 64; unit += F.G) {
        f32x16 acc[2][3];
#pragma unroll
        for (int t = 0; t < 2; ++t)
#pragma unroll
            for (int nt = 0; nt < 3; ++nt)
#pragma unroll
                for (int g = 0; g < 16; ++g) acc[t][nt][g] = 0.f;
        float ss0 = 0.f, ss1 = 0.f;
#ifdef PROBE_P4REP
        int nrep = PROBE_P4REP; asm volatile("" : "+s"(nrep));
#pragma unroll 1
        for (int rep = 0; rep < nrep; ++rep) {
        if (rep > 0) { ss0 = 0.f; ss1 = 0.f;
#pragma unroll
        for (int t = 0; t < 2; ++t)
#pragma unroll
            for (int nt = 0; nt < 3; ++nt)
#pragma unroll
                for (int g = 0; g < 16; ++g) acc[t][nt][g] = 0.f; }
#endif
#pragma unroll 1
        for (int c = -1; c < 4; ++c) {
            if (stager) {
                if (c < 3) {
                    const int cn = (c + 1 + crot) & 3;
                    LAS unsigned char* sh = F.lds + RING_OFF + ((c + 1) & 1) * 65536;
#pragma unroll 1
                    for (int hb = 0; hb < 2; ++hb) {
                        v4u xr[8];
#pragma unroll
                        for (int i = 0; i < 8; ++i) { const int id = (hb * 8 + i) * 256 + F.tid, row = id >> 6, g = id & 63; xr[i] = *(const v4u*)(HB + ((size_t)unit * 64 + row) * DM + 512 * cn + 8 * g); }
#pragma unroll
                        for (int i = 0; i < 8; ++i) { const int id = (hb * 8 + i) * 256 + F.tid, row = id >> 6, g = id & 63; *(LAS v4u*)(sh + row * 1024 + ((g ^ (row & 15)) << 4)) = xr[i]; }
                    }
                }
            } else if (c >= 0) {
                const LAS unsigned char* sh = F.lds + RING_OFF + (c & 1) * 65536;
#pragma unroll 2
                for (int s8 = 0; s8 < 8; ++s8) {
                    const int ks = mw + 4 * ((s8 + krot) & 7), ksg = 32 * ((c + crot) & 3) + ks;
                    const int fo0 = r * 1024 + ((((2 * ks + h) ^ (r & 15))) << 4), fo1 = fo0 + 32 * 1024;
                    const v4u h0 = *(const LAS v4u*)(sh + fo0), h1 = *(const LAS v4u*)(sh + fo1);
#define P4_SS(SS, HV) { const float e0 = bf_lo(HV.x), e1 = bf_hi(HV.x), e2 = bf_lo(HV.y), e3 = bf_hi(HV.y), e4 = bf_lo(HV.z), e5 = bf_hi(HV.z), e6 = bf_lo(HV.w), e7 = bf_hi(HV.w); \
                    SS += ((e0 * e0 + e1 * e1) + (e2 * e2 + e3 * e3)) + ((e4 * e4 + e5 * e5) + (e6 * e6 + e7 * e7)); }
                    P4_SS(ss0, h0) P4_SS(ss1, h1)
#undef P4_SS
                    const bf16x8 ahi0 = __builtin_bit_cast(bf16x8, h0), ahi1 = __builtin_bit_cast(bf16x8, h1);
#pragma unroll
                    for (int nt = 0; nt < 3; ++nt) {
                        const int fo = (((ksg * 3 + nt) * 64 + lane) << 3);
                        const bf16x8 bh = ld8(WRH + fo), bl = ld8(WRL + fo);
                        acc[0][nt] = mfma_bf(ahi0, bh, acc[0][nt]); acc[0][nt] = mfma_bf(ahi0, bl, acc[0][nt]);
                        acc[1][nt] = mfma_bf(ahi1, bh, acc[1][nt]); acc[1][nt] = mfma_bf(ahi1, bl, acc[1][nt]);
                    }
                }
            }
            __syncthreads();
        }
#ifdef PROBE_P4REP
        }
#endif
        ss0 += __shfl_xor(ss0, 32); ss1 += __shfl_xor(ss1, 32);
        if (!stager && h == 0) { ssp[mw * 32 + r] = ss0; ssp[128 + mw * 32 + r] = ss1; }
#pragma unroll
        for (int t = 0; t < 2; ++t) {
#pragma unroll
            for (int nt = 0; nt < 3; ++nt)
#pragma unroll
                for (int g = 0; g < 16; ++g) { if (!stager) part[(mw * 32 + crow(g, h)) * 96 + nt * 32 + r] = acc[t][nt][g]; }
            __syncthreads();
            for (int idx = F.tid; idx < 32 * 72; idx += NWAVES * 64) { const int tk = idx / 72, c = idx % 72; float v = 0.f;
#pragma unroll
                for (int i = 0; i < 4; ++i) v += part[(i * 32 + tk) * 96 + c];
                lg[t * 32 * 72 + idx] = v; }
            __syncthreads();
        }
        LAS unsigned* hist = (LAS unsigned*)rsl + 64;
        if (F.tid < 128) hist[F.tid] = 0u;
        __syncthreads();
        int tok = 0, e0 = 0, e1 = 0; unsigned r0 = 0, r1 = 0; float g0 = 0.f, g1 = 0.f, rs = 0.f;
        if (F.tid < 64) {
            tok = unit * 64 + F.tid; float tsum = 0.f;
#pragma unroll
            for (int i = 0; i < 4; ++i) tsum += ssp[(F.tid >> 5) * 128 + i * 32 + (F.tid & 31)];
            rs = 1.0f / sqrtf(tsum * (1.0f / DM) + RMS_EPS); RSTD[tok] = rs;
            const LAS float* l = lg + F.tid * 72;
            float gl[8]; int gi = 0; float gm = -3.0e38f;
#pragma unroll
            for (int i = 0; i < 8; ++i) { gl[i] = l[i] * rs + b_rg[i]; if (gl[i] > gm) { gm = gl[i]; gi = i; } }
            float gs = 0.f;
#pragma unroll
            for (int i = 0; i < 8; ++i) gs += expf(gl[i] - gm);
            const float gval = 1.0f / gs;
            float el[8]; int i0 = 0; float m0 = -3.0e38f;
#pragma unroll
            for (int i = 0; i < 8; ++i) { el[i] = l[8 + gi * 8 + i] * rs + b_re[gi * 8 + i]; if (el[i] > m0) { m0 = el[i]; i0 = i; } }
            int i1 = 0; float m1 = -3.0e38f;
#pragma unroll
            for (int i = 0; i < 8; ++i) if (i != i0 && el[i] > m1) { m1 = el[i]; i1 = i; }
            const float p1 = expf(m1 - m0); g0 = gval / (1.0f + p1); g1 = gval * p1 / (1.0f + p1);
            e0 = gi * 8 + i0; e1 = gi * 8 + i1;
            r0 = atomicAdd((unsigned*)(hist + e0), 1u); r1 = atomicAdd((unsigned*)(hist + e1), 1u);
        }
        __syncthreads();
        if (F.tid < 64) { const unsigned n = hist[F.tid]; if (n) hist[64 + F.tid] = atomicAdd(CNT + 16 * F.tid, n); }
        __syncthreads();
        if (F.tid < 64) {
            const int pos0 = (int)(hist[64 + e0] + r0), pos1 = (int)(hist[64 + e1] + r1);
            LIST[e0 * NTOK + pos0] = tok; LIST[e1 * NTOK + pos1] = tok; GATEW[e0 * NTOK + pos0] = g0; GATEW[e1 * NTOK + pos1] = g1; RSTDW[e0 * NTOK + pos0] = rs; RSTDW[e1 * NTOK + pos1] = rs;
            *(int4*)(TOKINFO + 4 * tok) = make_int4(e0, pos0, e1, pos1);
        }
        __syncthreads();
    }
}

__device__ __forceinline__ void build_tables(Frame& F) {
    LAS int* T = (LAS int*)(F.lds + TBL_OFF);
    __syncthreads();
    if (F.tid < NEXP) {
        const int c = (int)__hip_atomic_load(F.ctl + CW_CNT + 16 * F.tid, __ATOMIC_RELAXED, __HIP_MEMORY_SCOPE_AGENT); const int mt = (c + 255) >> 8;
        int incl = mt;
#pragma unroll
        for (int o = 1; o < 64; o <<= 1) { const int v = __shfl_up(incl, o); if (F.tid >= o) incl += v; }
        const int st = incl - mt;
        T[TBL_TSTART + F.tid] = st; T[TBL_CNTS + F.tid] = c;
        for (int i = 0; i < mt; ++i) T[TBL_TE + st + i] = F.tid;
        if (F.tid == NEXP - 1) { T[TBL_TSTART + NEXP] = incl; T[TBL_NT] = incl; }
    }
    __syncthreads();
}
struct MoeGather {
    const int* list; const LAS int* T; LAS int* tokbuf; int NT; const float* rstdw; const float* gatew;
    __device__ __forceinline__ void info(const pg8::Unit& u, int& e, int& base, int& cnt) const { e = u.pn / NT; base = (u.pm - T[TBL_TSTART + e]) * 256; cnt = T[TBL_CNTS + e]; }
    __device__ __forceinline__ unsigned tok_direct(const pg8::Unit& u, int row) const { int e, base, cnt; info(u, e, base, cnt); const int idx = base + row; return idx < cnt ? (unsigned)list[e * NTOK + idx] : 0u; }
    __device__ __forceinline__ void issue(const pg8::Unit& u, int par, int lane) const { int e, base, cnt; info(u, e, base, cnt);
        __builtin_amdgcn_global_load_lds((const unsigned*)(list + e * NTOK + base + 4 * lane), (LAS unsigned*)(tokbuf + par * 256), 16, 0, 0);
        __builtin_amdgcn_global_load_lds((const unsigned*)(rstdw + e * NTOK + base + 4 * lane), (LAS unsigned*)(tokbuf + 512 + par * 256), 16, 0, 0);
        __builtin_amdgcn_global_load_lds((const unsigned*)(gatew + e * NTOK + base + 4 * lane), (LAS unsigned*)(tokbuf + 1024 + par * 256), 16, 0, 0); }
    __device__ __forceinline__ void direct_rg(const pg8::Unit& u, int row, float& rs, float& gw) const { int e, base, cnt; info(u, e, base, cnt); rs = rstdw[e * NTOK + base + row]; gw = gatew[e * NTOK + base + row]; }
    __device__ __forceinline__ unsigned tok_lds(const pg8::Unit& u, int par, int row) const { int e, base, cnt; info(u, e, base, cnt); const unsigned t = (unsigned)tokbuf[par * 256 + row]; return (base + row) < cnt ? t : 0u; }
};
namespace pg8 {
template <class Epi, class Sched>
__device__ __forceinline__ void gemm_phase_g(PG8_LAS unsigned char* lds, const Gemm g, const Sched& S, const Epi& E, const MoeGather& GA) {
    const int tid = threadIdx.x, wid = __builtin_amdgcn_readfirstlane(tid >> 6), lane = tid & 63, wr = wid >> 2, wc = wid & 3, fr = lane & 15, fq = lane >> 4;
    const int K = g.K, nt = K / BK;
    unsigned voffB[2], cofA[2]; int rowA[2];
#pragma unroll
    for (int i = 0; i < 2; ++i) { int R, C; stage_rc(tid * 16 + i * 8192, R, C); const int Rb = Epi::PERM ? ((R & ~31) + perm32(R & 31)) : R;
        rowA[i] = R; cofA[i] = (unsigned)C * 2u; voffB[i] = (unsigned)(Rb * K + C) * 2u; }
    const unsigned rowbytes = (unsigned)K * 2u;
    const size_t kstep = (size_t)(BK * 2);
    const size_t hstep = (size_t)HALF * K * 2;
    const size_t tstep = 2 * hstep;
    const unsigned ldsw = (unsigned)wid * 1024u;
    const int aoff = lds_byte(wr * 64 + fr, fq * 8), boff = lds_byte(wc * 32 + fr, fq * 8);
#define PG8_SA(b, h) (((b) * 2 + (h)) * HTB)
#define PG8_SB(b, h) ((4 + (b) * 2 + (h)) * HTB)
#define PG8_STAGE(bufoff, gbase, voff) do { _Pragma("unroll") for (int _i = 0; _i < 2; ++_i) \
        __builtin_amdgcn_global_load_lds((const unsigned*)((const char*)(gbase) + (voff)[_i]), (PG8_LAS unsigned*)(lds + (bufoff) + ldsw + _i * 8192), 16, 0, 0); } while (0)
#define PG8_LDA(dst, b, h) do { _Pragma("unroll") for (int m = 0; m < 4; ++m) _Pragma("unroll") for (int k = 0; k < 2; ++k) dst[m][k] = *(const PG8_LAS bf16x8*)(lds + PG8_SA(b, h) + aoff + m * 2048 + k * 1024); } while (0)
#define PG8_LDB(dst, b, h) do { _Pragma("unroll") for (int n = 0; n < 2; ++n) _Pragma("unroll") for (int k = 0; k < 2; ++k) dst[n][k] = *(const PG8_LAS bf16x8*)(lds + PG8_SB(b, h) + boff + n * 2048 + k * 1024); } while (0)
#define PG8_MMA(ai, bj, At, Bt) do { __builtin_amdgcn_s_setprio(1); _Pragma("unroll") for (int m = 0; m < 4; ++m) _Pragma("unroll") for (int n = 0; n < 2; ++n) _Pragma("unroll") for (int k = 0; k < 2; ++k) \
        acc[ai][bj][m][n] = __builtin_amdgcn_mfma_f32_16x16x32_bf16(Bt[n][k], At[m][k], acc[ai][bj][m][n], 0, 0, 0); __builtin_amdgcn_s_setprio(0); } while (0)
#define PG8_WAIT_V(n) asm volatile("s_waitcnt vmcnt(" #n ")" ::: "memory")
#define PG8_WAIT_L(n) asm volatile("s_waitcnt lgkmcnt(" #n ")" ::: "memory")
#define PG8_BAR __builtin_amdgcn_s_barrier()
#define PG8_SCHED __builtin_amdgcn_sched_barrier(0)
    Unit cur, nxt; int ui = 0;
    if (!S.next(0, cur)) return;
    f32x4 acc[2][2][4][2];
#pragma unroll
    for (int a = 0; a < 2; ++a)
#pragma unroll
        for (int b = 0; b < 2; ++b)
#pragma unroll
            for (int m = 0; m < 4; ++m)
#pragma unroll
                for (int n = 0; n < 2; ++n) acc[a][b][m][n] = (f32x4){0.f, 0.f, 0.f, 0.f};
    bf16x8 At[4][2], B0[2][2], B1[2][2];
    const char* A0 = (const char*)g.A; const char* cB = (const char*)g.Bt + (size_t)cur.pn * tstep;
    PG8_LAS int* tb = GA.tokbuf;
    if (tid < 256) { tb[tid] = (int)GA.tok_direct(cur, tid); float rs_, gw_; GA.direct_rg(cur, tid, rs_, gw_); ((PG8_LAS float*)tb)[512 + tid] = rs_; ((PG8_LAS float*)tb)[1024 + tid] = gw_; }
    PG8_WAIT_L(0); PG8_BAR;
#define PG8_OFFS(dst, par, half) do { _Pragma("unroll") for (int _i = 0; _i < 2; ++_i) dst[_i] = (unsigned)tb[(par) * 256 + (half) * HALF + rowA[_i]] * rowbytes + cofA[_i]; } while (0)
    {
        unsigned c0[2], c1[2]; PG8_OFFS(c0, 0, 0); PG8_OFFS(c1, 0, 1);
        PG8_STAGE(PG8_SB(0, 0), cB, voffB); PG8_STAGE(PG8_SB(0, 1), cB + hstep, voffB); PG8_STAGE(PG8_SA(0, 0), A0, c0); PG8_STAGE(PG8_SA(0, 1), A0, c1);
        if (wr == 1) PG8_BAR;
        PG8_WAIT_V(2); PG8_BAR;
        PG8_STAGE(PG8_SB(1, 0), cB + kstep, voffB); PG8_STAGE(PG8_SA(1, 0), A0 + kstep, c0); PG8_STAGE(PG8_SB(1, 1), cB + hstep + kstep, voffB);
        PG8_WAIT_V(6); PG8_BAR;
    }
    int t_issue = 2, t_fix = 6; asm volatile("" : "+s"(t_issue), "+s"(t_fix));
    for (;;) {
        const bool has_next = S.next(ui + 1, nxt);
        const char* nB = has_next ? (const char*)g.Bt + (size_t)nxt.pn * tstep : cB;
        const int pc = ui & 1, pnx = (ui + 1) & 1;
        for (int t = 0; t < nt; t += 2) {
            const bool last = (t == nt - 2);
            const char* a1 = A0 + (size_t)(t + 1) * kstep;
            const char* a2 = last ? A0 : A0 + (size_t)(t + 2) * kstep; const char* b2 = last ? nB : cB + (size_t)(t + 2) * kstep;
            const char* a3 = a2 + kstep; const char* b3 = b2 + kstep;
            if (t == t_fix && has_next && tid < 256) { int e_, base_, cnt_; GA.info(nxt, e_, base_, cnt_); if (base_ + tid >= cnt_) tb[pnx * 256 + tid] = 0; }
            const int ps = (last && has_next) ? pnx : pc;
            unsigned c1[2], s0[2], s1[2]; PG8_OFFS(c1, pc, 1); PG8_OFFS(s0, ps, 0); PG8_OFFS(s1, ps, 1);
            PG8_LDB(B0, 0, 0); PG8_LDB(B1, 0, 1); PG8_SCHED; PG8_LDA(At, 0, 0); PG8_STAGE(PG8_SA(1, 1), a1, c1);
            if (t == t_issue && has_next && wid == 0) GA.issue(nxt, pnx, lane);
            PG8_WAIT_V(8); PG8_WAIT_L(0); PG8_BAR; PG8_MMA(0, 0, At, B0); PG8_MMA(0, 1, At, B1); PG8_BAR; PG8_SCHED;
            PG8_LDA(At, 0, 1); PG8_STAGE(PG8_SB(0, 0), b2, voffB); PG8_STAGE(PG8_SB(0, 1), b2 + hstep, voffB); PG8_STAGE(PG8_SA(0, 0), a2, s0);
            PG8_WAIT_V(8); PG8_WAIT_L(0); PG8_BAR; PG8_MMA(1, 0, At, B0); PG8_MMA(1, 1, At, B1); PG8_BAR; PG8_SCHED;
            PG8_LDB(B0, 1, 0); PG8_LDB(B1, 1, 1); PG8_SCHED; PG8_LDA(At, 1, 0); PG8_STAGE(PG8_SA(0, 1), a2, s1);
            PG8_WAIT_V(8); PG8_WAIT_L(0); PG8_BAR; PG8_MMA(0, 0, At, B0); PG8_MMA(0, 1, At, B1); PG8_BAR; PG8_SCHED;
            PG8_LDA(At, 1, 1); PG8_STAGE(PG8_SB(1, 0), b3, voffB); PG8_STAGE(PG8_SB(1, 1), b3 + hstep, voffB); PG8_STAGE(PG8_SA(1, 0), a3, s0);
            PG8_WAIT_V(8); PG8_WAIT_L(0); PG8_BAR; PG8_MMA(1, 0, At, B0); PG8_MMA(1, 1, At, B1); PG8_BAR; PG8_SCHED;
        }
        if (wr == 0) PG8_BAR;
        E.par = pc; E(acc, cur, wr, wc, fr, fq); S.done(cur);
        if (!has_next) break;
#pragma unroll
        for (int a = 0; a < 2; ++a)
#pragma unroll
            for (int b = 0; b < 2; ++b)
#pragma unroll
                for (int m = 0; m < 4; ++m)
#pragma unroll
                    for (int n = 0; n < 2; ++n) acc[a][b][m][n] = (f32x4){0.f, 0.f, 0.f, 0.f};
        cur = nxt; cB = nB; ++ui;
        if (wr == 1) PG8_BAR;
    }
    PG8_WAIT_V(0);
    PG8_BAR;
#undef PG8_SA
#undef PG8_SB
#undef PG8_STAGE
#undef PG8_LDA
#undef PG8_LDB
#undef PG8_MMA
#undef PG8_WAIT_V
#undef PG8_WAIT_L
#undef PG8_BAR
#undef PG8_SCHED
#undef PG8_OFFS
}
}
struct MoeOrder {
    const LAS int* T; int NT, G, c;
    __device__ bool next(int i, pg8::Unit& u) const {
        const int L = i * G + c; if (L >= T[TBL_NT] * NT) return false;
        const int mt = L / NT; u.pm = mt; u.pn = T[TBL_TE + mt] * NT + (L % NT); return true;
    }
    __device__ __forceinline__ void a_ready(const pg8::Unit&) const {}
    __device__ __forceinline__ void done(const pg8::Unit&) const {}
};
struct EpiSwiGLU {
    static constexpr bool PERM = true, AFTER_DRAIN = false, MIDK = false;
    bf16* HDN; const LAS float* RG; const LAS int* T; mutable int par;
    __device__ __forceinline__ void operator()(const pg8::f32x4 (&acc)[2][2][4][2], const pg8::Unit& u, int wr, int wc, int fr, int fq) const {
        const int col0 = (u.pn & 3) * 128 + wc * 32 + 8 * fq; const int e = u.pn >> 2; const int base = (u.pm - T[TBL_TSTART + e]) * 256, cnt = T[TBL_CNTS + e];
#pragma unroll
        for (int ai = 0; ai < 2; ++ai)
#pragma unroll
            for (int m = 0; m < 4; ++m) { const int rl = ai * 128 + wr * 64 + m * 16 + fr; const int row = u.pm * 256 + rl; const bool ok = (base + rl) < cnt;
                const float rsr = RG[par * 256 + rl], gwr = RG[512 + par * 256 + rl];
                const float rs = ok ? rsr : 0.f, gw = ok ? gwr : 0.f;
                float o[8];
#pragma unroll
                for (int n = 0; n < 2; ++n)
#pragma unroll
                    for (int q = 0; q < 4; ++q) { const float g = acc[ai][0][m][n][q] * rs, up = acc[ai][1][m][n][q] * rs;
                        const float sg = g * __builtin_amdgcn_rcpf(1.0f + __builtin_amdgcn_exp2f(-g * LOG2E)); o[4 * n + q] = sg * up * gw; }
                v4u wv; wv.x = pk2(o[0], o[1]); wv.y = pk2(o[2], o[3]); wv.z = pk2(o[4], o[5]); wv.w = pk2(o[6], o[7]);
                *(v4u*)(HDN + (size_t)row * DEXP + col0) = wv; }
    }
};
struct EpiY {
    static constexpr bool PERM = true, AFTER_DRAIN = false, MIDK = false;
    bf16* Y; const LAS int* T;
    __device__ __forceinline__ void operator()(const pg8::f32x4 (&acc)[2][2][4][2], const pg8::Unit& u, int wr, int wc, int fr, int fq) const {
        const int col0 = (u.pn & 7) * 256 + wc * 32 + 8 * fq; const int e = u.pn >> 3; const int nvalid = T[TBL_CNTS + e] - (u.pm - T[TBL_TSTART + e]) * 256;
#pragma unroll
        for (int ai = 0; ai < 2; ++ai)
#pragma unroll
            for (int m = 0; m < 4; ++m) { const int rl = ai * 128 + wr * 64 + m * 16 + fr; bf16* rowp = Y + (size_t)(u.pm * 256 + rl) * DM + col0;
                if (rl < nvalid) {
#pragma unroll
                    for (int bj = 0; bj < 2; ++bj) { const pg8::f32x4 v0 = acc[ai][bj][m][0], v1 = acc[ai][bj][m][1];
                        v4u w; w.x = pk2(v0[0], v0[1]); w.y = pk2(v0[2], v0[3]); w.z = pk2(v1[0], v1[1]); w.w = pk2(v1[2], v1[3]); *(v4u*)(rowp + bj * 128) = w; } } }
    }
};
struct P8Row { v4u h[4], a[4], b[4]; };
__device__ __forceinline__ void p8_load(P8Row& r, const bf16* HB, const bf16* Y, const LAS int* T, int4 ti, int t, int lane) {
    const size_t s0 = (size_t)T[TBL_TSTART + ti.x] * 256 + ti.y, s1 = (size_t)T[TBL_TSTART + ti.z] * 256 + ti.w;
    const v4u* hp = (const v4u*)(HB + (size_t)t * DM) + lane; const v4u* y0 = (const v4u*)(Y + s0 * DM) + lane; const v4u* y1 = (const v4u*)(Y + s1 * DM) + lane;
#pragma unroll
    for (int j = 0; j < 4; ++j) { r.h[j] = __builtin_nontemporal_load(hp + 64 * j); r.a[j] = __builtin_nontemporal_load(y0 + 64 * j); r.b[j] = __builtin_nontemporal_load(y1 + 64 * j); }
}
__device__ __forceinline__ void p8_combine(Frame& F) {
    const LAS int* T = (const LAS int*)(F.lds + TBL_OFF);
    const int gw = F.vcu * NWAVES + F.wave, NGW = F.G * NWAVES;
    const bf16* Y = (const bf16*)(F.ws + WS_Y); const bf16* HB = (const bf16*)(F.ws + WS_HB); const int* TOKINFO = (const int*)(F.ws + WS_TOKINFO);
    constexpr int RPW = 8;
    int4 ti[RPW];
#pragma unroll
    for (int k = 0; k < RPW; ++k) { const int t = gw + k * NGW; ti[k] = (t < NTOK) ? *(const int4*)(TOKINFO + 4 * t) : make_int4(0, 0, 0, 0); }
    P8Row cur; if (gw < NTOK) p8_load(cur, HB, Y, T, ti[0], gw, F.lane);
#pragma unroll
    for (int k = 0; k < RPW; ++k) {
        const int t = gw + k * NGW; if (t >= NTOK) break;
        P8Row nxt; const int tn = t + NGW;
        if (k + 1 < RPW && tn < NTOK) p8_load(nxt, HB, Y, T, ti[k + 1 < RPW ? k + 1 : k], tn, F.lane);
        f32x4* od = (f32x4*)(F.out + (size_t)t * DM) + 2 * F.lane;
#pragma unroll
        for (int j = 0; j < 4; ++j) {
            const v4u h = cur.h[j], a = cur.a[j], b = cur.b[j]; f32x4 v0, v1;
            v0[0] = bf_lo(h.x) + bf_lo(a.x) + bf_lo(b.x); v0[1] = bf_hi(h.x) + bf_hi(a.x) + bf_hi(b.x); v0[2] = bf_lo(h.y) + bf_lo(a.y) + bf_lo(b.y); v0[3] = bf_hi(h.y) + bf_hi(a.y) + bf_hi(b.y);
            v1[0] = bf_lo(h.z) + bf_lo(a.z) + bf_lo(b.z); v1[1] = bf_hi(h.z) + bf_hi(a.z) + bf_hi(b.z); v1[2] = bf_lo(h.w) + bf_lo(a.w) + bf_lo(b.w); v1[3] = bf_hi(h.w) + bf_hi(a.w) + bf_hi(b.w);
            od[128 * j] = v0; od[128 * j + 1] = v1;
        }
        cur = nxt;
    }
    for (int t = gw + RPW * NGW; t < NTOK; t += NGW) {
        const int4 tj = *(const int4*)(TOKINFO + 4 * t); P8Row r; p8_load(r, HB, Y, T, tj, t, F.lane);
        f32x4* od = (f32x4*)(F.out + (size_t)t * DM) + 2 * F.lane;
#pragma unroll
        for (int j = 0; j < 4; ++j) {
            const v4u h = r.h[j], a = r.a[j], b = r.b[j]; f32x4 v0, v1;
            v0[0] = bf_lo(h.x) + bf_lo(a.x) + bf_lo(b.x); v0[1] = bf_hi(h.x) + bf_hi(a.x) + bf_hi(b.x); v0[2] = bf_lo(h.y) + bf_lo(a.y) + bf_lo(b.y); v0[3] = bf_hi(h.y) + bf_hi(a.y) + bf_hi(b.y);
            v1[0] = bf_lo(h.z) + bf_lo(a.z) + bf_lo(b.z); v1[1] = bf_hi(h.z) + bf_hi(a.z) + bf_hi(b.z); v1[2] = bf_lo(h.w) + bf_lo(a.w) + bf_lo(b.w); v1[3] = bf_hi(h.w) + bf_hi(a.w) + bf_hi(b.w);
            od[128 * j] = v0; od[128 * j + 1] = v1;
        }
    }
}

__global__ void __launch_bounds__(NWAVES * 64, 2) mk_fwd(Args args) {
    extern __shared__ __attribute__((aligned(16))) unsigned char lds[];
    Frame F;
    F.lds = (LAS unsigned char*)lds; F.ws = args.ws; F.ctl = (unsigned*)(args.ws + WS_CTL);
    F.tid = threadIdx.x; F.lane = F.tid & 63; F.wave = __builtin_amdgcn_readfirstlane(F.tid >> 6);
    F.G = gridDim.x; { const int bx = blockIdx.x; F.vcu = (F.G % 8 == 0) ? (bx % 8) * (F.G / 8) + bx / 8 : bx; }
    F.in = args.in; F.out = args.out;
    volatile LAS unsigned* MISC = (volatile LAS unsigned*)(F.lds + MISC_OFF);
    if (F.tid < 64) MISC[F.tid] = 0u;
    __syncthreads();
    const int lo = args.ph_lo, hi = args.ph_hi;
    const bool use_bar = (hi - lo) > 1;
    XcdBarrier bar; bar.bar = F.ctl + CW_BAR + args.li * XCD_BAR_WORDS; bar.x = 0; bar.st = nullptr;
    if (use_bar) bar = xcd_barrier_post(F.ctl + CW_BAR + args.li * XCD_BAR_WORDS, MISC + 8);
#define IN(k) (lo <= (k) && (k) < hi)
#define SEAM(k) do { if (IN(k) && (IN((k) + 1) || ((k) == 4 && IN(6)))) xcd_barrier(bar); } while (0)
    bf16* BIG = (bf16*)(F.ws + WS_BIG);

    if (IN(0)) { p0_prologue(F); SEAM(0); }
    if (IN(1)) {
        pg8::Gemm g{BIG, BIG, 0, 0, DM}; P1Order S{F.G, F.vcu};
        EpiQKV E{(bf16*)(F.ws + WS_QS), (bf16*)(F.ws + WS_KS), (bf16*)(F.ws + WS_QW), (bf16*)(F.ws + WS_KW), (bf16*)(F.ws + WS_VT), F.in[5], F.in[6]};
        pg8::gemm_phase<EpiQKV, P1Order, true, true>(F.lds + RING_OFF, g, S, E);
        {
            const int rounds = (P1_UNITS + F.G - 1) / F.G, first_idle = P1_UNITS - (rounds - 1) * F.G, nidle = F.G - first_idle;
            const int base = NITEMS - TAIL6_ITEMS - tail1_items(F.G);
            if (F.vcu >= first_idle) conv_range(F, base + (F.vcu - first_idle) * NWAVES + F.wave, nidle * NWAVES, NITEMS - TAIL6_ITEMS);
        }
        SEAM(1);
    }
    if (IN(2)) { p2_attention(F); SEAM(2); }
    if (IN(3)) {
        pg8::Gemm g{(const bf16*)(F.ws + WS_MIXED), (const bf16*)(F.ws + WS_WOUT), NTOK, DM, DM}; pg8::StaticOrder S; S.init(NTOK, DM, F.G, (int)blockIdx.x);
        LAS float* RS = (LAS float*)(F.lds + ATT_TBR_OFF);
        {   const float* SSQ = (const float*)(F.ws + WS_SSQ);
            for (int i = 0; i < 4; ++i) { pg8::Unit u; if (!S.next(i, u)) break;
                if (F.tid < 256) { const pg8::f32x4* q = (const pg8::f32x4*)(SSQ + (size_t)(u.pm * 256 + F.tid) * 16); const pg8::f32x4 a = q[0], b = q[1], c = q[2], d = q[3];
                    float sb = 0.f, sw = 0.f;
#pragma unroll
                    for (int q_ = 0; q_ < ATT_WAVES; ++q_) { sb += (q_ < 4 ? a[q_ & 3] : b[q_ & 3]); sw += (q_ < 4 ? c[q_ & 3] : d[q_ & 3]); }
                    RS[(i * 256 + F.tid) * 2] = 1.0f / sqrtf(sb * (1.0f / 1024.0f) + RMS_EPS); RS[(i * 256 + F.tid) * 2 + 1] = 1.0f / sqrtf(sw * (1.0f / 1024.0f) + RMS_EPS);
                    RS[2048 + i * 256 + F.tid] = ((const float*)(F.ws + WS_RINV))[u.pm * 256 + F.tid]; } }
            __syncthreads(); }
        EpiRes E{(bf16*)(F.ws + WS_HB), RS, (const bf16*)(F.ws + WS_BIG), 0};
        pg8::gemm_phase<EpiRes, pg8::StaticOrder, true, true>(F.lds + RING_OFF, g, S, E);
        SEAM(3);
    }
    if (IN(4)) { p4_router(F); SEAM(4); }
    if (IN(5) || IN(6) || IN(7) || IN(8)) build_tables(F);
    if (IN(6)) {
        pg8::Gemm g{(const bf16*)(F.ws + WS_HB), (const bf16*)(F.ws + WS_WGU), 0, 0, DM}; MoeOrder S{(const LAS int*)(F.lds + TBL_OFF), 4, F.G, F.vcu};
        MoeGather GA{(const int*)(F.ws + WS_LIST), (const LAS int*)(F.lds + TBL_OFF), (LAS int*)(F.lds + TOKBUF_OFF), 4, (const float*)(F.ws + WS_RSTDW), (const float*)(F.ws + WS_GATEW)};
        EpiSwiGLU E{(bf16*)(F.ws + WS_HDN), (const LAS float*)(F.lds + TOKBUF_OFF + 2048), (const LAS int*)(F.lds + TBL_OFF), 0};
        pg8::gemm_phase_g<EpiSwiGLU, MoeOrder>(F.lds + RING_OFF, g, S, E, GA);
        {
            const int units = S.T[TBL_NT] * 4, rounds = (units + F.G - 1) / F.G, first_idle = units - (rounds - 1) * F.G, nidle = F.G - first_idle;
            const int base = NITEMS - TAIL6_ITEMS; int mid = base + nidle * NWAVES * TAIL6_PER_WAVE; if (mid > NITEMS) mid = NITEMS;
            if (nidle > 0 && F.vcu >= first_idle) conv_range(F, base + (F.vcu - first_idle) * NWAVES + F.wave, nidle * NWAVES, mid);
            conv_range(F, mid + F.vcu * NWAVES + F.wave, F.G * NWAVES, NITEMS);
        }
        SEAM(6);
    }
    if (IN(7)) {
        pg8::Gemm g{(const bf16*)(F.ws + WS_HDN), (const bf16*)(F.ws + WS_WD), 0, 0, DEXP}; MoeOrder S{(const LAS int*)(F.lds + TBL_OFF), 8, F.G, F.vcu};
        EpiY E{(bf16*)(F.ws + WS_Y), (const LAS int*)(F.lds + TBL_OFF)};
        pg8::gemm_phase<EpiY, MoeOrder, true, true>(F.lds + RING_OFF, g, S, E);
        SEAM(7);
    }
    if (IN(8)) p8_combine(F);
#undef IN
#undef SEAM
}

extern "C" void kernel_launch(void* const* d_in, const int* in_sizes, int n_in, void* d_out, int out_size, void* d_ws, size_t ws_size, hipStream_t stream) {
    static int grid = 0;
    if (grid == 0) {
        if (n_in != 19 || out_size != NTOK * DM || ws_size < WS_END) { fprintf(stderr, "kernel_launch: unexpected shapes (n_in %d out %d ws %zu)\n", n_in, out_size, ws_size); grid = -1; return; }
        int dev = 0, cus = 0, per_cu = 0;
        if (hipGetDevice(&dev) != hipSuccess || hipDeviceGetAttribute(&cus, hipDeviceAttributeMultiprocessorCount, dev) != hipSuccess) { grid = -1; return; }
        if (hipFuncSetAttribute((const void*)mk_fwd, hipFuncAttributeMaxDynamicSharedMemorySize, LDS_BYTES) != hipSuccess) { fprintf(stderr, "kernel_launch: hipFuncSetAttribute failed\n"); grid = -1; return; }
        if (hipOccupancyMaxActiveBlocksPerMultiprocessor(&per_cu, (const void*)mk_fwd, NWAVES * 64, LDS_BYTES) != hipSuccess || per_cu < 1) { fprintf(stderr, "kernel_launch: occupancy query reports %d\n", per_cu); }
        (void)hipGetLastError();
        grid = cus;
    }
    if (grid < 0) return;
    (void)hipMemsetAsync((char*)d_ws + WS_CTL, 0, CTL_ZERO_BYTES, stream);
    Args a{};
    for (int i = 0; i < 19; ++i) a.in[i] = (const float*)d_in[i];
    a.out = (float*)d_out; a.ws = (unsigned char*)d_ws;
#if MK_N_LAUNCHES == 1
    a.ph_lo = 0; a.ph_hi = N_PHASES; a.li = 0;
    hipLaunchKernelGGL(mk_fwd, dim3(grid), dim3(NWAVES * 64), LDS_BYTES, stream, a);
#else
    a.li = 0;
    for (int p = 0; p < N_PHASES; ++p) { a.ph_lo = p; a.ph_hi = p + 1; hipLaunchKernelGGL(mk_fwd, dim3(grid), dim3(NWAVES * 64), LDS_BYTES, stream, a); }
#endif
}
```

```cpp
#include <hip/hip_runtime.h>
#include <cstdio>
#include <cstdint>
namespace pg8 {
#define PG8_LAS __attribute__((address_space(3)))
typedef unsigned short bf16_t;
typedef short bf16x8 __attribute__((ext_vector_type(8)));
typedef float f32x4 __attribute__((ext_vector_type(4)));
typedef unsigned u32x4 __attribute__((ext_vector_type(4)));
constexpr int BM = 256, BK = 64, HALF = 128, HTB = HALF * BK * 2  , STAGE_BYTES = 8 * HTB, NXCD = 8, WGM = 8;

__host__ __device__ __forceinline__ int lds_byte(int r, int c) { const int st = (r >> 4) * 2 + (c >> 5), rr = r & 15, cc = c & 31, ob = rr * 64 + cc * 2; return st * 1024 + (ob ^ (((ob >> 9) & 1) << 5)); }
__host__ __device__ __forceinline__ void stage_rc(int b, int& R, int& C) { const int st = b / 1024, sb = b % 1024, swz = sb ^ (((sb >> 9) & 1) << 5); R = (st >> 1) * 16 + swz / 64; C = (st & 1) * 32 + (swz % 64) / 2; }
__host__ __device__ __forceinline__ int perm32(int rho) { const int n = rho >> 4, i = rho & 15; return 8 * (i >> 2) + 4 * n + (i & 3); }

struct Unit { int pm, pn; };
struct Gemm { const bf16_t* A; const bf16_t* Bt; int M, N, K; };

struct StaticOrder {
    int nM, nN, nwg, G, c;
    __host__ __device__ void init(int M, int N, int G_, int c_) { nM = M / BM; nN = N / BM; nwg = nM * nN; G = G_; c = c_; }
    __host__ __device__ bool next(int i, Unit& u) const {
        const long L = (long)i * G + c; if (L >= nwg) return false;
        int wgid = (int)L; { const int q = nwg / NXCD, r = nwg % NXCD, xcd = wgid % NXCD, off = wgid / NXCD; wgid = (xcd < r ? xcd * (q + 1) : r * (q + 1) + (xcd - r) * q) + off; }
        const int nig = WGM * nN, gid = wgid / nig, fm = gid * WGM, gsz = (nM - fm) < WGM ? (nM - fm) : WGM;
        u.pm = fm + ((wgid % nig) % gsz); u.pn = (wgid % nig) / gsz; return true;
    }
    __device__ __forceinline__ void a_ready(const Unit&) const {}
    __device__ __forceinline__ void done(const Unit&) const {}
};

__device__ __forceinline__ unsigned cvt_pk_bf16(float lo, float hi) { unsigned r; asm volatile("v_cvt_pk_bf16_f32 %0, %1, %2" : "=v"(r) : "v"(lo), "v"(hi)); return r; }
typedef float f32x2 __attribute__((ext_vector_type(2)));
__device__ __forceinline__ f32x2 gelu_pk(f32x2 v) {
    const f32x2 av = __builtin_elementwise_abs(v), d = av * 0.2316418882f + 1.0f;
    f32x2 t; t.x = __builtin_amdgcn_rcpf(d.x); t.y = __builtin_amdgcn_rcpf(d.y);
    f32x2 q = t * 0.5307027145f + (-0.7265760135f); q = q * t + 0.7107068705f; q = q * t + (-0.142248368f); q = q * t + 0.127414796f; q = q * t;
    const f32x2 s = (v * v) * (-0.72134752044f);
    f32x2 e; e.x = __builtin_amdgcn_exp2f(s.x); e.y = __builtin_amdgcn_exp2f(s.y);
    const f32x2 m = v * (q * e), r = v - m;
    f32x2 o; o.x = v.x < 0.f ? m.x : r.x; o.y = v.y < 0.f ? m.y : r.y; return o;
}

template <int ACT  > struct EpiBf16 {
    static constexpr bool PERM = true, AFTER_DRAIN = false; static_assert(ACT == 0 || ACT == 1, "EpiBf16: ACT is 0 (none) or 1 (gelu_pk)");
    bf16_t* O; int ldc; const float* bias; int split_cols; size_t split_stride; float scale0;
    __device__ __forceinline__ void operator()(const f32x4 (&acc)[2][2][4][2], const Unit& u, int wr, int wc, int fr, int fq) const {
        const int row0 = u.pm * BM + wr * 64 + fr; int colt = u.pn * BM; bf16_t* base = O;
        float sc = 1.f; if (split_cols) { const int t = colt / split_cols; base += (size_t)t * split_stride; colt -= t * split_cols; if (t == 0) sc = scale0; }
        const int col0 = colt + wc * 32 + 8 * fq, bcol0 = u.pn * BM + wc * 32 + 8 * fq;
        f32x4 bv[2][2];
#pragma unroll
        for (int bj = 0; bj < 2; ++bj)
#pragma unroll
            for (int n = 0; n < 2; ++n) bv[bj][n] = bias ? *(const f32x4*)(bias + bcol0 + bj * HALF + 4 * n) : (f32x4){0.f, 0.f, 0.f, 0.f};
#pragma unroll
        for (int ai = 0; ai < 2; ++ai)
#pragma unroll
            for (int m = 0; m < 4; ++m) { bf16_t* rowp = base + (size_t)(row0 + ai * HALF + m * 16) * ldc + col0;
#pragma unroll
                for (int bj = 0; bj < 2; ++bj) { f32x4 v0 = acc[ai][bj][m][0] + bv[bj][0], v1 = acc[ai][bj][m][1] + bv[bj][1];
                    if (ACT == 1) { f32x2 a = gelu_pk((f32x2){v0[0], v0[1]}), b = gelu_pk((f32x2){v0[2], v0[3]}), c = gelu_pk((f32x2){v1[0], v1[1]}), d = gelu_pk((f32x2){v1[2], v1[3]});
                        v0 = (f32x4){a.x, a.y, b.x, b.y}; v1 = (f32x4){c.x, c.y, d.x, d.y}; }
                    v0 = v0 * sc; v1 = v1 * sc; u32x4 w; w.x = cvt_pk_bf16(v0[0], v0[1]); w.y = cvt_pk_bf16(v0[2], v0[3]); w.z = cvt_pk_bf16(v1[0], v1[1]); w.w = cvt_pk_bf16(v1[2], v1[3]);
                    *(u32x4*)(rowp + bj * HALF) = w; } }
    }
};

struct PanelStats {
    unsigned* xbuf;
    unsigned* cnt;
    unsigned* tmo;
    int ntn; float eps;
    unsigned code;
    __device__ __forceinline__ bool run(const f32x4 (&v)[2][2][4][2], const Unit& u, int wr, int wc, int fr, int fq, PG8_LAS unsigned char* lds, int wid, int lane) const {
        typedef float f32x2v __attribute__((ext_vector_type(2)));
        PG8_LAS f32x2v* P = (PG8_LAS f32x2v*)lds;
        PG8_LAS f32x2v* S = (PG8_LAS f32x2v*)(lds + 8192);
        PG8_LAS unsigned* flag = (PG8_LAS unsigned*)(lds + 8192 + 2048);
#pragma unroll
        for (int ai = 0; ai < 2; ++ai)
#pragma unroll
            for (int m = 0; m < 4; ++m) {
                float s = 0.f;
#pragma unroll
                for (int bj = 0; bj < 2; ++bj)
#pragma unroll
                    for (int n = 0; n < 2; ++n) { const f32x4 x = v[ai][bj][m][n]; s += (x[0] + x[1]) + (x[2] + x[3]); }
                s += __shfl_xor(s, 16); s += __shfl_xor(s, 32);
                const float mw = s * (1.0f / 64.0f); float q = 0.f;
#pragma unroll
                for (int bj = 0; bj < 2; ++bj)
#pragma unroll
                    for (int n = 0; n < 2; ++n) { const f32x4 d = v[ai][bj][m][n] - mw; q += (d[0] * d[0] + d[1] * d[1]) + (d[2] * d[2] + d[3] * d[3]); }
                q += __shfl_xor(q, 16); q += __shfl_xor(q, 32);
                if (fq == 0) P[(ai * HALF + wr * 64 + m * 16 + fr) * 4 + wc] = (f32x2v){mw, q};
            }
        asm volatile("s_waitcnt lgkmcnt(0)" ::: "memory"); __builtin_amdgcn_s_barrier(); asm volatile("" ::: "memory");
#if defined(BROKEN_EXCHANGE_NO_WAIT)
#warning BROKEN CONTROL BUILD: the row-statistics exchange does not wait; results are wrong by design
        if (blockIdx.x >= 64) { const long long t0_ = clock64(); while (clock64() - t0_ < 60000) __builtin_amdgcn_s_sleep(8); }
#endif
        const int row = wid * 32 + (lane & 31);
        if (lane < 32) {
            const f32x2v a = P[row * 4 + 0], b = P[row * 4 + 1], c = P[row * 4 + 2], d = P[row * 4 + 3];
            const float mt = (a.x + b.x + c.x + d.x) * 0.25f;
            const float da = a.x - mt, db = b.x - mt, dc = c.x - mt, dd = d.x - mt;
            const float m2 = (a.y + b.y) + (c.y + d.y) + 64.0f * ((da * da + db * db) + (dc * dc + dd * dd));
            unsigned long long* slot = (unsigned long long*)xbuf + ((size_t)(u.pm * BM + row) * 4 + u.pn);
            __hip_atomic_store(slot, ((unsigned long long)__float_as_uint(m2) << 32) | __float_as_uint(mt), __ATOMIC_RELAXED, __HIP_MEMORY_SCOPE_AGENT);
        }
        asm volatile("s_waitcnt vmcnt(0)" ::: "memory");
        if (lane == 0) __hip_atomic_fetch_add(cnt + 64 * u.pm, 1u, __ATOMIC_RELAXED, __HIP_MEMORY_SCOPE_AGENT);
        if (wid == 0) {
            bool dead = false; const unsigned long long t0 = __builtin_amdgcn_s_memrealtime(); const unsigned want = 8u * (unsigned)ntn;
            for (;;) {
#if defined(BROKEN_EXCHANGE_NO_WAIT)
                break;
#endif
                if ((unsigned)__builtin_amdgcn_readfirstlane(__hip_atomic_load(cnt + 64 * u.pm, __ATOMIC_RELAXED, __HIP_MEMORY_SCOPE_AGENT)) >= want) break;
                if (__builtin_amdgcn_s_memrealtime() - t0 > 2000000ull) {
                    if (lane == 0) { unsigned expect = 0u; __hip_atomic_compare_exchange_strong(tmo + 1, &expect, code | (unsigned)(u.pm & 0xff), __ATOMIC_RELAXED, __ATOMIC_RELAXED, __HIP_MEMORY_SCOPE_AGENT);
                                     __hip_atomic_store(tmo, 1u, __ATOMIC_RELAXED, __HIP_MEMORY_SCOPE_AGENT); }
                    dead = true; break; }
                __builtin_amdgcn_s_sleep(2);
            }
            __builtin_amdgcn_fence(__ATOMIC_ACQUIRE, "agent");
            if (lane == 0) flag[0] = dead ? 1u : 0u;
        }
        asm volatile("s_waitcnt vmcnt(0) lgkmcnt(0)" ::: "memory"); __builtin_amdgcn_s_barrier(); asm volatile("" ::: "memory");
        const bool bad = flag[0] != 0u;
        if (lane < 32) {
            const unsigned long long* slot = (const unsigned long long*)xbuf + (size_t)(u.pm * BM + row) * 4; float mt[4], m2[4]; float ms = 0.f;
#pragma unroll
            for (int t = 0; t < 4; ++t) { if (t < ntn) { const unsigned long long w = __hip_atomic_load(slot + t, __ATOMIC_RELAXED, __HIP_MEMORY_SCOPE_AGENT); mt[t] = __uint_as_float((unsigned)w); m2[t] = __uint_as_float((unsigned)(w >> 32)); } else { mt[t] = 0.f; m2[t] = 0.f; } ms += mt[t]; }
            const float mean = ms / (float)ntn; float q = 0.f;
#pragma unroll
            for (int t = 0; t < 4; ++t) if (t < ntn) { const float dm = mt[t] - mean; q += m2[t] + 256.0f * dm * dm; }
            S[row] = (f32x2v){mean, 1.0f / sqrtf(q / (256.0f * (float)ntn) + eps)};
        }
        asm volatile("s_waitcnt lgkmcnt(0)" ::: "memory"); __builtin_amdgcn_s_barrier(); asm volatile("" ::: "memory");
        return bad;
    }
};
struct EpiLnRes {
    static constexpr bool PERM = false, AFTER_DRAIN = true;
    const float* base; float* out; int ldc; const float* bias; PanelStats st; unsigned poison;
    __device__ __forceinline__ void fused(f32x4 (&acc)[2][2][4][2], const Unit& u, int wr, int wc, int fr, int fq, PG8_LAS unsigned char* lds, int wid, int lane) const {
        typedef float f32x2v __attribute__((ext_vector_type(2)));
        const PG8_LAS f32x2v* S = (const PG8_LAS f32x2v*)(lds + 8192);
        const int col0 = u.pn * BM + wc * 32 + 4 * fq;
#pragma unroll
        for (int bj = 0; bj < 2; ++bj)
#pragma unroll
            for (int n = 0; n < 2; ++n) { const f32x4 bv = bias ? *(const f32x4*)(bias + col0 + bj * HALF + n * 16) : (f32x4){0.f, 0.f, 0.f, 0.f};
#pragma unroll
                for (int ai = 0; ai < 2; ++ai)
#pragma unroll
                    for (int m = 0; m < 4; ++m) acc[ai][bj][m][n] += bv; }
        f32x4 pre[4][2][2];
#pragma unroll
        for (int m = 0; m < 4; ++m) { const size_t off = (size_t)(u.pm * BM + wr * 64 + m * 16 + fr) * ldc + col0;
#pragma unroll
            for (int bj = 0; bj < 2; ++bj)
#pragma unroll
                for (int n = 0; n < 2; ++n) pre[m][bj][n] = *(const f32x4*)(base + off + bj * HALF + n * 16); }
        const bool bad = st.run(acc, u, wr, wc, fr, fq, lds, wid, lane) || poison != 0u;
        const float qnan = __builtin_nanf("");
#pragma unroll
        for (int ai = 0; ai < 2; ++ai)
#pragma unroll
            for (int m = 0; m < 4; ++m) { const int r = ai * HALF + wr * 64 + m * 16 + fr; const f32x2v sr = S[r]; const size_t off = (size_t)(u.pm * BM + r) * ldc + col0;
#pragma unroll
                for (int bj = 0; bj < 2; ++bj)
#pragma unroll
                    for (int n = 0; n < 2; ++n) { const f32x4 bs = ai == 0 ? pre[m][bj][n] : *(const f32x4*)(base + off + bj * HALF + n * 16); f32x4 o = bs + (acc[ai][bj][m][n] - sr.x) * sr.y;
                        if (bad) o = (f32x4){qnan, qnan, qnan, qnan}; *(f32x4*)(out + off + bj * HALF + n * 16) = o; }
                if (m & 1) asm volatile("" ::: "memory"); }
    }
};
struct EpiLnResLn {
    static constexpr bool PERM = false, AFTER_DRAIN = true;
    const float* base; float* out; bf16_t* xn; int ldc; const float* bias; PanelStats st1, st2; unsigned poison;
    __device__ __forceinline__ void fused(f32x4 (&acc)[2][2][4][2], const Unit& u, int wr, int wc, int fr, int fq, PG8_LAS unsigned char* lds, int wid, int lane) const {
        typedef float f32x2v __attribute__((ext_vector_type(2))); typedef unsigned u32x2v __attribute__((ext_vector_type(2)));
        const PG8_LAS f32x2v* S = (const PG8_LAS f32x2v*)(lds + 8192);
        const int col0 = u.pn * BM + wc * 32 + 4 * fq;
#pragma unroll
        for (int bj = 0; bj < 2; ++bj)
#pragma unroll
            for (int n = 0; n < 2; ++n) { const f32x4 bv = bias ? *(const f32x4*)(bias + col0 + bj * HALF + n * 16) : (f32x4){0.f, 0.f, 0.f, 0.f};
#pragma unroll
                for (int ai = 0; ai < 2; ++ai)
#pragma unroll
                    for (int m = 0; m < 4; ++m) acc[ai][bj][m][n] += bv; }
        bool bad = st1.run(acc, u, wr, wc, fr, fq, lds, wid, lane) || poison != 0u;
        const float qnan = __builtin_nanf("");
#pragma unroll
        for (int ai = 0; ai < 2; ++ai)
#pragma unroll
            for (int m = 0; m < 4; ++m) { const int r = ai * HALF + wr * 64 + m * 16 + fr; const f32x2v sr = S[r]; const size_t off = (size_t)(u.pm * BM + r) * ldc + col0;
#pragma unroll
                for (int bj = 0; bj < 2; ++bj)
#pragma unroll
                    for (int n = 0; n < 2; ++n) { const f32x4 bs = *(const f32x4*)(base + off + bj * HALF + n * 16); acc[ai][bj][m][n] = bs + (acc[ai][bj][m][n] - sr.x) * sr.y; }
                asm volatile("" : "+v"(acc[ai][0][m][0]), "+v"(acc[ai][0][m][1]), "+v"(acc[ai][1][m][0]), "+v"(acc[ai][1][m][1]));
                if (m & 1) asm volatile("" ::: "memory"); }
        const bool bad1 = bad;
        bad = st2.run(acc, u, wr, wc, fr, fq, lds, wid, lane) || bad;
#pragma unroll
        for (int ai = 0; ai < 2; ++ai)
#pragma unroll
            for (int m = 0; m < 4; ++m) { const int r = ai * HALF + wr * 64 + m * 16 + fr; const f32x2v sr = S[r]; const size_t off = (size_t)(u.pm * BM + r) * ldc + col0;
#pragma unroll
                for (int bj = 0; bj < 2; ++bj)
#pragma unroll
                    for (int n = 0; n < 2; ++n) { const f32x4 x1 = acc[ai][bj][m][n]; *(f32x4*)(out + off + bj * HALF + n * 16) = bad1 ? (f32x4){qnan, qnan, qnan, qnan} : x1;
                        const f32x4 o = (x1 - sr.x) * sr.y; u32x2v w; w.x = cvt_pk_bf16(o[0], o[1]); w.y = cvt_pk_bf16(o[2], o[3]);
                        if (bad) { w.x = 0x7fc07fc0u; w.y = 0x7fc07fc0u; } *(u32x2v*)(xn + off + bj * HALF + n * 16) = w; }
                asm volatile("" ::: "memory"); }
    }
};

template <class Epi, class Sched, bool ALIGN_EPI = false, bool SP2 = false>
__device__ __forceinline__ void gemm_phase(PG8_LAS unsigned char* lds, const Gemm g, const Sched& S, const Epi& E) {
    const int tid = threadIdx.x, wid = __builtin_amdgcn_readfirstlane(tid >> 6), lane = tid & 63, wr = wid >> 2, wc = wid & 3, fr = lane & 15, fq = lane >> 4;
    const int K = g.K, nt = K / BK;
    unsigned voffA[2], voffB[2];
#pragma unroll
    for (int i = 0; i < 2; ++i) { int R, C; stage_rc(tid * 16 + i * 8192, R, C); const int Rb = Epi::PERM ? ((R & ~31) + perm32(R & 31)) : R;
        voffA[i] = (unsigned)(R * K + C) * 2u; voffB[i] = (unsigned)(Rb * K + C) * 2u; }
    const size_t kstep = (size_t)(BK * 2);
    const size_t hstep = (size_t)HALF * K * 2;
    const size_t tstep = 2 * hstep;
    const unsigned ldsw = (unsigned)wid * 1024u;
    const int aoff = lds_byte(wr * 64 + fr, fq * 8), boff = lds_byte(wc * 32 + fr, fq * 8);
#define PG8_SA(b, h) (((b) * 2 + (h)) * HTB)
#define PG8_SB(b, h) ((4 + (b) * 2 + (h)) * HTB)
#define PG8_STAGE(bufoff, gbase, voff) do { _Pragma("unroll") for (int _i = 0; _i < 2; ++_i) \
        __builtin_amdgcn_global_load_lds((const unsigned*)((const char*)(gbase) + (voff)[_i]), (PG8_LAS unsigned*)(lds + (bufoff) + ldsw + _i * 8192), 16, 0, 0); } while (0)
#define PG8_LDA(dst, b, h) do { _Pragma("unroll") for (int m = 0; m < 4; ++m) _Pragma("unroll") for (int k = 0; k < 2; ++k) dst[m][k] = *(const PG8_LAS bf16x8*)(lds + PG8_SA(b, h) + aoff + m * 2048 + k * 1024); } while (0)
#define PG8_LDB(dst, b, h) do { _Pragma("unroll") for (int n = 0; n < 2; ++n) _Pragma("unroll") for (int k = 0; k < 2; ++k) dst[n][k] = *(const PG8_LAS bf16x8*)(lds + PG8_SB(b, h) + boff + n * 2048 + k * 1024); } while (0)
#define PG8_MMA(ai, bj, At, Bt) do { __builtin_amdgcn_s_setprio(1); _Pragma("unroll") for (int m = 0; m < 4; ++m) _Pragma("unroll") for (int n = 0; n < 2; ++n) _Pragma("unroll") for (int k = 0; k < 2; ++k) \
        acc[ai][bj][m][n] = __builtin_amdgcn_mfma_f32_16x16x32_bf16(Bt[n][k], At[m][k], acc[ai][bj][m][n], 0, 0, 0); __builtin_amdgcn_s_setprio(0); } while (0)
#define PG8_WAIT_V(n) asm volatile("s_waitcnt vmcnt(" #n ")" ::: "memory")
#define PG8_WAIT_L(n) asm volatile("s_waitcnt lgkmcnt(" #n ")" ::: "memory")
#define PG8_BAR __builtin_amdgcn_s_barrier()
#define PG8_SCHED __builtin_amdgcn_sched_barrier(0)
    Unit cur, nxt; int ui = 0;
    if (!S.next(0, cur)) return;
    f32x4 acc[2][2][4][2];
#pragma unroll
    for (int a = 0; a < 2; ++a)
#pragma unroll
        for (int b = 0; b < 2; ++b)
#pragma unroll
            for (int m = 0; m < 4; ++m)
#pragma unroll
                for (int n = 0; n < 2; ++n) acc[a][b][m][n] = (f32x4){0.f, 0.f, 0.f, 0.f};
    bf16x8 At[4][2], B0[2][2], B1[2][2];
    const char* cA = (const char*)g.A + (size_t)cur.pm * tstep; const char* cB = (const char*)g.Bt + (size_t)cur.pn * tstep;
    S.a_ready(cur);
    if constexpr (SP2) {
        PG8_STAGE(PG8_SB(0, 0), cB, voffB); PG8_STAGE(PG8_SB(0, 1), cB + hstep, voffB); PG8_STAGE(PG8_SA(0, 0), cA, voffA); PG8_STAGE(PG8_SA(0, 1), cA + hstep, voffA);
        if (wr == 1) PG8_BAR;
        PG8_WAIT_V(2); PG8_BAR;
        PG8_STAGE(PG8_SB(1, 0), cB + kstep, voffB); PG8_STAGE(PG8_SA(1, 0), cA + kstep, voffA); PG8_STAGE(PG8_SB(1, 1), cB + hstep + kstep, voffB);
        PG8_WAIT_V(6); PG8_BAR;
    } else {
        PG8_STAGE(PG8_SB(0, 0), cB, voffB); PG8_STAGE(PG8_SA(0, 0), cA, voffA); PG8_STAGE(PG8_SB(0, 1), cB + hstep, voffB); PG8_STAGE(PG8_SA(0, 1), cA + hstep, voffA);
        if (wr == 1) PG8_BAR;
        PG8_WAIT_V(4); PG8_BAR;
        PG8_STAGE(PG8_SB(1, 0), cB + kstep, voffB); PG8_STAGE(PG8_SA(1, 0), cA + kstep, voffA); PG8_STAGE(PG8_SB(1, 1), cB + hstep + kstep, voffB);
        PG8_WAIT_V(6); PG8_BAR;
    }
    int t_mid = nt >> 1; if constexpr (Epi::MIDK) asm volatile("" : "+s"(t_mid));
    for (;;) {
        const bool has_next = S.next(ui + 1, nxt);
        const char* nA = has_next ? (const char*)g.A + (size_t)nxt.pm * tstep : cA; const char* nB = has_next ? (const char*)g.Bt + (size_t)nxt.pn * tstep : cB;
        for (int t = 0; t < nt; t += 2) {
            const bool last = (t == nt - 2);
            if constexpr (Epi::MIDK) { if (t == t_mid) E.midk(acc, cur, wr, fr); }
            const char* a1 = cA + (size_t)(t + 1) * kstep;
            const char* a2 = last ? nA : cA + (size_t)(t + 2) * kstep; const char* b2 = last ? nB : cB + (size_t)(t + 2) * kstep;
            const char* a3 = a2 + kstep; const char* b3 = b2 + kstep;
            if (last && has_next) S.a_ready(nxt);
            if constexpr (SP2) {
            PG8_LDB(B0, 0, 0); PG8_LDB(B1, 0, 1); PG8_SCHED; PG8_LDA(At, 0, 0); PG8_STAGE(PG8_SA(1, 1), a1 + hstep, voffA);
            PG8_WAIT_V(8); PG8_WAIT_L(0); PG8_BAR; PG8_MMA(0, 0, At, B0); PG8_MMA(0, 1, At, B1); PG8_BAR; PG8_SCHED;
            PG8_LDA(At, 0, 1); PG8_STAGE(PG8_SB(0, 0), b2, voffB); PG8_STAGE(PG8_SB(0, 1), b2 + hstep, voffB); PG8_STAGE(PG8_SA(0, 0), a2, voffA);
            PG8_WAIT_V(8); PG8_WAIT_L(0); PG8_BAR; PG8_MMA(1, 0, At, B0); PG8_MMA(1, 1, At, B1); PG8_BAR; PG8_SCHED;
            PG8_LDB(B0, 1, 0); PG8_LDB(B1, 1, 1); PG8_SCHED; PG8_LDA(At, 1, 0); PG8_STAGE(PG8_SA(0, 1), a2 + hstep, voffA);
            PG8_WAIT_V(8); PG8_WAIT_L(0); PG8_BAR; PG8_MMA(0, 0, At, B0); PG8_MMA(0, 1, At, B1); PG8_BAR; PG8_SCHED;
            PG8_LDA(At, 1, 1); PG8_STAGE(PG8_SB(1, 0), b3, voffB); PG8_STAGE(PG8_SB(1, 1), b3 + hstep, voffB); PG8_STAGE(PG8_SA(1, 0), a3, voffA);
            PG8_WAIT_V(8); PG8_WAIT_L(0); PG8_BAR; PG8_MMA(1, 0, At, B0); PG8_MMA(1, 1, At, B1); PG8_BAR; PG8_SCHED;
            } else {
            PG8_LDB(B0, 0, 0); PG8_SCHED; PG8_LDA(At, 0, 0); PG8_STAGE(PG8_SA(1, 1), a1 + hstep, voffA);
            PG8_WAIT_L(8); PG8_BAR; PG8_WAIT_L(0); PG8_MMA(0, 0, At, B0); PG8_BAR; PG8_SCHED;
            PG8_LDB(B1, 0, 1); PG8_STAGE(PG8_SB(0, 0), b2, voffB);
            PG8_BAR; PG8_WAIT_L(0); PG8_MMA(0, 1, At, B1); PG8_BAR;
            PG8_LDA(At, 0, 1); PG8_STAGE(PG8_SA(0, 0), a2, voffA);
            PG8_BAR; PG8_WAIT_L(0); PG8_MMA(1, 0, At, B0); PG8_BAR; PG8_SCHED;
            PG8_STAGE(PG8_SB(0, 1), b2 + hstep, voffB);
            PG8_WAIT_V(6); PG8_BAR; PG8_MMA(1, 1, At, B1); PG8_BAR;
            PG8_LDB(B0, 1, 0); PG8_SCHED; PG8_LDA(At, 1, 0); PG8_STAGE(PG8_SA(0, 1), a2 + hstep, voffA);
            PG8_WAIT_L(8); PG8_BAR; PG8_WAIT_L(0); PG8_MMA(0, 0, At, B0); PG8_BAR; PG8_SCHED;
            PG8_LDB(B1, 1, 1); PG8_STAGE(PG8_SB(1, 0), b3, voffB);
            PG8_BAR; PG8_WAIT_L(0); PG8_MMA(0, 1, At, B1); PG8_BAR;
            PG8_LDA(At, 1, 1); PG8_STAGE(PG8_SA(1, 0), a3, voffA);
            PG8_BAR; PG8_WAIT_L(0); PG8_MMA(1, 0, At, B0); PG8_BAR; PG8_SCHED;
            PG8_STAGE(PG8_SB(1, 1), b3 + hstep, voffB);
            PG8_WAIT_V(6); PG8_BAR; PG8_MMA(1, 1, At, B1); PG8_BAR;
            }
        }
        if constexpr (ALIGN_EPI) { if (wr == 0) PG8_BAR; }
        if constexpr (!Epi::AFTER_DRAIN) { E(acc, cur, wr, wc, fr, fq); S.done(cur); }
        if (!has_next) break;
#pragma unroll
        for (int a = 0; a < 2; ++a)
#pragma unroll
            for (int b = 0; b < 2; ++b)
#pragma unroll
                for (int m = 0; m < 4; ++m)
#pragma unroll
                    for (int n = 0; n < 2; ++n) acc[a][b][m][n] = (f32x4){0.f, 0.f, 0.f, 0.f};
        cur = nxt; cA = nA; cB = nB; ++ui;
        if constexpr (ALIGN_EPI) { if (wr == 1) PG8_BAR; }
    }
    PG8_WAIT_V(0);
    if constexpr (!ALIGN_EPI) { if (wr == 0) PG8_BAR; }
    PG8_BAR;
    if constexpr (Epi::AFTER_DRAIN) { E.fused(acc, cur, wr, wc, fr, fq, lds, wid, lane); S.done(cur); }
#undef PG8_SA
#undef PG8_SB
#undef PG8_STAGE
#undef PG8_LDA
#undef PG8_LDB
#undef PG8_MMA
#undef PG8_WAIT_V
#undef PG8_WAIT_L
#undef PG8_BAR
#undef PG8_SCHED
}
}


#ifndef MK_N_LAUNCHES
#define MK_N_LAUNCHES 1
#endif
constexpr int N_PHASES = 9;
constexpr int NWAVES = 8;

constexpr int DM = 2048, BATCH = 4, SEQ = 4096, NTOK = BATCH * SEQ, NMETA = 16;
constexpr int MPAD = 16640, NTILE_X = MPAD / 256;
constexpr int N_QK = 3328, NT_QK = N_QK / 256;
constexpr int N_V = 1280, NT_V = N_V / 256;
constexpr int NT_W = NT_QK + NT_V;
constexpr int P1_UNITS_A = NTILE_X * NT_QK, P1_UNITS = P1_UNITS_A + NT_V * NTILE_X;
constexpr int NEXP = 64, DEXP = 512, MAXTILES = 192, SPAD = MAXTILES * 256;
constexpr float RMS_EPS = 1e-6f;
constexpr float LOG2E = 1.4426950408889634f;
constexpr float C2 = 0.125f * LOG2E;
constexpr float SB_EXIT = -150.0f;

constexpr size_t MiB = 1u << 20;
constexpr size_t WS_CTL = 0, CTL_ZERO_BYTES = 128 * 1024;
constexpr size_t WS_BIG = 1 * MiB;
constexpr size_t WS_QS = 84 * MiB, WS_KS = WS_QS + (size_t)MPAD * 1024 * 2, WS_QW = WS_KS + (size_t)MPAD * 1024 * 2, WS_KW = WS_QW + (size_t)MPAD * 1024 * 2;
constexpr size_t WS_VT = 190 * MiB;
constexpr size_t WS_MIXED = 231 * MiB, WS_HB = 295 * MiB;
constexpr size_t WS_Y = 1 * MiB;
constexpr size_t WS_PROJ = 359 * MiB;
constexpr size_t WS_HDN = 423 * MiB;
constexpr size_t WS_WOUT = 471 * MiB, WS_WR = 479 * MiB;
constexpr size_t WS_WGU = 480 * MiB, WS_WD = 736 * MiB;
constexpr size_t WS_LIST = 864 * MiB, WS_GATEW = 868 * MiB, WS_TOKINFO = 872 * MiB, WS_RSTD = 873 * MiB, WS_RSTDW = 874 * MiB;
constexpr size_t WS_RINV = 877 * MiB;
constexpr size_t WS_SSQ = 878 * MiB;
constexpr size_t WS_END = 880 * MiB;
static_assert(WS_RSTDW + (size_t)NEXP * NTOK * 4 <= WS_END, "ws map 4");
static_assert(WS_KW + (size_t)MPAD * 256 * 2 <= WS_VT && WS_VT + (size_t)N_V * MPAD * 2 <= WS_MIXED , "ws map 1");
static_assert(WS_Y + (size_t)SPAD * 2048 * 2 <= WS_MIXED && WS_HDN + (size_t)SPAD * 512 * 2 <= WS_WOUT && WS_HB + (size_t)NTOK * 2048 * 2 <= WS_HDN, "ws map 2");
static_assert(WS_BIG + (size_t)(NTILE_X + NT_W) * 256 * 2048 * 2 <= WS_QS, "ws map 3");
constexpr int CW_TMO = 0, CW_BAR = 4096, CW_CNT = 16384;

constexpr int RING_OFF = 0, RING_BYTES = 131072;
constexpr int MISC_OFF = RING_BYTES;
constexpr int TBL_OFF = MISC_OFF + 256;
constexpr int TBL_TSTART = 0, TBL_NT = 65, TBL_TE = 66, TBL_CNTS = 66 + MAXTILES, TBL_WORDS = 66 + MAXTILES + 64;
constexpr int TOKBUF_OFF = MISC_OFF + 4096;
constexpr int ATT_TBR_OFF = TOKBUF_OFF + 6144;
constexpr int LDS_BYTES = 163840;
static_assert(TBL_OFF + TBL_WORDS * 4 <= TOKBUF_OFF && TOKBUF_OFF + 6144 <= LDS_BYTES && ATT_TBR_OFF + 16 * 192 * 4 <= LDS_BYTES, "LDS map");

#define LAS __attribute__((address_space(3)))
typedef unsigned short bf16;
typedef unsigned v4u __attribute__((ext_vector_type(4)));
typedef unsigned v2u __attribute__((ext_vector_type(2)));
typedef float f32x4 __attribute__((ext_vector_type(4)));
typedef float f32x16 __attribute__((ext_vector_type(16)));
typedef short bf16x8 __attribute__((ext_vector_type(8)));
typedef _Float16 f16x8 __attribute__((ext_vector_type(8)));
typedef _Float16 f16x2 __attribute__((ext_vector_type(2)));
typedef float f32x2 __attribute__((ext_vector_type(2)));
typedef __bf16 bf16x2_t __attribute__((ext_vector_type(2)));
#define LDS_WAIT() asm volatile("s_waitcnt lgkmcnt(0)" ::: "memory")
#define VM_WAIT() asm volatile("s_waitcnt vmcnt(0)" ::: "memory")
__device__ __forceinline__ unsigned pk2(float lo, float hi) { f32x2 v = {lo, hi}; bf16x2_t b = __builtin_convertvector(v, bf16x2_t); return __builtin_bit_cast(unsigned, b); }
__device__ __forceinline__ float bf_lo(unsigned u) { return __uint_as_float(u << 16); }
__device__ __forceinline__ float bf_hi(unsigned u) { return __uint_as_float(u & 0xffff0000u); }
__device__ __forceinline__ float wave_sum(float v) {
#pragma unroll
    for (int o = 1; o < 64; o <<= 1) v += __shfl_xor(v, o);
    return v;
}
__device__ __forceinline__ int crow(int reg, int h) { return (reg & 3) + 8 * (reg >> 2) + 4 * h; }

#define XB_TMO      128
#define XB_XCNT(j)  (256  + 64 * (j))
#define XB_XSUB(j)  (1280 + 64 * (j))
#define XB_XGEN(j)  (2304 + 64 * (j))
#define XB_TOP      3328
#define XB_TOPGEN   3392
#define XCD_BAR_WORDS 3456
#define XB_SPIN_CAP (1u << 18)

__device__ __forceinline__ unsigned xb_ld(unsigned* p)              { return __hip_atomic_load(p, __ATOMIC_RELAXED, __HIP_MEMORY_SCOPE_AGENT); }
__device__ __forceinline__ unsigned xb_add(unsigned* p, unsigned v) { return __hip_atomic_fetch_add(p, v, __ATOMIC_RELAXED, __HIP_MEMORY_SCOPE_AGENT); }
__device__ __forceinline__ unsigned xb_xcc_id() { return (unsigned)__builtin_amdgcn_s_getreg((3 << 11) | 20) & 0xFu; }
#define XB_SPIN(cond, bar) do { unsigned _sp = 0; while (cond) { __builtin_amdgcn_s_sleep(1); \
    if ((++_sp & 255u) == 0u) { if (xb_ld(&(bar)[XB_TMO])) break; if (_sp > XB_SPIN_CAP) { atomicAdd(&(bar)[XB_TMO], 1u); break; } } } } while (0)

struct XcdBarrier {
    unsigned* bar; unsigned x;
    volatile LAS unsigned* st;
};

__device__ __forceinline__ XcdBarrier xcd_barrier_post(unsigned* bar, volatile LAS unsigned* st) {
    XcdBarrier b; b.bar = bar; b.x = xb_xcc_id(); b.st = st;
    if (threadIdx.x == 0) (void)xb_add(&bar[XB_XCNT(b.x)], 1u);
    return b;
}
__device__ __forceinline__ void xcd_barrier_complete(unsigned* bar, unsigned x, unsigned& nloc, unsigned& nx) {
    const unsigned G = gridDim.x * gridDim.y * gridDim.z;
    unsigned sum, cnt, mine, sp = 0u;
    for (;;) {
        sum = 0u; cnt = 0u; mine = 0u;
#pragma unroll
        for (unsigned j = 0; j < 16; ++j) { const unsigned c = xb_ld(&bar[XB_XCNT(j)]); sum += c; cnt += (c > 0u) ? 1u : 0u; mine = (j == x) ? c : mine; }
        if (sum == G) break;
        __builtin_amdgcn_s_sleep(1);
        if ((++sp & 255u) == 0u) { if (xb_ld(&bar[XB_TMO])) break; if (sp > XB_SPIN_CAP) { atomicAdd(&bar[XB_TMO], 1u); break; } }
    }
    nloc = mine > 0u ? mine : 1u; nx = cnt > 0u ? cnt : 1u;
}

__device__ __forceinline__ void xcd_barrier(const XcdBarrier& b) {
    asm volatile("s_waitcnt vmcnt(0)" ::: "memory");
    __syncthreads();
    if (threadIdx.x == 0) {
        unsigned* bar = b.bar;
        __builtin_amdgcn_s_waitcnt(0);
        unsigned nloc = b.st[0], nx = b.st[1];
        if (nloc == 0u) { xcd_barrier_complete(bar, b.x, nloc, nx); b.st[0] = nloc; b.st[1] = nx; }
        const unsigned old = xb_add(&bar[XB_XSUB(b.x)], 1u);
        const unsigned gen = old / nloc;
        if (old + 1u == (gen + 1u) * nloc) {
            __builtin_amdgcn_fence(__ATOMIC_RELEASE, "agent");
            asm volatile("s_waitcnt vmcnt(0)" ::: "memory");
            const unsigned og = xb_add(&bar[XB_TOP], 1u);
            const unsigned tg = og / nx;
            if (og + 1u == (tg + 1u) * nx) xb_add(&bar[XB_TOPGEN], 1u);
            else XB_SPIN(xb_ld(&bar[XB_TOPGEN]) == tg, bar);
            __builtin_amdgcn_fence(__ATOMIC_ACQUIRE, "agent");
            xb_add(&bar[XB_XGEN(b.x)], 1u);
            asm volatile("s_waitcnt vmcnt(0)" ::: "memory");
        } else {
            XB_SPIN(xb_ld(&bar[XB_XGEN(b.x)]) == gen, bar);
            __builtin_amdgcn_fence(__ATOMIC_ACQUIRE, "agent");
            asm volatile("s_waitcnt vmcnt(0)" ::: "memory");
        }
    }
    __syncthreads();
}


struct Args { const float* in[19]; float* out; unsigned char* ws; int ph_lo, ph_hi, li, pad; };
struct Frame {
    LAS unsigned char* lds; unsigned* ctl; unsigned char* ws;
    int tid, lane, wave, vcu, G;
    const float* const* in; float* out;
};

struct TrItem { f32x4 v[16]; f32x4 g[4]; };
__device__ __forceinline__ void tr_load(TrItem& t, const float* srcp, int ldsrc, const float* gp) {
#pragma unroll
    for (int i = 0; i < 16; ++i) t.v[i] = __builtin_nontemporal_load((const f32x4*)(srcp + (size_t)i * ldsrc));
    if (gp) {
#pragma unroll
        for (int i = 0; i < 4; ++i) t.g[i] = *(const f32x4*)(gp + 4 * i);
    } else {
#pragma unroll
        for (int i = 0; i < 4; ++i) t.g[i] = (f32x4){1.f, 1.f, 1.f, 1.f};
    }
}
__device__ __forceinline__ void tr_store(const TrItem& t, bf16* dstp, int ldd) {
#pragma unroll
    for (int j = 0; j < 4; ++j)
#pragma unroll
        for (int c = 0; c < 2; ++c) {
            v4u o;
            o.x = pk2(t.v[8 * c + 0][j] * t.g[2 * c][0], t.v[8 * c + 1][j] * t.g[2 * c][1]); o.y = pk2(t.v[8 * c + 2][j] * t.g[2 * c][2], t.v[8 * c + 3][j] * t.g[2 * c][3]);
            o.z = pk2(t.v[8 * c + 4][j] * t.g[2 * c + 1][0], t.v[8 * c + 5][j] * t.g[2 * c + 1][1]); o.w = pk2(t.v[8 * c + 6][j] * t.g[2 * c + 1][2], t.v[8 * c + 7][j] * t.g[2 * c + 1][3]);
            *(v4u*)(dstp + (size_t)j * ldd + 8 * c) = o;
        }
}
__device__ __forceinline__ int win_src_col(int P) {
    if (P < 2048) return P;
    if (P < 3328) { const int p = P - 2048, t = p >> 8, pp = p & 255, bj = pp >> 7, wc = (pp & 127) >> 5, i = pp & 31; return (t < 4 ? 3072 + t * 256 : 4096) + 64 * wc + 32 * bj + i; }
    if (P < 4352) return 2048 + (P - 3328);
    return P;
}
__device__ __forceinline__ float rms_row_to_bf16(const float* xrow, bf16* orow, int lane) {
    const f32x4* xr = (const f32x4*)xrow + lane;
    f32x4 v[8]; float s = 0.f;
#pragma unroll
    for (int j = 0; j < 8; ++j) { v[j] = xr[64 * j]; s += (v[j].x * v[j].x + v[j].y * v[j].y) + (v[j].z * v[j].z + v[j].w * v[j].w); }
    const float rinv = sqrtf(wave_sum(s) * (1.f / DM) + RMS_EPS), rstd = 1.0f / rinv;
    v2u* o8 = (v2u*)orow + lane;
#pragma unroll
    for (int j = 0; j < 8; ++j) { v2u w; w.x = pk2(v[j].x * rstd, v[j].y * rstd); w.y = pk2(v[j].z * rstd, v[j].w * rstd); o8[64 * j] = w; }
    return rinv;
}
constexpr int I_IN = 32 * 72, I_OUT = 32 * 32, I_GU = NEXP * 32 * 16, I_D = NEXP * 8 * 32;
constexpr int NITEMS = I_IN + I_OUT + I_GU + I_D;
constexpr int TAIL1_PER_WAVE = 8, TAIL6_PER_WAVE = 9, TAIL6_ITEMS = 9216;
#ifndef P2_ITEMS_DEF
#define P2_ITEMS_DEF 32896
#endif
constexpr int P2_ITEMS = P2_ITEMS_DEF;
#ifndef ATT_WAVES_DEF
#define ATT_WAVES_DEF 4
#endif
constexpr int ATT_WAVES = ATT_WAVES_DEF;
__device__ __forceinline__ void conv_range(Frame& F, int it0, int step, int end) {
    bf16* WIN = (bf16*)(F.ws + WS_BIG) + (size_t)MPAD * DM;
    const float* ln_mix = F.in[3]; const float* w_in = F.in[4];
    const float* on_sb = F.in[8]; const float* on_sw = F.in[9]; const float* w_out = F.in[10]; const float* ln_ffn = F.in[11];
    const float* w_gate = F.in[16]; const float* w_up = F.in[17]; const float* w_down = F.in[18];
    bf16* WOUT = (bf16*)(F.ws + WS_WOUT); bf16* WGU = (bf16*)(F.ws + WS_WGU); bf16* WD = (bf16*)(F.ws + WS_WD);
    const int kr = F.lane >> 4, nq = F.lane & 15;
#define P0_ITEM(it, SRCP, LDS_, GP, DSTP, LDD) do { int r_ = (it); \
        if (r_ < I_IN) { const int kb = r_ / 72, nb = r_ % 72, k0 = 64 * kb + 16 * kr; SRCP = w_in + (size_t)k0 * 4608 + win_src_col(64 * nb + 4 * nq); LDS_ = 4608; GP = ln_mix + k0; DSTP = WIN + (size_t)(64 * nb + 4 * nq) * DM + k0; LDD = DM; } \
        else if ((r_ -= I_IN) < I_OUT) { const int kb = r_ >> 5, nb = r_ & 31, k0 = 64 * kb + 16 * kr; SRCP = w_out + (size_t)k0 * DM + 64 * nb + 4 * nq; LDS_ = DM; GP = (k0 < 1024 ? on_sb + k0 : on_sw + (k0 - 1024)); DSTP = WOUT + (size_t)(64 * nb + 4 * nq) * DM + k0; LDD = DM; } \
        else if ((r_ -= I_OUT) < I_GU) { const int e = r_ >> 9, q = r_ & 511, kb = q >> 4, nb = q & 15, k0 = 64 * kb + 16 * kr, nt = nb >> 2, bj = (nb >> 1) & 1, j0 = (nb & 1) * 64; \
            SRCP = (bj ? w_up : w_gate) + (size_t)e * DM * DEXP + (size_t)k0 * DEXP + nt * 128 + j0 + 4 * nq; LDS_ = DEXP; GP = ln_ffn + k0; DSTP = WGU + ((size_t)e * 1024 + 64 * nb + 4 * nq) * DM + k0; LDD = DM; } \
        else { r_ -= I_GU; const int e = r_ >> 8, q = r_ & 255, kb = q >> 5, nb = q & 31, k0 = 64 * kb + 16 * kr; \
            SRCP = w_down + (size_t)e * DEXP * DM + (size_t)k0 * DM + 64 * nb + 4 * nq; LDS_ = DM; GP = nullptr; DSTP = WD + ((size_t)e * 2048 + 64 * nb + 4 * nq) * DEXP + k0; LDD = DEXP; } } while (0)
    {
        TrItem cur; const float* sp; const float* gp; bf16* dp; int lds_, ldd; bf16* dpn; int lddn;
        int it = it0;
        if (it < end) { P0_ITEM(it, sp, lds_, gp, dp, ldd); tr_load(cur, sp, lds_, gp); }
        while (it < end) {
            const int itn = it + step; TrItem nxt;
            if (itn < end) { P0_ITEM(itn, sp, lds_, gp, dpn, lddn); tr_load(nxt, sp, lds_, gp); }
            tr_store(cur, dp, ldd);
            if (itn < end) { cur = nxt; dp = dpn; ldd = lddn; }
            it = itn;
        }
    }
#undef P0_ITEM
}
__device__ __forceinline__ void conv_range3(Frame& F, int it0, int step, int end) {
    bf16* WIN = (bf16*)(F.ws + WS_BIG) + (size_t)MPAD * DM;
    const float* ln_mix = F.in[3]; const float* w_in = F.in[4];
    const float* on_sb = F.in[8]; const float* on_sw = F.in[9]; const float* w_out = F.in[10]; const float* ln_ffn = F.in[11];
    const float* w_gate = F.in[16]; const float* w_up = F.in[17]; const float* w_down = F.in[18];
    bf16* WOUT = (bf16*)(F.ws + WS_WOUT); bf16* WGU = (bf16*)(F.ws + WS_WGU); bf16* WD = (bf16*)(F.ws + WS_WD);
    const int kr = F.lane >> 4, nq = F.lane & 15;
#define P0_ITEM(it, SRCP, LDS_, GP, DSTP, LDD) do { int r_ = (it); \
        if (r_ < I_IN) { const int kb = r_ / 72, nb = r_ % 72, k0 = 64 * kb + 16 * kr; SRCP = w_in + (size_t)k0 * 4608 + win_src_col(64 * nb + 4 * nq); LDS_ = 4608; GP = ln_mix + k0; DSTP = WIN + (size_t)(64 * nb + 4 * nq) * DM + k0; LDD = DM; } \
        else if ((r_ -= I_IN) < I_OUT) { const int kb = r_ >> 5, nb = r_ & 31, k0 = 64 * kb + 16 * kr; SRCP = w_out + (size_t)k0 * DM + 64 * nb + 4 * nq; LDS_ = DM; GP = (k0 < 1024 ? on_sb + k0 : on_sw + (k0 - 1024)); DSTP = WOUT + (size_t)(64 * nb + 4 * nq) * DM + k0; LDD = DM; } \
        else if ((r_ -= I_OUT) < I_GU) { const int e = r_ >> 9, q = r_ & 511, kb = q >> 4, nb = q & 15, k0 = 64 * kb + 16 * kr, nt = nb >> 2, bj = (nb >> 1) & 1, j0 = (nb & 1) * 64; \
            SRCP = (bj ? w_up : w_gate) + (size_t)e * DM * DEXP + (size_t)k0 * DEXP + nt * 128 + j0 + 4 * nq; LDS_ = DEXP; GP = ln_ffn + k0; DSTP = WGU + ((size_t)e * 1024 + 64 * nb + 4 * nq) * DM + k0; LDD = DM; } \
        else { r_ -= I_GU; const int e = r_ >> 8, q = r_ & 255, kb = q >> 5, nb = q & 31, k0 = 64 * kb + 16 * kr; \
            SRCP = w_down + (size_t)e * DEXP * DM + (size_t)k0 * DM + 64 * nb + 4 * nq; LDS_ = DM; GP = nullptr; DSTP = WD + ((size_t)e * 2048 + 64 * nb + 4 * nq) * DEXP + k0; LDD = DEXP; } } while (0)
    struct V16 { f32x4 v[16]; };
#define C3_LOAD(B, it) do { if ((it) < end) { const float* sp_; const float* gp_; bf16* dp_; int ls_, ld_; P0_ITEM((it), sp_, ls_, gp_, dp_, ld_); (void)gp_; (void)dp_; (void)ld_; \
        _Pragma("unroll") for (int i_ = 0; i_ < 16; ++i_) B.v[i_] = __builtin_nontemporal_load((const f32x4*)(sp_ + (size_t)i_ * ls_)); } } while (0)
#define C3_STORE(B, it) do { if ((it) < end) { const float* sp_; const float* gp_; bf16* dp_; int ls_, ld_; P0_ITEM((it), sp_, ls_, gp_, dp_, ld_); (void)sp_; (void)ls_; \
        f32x4 g_[4]; _Pragma("unroll") for (int i_ = 0; i_ < 4; ++i_) g_[i_] = gp_ ? *(const f32x4*)(gp_ + 4 * i_) : (f32x4){1.f, 1.f, 1.f, 1.f}; \
        _Pragma("unroll") for (int j_ = 0; j_ < 4; ++j_) _Pragma("unroll") for (int c_ = 0; c_ < 2; ++c_) { v4u o_; \
            o_.x = pk2(B.v[8 * c_ + 0][j_] * g_[2 * c_][0], B.v[8 * c_ + 1][j_] * g_[2 * c_][1]); o_.y = pk2(B.v[8 * c_ + 2][j_] * g_[2 * c_][2], B.v[8 * c_ + 3][j_] * g_[2 * c_][3]); \
            o_.z = pk2(B.v[8 * c_ + 4][j_] * g_[2 * c_ + 1][0], B.v[8 * c_ + 5][j_] * g_[2 * c_ + 1][1]); o_.w = pk2(B.v[8 * c_ + 6][j_] * g_[2 * c_ + 1][2], B.v[8 * c_ + 7][j_] * g_[2 * c_ + 1][3]); \
            *(v4u*)(dp_ + (size_t)j_ * ld_ + 8 * c_) = o_; } } } while (0)
    {
        V16 A, B, C; int it = it0;
        C3_LOAD(A, it); C3_LOAD(B, it + step);
        while (it < end) {
            C3_LOAD(C, it + 2 * step); C3_STORE(A, it);
            C3_LOAD(A, it + 3 * step); C3_STORE(B, it + step);
            C3_LOAD(B, it + 4 * step); C3_STORE(C, it + 2 * step);
            it += 3 * step;
        }
    }
#undef C3_LOAD
#undef C3_STORE
#undef P0_ITEM
}
__device__ __forceinline__ int tail1_items(int G) { const int rounds = (P1_UNITS + G - 1) / G, nidle = rounds * G - P1_UNITS; return nidle * NWAVES * TAIL1_PER_WAVE; }
__device__ __forceinline__ void p0_prologue(Frame& F) {
    const int gw = F.vcu * NWAVES + F.wave, NGW = F.G * NWAVES;
    if (blockIdx.x == 0 && F.tid < NEXP) __hip_atomic_store(F.ctl + CW_CNT + 16 * F.tid, 0u, __ATOMIC_RELAXED, __HIP_MEMORY_SCOPE_AGENT);
    bf16* BIG = (bf16*)(F.ws + WS_BIG);
    bf16* WIN = BIG + (size_t)MPAD * DM;
    const float* x = F.in[0]; const float* meta = F.in[1]; const float* ln_mix = F.in[3]; const float* w_in = F.in[4];
    const float* on_sb = F.in[8]; const float* on_sw = F.in[9]; const float* w_out = F.in[10]; const float* ln_ffn = F.in[11];
    const float* w_rg = F.in[12]; const float* w_re = F.in[14]; const float* w_gate = F.in[16]; const float* w_up = F.in[17]; const float* w_down = F.in[18];
    for (int m = gw; m < MPAD; m += NGW) {
        bf16* orow = BIG + (size_t)m * DM;
        if (m < NTOK) { const float ri = rms_row_to_bf16(x + (size_t)m * DM, orow, F.lane); if (F.lane == 0) ((float*)(F.ws + WS_RINV))[m] = ri; }
        else if (m < NTOK + NMETA) (void)rms_row_to_bf16(meta + (size_t)(m - NTOK) * DM, orow, F.lane);
        else { v4u z = {0u, 0u, 0u, 0u}; v4u* o = (v4u*)orow + F.lane;
#pragma unroll
            for (int j = 0; j < 4; ++j) o[64 * j] = z; }
    }
    conv_range(F, gw, NGW, NITEMS - TAIL6_ITEMS - tail1_items(F.G) - P2_ITEMS);
    bf16* WRH = (bf16*)(F.ws + WS_WR); bf16* WRL = WRH + 96 * DM;
    for (int idx = (F.vcu * NWAVES * 64 + F.tid); idx < 96 * DM; idx += F.G * NWAVES * 64) {
        const int c = idx / DM, k = idx % DM;
        float v = 0.f; if (c < 8) v = w_rg[k * 8 + c]; else if (c < 72) v = w_re[k * 64 + (c - 8)];
        v *= ln_ffn[k];
        const unsigned hi = pk2(v, 0.f) & 0xffffu; const float lo = v - __uint_as_float(hi << 16);
        const int fidx = ((((k >> 4) * 3 + (c >> 5)) * 64 + (((k >> 3) & 1) * 32 + (c & 31))) << 3) + (k & 7);
        WRH[fidx] = (bf16)hi; WRL[fidx] = (bf16)(pk2(lo, 0.f) & 0xffffu);
    }
}

struct P1Order {
    int G, c;
    __device__ bool next(int i, pg8::Unit& u) const {
        const int L = i * G + c; if (L >= P1_UNITS) return false;
        if (L < P1_UNITS_A) { u.pm = L / NT_QK; u.pn = NTILE_X + (L % NT_QK); }
        else { const int l = L - P1_UNITS_A; u.pm = NTILE_X + NT_QK + l / NTILE_X; u.pn = l % NTILE_X; }
        return true;
    }
    __device__ __forceinline__ void a_ready(const pg8::Unit&) const {}
    __device__ __forceinline__ void done(const pg8::Unit&) const {}
};
struct EpiQKV {
    static constexpr bool PERM = true, AFTER_DRAIN = false, MIDK = false;
    bf16 *QS, *KS, *QW, *KW, *VT; const float *q_norm, *k_norm;
    __device__ __forceinline__ void operator()(const pg8::f32x4 (&acc)[2][2][4][2], const pg8::Unit& u, int wr, int wc, int fr, int fq) const {
        using pg8::HALF;
        if (u.pm < NTILE_X) {
            const int t = u.pn - NTILE_X; const int row0 = u.pm * 256 + wr * 64 + fr;
            if (t < 8) {
                bf16* base = (t < 4) ? QS : KS; const float sc = (t < 4) ? C2 : 1.0f; const int col0 = (t & 3) * 256 + wc * 32 + 8 * fq;
#pragma unroll
                for (int ai = 0; ai < 2; ++ai)
#pragma unroll
                    for (int m = 0; m < 4; ++m) { bf16* rowp = base + (size_t)(row0 + ai * HALF + m * 16) * 1024 + col0;
#pragma unroll
                        for (int bj = 0; bj < 2; ++bj) { const pg8::f32x4 v0 = acc[ai][bj][m][0] * sc, v1 = acc[ai][bj][m][1] * sc;
                            v4u w; w.x = pk2(v0[0], v0[1]); w.y = pk2(v0[2], v0[3]); w.z = pk2(v1[0], v1[1]); w.w = pk2(v1[2], v1[3]); *(v4u*)(rowp + bj * HALF) = w; } }
            } else {
                const bool isq = t < 12; const float* gain = isq ? q_norm : k_norm; const float sc = isq ? C2 : 1.0f;
                bf16* base = isq ? (QW + (t - 8) * 256 + wc * 64) : (KW + wc * 64); const int ld = isq ? 1024 : 256;
                pg8::f32x4 g[2][2];
#pragma unroll
                for (int bj = 0; bj < 2; ++bj)
#pragma unroll
                    for (int n = 0; n < 2; ++n) g[bj][n] = *(const pg8::f32x4*)(gain + 32 * bj + 8 * fq + 4 * n) * sc;
#pragma unroll
                for (int ai = 0; ai < 2; ++ai)
#pragma unroll
                    for (int m = 0; m < 4; ++m) {
                        float ss = 0.f;
#pragma unroll
                        for (int bj = 0; bj < 2; ++bj)
#pragma unroll
                            for (int n = 0; n < 2; ++n) { const pg8::f32x4 v = acc[ai][bj][m][n]; ss += (v[0] * v[0] + v[1] * v[1]) + (v[2] * v[2] + v[3] * v[3]); }
                        ss += __shfl_xor(ss, 16); ss += __shfl_xor(ss, 32);
                        const float rstd = 1.0f / sqrtf(ss * (1.0f / 64.0f) + RMS_EPS);
                        bf16* rowp = base + (size_t)(row0 + ai * HALF + m * 16) * ld + 8 * fq;
#pragma unroll
                        for (int bj = 0; bj < 2; ++bj) { const pg8::f32x4 v0 = acc[ai][bj][m][0] * rstd * g[bj][0], v1 = acc[ai][bj][m][1] * rstd * g[bj][1];
                            v4u w; w.x = pk2(v0[0], v0[1]); w.y = pk2(v0[2], v0[3]); w.z = pk2(v1[0], v1[1]); w.w = pk2(v1[2], v1[3]); *(v4u*)(rowp + 32 * bj) = w; } }
            }
        } else {
            const int vrow0 = (u.pm - NTILE_X - NT_QK) * 256 + wr * 64 + fr;
#pragma unroll
            for (int ai = 0; ai < 2; ++ai)
#pragma unroll
                for (int m = 0; m < 4; ++m) { bf16* rowp = VT + (size_t)(vrow0 + ai * HALF + m * 16) * MPAD + u.pn * 256 + wc * 32 + 16 * (fq >> 1) + 4 * (fq & 1);
#pragma unroll
                    for (int bj = 0; bj < 2; ++bj)
#pragma unroll
                        for (int n = 0; n < 2; ++n) { const pg8::f32x4 v = acc[ai][bj][m][n]; v2u w; w.x = pk2(v[0], v[1]); w.y = pk2(v[2], v[3]); *(v2u*)(rowp + bj * HALF + 8 * n) = w; } }
        }
    }
};

namespace att {
__device__ __forceinline__ f32x16 mfma_bf(bf16x8 a, bf16x8 b, f32x16 c) { return __builtin_amdgcn_mfma_f32_32x32x16_bf16(a, b, c, 0, 0, 0); }
__device__ __forceinline__ f32x16 mfma_h(f16x8 a, f16x8 b, f32x16 c) { return __builtin_amdgcn_mfma_f32_32x32x16_f16(a, b, c, 0, 0, 0); }
__device__ __forceinline__ bf16x8 ld8(const bf16* p) { return *(const bf16x8*)p; }
__device__ __forceinline__ bf16x8 pack8(const float* w) { v4u o; o.x = pk2(w[0], w[1]); o.y = pk2(w[2], w[3]); o.z = pk2(w[4], w[5]); o.w = pk2(w[6], w[7]); return __builtin_bit_cast(bf16x8, o); }

struct KT { bf16x8 k[4]; bf16x8 v[4]; };
__device__ __forceinline__ void glds16(const void* gsrc, unsigned lds_dst) { unsigned keep;
    asm volatile("s_mov_b32 %0, m0\n\ts_mov_b32 m0, %2\n\ts_nop 0\n\tglobal_load_lds_dwordx4 %1, off\n\ts_mov_b32 m0, %0" : "=&s"(keep) : "v"(gsrc), "s"(lds_dst) : "memory"); }
__device__ __forceinline__ void dma_tile(unsigned slot, const bf16* Kb, int ldk, const bf16* Vt, int b, int j, int lane) {
#pragma unroll
    for (int i = 0; i < 4; ++i) { const int row = 8 * i + (lane >> 3), ch = (lane & 7) ^ (row & 7);
        const int krow = (j >= 0) ? (b * SEQ + 32 * j + row) : (NTOK + (row & 15));
        glds16(Kb + (size_t)krow * ldk + ch * 8, (unsigned)__builtin_amdgcn_readfirstlane(slot + i * 1024)); }
    const int col0 = (j >= 0) ? (b * SEQ + 32 * j) : NTOK;
#pragma unroll
    for (int i = 0; i < 4; ++i) { const int row = 16 * i + (lane >> 2), c = (lane & 3) ^ ((row >> 2) & 3); const int cc = (j >= 0) ? c : (c & 1);
        glds16(Vt + (size_t)row * MPAD + col0 + cc * 8, (unsigned)__builtin_amdgcn_readfirstlane(slot + 4096 + i * 1024)); }
}
__device__ __forceinline__ void lds_frags(KT& t, const LAS unsigned char* slot, int r, int h) {
#pragma unroll
    for (int s = 0; s < 4; ++s) { const int c = 2 * s + h; t.k[s] = *(const LAS bf16x8*)(slot + (r >> 3) * 1024 + ((r & 7) * 8 + (c ^ (r & 7))) * 16); }
#pragma unroll
    for (int dh = 0; dh < 2; ++dh)
#pragma unroll
        for (int s = 0; s < 2; ++s) { const int row = 32 * dh + r, c = 2 * s + h; t.v[dh * 2 + s] = *(const LAS bf16x8*)(slot + 4096 + row * 64 + (c ^ ((row >> 2) & 3)) * 16); }
}
#define ATT_WAITV(n) asm volatile("s_waitcnt vmcnt(" #n ")" ::: "memory")

struct SbState { f32x16 o0, o1; float R; };
template <int KIND>
__device__ __forceinline__ void sb_tile(SbState& S, const KT& t, const bf16x8 (&qf)[4], const f16x8& U0, const f16x8& U1, int r, int h) {
    f32x16 z = {0.f, 0.f, 0.f, 0.f, 0.f, 0.f, 0.f, 0.f, 0.f, 0.f, 0.f, 0.f, 0.f, 0.f, 0.f, 0.f};
#pragma unroll
    for (int s = 0; s < 4; ++s) z = mfma_bf(t.k[s], qf[s], z);
    f32x16 init; float L[16];
#pragma unroll
    for (int g = 0; g < 16; ++g) {
        const float zz = z[g];
        const float e = __builtin_amdgcn_exp2f(-__builtin_fabsf(zz));
        const float zp = __builtin_amdgcn_fmed3f(zz, 0.f, 3.0e38f);
        const float sp = zp + __builtin_amdgcn_logf(1.0f + e);
        float Lv = -sp;
        if (KIND == 1) Lv = (crow(g, h) < r) ? Lv : 0.f;
        if (KIND == 2) Lv = (crow(g, h) < 16) ? Lv : 0.f;
        L[g] = Lv; init[g] = zz + Lv + S.R;
    }
    f16x8 lb0, lb1;
#pragma unroll
    for (int j = 0; j < 8; ++j) { lb0[j] = (_Float16)L[j]; lb1[j] = (_Float16)L[8 + j]; }
    f32x16 lw = mfma_h(U0, lb0, init); lw = mfma_h(U1, lb1, lw);
    float Rn = lw[0] - z[0];
    Rn = __shfl(Rn, r);
    float w[16];
#pragma unroll
    for (int g = 0; g < 16; ++g) {
        float wv = __builtin_amdgcn_exp2f(lw[g]);
        if (KIND == 1) wv = (crow(g, h) < r) ? wv : 0.f;
        if (KIND == 2) wv = (crow(g, h) < 16) ? wv : 0.f;
        w[g] = wv;
    }
    const bf16x8 wb0 = pack8(w), wb1 = pack8(w + 8);
    S.o0 = mfma_bf(t.v[0], wb0, S.o0); S.o0 = mfma_bf(t.v[1], wb1, S.o0);
    S.o1 = mfma_bf(t.v[2], wb0, S.o1); S.o1 = mfma_bf(t.v[3], wb1, S.o1);
    S.R = Rn;
}

struct SwState { f32x16 o0, o1; float m, l; };
template <int KIND>
__device__ __forceinline__ void sw_tile(SwState& S, const KT& t, const bf16x8 (&qf)[4], const LAS float* tb, int r, int h) {
    f32x16 z = {0.f, 0.f, 0.f, 0.f, 0.f, 0.f, 0.f, 0.f, 0.f, 0.f, 0.f, 0.f, 0.f, 0.f, 0.f, 0.f};
#pragma unroll
    for (int s = 0; s < 4; ++s) z = mfma_bf(t.k[s], qf[s], z);
    float sc[16]; float mx = -1e30f;
#pragma unroll
    for (int g = 0; g < 16; ++g) {
        float v = z[g] + tb[(g & 3) + 8 * (g >> 2)];
        if (KIND == 1) v = (crow(g, h) <= r) ? v : -1e30f;
        if (KIND == 2) v = (crow(g, h) < 16) ? v : -1e30f;
        if (KIND == 3) v = (crow(g, h) > r) ? v : -1e30f;
        sc[g] = v; mx = __builtin_fmaxf(mx, v);
    }
    mx = __builtin_fmaxf(mx, __shfl_xor(mx, 32));
    const float mn = __builtin_fmaxf(S.m, mx);
    const float alpha = __builtin_amdgcn_exp2f(S.m - mn);
    S.l *= alpha; S.o0 *= alpha; S.o1 *= alpha;
    float p[16]; float ls = 0.f;
#pragma unroll
    for (int g = 0; g < 16; ++g) { p[g] = __builtin_amdgcn_exp2f(sc[g] - mn); ls += p[g]; }
    S.l += ls; S.m = mn;
    const bf16x8 wb0 = pack8(p), wb1 = pack8(p + 8);
    S.o0 = mfma_bf(t.v[0], wb0, S.o0); S.o0 = mfma_bf(t.v[1], wb1, S.o0);
    S.o1 = mfma_bf(t.v[2], wb0, S.o1); S.o1 = mfma_bf(t.v[3], wb1, S.o1);
}
__device__ __forceinline__ float store_o(bf16* orow, const f32x16& o0, const f32x16& o1, float scale, int h) {
    float ss = 0.f;
#pragma unroll
    for (int q = 0; q < 4; ++q) {
        const float a0 = o0[4 * q] * scale, a1 = o0[4 * q + 1] * scale, a2 = o0[4 * q + 2] * scale, a3 = o0[4 * q + 3] * scale;
        const float b0 = o1[4 * q] * scale, b1 = o1[4 * q + 1] * scale, b2 = o1[4 * q + 2] * scale, b3 = o1[4 * q + 3] * scale;
        ss += ((a0 * a0 + a1 * a1) + (a2 * a2 + a3 * a3)) + ((b0 * b0 + b1 * b1) + (b2 * b2 + b3 * b3));
        v2u w; w.x = pk2(a0, a1); w.y = pk2(a2, a3); *(v2u*)(orow + 8 * q + 4 * h) = w;
        v2u x; x.x = pk2(b0, b1); x.y = pk2(b2, b3); *(v2u*)(orow + 32 + 8 * q + 4 * h) = x;
    }
    return ss;
}
}

__device__ __forceinline__ void p2_attention(Frame& F) {
    using namespace att;
    const int lane = F.lane, r = lane & 31, h = lane >> 5, w = F.wave;
    const bf16* VT = (const bf16*)(F.ws + WS_VT); bf16* MIX = (bf16*)(F.ws + WS_MIXED); float* SSQ = (float*)(F.ws + WS_SSQ);
    LAS float* tbr = (LAS float*)(F.lds + ATT_TBR_OFF);
    const LAS unsigned char* area = F.lds + RING_OFF + w * 16384;
    const unsigned slot0 = (unsigned)(uintptr_t)area;
    { const float* rel_bias = F.in[2];
      for (int idx = F.tid; idx < 16 * 192; idx += NWAVES * 64) {
        const int hq = idx / 192, x = idx % 192, d = 159 - x; float v = 0.f;
        if (d >= 0) { int bkt = d; if (d >= 16) { bkt = 16 + (int)(logf((float)d / 16.0f) / logf(8.0f) * 16.0f); bkt = bkt > 31 ? 31 : bkt; } v = rel_bias[bkt * 16 + hq] * LOG2E; }
        tbr[idx] = v;
      } }
    __syncthreads();
    if (w >= ATT_WAVES) {
        const int p2_end = NITEMS - TAIL6_ITEMS - tail1_items(F.G);
        conv_range3(F, p2_end - P2_ITEMS + F.vcu * (NWAVES - ATT_WAVES) + (w - ATT_WAVES), F.G * (NWAVES - ATT_WAVES), p2_end);
        return;
    }
    __builtin_amdgcn_s_setprio(3);
    for (int unit = F.vcu; unit < NTOK / 32; unit += F.G) {
        const int b = unit >> 7, a = unit & 127;
        const size_t qrow = (size_t)b * SEQ + 32 * a + r;
#pragma unroll 1
        for (int bi = 0; bi < 2; ++bi) {
            const int branch = bi;
            if (branch == 0) {
            const bf16* KS = (const bf16*)(F.ws + WS_KS); const bf16* QS = (const bf16*)(F.ws + WS_QS);
            f16x8 U0, U1;
#pragma unroll
            for (int j = 0; j < 8; ++j) { const int c0 = 8 * (j >> 2) + 4 * h + (j & 3); U0[j] = (c0 > r) ? (_Float16)1.0f : (_Float16)0.0f; U1[j] = (16 + c0 > r) ? (_Float16)1.0f : (_Float16)0.0f; }
            float ssl = 0.f;
#pragma unroll 1
            for (int hh = 0; hh < 16 / ATT_WAVES; ++hh) {
                const int head = (16 / ATT_WAVES) * w + hh;
                ATT_WAITV(0);
                const bf16* Kb = KS + head * 64;
                bf16x8 ql[4];
#pragma unroll
                for (int s = 0; s < 4; ++s) ql[s] = ld8(QS + qrow * 1024 + head * 64 + 16 * s + 8 * h);
                SbState S; S.R = 0.f;
#pragma unroll
                for (int g = 0; g < 16; ++g) { S.o0[g] = 0.f; S.o1[g] = 0.f; }
                const bf16* Vt = VT + (size_t)(head * 64) * MPAD;
                unsigned sl_cur = slot0, sl_nxt = slot0 + 8192;
                int jt = a;
                dma_tile(sl_cur, Kb, 1024, Vt, b, jt, lane); dma_tile(sl_nxt, Kb, 1024, Vt, b, jt - 1, lane);
                ATT_WAITV(8);
                KT T; lds_frags(T, area + (sl_cur - slot0), r, h);
                sb_tile<1>(S, T, ql, U0, U1, r, h);
                if (!__all(S.R < SB_EXIT)) {
                    --jt;
                    for (;;) {
                        { const unsigned t_ = sl_cur; sl_cur = sl_nxt; sl_nxt = t_; }
                        const bool has_next = jt >= 0;
                        if (has_next) { dma_tile(sl_nxt, Kb, 1024, Vt, b, jt - 1, lane); ATT_WAITV(8); } else ATT_WAITV(0);
                        lds_frags(T, area + (sl_cur - slot0), r, h);
                        if (jt >= 0) sb_tile<0>(S, T, ql, U0, U1, r, h); else sb_tile<2>(S, T, ql, U0, U1, r, h);
                        if (!has_next || __all(S.R < SB_EXIT)) break;
                        --jt;
                    }
                }
                ssl += store_o(MIX + qrow * DM + head * 64, S.o0, S.o1, 1.0f, h);
            }
            ssl += __shfl_xor(ssl, 32);
            if (h == 0) SSQ[qrow * 16 + w] = ssl;
        }
            else {
            const bf16* KW = (const bf16*)(F.ws + WS_KW); const bf16* QW = (const bf16*)(F.ws + WS_QW);
            float ssl = 0.f;
#pragma unroll 1
            for (int hh = 0; hh < 16 / ATT_WAVES; ++hh) {
                const int hq = (16 / ATT_WAVES) * w + hh, kvh = hq >> 2;
                ATT_WAITV(0);
                const bf16* Kb = KW + kvh * 64;
                bf16x8 ql[4];
#pragma unroll
                for (int s = 0; s < 4; ++s) ql[s] = ld8(QW + qrow * 1024 + hq * 64 + 16 * s + 8 * h);
                const float sink2 = F.in[7][hq] * LOG2E;
                SwState S; S.m = sink2; S.l = 0.f;
#pragma unroll
                for (int g = 0; g < 16; ++g) { S.o0[g] = 0.f; S.o1[g] = 0.f; }
                const LAS float* tbh = tbr + hq * 192 + 4 * h;
                const int jlo = (a >= 4) ? a - 4 : 0;
                const bf16* Vt = VT + (size_t)(1024 + kvh * 64) * MPAD;
                unsigned sl_cur = slot0, sl_nxt = slot0 + 8192;
                int jt = a;
#define SW_NEXT(j) (((j) > jlo) ? (j) - 1 : -1)
                dma_tile(sl_cur, Kb, 256, Vt, b, jt, lane); dma_tile(sl_nxt, Kb, 256, Vt, b, SW_NEXT(jt), lane);
                ATT_WAITV(8);
                KT T; lds_frags(T, area + (sl_cur - slot0), r, h);
                sw_tile<1>(S, T, ql, tbh + (159 - r), r, h);
                jt = SW_NEXT(jt);
                for (;;) {
                    { const unsigned t_ = sl_cur; sl_cur = sl_nxt; sl_nxt = t_; }
                    if (jt >= 0) { dma_tile(sl_nxt, Kb, 256, Vt, b, SW_NEXT(jt), lane); ATT_WAITV(8); } else ATT_WAITV(0);
                    lds_frags(T, area + (sl_cur - slot0), r, h);
                    if (jt < 0) { const int dq = 32 * a + r + 16; sw_tile<2>(S, T, ql, tbh + (159 - (dq < 159 ? dq : 159)), r, h); break; }
                    const LAS float* tb = tbh + (159 - (32 * (a - jt) + r));
                    if (jt == a - 4) sw_tile<3>(S, T, ql, tb, r, h); else sw_tile<0>(S, T, ql, tb, r, h);
                    jt = SW_NEXT(jt);
                }
#undef SW_NEXT
                const float lt = S.l + __shfl_xor(S.l, 32) + __builtin_amdgcn_exp2f(sink2 - S.m);
                ssl += store_o(MIX + qrow * DM + 1024 + hq * 64, S.o0, S.o1, 1.0f / lt, h);
            }
            ssl += __shfl_xor(ssl, 32);
            if (h == 0) SSQ[qrow * 16 + 8 + w] = ssl;
        }
        }
    }
    __builtin_amdgcn_s_setprio(0);
}

struct EpiRes {
    static constexpr bool PERM = true, AFTER_DRAIN = false, MIDK = true;
    bf16* P; const LAS float* RS; const bf16* XN; mutable int ui;
    __device__ __forceinline__ void midk(pg8::f32x4 (&acc)[2][2][4][2], const pg8::Unit& u, int wr, int fr) const {
#pragma unroll
        for (int ai = 0; ai < 2; ++ai)
#pragma unroll
            for (int m = 0; m < 4; ++m) { const LAS float* q = RS + (ui * 256 + ai * 128 + wr * 64 + m * 16 + fr) * 2; const float ratio = q[0] / q[1];
#pragma unroll
                for (int bj = 0; bj < 2; ++bj)
#pragma unroll
                    for (int n = 0; n < 2; ++n) acc[ai][bj][m][n] *= ratio; }
    }
    __device__ __forceinline__ void operator()(const pg8::f32x4 (&acc)[2][2][4][2], const pg8::Unit& u, int wr, int wc, int fr, int fq) const {
        const int col0 = u.pn * 256 + wc * 32 + 8 * fq;
        v4u xr[2][4][2];
#pragma unroll
        for (int ai = 0; ai < 2; ++ai)
#pragma unroll
            for (int m = 0; m < 4; ++m) { const int rl = ai * 128 + wr * 64 + m * 16 + fr; const bf16* xp = XN + (size_t)(u.pm * 256 + rl) * DM + col0;
#pragma unroll
                for (int bj = 0; bj < 2; ++bj) xr[ai][m][bj] = *(const v4u*)(xp + bj * 128); }
#pragma unroll
        for (int ai = 0; ai < 2; ++ai)
#pragma unroll
            for (int m = 0; m < 4; ++m) { const int rl = ai * 128 + wr * 64 + m * 16 + fr; bf16* rowp = P + (size_t)(u.pm * 256 + rl) * DM + col0; const float rw = RS[(ui * 256 + rl) * 2 + 1], ri = RS[2048 + ui * 256 + rl];
#pragma unroll
                for (int bj = 0; bj < 2; ++bj) { const pg8::f32x4 v0 = acc[ai][bj][m][0] * rw, v1 = acc[ai][bj][m][1] * rw; const v4u x = xr[ai][m][bj];
                    v4u w; w.x = pk2(bf_lo(x.x) * ri + v0[0], bf_hi(x.x) * ri + v0[1]); w.y = pk2(bf_lo(x.y) * ri + v0[2], bf_hi(x.y) * ri + v0[3]);
                    w.z = pk2(bf_lo(x.z) * ri + v1[0], bf_hi(x.z) * ri + v1[1]); w.w = pk2(bf_lo(x.w) * ri + v1[2], bf_hi(x.w) * ri + v1[3]); *(v4u*)(rowp + bj * 128) = w; } }
        ++ui;
    }
};

__device__ __forceinline__ void p4_router(Frame& F) {
    using namespace att;
    const int lane = F.lane, r = lane & 31, h = lane >> 5, w = F.wave;
    const bf16* HB = (const bf16*)(F.ws + WS_HB);
    const bf16* WRH = (const bf16*)(F.ws + WS_WR); const bf16* WRL = WRH + 96 * DM;
    const float* b_rg = F.in[13]; const float* b_re = F.in[15];
    unsigned* CNT = F.ctl + CW_CNT;
    int* LIST = (int*)(F.ws + WS_LIST); float* GATEW = (float*)(F.ws + WS_GATEW); int* TOKINFO = (int*)(F.ws + WS_TOKINFO); float* RSTD = (float*)(F.ws + WS_RSTD); float* RSTDW = (float*)(F.ws + WS_RSTDW);
    LAS float* part = (LAS float*)(F.lds + RING_OFF);
    LAS float* ssp = (LAS float*)(F.lds + RING_OFF + 98304);
    LAS float* lg = (LAS float*)(F.lds + RING_OFF + 98304 + 2048);
    LAS float* rsl = (LAS float*)(F.lds + RING_OFF + 98304 + 2048 + 18432);
    const bool stager = __builtin_amdgcn_readfirstlane(w) < 4; const int mw = w & 3;
    const int crot = F.vcu & 3, krot = (F.vcu >> 2) & 7;
    for (int unit = F.vcu; unit < NTOK / 64; unit += F.G) {
        if (stager) {
#pragma unroll 1
            for (int c = 0; c < 5; ++c) {
                if (c < 4) {
                    const int cn = (c + crot) & 3;
                    LAS unsigned char* sh = F.lds + RING_OFF + (c & 1) * 65536;
#pragma unroll 1
                    for (int hb = 0; hb < 2; ++hb) {
                        v4u xr[8];
#pragma unroll
                        for (int i = 0; i < 8; ++i) { const int id = (hb * 8 + i) * 256 + F.tid, row = id >> 6, g = id & 63; xr[i] = *(const v4u*)(HB + ((size_t)unit * 64 + row) * DM + 512 * cn + 8 * g); }
#pragma unroll
                        for (int i = 0; i < 8; ++i) { const int id = (hb * 8 + i) * 256 + F.tid, row = id >> 6, g = id & 63; *(LAS v4u*)(sh + row * 1024 + ((g ^ (row & 15)) << 4)) = xr[i]; }
                    }
                }
                __syncthreads();
            }
        } else {
            f32x16 acc[2][3];
#pragma unroll
            for (int t = 0; t < 2; ++t)
#pragma unroll
                for (int nt = 0; nt < 3; ++nt)
#pragma unroll
                    for (int g = 0; g < 16; ++g) acc[t][nt][g] = 0.f;
            float ss0 = 0.f, ss1 = 0.f;
            bf16x8 wah[3], wal[3], wbh[3], wbl[3];
#define P4_WLOAD(WH, WL, C_, S8_) { const int ksg_ = 32 * (((C_) + crot) & 3) + mw + 4 * (((S8_) + krot) & 7); \
                _Pragma("unroll") for (int nt = 0; nt < 3; ++nt) { const int fo = (((ksg_ * 3 + nt) * 64 + lane) << 3); WH[nt] = ld8(WRH + fo); WL[nt] = ld8(WRL + fo); } }
#define P4_SS(SS, HV) { const float e0 = bf_lo(HV.x), e1 = bf_hi(HV.x), e2 = bf_lo(HV.y), e3 = bf_hi(HV.y), e4 = bf_lo(HV.z), e5 = bf_hi(HV.z), e6 = bf_lo(HV.w), e7 = bf_hi(HV.w); \
                SS += ((e0 * e0 + e1 * e1) + (e2 * e2 + e3 * e3)) + ((e4 * e4 + e5 * e5) + (e6 * e6 + e7 * e7)); }
#define P4_KSTEP(WH, WL, S8_) { const int ks = mw + 4 * (((S8_) + krot) & 7); \
                const int fo0 = r * 1024 + ((((2 * ks + h) ^ (r & 15))) << 4), fo1 = fo0 + 32 * 1024; \
                const v4u h0 = *(const LAS v4u*)(sh + fo0), h1 = *(const LAS v4u*)(sh + fo1); \
                P4_SS(ss0, h0) P4_SS(ss1, h1) \
                const bf16x8 ahi0 = __builtin_bit_cast(bf16x8, h0), ahi1 = __builtin_bit_cast(bf16x8, h1); \
                _Pragma("unroll") for (int nt = 0; nt < 3; ++nt) { \
                    acc[0][nt] = mfma_bf(ahi0, WH[nt], acc[0][nt]); acc[1][nt] = mfma_bf(ahi1, WH[nt], acc[1][nt]); \
                    acc[0][nt] = mfma_bf(ahi0, WL[nt], acc[0][nt]); acc[1][nt] = mfma_bf(ahi1, WL[nt], acc[1][nt]); } }
            P4_WLOAD(wah, wal, 0, 0)
            __syncthreads();
#pragma unroll 1
            for (int c = 0; c < 4; ++c) {
                const LAS unsigned char* sh = F.lds + RING_OFF + (c & 1) * 65536;
#pragma unroll 1
                for (int s8 = 0; s8 < 8; s8 += 2) {
                    P4_WLOAD(wbh, wbl, c, s8 + 1)
                    P4_KSTEP(wah, wal, s8)
                    { const int j = c * 8 + s8 + 2; P4_WLOAD(wah, wal, j >> 3, j & 7) }
                    P4_KSTEP(wbh, wbl, s8 + 1)
                }
                __syncthreads();
            }
#undef P4_SS
#undef P4_KSTEP
#undef P4_WLOAD
            ss0 += __shfl_xor(ss0, 32); ss1 += __shfl_xor(ss1, 32);
            if (h == 0) { ssp[mw * 32 + r] = ss0; ssp[128 + mw * 32 + r] = ss1; }
#pragma unroll
            for (int t = 0; t < 2; ++t)
#pragma unroll
                for (int nt = 0; nt < 3; ++nt)
#pragma unroll
                    for (int g = 0; g < 16; ++g) part[((t * 4 + mw) * 32 + crow(g, h)) * 96 + nt * 32 + r] = acc[t][nt][g];
        }
        __syncthreads();
        for (int idx = F.tid; idx < 64 * 72; idx += NWAVES * 64) { const int tkk = idx / 72, cc = idx % 72, t = tkk >> 5, tk = tkk & 31; float v = 0.f;
#pragma unroll
            for (int i = 0; i < 4; ++i) v += part[((t * 4 + i) * 32 + tk) * 96 + cc];
            lg[idx] = v; }
        __syncthreads();
        LAS unsigned* hist = (LAS unsigned*)rsl + 64;
        if (F.tid < 128) hist[F.tid] = 0u;
        __syncthreads();
        int tok = 0, e0 = 0, e1 = 0; unsigned r0 = 0, r1 = 0; float g0 = 0.f, g1 = 0.f, rs = 0.f;
        if (F.tid < 64) {
            tok = unit * 64 + F.tid; float tsum = 0.f;
#pragma unroll
            for (int i = 0; i < 4; ++i) tsum += ssp[(F.tid >> 5) * 128 + i * 32 + (F.tid & 31)];
            rs = 1.0f / sqrtf(tsum * (1.0f / DM) + RMS_EPS); RSTD[tok] = rs;
            const LAS float* l = lg + F.tid * 72;
            float gl[8]; int gi = 0; float gm = -3.0e38f;
#pragma unroll
            for (int i = 0; i < 8; ++i) { gl[i] = l[i] * rs + b_rg[i]; if (gl[i] > gm) { gm = gl[i]; gi = i; } }
            float gs = 0.f;
#pragma unroll
            for (int i = 0; i < 8; ++i) gs += expf(gl[i] - gm);
            const float gval = 1.0f / gs;
            float el[8]; int i0 = 0; float m0 = -3.0e38f;
#pragma unroll
            for (int i = 0; i < 8; ++i) { el[i] = l[8 + gi * 8 + i] * rs + b_re[gi * 8 + i]; if (el[i] > m0) { m0 = el[i]; i0 = i; } }
            int i1 = 0; float m1 = -3.0e38f;
#pragma unroll
            for (int i = 0; i < 8; ++i) if (i != i0 && el[i] > m1) { m1 = el[i]; i1 = i; }
            const float p1 = expf(m1 - m0); g0 = gval / (1.0f + p1); g1 = gval * p1 / (1.0f + p1);
            e0 = gi * 8 + i0; e1 = gi * 8 + i1;
            r0 = atomicAdd((unsigned*)(hist + e0), 1u); r1 = atomicAdd((unsigned*)(hist + e1), 1u);
        }
        __syncthreads();
        if (F.tid < 64) { const unsigned n = hist[F.tid]; if (n) hist[64 + F.tid] = atomicAdd(CNT + 16 * F.tid, n); }
        __syncthreads();
        if (F.tid < 64) {
            const int pos0 = (int)(hist[64 + e0] + r0), pos1 = (int)(hist[64 + e1] + r1);
            LIST[e0 * NTOK + pos0] = tok; LIST[e1 * NTOK + pos1] = tok; GATEW[e0 * NTOK + pos0] = g0; GATEW[e1 * NTOK + pos1] = g1; RSTDW[e0 * NTOK + pos0] = rs; RSTDW[e1 * NTOK + pos1] = rs;
            *(int4*)(TOKINFO + 4 * tok) = make_int4(e0, pos0, e1, pos1);
        }
        __syncthreads();
    }
}

__device__ __forceinline__ void build_tables(Frame& F) {
    LAS int* T = (LAS int*)(F.lds + TBL_OFF);
    __syncthreads();
    if (F.tid < NEXP) {
        const int c = (int)__hip_atomic_load(F.ctl + CW_CNT + 16 * F.tid, __ATOMIC_RELAXED, __HIP_MEMORY_SCOPE_AGENT); const int mt = (c + 255) >> 8;
        int incl = mt;
#pragma unroll
        for (int o = 1; o < 64; o <<= 1) { const int v = __shfl_up(incl, o); if (F.tid >= o) incl += v; }
        const int st = incl - mt;
        T[TBL_TSTART + F.tid] = st; T[TBL_CNTS + F.tid] = c;
        for (int i = 0; i < mt; ++i) T[TBL_TE + st + i] = F.tid;
        if (F.tid == NEXP - 1) { T[TBL_TSTART + NEXP] = incl; T[TBL_NT] = incl; }
    }
    __syncthreads();
}
struct MoeGather {
    const int* list; const LAS int* T; LAS int* tokbuf; int NT; const float* rstdw; const float* gatew;
    __device__ __forceinline__ void info(const pg8::Unit& u, int& e, int& base, int& cnt) const { e = u.pn / NT; base = (u.pm - T[TBL_TSTART + e]) * 256; cnt = T[TBL_CNTS + e]; }
    __device__ __forceinline__ unsigned tok_direct(const pg8::Unit& u, int row) const { int e, base, cnt; info(u, e, base, cnt); const int idx = base + row; return idx < cnt ? (unsigned)list[e * NTOK + idx] : 0u; }
    __device__ __forceinline__ void issue(const pg8::Unit& u, int par, int lane) const { int e, base, cnt; info(u, e, base, cnt);
        __builtin_amdgcn_global_load_lds((const unsigned*)(list + e * NTOK + base + 4 * lane), (LAS unsigned*)(tokbuf + par * 256), 16, 0, 0);
        __builtin_amdgcn_global_load_lds((const unsigned*)(rstdw + e * NTOK + base + 4 * lane), (LAS unsigned*)(tokbuf + 512 + par * 256), 16, 0, 0);
        __builtin_amdgcn_global_load_lds((const unsigned*)(gatew + e * NTOK + base + 4 * lane), (LAS unsigned*)(tokbuf + 1024 + par * 256), 16, 0, 0); }
    __device__ __forceinline__ void direct_rg(const pg8::Unit& u, int row, float& rs, float& gw) const { int e, base, cnt; info(u, e, base, cnt); rs = rstdw[e * NTOK + base + row]; gw = gatew[e * NTOK + base + row]; }
    __device__ __forceinline__ unsigned tok_lds(const pg8::Unit& u, int par, int row) const { int e, base, cnt; info(u, e, base, cnt); const unsigned t = (unsigned)tokbuf[par * 256 + row]; return (base + row) < cnt ? t : 0u; }
};
namespace pg8 {
template <class Epi, class Sched>
__device__ __forceinline__ void gemm_phase_g(PG8_LAS unsigned char* lds, const Gemm g, const Sched& S, const Epi& E, const MoeGather& GA) {
    const int tid = threadIdx.x, wid = __builtin_amdgcn_readfirstlane(tid >> 6), lane = tid & 63, wr = wid >> 2, wc = wid & 3, fr = lane & 15, fq = lane >> 4;
    const int K = g.K, nt = K / BK;
    unsigned voffB[2], cofA[2]; int rowA[2];
#pragma unroll
    for (int i = 0; i < 2; ++i) { int R, C; stage_rc(tid * 16 + i * 8192, R, C); const int Rb = Epi::PERM ? ((R & ~31) + perm32(R & 31)) : R;
        rowA[i] = R; cofA[i] = (unsigned)C * 2u; voffB[i] = (unsigned)(Rb * K + C) * 2u; }
    const unsigned rowbytes = (unsigned)K * 2u;
    const size_t kstep = (size_t)(BK * 2);
    const size_t hstep = (size_t)HALF * K * 2;
    const size_t tstep = 2 * hstep;
    const unsigned ldsw = (unsigned)wid * 1024u;
    const int aoff = lds_byte(wr * 64 + fr, fq * 8), boff = lds_byte(wc * 32 + fr, fq * 8);
#define PG8_SA(b, h) (((b) * 2 + (h)) * HTB)
#define PG8_SB(b, h) ((4 + (b) * 2 + (h)) * HTB)
#define PG8_STAGE(bufoff, gbase, voff) do { _Pragma("unroll") for (int _i = 0; _i < 2; ++_i) \
        __builtin_amdgcn_global_load_lds((const unsigned*)((const char*)(gbase) + (voff)[_i]), (PG8_LAS unsigned*)(lds + (bufoff) + ldsw + _i * 8192), 16, 0, 0); } while (0)
#define PG8_LDA(dst, b, h) do { _Pragma("unroll") for (int m = 0; m < 4; ++m) _Pragma("unroll") for (int k = 0; k < 2; ++k) dst[m][k] = *(const PG8_LAS bf16x8*)(lds + PG8_SA(b, h) + aoff + m * 2048 + k * 1024); } while (0)
#define PG8_LDB(dst, b, h) do { _Pragma("unroll") for (int n = 0; n < 2; ++n) _Pragma("unroll") for (int k = 0; k < 2; ++k) dst[n][k] = *(const PG8_LAS bf16x8*)(lds + PG8_SB(b, h) + boff + n * 2048 + k * 1024); } while (0)
#define PG8_MMA(ai, bj, At, Bt) do { __builtin_amdgcn_s_setprio(1); _Pragma("unroll") for (int m = 0; m < 4; ++m) _Pragma("unroll") for (int n = 0; n < 2; ++n) _Pragma("unroll") for (int k = 0; k < 2; ++k) \
        acc[ai][bj][m][n] = __builtin_amdgcn_mfma_f32_16x16x32_bf16(Bt[n][k], At[m][k], acc[ai][bj][m][n], 0, 0, 0); __builtin_amdgcn_s_setprio(0); } while (0)
#define PG8_WAIT_V(n) asm volatile("s_waitcnt vmcnt(" #n ")" ::: "memory")
#define PG8_WAIT_L(n) asm volatile("s_waitcnt lgkmcnt(" #n ")" ::: "memory")
#define PG8_BAR __builtin_amdgcn_s_barrier()
#define PG8_SCHED __builtin_amdgcn_sched_barrier(0)
    Unit cur, nxt; int ui = 0;
    if (!S.next(0, cur)) return;
    f32x4 acc[2][2][4][2];
#pragma unroll
    for (int a = 0; a < 2; ++a)
#pragma unroll
        for (int b = 0; b < 2; ++b)
#pragma unroll
            for (int m = 0; m < 4; ++m)
#pragma unroll
                for (int n = 0; n < 2; ++n) acc[a][b][m][n] = (f32x4){0.f, 0.f, 0.f, 0.f};
    bf16x8 At[4][2], B0[2][2], B1[2][2];
    const char* A0 = (const char*)g.A; const char* cB = (const char*)g.Bt + (size_t)cur.pn * tstep;
    PG8_LAS int* tb = GA.tokbuf;
    if (tid < 256) { tb[tid] = (int)GA.tok_direct(cur, tid); float rs_, gw_; GA.direct_rg(cur, tid, rs_, gw_); ((PG8_LAS float*)tb)[512 + tid] = rs_; ((PG8_LAS float*)tb)[1024 + tid] = gw_; }
    PG8_WAIT_L(0); PG8_BAR;
#define PG8_OFFS(dst, par, half) do { _Pragma("unroll") for (int _i = 0; _i < 2; ++_i) dst[_i] = (unsigned)tb[(par) * 256 + (half) * HALF + rowA[_i]] * rowbytes + cofA[_i]; } while (0)
    {
        unsigned c0[2], c1[2]; PG8_OFFS(c0, 0, 0); PG8_OFFS(c1, 0, 1);
        PG8_STAGE(PG8_SB(0, 0), cB, voffB); PG8_STAGE(PG8_SB(0, 1), cB + hstep, voffB); PG8_STAGE(PG8_SA(0, 0), A0, c0); PG8_STAGE(PG8_SA(0, 1), A0, c1);
        if (wr == 1) PG8_BAR;
        PG8_WAIT_V(2); PG8_BAR;
        PG8_STAGE(PG8_SB(1, 0), cB + kstep, voffB); PG8_STAGE(PG8_SA(1, 0), A0 + kstep, c0); PG8_STAGE(PG8_SB(1, 1), cB + hstep + kstep, voffB);
        PG8_WAIT_V(6); PG8_BAR;
    }
    int t_issue = 2, t_fix = 6; asm volatile("" : "+s"(t_issue), "+s"(t_fix));
    for (;;) {
        const bool has_next = S.next(ui + 1, nxt);
        const char* nB = has_next ? (const char*)g.Bt + (size_t)nxt.pn * tstep : cB;
        const int pc = ui & 1, pnx = (ui + 1) & 1;
        for (int t = 0; t < nt; t += 2) {
            const bool last = (t == nt - 2);
            const char* a1 = A0 + (size_t)(t + 1) * kstep;
            const char* a2 = last ? A0 : A0 + (size_t)(t + 2) * kstep; const char* b2 = last ? nB : cB + (size_t)(t + 2) * kstep;
            const char* a3 = a2 + kstep; const char* b3 = b2 + kstep;
            if (t == t_fix && has_next && tid < 256) { int e_, base_, cnt_; GA.info(nxt, e_, base_, cnt_); if (base_ + tid >= cnt_) tb[pnx * 256 + tid] = 0; }
            const int ps = (last && has_next) ? pnx : pc;
            unsigned c1[2], s0[2], s1[2]; PG8_OFFS(c1, pc, 1); PG8_OFFS(s0, ps, 0); PG8_OFFS(s1, ps, 1);
            PG8_LDB(B0, 0, 0); PG8_LDB(B1, 0, 1); PG8_SCHED; PG8_LDA(At, 0, 0); PG8_STAGE(PG8_SA(1, 1), a1, c1);
            if (t == t_issue && has_next && wid == 0) GA.issue(nxt, pnx, lane);
            PG8_WAIT_V(8); PG8_WAIT_L(0); PG8_BAR; PG8_MMA(0, 0, At, B0); PG8_MMA(0, 1, At, B1); PG8_BAR; PG8_SCHED;
            PG8_LDA(At, 0, 1); PG8_STAGE(PG8_SB(0, 0), b2, voffB); PG8_STAGE(PG8_SB(0, 1), b2 + hstep, voffB); PG8_STAGE(PG8_SA(0, 0), a2, s0);
            PG8_WAIT_V(8); PG8_WAIT_L(0); PG8_BAR; PG8_MMA(1, 0, At, B0); PG8_MMA(1, 1, At, B1); PG8_BAR; PG8_SCHED;
            PG8_LDB(B0, 1, 0); PG8_LDB(B1, 1, 1); PG8_SCHED; PG8_LDA(At, 1, 0); PG8_STAGE(PG8_SA(0, 1), a2, s1);
            PG8_WAIT_V(8); PG8_WAIT_L(0); PG8_BAR; PG8_MMA(0, 0, At, B0); PG8_MMA(0, 1, At, B1); PG8_BAR; PG8_SCHED;
            PG8_LDA(At, 1, 1); PG8_STAGE(PG8_SB(1, 0), b3, voffB); PG8_STAGE(PG8_SB(1, 1), b3 + hstep, voffB); PG8_STAGE(PG8_SA(1, 0), a3, s0);
            PG8_WAIT_V(8); PG8_WAIT_L(0); PG8_BAR; PG8_MMA(1, 0, At, B0); PG8_MMA(1, 1, At, B1); PG8_BAR; PG8_SCHED;
        }
        if (wr == 0) PG8_BAR;
        E.par = pc; E(acc, cur, wr, wc, fr, fq); S.done(cur);
        if (!has_next) break;
#pragma unroll
        for (int a = 0; a < 2; ++a)
#pragma unroll
            for (int b = 0; b < 2; ++b)
#pragma unroll
                for (int m = 0; m < 4; ++m)
#pragma unroll
                    for (int n = 0; n < 2; ++n) acc[a][b][m][n] = (f32x4){0.f, 0.f, 0.f, 0.f};
        cur = nxt; cB = nB; ++ui;
        if (wr == 1) PG8_BAR;
    }
    PG8_WAIT_V(0);
    PG8_BAR;
#undef PG8_SA
#undef PG8_SB
#undef PG8_STAGE
#undef PG8_LDA
#undef PG8_LDB
#undef PG8_MMA
#undef PG8_WAIT_V
#undef PG8_WAIT_L
#undef PG8_BAR
#undef PG8_SCHED
#undef PG8_OFFS
}
}
struct MoeOrder {
    const LAS int* T; int NT, G, c;
    __device__ bool next(int i, pg8::Unit& u) const {
        const int L = i * G + c; if (L >= T[TBL_NT] * NT) return false;
        const int mt = L / NT; u.pm = mt; u.pn = T[TBL_TE + mt] * NT + (L % NT); return true;
    }
    __device__ __forceinline__ void a_ready(const pg8::Unit&) const {}
    __device__ __forceinline__ void done(const pg8::Unit&) const {}
};
struct EpiSwiGLU {
    static constexpr bool PERM = true, AFTER_DRAIN = false, MIDK = false;
    bf16* HDN; const LAS float* RG; const LAS int* T; mutable int par;
    __device__ __forceinline__ void operator()(const pg8::f32x4 (&acc)[2][2][4][2], const pg8::Unit& u, int wr, int wc, int fr, int fq) const {
        const int col0 = (u.pn & 3) * 128 + wc * 32 + 8 * fq; const int e = u.pn >> 2; const int base = (u.pm - T[TBL_TSTART + e]) * 256, cnt = T[TBL_CNTS + e];
#pragma unroll
        for (int ai = 0; ai < 2; ++ai)
#pragma unroll
            for (int m = 0; m < 4; ++m) { const int rl = ai * 128 + wr * 64 + m * 16 + fr; const int row = u.pm * 256 + rl; const bool ok = (base + rl) < cnt;
                const float rsr = RG[par * 256 + rl], gwr = RG[512 + par * 256 + rl];
                const float rs = ok ? rsr : 0.f, gw = ok ? gwr : 0.f;
                float o[8];
#pragma unroll
                for (int n = 0; n < 2; ++n)
#pragma unroll
                    for (int q = 0; q < 4; ++q) { const float g = acc[ai][0][m][n][q] * rs, up = acc[ai][1][m][n][q] * rs;
                        const float sg = g * __builtin_amdgcn_rcpf(1.0f + __builtin_amdgcn_exp2f(-g * LOG2E)); o[4 * n + q] = sg * up * gw; }
                v4u wv; wv.x = pk2(o[0], o[1]); wv.y = pk2(o[2], o[3]); wv.z = pk2(o[4], o[5]); wv.w = pk2(o[6], o[7]);
                *(v4u*)(HDN + (size_t)row * DEXP + col0) = wv; }
    }
};
struct EpiY {
    static constexpr bool PERM = true, AFTER_DRAIN = false, MIDK = false;
    bf16* Y; const LAS int* T;
    __device__ __forceinline__ void operator()(const pg8::f32x4 (&acc)[2][2][4][2], const pg8::Unit& u, int wr, int wc, int fr, int fq) const {
        const int col0 = (u.pn & 7) * 256 + wc * 32 + 8 * fq; const int e = u.pn >> 3; const int nvalid = T[TBL_CNTS + e] - (u.pm - T[TBL_TSTART + e]) * 256;
#pragma unroll
        for (int ai = 0; ai < 2; ++ai)
#pragma unroll
            for (int m = 0; m < 4; ++m) { const int rl = ai * 128 + wr * 64 + m * 16 + fr; bf16* rowp = Y + (size_t)(u.pm * 256 + rl) * DM + col0;
                if (rl < nvalid) {
#pragma unroll
                    for (int bj = 0; bj < 2; ++bj) { const pg8::f32x4 v0 = acc[ai][bj][m][0], v1 = acc[ai][bj][m][1];
                        v4u w; w.x = pk2(v0[0], v0[1]); w.y = pk2(v0[2], v0[3]); w.z = pk2(v1[0], v1[1]); w.w = pk2(v1[2], v1[3]); *(v4u*)(rowp + bj * 128) = w; } } }
    }
};
struct P8Row { v4u h[4], a[4], b[4]; };
__device__ __forceinline__ void p8_load(P8Row& r, const bf16* HB, const bf16* Y, const LAS int* T, int4 ti, int t, int lane) {
    const size_t s0 = (size_t)T[TBL_TSTART + ti.x] * 256 + ti.y, s1 = (size_t)T[TBL_TSTART + ti.z] * 256 + ti.w;
    const v4u* hp = (const v4u*)(HB + (size_t)t * DM) + lane; const v4u* y0 = (const v4u*)(Y + s0 * DM) + lane; const v4u* y1 = (const v4u*)(Y + s1 * DM) + lane;
#pragma unroll
    for (int j = 0; j < 4; ++j) { r.h[j] = __builtin_nontemporal_load(hp + 64 * j); r.a[j] = __builtin_nontemporal_load(y0 + 64 * j); r.b[j] = __builtin_nontemporal_load(y1 + 64 * j); }
}
__device__ __forceinline__ void p8_combine(Frame& F) {
    const LAS int* T = (const LAS int*)(F.lds + TBL_OFF);
    const int gw = F.vcu * NWAVES + F.wave, NGW = F.G * NWAVES;
    const bf16* Y = (const bf16*)(F.ws + WS_Y); const bf16* HB = (const bf16*)(F.ws + WS_HB); const int* TOKINFO = (const int*)(F.ws + WS_TOKINFO);
    constexpr int RPW = 8;
    int4 ti[RPW];
#pragma unroll
    for (int k = 0; k < RPW; ++k) { const int t = gw + k * NGW; ti[k] = (t < NTOK) ? *(const int4*)(TOKINFO + 4 * t) : make_int4(0, 0, 0, 0); }
    P8Row cur; if (gw < NTOK) p8_load(cur, HB, Y, T, ti[0], gw, F.lane);
#pragma unroll
    for (int k = 0; k < RPW; ++k) {
        const int t = gw + k * NGW; if (t >= NTOK) break;
        P8Row nxt; const int tn = t + NGW;
        if (k + 1 < RPW && tn < NTOK) p8_load(nxt, HB, Y, T, ti[k + 1 < RPW ? k + 1 : k], tn, F.lane);
        f32x4* od = (f32x4*)(F.out + (size_t)t * DM) + 2 * F.lane;
#pragma unroll
        for (int j = 0; j < 4; ++j) {
            const v4u h = cur.h[j], a = cur.a[j], b = cur.b[j]; f32x4 v0, v1;
            v0[0] = bf_lo(h.x) + bf_lo(a.x) + bf_lo(b.x); v0[1] = bf_hi(h.x) + bf_hi(a.x) + bf_hi(b.x); v0[2] = bf_lo(h.y) + bf_lo(a.y) + bf_lo(b.y); v0[3] = bf_hi(h.y) + bf_hi(a.y) + bf_hi(b.y);
            v1[0] = bf_lo(h.z) + bf_lo(a.z) + bf_lo(b.z); v1[1] = bf_hi(h.z) + bf_hi(a.z) + bf_hi(b.z); v1[2] = bf_lo(h.w) + bf_lo(a.w) + bf_lo(b.w); v1[3] = bf_hi(h.w) + bf_hi(a.w) + bf_hi(b.w);
            od[128 * j] = v0; od[128 * j + 1] = v1;
        }
        cur = nxt;
    }
    for (int t = gw + RPW * NGW; t < NTOK; t += NGW) {
        const int4 tj = *(const int4*)(TOKINFO + 4 * t); P8Row r; p8_load(r, HB, Y, T, tj, t, F.lane);
        f32x4* od = (f32x4*)(F.out + (size_t)t * DM) + 2 * F.lane;
#pragma unroll
        for (int j = 0; j < 4; ++j) {
            const v4u h = r.h[j], a = r.a[j], b = r.b[j]; f32x4 v0, v1;
            v0[0] = bf_lo(h.x) + bf_lo(a.x) + bf_lo(b.x); v0[1] = bf_hi(h.x) + bf_hi(a.x) + bf_hi(b.x); v0[2] = bf_lo(h.y) + bf_lo(a.y) + bf_lo(b.y); v0[3] = bf_hi(h.y) + bf_hi(a.y) + bf_hi(b.y);
            v1[0] = bf_lo(h.z) + bf_lo(a.z) + bf_lo(b.z); v1[1] = bf_hi(h.z) + bf_hi(a.z) + bf_hi(b.z); v1[2] = bf_lo(h.w) + bf_lo(a.w) + bf_lo(b.w); v1[3] = bf_hi(h.w) + bf_hi(a.w) + bf_hi(b.w);
            od[128 * j] = v0; od[128 * j + 1] = v1;
        }
    }
}

__global__ void __launch_bounds__(NWAVES * 64, 2) mk_fwd(Args args) {
    extern __shared__ __attribute__((aligned(16))) unsigned char lds[];
    Frame F;
    F.lds = (LAS unsigned char*)lds; F.ws = args.ws; F.ctl = (unsigned*)(args.ws + WS_CTL);
    F.tid = threadIdx.x; F.lane = F.tid & 63; F.wave = __builtin_amdgcn_readfirstlane(F.tid >> 6);
    F.G = gridDim.x; { const int bx = blockIdx.x; F.vcu = (F.G % 8 == 0) ? (bx % 8) * (F.G / 8) + bx / 8 : bx; }
    F.in = args.in; F.out = args.out;
    volatile LAS unsigned* MISC = (volatile LAS unsigned*)(F.lds + MISC_OFF);
    if (F.tid < 64) MISC[F.tid] = 0u;
    __syncthreads();
    const int lo = args.ph_lo, hi = args.ph_hi;
    const bool use_bar = (hi - lo) > 1;
    XcdBarrier bar; bar.bar = F.ctl + CW_BAR + args.li * XCD_BAR_WORDS; bar.x = 0; bar.st = nullptr;
    if (use_bar) bar = xcd_barrier_post(F.ctl + CW_BAR + args.li * XCD_BAR_WORDS, MISC + 8);
#define IN(k) (lo <= (k) && (k) < hi)
#define SEAM(k) do { if (IN(k) && (IN((k) + 1) || ((k) == 4 && IN(6)))) xcd_barrier(bar); } while (0)
    bf16* BIG = (bf16*)(F.ws + WS_BIG);

    if (IN(0)) { p0_prologue(F); SEAM(0); }
    if (IN(1)) {
        pg8::Gemm g{BIG, BIG, 0, 0, DM}; P1Order S{F.G, F.vcu};
        EpiQKV E{(bf16*)(F.ws + WS_QS), (bf16*)(F.ws + WS_KS), (bf16*)(F.ws + WS_QW), (bf16*)(F.ws + WS_KW), (bf16*)(F.ws + WS_VT), F.in[5], F.in[6]};
        pg8::gemm_phase<EpiQKV, P1Order, true, true>(F.lds + RING_OFF, g, S, E);
        {
            const int rounds = (P1_UNITS + F.G - 1) / F.G, first_idle = P1_UNITS - (rounds - 1) * F.G, nidle = F.G - first_idle;
            const int base = NITEMS - TAIL6_ITEMS - tail1_items(F.G);
            if (F.vcu >= first_idle) conv_range(F, base + (F.vcu - first_idle) * NWAVES + F.wave, nidle * NWAVES, NITEMS - TAIL6_ITEMS);
        }
        SEAM(1);
    }
    if (IN(2)) { p2_attention(F); SEAM(2); }
    if (IN(3)) {
        pg8::Gemm g{(const bf16*)(F.ws + WS_MIXED), (const bf16*)(F.ws + WS_WOUT), NTOK, DM, DM}; pg8::StaticOrder S; S.init(NTOK, DM, F.G, (int)blockIdx.x);
        LAS float* RS = (LAS float*)(F.lds + ATT_TBR_OFF);
        {   const float* SSQ = (const float*)(F.ws + WS_SSQ);
            for (int i = 0; i < 4; ++i) { pg8::Unit u; if (!S.next(i, u)) break;
                if (F.tid < 256) { const pg8::f32x4* q = (const pg8::f32x4*)(SSQ + (size_t)(u.pm * 256 + F.tid) * 16); const pg8::f32x4 a = q[0], b = q[1], c = q[2], d = q[3];
                    float sb = 0.f, sw = 0.f;
#pragma unroll
                    for (int q_ = 0; q_ < ATT_WAVES; ++q_) { sb += (q_ < 4 ? a[q_ & 3] : b[q_ & 3]); sw += (q_ < 4 ? c[q_ & 3] : d[q_ & 3]); }
                    RS[(i * 256 + F.tid) * 2] = 1.0f / sqrtf(sb * (1.0f / 1024.0f) + RMS_EPS); RS[(i * 256 + F.tid) * 2 + 1] = 1.0f / sqrtf(sw * (1.0f / 1024.0f) + RMS_EPS);
                    RS[2048 + i * 256 + F.tid] = ((const float*)(F.ws + WS_RINV))[u.pm * 256 + F.tid]; } }
            __syncthreads(); }
        EpiRes E{(bf16*)(F.ws + WS_HB), RS, (const bf16*)(F.ws + WS_BIG), 0};
        pg8::gemm_phase<EpiRes, pg8::StaticOrder, true, true>(F.lds + RING_OFF, g, S, E);
        SEAM(3);
    }
    if (IN(4)) { p4_router(F); SEAM(4); }
    if (IN(5) || IN(6) || IN(7) || IN(8)) build_tables(F);
    if (IN(6)) {
        pg8::Gemm g{(const bf16*)(F.ws + WS_HB), (const bf16*)(F.ws + WS_WGU), 0, 0, DM}; MoeOrder S{(const LAS int*)(F.lds + TBL_OFF), 4, F.G, F.vcu};
        MoeGather GA{(const int*)(F.ws + WS_LIST), (const LAS int*)(F.lds + TBL_OFF), (LAS int*)(F.lds + TOKBUF_OFF), 4, (const float*)(F.ws + WS_RSTDW), (const float*)(F.ws + WS_GATEW)};
        EpiSwiGLU E{(bf16*)(F.ws + WS_HDN), (const LAS float*)(F.lds + TOKBUF_OFF + 2048), (const LAS int*)(F.lds + TBL_OFF), 0};
        pg8::gemm_phase_g<EpiSwiGLU, MoeOrder>(F.lds + RING_OFF, g, S, E, GA);
        {
            const int units = S.T[TBL_NT] * 4, rounds = (units + F.G - 1) / F.G, first_idle = units - (rounds - 1) * F.G, nidle = F.G - first_idle;
            const int base = NITEMS - TAIL6_ITEMS; int mid = base + nidle * NWAVES * TAIL6_PER_WAVE; if (mid > NITEMS) mid = NITEMS;
            if (nidle > 0 && F.vcu >= first_idle) conv_range(F, base + (F.vcu - first_idle) * NWAVES + F.wave, nidle * NWAVES, mid);
            conv_range(F, mid + F.vcu * NWAVES + F.wave, F.G * NWAVES, NITEMS);
        }
        SEAM(6);
    }
    if (IN(7)) {
        pg8::Gemm g{(const bf16*)(F.ws + WS_HDN), (const bf16*)(F.ws + WS_WD), 0, 0, DEXP}; MoeOrder S{(const LAS int*)(F.lds + TBL_OFF), 8, F.G, F.vcu};
        EpiY E{(bf16*)(F.ws + WS_Y), (const LAS int*)(F.lds + TBL_OFF)};
        pg8::gemm_phase<EpiY, MoeOrder, true, true>(F.lds + RING_OFF, g, S, E);
        SEAM(7);
    }
    if (IN(8)) p8_combine(F);
#undef IN
#undef SEAM
}

extern "C" void kernel_launch(void* const* d_in, const int* in_sizes, int n_in, void* d_out, int out_size, void* d_ws, size_t ws_size, hipStream_t stream) {
    static int grid = 0;
    if (grid == 0) {
        if (n_in != 19 || out_size != NTOK * DM || ws_size < WS_END) { fprintf(stderr, "kernel_launch: unexpected shapes (n_in %d out %d ws %zu)\n", n_in, out_size, ws_size); grid = -1; return; }
        int dev = 0, cus = 0, per_cu = 0;
        if (hipGetDevice(&dev) != hipSuccess || hipDeviceGetAttribute(&cus, hipDeviceAttributeMultiprocessorCount, dev) != hipSuccess) { grid = -1; return; }
        if (hipFuncSetAttribute((const void*)mk_fwd, hipFuncAttributeMaxDynamicSharedMemorySize, LDS_BYTES) != hipSuccess) { fprintf(stderr, "kernel_launch: hipFuncSetAttribute failed\n"); grid = -1; return; }
        if (hipOccupancyMaxActiveBlocksPerMultiprocessor(&per_cu, (const void*)mk_fwd, NWAVES * 64, LDS_BYTES) != hipSuccess || per_cu < 1) { fprintf(stderr, "kernel_launch: occupancy query reports %d\n", per_cu); }
        (void)hipGetLastError();
        grid = cus;
    }
    if (grid < 0) return;
    (void)hipMemsetAsync((char*)d_ws + WS_CTL, 0, CTL_ZERO_BYTES, stream);
    Args a{};
    for (int i = 0; i < 19; ++i) a.in[i] = (const float*)d_in[i];
    a.out = (float*)d_out; a.ws = (unsigned char*)d_ws;
#if MK_N_LAUNCHES == 1
    a.ph_lo = 0; a.ph_hi = N_PHASES; a.li = 0;
    hipLaunchKernelGGL(mk_fwd, dim3(grid), dim3(NWAVES * 64), LDS_BYTES, stream, a);
#else
    a.li = 0;
    for (int p = 0; p < N_PHASES; ++p) { a.ph_lo = p; a.ph_hi = p + 1; hipLaunchKernelGGL(mk_fwd, dim3(grid), dim3(NWAVES * 64), LDS_BYTES, stream, a); }
#endif
}
```

```cpp
#include <hip/hip_runtime.h>
#include <cstdio>
#include <cstdint>
namespace pg8 {
#define PG8_LAS __attribute__((address_space(3)))
typedef unsigned short bf16_t;
typedef short bf16x8 __attribute__((ext_vector_type(8)));
typedef float f32x4 __attribute__((ext_vector_type(4)));
typedef unsigned u32x4 __attribute__((ext_vector_type(4)));
constexpr int BM = 256, BK = 64, HALF = 128, HTB = HALF * BK * 2  , STAGE_BYTES = 8 * HTB, NXCD = 8, WGM = 8;

__host__ __device__ __forceinline__ int lds_byte(int r, int c) { const int st = (r >> 4) * 2 + (c >> 5), rr = r & 15, cc = c & 31, ob = rr * 64 + cc * 2; return st * 1024 + (ob ^ (((ob >> 9) & 1) << 5)); }
__host__ __device__ __forceinline__ void stage_rc(int b, int& R, int& C) { const int st = b / 1024, sb = b % 1024, swz = sb ^ (((sb >> 9) & 1) << 5); R = (st >> 1) * 16 + swz / 64; C = (st & 1) * 32 + (swz % 64) / 2; }
__host__ __device__ __forceinline__ int perm32(int rho) { const int n = rho >> 4, i = rho & 15; return 8 * (i >> 2) + 4 * n + (i & 3); }

struct Unit { int pm, pn; };
struct Gemm { const bf16_t* A; const bf16_t* Bt; int M, N, K; };

struct StaticOrder {
    int nM, nN, nwg, G, c;
    __host__ __device__ void init(int M, int N, int G_, int c_) { nM = M / BM; nN = N / BM; nwg = nM * nN; G = G_; c = c_; }
    __host__ __device__ bool next(int i, Unit& u) const {
        const long L = (long)i * G + c; if (L >= nwg) return false;
        int wgid = (int)L; { const int q = nwg / NXCD, r = nwg % NXCD, xcd = wgid % NXCD, off = wgid / NXCD; wgid = (xcd < r ? xcd * (q + 1) : r * (q + 1) + (xcd - r) * q) + off; }
        const int nig = WGM * nN, gid = wgid / nig, fm = gid * WGM, gsz = (nM - fm) < WGM ? (nM - fm) : WGM;
        u.pm = fm + ((wgid % nig) % gsz); u.pn = (wgid % nig) / gsz; return true;
    }
    __device__ __forceinline__ void a_ready(const Unit&) const {}
    __device__ __forceinline__ void done(const Unit&) const {}
};

__device__ __forceinline__ unsigned cvt_pk_bf16(float lo, float hi) { unsigned r; asm volatile("v_cvt_pk_bf16_f32 %0, %1, %2" : "=v"(r) : "v"(lo), "v"(hi)); return r; }
typedef float f32x2 __attribute__((ext_vector_type(2)));
__device__ __forceinline__ f32x2 gelu_pk(f32x2 v) {
    const f32x2 av = __builtin_elementwise_abs(v), d = av * 0.2316418882f + 1.0f;
    f32x2 t; t.x = __builtin_amdgcn_rcpf(d.x); t.y = __builtin_amdgcn_rcpf(d.y);
    f32x2 q = t * 0.5307027145f + (-0.7265760135f); q = q * t + 0.7107068705f; q = q * t + (-0.142248368f); q = q * t + 0.127414796f; q = q * t;
    const f32x2 s = (v * v) * (-0.72134752044f);
    f32x2 e; e.x = __builtin_amdgcn_exp2f(s.x); e.y = __builtin_amdgcn_exp2f(s.y);
    const f32x2 m = v * (q * e), r = v - m;
    f32x2 o; o.x = v.x < 0.f ? m.x : r.x; o.y = v.y < 0.f ? m.y : r.y; return o;
}

template <int ACT  > struct EpiBf16 {
    static constexpr bool PERM = true, AFTER_DRAIN = false; static_assert(ACT == 0 || ACT == 1, "EpiBf16: ACT is 0 (none) or 1 (gelu_pk)");
    bf16_t* O; int ldc; const float* bias; int split_cols; size_t split_stride; float scale0;
    __device__ __forceinline__ void operator()(const f32x4 (&acc)[2][2][4][2], const Unit& u, int wr, int wc, int fr, int fq) const {
        const int row0 = u.pm * BM + wr * 64 + fr; int colt = u.pn * BM; bf16_t* base = O;
        float sc = 1.f; if (split_cols) { const int t = colt / split_cols; base += (size_t)t * split_stride; colt -= t * split_cols; if (t == 0) sc = scale0; }
        const int col0 = colt + wc * 32 + 8 * fq, bcol0 = u.pn * BM + wc * 32 + 8 * fq;
        f32x4 bv[2][2];
#pragma unroll
        for (int bj = 0; bj < 2; ++bj)
#pragma unroll
            for (int n = 0; n < 2; ++n) bv[bj][n] = bias ? *(const f32x4*)(bias + bcol0 + bj * HALF + 4 * n) : (f32x4){0.f, 0.f, 0.f, 0.f};
#pragma unroll
        for (int ai = 0; ai < 2; ++ai)
#pragma unroll
            for (int m = 0; m < 4; ++m) { bf16_t* rowp = base + (size_t)(row0 + ai * HALF + m * 16) * ldc + col0;
#pragma unroll
                for (int bj = 0; bj < 2; ++bj) { f32x4 v0 = acc[ai][bj][m][0] + bv[bj][0], v1 = acc[ai][bj][m][1] + bv[bj][1];
                    if (ACT == 1) { f32x2 a = gelu_pk((f32x2){v0[0], v0[1]}), b = gelu_pk((f32x2){v0[2], v0[3]}), c = gelu_pk((f32x2){v1[0], v1[1]}), d = gelu_pk((f32x2){v1[2], v1[3]});
                        v0 = (f32x4){a.x, a.y, b.x, b.y}; v1 = (f32x4){c.x, c.y, d.x, d.y}; }
                    v0 = v0 * sc; v1 = v1 * sc; u32x4 w; w.x = cvt_pk_bf16(v0[0], v0[1]); w.y = cvt_pk_bf16(v0[2], v0[3]); w.z = cvt_pk_bf16(v1[0], v1[1]); w.w = cvt_pk_bf16(v1[2], v1[3]);
                    *(u32x4*)(rowp + bj * HALF) = w; } }
    }
};

struct PanelStats {
    unsigned* xbuf;
    unsigned* cnt;
    unsigned* tmo;
    int ntn; float eps;
    unsigned code;
    __device__ __forceinline__ bool run(const f32x4 (&v)[2][2][4][2], const Unit& u, int wr, int wc, int fr, int fq, PG8_LAS unsigned char* lds, int wid, int lane) const {
        typedef float f32x2v __attribute__((ext_vector_type(2)));
        PG8_LAS f32x2v* P = (PG8_LAS f32x2v*)lds;
        PG8_LAS f32x2v* S = (PG8_LAS f32x2v*)(lds + 8192);
        PG8_LAS unsigned* flag = (PG8_LAS unsigned*)(lds + 8192 + 2048);
#pragma unroll
        for (int ai = 0; ai < 2; ++ai)
#pragma unroll
            for (int m = 0; m < 4; ++m) {
                float s = 0.f;
#pragma unroll
                for (int bj = 0; bj < 2; ++bj)
#pragma unroll
                    for (int n = 0; n < 2; ++n) { const f32x4 x = v[ai][bj][m][n]; s += (x[0] + x[1]) + (x[2] + x[3]); }
                s += __shfl_xor(s, 16); s += __shfl_xor(s, 32);
                const float mw = s * (1.0f / 64.0f); float q = 0.f;
#pragma unroll
                for (int bj = 0; bj < 2; ++bj)
#pragma unroll
                    for (int n = 0; n < 2; ++n) { const f32x4 d = v[ai][bj][m][n] - mw; q += (d[0] * d[0] + d[1] * d[1]) + (d[2] * d[2] + d[3] * d[3]); }
                q += __shfl_xor(q, 16); q += __shfl_xor(q, 32);
                if (fq == 0) P[(ai * HALF + wr * 64 + m * 16 + fr) * 4 + wc] = (f32x2v){mw, q};
            }
        asm volatile("s_waitcnt lgkmcnt(0)" ::: "memory"); __builtin_amdgcn_s_barrier(); asm volatile("" ::: "memory");
#if defined(BROKEN_EXCHANGE_NO_WAIT)
#warning BROKEN CONTROL BUILD: the row-statistics exchange does not wait; results are wrong by design
        if (blockIdx.x >= 64) { const long long t0_ = clock64(); while (clock64() - t0_ < 60000) __builtin_amdgcn_s_sleep(8); }
#endif
        const int row = wid * 32 + (lane & 31);
        if (lane < 32) {
            const f32x2v a = P[row * 4 + 0], b = P[row * 4 + 1], c = P[row * 4 + 2], d = P[row * 4 + 3];
            const float mt = (a.x + b.x + c.x + d.x) * 0.25f;
            const float da = a.x - mt, db = b.x - mt, dc = c.x - mt, dd = d.x - mt;
            const float m2 = (a.y + b.y) + (c.y + d.y) + 64.0f * ((da * da + db * db) + (dc * dc + dd * dd));
            unsigned long long* slot = (unsigned long long*)xbuf + ((size_t)(u.pm * BM + row) * 4 + u.pn);
            __hip_atomic_store(slot, ((unsigned long long)__float_as_uint(m2) << 32) | __float_as_uint(mt), __ATOMIC_RELAXED, __HIP_MEMORY_SCOPE_AGENT);
        }
        asm volatile("s_waitcnt vmcnt(0)" ::: "memory");
        if (lane == 0) __hip_atomic_fetch_add(cnt + 64 * u.pm, 1u, __ATOMIC_RELAXED, __HIP_MEMORY_SCOPE_AGENT);
        if (wid == 0) {
            bool dead = false; const unsigned long long t0 = __builtin_amdgcn_s_memrealtime(); const unsigned want = 8u * (unsigned)ntn;
            for (;;) {
#if defined(BROKEN_EXCHANGE_NO_WAIT)
                break;
#endif
                if ((unsigned)__builtin_amdgcn_readfirstlane(__hip_atomic_load(cnt + 64 * u.pm, __ATOMIC_RELAXED, __HIP_MEMORY_SCOPE_AGENT)) >= want) break;
                if (__builtin_amdgcn_s_memrealtime() - t0 > 2000000ull) {
                    if (lane == 0) { unsigned expect = 0u; __hip_atomic_compare_exchange_strong(tmo + 1, &expect, code | (unsigned)(u.pm & 0xff), __ATOMIC_RELAXED, __ATOMIC_RELAXED, __HIP_MEMORY_SCOPE_AGENT);
                                     __hip_atomic_store(tmo, 1u, __ATOMIC_RELAXED, __HIP_MEMORY_SCOPE_AGENT); }
                    dead = true; break; }
                __builtin_amdgcn_s_sleep(2);
            }
            __builtin_amdgcn_fence(__ATOMIC_ACQUIRE, "agent");
            if (lane == 0) flag[0] = dead ? 1u : 0u;
        }
        asm volatile("s_waitcnt vmcnt(0) lgkmcnt(0)" ::: "memory"); __builtin_amdgcn_s_barrier(); asm volatile("" ::: "memory");
        const bool bad = flag[0] != 0u;
        if (lane < 32) {
            const unsigned long long* slot = (const unsigned long long*)xbuf + (size_t)(u.pm * BM + row) * 4; float mt[4], m2[4]; float ms = 0.f;
#pragma unroll
            for (int t = 0; t < 4; ++t) { if (t < ntn) { const unsigned long long w = __hip_atomic_load(slot + t, __ATOMIC_RELAXED, __HIP_MEMORY_SCOPE_AGENT); mt[t] = __uint_as_float((unsigned)w); m2[t] = __uint_as_float((unsigned)(w >> 32)); } else { mt[t] = 0.f; m2[t] = 0.f; } ms += mt[t]; }
            const float mean = ms / (float)ntn; float q = 0.f;
#pragma unroll
            for (int t = 0; t < 4; ++t) if (t < ntn) { const float dm = mt[t] - mean; q += m2[t] + 256.0f * dm * dm; }
            S[row] = (f32x2v){mean, 1.0f / sqrtf(q / (256.0f * (float)ntn) + eps)};
        }
        asm volatile("s_waitcnt lgkmcnt(0)" ::: "memory"); __builtin_amdgcn_s_barrier(); asm volatile("" ::: "memory");
        return bad;
    }
};
struct EpiLnRes {
    static constexpr bool PERM = false, AFTER_DRAIN = true;
    const float* base; float* out; int ldc; const float* bias; PanelStats st; unsigned poison;
    __device__ __forceinline__ void fused(f32x4 (&acc)[2][2][4][2], const Unit& u, int wr, int wc, int fr, int fq, PG8_LAS unsigned char* lds, int wid, int lane) const {
        typedef float f32x2v __attribute__((ext_vector_type(2)));
        const PG8_LAS f32x2v* S = (const PG8_LAS f32x2v*)(lds + 8192);
        const int col0 = u.pn * BM + wc * 32 + 4 * fq;
#pragma unroll
        for (int bj = 0; bj < 2; ++bj)
#pragma unroll
            for (int n = 0; n < 2; ++n) { const f32x4 bv = bias ? *(const f32x4*)(bias + col0 + bj * HALF + n * 16) : (f32x4){0.f, 0.f, 0.f, 0.f};
#pragma unroll
                for (int ai = 0; ai < 2; ++ai)
#pragma unroll
                    for (int m = 0; m < 4; ++m) acc[ai][bj][m][n] += bv; }
        f32x4 pre[4][2][2];
#pragma unroll
        for (int m = 0; m < 4; ++m) { const size_t off = (size_t)(u.pm * BM + wr * 64 + m * 16 + fr) * ldc + col0;
#pragma unroll
            for (int bj = 0; bj < 2; ++bj)
#pragma unroll
                for (int n = 0; n < 2; ++n) pre[m][bj][n] = *(const f32x4*)(base + off + bj * HALF + n * 16); }
        const bool bad = st.run(acc, u, wr, wc, fr, fq, lds, wid, lane) || poison != 0u;
        const float qnan = __builtin_nanf("");
#pragma unroll
        for (int ai = 0; ai < 2; ++ai)
#pragma unroll
            for (int m = 0; m < 4; ++m) { const int r = ai * HALF + wr * 64 + m * 16 + fr; const f32x2v sr = S[r]; const size_t off = (size_t)(u.pm * BM + r) * ldc + col0;
#pragma unroll
                for (int bj = 0; bj < 2; ++bj)
#pragma unroll
                    for (int n = 0; n < 2; ++n) { const f32x4 bs = ai == 0 ? pre[m][bj][n] : *(const f32x4*)(base + off + bj * HALF + n * 16); f32x4 o = bs + (acc[ai][bj][m][n] - sr.x) * sr.y;
                        if (bad) o = (f32x4){qnan, qnan, qnan, qnan}; *(f32x4*)(out + off + bj * HALF + n * 16) = o; }
                if (m & 1) asm volatile("" ::: "memory"); }
    }
};
struct EpiLnResLn {
    static constexpr bool PERM = false, AFTER_DRAIN = true;
    const float* base; float* out; bf16_t* xn; int ldc; const float* bias; PanelStats st1, st2; unsigned poison;
    __device__ __forceinline__ void fused(f32x4 (&acc)[2][2][4][2], const Unit& u, int wr, int wc, int fr, int fq, PG8_LAS unsigned char* lds, int wid, int lane) const {
        typedef float f32x2v __attribute__((ext_vector_type(2))); typedef unsigned u32x2v __attribute__((ext_vector_type(2)));
        const PG8_LAS f32x2v* S = (const PG8_LAS f32x2v*)(lds + 8192);
        const int col0 = u.pn * BM + wc * 32 + 4 * fq;
#pragma unroll
        for (int bj = 0; bj < 2; ++bj)
#pragma unroll
            for (int n = 0; n < 2; ++n) { const f32x4 bv = bias ? *(const f32x4*)(bias + col0 + bj * HALF + n * 16) : (f32x4){0.f, 0.f, 0.f, 0.f};
#pragma unroll
                for (int ai = 0; ai < 2; ++ai)
#pragma unroll
                    for (int m = 0; m < 4; ++m) acc[ai][bj][m][n] += bv; }
        bool bad = st1.run(acc, u, wr, wc, fr, fq, lds, wid, lane) || poison != 0u;
        const float qnan = __builtin_nanf("");
#pragma unroll
        for (int ai = 0; ai < 2; ++ai)
#pragma unroll
            for (int m = 0; m < 4; ++m) { const int r = ai * HALF + wr * 64 + m * 16 + fr; const f32x2v sr = S[r]; const size_t off = (size_t)(u.pm * BM + r) * ldc + col0;
#pragma unroll
                for (int bj = 0; bj < 2; ++bj)
#pragma unroll
                    for (int n = 0; n < 2; ++n) { const f32x4 bs = *(const f32x4*)(base + off + bj * HALF + n * 16); acc[ai][bj][m][n] = bs + (acc[ai][bj][m][n] - sr.x) * sr.y; }
                asm volatile("" : "+v"(acc[ai][0][m][0]), "+v"(acc[ai][0][m][1]), "+v"(acc[ai][1][m][0]), "+v"(acc[ai][1][m][1]));
                if (m & 1) asm volatile("" ::: "memory"); }
        const bool bad1 = bad;
        bad = st2.run(acc, u, wr, wc, fr, fq, lds, wid, lane) || bad;
#pragma unroll
        for (int ai = 0; ai < 2; ++ai)
#pragma unroll
            for (int m = 0; m < 4; ++m) { const int r = ai * HALF + wr * 64 + m * 16 + fr; const f32x2v sr = S[r]; const size_t off = (size_t)(u.pm * BM + r) * ldc + col0;
#pragma unroll
                for (int bj = 0; bj < 2; ++bj)
#pragma unroll
                    for (int n = 0; n < 2; ++n) { const f32x4 x1 = acc[ai][bj][m][n]; *(f32x4*)(out + off + bj * HALF + n * 16) = bad1 ? (f32x4){qnan, qnan, qnan, qnan} : x1;
                        const f32x4 o = (x1 - sr.x) * sr.y; u32x2v w; w.x = cvt_pk_bf16(o[0], o[1]); w.y = cvt_pk_bf16(o[2], o[3]);
                        if (bad) { w.x = 0x7fc07fc0u; w.y = 0x7fc07fc0u; } *(u32x2v*)(xn + off + bj * HALF + n * 16) = w; }
                asm volatile("" ::: "memory"); }
    }
};

template <class Epi, class Sched, bool ALIGN_EPI = false, bool SP2 = false>
__device__ __forceinline__ void gemm_phase(PG8_LAS unsigned char* lds, const Gemm g, const Sched& S, const Epi& E) {
    const int tid = threadIdx.x, wid = __builtin_amdgcn_readfirstlane(tid >> 6), lane = tid & 63, wr = wid >> 2, wc = wid & 3, fr = lane & 15, fq = lane >> 4;
    const int K = g.K, nt = K / BK;
    unsigned voffA[2], voffB[2];
#pragma unroll
    for (int i = 0; i < 2; ++i) { int R, C; stage_rc(tid * 16 + i * 8192, R, C); const int Rb = Epi::PERM ? ((R & ~31) + perm32(R & 31)) : R;
        voffA[i] = (unsigned)(R * K + C) * 2u; voffB[i] = (unsigned)(Rb * K + C) * 2u; }
    const size_t kstep = (size_t)(BK * 2);
    const size_t hstep = (size_t)HALF * K * 2;
    const size_t tstep = 2 * hstep;
    const unsigned ldsw = (unsigned)wid * 1024u;
    const int aoff = lds_byte(wr * 64 + fr, fq * 8), boff = lds_byte(wc * 32 + fr, fq * 8);
#define PG8_SA(b, h) (((b) * 2 + (h)) * HTB)
#define PG8_SB(b, h) ((4 + (b) * 2 + (h)) * HTB)
#define PG8_STAGE(bufoff, gbase, voff) do { _Pragma("unroll") for (int _i = 0; _i < 2; ++_i) \
        __builtin_amdgcn_global_load_lds((const unsigned*)((const char*)(gbase) + (voff)[_i]), (PG8_LAS unsigned*)(lds + (bufoff) + ldsw + _i * 8192), 16, 0, 0); } while (0)
#define PG8_LDA(dst, b, h) do { _Pragma("unroll") for (int m = 0; m < 4; ++m) _Pragma("unroll") for (int k = 0; k < 2; ++k) dst[m][k] = *(const PG8_LAS bf16x8*)(lds + PG8_SA(b, h) + aoff + m * 2048 + k * 1024); } while (0)
#define PG8_LDB(dst, b, h) do { _Pragma("unroll") for (int n = 0; n < 2; ++n) _Pragma("unroll") for (int k = 0; k < 2; ++k) dst[n][k] = *(const PG8_LAS bf16x8*)(lds + PG8_SB(b, h) + boff + n * 2048 + k * 1024); } while (0)
#define PG8_MMA(ai, bj, At, Bt) do { __builtin_amdgcn_s_setprio(1); _Pragma("unroll") for (int m = 0; m < 4; ++m) _Pragma("unroll") for (int n = 0; n < 2; ++n) _Pragma("unroll") for (int k = 0; k < 2; ++k) \
        acc[ai][bj][m][n] = __builtin_amdgcn_mfma_f32_16x16x32_bf16(Bt[n][k], At[m][k], acc[ai][bj][m][n], 0, 0, 0); __builtin_amdgcn_s_setprio(0); } while (0)
#define PG8_WAIT_V(n) asm volatile("s_waitcnt vmcnt(" #n ")" ::: "memory")
#define PG8_WAIT_L(n) asm volatile("s_waitcnt lgkmcnt(" #n ")" ::: "memory")
#define PG8_BAR __builtin_amdgcn_s_barrier()
#define PG8_SCHED __builtin_amdgcn_sched_barrier(0)
    Unit cur, nxt; int ui = 0;
    if (!S.next(0, cur)) return;
    f32x4 acc[2][2][4][2];
#pragma unroll
    for (int a = 0; a < 2; ++a)
#pragma unroll
        for (int b = 0; b < 2; ++b)
#pragma unroll
            for (int m = 0; m < 4; ++m)
#pragma unroll
                for (int n = 0; n < 2; ++n) acc[a][b][m][n] = (f32x4){0.f, 0.f, 0.f, 0.f};
    bf16x8 At[4][2], B0[2][2], B1[2][2];
    const char* cA = (const char*)g.A + (size_t)cur.pm * tstep; const char* cB = (const char*)g.Bt + (size_t)cur.pn * tstep;
    S.a_ready(cur);
    if constexpr (SP2) {
        PG8_STAGE(PG8_SB(0, 0), cB, voffB); PG8_STAGE(PG8_SB(0, 1), cB + hstep, voffB); PG8_STAGE(PG8_SA(0, 0), cA, voffA); PG8_STAGE(PG8_SA(0, 1), cA + hstep, voffA);
        if (wr == 1) PG8_BAR;
        PG8_WAIT_V(2); PG8_BAR;
        PG8_STAGE(PG8_SB(1, 0), cB + kstep, voffB); PG8_STAGE(PG8_SA(1, 0), cA + kstep, voffA); PG8_STAGE(PG8_SB(1, 1), cB + hstep + kstep, voffB);
        PG8_WAIT_V(6); PG8_BAR;
    } else {
        PG8_STAGE(PG8_SB(0, 0), cB, voffB); PG8_STAGE(PG8_SA(0, 0), cA, voffA); PG8_STAGE(PG8_SB(0, 1), cB + hstep, voffB); PG8_STAGE(PG8_SA(0, 1), cA + hstep, voffA);
        if (wr == 1) PG8_BAR;
        PG8_WAIT_V(4); PG8_BAR;
        PG8_STAGE(PG8_SB(1, 0), cB + kstep, voffB); PG8_STAGE(PG8_SA(1, 0), cA + kstep, voffA); PG8_STAGE(PG8_SB(1, 1), cB + hstep + kstep, voffB);
        PG8_WAIT_V(6); PG8_BAR;
    }
    int t_mid = nt >> 1; if constexpr (Epi::MIDK) asm volatile("" : "+s"(t_mid));
    for (;;) {
        const bool has_next = S.next(ui + 1, nxt);
        const char* nA = has_next ? (const char*)g.A + (size_t)nxt.pm * tstep : cA; const char* nB = has_next ? (const char*)g.Bt + (size_t)nxt.pn * tstep : cB;
        for (int t = 0; t < nt; t += 2) {
            const bool last = (t == nt - 2);
            if constexpr (Epi::MIDK) { if (t == t_mid) E.midk(acc, cur, wr, fr); }
            const char* a1 = cA + (size_t)(t + 1) * kstep;
            const char* a2 = last ? nA : cA + (size_t)(t + 2) * kstep; const char* b2 = last ? nB : cB + (size_t)(t + 2) * kstep;
            const char* a3 = a2 + kstep; const char* b3 = b2 + kstep;
            if (last && has_next) S.a_ready(nxt);
            if constexpr (SP2) {
            PG8_LDB(B0, 0, 0); PG8_LDB(B1, 0, 1); PG8_SCHED; PG8_LDA(At, 0, 0); PG8_STAGE(PG8_SA(1, 1), a1 + hstep, voffA);
            PG8_WAIT_V(8); PG8_WAIT_L(0); PG8_BAR; PG8_MMA(0, 0, At, B0); PG8_MMA(0, 1, At, B1); PG8_BAR; PG8_SCHED;
            PG8_LDA(At, 0, 1); PG8_STAGE(PG8_SB(0, 0), b2, voffB); PG8_STAGE(PG8_SB(0, 1), b2 + hstep, voffB); PG8_STAGE(PG8_SA(0, 0), a2, voffA);
            PG8_WAIT_V(8); PG8_WAIT_L(0); PG8_BAR; PG8_MMA(1, 0, At, B0); PG8_MMA(1, 1, At, B1); PG8_BAR; PG8_SCHED;
            PG8_LDB(B0, 1, 0); PG8_LDB(B1, 1, 1); PG8_SCHED; PG8_LDA(At, 1, 0); PG8_STAGE(PG8_SA(0, 1), a2 + hstep, voffA);
            PG8_WAIT_V(8); PG8_WAIT_L(0); PG8_BAR; PG8_MMA(0, 0, At, B0); PG8_MMA(0, 1, At, B1); PG8_BAR; PG8_SCHED;
            PG8_LDA(At, 1, 1); PG8_STAGE(PG8_SB(1, 0), b3, voffB); PG8_STAGE(PG8_SB(1, 1), b3 + hstep, voffB); PG8_STAGE(PG8_SA(1, 0), a3, voffA);
            PG8_WAIT_V(8); PG8_WAIT_L(0); PG8_BAR; PG8_MMA(1, 0, At, B0); PG8_MMA(1, 1, At, B1); PG8_BAR; PG8_SCHED;
            } else {
            PG8_LDB(B0, 0, 0); PG8_SCHED; PG8_LDA(At, 0, 0); PG8_STAGE(PG8_SA(1, 1), a1 + hstep, voffA);
            PG8_WAIT_L(8); PG8_BAR; PG8_WAIT_L(0); PG8_MMA(0, 0, At, B0); PG8_BAR; PG8_SCHED;
            PG8_LDB(B1, 0, 1); PG8_STAGE(PG8_SB(0, 0), b2, voffB);
            PG8_BAR; PG8_WAIT_L(0); PG8_MMA(0, 1, At, B1); PG8_BAR;
            PG8_LDA(At, 0, 1); PG8_STAGE(PG8_SA(0, 0), a2, voffA);
            PG8_BAR; PG8_WAIT_L(0); PG8_MMA(1, 0, At, B0); PG8_BAR; PG8_SCHED;
            PG8_STAGE(PG8_SB(0, 1), b2 + hstep, voffB);
            PG8_WAIT_V(6); PG8_BAR; PG8_MMA(1, 1, At, B1); PG8_BAR;
            PG8_LDB(B0, 1, 0); PG8_SCHED; PG8_LDA(At, 1, 0); PG8_STAGE(PG8_SA(0, 1), a2 + hstep, voffA);
            PG8_WAIT_L(8); PG8_BAR; PG8_WAIT_L(0); PG8_MMA(0, 0, At, B0); PG8_BAR; PG8_SCHED;
            PG8_LDB(B1, 1, 1); PG8_STAGE(PG8_SB(1, 0), b3, voffB);
            PG8_BAR; PG8_WAIT_L(0); PG8_MMA(0, 1, At, B1); PG8_BAR;
            PG8_LDA(At, 1, 1); PG8_STAGE(PG8_SA(1, 0), a3, voffA);
            PG8_BAR; PG8_WAIT_L(0); PG8_MMA(1, 0, At, B0); PG8_BAR; PG8_SCHED;
            PG8_STAGE(PG8_SB(1, 1), b3 + hstep, voffB);
            PG8_WAIT_V(6); PG8_BAR; PG8_MMA(1, 1, At, B1); PG8_BAR;
            }
        }
        if constexpr (ALIGN_EPI) { if (wr == 0) PG8_BAR; }
        if constexpr (!Epi::AFTER_DRAIN) { E(acc, cur, wr, wc, fr, fq); S.done(cur); }
        if (!has_next) break;
#pragma unroll
        for (int a = 0; a < 2; ++a)
#pragma unroll
            for (int b = 0; b < 2; ++b)
#pragma unroll
                for (int m = 0; m < 4; ++m)
#pragma unroll
                    for (int n = 0; n < 2; ++n) acc[a][b][m][n] = (f32x4){0.f, 0.f, 0.f, 0.f};
        cur = nxt; cA = nA; cB = nB; ++ui;
        if constexpr (ALIGN_EPI) { if (wr == 1) PG8_BAR; }
    }
    PG8_WAIT_V(0);
    if constexpr (!ALIGN_EPI) { if (wr == 0) PG8_BAR; }
    PG8_BAR;
    if constexpr (Epi::AFTER_DRAIN) { E.fused(acc, cur, wr, wc, fr, fq, lds, wid, lane); S.done(cur); }
#undef PG8_SA
#undef PG8_SB
#undef PG8_STAGE
#undef PG8_LDA
#undef PG8_LDB
#undef PG8_MMA
#undef PG8_WAIT_V
#undef PG8_WAIT_L
#undef PG8_BAR
#undef PG8_SCHED
}
}


#ifndef MK_N_LAUNCHES
#define MK_N_LAUNCHES 1
#endif
constexpr int N_PHASES = 9;
constexpr int NWAVES = 8;

constexpr int DM = 2048, BATCH = 4, SEQ = 4096, NTOK = BATCH * SEQ, NMETA = 16;
constexpr int MPAD = 16640, NTILE_X = MPAD / 256;
constexpr int N_QK = 3328, NT_QK = N_QK / 256;
constexpr int N_V = 1280, NT_V = N_V / 256;
constexpr int NT_W = NT_QK + NT_V;
constexpr int P1_UNITS_A = NTILE_X * NT_QK, P1_UNITS = P1_UNITS_A + NT_V * NTILE_X;
constexpr int NEXP = 64, DEXP = 512, MAXTILES = 192, SPAD = MAXTILES * 256;
constexpr float RMS_EPS = 1e-6f;
constexpr float LOG2E = 1.4426950408889634f;
constexpr float C2 = 0.125f * LOG2E;
constexpr float SB_EXIT = -150.0f;

constexpr size_t MiB = 1u << 20;
constexpr size_t WS_CTL = 0, CTL_ZERO_BYTES = 128 * 1024;
constexpr size_t WS_BIG = 1 * MiB;
constexpr size_t WS_QS = 84 * MiB, WS_KS = WS_QS + (size_t)MPAD * 1024 * 2, WS_QW = WS_KS + (size_t)MPAD * 1024 * 2, WS_KW = WS_QW + (size_t)MPAD * 1024 * 2;
constexpr size_t WS_VT = 190 * MiB;
constexpr size_t WS_MIXED = 231 * MiB, WS_HB = 295 * MiB;
constexpr size_t WS_Y = 1 * MiB;
constexpr size_t WS_PROJ = 359 * MiB;
constexpr size_t WS_HDN = 423 * MiB;
constexpr size_t WS_WOUT = 471 * MiB, WS_WR = 479 * MiB;
constexpr size_t WS_WGU = 480 * MiB, WS_WD = 736 * MiB;
constexpr size_t WS_LIST = 864 * MiB, WS_GATEW = 868 * MiB, WS_TOKINFO = 872 * MiB, WS_RSTD = 873 * MiB, WS_RSTDW = 874 * MiB;
constexpr size_t WS_RINV = 877 * MiB;
constexpr size_t WS_SSQ = 878 * MiB;
constexpr size_t WS_END = 880 * MiB;
static_assert(WS_RSTDW + (size_t)NEXP * NTOK * 4 <= WS_END, "ws map 4");
static_assert(WS_KW + (size_t)MPAD * 256 * 2 <= WS_VT && WS_VT + (size_t)N_V * MPAD * 2 <= WS_MIXED , "ws map 1");
static_assert(WS_Y + (size_t)SPAD * 2048 * 2 <= WS_MIXED && WS_HDN + (size_t)SPAD * 512 * 2 <= WS_WOUT && WS_HB + (size_t)NTOK * 2048 * 2 <= WS_HDN, "ws map 2");
static_assert(WS_BIG + (size_t)(NTILE_X + NT_W) * 256 * 2048 * 2 <= WS_QS, "ws map 3");
constexpr int CW_TMO = 0, CW_BAR = 4096, CW_CNT = 16384;

constexpr int RING_OFF = 0, RING_BYTES = 131072;
constexpr int MISC_OFF = RING_BYTES;
constexpr int TBL_OFF = MISC_OFF + 256;
constexpr int TBL_TSTART = 0, TBL_NT = 65, TBL_TE = 66, TBL_CNTS = 66 + MAXTILES, TBL_WORDS = 66 + MAXTILES + 64;
constexpr int TOKBUF_OFF = MISC_OFF + 4096;
constexpr int ATT_TBR_OFF = TOKBUF_OFF + 6144;
constexpr int LDS_BYTES = 163840;
static_assert(TBL_OFF + TBL_WORDS * 4 <= TOKBUF_OFF && TOKBUF_OFF + 6144 <= LDS_BYTES && ATT_TBR_OFF + 16 * 192 * 4 <= LDS_BYTES, "LDS map");

#define LAS __attribute__((address_space(3)))
typedef unsigned short bf16;
typedef unsigned v4u __attribute__((ext_vector_type(4)));
typedef unsigned v2u __attribute__((ext_vector_type(2)));
typedef float f32x4 __attribute__((ext_vector_type(4)));
typedef float f32x16 __attribute__((ext_vector_type(16)));
typedef short bf16x8 __attribute__((ext_vector_type(8)));
typedef _Float16 f16x8 __attribute__((ext_vector_type(8)));
typedef _Float16 f16x2 __attribute__((ext_vector_type(2)));
typedef float f32x2 __attribute__((ext_vector_type(2)));
typedef __bf16 bf16x2_t __attribute__((ext_vector_type(2)));
#define LDS_WAIT() asm volatile("s_waitcnt lgkmcnt(0)" ::: "memory")
#define VM_WAIT() asm volatile("s_waitcnt vmcnt(0)" ::: "memory")
__device__ __forceinline__ unsigned pk2(float lo, float hi) { f32x2 v = {lo, hi}; bf16x2_t b = __builtin_convertvector(v, bf16x2_t); return __builtin_bit_cast(unsigned, b); }
__device__ __forceinline__ float bf_lo(unsigned u) { return __uint_as_float(u << 16); }
__device__ __forceinline__ float bf_hi(unsigned u) { return __uint_as_float(u & 0xffff0000u); }
__device__ __forceinline__ float wave_sum(float v) {
#pragma unroll
    for (int o = 1; o < 64; o <<= 1) v += __shfl_xor(v, o);
    return v;
}
__device__ __forceinline__ int crow(int reg, int h) { return (reg & 3) + 8 * (reg >> 2) + 4 * h; }

#define XB_TMO      128
#define XB_XCNT(j)  (256  + 64 * (j))
#define XB_XSUB(j)  (1280 + 64 * (j))
#define XB_XGEN(j)  (2304 + 64 * (j))
#define XB_TOP      3328
#define XB_TOPGEN   3392
#define XCD_BAR_WORDS 3456
#define XB_SPIN_CAP (1u << 18)

__device__ __forceinline__ unsigned xb_ld(unsigned* p)              { return __hip_atomic_load(p, __ATOMIC_RELAXED, __HIP_MEMORY_SCOPE_AGENT); }
__device__ __forceinline__ unsigned xb_add(unsigned* p, unsigned v) { return __hip_atomic_fetch_add(p, v, __ATOMIC_RELAXED, __HIP_MEMORY_SCOPE_AGENT); }
__device__ __forceinline__ unsigned xb_xcc_id() { return (unsigned)__builtin_amdgcn_s_getreg((3 << 11) | 20) & 0xFu; }
#define XB_SPIN(cond, bar) do { unsigned _sp = 0; while (cond) { __builtin_amdgcn_s_sleep(1); \
    if ((++_sp & 255u) == 0u) { if (xb_ld(&(bar)[XB_TMO])) break; if (_sp > XB_SPIN_CAP) { atomicAdd(&(bar)[XB_TMO], 1u); break; } } } } while (0)

struct XcdBarrier {
    unsigned* bar; unsigned x;
    volatile LAS unsigned* st;
};

__device__ __forceinline__ XcdBarrier xcd_barrier_post(unsigned* bar, volatile LAS unsigned* st) {
    XcdBarrier b; b.bar = bar; b.x = xb_xcc_id(); b.st = st;
    if (threadIdx.x == 0) (void)xb_add(&bar[XB_XCNT(b.x)], 1u);
    return b;
}
__device__ __forceinline__ void xcd_barrier_complete(unsigned* bar, unsigned x, unsigned& nloc, unsigned& nx) {
    const unsigned G = gridDim.x * gridDim.y * gridDim.z;
    unsigned sum, cnt, mine, sp = 0u;
    for (;;) {
        sum = 0u; cnt = 0u; mine = 0u;
#pragma unroll
        for (unsigned j = 0; j < 16; ++j) { const unsigned c = xb_ld(&bar[XB_XCNT(j)]); sum += c; cnt += (c > 0u) ? 1u : 0u; mine = (j == x) ? c : mine; }
        if (sum == G) break;
        __builtin_amdgcn_s_sleep(1);
        if ((++sp & 255u) == 0u) { if (xb_ld(&bar[XB_TMO])) break; if (sp > XB_SPIN_CAP) { atomicAdd(&bar[XB_TMO], 1u); break; } }
    }
    nloc = mine > 0u ? mine : 1u; nx = cnt > 0u ? cnt : 1u;
}

__device__ __forceinline__ void xcd_barrier(const XcdBarrier& b) {
    asm volatile("s_waitcnt vmcnt(0)" ::: "memory");
    __syncthreads();
    if (threadIdx.x == 0) {
        unsigned* bar = b.bar;
        __builtin_amdgcn_s_waitcnt(0);
        unsigned nloc = b.st[0], nx = b.st[1];
        if (nloc == 0u) { xcd_barrier_complete(bar, b.x, nloc, nx); b.st[0] = nloc; b.st[1] = nx; }
        const unsigned old = xb_add(&bar[XB_XSUB(b.x)], 1u);
        const unsigned gen = old / nloc;
        if (old + 1u == (gen + 1u) * nloc) {
            __builtin_amdgcn_fence(__ATOMIC_RELEASE, "agent");
            asm volatile("s_waitcnt vmcnt(0)" ::: "memory");
            const unsigned og = xb_add(&bar[XB_TOP], 1u);
            const unsigned tg = og / nx;
            if (og + 1u == (tg + 1u) * nx) xb_add(&bar[XB_TOPGEN], 1u);
            else XB_SPIN(xb_ld(&bar[XB_TOPGEN]) == tg, bar);
            __builtin_amdgcn_fence(__ATOMIC_ACQUIRE, "agent");
            xb_add(&bar[XB_XGEN(b.x)], 1u);
            asm volatile("s_waitcnt vmcnt(0)" ::: "memory");
        } else {
            XB_SPIN(xb_ld(&bar[XB_XGEN(b.x)]) == gen, bar);
            __builtin_amdgcn_fence(__ATOMIC_ACQUIRE, "agent");
            asm volatile("s_waitcnt vmcnt(0)" ::: "memory");
        }
    }
    __syncthreads();
}


struct Args { const float* in[19]; float* out; unsigned char* ws; int ph_lo, ph_hi, li, pad; };
struct Frame {
    LAS unsigned char* lds; unsigned* ctl; unsigned char* ws;
    int tid, lane, wave, vcu, G;
    const float* const* in; float* out;
};

struct TrItem { f32x4 v[16]; f32x4 g[4]; };
__device__ __forceinline__ void tr_load(TrItem& t, const float* srcp, int ldsrc, const float* gp) {
#pragma unroll
    for (int i = 0; i < 16; ++i) t.v[i] = __builtin_nontemporal_load((const f32x4*)(srcp + (size_t)i * ldsrc));
    if (gp) {
#pragma unroll
        for (int i = 0; i < 4; ++i) t.g[i] = *(const f32x4*)(gp + 4 * i);
    } else {
#pragma unroll
        for (int i = 0; i < 4; ++i) t.g[i] = (f32x4){1.f, 1.f, 1.f, 1.f};
    }
}
__device__ __forceinline__ void tr_store(const TrItem& t, bf16* dstp, int ldd) {
#pragma unroll
    for (int j = 0; j < 4; ++j)
#pragma unroll
        for (int c = 0; c < 2; ++c) {
            v4u o;
            o.x = pk2(t.v[8 * c + 0][j] * t.g[2 * c][0], t.v[8 * c + 1][j] * t.g[2 * c][1]); o.y = pk2(t.v[8 * c + 2][j] * t.g[2 * c][2], t.v[8 * c + 3][j] * t.g[2 * c][3]);
            o.z = pk2(t.v[8 * c + 4][j] * t.g[2 * c + 1][0], t.v[8 * c + 5][j] * t.g[2 * c + 1][1]); o.w = pk2(t.v[8 * c + 6][j] * t.g[2 * c + 1][2], t.v[8 * c + 7][j] * t.g[2 * c + 1][3]);
            *(v4u*)(dstp + (size_t)j * ldd + 8 * c) = o;
        }
}
__device__ __forceinline__ int win_src_col(int P) {
    if (P < 2048) return P;
    if (P < 3328) { const int p = P - 2048, t = p >> 8, pp = p & 255, bj = pp >> 7, wc = (pp & 127) >> 5, i = pp & 31; return (t < 4 ? 3072 + t * 256 : 4096) + 64 * wc + 32 * bj + i; }
    if (P < 4352) return 2048 + (P - 3328);
    return P;
}
__device__ __forceinline__ float rms_row_to_bf16(const float* xrow, bf16* orow, int lane) {
    const f32x4* xr = (const f32x4*)xrow + lane;
    f32x4 v[8]; float s = 0.f;
#pragma unroll
    for (int j = 0; j < 8; ++j) { v[j] = xr[64 * j]; s += (v[j].x * v[j].x + v[j].y * v[j].y) + (v[j].z * v[j].z + v[j].w * v[j].w); }
    const float rinv = sqrtf(wave_sum(s) * (1.f / DM) + RMS_EPS), rstd = 1.0f / rinv;
    v2u* o8 = (v2u*)orow + lane;
#pragma unroll
    for (int j = 0; j < 8; ++j) { v2u w; w.x = pk2(v[j].x * rstd, v[j].y * rstd); w.y = pk2(v[j].z * rstd, v[j].w * rstd); o8[64 * j] = w; }
    return rinv;
}
constexpr int I_IN = 32 * 72, I_OUT = 32 * 32, I_GU = NEXP * 32 * 16, I_D = NEXP * 8 * 32;
constexpr int NITEMS = I_IN + I_OUT + I_GU + I_D;
constexpr int TAIL1_PER_WAVE = 8, TAIL6_PER_WAVE = 9, TAIL6_ITEMS = 9216;
#ifndef P2_ITEMS_DEF
#define P2_ITEMS_DEF 32896
#endif
constexpr int P2_ITEMS = P2_ITEMS_DEF;
#ifndef ATT_WAVES_DEF
#define ATT_WAVES_DEF 4
#endif
constexpr int ATT_WAVES = ATT_WAVES_DEF;
__device__ __forceinline__ void conv_range(Frame& F, int it0, int step, int end) {
    bf16* WIN = (bf16*)(F.ws + WS_BIG) + (size_t)MPAD * DM;
    const float* ln_mix = F.in[3]; const float* w_in = F.in[4];
    const float* on_sb = F.in[8]; const float* on_sw = F.in[9]; const float* w_out = F.in[10]; const float* ln_ffn = F.in[11];
    const float* w_gate = F.in[16]; const float* w_up = F.in[17]; const float* w_down = F.in[18];
    bf16* WOUT = (bf16*)(F.ws + WS_WOUT); bf16* WGU = (bf16*)(F.ws + WS_WGU); bf16* WD = (bf16*)(F.ws + WS_WD);
    const int kr = F.lane >> 4, nq = F.lane & 15;
#define P0_ITEM(it, SRCP, LDS_, GP, DSTP, LDD) do { int r_ = (it); \
        if (r_ < I_IN) { const int kb = r_ / 72, nb = r_ % 72, k0 = 64 * kb + 16 * kr; SRCP = w_in + (size_t)k0 * 4608 + win_src_col(64 * nb + 4 * nq); LDS_ = 4608; GP = ln_mix + k0; DSTP = WIN + (size_t)(64 * nb + 4 * nq) * DM + k0; LDD = DM; } \
        else if ((r_ -= I_IN) < I_OUT) { const int kb = r_ >> 5, nb = r_ & 31, k0 = 64 * kb + 16 * kr; SRCP = w_out + (size_t)k0 * DM + 64 * nb + 4 * nq; LDS_ = DM; GP = (k0 < 1024 ? on_sb + k0 : on_sw + (k0 - 1024)); DSTP = WOUT + (size_t)(64 * nb + 4 * nq) * DM + k0; LDD = DM; } \
        else if ((r_ -= I_OUT) < I_GU) { const int e = r_ >> 9, q = r_ & 511, kb = q >> 4, nb = q & 15, k0 = 64 * kb + 16 * kr, nt = nb >> 2, bj = (nb >> 1) & 1, j0 = (nb & 1) * 64; \
            SRCP = (bj ? w_up : w_gate) + (size_t)e * DM * DEXP + (size_t)k0 * DEXP + nt * 128 + j0 + 4 * nq; LDS_ = DEXP; GP = ln_ffn + k0; DSTP = WGU + ((size_t)e * 1024 + 64 * nb + 4 * nq) * DM + k0; LDD = DM; } \
        else { r_ -= I_GU; const int e = r_ >> 8, q = r_ & 255, kb = q >> 5, nb = q & 31, k0 = 64 * kb + 16 * kr; \
            SRCP = w_down + (size_t)e * DEXP * DM + (size_t)k0 * DM + 64 * nb + 4 * nq; LDS_ = DM; GP = nullptr; DSTP = WD + ((size_t)e * 2048 + 64 * nb + 4 * nq) * DEXP + k0; LDD = DEXP; } } while (0)
    {
        TrItem cur; const float* sp; const float* gp; bf16* dp; int lds_, ldd; bf16* dpn; int lddn;
        int it = it0;
        if (it < end) { P0_ITEM(it, sp, lds_, gp, dp, ldd); tr_load(cur, sp, lds_, gp); }
        while (it < end) {
            const int itn = it + step; TrItem nxt;
            if (itn < end) { P0_ITEM(itn, sp, lds_, gp, dpn, lddn); tr_load(nxt, sp, lds_, gp); }
            tr_store(cur, dp, ldd);
            if (itn < end) { cur = nxt; dp = dpn; ldd = lddn; }
            it = itn;
        }
    }
#undef P0_ITEM
}
__device__ __forceinline__ void conv_range3(Frame& F, int it0, int step, int end) {
    bf16* WIN = (bf16*)(F.ws + WS_BIG) + (size_t)MPAD * DM;
    const float* ln_mix = F.in[3]; const float* w_in = F.in[4];
    const float* on_sb = F.in[8]; const float* on_sw = F.in[9]; const float* w_out = F.in[10]; const float* ln_ffn = F.in[11];
    const float* w_gate = F.in[16]; const float* w_up = F.in[17]; const float* w_down = F.in[18];
    bf16* WOUT = (bf16*)(F.ws + WS_WOUT); bf16* WGU = (bf16*)(F.ws + WS_WGU); bf16* WD = (bf16*)(F.ws + WS_WD);
    const int kr = F.lane >> 4, nq = F.lane & 15;
#define P0_ITEM(it, SRCP, LDS_, GP, DSTP, LDD) do { int r_ = (it); \
        if (r_ < I_IN) { const int kb = r_ / 72, nb = r_ % 72, k0 = 64 * kb + 16 * kr; SRCP = w_in + (size_t)k0 * 4608 + win_src_col(64 * nb + 4 * nq); LDS_ = 4608; GP = ln_mix + k0; DSTP = WIN + (size_t)(64 * nb + 4 * nq) * DM + k0; LDD = DM; } \
        else if ((r_ -= I_IN) < I_OUT) { const int kb = r_ >> 5, nb = r_ & 31, k0 = 64 * kb + 16 * kr; SRCP = w_out + (size_t)k0 * DM + 64 * nb + 4 * nq; LDS_ = DM; GP = (k0 < 1024 ? on_sb + k0 : on_sw + (k0 - 1024)); DSTP = WOUT + (size_t)(64 * nb + 4 * nq) * DM + k0; LDD = DM; } \
        else if ((r_ -= I_OUT) < I_GU) { const int e = r_ >> 9, q = r_ & 511, kb = q >> 4, nb = q & 15, k0 = 64 * kb + 16 * kr, nt = nb >> 2, bj = (nb >> 1) & 1, j0 = (nb & 1) * 64; \
            SRCP = (bj ? w_up : w_gate) + (size_t)e * DM * DEXP + (size_t)k0 * DEXP + nt * 128 + j0 + 4 * nq; LDS_ = DEXP; GP = ln_ffn + k0; DSTP = WGU + ((size_t)e * 1024 + 64 * nb + 4 * nq) * DM + k0; LDD = DM; } \
        else { r_ -= I_GU; const int e = r_ >> 8, q = r_ & 255, kb = q >> 5, nb = q & 31, k0 = 64 * kb + 16 * kr; \
            SRCP = w_down + (size_t)e * DEXP * DM + (size_t)k0 * DM + 64 * nb + 4 * nq; LDS_ = DM; GP = nullptr; DSTP = WD + ((size_t)e * 2048 + 64 * nb + 4 * nq) * DEXP + k0; LDD = DEXP; } } while (0)
    struct V16 { f32x4 v[16]; };
#define C3_LOAD(B, it) do { if ((it) < end) { const float* sp_; const float* gp_; bf16* dp_; int ls_, ld_; P0_ITEM((it), sp_, ls_, gp_, dp_, ld_); (void)gp_; (void)dp_; (void)ld_; \
        _Pragma("unroll") for (int i_ = 0; i_ < 16; ++i_) B.v[i_] = __builtin_nontemporal_load((const f32x4*)(sp_ + (size_t)i_ * ls_)); } } while (0)
#define C3_STORE(B, it) do { if ((it) < end) { const float* sp_; const float* gp_; bf16* dp_; int ls_, ld_; P0_ITEM((it), sp_, ls_, gp_, dp_, ld_); (void)sp_; (void)ls_; \
        f32x4 g_[4]; _Pragma("unroll") for (int i_ = 0; i_ < 4; ++i_) g_[i_] = gp_ ? *(const f32x4*)(gp_ + 4 * i_) : (f32x4){1.f, 1.f, 1.f, 1.f}; \
        _Pragma("unroll") for (int j_ = 0; j_ < 4; ++j_) _Pragma("unroll") for (int c_ = 0; c_ < 2; ++c_) { v4u o_; \
            o_.x = pk2(B.v[8 * c_ + 0][j_] * g_[2 * c_][0], B.v[8 * c_ + 1][j_] * g_[2 * c_][1]); o_.y = pk2(B.v[8 * c_ + 2][j_] * g_[2 * c_][2], B.v[8 * c_ + 3][j_] * g_[2 * c_][3]); \
            o_.z = pk2(B.v[8 * c_ + 4][j_] * g_[2 * c_ + 1][0], B.v[8 * c_ + 5][j_] * g_[2 * c_ + 1][1]); o_.w = pk2(B.v[8 * c_ + 6][j_] * g_[2 * c_ + 1][2], B.v[8 * c_ + 7][j_] * g_[2 * c_ + 1][3]); \
            *(v4u*)(dp_ + (size_t)j_ * ld_ + 8 * c_) = o_; } } } while (0)
    {
        V16 A, B, C; int it = it0;
        C3_LOAD(A, it); C3_LOAD(B, it + step);
        while (it < end) {
            C3_LOAD(C, it + 2 * step); C3_STORE(A, it);
            C3_LOAD(A, it + 3 * step); C3_STORE(B, it + step);
            C3_LOAD(B, it + 4 * step); C3_STORE(C, it + 2 * step);
            it += 3 * step;
        }
    }
#undef C3_LOAD
#undef C3_STORE
#undef P0_ITEM
}
__device__ __forceinline__ int tail1_items(int G) { const int rounds = (P1_UNITS + G - 1) / G, nidle = rounds * G - P1_UNITS; return nidle * NWAVES * TAIL1_PER_WAVE; }
__device__ __forceinline__ void p0_prologue(Frame& F) {
    const int gw = F.vcu * NWAVES + F.wave, NGW = F.G * NWAVES;
    if (blockIdx.x == 0 && F.tid < NEXP) __hip_atomic_store(F.ctl + CW_CNT + F.tid, 0u, __ATOMIC_RELAXED, __HIP_MEMORY_SCOPE_AGENT);
    bf16* BIG = (bf16*)(F.ws + WS_BIG);
    bf16* WIN = BIG + (size_t)MPAD * DM;
    const float* x = F.in[0]; const float* meta = F.in[1]; const float* ln_mix = F.in[3]; const float* w_in = F.in[4];
    const float* on_sb = F.in[8]; const float* on_sw = F.in[9]; const float* w_out = F.in[10]; const float* ln_ffn = F.in[11];
    const float* w_rg = F.in[12]; const float* w_re = F.in[14]; const float* w_gate = F.in[16]; const float* w_up = F.in[17]; const float* w_down = F.in[18];
    for (int m = gw; m < MPAD; m += NGW) {
        bf16* orow = BIG + (size_t)m * DM;
        if (m < NTOK) { const float ri = rms_row_to_bf16(x + (size_t)m * DM, orow, F.lane); if (F.lane == 0) ((float*)(F.ws + WS_RINV))[m] = ri; }
        else if (m < NTOK + NMETA) (void)rms_row_to_bf16(meta + (size_t)(m - NTOK) * DM, orow, F.lane);
        else { v4u z = {0u, 0u, 0u, 0u}; v4u* o = (v4u*)orow + F.lane;
#pragma unroll
            for (int j = 0; j < 4; ++j) o[64 * j] = z; }
    }
    conv_range(F, gw, NGW, NITEMS - TAIL6_ITEMS - tail1_items(F.G) - P2_ITEMS);
    bf16* WRH = (bf16*)(F.ws + WS_WR); bf16* WRL = WRH + 96 * DM;
    for (int idx = (F.vcu * NWAVES * 64 + F.tid); idx < 96 * DM; idx += F.G * NWAVES * 64) {
        const int c = idx / DM, k = idx % DM;
        float v = 0.f; if (c < 8) v = w_rg[k * 8 + c]; else if (c < 72) v = w_re[k * 64 + (c - 8)];
        v *= ln_ffn[k];
        const unsigned hi = pk2(v, 0.f) & 0xffffu; const float lo = v - __uint_as_float(hi << 16);
        const int fidx = ((((k >> 4) * 3 + (c >> 5)) * 64 + (((k >> 3) & 1) * 32 + (c & 31))) << 3) + (k & 7);
        WRH[fidx] = (bf16)hi; WRL[fidx] = (bf16)(pk2(lo, 0.f) & 0xffffu);
    }
}

struct P1Order {
    int G, c;
    __device__ bool next(int i, pg8::Unit& u) const {
        const int L = i * G + c; if (L >= P1_UNITS) return false;
        if (L < P1_UNITS_A) { u.pm = L / NT_QK; u.pn = NTILE_X + (L % NT_QK); }
        else { const int l = L - P1_UNITS_A; u.pm = NTILE_X + NT_QK + l / NTILE_X; u.pn = l % NTILE_X; }
        return true;
    }
    __device__ __forceinline__ void a_ready(const pg8::Unit&) const {}
    __device__ __forceinline__ void done(const pg8::Unit&) const {}
};
struct EpiQKV {
    static constexpr bool PERM = true, AFTER_DRAIN = false, MIDK = false;
    bf16 *QS, *KS, *QW, *KW, *VT; const float *q_norm, *k_norm;
    __device__ __forceinline__ void operator()(const pg8::f32x4 (&acc)[2][2][4][2], const pg8::Unit& u, int wr, int wc, int fr, int fq) const {
        using pg8::HALF;
        if (u.pm < NTILE_X) {
            const int t = u.pn - NTILE_X; const int row0 = u.pm * 256 + wr * 64 + fr;
            if (t < 8) {
                bf16* base = (t < 4) ? QS : KS; const float sc = (t < 4) ? C2 : 1.0f; const int col0 = (t & 3) * 256 + wc * 32 + 8 * fq;
#pragma unroll
                for (int ai = 0; ai < 2; ++ai)
#pragma unroll
                    for (int m = 0; m < 4; ++m) { bf16* rowp = base + (size_t)(row0 + ai * HALF + m * 16) * 1024 + col0;
#pragma unroll
                        for (int bj = 0; bj < 2; ++bj) { const pg8::f32x4 v0 = acc[ai][bj][m][0] * sc, v1 = acc[ai][bj][m][1] * sc;
                            v4u w; w.x = pk2(v0[0], v0[1]); w.y = pk2(v0[2], v0[3]); w.z = pk2(v1[0], v1[1]); w.w = pk2(v1[2], v1[3]); *(v4u*)(rowp + bj * HALF) = w; } }
            } else {
                const bool isq = t < 12; const float* gain = isq ? q_norm : k_norm; const float sc = isq ? C2 : 1.0f;
                bf16* base = isq ? (QW + (t - 8) * 256 + wc * 64) : (KW + wc * 64); const int ld = isq ? 1024 : 256;
                pg8::f32x4 g[2][2];
#pragma unroll
                for (int bj = 0; bj < 2; ++bj)
#pragma unroll
                    for (int n = 0; n < 2; ++n) g[bj][n] = *(const pg8::f32x4*)(gain + 32 * bj + 8 * fq + 4 * n) * sc;
#pragma unroll
                for (int ai = 0; ai < 2; ++ai)
#pragma unroll
                    for (int m = 0; m < 4; ++m) {
                        float ss = 0.f;
#pragma unroll
                        for (int bj = 0; bj < 2; ++bj)
#pragma unroll
                            for (int n = 0; n < 2; ++n) { const pg8::f32x4 v = acc[ai][bj][m][n]; ss += (v[0] * v[0] + v[1] * v[1]) + (v[2] * v[2] + v[3] * v[3]); }
                        ss += __shfl_xor(ss, 16); ss += __shfl_xor(ss, 32);
                        const float rstd = 1.0f / sqrtf(ss * (1.0f / 64.0f) + RMS_EPS);
                        bf16* rowp = base + (size_t)(row0 + ai * HALF + m * 16) * ld + 8 * fq;
#pragma unroll
                        for (int bj = 0; bj < 2; ++bj) { const pg8::f32x4 v0 = acc[ai][bj][m][0] * rstd * g[bj][0], v1 = acc[ai][bj][m][1] * rstd * g[bj][1];
                            v4u w; w.x = pk2(v0[0], v0[1]); w.y = pk2(v0[2], v0[3]); w.z = pk2(v1[0], v1[1]); w.w = pk2(v1[2], v1[3]); *(v4u*)(rowp + 32 * bj) = w; } }
            }
        } else {
            const int vrow0 = (u.pm - NTILE_X - NT_QK) * 256 + wr * 64 + fr;
#pragma unroll
            for (int ai = 0; ai < 2; ++ai)
#pragma unroll
                for (int m = 0; m < 4; ++m) { bf16* rowp = VT + (size_t)(vrow0 + ai * HALF + m * 16) * MPAD + u.pn * 256 + wc * 32 + 16 * (fq >> 1) + 4 * (fq & 1);
#pragma unroll
                    for (int bj = 0; bj < 2; ++bj)
#pragma unroll
                        for (int n = 0; n < 2; ++n) { const pg8::f32x4 v = acc[ai][bj][m][n]; v2u w; w.x = pk2(v[0], v[1]); w.y = pk2(v[2], v[3]); *(v2u*)(rowp + bj * HALF + 8 * n) = w; } }
        }
    }
};

namespace att {
__device__ __forceinline__ f32x16 mfma_bf(bf16x8 a, bf16x8 b, f32x16 c) { return __builtin_amdgcn_mfma_f32_32x32x16_bf16(a, b, c, 0, 0, 0); }
__device__ __forceinline__ f32x16 mfma_h(f16x8 a, f16x8 b, f32x16 c) { return __builtin_amdgcn_mfma_f32_32x32x16_f16(a, b, c, 0, 0, 0); }
__device__ __forceinline__ bf16x8 ld8(const bf16* p) { return *(const bf16x8*)p; }
__device__ __forceinline__ bf16x8 pack8(const float* w) { v4u o; o.x = pk2(w[0], w[1]); o.y = pk2(w[2], w[3]); o.z = pk2(w[4], w[5]); o.w = pk2(w[6], w[7]); return __builtin_bit_cast(bf16x8, o); }

struct KT { bf16x8 k[4]; bf16x8 v[4]; };
__device__ __forceinline__ void glds16(const void* gsrc, unsigned lds_dst) { unsigned keep;
    asm volatile("s_mov_b32 %0, m0\n\ts_mov_b32 m0, %2\n\ts_nop 0\n\tglobal_load_lds_dwordx4 %1, off\n\ts_mov_b32 m0, %0" : "=&s"(keep) : "v"(gsrc), "s"(lds_dst) : "memory"); }
__device__ __forceinline__ void dma_tile(unsigned slot, const bf16* Kb, int ldk, const bf16* Vt, int b, int j, int lane) {
#pragma unroll
    for (int i = 0; i < 4; ++i) { const int row = 8 * i + (lane >> 3), ch = (lane & 7) ^ (row & 7);
        const int krow = (j >= 0) ? (b * SEQ + 32 * j + row) : (NTOK + (row & 15));
        glds16(Kb + (size_t)krow * ldk + ch * 8, (unsigned)__builtin_amdgcn_readfirstlane(slot + i * 1024)); }
    const int col0 = (j >= 0) ? (b * SEQ + 32 * j) : NTOK;
#pragma unroll
    for (int i = 0; i < 4; ++i) { const int row = 16 * i + (lane >> 2), c = (lane & 3) ^ ((row >> 2) & 3); const int cc = (j >= 0) ? c : (c & 1);
        glds16(Vt + (size_t)row * MPAD + col0 + cc * 8, (unsigned)__builtin_amdgcn_readfirstlane(slot + 4096 + i * 1024)); }
}
__device__ __forceinline__ void lds_frags(KT& t, const LAS unsigned char* slot, int r, int h) {
#pragma unroll
    for (int s = 0; s < 4; ++s) { const int c = 2 * s + h; t.k[s] = *(const LAS bf16x8*)(slot + (r >> 3) * 1024 + ((r & 7) * 8 + (c ^ (r & 7))) * 16); }
#pragma unroll
    for (int dh = 0; dh < 2; ++dh)
#pragma unroll
        for (int s = 0; s < 2; ++s) { const int row = 32 * dh + r, c = 2 * s + h; t.v[dh * 2 + s] = *(const LAS bf16x8*)(slot + 4096 + row * 64 + (c ^ ((row >> 2) & 3)) * 16); }
}
#define ATT_WAITV(n) asm volatile("s_waitcnt vmcnt(" #n ")" ::: "memory")

struct SbState { f32x16 o0, o1; float R; };
template <int KIND>
__device__ __forceinline__ void sb_tile(SbState& S, const KT& t, const bf16x8 (&qf)[4], const f16x8& U0, const f16x8& U1, int r, int h) {
    f32x16 z = {0.f, 0.f, 0.f, 0.f, 0.f, 0.f, 0.f, 0.f, 0.f, 0.f, 0.f, 0.f, 0.f, 0.f, 0.f, 0.f};
#pragma unroll
    for (int s = 0; s < 4; ++s) z = mfma_bf(t.k[s], qf[s], z);
    f32x16 init; float L[16];
#pragma unroll
    for (int g = 0; g < 16; ++g) {
        const float zz = z[g];
        const float e = __builtin_amdgcn_exp2f(-__builtin_fabsf(zz));
        const float zp = __builtin_amdgcn_fmed3f(zz, 0.f, 3.0e38f);
        const float sp = zp + __builtin_amdgcn_logf(1.0f + e);
        float Lv = -sp;
        if (KIND == 1) Lv = (crow(g, h) < r) ? Lv : 0.f;
        if (KIND == 2) Lv = (crow(g, h) < 16) ? Lv : 0.f;
        L[g] = Lv; init[g] = zz + Lv + S.R;
    }
    f16x8 lb0, lb1;
#pragma unroll
    for (int j = 0; j < 8; ++j) { lb0[j] = (_Float16)L[j]; lb1[j] = (_Float16)L[8 + j]; }
    f32x16 lw = mfma_h(U0, lb0, init); lw = mfma_h(U1, lb1, lw);
    float Rn = lw[0] - z[0];
    Rn = __shfl(Rn, r);
    float w[16];
#pragma unroll
    for (int g = 0; g < 16; ++g) {
        float wv = __builtin_amdgcn_exp2f(lw[g]);
        if (KIND == 1) wv = (crow(g, h) < r) ? wv : 0.f;
        if (KIND == 2) wv = (crow(g, h) < 16) ? wv : 0.f;
        w[g] = wv;
    }
    const bf16x8 wb0 = pack8(w), wb1 = pack8(w + 8);
    S.o0 = mfma_bf(t.v[0], wb0, S.o0); S.o0 = mfma_bf(t.v[1], wb1, S.o0);
    S.o1 = mfma_bf(t.v[2], wb0, S.o1); S.o1 = mfma_bf(t.v[3], wb1, S.o1);
    S.R = Rn;
}

struct SwState { f32x16 o0, o1; float m, l; };
template <int KIND>
__device__ __forceinline__ void sw_tile(SwState& S, const KT& t, const bf16x8 (&qf)[4], const LAS float* tb, int r, int h) {
    f32x16 z = {0.f, 0.f, 0.f, 0.f, 0.f, 0.f, 0.f, 0.f, 0.f, 0.f, 0.f, 0.f, 0.f, 0.f, 0.f, 0.f};
#pragma unroll
    for (int s = 0; s < 4; ++s) z = mfma_bf(t.k[s], qf[s], z);
    float sc[16]; float mx = -1e30f;
#pragma unroll
    for (int g = 0; g < 16; ++g) {
        float v = z[g] + tb[(g & 3) + 8 * (g >> 2)];
        if (KIND == 1) v = (crow(g, h) <= r) ? v : -1e30f;
        if (KIND == 2) v = (crow(g, h) < 16) ? v : -1e30f;
        if (KIND == 3) v = (crow(g, h) > r) ? v : -1e30f;
        sc[g] = v; mx = __builtin_fmaxf(mx, v);
    }
    mx = __builtin_fmaxf(mx, __shfl_xor(mx, 32));
    const float mn = __builtin_fmaxf(S.m, mx);
    const float alpha = __builtin_amdgcn_exp2f(S.m - mn);
    S.l *= alpha; S.o0 *= alpha; S.o1 *= alpha;
    float p[16]; float ls = 0.f;
#pragma unroll
    for (int g = 0; g < 16; ++g) { p[g] = __builtin_amdgcn_exp2f(sc[g] - mn); ls += p[g]; }
    S.l += ls; S.m = mn;
    const bf16x8 wb0 = pack8(p), wb1 = pack8(p + 8);
    S.o0 = mfma_bf(t.v[0], wb0, S.o0); S.o0 = mfma_bf(t.v[1], wb1, S.o0);
    S.o1 = mfma_bf(t.v[2], wb0, S.o1); S.o1 = mfma_bf(t.v[3], wb1, S.o1);
}
__device__ __forceinline__ float store_o(bf16* orow, const f32x16& o0, const f32x16& o1, float scale, int h) {
    float ss = 0.f;
#pragma unroll
    for (int q = 0; q < 4; ++q) {
        const float a0 = o0[4 * q] * scale, a1 = o0[4 * q + 1] * scale, a2 = o0[4 * q + 2] * scale, a3 = o0[4 * q + 3] * scale;
        const float b0 = o1[4 * q] * scale, b1 = o1[4 * q + 1] * scale, b2 = o1[4 * q + 2] * scale, b3 = o1[4 * q + 3] * scale;
        ss += ((a0 * a0 + a1 * a1) + (a2 * a2 + a3 * a3)) + ((b0 * b0 + b1 * b1) + (b2 * b2 + b3 * b3));
        v2u w; w.x = pk2(a0, a1); w.y = pk2(a2, a3); *(v2u*)(orow + 8 * q + 4 * h) = w;
        v2u x; x.x = pk2(b0, b1); x.y = pk2(b2, b3); *(v2u*)(orow + 32 + 8 * q + 4 * h) = x;
    }
    return ss;
}
}

__device__ __forceinline__ void p2_attention(Frame& F) {
    using namespace att;
    const int lane = F.lane, r = lane & 31, h = lane >> 5, w = F.wave;
    const bf16* VT = (const bf16*)(F.ws + WS_VT); bf16* MIX = (bf16*)(F.ws + WS_MIXED); float* SSQ = (float*)(F.ws + WS_SSQ);
    LAS float* tbr = (LAS float*)(F.lds + ATT_TBR_OFF);
    const LAS unsigned char* area = F.lds + RING_OFF + w * 16384;
    const unsigned slot0 = (unsigned)(uintptr_t)area;
    { const float* rel_bias = F.in[2];
      for (int idx = F.tid; idx < 16 * 192; idx += NWAVES * 64) {
        const int hq = idx / 192, x = idx % 192, d = 159 - x; float v = 0.f;
        if (d >= 0) { int bkt = d; if (d >= 16) { bkt = 16 + (int)(logf((float)d / 16.0f) / logf(8.0f) * 16.0f); bkt = bkt > 31 ? 31 : bkt; } v = rel_bias[bkt * 16 + hq] * LOG2E; }
        tbr[idx] = v;
      } }
    __syncthreads();
    if (w >= ATT_WAVES) {
        const int p2_end = NITEMS - TAIL6_ITEMS - tail1_items(F.G);
        conv_range3(F, p2_end - P2_ITEMS + F.vcu * (NWAVES - ATT_WAVES) + (w - ATT_WAVES), F.G * (NWAVES - ATT_WAVES), p2_end);
        return;
    }
    __builtin_amdgcn_s_setprio(3);
    for (int unit = F.vcu; unit < NTOK / 32; unit += F.G) {
        const int b = unit >> 7, hg = unit & 3; int qa = (unit >> 2) & 31; if (unit >= NTOK / 64) qa = 31 - qa;
        const int a = 4 * qa + w;
        const size_t qrow = (size_t)b * SEQ + 32 * a + r;
#pragma unroll 1
        for (int bi = 0; bi < 2; ++bi) {
            const int branch = bi;
            if (branch == 0) {
            const bf16* KS = (const bf16*)(F.ws + WS_KS); const bf16* QS = (const bf16*)(F.ws + WS_QS);
            f16x8 U0, U1;
#pragma unroll
            for (int j = 0; j < 8; ++j) { const int c0 = 8 * (j >> 2) + 4 * h + (j & 3); U0[j] = (c0 > r) ? (_Float16)1.0f : (_Float16)0.0f; U1[j] = (16 + c0 > r) ? (_Float16)1.0f : (_Float16)0.0f; }
            float ssl = 0.f;
#pragma unroll 1
            for (int hh = 0; hh < 16 / ATT_WAVES; ++hh) {
                const int head = 4 * hg + hh;
                ATT_WAITV(0);
                const bf16* Kb = KS + head * 64;
                bf16x8 ql[4];
#pragma unroll
                for (int s = 0; s < 4; ++s) ql[s] = ld8(QS + qrow * 1024 + head * 64 + 16 * s + 8 * h);
                SbState S; S.R = 0.f;
#pragma unroll
                for (int g = 0; g < 16; ++g) { S.o0[g] = 0.f; S.o1[g] = 0.f; }
                const bf16* Vt = VT + (size_t)(head * 64) * MPAD;
                unsigned sl_cur = slot0, sl_nxt = slot0 + 8192;
                int jt = a;
                dma_tile(sl_cur, Kb, 1024, Vt, b, jt, lane); dma_tile(sl_nxt, Kb, 1024, Vt, b, jt - 1, lane);
                ATT_WAITV(8);
                KT T; lds_frags(T, area + (sl_cur - slot0), r, h);
                sb_tile<1>(S, T, ql, U0, U1, r, h);
                if (!__all(S.R < SB_EXIT)) {
                    --jt;
                    for (;;) {
                        { const unsigned t_ = sl_cur; sl_cur = sl_nxt; sl_nxt = t_; }
                        const bool has_next = jt >= 0;
                        if (has_next) { dma_tile(sl_nxt, Kb, 1024, Vt, b, jt - 1, lane); ATT_WAITV(8); } else ATT_WAITV(0);
                        lds_frags(T, area + (sl_cur - slot0), r, h);
                        if (jt >= 0) sb_tile<0>(S, T, ql, U0, U1, r, h); else sb_tile<2>(S, T, ql, U0, U1, r, h);
                        if (!has_next || __all(S.R < SB_EXIT)) break;
                        --jt;
                    }
                }
                ssl += store_o(MIX + qrow * DM + head * 64, S.o0, S.o1, 1.0f, h);
            }
            ssl += __shfl_xor(ssl, 32);
            if (h == 0) SSQ[qrow * 16 + hg] = ssl;
        }
            else {
            const bf16* KW = (const bf16*)(F.ws + WS_KW); const bf16* QW = (const bf16*)(F.ws + WS_QW);
            float ssl = 0.f;
#pragma unroll 1
            for (int hh = 0; hh < 16 / ATT_WAVES; ++hh) {
                const int hq = 4 * hg + hh, kvh = hq >> 2;
                ATT_WAITV(0);
                const bf16* Kb = KW + kvh * 64;
                bf16x8 ql[4];
#pragma unroll
                for (int s = 0; s < 4; ++s) ql[s] = ld8(QW + qrow * 1024 + hq * 64 + 16 * s + 8 * h);
                const float sink2 = F.in[7][hq] * LOG2E;
                SwState S; S.m = sink2; S.l = 0.f;
#pragma unroll
                for (int g = 0; g < 16; ++g) { S.o0[g] = 0.f; S.o1[g] = 0.f; }
                const LAS float* tbh = tbr + hq * 192 + 4 * h;
                const int jlo = (a >= 4) ? a - 4 : 0;
                const bf16* Vt = VT + (size_t)(1024 + kvh * 64) * MPAD;
                unsigned sl_cur = slot0, sl_nxt = slot0 + 8192;
                int jt = a;
#define SW_NEXT(j) (((j) > jlo) ? (j) - 1 : -1)
                dma_tile(sl_cur, Kb, 256, Vt, b, jt, lane); dma_tile(sl_nxt, Kb, 256, Vt, b, SW_NEXT(jt), lane);
                ATT_WAITV(8);
                KT T; lds_frags(T, area + (sl_cur - slot0), r, h);
                sw_tile<1>(S, T, ql, tbh + (159 - r), r, h);
                jt = SW_NEXT(jt);
                for (;;) {
                    { const unsigned t_ = sl_cur; sl_cur = sl_nxt; sl_nxt = t_; }
                    if (jt >= 0) { dma_tile(sl_nxt, Kb, 256, Vt, b, SW_NEXT(jt), lane); ATT_WAITV(8); } else ATT_WAITV(0);
                    lds_frags(T, area + (sl_cur - slot0), r, h);
                    if (jt < 0) { const int dq = 32 * a + r + 16; sw_tile<2>(S, T, ql, tbh + (159 - (dq < 159 ? dq : 159)), r, h); break; }
                    const LAS float* tb = tbh + (159 - (32 * (a - jt) + r));
                    if (jt == a - 4) sw_tile<3>(S, T, ql, tb, r, h); else sw_tile<0>(S, T, ql, tb, r, h);
                    jt = SW_NEXT(jt);
                }
#undef SW_NEXT
                const float lt = S.l + __shfl_xor(S.l, 32) + __builtin_amdgcn_exp2f(sink2 - S.m);
                ssl += store_o(MIX + qrow * DM + 1024 + hq * 64, S.o0, S.o1, 1.0f / lt, h);
            }
            ssl += __shfl_xor(ssl, 32);
            if (h == 0) SSQ[qrow * 16 + 8 + hg] = ssl;
        }
        }
    }
    __builtin_amdgcn_s_setprio(0);
}

struct EpiRes {
    static constexpr bool PERM = true, AFTER_DRAIN = false, MIDK = true;
    bf16* P; const LAS float* RS; const bf16* XN; mutable int ui;
    __device__ __forceinline__ void midk(pg8::f32x4 (&acc)[2][2][4][2], const pg8::Unit& u, int wr, int fr) const {
#pragma unroll
        for (int ai = 0; ai < 2; ++ai)
#pragma unroll
            for (int m = 0; m < 4; ++m) { const LAS float* q = RS + (ui * 256 + ai * 128 + wr * 64 + m * 16 + fr) * 2; const float ratio = q[0] / q[1];
#pragma unroll
                for (int bj = 0; bj < 2; ++bj)
#pragma unroll
                    for (int n = 0; n < 2; ++n) acc[ai][bj][m][n] *= ratio; }
    }
    __device__ __forceinline__ void operator()(const pg8::f32x4 (&acc)[2][2][4][2], const pg8::Unit& u, int wr, int wc, int fr, int fq) const {
        const int col0 = u.pn * 256 + wc * 32 + 8 * fq;
        v4u xr[2][4][2];
#pragma unroll
        for (int ai = 0; ai < 2; ++ai)
#pragma unroll
            for (int m = 0; m < 4; ++m) { const int rl = ai * 128 + wr * 64 + m * 16 + fr; const bf16* xp = XN + (size_t)(u.pm * 256 + rl) * DM + col0;
#pragma unroll
                for (int bj = 0; bj < 2; ++bj) xr[ai][m][bj] = *(const v4u*)(xp + bj * 128); }
#pragma unroll
        for (int ai = 0; ai < 2; ++ai)
#pragma unroll
            for (int m = 0; m < 4; ++m) { const int rl = ai * 128 + wr * 64 + m * 16 + fr; bf16* rowp = P + (size_t)(u.pm * 256 + rl) * DM + col0; const float rw = RS[(ui * 256 + rl) * 2 + 1], ri = RS[2048 + ui * 256 + rl];
#pragma unroll
                for (int bj = 0; bj < 2; ++bj) { const pg8::f32x4 v0 = acc[ai][bj][m][0] * rw, v1 = acc[ai][bj][m][1] * rw; const v4u x = xr[ai][m][bj];
                    v4u w; w.x = pk2(bf_lo(x.x) * ri + v0[0], bf_hi(x.x) * ri + v0[1]); w.y = pk2(bf_lo(x.y) * ri + v0[2], bf_hi(x.y) * ri + v0[3]);
                    w.z = pk2(bf_lo(x.z) * ri + v1[0], bf_hi(x.z) * ri + v1[1]); w.w = pk2(bf_lo(x.w) * ri + v1[2], bf_hi(x.w) * ri + v1[3]); *(v4u*)(rowp + bj * 128) = w; } }
        ++ui;
    }
};

__device__ __forceinline__ void p4_router(Frame& F) {
    using namespace att;
    const int lane = F.lane, r = lane & 31, h = lane >> 5, w = F.wave;
    const bf16* HB = (const bf16*)(F.ws + WS_HB);
    const bf16* WRH = (const bf16*)(F.ws + WS_WR); const bf16* WRL = WRH + 96 * DM;
    const float* b_rg = F.in[13]; const float* b_re = F.in[15];
    unsigned* CNT = F.ctl + CW_CNT;
    int* LIST = (int*)(F.ws + WS_LIST); float* GATEW = (float*)(F.ws + WS_GATEW); int* TOKINFO = (int*)(F.ws + WS_TOKINFO); float* RSTD = (float*)(F.ws + WS_RSTD); float* RSTDW = (float*)(F.ws + WS_RSTDW);
    LAS float* part = (LAS float*)(F.lds + RING_OFF);
    LAS float* ssp = (LAS float*)(F.lds + RING_OFF + 98304);
    LAS float* lg = (LAS float*)(F.lds + RING_OFF + 98304 + 2048);
    LAS float* rsl = (LAS float*)(F.lds + RING_OFF + 98304 + 2048 + 18432);
    const bool stager = __builtin_amdgcn_readfirstlane(w) < 4; const int mw = w & 3;
    const int crot = F.vcu & 3, krot = (F.vcu >> 2) & 7;
    for (int unit = F.vcu; unit < NTOK / 64; unit += F.G) {
        if (stager) {
#pragma unroll 1
            for (int c = 0; c < 5; ++c) {
                if (c < 4) {
                    const int cn = (c + crot) & 3;
                    LAS unsigned char* sh = F.lds + RING_OFF + (c & 1) * 65536;
#pragma unroll 1
                    for (int hb = 0; hb < 2; ++hb) {
                        v4u xr[8];
#pragma unroll
                        for (int i = 0; i < 8; ++i) { const int id = (hb * 8 + i) * 256 + F.tid, row = id >> 6, g = id & 63; xr[i] = *(const v4u*)(HB + ((size_t)unit * 64 + row) * DM + 512 * cn + 8 * g); }
#pragma unroll
                        for (int i = 0; i < 8; ++i) { const int id = (hb * 8 + i) * 256 + F.tid, row = id >> 6, g = id & 63; *(LAS v4u*)(sh + row * 1024 + ((g ^ (row & 15)) << 4)) = xr[i]; }
                    }
                }
                __syncthreads();
            }
        } else {
            f32x16 acc[2][3];
#pragma unroll
            for (int t = 0; t < 2; ++t)
#pragma unroll
                for (int nt = 0; nt < 3; ++nt)
#pragma unroll
                    for (int g = 0; g < 16; ++g) acc[t][nt][g] = 0.f;
            float ss0 = 0.f, ss1 = 0.f;
            bf16x8 wah[3], wal[3], wbh[3], wbl[3];
#define P4_WLOAD(WH, WL, C_, S8_) { const int ksg_ = 32 * (((C_) + crot) & 3) + mw + 4 * (((S8_) + krot) & 7); \
                _Pragma("unroll") for (int nt = 0; nt < 3; ++nt) { const int fo = (((ksg_ * 3 + nt) * 64 + lane) << 3); WH[nt] = ld8(WRH + fo); WL[nt] = ld8(WRL + fo); } }
#define P4_SS(SS, HV) { const float e0 = bf_lo(HV.x), e1 = bf_hi(HV.x), e2 = bf_lo(HV.y), e3 = bf_hi(HV.y), e4 = bf_lo(HV.z), e5 = bf_hi(HV.z), e6 = bf_lo(HV.w), e7 = bf_hi(HV.w); \
                SS += ((e0 * e0 + e1 * e1) + (e2 * e2 + e3 * e3)) + ((e4 * e4 + e5 * e5) + (e6 * e6 + e7 * e7)); }
#define P4_KSTEP(WH, WL, S8_) { const int ks = mw + 4 * (((S8_) + krot) & 7); \
                const int fo0 = r * 1024 + ((((2 * ks + h) ^ (r & 15))) << 4), fo1 = fo0 + 32 * 1024; \
                const v4u h0 = *(const LAS v4u*)(sh + fo0), h1 = *(const LAS v4u*)(sh + fo1); \
                P4_SS(ss0, h0) P4_SS(ss1, h1) \
                const bf16x8 ahi0 = __builtin_bit_cast(bf16x8, h0), ahi1 = __builtin_bit_cast(bf16x8, h1); \
                _Pragma("unroll") for (int nt = 0; nt < 3; ++nt) { \
                    acc[0][nt] = mfma_bf(ahi0, WH[nt], acc[0][nt]); acc[1][nt] = mfma_bf(ahi1, WH[nt], acc[1][nt]); \
                    acc[0][nt] = mfma_bf(ahi0, WL[nt], acc[0][nt]); acc[1][nt] = mfma_bf(ahi1, WL[nt], acc[1][nt]); } }
            P4_WLOAD(wah, wal, 0, 0)
            __syncthreads();
#pragma unroll 1
            for (int c = 0; c < 4; ++c) {
                const LAS unsigned char* sh = F.lds + RING_OFF + (c & 1) * 65536;
#pragma unroll 1
                for (int s8 = 0; s8 < 8; s8 += 2) {
                    P4_WLOAD(wbh, wbl, c, s8 + 1)
                    P4_KSTEP(wah, wal, s8)
                    { const int j = c * 8 + s8 + 2; P4_WLOAD(wah, wal, j >> 3, j & 7) }
                    P4_KSTEP(wbh, wbl, s8 + 1)
                }
                __syncthreads();
            }
#undef P4_SS
#undef P4_KSTEP
#undef P4_WLOAD
            ss0 += __shfl_xor(ss0, 32); ss1 += __shfl_xor(ss1, 32);
            if (h == 0) { ssp[mw * 32 + r] = ss0; ssp[128 + mw * 32 + r] = ss1; }
#pragma unroll
            for (int t = 0; t < 2; ++t)
#pragma unroll
                for (int nt = 0; nt < 3; ++nt)
#pragma unroll
                    for (int g = 0; g < 16; ++g) part[((t * 4 + mw) * 32 + crow(g, h)) * 96 + nt * 32 + r] = acc[t][nt][g];
        }
        __syncthreads();
        for (int idx = F.tid; idx < 64 * 72; idx += NWAVES * 64) { const int tkk = idx / 72, cc = idx % 72, t = tkk >> 5, tk = tkk & 31; float v = 0.f;
#pragma unroll
            for (int i = 0; i < 4; ++i) v += part[((t * 4 + i) * 32 + tk) * 96 + cc];
            lg[idx] = v; }
        __syncthreads();
        LAS unsigned* hist = (LAS unsigned*)rsl + 64;
        if (F.tid < 128) hist[F.tid] = 0u;
        __syncthreads();
        int tok = 0, e0 = 0, e1 = 0; unsigned r0 = 0, r1 = 0; float g0 = 0.f, g1 = 0.f, rs = 0.f;
        if (F.tid < 64) {
            tok = unit * 64 + F.tid; float tsum = 0.f;
#pragma unroll
            for (int i = 0; i < 4; ++i) tsum += ssp[(F.tid >> 5) * 128 + i * 32 + (F.tid & 31)];
            rs = 1.0f / sqrtf(tsum * (1.0f / DM) + RMS_EPS); RSTD[tok] = rs;
            const LAS float* l = lg + F.tid * 72;
            float gl[8]; int gi = 0; float gm = -3.0e38f;
#pragma unroll
            for (int i = 0; i < 8; ++i) { gl[i] = l[i] * rs + b_rg[i]; if (gl[i] > gm) { gm = gl[i]; gi = i; } }
            float gs = 0.f;
#pragma unroll
            for (int i = 0; i < 8; ++i) gs += expf(gl[i] - gm);
            const float gval = 1.0f / gs;
            float el[8]; int i0 = 0; float m0 = -3.0e38f;
#pragma unroll
            for (int i = 0; i < 8; ++i) { el[i] = l[8 + gi * 8 + i] * rs + b_re[gi * 8 + i]; if (el[i] > m0) { m0 = el[i]; i0 = i; } }
            int i1 = 0; float m1 = -3.0e38f;
#pragma unroll
            for (int i = 0; i < 8; ++i) if (i != i0 && el[i] > m1) { m1 = el[i]; i1 = i; }
            const float p1 = expf(m1 - m0); g0 = gval / (1.0f + p1); g1 = gval * p1 / (1.0f + p1);
            e0 = gi * 8 + i0; e1 = gi * 8 + i1;
            r0 = atomicAdd((unsigned*)(hist + e0), 1u); r1 = atomicAdd((unsigned*)(hist + e1), 1u);
        }
        __syncthreads();
        if (F.tid < 64) { const unsigned n = hist[F.tid]; if (n) hist[64 + F.tid] = atomicAdd(CNT + F.tid, n); }
        __syncthreads();
        if (F.tid < 64) {
            const int pos0 = (int)(hist[64 + e0] + r0), pos1 = (int)(hist[64 + e1] + r1);
            LIST[e0 * NTOK + pos0] = tok; LIST[e1 * NTOK + pos1] = tok; GATEW[e0 * NTOK + pos0] = g0; GATEW[e1 * NTOK + pos1] = g1; RSTDW[e0 * NTOK + pos0] = rs; RSTDW[e1 * NTOK + pos1] = rs;
            *(int4*)(TOKINFO + 4 * tok) = make_int4(e0, pos0, e1, pos1);
        }
        __syncthreads();
    }
}

__device__ __forceinline__ void build_tables(Frame& F) {
    LAS int* T = (LAS int*)(F.lds + TBL_OFF);
    __syncthreads();
    if (F.tid < NEXP) {
        const int c = (int)__hip_atomic_load(F.ctl + CW_CNT + F.tid, __ATOMIC_RELAXED, __HIP_MEMORY_SCOPE_AGENT); const int mt = (c + 255) >> 8;
        int incl = mt;
#pragma unroll
        for (int o = 1; o < 64; o <<= 1) { const int v = __shfl_up(incl, o); if (F.tid >= o) incl += v; }
        const int st = incl - mt;
        T[TBL_TSTART + F.tid] = st; T[TBL_CNTS + F.tid] = c;
        for (int i = 0; i < mt; ++i) T[TBL_TE + st + i] = F.tid;
        if (F.tid == NEXP - 1) { T[TBL_TSTART + NEXP] = incl; T[TBL_NT] = incl; }
    }
    __syncthreads();
}
struct MoeGather {
    const int* list; const LAS int* T; LAS int* tokbuf; int NT; const float* rstdw; const float* gatew;
    __device__ __forceinline__ void info(const pg8::Unit& u, int& e, int& base, int& cnt) const { e = u.pn / NT; base = (u.pm - T[TBL_TSTART + e]) * 256; cnt = T[TBL_CNTS + e]; }
    __device__ __forceinline__ unsigned tok_direct(const pg8::Unit& u, int row) const { int e, base, cnt; info(u, e, base, cnt); const int idx = base + row; return idx < cnt ? (unsigned)list[e * NTOK + idx] : 0u; }
    __device__ __forceinline__ void issue(const pg8::Unit& u, int par, int lane) const { int e, base, cnt; info(u, e, base, cnt);
        __builtin_amdgcn_global_load_lds((const unsigned*)(list + e * NTOK + base + 4 * lane), (LAS unsigned*)(tokbuf + par * 256), 16, 0, 0);
        __builtin_amdgcn_global_load_lds((const unsigned*)(rstdw + e * NTOK + base + 4 * lane), (LAS unsigned*)(tokbuf + 512 + par * 256), 16, 0, 0);
        __builtin_amdgcn_global_load_lds((const unsigned*)(gatew + e * NTOK + base + 4 * lane), (LAS unsigned*)(tokbuf + 1024 + par * 256), 16, 0, 0); }
    __device__ __forceinline__ void direct_rg(const pg8::Unit& u, int row, float& rs, float& gw) const { int e, base, cnt; info(u, e, base, cnt); rs = rstdw[e * NTOK + base + row]; gw = gatew[e * NTOK + base + row]; }
    __device__ __forceinline__ unsigned tok_lds(const pg8::Unit& u, int par, int row) const { int e, base, cnt; info(u, e, base, cnt); const unsigned t = (unsigned)tokbuf[par * 256 + row]; return (base + row) < cnt ? t : 0u; }
};
namespace pg8 {
template <class Epi, class Sched>
__device__ __forceinline__ void gemm_phase_g(PG8_LAS unsigned char* lds, const Gemm g, const Sched& S, const Epi& E, const MoeGather& GA) {
    const int tid = threadIdx.x, wid = __builtin_amdgcn_readfirstlane(tid >> 6), lane = tid & 63, wr = wid >> 2, wc = wid & 3, fr = lane & 15, fq = lane >> 4;
    const int K = g.K, nt = K / BK;
    unsigned voffB[2], cofA[2]; int rowA[2];
#pragma unroll
    for (int i = 0; i < 2; ++i) { int R, C; stage_rc(tid * 16 + i * 8192, R, C); const int Rb = Epi::PERM ? ((R & ~31) + perm32(R & 31)) : R;
        rowA[i] = R; cofA[i] = (unsigned)C * 2u; voffB[i] = (unsigned)(Rb * K + C) * 2u; }
    const unsigned rowbytes = (unsigned)K * 2u;
    const size_t kstep = (size_t)(BK * 2);
    const size_t hstep = (size_t)HALF * K * 2;
    const size_t tstep = 2 * hstep;
    const unsigned ldsw = (unsigned)wid * 1024u;
    const int aoff = lds_byte(wr * 64 + fr, fq * 8), boff = lds_byte(wc * 32 + fr, fq * 8);
#define PG8_SA(b, h) (((b) * 2 + (h)) * HTB)
#define PG8_SB(b, h) ((4 + (b) * 2 + (h)) * HTB)
#define PG8_STAGE(bufoff, gbase, voff) do { _Pragma("unroll") for (int _i = 0; _i < 2; ++_i) \
        __builtin_amdgcn_global_load_lds((const unsigned*)((const char*)(gbase) + (voff)[_i]), (PG8_LAS unsigned*)(lds + (bufoff) + ldsw + _i * 8192), 16, 0, 0); } while (0)
#define PG8_LDA(dst, b, h) do { _Pragma("unroll") for (int m = 0; m < 4; ++m) _Pragma("unroll") for (int k = 0; k < 2; ++k) dst[m][k] = *(const PG8_LAS bf16x8*)(lds + PG8_SA(b, h) + aoff + m * 2048 + k * 1024); } while (0)
#define PG8_LDB(dst, b, h) do { _Pragma("unroll") for (int n = 0; n < 2; ++n) _Pragma("unroll") for (int k = 0; k < 2; ++k) dst[n][k] = *(const PG8_LAS bf16x8*)(lds + PG8_SB(b, h) + boff + n * 2048 + k * 1024); } while (0)
#define PG8_MMA(ai, bj, At, Bt) do { __builtin_amdgcn_s_setprio(1); _Pragma("unroll") for (int m = 0; m < 4; ++m) _Pragma("unroll") for (int n = 0; n < 2; ++n) _Pragma("unroll") for (int k = 0; k < 2; ++k) \
        acc[ai][bj][m][n] = __builtin_amdgcn_mfma_f32_16x16x32_bf16(Bt[n][k], At[m][k], acc[ai][bj][m][n], 0, 0, 0); __builtin_amdgcn_s_setprio(0); } while (0)
#define PG8_WAIT_V(n) asm volatile("s_waitcnt vmcnt(" #n ")" ::: "memory")
#define PG8_WAIT_L(n) asm volatile("s_waitcnt lgkmcnt(" #n ")" ::: "memory")
#define PG8_BAR __builtin_amdgcn_s_barrier()
#define PG8_SCHED __builtin_amdgcn_sched_barrier(0)
    Unit cur, nxt; int ui = 0;
    if (!S.next(0, cur)) return;
    f32x4 acc[2][2][4][2];
#pragma unroll
    for (int a = 0; a < 2; ++a)
#pragma unroll
        for (int b = 0; b < 2; ++b)
#pragma unroll
            for (int m = 0; m < 4; ++m)
#pragma unroll
                for (int n = 0; n < 2; ++n) acc[a][b][m][n] = (f32x4){0.f, 0.f, 0.f, 0.f};
    bf16x8 At[4][2], B0[2][2], B1[2][2];
    const char* A0 = (const char*)g.A; const char* cB = (const char*)g.Bt + (size_t)cur.pn * tstep;
    PG8_LAS int* tb = GA.tokbuf;
    if (tid < 256) { tb[tid] = (int)GA.tok_direct(cur, tid); float rs_, gw_; GA.direct_rg(cur, tid, rs_, gw_); ((PG8_LAS float*)tb)[512 + tid] = rs_; ((PG8_LAS float*)tb)[1024 + tid] = gw_; }
    PG8_WAIT_L(0); PG8_BAR;
#define PG8_OFFS(dst, par, half) do { _Pragma("unroll") for (int _i = 0; _i < 2; ++_i) dst[_i] = (unsigned)tb[(par) * 256 + (half) * HALF + rowA[_i]] * rowbytes + cofA[_i]; } while (0)
    {
        unsigned c0[2], c1[2]; PG8_OFFS(c0, 0, 0); PG8_OFFS(c1, 0, 1);
        PG8_STAGE(PG8_SB(0, 0), cB, voffB); PG8_STAGE(PG8_SB(0, 1), cB + hstep, voffB); PG8_STAGE(PG8_SA(0, 0), A0, c0); PG8_STAGE(PG8_SA(0, 1), A0, c1);
        if (wr == 1) PG8_BAR;
        PG8_WAIT_V(2); PG8_BAR;
        PG8_STAGE(PG8_SB(1, 0), cB + kstep, voffB); PG8_STAGE(PG8_SA(1, 0), A0 + kstep, c0); PG8_STAGE(PG8_SB(1, 1), cB + hstep + kstep, voffB);
        PG8_WAIT_V(6); PG8_BAR;
    }
    int t_issue = 2, t_fix = 6; asm volatile("" : "+s"(t_issue), "+s"(t_fix));
    for (;;) {
        const bool has_next = S.next(ui + 1, nxt);
        const char* nB = has_next ? (const char*)g.Bt + (size_t)nxt.pn * tstep : cB;
        const int pc = ui & 1, pnx = (ui + 1) & 1;
        for (int t = 0; t < nt; t += 2) {
            const bool last = (t == nt - 2);
            const char* a1 = A0 + (size_t)(t + 1) * kstep;
            const char* a2 = last ? A0 : A0 + (size_t)(t + 2) * kstep; const char* b2 = last ? nB : cB + (size_t)(t + 2) * kstep;
            const char* a3 = a2 + kstep; const char* b3 = b2 + kstep;
            if (t == t_fix && has_next && tid < 256) { int e_, base_, cnt_; GA.info(nxt, e_, base_, cnt_); if (base_ + tid >= cnt_) tb[pnx * 256 + tid] = 0; }
            const int ps = (last && has_next) ? pnx : pc;
            unsigned c1[2], s0[2], s1[2]; PG8_OFFS(c1, pc, 1); PG8_OFFS(s0, ps, 0); PG8_OFFS(s1, ps, 1);
            PG8_LDB(B0, 0, 0); PG8_LDB(B1, 0, 1); PG8_SCHED; PG8_LDA(At, 0, 0); PG8_STAGE(PG8_SA(1, 1), a1, c1);
            if (t == t_issue && has_next && wid == 0) GA.issue(nxt, pnx, lane);
            PG8_WAIT_V(8); PG8_WAIT_L(0); PG8_BAR; PG8_MMA(0, 0, At, B0); PG8_MMA(0, 1, At, B1); PG8_BAR; PG8_SCHED;
            PG8_LDA(At, 0, 1); PG8_STAGE(PG8_SB(0, 0), b2, voffB); PG8_STAGE(PG8_SB(0, 1), b2 + hstep, voffB); PG8_STAGE(PG8_SA(0, 0), a2, s0);
            PG8_WAIT_V(8); PG8_WAIT_L(0); PG8_BAR; PG8_MMA(1, 0, At, B0); PG8_MMA(1, 1, At, B1); PG8_BAR; PG8_SCHED;
            PG8_LDB(B0, 1, 0); PG8_LDB(B1, 1, 1); PG8_SCHED; PG8_LDA(At, 1, 0); PG8_STAGE(PG8_SA(0, 1), a2, s1);
            PG8_WAIT_V(8); PG8_WAIT_L(0); PG8_BAR; PG8_MMA(0, 0, At, B0); PG8_MMA(0, 1, At, B1); PG8_BAR; PG8_SCHED;
            PG8_LDA(At, 1, 1); PG8_STAGE(PG8_SB(1, 0), b3, voffB); PG8_STAGE(PG8_SB(1, 1), b3 + hstep, voffB); PG8_STAGE(PG8_SA(1, 0), a3, s0);
            PG8_WAIT_V(8); PG8_WAIT_L(0); PG8_BAR; PG8_MMA(1, 0, At, B0); PG8_MMA(1, 1, At, B1); PG8_BAR; PG8_SCHED;
        }
        if (wr == 0) PG8_BAR;
        E.par = pc; E(acc, cur, wr, wc, fr, fq); S.done(cur);
        if (!has_next) break;
#pragma unroll
        for (int a = 0; a < 2; ++a)
#pragma unroll
            for (int b = 0; b < 2; ++b)
#pragma unroll
                for (int m = 0; m < 4; ++m)
#pragma unroll
                    for (int n = 0; n < 2; ++n) acc[a][b][m][n] = (f32x4){0.f, 0.f, 0.f, 0.f};
        cur = nxt; cB = nB; ++ui;
        if (wr == 1) PG8_BAR;
    }
    PG8_WAIT_V(0);
    PG8_BAR;
#undef PG8_SA
#undef PG8_SB
#undef PG8_STAGE
#undef PG8_LDA
#undef PG8_LDB
#undef PG8_MMA
#undef PG8_WAIT_V
#undef PG8_WAIT_L
#undef PG8_BAR
#undef PG8_SCHED
#undef PG8_OFFS
}
}
struct MoeOrder {
    const LAS int* T; int NT, G, c;
    __device__ bool next(int i, pg8::Unit& u) const {
        const int L = i * G + c; if (L >= T[TBL_NT] * NT) return false;
        const int mt = L / NT; u.pm = mt; u.pn = T[TBL_TE + mt] * NT + (L % NT); return true;
    }
    __device__ __forceinline__ void a_ready(const pg8::Unit&) const {}
    __device__ __forceinline__ void done(const pg8::Unit&) const {}
};
struct EpiSwiGLU {
    static constexpr bool PERM = true, AFTER_DRAIN = false, MIDK = false;
    bf16* HDN; const LAS float* RG; const LAS int* T; mutable int par;
    __device__ __forceinline__ void operator()(const pg8::f32x4 (&acc)[2][2][4][2], const pg8::Unit& u, int wr, int wc, int fr, int fq) const {
        const int col0 = (u.pn & 3) * 128 + wc * 32 + 8 * fq; const int e = u.pn >> 2; const int base = (u.pm - T[TBL_TSTART + e]) * 256, cnt = T[TBL_CNTS + e];
#pragma unroll
        for (int ai = 0; ai < 2; ++ai)
#pragma unroll
            for (int m = 0; m < 4; ++m) { const int rl = ai * 128 + wr * 64 + m * 16 + fr; const int row = u.pm * 256 + rl; const bool ok = (base + rl) < cnt;
                const float rsr = RG[par * 256 + rl], gwr = RG[512 + par * 256 + rl];
                const float rs = ok ? rsr : 0.f, gw = ok ? gwr : 0.f;
                float o[8];
#pragma unroll
                for (int n = 0; n < 2; ++n)
#pragma unroll
                    for (int q = 0; q < 4; ++q) { const float g = acc[ai][0][m][n][q] * rs, up = acc[ai][1][m][n][q] * rs;
                        const float sg = g * __builtin_amdgcn_rcpf(1.0f + __builtin_amdgcn_exp2f(-g * LOG2E)); o[4 * n + q] = sg * up * gw; }
                v4u wv; wv.x = pk2(o[0], o[1]); wv.y = pk2(o[2], o[3]); wv.z = pk2(o[4], o[5]); wv.w = pk2(o[6], o[7]);
                *(v4u*)(HDN + (size_t)row * DEXP + col0) = wv; }
    }
};
struct EpiY {
    static constexpr bool PERM = true, AFTER_DRAIN = false, MIDK = false;
    bf16* Y; const LAS int* T;
    __device__ __forceinline__ void operator()(const pg8::f32x4 (&acc)[2][2][4][2], const pg8::Unit& u, int wr, int wc, int fr, int fq) const {
        const int col0 = (u.pn & 7) * 256 + wc * 32 + 8 * fq; const int e = u.pn >> 3; const int nvalid = T[TBL_CNTS + e] - (u.pm - T[TBL_TSTART + e]) * 256;
#pragma unroll
        for (int ai = 0; ai < 2; ++ai)
#pragma unroll
            for (int m = 0; m < 4; ++m) { const int rl = ai * 128 + wr * 64 + m * 16 + fr; bf16* rowp = Y + (size_t)(u.pm * 256 + rl) * DM + col0;
                if (rl < nvalid) {
#pragma unroll
                    for (int bj = 0; bj < 2; ++bj) { const pg8::f32x4 v0 = acc[ai][bj][m][0], v1 = acc[ai][bj][m][1];
                        v4u w; w.x = pk2(v0[0], v0[1]); w.y = pk2(v0[2], v0[3]); w.z = pk2(v1[0], v1[1]); w.w = pk2(v1[2], v1[3]); *(v4u*)(rowp + bj * 128) = w; } } }
    }
};
struct P8Row { v4u h[4], a[4], b[4]; };
__device__ __forceinline__ void p8_load(P8Row& r, const bf16* HB, const bf16* Y, const LAS int* T, int4 ti, int t, int lane) {
    const size_t s0 = (size_t)T[TBL_TSTART + ti.x] * 256 + ti.y, s1 = (size_t)T[TBL_TSTART + ti.z] * 256 + ti.w;
    const v4u* hp = (const v4u*)(HB + (size_t)t * DM) + lane; const v4u* y0 = (const v4u*)(Y + s0 * DM) + lane; const v4u* y1 = (const v4u*)(Y + s1 * DM) + lane;
#pragma unroll
    for (int j = 0; j < 4; ++j) { r.h[j] = __builtin_nontemporal_load(hp + 64 * j); r.a[j] = __builtin_nontemporal_load(y0 + 64 * j); r.b[j] = __builtin_nontemporal_load(y1 + 64 * j); }
}
__device__ __forceinline__ void p8_combine(Frame& F) {
    const LAS int* T = (const LAS int*)(F.lds + TBL_OFF);
    const int gw = F.vcu * NWAVES + F.wave, NGW = F.G * NWAVES;
    const bf16* Y = (const bf16*)(F.ws + WS_Y); const bf16* HB = (const bf16*)(F.ws + WS_HB); const int* TOKINFO = (const int*)(F.ws + WS_TOKINFO);
    constexpr int RPW = 8;
    int4 ti[RPW];
#pragma unroll
    for (int k = 0; k < RPW; ++k) { const int t = gw + k * NGW; ti[k] = (t < NTOK) ? *(const int4*)(TOKINFO + 4 * t) : make_int4(0, 0, 0, 0); }
    P8Row cur; if (gw < NTOK) p8_load(cur, HB, Y, T, ti[0], gw, F.lane);
#pragma unroll
    for (int k = 0; k < RPW; ++k) {
        const int t = gw + k * NGW; if (t >= NTOK) break;
        P8Row nxt; const int tn = t + NGW;
        if (k + 1 < RPW && tn < NTOK) p8_load(nxt, HB, Y, T, ti[k + 1 < RPW ? k + 1 : k], tn, F.lane);
        f32x4* od = (f32x4*)(F.out + (size_t)t * DM) + 2 * F.lane;
#pragma unroll
        for (int j = 0; j < 4; ++j) {
            const v4u h = cur.h[j], a = cur.a[j], b = cur.b[j]; f32x4 v0, v1;
            v0[0] = bf_lo(h.x) + bf_lo(a.x) + bf_lo(b.x); v0[1] = bf_hi(h.x) + bf_hi(a.x) + bf_hi(b.x); v0[2] = bf_lo(h.y) + bf_lo(a.y) + bf_lo(b.y); v0[3] = bf_hi(h.y) + bf_hi(a.y) + bf_hi(b.y);
            v1[0] = bf_lo(h.z) + bf_lo(a.z) + bf_lo(b.z); v1[1] = bf_hi(h.z) + bf_hi(a.z) + bf_hi(b.z); v1[2] = bf_lo(h.w) + bf_lo(a.w) + bf_lo(b.w); v1[3] = bf_hi(h.w) + bf_hi(a.w) + bf_hi(b.w);
            od[128 * j] = v0; od[128 * j + 1] = v1;
        }
        cur = nxt;
    }
    for (int t = gw + RPW * NGW; t < NTOK; t += NGW) {
        const int4 tj = *(const int4*)(TOKINFO + 4 * t); P8Row r; p8_load(r, HB, Y, T, tj, t, F.lane);
        f32x4* od = (f32x4*)(F.out + (size_t)t * DM) + 2 * F.lane;
#pragma unroll
        for (int j = 0; j < 4; ++j) {
            const v4u h = r.h[j], a = r.a[j], b = r.b[j]; f32x4 v0, v1;
            v0[0] = bf_lo(h.x) + bf_lo(a.x) + bf_lo(b.x); v0[1] = bf_hi(h.x) + bf_hi(a.x) + bf_hi(b.x); v0[2] = bf_lo(h.y) + bf_lo(a.y) + bf_lo(b.y); v0[3] = bf_hi(h.y) + bf_hi(a.y) + bf_hi(b.y);
            v1[0] = bf_lo(h.z) + bf_lo(a.z) + bf_lo(b.z); v1[1] = bf_hi(h.z) + bf_hi(a.z) + bf_hi(b.z); v1[2] = bf_lo(h.w) + bf_lo(a.w) + bf_lo(b.w); v1[3] = bf_hi(h.w) + bf_hi(a.w) + bf_hi(b.w);
            od[128 * j] = v0; od[128 * j + 1] = v1;
        }
    }
}

__global__ void __launch_bounds__(NWAVES * 64, 2) mk_fwd(Args args) {
    extern __shared__ __attribute__((aligned(16))) unsigned char lds[];
    Frame F;
    F.lds = (LAS unsigned char*)lds; F.ws = args.ws; F.ctl = (unsigned*)(args.ws + WS_CTL);
    F.tid = threadIdx.x; F.lane = F.tid & 63; F.wave = __builtin_amdgcn_readfirstlane(F.tid >> 6);
    F.G = gridDim.x; { const int bx = blockIdx.x; F.vcu = (F.G % 8 == 0) ? (bx % 8) * (F.G / 8) + bx / 8 : bx; }
    F.in = args.in; F.out = args.out;
    volatile LAS unsigned* MISC = (volatile LAS unsigned*)(F.lds + MISC_OFF);
    if (F.tid < 64) MISC[F.tid] = 0u;
    __syncthreads();
    const int lo = args.ph_lo, hi = args.ph_hi;
    const bool use_bar = (hi - lo) > 1;
    XcdBarrier bar; bar.bar = F.ctl + CW_BAR + args.li * XCD_BAR_WORDS; bar.x = 0; bar.st = nullptr;
    if (use_bar) bar = xcd_barrier_post(F.ctl + CW_BAR + args.li * XCD_BAR_WORDS, MISC + 8);
#define IN(k) (lo <= (k) && (k) < hi)
#define SEAM(k) do { if (IN(k) && (IN((k) + 1) || ((k) == 4 && IN(6)))) xcd_barrier(bar); } while (0)
    bf16* BIG = (bf16*)(F.ws + WS_BIG);

    if (IN(0)) { p0_prologue(F); SEAM(0); }
    if (IN(1)) {
        pg8::Gemm g{BIG, BIG, 0, 0, DM}; P1Order S{F.G, F.vcu};
        EpiQKV E{(bf16*)(F.ws + WS_QS), (bf16*)(F.ws + WS_KS), (bf16*)(F.ws + WS_QW), (bf16*)(F.ws + WS_KW), (bf16*)(F.ws + WS_VT), F.in[5], F.in[6]};
        pg8::gemm_phase<EpiQKV, P1Order, true, true>(F.lds + RING_OFF, g, S, E);
        {
            const int rounds = (P1_UNITS + F.G - 1) / F.G, first_idle = P1_UNITS - (rounds - 1) * F.G, nidle = F.G - first_idle;
            const int base = NITEMS - TAIL6_ITEMS - tail1_items(F.G);
            if (F.vcu >= first_idle) conv_range(F, base + (F.vcu - first_idle) * NWAVES + F.wave, nidle * NWAVES, NITEMS - TAIL6_ITEMS);
        }
        SEAM(1);
    }
    if (IN(2)) { p2_attention(F); SEAM(2); }
    if (IN(3)) {
        pg8::Gemm g{(const bf16*)(F.ws + WS_MIXED), (const bf16*)(F.ws + WS_WOUT), NTOK, DM, DM}; pg8::StaticOrder S; S.init(NTOK, DM, F.G, (int)blockIdx.x);
        LAS float* RS = (LAS float*)(F.lds + ATT_TBR_OFF);
        {   const float* SSQ = (const float*)(F.ws + WS_SSQ);
            for (int i = 0; i < 4; ++i) { pg8::Unit u; if (!S.next(i, u)) break;
                if (F.tid < 256) { const pg8::f32x4* q = (const pg8::f32x4*)(SSQ + (size_t)(u.pm * 256 + F.tid) * 16); const pg8::f32x4 a = q[0], b = q[1], c = q[2], d = q[3];
                    float sb = 0.f, sw = 0.f;
#pragma unroll
                    for (int q_ = 0; q_ < ATT_WAVES; ++q_) { sb += (q_ < 4 ? a[q_ & 3] : b[q_ & 3]); sw += (q_ < 4 ? c[q_ & 3] : d[q_ & 3]); }
                    RS[(i * 256 + F.tid) * 2] = 1.0f / sqrtf(sb * (1.0f / 1024.0f) + RMS_EPS); RS[(i * 256 + F.tid) * 2 + 1] = 1.0f / sqrtf(sw * (1.0f / 1024.0f) + RMS_EPS);
                    RS[2048 + i * 256 + F.tid] = ((const float*)(F.ws + WS_RINV))[u.pm * 256 + F.tid]; } }
            __syncthreads(); }
        EpiRes E{(bf16*)(F.ws + WS_HB), RS, (const bf16*)(F.ws + WS_BIG), 0};
        pg8::gemm_phase<EpiRes, pg8::StaticOrder, true, true>(F.lds + RING_OFF, g, S, E);
        SEAM(3);
    }
    if (IN(4)) { p4_router(F); SEAM(4); }
    if (IN(5) || IN(6) || IN(7) || IN(8)) build_tables(F);
    if (IN(6)) {
        pg8::Gemm g{(const bf16*)(F.ws + WS_HB), (const bf16*)(F.ws + WS_WGU), 0, 0, DM}; MoeOrder S{(const LAS int*)(F.lds + TBL_OFF), 4, F.G, F.vcu};
        MoeGather GA{(const int*)(F.ws + WS_LIST), (const LAS int*)(F.lds + TBL_OFF), (LAS int*)(F.lds + TOKBUF_OFF), 4, (const float*)(F.ws + WS_RSTDW), (const float*)(F.ws + WS_GATEW)};
        EpiSwiGLU E{(bf16*)(F.ws + WS_HDN), (const LAS float*)(F.lds + TOKBUF_OFF + 2048), (const LAS int*)(F.lds + TBL_OFF), 0};
        pg8::gemm_phase_g<EpiSwiGLU, MoeOrder>(F.lds + RING_OFF, g, S, E, GA);
        {
            const int units = S.T[TBL_NT] * 4, rounds = (units + F.G - 1) / F.G, first_idle = units - (rounds - 1) * F.G, nidle = F.G - first_idle;
            const int base = NITEMS - TAIL6_ITEMS; int mid = base + nidle * NWAVES * TAIL6_PER_WAVE; if (mid > NITEMS) mid = NITEMS;
            if (nidle > 0 && F.vcu >= first_idle) conv_range(F, base + (F.vcu - first_idle) * NWAVES + F.wave, nidle * NWAVES, mid);
            conv_range(F, mid + F.vcu * NWAVES + F.wave, F.G * NWAVES, NITEMS);
        }
        SEAM(6);
    }
    if (IN(7)) {
        pg8::Gemm g{(const bf16*)(F.ws + WS_HDN), (const bf16*)(F.ws + WS_WD), 0, 0, DEXP}; MoeOrder S{(const LAS int*)(F.lds + TBL_OFF), 8, F.G, F.vcu};
        EpiY E{(bf16*)(F.ws + WS_Y), (const LAS int*)(F.lds + TBL_OFF)};
        pg8::gemm_phase<EpiY, MoeOrder, true, true>(F.lds + RING_OFF, g, S, E);
        SEAM(7);
    }
    if (IN(8)) p8_combine(F);
#undef IN
#undef SEAM
}

extern "C" void kernel_launch(void* const* d_in, const int* in_sizes, int n_in, void* d_out, int out_size, void* d_ws, size_t ws_size, hipStream_t stream) {
    static int grid = 0;
    if (grid == 0) {
        if (n_in != 19 || out_size != NTOK * DM || ws_size < WS_END) { fprintf(stderr, "kernel_launch: unexpected shapes (n_in %d out %d ws %zu)\n", n_in, out_size, ws_size); grid = -1; return; }
        int dev = 0, cus = 0, per_cu = 0;
        if (hipGetDevice(&dev) != hipSuccess || hipDeviceGetAttribute(&cus, hipDeviceAttributeMultiprocessorCount, dev) != hipSuccess) { grid = -1; return; }
        if (hipFuncSetAttribute((const void*)mk_fwd, hipFuncAttributeMaxDynamicSharedMemorySize, LDS_BYTES) != hipSuccess) { fprintf(stderr, "kernel_launch: hipFuncSetAttribute failed\n"); grid = -1; return; }
        if (hipOccupancyMaxActiveBlocksPerMultiprocessor(&per_cu, (const void*)mk_fwd, NWAVES * 64, LDS_BYTES) != hipSuccess || per_cu < 1) { fprintf(stderr, "kernel_launch: occupancy query reports %d\n", per_cu); }
        (void)hipGetLastError();
        grid = cus;
    }
    if (grid < 0) return;
    (void)hipMemsetAsync((char*)d_ws + WS_CTL, 0, CTL_ZERO_BYTES, stream);
    Args a{};
    for (int i = 0; i < 19; ++i) a.in[i] = (const float*)d_in[i];
    a.out = (float*)d_out; a.ws = (unsigned char*)d_ws;
#if MK_N_LAUNCHES == 1
    a.ph_lo = 0; a.ph_hi = N_PHASES; a.li = 0;
    hipLaunchKernelGGL(mk_fwd, dim3(grid), dim3(NWAVES * 64), LDS_BYTES, stream, a);
#else
    a.li = 0;
    for (int p = 0; p < N_PHASES; ++p) { a.ph_lo = p; a.ph_hi = p + 1; hipLaunchKernelGGL(mk_fwd, dim3(grid), dim3(NWAVES * 64), LDS_BYTES, stream, a); }
#endif
}
```

```cpp
#include <hip/hip_runtime.h>
#include <cstdio>
#include <cstdint>
#define TAIL1_PW 24
#define TAIL6_PW 34
namespace pg8 {
#define PG8_LAS __attribute__((address_space(3)))
typedef unsigned short bf16_t;
typedef short bf16x8 __attribute__((ext_vector_type(8)));
typedef float f32x4 __attribute__((ext_vector_type(4)));
typedef unsigned u32x4 __attribute__((ext_vector_type(4)));
constexpr int BM = 256, BK = 64, HALF = 128, HTB = HALF * BK * 2  , STAGE_BYTES = 8 * HTB, NXCD = 8, WGM = 8;

__host__ __device__ __forceinline__ int lds_byte(int r, int c) { const int st = (r >> 4) * 2 + (c >> 5), rr = r & 15, cc = c & 31, ob = rr * 64 + cc * 2; return st * 1024 + (ob ^ (((ob >> 9) & 1) << 5)); }
__host__ __device__ __forceinline__ void stage_rc(int b, int& R, int& C) { const int st = b / 1024, sb = b % 1024, swz = sb ^ (((sb >> 9) & 1) << 5); R = (st >> 1) * 16 + swz / 64; C = (st & 1) * 32 + (swz % 64) / 2; }
__host__ __device__ __forceinline__ int perm32(int rho) { const int n = rho >> 4, i = rho & 15; return 8 * (i >> 2) + 4 * n + (i & 3); }

struct Unit { int pm, pn; };
struct Gemm { const bf16_t* A; const bf16_t* Bt; int M, N, K; };

struct StaticOrder {
    int nM, nN, nwg, G, c;
    __host__ __device__ void init(int M, int N, int G_, int c_) { nM = M / BM; nN = N / BM; nwg = nM * nN; G = G_; c = c_; }
    __host__ __device__ bool next(int i, Unit& u) const {
        const long L = (long)i * G + c; if (L >= nwg) return false;
        int wgid = (int)L; { const int q = nwg / NXCD, r = nwg % NXCD, xcd = wgid % NXCD, off = wgid / NXCD; wgid = (xcd < r ? xcd * (q + 1) : r * (q + 1) + (xcd - r) * q) + off; }
        const int nig = WGM * nN, gid = wgid / nig, fm = gid * WGM, gsz = (nM - fm) < WGM ? (nM - fm) : WGM;
        u.pm = fm + ((wgid % nig) % gsz); u.pn = (wgid % nig) / gsz; return true;
    }
    __device__ __forceinline__ void a_ready(const Unit&) const {}
    __device__ __forceinline__ void done(const Unit&) const {}
};

__device__ __forceinline__ unsigned cvt_pk_bf16(float lo, float hi) { unsigned r; asm volatile("v_cvt_pk_bf16_f32 %0, %1, %2" : "=v"(r) : "v"(lo), "v"(hi)); return r; }
typedef float f32x2 __attribute__((ext_vector_type(2)));
__device__ __forceinline__ f32x2 gelu_pk(f32x2 v) {
    const f32x2 av = __builtin_elementwise_abs(v), d = av * 0.2316418882f + 1.0f;
    f32x2 t; t.x = __builtin_amdgcn_rcpf(d.x); t.y = __builtin_amdgcn_rcpf(d.y);
    f32x2 q = t * 0.5307027145f + (-0.7265760135f); q = q * t + 0.7107068705f; q = q * t + (-0.142248368f); q = q * t + 0.127414796f; q = q * t;
    const f32x2 s = (v * v) * (-0.72134752044f);
    f32x2 e; e.x = __builtin_amdgcn_exp2f(s.x); e.y = __builtin_amdgcn_exp2f(s.y);
    const f32x2 m = v * (q * e), r = v - m;
    f32x2 o; o.x = v.x < 0.f ? m.x : r.x; o.y = v.y < 0.f ? m.y : r.y; return o;
}

template <int ACT  > struct EpiBf16 {
    static constexpr bool PERM = true, AFTER_DRAIN = false; static_assert(ACT == 0 || ACT == 1, "EpiBf16: ACT is 0 (none) or 1 (gelu_pk)");
    bf16_t* O; int ldc; const float* bias; int split_cols; size_t split_stride; float scale0;
    __device__ __forceinline__ void operator()(const f32x4 (&acc)[2][2][4][2], const Unit& u, int wr, int wc, int fr, int fq) const {
        const int row0 = u.pm * BM + wr * 64 + fr; int colt = u.pn * BM; bf16_t* base = O;
        float sc = 1.f; if (split_cols) { const int t = colt / split_cols; base += (size_t)t * split_stride; colt -= t * split_cols; if (t == 0) sc = scale0; }
        const int col0 = colt + wc * 32 + 8 * fq, bcol0 = u.pn * BM + wc * 32 + 8 * fq;
        f32x4 bv[2][2];
#pragma unroll
        for (int bj = 0; bj < 2; ++bj)
#pragma unroll
            for (int n = 0; n < 2; ++n) bv[bj][n] = bias ? *(const f32x4*)(bias + bcol0 + bj * HALF + 4 * n) : (f32x4){0.f, 0.f, 0.f, 0.f};
#pragma unroll
        for (int ai = 0; ai < 2; ++ai)
#pragma unroll
            for (int m = 0; m < 4; ++m) { bf16_t* rowp = base + (size_t)(row0 + ai * HALF + m * 16) * ldc + col0;
#pragma unroll
                for (int bj = 0; bj < 2; ++bj) { f32x4 v0 = acc[ai][bj][m][0] + bv[bj][0], v1 = acc[ai][bj][m][1] + bv[bj][1];
                    if (ACT == 1) { f32x2 a = gelu_pk((f32x2){v0[0], v0[1]}), b = gelu_pk((f32x2){v0[2], v0[3]}), c = gelu_pk((f32x2){v1[0], v1[1]}), d = gelu_pk((f32x2){v1[2], v1[3]});
                        v0 = (f32x4){a.x, a.y, b.x, b.y}; v1 = (f32x4){c.x, c.y, d.x, d.y}; }
                    v0 = v0 * sc; v1 = v1 * sc; u32x4 w; w.x = cvt_pk_bf16(v0[0], v0[1]); w.y = cvt_pk_bf16(v0[2], v0[3]); w.z = cvt_pk_bf16(v1[0], v1[1]); w.w = cvt_pk_bf16(v1[2], v1[3]);
                    *(u32x4*)(rowp + bj * HALF) = w; } }
    }
};

struct PanelStats {
    unsigned* xbuf;
    unsigned* cnt;
    unsigned* tmo;
    int ntn; float eps;
    unsigned code;
    __device__ __forceinline__ bool run(const f32x4 (&v)[2][2][4][2], const Unit& u, int wr, int wc, int fr, int fq, PG8_LAS unsigned char* lds, int wid, int lane) const {
        typedef float f32x2v __attribute__((ext_vector_type(2)));
        PG8_LAS f32x2v* P = (PG8_LAS f32x2v*)lds;
        PG8_LAS f32x2v* S = (PG8_LAS f32x2v*)(lds + 8192);
        PG8_LAS unsigned* flag = (PG8_LAS unsigned*)(lds + 8192 + 2048);
#pragma unroll
        for (int ai = 0; ai < 2; ++ai)
#pragma unroll
            for (int m = 0; m < 4; ++m) {
                float s = 0.f;
#pragma unroll
                for (int bj = 0; bj < 2; ++bj)
#pragma unroll
                    for (int n = 0; n < 2; ++n) { const f32x4 x = v[ai][bj][m][n]; s += (x[0] + x[1]) + (x[2] + x[3]); }
                s += __shfl_xor(s, 16); s += __shfl_xor(s, 32);
                const float mw = s * (1.0f / 64.0f); float q = 0.f;
#pragma unroll
                for (int bj = 0; bj < 2; ++bj)
#pragma unroll
                    for (int n = 0; n < 2; ++n) { const f32x4 d = v[ai][bj][m][n] - mw; q += (d[0] * d[0] + d[1] * d[1]) + (d[2] * d[2] + d[3] * d[3]); }
                q += __shfl_xor(q, 16); q += __shfl_xor(q, 32);
                if (fq == 0) P[(ai * HALF + wr * 64 + m * 16 + fr) * 4 + wc] = (f32x2v){mw, q};
            }
        asm volatile("s_waitcnt lgkmcnt(0)" ::: "memory"); __builtin_amdgcn_s_barrier(); asm volatile("" ::: "memory");
#if defined(BROKEN_EXCHANGE_NO_WAIT)
#warning BROKEN CONTROL BUILD: the row-statistics exchange does not wait; results are wrong by design
        if (blockIdx.x >= 64) { const long long t0_ = clock64(); while (clock64() - t0_ < 60000) __builtin_amdgcn_s_sleep(8); }
#endif
        const int row = wid * 32 + (lane & 31);
        if (lane < 32) {
            const f32x2v a = P[row * 4 + 0], b = P[row * 4 + 1], c = P[row * 4 + 2], d = P[row * 4 + 3];
            const float mt = (a.x + b.x + c.x + d.x) * 0.25f;
            const float da = a.x - mt, db = b.x - mt, dc = c.x - mt, dd = d.x - mt;
            const float m2 = (a.y + b.y) + (c.y + d.y) + 64.0f * ((da * da + db * db) + (dc * dc + dd * dd));
            unsigned long long* slot = (unsigned long long*)xbuf + ((size_t)(u.pm * BM + row) * 4 + u.pn);
            __hip_atomic_store(slot, ((unsigned long long)__float_as_uint(m2) << 32) | __float_as_uint(mt), __ATOMIC_RELAXED, __HIP_MEMORY_SCOPE_AGENT);
        }
        asm volatile("s_waitcnt vmcnt(0)" ::: "memory");
        if (lane == 0) __hip_atomic_fetch_add(cnt + 64 * u.pm, 1u, __ATOMIC_RELAXED, __HIP_MEMORY_SCOPE_AGENT);
        if (wid == 0) {
            bool dead = false; const unsigned long long t0 = __builtin_amdgcn_s_memrealtime(); const unsigned want = 8u * (unsigned)ntn;
            for (;;) {
#if defined(BROKEN_EXCHANGE_NO_WAIT)
                break;
#endif
                if ((unsigned)__builtin_amdgcn_readfirstlane(__hip_atomic_load(cnt + 64 * u.pm, __ATOMIC_RELAXED, __HIP_MEMORY_SCOPE_AGENT)) >= want) break;
                if (__builtin_amdgcn_s_memrealtime() - t0 > 2000000ull) {
                    if (lane == 0) { unsigned expect = 0u; __hip_atomic_compare_exchange_strong(tmo + 1, &expect, code | (unsigned)(u.pm & 0xff), __ATOMIC_RELAXED, __ATOMIC_RELAXED, __HIP_MEMORY_SCOPE_AGENT);
                                     __hip_atomic_store(tmo, 1u, __ATOMIC_RELAXED, __HIP_MEMORY_SCOPE_AGENT); }
                    dead = true; break; }
                __builtin_amdgcn_s_sleep(2);
            }
            __builtin_amdgcn_fence(__ATOMIC_ACQUIRE, "agent");
            if (lane == 0) flag[0] = dead ? 1u : 0u;
        }
        asm volatile("s_waitcnt vmcnt(0) lgkmcnt(0)" ::: "memory"); __builtin_amdgcn_s_barrier(); asm volatile("" ::: "memory");
        const bool bad = flag[0] != 0u;
        if (lane < 32) {
            const unsigned long long* slot = (const unsigned long long*)xbuf + (size_t)(u.pm * BM + row) * 4; float mt[4], m2[4]; float ms = 0.f;
#pragma unroll
            for (int t = 0; t < 4; ++t) { if (t < ntn) { const unsigned long long w = __hip_atomic_load(slot + t, __ATOMIC_RELAXED, __HIP_MEMORY_SCOPE_AGENT); mt[t] = __uint_as_float((unsigned)w); m2[t] = __uint_as_float((unsigned)(w >> 32)); } else { mt[t] = 0.f; m2[t] = 0.f; } ms += mt[t]; }
            const float mean = ms / (float)ntn; float q = 0.f;
#pragma unroll
            for (int t = 0; t < 4; ++t) if (t < ntn) { const float dm = mt[t] - mean; q += m2[t] + 256.0f * dm * dm; }
            S[row] = (f32x2v){mean, 1.0f / sqrtf(q / (256.0f * (float)ntn) + eps)};
        }
        asm volatile("s_waitcnt lgkmcnt(0)" ::: "memory"); __builtin_amdgcn_s_barrier(); asm volatile("" ::: "memory");
        return bad;
    }
};
struct EpiLnRes {
    static constexpr bool PERM = false, AFTER_DRAIN = true;
    const float* base; float* out; int ldc; const float* bias; PanelStats st; unsigned poison;
    __device__ __forceinline__ void fused(f32x4 (&acc)[2][2][4][2], const Unit& u, int wr, int wc, int fr, int fq, PG8_LAS unsigned char* lds, int wid, int lane) const {
        typedef float f32x2v __attribute__((ext_vector_type(2)));
        const PG8_LAS f32x2v* S = (const PG8_LAS f32x2v*)(lds + 8192);
        const int col0 = u.pn * BM + wc * 32 + 4 * fq;
#pragma unroll
        for (int bj = 0; bj < 2; ++bj)
#pragma unroll
            for (int n = 0; n < 2; ++n) { const f32x4 bv = bias ? *(const f32x4*)(bias + col0 + bj * HALF + n * 16) : (f32x4){0.f, 0.f, 0.f, 0.f};
#pragma unroll
                for (int ai = 0; ai < 2; ++ai)
#pragma unroll
                    for (int m = 0; m < 4; ++m) acc[ai][bj][m][n] += bv; }
        f32x4 pre[4][2][2];
#pragma unroll
        for (int m = 0; m < 4; ++m) { const size_t off = (size_t)(u.pm * BM + wr * 64 + m * 16 + fr) * ldc + col0;
#pragma unroll
            for (int bj = 0; bj < 2; ++bj)
#pragma unroll
                for (int n = 0; n < 2; ++n) pre[m][bj][n] = *(const f32x4*)(base + off + bj * HALF + n * 16); }
        const bool bad = st.run(acc, u, wr, wc, fr, fq, lds, wid, lane) || poison != 0u;
        const float qnan = __builtin_nanf("");
#pragma unroll
        for (int ai = 0; ai < 2; ++ai)
#pragma unroll
            for (int m = 0; m < 4; ++m) { const int r = ai * HALF + wr * 64 + m * 16 + fr; const f32x2v sr = S[r]; const size_t off = (size_t)(u.pm * BM + r) * ldc + col0;
#pragma unroll
                for (int bj = 0; bj < 2; ++bj)
#pragma unroll
                    for (int n = 0; n < 2; ++n) { const f32x4 bs = ai == 0 ? pre[m][bj][n] : *(const f32x4*)(base + off + bj * HALF + n * 16); f32x4 o = bs + (acc[ai][bj][m][n] - sr.x) * sr.y;
                        if (bad) o = (f32x4){qnan, qnan, qnan, qnan}; *(f32x4*)(out + off + bj * HALF + n * 16) = o; }
                if (m & 1) asm volatile("" ::: "memory"); }
    }
};
struct EpiLnResLn {
    static constexpr bool PERM = false, AFTER_DRAIN = true;
    const float* base; float* out; bf16_t* xn; int ldc; const float* bias; PanelStats st1, st2; unsigned poison;
    __device__ __forceinline__ void fused(f32x4 (&acc)[2][2][4][2], const Unit& u, int wr, int wc, int fr, int fq, PG8_LAS unsigned char* lds, int wid, int lane) const {
        typedef float f32x2v __attribute__((ext_vector_type(2))); typedef unsigned u32x2v __attribute__((ext_vector_type(2)));
        const PG8_LAS f32x2v* S = (const PG8_LAS f32x2v*)(lds + 8192);
        const int col0 = u.pn * BM + wc * 32 + 4 * fq;
#pragma unroll
        for (int bj = 0; bj < 2; ++bj)
#pragma unroll
            for (int n = 0; n < 2; ++n) { const f32x4 bv = bias ? *(const f32x4*)(bias + col0 + bj * HALF + n * 16) : (f32x4){0.f, 0.f, 0.f, 0.f};
#pragma unroll
                for (int ai = 0; ai < 2; ++ai)
#pragma unroll
                    for (int m = 0; m < 4; ++m) acc[ai][bj][m][n] += bv; }
        bool bad = st1.run(acc, u, wr, wc, fr, fq, lds, wid, lane) || poison != 0u;
        const float qnan = __builtin_nanf("");
#pragma unroll
        for (int ai = 0; ai < 2; ++ai)
#pragma unroll
            for (int m = 0; m < 4; ++m) { const int r = ai * HALF + wr * 64 + m * 16 + fr; const f32x2v sr = S[r]; const size_t off = (size_t)(u.pm * BM + r) * ldc + col0;
#pragma unroll
                for (int bj = 0; bj < 2; ++bj)
#pragma unroll
                    for (int n = 0; n < 2; ++n) { const f32x4 bs = *(const f32x4*)(base + off + bj * HALF + n * 16); acc[ai][bj][m][n] = bs + (acc[ai][bj][m][n] - sr.x) * sr.y; }
                asm volatile("" : "+v"(acc[ai][0][m][0]), "+v"(acc[ai][0][m][1]), "+v"(acc[ai][1][m][0]), "+v"(acc[ai][1][m][1]));
                if (m & 1) asm volatile("" ::: "memory"); }
        const bool bad1 = bad;
        bad = st2.run(acc, u, wr, wc, fr, fq, lds, wid, lane) || bad;
#pragma unroll
        for (int ai = 0; ai < 2; ++ai)
#pragma unroll
            for (int m = 0; m < 4; ++m) { const int r = ai * HALF + wr * 64 + m * 16 + fr; const f32x2v sr = S[r]; const size_t off = (size_t)(u.pm * BM + r) * ldc + col0;
#pragma unroll
                for (int bj = 0; bj < 2; ++bj)
#pragma unroll
                    for (int n = 0; n < 2; ++n) { const f32x4 x1 = acc[ai][bj][m][n]; *(f32x4*)(out + off + bj * HALF + n * 16) = bad1 ? (f32x4){qnan, qnan, qnan, qnan} : x1;
                        const f32x4 o = (x1 - sr.x) * sr.y; u32x2v w; w.x = cvt_pk_bf16(o[0], o[1]); w.y = cvt_pk_bf16(o[2], o[3]);
                        if (bad) { w.x = 0x7fc07fc0u; w.y = 0x7fc07fc0u; } *(u32x2v*)(xn + off + bj * HALF + n * 16) = w; }
                asm volatile("" ::: "memory"); }
    }
};

template <class Epi, class Sched, bool ALIGN_EPI = false, bool SP2 = false>
__device__ __forceinline__ void gemm_phase(PG8_LAS unsigned char* lds, const Gemm g, const Sched& S, const Epi& E) {
    const int tid = threadIdx.x, wid = __builtin_amdgcn_readfirstlane(tid >> 6), lane = tid & 63, wr = wid >> 2, wc = wid & 3, fr = lane & 15, fq = lane >> 4;
    const int K = g.K, nt = K / BK;
    unsigned voffA[2], voffB[2];
#pragma unroll
    for (int i = 0; i < 2; ++i) { int R, C; stage_rc(tid * 16 + i * 8192, R, C); const int Rb = Epi::PERM ? ((R & ~31) + perm32(R & 31)) : R;
        voffA[i] = (unsigned)(R * K + C) * 2u; voffB[i] = (unsigned)(Rb * K + C) * 2u; }
    const size_t kstep = (size_t)(BK * 2);
    const size_t hstep = (size_t)HALF * K * 2;
    const size_t tstep = 2 * hstep;
    const unsigned ldsw = (unsigned)wid * 1024u;
    const int aoff = lds_byte(wr * 64 + fr, fq * 8), boff = lds_byte(wc * 32 + fr, fq * 8);
#define PG8_SA(b, h) (((b) * 2 + (h)) * HTB)
#define PG8_SB(b, h) ((4 + (b) * 2 + (h)) * HTB)
#define PG8_STAGE(bufoff, gbase, voff) do { _Pragma("unroll") for (int _i = 0; _i < 2; ++_i) \
        __builtin_amdgcn_global_load_lds((const unsigned*)((const char*)(gbase) + (voff)[_i]), (PG8_LAS unsigned*)(lds + (bufoff) + ldsw + _i * 8192), 16, 0, 0); } while (0)
#define PG8_LDA(dst, b, h) do { _Pragma("unroll") for (int m = 0; m < 4; ++m) _Pragma("unroll") for (int k = 0; k < 2; ++k) dst[m][k] = *(const PG8_LAS bf16x8*)(lds + PG8_SA(b, h) + aoff + m * 2048 + k * 1024); } while (0)
#define PG8_LDB(dst, b, h) do { _Pragma("unroll") for (int n = 0; n < 2; ++n) _Pragma("unroll") for (int k = 0; k < 2; ++k) dst[n][k] = *(const PG8_LAS bf16x8*)(lds + PG8_SB(b, h) + boff + n * 2048 + k * 1024); } while (0)
#define PG8_MMA(ai, bj, At, Bt) do { __builtin_amdgcn_s_setprio(1); _Pragma("unroll") for (int m = 0; m < 4; ++m) _Pragma("unroll") for (int n = 0; n < 2; ++n) _Pragma("unroll") for (int k = 0; k < 2; ++k) \
        acc[ai][bj][m][n] = __builtin_amdgcn_mfma_f32_16x16x32_bf16(Bt[n][k], At[m][k], acc[ai][bj][m][n], 0, 0, 0); __builtin_amdgcn_s_setprio(0); } while (0)
#define PG8_WAIT_V(n) asm volatile("s_waitcnt vmcnt(" #n ")" ::: "memory")
#define PG8_WAIT_L(n) asm volatile("s_waitcnt lgkmcnt(" #n ")" ::: "memory")
#define PG8_BAR __builtin_amdgcn_s_barrier()
#define PG8_SCHED __builtin_amdgcn_sched_barrier(0)
    Unit cur, nxt; int ui = 0;
    if (!S.next(0, cur)) return;
    f32x4 acc[2][2][4][2];
#pragma unroll
    for (int a = 0; a < 2; ++a)
#pragma unroll
        for (int b = 0; b < 2; ++b)
#pragma unroll
            for (int m = 0; m < 4; ++m)
#pragma unroll
                for (int n = 0; n < 2; ++n) acc[a][b][m][n] = (f32x4){0.f, 0.f, 0.f, 0.f};
    bf16x8 At[4][2], B0[2][2], B1[2][2];
    const char* cA = (const char*)g.A + (size_t)cur.pm * tstep; const char* cB = (const char*)g.Bt + (size_t)cur.pn * tstep;
    S.a_ready(cur);
    if constexpr (SP2) {
        PG8_STAGE(PG8_SB(0, 0), cB, voffB); PG8_STAGE(PG8_SB(0, 1), cB + hstep, voffB); PG8_STAGE(PG8_SA(0, 0), cA, voffA); PG8_STAGE(PG8_SA(0, 1), cA + hstep, voffA);
        if (wr == 1) PG8_BAR;
        PG8_WAIT_V(2); PG8_BAR;
        PG8_STAGE(PG8_SB(1, 0), cB + kstep, voffB); PG8_STAGE(PG8_SA(1, 0), cA + kstep, voffA); PG8_STAGE(PG8_SB(1, 1), cB + hstep + kstep, voffB);
        PG8_WAIT_V(6); PG8_BAR;
    } else {
        PG8_STAGE(PG8_SB(0, 0), cB, voffB); PG8_STAGE(PG8_SA(0, 0), cA, voffA); PG8_STAGE(PG8_SB(0, 1), cB + hstep, voffB); PG8_STAGE(PG8_SA(0, 1), cA + hstep, voffA);
        if (wr == 1) PG8_BAR;
        PG8_WAIT_V(4); PG8_BAR;
        PG8_STAGE(PG8_SB(1, 0), cB + kstep, voffB); PG8_STAGE(PG8_SA(1, 0), cA + kstep, voffA); PG8_STAGE(PG8_SB(1, 1), cB + hstep + kstep, voffB);
        PG8_WAIT_V(6); PG8_BAR;
    }
    int t_mid = nt >> 1; if constexpr (Epi::MIDK) asm volatile("" : "+s"(t_mid));
    for (;;) {
        const bool has_next = S.next(ui + 1, nxt);
        const char* nA = has_next ? (const char*)g.A + (size_t)nxt.pm * tstep : cA; const char* nB = has_next ? (const char*)g.Bt + (size_t)nxt.pn * tstep : cB;
        for (int t = 0; t < nt; t += 2) {
            const bool last = (t == nt - 2);
            if constexpr (Epi::MIDK) { if (t == t_mid) E.midk(acc, cur, wr, fr); }
            const char* a1 = cA + (size_t)(t + 1) * kstep;
            const char* a2 = last ? nA : cA + (size_t)(t + 2) * kstep; const char* b2 = last ? nB : cB + (size_t)(t + 2) * kstep;
            const char* a3 = a2 + kstep; const char* b3 = b2 + kstep;
            if (last && has_next) S.a_ready(nxt);
            if constexpr (SP2) {
            PG8_LDB(B0, 0, 0); PG8_LDB(B1, 0, 1); PG8_SCHED; PG8_LDA(At, 0, 0); PG8_STAGE(PG8_SA(1, 1), a1 + hstep, voffA);
            PG8_WAIT_V(8); PG8_WAIT_L(0); PG8_BAR; PG8_MMA(0, 0, At, B0); PG8_MMA(0, 1, At, B1); PG8_BAR; PG8_SCHED;
            PG8_LDA(At, 0, 1); PG8_STAGE(PG8_SB(0, 0), b2, voffB); PG8_STAGE(PG8_SB(0, 1), b2 + hstep, voffB); PG8_STAGE(PG8_SA(0, 0), a2, voffA);
            PG8_WAIT_V(8); PG8_WAIT_L(0); PG8_BAR; PG8_MMA(1, 0, At, B0); PG8_MMA(1, 1, At, B1); PG8_BAR; PG8_SCHED;
            PG8_LDB(B0, 1, 0); PG8_LDB(B1, 1, 1); PG8_SCHED; PG8_LDA(At, 1, 0); PG8_STAGE(PG8_SA(0, 1), a2 + hstep, voffA);
            PG8_WAIT_V(8); PG8_WAIT_L(0); PG8_BAR; PG8_MMA(0, 0, At, B0); PG8_MMA(0, 1, At, B1); PG8_BAR; PG8_SCHED;
            PG8_LDA(At, 1, 1); PG8_STAGE(PG8_SB(1, 0), b3, voffB); PG8_STAGE(PG8_SB(1, 1), b3 + hstep, voffB); PG8_STAGE(PG8_SA(1, 0), a3, voffA);
            PG8_WAIT_V(8); PG8_WAIT_L(0); PG8_BAR; PG8_MMA(1, 0, At, B0); PG8_MMA(1, 1, At, B1); PG8_BAR; PG8_SCHED;
            } else {
            PG8_LDB(B0, 0, 0); PG8_SCHED; PG8_LDA(At, 0, 0); PG8_STAGE(PG8_SA(1, 1), a1 + hstep, voffA);
            PG8_WAIT_L(8); PG8_BAR; PG8_WAIT_L(0); PG8_MMA(0, 0, At, B0); PG8_BAR; PG8_SCHED;
            PG8_LDB(B1, 0, 1); PG8_STAGE(PG8_SB(0, 0), b2, voffB);
            PG8_BAR; PG8_WAIT_L(0); PG8_MMA(0, 1, At, B1); PG8_BAR;
            PG8_LDA(At, 0, 1); PG8_STAGE(PG8_SA(0, 0), a2, voffA);
            PG8_BAR; PG8_WAIT_L(0); PG8_MMA(1, 0, At, B0); PG8_BAR; PG8_SCHED;
            PG8_STAGE(PG8_SB(0, 1), b2 + hstep, voffB);
            PG8_WAIT_V(6); PG8_BAR; PG8_MMA(1, 1, At, B1); PG8_BAR;
            PG8_LDB(B0, 1, 0); PG8_SCHED; PG8_LDA(At, 1, 0); PG8_STAGE(PG8_SA(0, 1), a2 + hstep, voffA);
            PG8_WAIT_L(8); PG8_BAR; PG8_WAIT_L(0); PG8_MMA(0, 0, At, B0); PG8_BAR; PG8_SCHED;
            PG8_LDB(B1, 1, 1); PG8_STAGE(PG8_SB(1, 0), b3, voffB);
            PG8_BAR; PG8_WAIT_L(0); PG8_MMA(0, 1, At, B1); PG8_BAR;
            PG8_LDA(At, 1, 1); PG8_STAGE(PG8_SA(1, 0), a3, voffA);
            PG8_BAR; PG8_WAIT_L(0); PG8_MMA(1, 0, At, B0); PG8_BAR; PG8_SCHED;
            PG8_STAGE(PG8_SB(1, 1), b3 + hstep, voffB);
            PG8_WAIT_V(6); PG8_BAR; PG8_MMA(1, 1, At, B1); PG8_BAR;
            }
        }
        if constexpr (ALIGN_EPI) { if (wr == 0) PG8_BAR; }
        if constexpr (!Epi::AFTER_DRAIN) { E(acc, cur, wr, wc, fr, fq); S.done(cur); }
        if (!has_next) break;
#pragma unroll
        for (int a = 0; a < 2; ++a)
#pragma unroll
            for (int b = 0; b < 2; ++b)
#pragma unroll
                for (int m = 0; m < 4; ++m)
#pragma unroll
                    for (int n = 0; n < 2; ++n) acc[a][b][m][n] = (f32x4){0.f, 0.f, 0.f, 0.f};
        cur = nxt; cA = nA; cB = nB; ++ui;
        if constexpr (ALIGN_EPI) { if (wr == 1) PG8_BAR; }
    }
    PG8_WAIT_V(0);
    if constexpr (!ALIGN_EPI) { if (wr == 0) PG8_BAR; }
    PG8_BAR;
    if constexpr (Epi::AFTER_DRAIN) { E.fused(acc, cur, wr, wc, fr, fq, lds, wid, lane); S.done(cur); }
#undef PG8_SA
#undef PG8_SB
#undef PG8_STAGE
#undef PG8_LDA
#undef PG8_LDB
#undef PG8_MMA
#undef PG8_WAIT_V
#undef PG8_WAIT_L
#undef PG8_BAR
#undef PG8_SCHED
}
}


#ifndef MK_N_LAUNCHES
#define MK_N_LAUNCHES 1
#endif
constexpr int N_PHASES = 9;
constexpr int NWAVES = 8;

constexpr int DM = 2048, BATCH = 4, SEQ = 4096, NTOK = BATCH * SEQ, NMETA = 16;
constexpr int MPAD = 16640, NTILE_X = MPAD / 256;
constexpr int N_QK = 3328, NT_QK = N_QK / 256;
constexpr int N_V = 1280, NT_V = N_V / 256;
constexpr int NT_W = NT_QK + NT_V;
constexpr int P1_UNITS_A = NTILE_X * NT_QK, P1_UNITS = P1_UNITS_A + NT_V * NTILE_X;
constexpr int NEXP = 64, DEXP = 512, MAXTILES = 192, SPAD = MAXTILES * 256;
constexpr float RMS_EPS = 1e-6f;
constexpr float LOG2E = 1.4426950408889634f;
constexpr float C2 = 0.125f * LOG2E;
constexpr float SB_EXIT = -150.0f;

constexpr size_t MiB = 1u << 20;
constexpr size_t WS_CTL = 0, CTL_ZERO_BYTES = 128 * 1024;
constexpr size_t WS_BIG = 1 * MiB;
constexpr size_t WS_QS = 84 * MiB, WS_KS = WS_QS + (size_t)MPAD * 1024 * 2, WS_QW = WS_KS + (size_t)MPAD * 1024 * 2, WS_KW = WS_QW + (size_t)MPAD * 1024 * 2;
constexpr size_t WS_VT = 190 * MiB;
constexpr size_t WS_MIXED = 231 * MiB, WS_HB = 295 * MiB;
constexpr size_t WS_Y = 1 * MiB;
constexpr size_t WS_PROJ = 359 * MiB;
constexpr size_t WS_HDN = 423 * MiB;
constexpr size_t WS_WOUT = 471 * MiB, WS_WR = 479 * MiB;
constexpr size_t WS_WGU = 480 * MiB, WS_WD = 736 * MiB;
constexpr size_t WS_LIST = 864 * MiB, WS_GATEW = 868 * MiB, WS_TOKINFO = 872 * MiB, WS_RSTD = 873 * MiB, WS_RSTDW = 874 * MiB;
constexpr size_t WS_RINV = 877 * MiB;
constexpr size_t WS_SSQ = 878 * MiB;
constexpr size_t WS_END = 880 * MiB;
static_assert(WS_RSTDW + (size_t)NEXP * NTOK * 4 <= WS_END, "ws map 4");
static_assert(WS_KW + (size_t)MPAD * 256 * 2 <= WS_VT && WS_VT + (size_t)N_V * MPAD * 2 <= WS_MIXED , "ws map 1");
static_assert(WS_Y + (size_t)SPAD * 2048 * 2 <= WS_MIXED && WS_HDN + (size_t)SPAD * 512 * 2 <= WS_WOUT && WS_HB + (size_t)NTOK * 2048 * 2 <= WS_HDN, "ws map 2");
static_assert(WS_BIG + (size_t)(NTILE_X + NT_W) * 256 * 2048 * 2 <= WS_QS, "ws map 3");
constexpr int CW_TMO = 0, CW_BAR = 4096, CW_CNT = 16384;

constexpr int RING_OFF = 0, RING_BYTES = 131072;
constexpr int MISC_OFF = RING_BYTES;
constexpr int TBL_OFF = MISC_OFF + 256;
constexpr int TBL_TSTART = 0, TBL_NT = 65, TBL_TE = 66, TBL_CNTS = 66 + MAXTILES, TBL_WORDS = 66 + MAXTILES + 64;
constexpr int TOKBUF_OFF = MISC_OFF + 4096;
constexpr int ATT_TBR_OFF = TOKBUF_OFF + 6144;
constexpr int LDS_BYTES = 163840;
static_assert(TBL_OFF + TBL_WORDS * 4 <= TOKBUF_OFF && TOKBUF_OFF + 6144 <= LDS_BYTES && ATT_TBR_OFF + 16 * 192 * 4 <= LDS_BYTES, "LDS map");

#define LAS __attribute__((address_space(3)))
typedef unsigned short bf16;
typedef unsigned v4u __attribute__((ext_vector_type(4)));
typedef unsigned v2u __attribute__((ext_vector_type(2)));
typedef float f32x4 __attribute__((ext_vector_type(4)));
typedef float f32x16 __attribute__((ext_vector_type(16)));
typedef short bf16x8 __attribute__((ext_vector_type(8)));
typedef _Float16 f16x8 __attribute__((ext_vector_type(8)));
typedef _Float16 f16x2 __attribute__((ext_vector_type(2)));
typedef float f32x2 __attribute__((ext_vector_type(2)));
typedef __bf16 bf16x2_t __attribute__((ext_vector_type(2)));
#define LDS_WAIT() asm volatile("s_waitcnt lgkmcnt(0)" ::: "memory")
#define VM_WAIT() asm volatile("s_waitcnt vmcnt(0)" ::: "memory")
__device__ __forceinline__ unsigned pk2(float lo, float hi) { f32x2 v = {lo, hi}; bf16x2_t b = __builtin_convertvector(v, bf16x2_t); return __builtin_bit_cast(unsigned, b); }
__device__ __forceinline__ float bf_lo(unsigned u) { return __uint_as_float(u << 16); }
__device__ __forceinline__ float bf_hi(unsigned u) { return __uint_as_float(u & 0xffff0000u); }
__device__ __forceinline__ float wave_sum(float v) {
#pragma unroll
    for (int o = 1; o < 64; o <<= 1) v += __shfl_xor(v, o);
    return v;
}
__device__ __forceinline__ int crow(int reg, int h) { return (reg & 3) + 8 * (reg >> 2) + 4 * h; }

#define XB_TMO      128
#define XB_XCNT(j)  (256  + 64 * (j))
#define XB_XSUB(j)  (1280 + 64 * (j))
#define XB_XGEN(j)  (2304 + 64 * (j))
#define XB_TOP      3328
#define XB_TOPGEN   3392
#define XCD_BAR_WORDS 3456
#define XB_SPIN_CAP (1u << 18)

__device__ __forceinline__ unsigned xb_ld(unsigned* p)              { return __hip_atomic_load(p, __ATOMIC_RELAXED, __HIP_MEMORY_SCOPE_AGENT); }
__device__ __forceinline__ unsigned xb_add(unsigned* p, unsigned v) { return __hip_atomic_fetch_add(p, v, __ATOMIC_RELAXED, __HIP_MEMORY_SCOPE_AGENT); }
__device__ __forceinline__ unsigned xb_xcc_id() { return (unsigned)__builtin_amdgcn_s_getreg((3 << 11) | 20) & 0xFu; }
#define XB_SPIN(cond, bar) do { unsigned _sp = 0; while (cond) { __builtin_amdgcn_s_sleep(1); \
    if ((++_sp & 255u) == 0u) { if (xb_ld(&(bar)[XB_TMO])) break; if (_sp > XB_SPIN_CAP) { atomicAdd(&(bar)[XB_TMO], 1u); break; } } } } while (0)

struct XcdBarrier {
    unsigned* bar; unsigned x;
    volatile LAS unsigned* st;
};

__device__ __forceinline__ XcdBarrier xcd_barrier_post(unsigned* bar, volatile LAS unsigned* st) {
    XcdBarrier b; b.bar = bar; b.x = xb_xcc_id(); b.st = st;
    if (threadIdx.x == 0) (void)xb_add(&bar[XB_XCNT(b.x)], 1u);
    return b;
}
__device__ __forceinline__ void xcd_barrier_complete(unsigned* bar, unsigned x, unsigned& nloc, unsigned& nx) {
    const unsigned G = gridDim.x * gridDim.y * gridDim.z;
    unsigned sum, cnt, mine, sp = 0u;
    for (;;) {
        sum = 0u; cnt = 0u; mine = 0u;
#pragma unroll
        for (unsigned j = 0; j < 16; ++j) { const unsigned c = xb_ld(&bar[XB_XCNT(j)]); sum += c; cnt += (c > 0u) ? 1u : 0u; mine = (j == x) ? c : mine; }
        if (sum == G) break;
        __builtin_amdgcn_s_sleep(1);
        if ((++sp & 255u) == 0u) { if (xb_ld(&bar[XB_TMO])) break; if (sp > XB_SPIN_CAP) { atomicAdd(&bar[XB_TMO], 1u); break; } }
    }
    nloc = mine > 0u ? mine : 1u; nx = cnt > 0u ? cnt : 1u;
}

__device__ __forceinline__ void xcd_barrier(const XcdBarrier& b) {
    asm volatile("s_waitcnt vmcnt(0)" ::: "memory");
    __syncthreads();
    if (threadIdx.x == 0) {
        unsigned* bar = b.bar;
        __builtin_amdgcn_s_waitcnt(0);
        unsigned nloc = b.st[0], nx = b.st[1];
        if (nloc == 0u) { xcd_barrier_complete(bar, b.x, nloc, nx); b.st[0] = nloc; b.st[1] = nx; }
        const unsigned old = xb_add(&bar[XB_XSUB(b.x)], 1u);
        const unsigned gen = old / nloc;
        if (old + 1u == (gen + 1u) * nloc) {
            __builtin_amdgcn_fence(__ATOMIC_RELEASE, "agent");
            asm volatile("s_waitcnt vmcnt(0)" ::: "memory");
            const unsigned og = xb_add(&bar[XB_TOP], 1u);
            const unsigned tg = og / nx;
            if (og + 1u == (tg + 1u) * nx) xb_add(&bar[XB_TOPGEN], 1u);
            else XB_SPIN(xb_ld(&bar[XB_TOPGEN]) == tg, bar);
            __builtin_amdgcn_fence(__ATOMIC_ACQUIRE, "agent");
            xb_add(&bar[XB_XGEN(b.x)], 1u);
            asm volatile("s_waitcnt vmcnt(0)" ::: "memory");
        } else {
            XB_SPIN(xb_ld(&bar[XB_XGEN(b.x)]) == gen, bar);
            __builtin_amdgcn_fence(__ATOMIC_ACQUIRE, "agent");
            asm volatile("s_waitcnt vmcnt(0)" ::: "memory");
        }
    }
    __syncthreads();
}


struct Args { const float* in[19]; float* out; unsigned char* ws; int ph_lo, ph_hi, li, pad; };
struct Frame {
    LAS unsigned char* lds; unsigned* ctl; unsigned char* ws;
    int tid, lane, wave, vcu, G;
    const float* const* in; float* out;
};

struct TrItem { f32x4 v[16]; f32x4 g[4]; };
__device__ __forceinline__ void tr_load(TrItem& t, const float* srcp, int ldsrc, const float* gp) {
#pragma unroll
    for (int i = 0; i < 16; ++i) t.v[i] = __builtin_nontemporal_load((const f32x4*)(srcp + (size_t)i * ldsrc));
    if (gp) {
#pragma unroll
        for (int i = 0; i < 4; ++i) t.g[i] = *(const f32x4*)(gp + 4 * i);
    } else {
#pragma unroll
        for (int i = 0; i < 4; ++i) t.g[i] = (f32x4){1.f, 1.f, 1.f, 1.f};
    }
}
__device__ __forceinline__ void tr_store(const TrItem& t, bf16* dstp, int ldd) {
#pragma unroll
    for (int j = 0; j < 4; ++j)
#pragma unroll
        for (int c = 0; c < 2; ++c) {
            v4u o;
            o.x = pk2(t.v[8 * c + 0][j] * t.g[2 * c][0], t.v[8 * c + 1][j] * t.g[2 * c][1]); o.y = pk2(t.v[8 * c + 2][j] * t.g[2 * c][2], t.v[8 * c + 3][j] * t.g[2 * c][3]);
            o.z = pk2(t.v[8 * c + 4][j] * t.g[2 * c + 1][0], t.v[8 * c + 5][j] * t.g[2 * c + 1][1]); o.w = pk2(t.v[8 * c + 6][j] * t.g[2 * c + 1][2], t.v[8 * c + 7][j] * t.g[2 * c + 1][3]);
            *(v4u*)(dstp + (size_t)j * ldd + 8 * c) = o;
        }
}
__device__ __forceinline__ int win_src_col(int P) {
    if (P < 2048) return P;
    if (P < 3328) { const int p = P - 2048, t = p >> 8, pp = p & 255, bj = pp >> 7, wc = (pp & 127) >> 5, i = pp & 31; return (t < 4 ? 3072 + t * 256 : 4096) + 64 * wc + 32 * bj + i; }
    if (P < 4352) return 2048 + (P - 3328);
    return P;
}
__device__ __forceinline__ float rms_row_to_bf16(const float* xrow, bf16* orow, int lane) {
    const f32x4* xr = (const f32x4*)xrow + lane;
    f32x4 v[8]; float s = 0.f;
#pragma unroll
    for (int j = 0; j < 8; ++j) { v[j] = xr[64 * j]; s += (v[j].x * v[j].x + v[j].y * v[j].y) + (v[j].z * v[j].z + v[j].w * v[j].w); }
    const float rinv = sqrtf(wave_sum(s) * (1.f / DM) + RMS_EPS), rstd = 1.0f / rinv;
    v2u* o8 = (v2u*)orow + lane;
#pragma unroll
    for (int j = 0; j < 8; ++j) { v2u w; w.x = pk2(v[j].x * rstd, v[j].y * rstd); w.y = pk2(v[j].z * rstd, v[j].w * rstd); o8[64 * j] = w; }
    return rinv;
}
constexpr int I_IN = 32 * 72, I_OUT = 32 * 32, I_GU = NEXP * 32 * 16, I_D = NEXP * 8 * 32;
constexpr int NITEMS = I_IN + I_OUT + I_GU + I_D;
#ifndef TAIL1_PW
#define TAIL1_PW 64
#endif
#ifndef TAIL6_PW
#define TAIL6_PW 48
#endif
#ifndef TAIL6_N
#define TAIL6_N 11264
#endif
constexpr int TAIL1_PER_WAVE = TAIL1_PW, TAIL6_PER_WAVE = TAIL6_PW, TAIL6_ITEMS = TAIL6_N;
#ifndef ATT_WAVES_DEF
#define ATT_WAVES_DEF 4
#endif
constexpr int ATT_WAVES = ATT_WAVES_DEF;
__device__ __forceinline__ void conv_range(Frame& F, int it0, int step, int end) {
    bf16* WIN = (bf16*)(F.ws + WS_BIG) + (size_t)MPAD * DM;
    const float* ln_mix = F.in[3]; const float* w_in = F.in[4];
    const float* on_sb = F.in[8]; const float* on_sw = F.in[9]; const float* w_out = F.in[10]; const float* ln_ffn = F.in[11];
    const float* w_gate = F.in[16]; const float* w_up = F.in[17]; const float* w_down = F.in[18];
    bf16* WOUT = (bf16*)(F.ws + WS_WOUT); bf16* WGU = (bf16*)(F.ws + WS_WGU); bf16* WD = (bf16*)(F.ws + WS_WD);
    const int kr = F.lane >> 4, nq = F.lane & 15;
#define P0_ITEM(it, SRCP, LDS_, GP, DSTP, LDD) do { int r_ = (it); \
        if (r_ < I_IN) { const int kb = r_ / 72, nb = r_ % 72, k0 = 64 * kb + 16 * kr; SRCP = w_in + (size_t)k0 * 4608 + win_src_col(64 * nb + 4 * nq); LDS_ = 4608; GP = ln_mix + k0; DSTP = WIN + (size_t)(64 * nb + 4 * nq) * DM + k0; LDD = DM; } \
        else if ((r_ -= I_IN) < I_OUT) { const int kb = r_ >> 5, nb = r_ & 31, k0 = 64 * kb + 16 * kr; SRCP = w_out + (size_t)k0 * DM + 64 * nb + 4 * nq; LDS_ = DM; GP = (k0 < 1024 ? on_sb + k0 : on_sw + (k0 - 1024)); DSTP = WOUT + (size_t)(64 * nb + 4 * nq) * DM + k0; LDD = DM; } \
        else if ((r_ -= I_OUT) < I_GU) { const int e = r_ >> 9, q = r_ & 511, kb = q >> 4, nb = q & 15, k0 = 64 * kb + 16 * kr, nt = nb >> 2, bj = (nb >> 1) & 1, j0 = (nb & 1) * 64; \
            SRCP = (bj ? w_up : w_gate) + (size_t)e * DM * DEXP + (size_t)k0 * DEXP + nt * 128 + j0 + 4 * nq; LDS_ = DEXP; GP = ln_ffn + k0; DSTP = WGU + ((size_t)e * 1024 + 64 * nb + 4 * nq) * DM + k0; LDD = DM; } \
        else { r_ -= I_GU; const int e = r_ >> 8, q = r_ & 255, kb = q >> 5, nb = q & 31, k0 = 64 * kb + 16 * kr; \
            SRCP = w_down + (size_t)e * DEXP * DM + (size_t)k0 * DM + 64 * nb + 4 * nq; LDS_ = DM; GP = nullptr; DSTP = WD + ((size_t)e * 2048 + 64 * nb + 4 * nq) * DEXP + k0; LDD = DEXP; } } while (0)
    {
        TrItem cur; const float* sp; const float* gp; bf16* dp; int lds_, ldd; bf16* dpn; int lddn;
        int it = it0;
        if (it < end) { P0_ITEM(it, sp, lds_, gp, dp, ldd); tr_load(cur, sp, lds_, gp); }
        while (it < end) {
            const int itn = it + step; TrItem nxt;
            if (itn < end) { P0_ITEM(itn, sp, lds_, gp, dpn, lddn); tr_load(nxt, sp, lds_, gp); }
            tr_store(cur, dp, ldd);
            if (itn < end) { cur = nxt; dp = dpn; ldd = lddn; }
            it = itn;
        }
    }
#undef P0_ITEM
}
__device__ __forceinline__ void conv_range3(Frame& F, int it0, int step, int end) {
    bf16* WIN = (bf16*)(F.ws + WS_BIG) + (size_t)MPAD * DM;
    const float* ln_mix = F.in[3]; const float* w_in = F.in[4];
    const float* on_sb = F.in[8]; const float* on_sw = F.in[9]; const float* w_out = F.in[10]; const float* ln_ffn = F.in[11];
    const float* w_gate = F.in[16]; const float* w_up = F.in[17]; const float* w_down = F.in[18];
    bf16* WOUT = (bf16*)(F.ws + WS_WOUT); bf16* WGU = (bf16*)(F.ws + WS_WGU); bf16* WD = (bf16*)(F.ws + WS_WD);
    const int kr = F.lane >> 3, nq = F.lane & 7;
#define P0_ITEM(it, SRCP, LDS_, GP, DSTP, LDD) do { int r_ = (it); \
        if (r_ < I_IN) { const int kb = r_ / 72, nb = r_ % 72, k0 = 64 * kb + 8 * kr; SRCP = w_in + (size_t)k0 * 4608 + win_src_col(64 * nb + 4 * nq); LDS_ = 4608; GP = ln_mix + k0; DSTP = WIN + (size_t)(64 * nb + 4 * nq) * DM + k0; LDD = DM; } \
        else if ((r_ -= I_IN) < I_OUT) { const int kb = r_ >> 5, nb = r_ & 31, k0 = 64 * kb + 8 * kr; SRCP = w_out + (size_t)k0 * DM + 64 * nb + 4 * nq; LDS_ = DM; GP = (k0 < 1024 ? on_sb + k0 : on_sw + (k0 - 1024)); DSTP = WOUT + (size_t)(64 * nb + 4 * nq) * DM + k0; LDD = DM; } \
        else if ((r_ -= I_OUT) < I_GU) { const int e = r_ >> 9, q = r_ & 511, kb = q >> 4, nb = q & 15, k0 = 64 * kb + 8 * kr, nt = nb >> 2, bj = (nb >> 1) & 1, j0 = (nb & 1) * 64; \
            SRCP = (bj ? w_up : w_gate) + (size_t)e * DM * DEXP + (size_t)k0 * DEXP + nt * 128 + j0 + 4 * nq; LDS_ = DEXP; GP = ln_ffn + k0; DSTP = WGU + ((size_t)e * 1024 + 64 * nb + 4 * nq) * DM + k0; LDD = DM; } \
        else { r_ -= I_GU; const int e = r_ >> 8, q = r_ & 255, kb = q >> 5, nb = q & 31, k0 = 64 * kb + 8 * kr; \
            SRCP = w_down + (size_t)e * DEXP * DM + (size_t)k0 * DM + 64 * nb + 4 * nq; LDS_ = DM; GP = nullptr; DSTP = WD + ((size_t)e * 2048 + 64 * nb + 4 * nq) * DEXP + k0; LDD = DEXP; } } while (0)
    struct V16 { f32x4 v[16]; };
#define C3_LOAD(B, it) do { if ((it) < end) { const float* sp_; const float* gp_; bf16* dp_; int ls_, ld_; P0_ITEM((it), sp_, ls_, gp_, dp_, ld_); (void)gp_; (void)dp_; (void)ld_; \
        _Pragma("unroll") for (int i_ = 0; i_ < 16; ++i_) B.v[i_] = __builtin_nontemporal_load((const f32x4*)(sp_ + (size_t)(i_ & 7) * ls_ + 32 * (i_ >> 3))); } } while (0)
#define C3_GAIN(G, it) do { if ((it) < end) { const float* sp_; const float* gp_; bf16* dp_; int ls_, ld_; P0_ITEM((it), sp_, ls_, gp_, dp_, ld_); (void)sp_; (void)ls_; (void)dp_; (void)ld_; \
        G[0] = gp_ ? *(const f32x4*)gp_ : (f32x4){1.f, 1.f, 1.f, 1.f}; G[1] = gp_ ? *(const f32x4*)(gp_ + 4) : (f32x4){1.f, 1.f, 1.f, 1.f}; } } while (0)
#define C3_STORE(B, G, it) do { if ((it) < end) { const float* sp_; const float* gp_; bf16* dp_; int ls_, ld_; P0_ITEM((it), sp_, ls_, gp_, dp_, ld_); (void)sp_; (void)ls_; (void)gp_; \
        _Pragma("unroll") for (int h_ = 0; h_ < 2; ++h_) _Pragma("unroll") for (int j_ = 0; j_ < 4; ++j_) { v4u o_; \
            o_.x = pk2(B.v[8 * h_ + 0][j_] * G[0][0], B.v[8 * h_ + 1][j_] * G[0][1]); o_.y = pk2(B.v[8 * h_ + 2][j_] * G[0][2], B.v[8 * h_ + 3][j_] * G[0][3]); \
            o_.z = pk2(B.v[8 * h_ + 4][j_] * G[1][0], B.v[8 * h_ + 5][j_] * G[1][1]); o_.w = pk2(B.v[8 * h_ + 6][j_] * G[1][2], B.v[8 * h_ + 7][j_] * G[1][3]); \
            *(v4u*)(dp_ + (size_t)(32 * h_ + j_) * ld_) = o_; } } } while (0)
    {
        V16 A, B, C; f32x4 gA[2], gB[2], gC[2]; int it = it0;
        C3_LOAD(A, it); C3_LOAD(B, it + step);
        while (it < end) {
            C3_GAIN(gA, it); C3_LOAD(C, it + 2 * step); C3_STORE(A, gA, it);
            C3_GAIN(gB, it + step); C3_LOAD(A, it + 3 * step); C3_STORE(B, gB, it + step);
            C3_GAIN(gC, it + 2 * step); C3_LOAD(B, it + 4 * step); C3_STORE(C, gC, it + 2 * step);
            it += 3 * step;
        }
    }
#undef C3_LOAD
#undef C3_GAIN
#undef C3_STORE
#undef P0_ITEM
}
struct CuSplit { int Gg, cg, nconv, cc; bool conv; };
__device__ __forceinline__ CuSplit split_cus(int G, int vcu, int units) {
    CuSplit s; const int rounds = (units + G - 1) / G; s.Gg = (rounds > 0) ? (units + rounds - 1) / rounds : G; s.nconv = G - s.Gg;
    if (G % 8 == 0) { const int xs = G / 8, x = vcu / xs, l = vcu % xs, q = s.nconv / 8, rm = s.nconv % 8;
        const int nx = q + (x < rm ? 1 : 0), before = x * q + (x < rm ? x : rm);
        s.conv = l >= xs - nx; s.cg = vcu - before; s.cc = before + (l - (xs - nx)); }
    else { s.conv = vcu >= s.Gg; s.cg = vcu; s.cc = vcu - s.Gg; }
    return s;
}
__device__ __forceinline__ int tail1_items(int G) { const int rounds = (P1_UNITS + G - 1) / G, nconv = G - (P1_UNITS + rounds - 1) / rounds; const int n = nconv * NWAVES * TAIL1_PER_WAVE; return n < I_GU ? n : I_GU; }
__device__ __forceinline__ void p0_prologue(Frame& F) {
    const int gw = F.vcu * NWAVES + F.wave, NGW = F.G * NWAVES;
    if (blockIdx.x == 0 && F.tid < NEXP) __hip_atomic_store(F.ctl + CW_CNT + F.tid, 0u, __ATOMIC_RELAXED, __HIP_MEMORY_SCOPE_AGENT);
    bf16* BIG = (bf16*)(F.ws + WS_BIG);
    bf16* WIN = BIG + (size_t)MPAD * DM;
    const float* x = F.in[0]; const float* meta = F.in[1]; const float* ln_mix = F.in[3]; const float* w_in = F.in[4];
    const float* on_sb = F.in[8]; const float* on_sw = F.in[9]; const float* w_out = F.in[10]; const float* ln_ffn = F.in[11];
    const float* w_rg = F.in[12]; const float* w_re = F.in[14]; const float* w_gate = F.in[16]; const float* w_up = F.in[17]; const float* w_down = F.in[18];
    for (int m = gw; m < MPAD; m += NGW) {
        bf16* orow = BIG + (size_t)m * DM;
        if (m < NTOK) { const float ri = rms_row_to_bf16(x + (size_t)m * DM, orow, F.lane); if (F.lane == 0) ((float*)(F.ws + WS_RINV))[m] = ri; }
        else if (m < NTOK + NMETA) (void)rms_row_to_bf16(meta + (size_t)(m - NTOK) * DM, orow, F.lane);
        else { v4u z = {0u, 0u, 0u, 0u}; v4u* o = (v4u*)orow + F.lane;
#pragma unroll
            for (int j = 0; j < 4; ++j) o[64 * j] = z; }
    }
    conv_range(F, gw, NGW, I_IN + I_OUT);
    bf16* WRH = (bf16*)(F.ws + WS_WR); bf16* WRL = WRH + 96 * DM;
    for (int idx = (F.vcu * NWAVES * 64 + F.tid); idx < 96 * DM; idx += F.G * NWAVES * 64) {
        const int c = idx / DM, k = idx % DM;
        float v = 0.f; if (c < 8) v = w_rg[k * 8 + c]; else if (c < 72) v = w_re[k * 64 + (c - 8)];
        v *= ln_ffn[k];
        const unsigned hi = pk2(v, 0.f) & 0xffffu; const float lo = v - __uint_as_float(hi << 16);
        const int fidx = ((((k >> 4) * 3 + (c >> 5)) * 64 + (((k >> 3) & 1) * 32 + (c & 31))) << 3) + (k & 7);
        WRH[fidx] = (bf16)hi; WRL[fidx] = (bf16)(pk2(lo, 0.f) & 0xffffu);
    }
}

struct P1Order {
    int G, c;
    __device__ bool next(int i, pg8::Unit& u) const {
        const int L = i * G + c; if (L >= P1_UNITS) return false;
        if (L < P1_UNITS_A) { u.pm = L / NT_QK; u.pn = NTILE_X + (L % NT_QK); }
        else { const int l = L - P1_UNITS_A; u.pm = NTILE_X + NT_QK + l / NTILE_X; u.pn = l % NTILE_X; }
        return true;
    }
    __device__ __forceinline__ void a_ready(const pg8::Unit&) const {}
    __device__ __forceinline__ void done(const pg8::Unit&) const {}
};
struct EpiQKV {
    static constexpr bool PERM = true, AFTER_DRAIN = false, MIDK = false;
    bf16 *QS, *KS, *QW, *KW, *VT; const float *q_norm, *k_norm;
    __device__ __forceinline__ void operator()(const pg8::f32x4 (&acc)[2][2][4][2], const pg8::Unit& u, int wr, int wc, int fr, int fq) const {
        using pg8::HALF;
        if (u.pm < NTILE_X) {
            const int t = u.pn - NTILE_X; const int row0 = u.pm * 256 + wr * 64 + fr;
            if (t < 8) {
                bf16* base = (t < 4) ? QS : KS; const float sc = (t < 4) ? C2 : 1.0f; const int col0 = (t & 3) * 256 + wc * 32 + 8 * fq;
#pragma unroll
                for (int ai = 0; ai < 2; ++ai)
#pragma unroll
                    for (int m = 0; m < 4; ++m) { bf16* rowp = base + (size_t)(row0 + ai * HALF + m * 16) * 1024 + col0;
#pragma unroll
                        for (int bj = 0; bj < 2; ++bj) { const pg8::f32x4 v0 = acc[ai][bj][m][0] * sc, v1 = acc[ai][bj][m][1] * sc;
                            v4u w; w.x = pk2(v0[0], v0[1]); w.y = pk2(v0[2], v0[3]); w.z = pk2(v1[0], v1[1]); w.w = pk2(v1[2], v1[3]); *(v4u*)(rowp + bj * HALF) = w; } }
            } else {
                const bool isq = t < 12; const float* gain = isq ? q_norm : k_norm; const float sc = isq ? C2 : 1.0f;
                bf16* base = isq ? (QW + (t - 8) * 256 + wc * 64) : (KW + wc * 64); const int ld = isq ? 1024 : 256;
                pg8::f32x4 g[2][2];
#pragma unroll
                for (int bj = 0; bj < 2; ++bj)
#pragma unroll
                    for (int n = 0; n < 2; ++n) g[bj][n] = *(const pg8::f32x4*)(gain + 32 * bj + 8 * fq + 4 * n) * sc;
#pragma unroll
                for (int ai = 0; ai < 2; ++ai)
#pragma unroll
                    for (int m = 0; m < 4; ++m) {
                        float ss = 0.f;
#pragma unroll
                        for (int bj = 0; bj < 2; ++bj)
#pragma unroll
                            for (int n = 0; n < 2; ++n) { const pg8::f32x4 v = acc[ai][bj][m][n]; ss += (v[0] * v[0] + v[1] * v[1]) + (v[2] * v[2] + v[3] * v[3]); }
                        ss += __shfl_xor(ss, 16); ss += __shfl_xor(ss, 32);
                        const float rstd = 1.0f / sqrtf(ss * (1.0f / 64.0f) + RMS_EPS);
                        bf16* rowp = base + (size_t)(row0 + ai * HALF + m * 16) * ld + 8 * fq;
#pragma unroll
                        for (int bj = 0; bj < 2; ++bj) { const pg8::f32x4 v0 = acc[ai][bj][m][0] * rstd * g[bj][0], v1 = acc[ai][bj][m][1] * rstd * g[bj][1];
                            v4u w; w.x = pk2(v0[0], v0[1]); w.y = pk2(v0[2], v0[3]); w.z = pk2(v1[0], v1[1]); w.w = pk2(v1[2], v1[3]); *(v4u*)(rowp + 32 * bj) = w; } }
            }
        } else {
            const int vrow0 = (u.pm - NTILE_X - NT_QK) * 256 + wr * 64 + fr;
#pragma unroll
            for (int ai = 0; ai < 2; ++ai)
#pragma unroll
                for (int m = 0; m < 4; ++m) { bf16* rowp = VT + (size_t)(vrow0 + ai * HALF + m * 16) * MPAD + u.pn * 256 + wc * 32 + 16 * (fq >> 1) + 4 * (fq & 1);
#pragma unroll
                    for (int bj = 0; bj < 2; ++bj)
#pragma unroll
                        for (int n = 0; n < 2; ++n) { const pg8::f32x4 v = acc[ai][bj][m][n]; v2u w; w.x = pk2(v[0], v[1]); w.y = pk2(v[2], v[3]); *(v2u*)(rowp + bj * HALF + 8 * n) = w; } }
        }
    }
};

namespace att {
__device__ __forceinline__ f32x16 mfma_bf(bf16x8 a, bf16x8 b, f32x16 c) { return __builtin_amdgcn_mfma_f32_32x32x16_bf16(a, b, c, 0, 0, 0); }
__device__ __forceinline__ f32x16 mfma_h(f16x8 a, f16x8 b, f32x16 c) { return __builtin_amdgcn_mfma_f32_32x32x16_f16(a, b, c, 0, 0, 0); }
__device__ __forceinline__ bf16x8 ld8(const bf16* p) { return *(const bf16x8*)p; }
__device__ __forceinline__ bf16x8 pack8(const float* w) { v4u o; o.x = pk2(w[0], w[1]); o.y = pk2(w[2], w[3]); o.z = pk2(w[4], w[5]); o.w = pk2(w[6], w[7]); return __builtin_bit_cast(bf16x8, o); }

struct KT { bf16x8 k[4]; bf16x8 v[4]; };
__device__ __forceinline__ void glds16(const void* gsrc, unsigned lds_dst) { unsigned keep;
    asm volatile("s_mov_b32 %0, m0\n\ts_mov_b32 m0, %2\n\ts_nop 0\n\tglobal_load_lds_dwordx4 %1, off\n\ts_mov_b32 m0, %0" : "=&s"(keep) : "v"(gsrc), "s"(lds_dst) : "memory"); }
__device__ __forceinline__ void dma_tile(unsigned slot, const bf16* Kb, int ldk, const bf16* Vt, int b, int j, int lane) {
#pragma unroll
    for (int i = 0; i < 4; ++i) { const int row = 8 * i + (lane >> 3), ch = (lane & 7) ^ (row & 7);
        const int krow = (j >= 0) ? (b * SEQ + 32 * j + row) : (NTOK + (row & 15));
        glds16(Kb + (size_t)krow * ldk + ch * 8, (unsigned)__builtin_amdgcn_readfirstlane(slot + i * 1024)); }
    const int col0 = (j >= 0) ? (b * SEQ + 32 * j) : NTOK;
#pragma unroll
    for (int i = 0; i < 4; ++i) { const int row = 16 * i + (lane >> 2), c = (lane & 3) ^ ((row >> 2) & 3); const int cc = (j >= 0) ? c : (c & 1);
        glds16(Vt + (size_t)row * MPAD + col0 + cc * 8, (unsigned)__builtin_amdgcn_readfirstlane(slot + 4096 + i * 1024)); }
}
__device__ __forceinline__ void lds_frags(KT& t, const LAS unsigned char* slot, int r, int h) {
#pragma unroll
    for (int s = 0; s < 4; ++s) { const int c = 2 * s + h; t.k[s] = *(const LAS bf16x8*)(slot + (r >> 3) * 1024 + ((r & 7) * 8 + (c ^ (r & 7))) * 16); }
#pragma unroll
    for (int dh = 0; dh < 2; ++dh)
#pragma unroll
        for (int s = 0; s < 2; ++s) { const int row = 32 * dh + r, c = 2 * s + h; t.v[dh * 2 + s] = *(const LAS bf16x8*)(slot + 4096 + row * 64 + (c ^ ((row >> 2) & 3)) * 16); }
}
#define ATT_WAITV(n) asm volatile("s_waitcnt vmcnt(" #n ")" ::: "memory")

struct SbState { f32x16 o0, o1; float R; };
template <int KIND>
__device__ __forceinline__ void sb_tile(SbState& S, const KT& t, const bf16x8 (&qf)[4], const f16x8& U0, const f16x8& U1, int r, int h) {
    f32x16 z = {0.f, 0.f, 0.f, 0.f, 0.f, 0.f, 0.f, 0.f, 0.f, 0.f, 0.f, 0.f, 0.f, 0.f, 0.f, 0.f};
#pragma unroll
    for (int s = 0; s < 4; ++s) z = mfma_bf(t.k[s], qf[s], z);
    f32x16 init; float L[16];
#pragma unroll
    for (int g = 0; g < 16; ++g) {
        const float zz = z[g];
        const float e = __builtin_amdgcn_exp2f(-__builtin_fabsf(zz));
        const float zp = __builtin_amdgcn_fmed3f(zz, 0.f, 3.0e38f);
        const float sp = zp + __builtin_amdgcn_logf(1.0f + e);
        float Lv = -sp;
        if (KIND == 1) Lv = (crow(g, h) < r) ? Lv : 0.f;
        if (KIND == 2) Lv = (crow(g, h) < 16) ? Lv : 0.f;
        L[g] = Lv; init[g] = zz + Lv + S.R;
    }
    f16x8 lb0, lb1;
#pragma unroll
    for (int j = 0; j < 8; ++j) { lb0[j] = (_Float16)L[j]; lb1[j] = (_Float16)L[8 + j]; }
    f32x16 lw = mfma_h(U0, lb0, init); lw = mfma_h(U1, lb1, lw);
    float Rn = lw[0] - z[0];
    Rn = __shfl(Rn, r);
    float w[16];
#pragma unroll
    for (int g = 0; g < 16; ++g) {
        float wv = __builtin_amdgcn_exp2f(lw[g]);
        if (KIND == 1) wv = (crow(g, h) < r) ? wv : 0.f;
        if (KIND == 2) wv = (crow(g, h) < 16) ? wv : 0.f;
        w[g] = wv;
    }
    const bf16x8 wb0 = pack8(w), wb1 = pack8(w + 8);
    S.o0 = mfma_bf(t.v[0], wb0, S.o0); S.o0 = mfma_bf(t.v[1], wb1, S.o0);
    S.o1 = mfma_bf(t.v[2], wb0, S.o1); S.o1 = mfma_bf(t.v[3], wb1, S.o1);
    S.R = Rn;
}

struct SwState { f32x16 o0, o1; float m, l; };
template <int KIND>
__device__ __forceinline__ void sw_tile(SwState& S, const KT& t, const bf16x8 (&qf)[4], const LAS float* tb, int r, int h) {
    f32x16 z = {0.f, 0.f, 0.f, 0.f, 0.f, 0.f, 0.f, 0.f, 0.f, 0.f, 0.f, 0.f, 0.f, 0.f, 0.f, 0.f};
#pragma unroll
    for (int s = 0; s < 4; ++s) z = mfma_bf(t.k[s], qf[s], z);
    float sc[16]; float mx = -1e30f;
#pragma unroll
    for (int g = 0; g < 16; ++g) {
        float v = z[g] + tb[(g & 3) + 8 * (g >> 2)];
        if (KIND == 1) v = (crow(g, h) <= r) ? v : -1e30f;
        if (KIND == 2) v = (crow(g, h) < 16) ? v : -1e30f;
        if (KIND == 3) v = (crow(g, h) > r) ? v : -1e30f;
        sc[g] = v; mx = __builtin_fmaxf(mx, v);
    }
    mx = __builtin_fmaxf(mx, __shfl_xor(mx, 32));
    const float mn = __builtin_fmaxf(S.m, mx);
    const float alpha = __builtin_amdgcn_exp2f(S.m - mn);
    S.l *= alpha; S.o0 *= alpha; S.o1 *= alpha;
    float p[16]; float ls = 0.f;
#pragma unroll
    for (int g = 0; g < 16; ++g) { p[g] = __builtin_amdgcn_exp2f(sc[g] - mn); ls += p[g]; }
    S.l += ls; S.m = mn;
    const bf16x8 wb0 = pack8(p), wb1 = pack8(p + 8);
    S.o0 = mfma_bf(t.v[0], wb0, S.o0); S.o0 = mfma_bf(t.v[1], wb1, S.o0);
    S.o1 = mfma_bf(t.v[2], wb0, S.o1); S.o1 = mfma_bf(t.v[3], wb1, S.o1);
}
__device__ __forceinline__ float store_o(bf16* orow, const f32x16& o0, const f32x16& o1, float scale, int h) {
    float ss = 0.f;
#pragma unroll
    for (int q = 0; q < 4; ++q) {
        const float a0 = o0[4 * q] * scale, a1 = o0[4 * q + 1] * scale, a2 = o0[4 * q + 2] * scale, a3 = o0[4 * q + 3] * scale;
        const float b0 = o1[4 * q] * scale, b1 = o1[4 * q + 1] * scale, b2 = o1[4 * q + 2] * scale, b3 = o1[4 * q + 3] * scale;
        ss += ((a0 * a0 + a1 * a1) + (a2 * a2 + a3 * a3)) + ((b0 * b0 + b1 * b1) + (b2 * b2 + b3 * b3));
        v2u w; w.x = pk2(a0, a1); w.y = pk2(a2, a3); *(v2u*)(orow + 8 * q + 4 * h) = w;
        v2u x; x.x = pk2(b0, b1); x.y = pk2(b2, b3); *(v2u*)(orow + 32 + 8 * q + 4 * h) = x;
    }
    return ss;
}
}

__device__ __forceinline__ void p2_attention(Frame& F) {
    using namespace att;
    const int lane = F.lane, r = lane & 31, h = lane >> 5, w = F.wave;
    const bf16* VT = (const bf16*)(F.ws + WS_VT); bf16* MIX = (bf16*)(F.ws + WS_MIXED); float* SSQ = (float*)(F.ws + WS_SSQ);
    LAS float* tbr = (LAS float*)(F.lds + ATT_TBR_OFF);
    const LAS unsigned char* area = F.lds + RING_OFF + w * 16384;
    const unsigned slot0 = (unsigned)(uintptr_t)area;
    { const float* rel_bias = F.in[2];
      for (int idx = F.tid; idx < 16 * 192; idx += NWAVES * 64) {
        const int hq = idx / 192, x = idx % 192, d = 159 - x; float v = 0.f;
        if (d >= 0) { int bkt = d; if (d >= 16) { bkt = 16 + (int)(logf((float)d / 16.0f) / logf(8.0f) * 16.0f); bkt = bkt > 31 ? 31 : bkt; } v = rel_bias[bkt * 16 + hq] * LOG2E; }
        tbr[idx] = v;
      } }
    __syncthreads();
    if (w >= ATT_WAVES) {
        const int p2_end = NITEMS - TAIL6_ITEMS - tail1_items(F.G);
        conv_range3(F, I_IN + I_OUT + F.vcu * (NWAVES - ATT_WAVES) + (w - ATT_WAVES), F.G * (NWAVES - ATT_WAVES), p2_end);
        return;
    }
    __builtin_amdgcn_s_setprio(3);
    for (int unit = F.vcu; unit < NTOK / 32; unit += F.G) {
        const int b = unit >> 7, hg = unit & 3; int qa = (unit >> 2) & 31; if (unit >= NTOK / 64) qa = 31 - qa;
        const int a = 4 * qa + w;
        const size_t qrow = (size_t)b * SEQ + 32 * a + r;
#pragma unroll 1
        for (int bi = 0; bi < 2; ++bi) {
            const int branch = bi;
            if (branch == 0) {
            const bf16* KS = (const bf16*)(F.ws + WS_KS); const bf16* QS = (const bf16*)(F.ws + WS_QS);
            f16x8 U0, U1;
#pragma unroll
            for (int j = 0; j < 8; ++j) { const int c0 = 8 * (j >> 2) + 4 * h + (j & 3); U0[j] = (c0 > r) ? (_Float16)1.0f : (_Float16)0.0f; U1[j] = (16 + c0 > r) ? (_Float16)1.0f : (_Float16)0.0f; }
            float ssl = 0.f;
#pragma unroll 1
            for (int hh = 0; hh < 16 / ATT_WAVES; ++hh) {
                const int head = 4 * hg + hh;
                ATT_WAITV(0);
                const bf16* Kb = KS + head * 64;
                bf16x8 ql[4];
#pragma unroll
                for (int s = 0; s < 4; ++s) ql[s] = ld8(QS + qrow * 1024 + head * 64 + 16 * s + 8 * h);
                SbState S; S.R = 0.f;
#pragma unroll
                for (int g = 0; g < 16; ++g) { S.o0[g] = 0.f; S.o1[g] = 0.f; }
                const bf16* Vt = VT + (size_t)(head * 64) * MPAD;
                unsigned sl_cur = slot0, sl_nxt = slot0 + 8192;
                int jt = a;
                dma_tile(sl_cur, Kb, 1024, Vt, b, jt, lane); dma_tile(sl_nxt, Kb, 1024, Vt, b, jt - 1, lane);
                ATT_WAITV(8);
                KT T; lds_frags(T, area + (sl_cur - slot0), r, h);
                sb_tile<1>(S, T, ql, U0, U1, r, h);
                if (!__all(S.R < SB_EXIT)) {
                    --jt;
                    for (;;) {
                        { const unsigned t_ = sl_cur; sl_cur = sl_nxt; sl_nxt = t_; }
                        const bool has_next = jt >= 0;
                        if (has_next) { dma_tile(sl_nxt, Kb, 1024, Vt, b, jt - 1, lane); ATT_WAITV(8); } else ATT_WAITV(0);
                        lds_frags(T, area + (sl_cur - slot0), r, h);
                        if (jt >= 0) sb_tile<0>(S, T, ql, U0, U1, r, h); else sb_tile<2>(S, T, ql, U0, U1, r, h);
                        if (!has_next || __all(S.R < SB_EXIT)) break;
                        --jt;
                    }
                }
                ssl += store_o(MIX + qrow * DM + head * 64, S.o0, S.o1, 1.0f, h);
            }
            ssl += __shfl_xor(ssl, 32);
            if (h == 0) SSQ[qrow * 16 + hg] = ssl;
        }
            else {
            const bf16* KW = (const bf16*)(F.ws + WS_KW); const bf16* QW = (const bf16*)(F.ws + WS_QW);
            float ssl = 0.f;
#pragma unroll 1
            for (int hh = 0; hh < 16 / ATT_WAVES; ++hh) {
                const int hq = 4 * hg + hh, kvh = hq >> 2;
                ATT_WAITV(0);
                const bf16* Kb = KW + kvh * 64;
                bf16x8 ql[4];
#pragma unroll
                for (int s = 0; s < 4; ++s) ql[s] = ld8(QW + qrow * 1024 + hq * 64 + 16 * s + 8 * h);
                const float sink2 = F.in[7][hq] * LOG2E;
                SwState S; S.m = sink2; S.l = 0.f;
#pragma unroll
                for (int g = 0; g < 16; ++g) { S.o0[g] = 0.f; S.o1[g] = 0.f; }
                const LAS float* tbh = tbr + hq * 192 + 4 * h;
                const int jlo = (a >= 4) ? a - 4 : 0;
                const bf16* Vt = VT + (size_t)(1024 + kvh * 64) * MPAD;
                unsigned sl_cur = slot0, sl_nxt = slot0 + 8192;
                int jt = a;
#define SW_NEXT(j) (((j) > jlo) ? (j) - 1 : -1)
                dma_tile(sl_cur, Kb, 256, Vt, b, jt, lane); dma_tile(sl_nxt, Kb, 256, Vt, b, SW_NEXT(jt), lane);
                ATT_WAITV(8);
                KT T; lds_frags(T, area + (sl_cur - slot0), r, h);
                sw_tile<1>(S, T, ql, tbh + (159 - r), r, h);
                jt = SW_NEXT(jt);
                for (;;) {
                    { const unsigned t_ = sl_cur; sl_cur = sl_nxt; sl_nxt = t_; }
                    if (jt >= 0) { dma_tile(sl_nxt, Kb, 256, Vt, b, SW_NEXT(jt), lane); ATT_WAITV(8); } else ATT_WAITV(0);
                    lds_frags(T, area + (sl_cur - slot0), r, h);
                    if (jt < 0) { const int dq = 32 * a + r + 16; sw_tile<2>(S, T, ql, tbh + (159 - (dq < 159 ? dq : 159)), r, h); break; }
                    const LAS float* tb = tbh + (159 - (32 * (a - jt) + r));
                    if (jt == a - 4) sw_tile<3>(S, T, ql, tb, r, h); else sw_tile<0>(S, T, ql, tb, r, h);
                    jt = SW_NEXT(jt);
                }
#undef SW_NEXT
                const float lt = S.l + __shfl_xor(S.l, 32) + __builtin_amdgcn_exp2f(sink2 - S.m);
                ssl += store_o(MIX + qrow * DM + 1024 + hq * 64, S.o0, S.o1, 1.0f / lt, h);
            }
            ssl += __shfl_xor(ssl, 32);
            if (h == 0) SSQ[qrow * 16 + 8 + hg] = ssl;
        }
        }
    }
    __builtin_amdgcn_s_setprio(0);
}

struct EpiRes {
    static constexpr bool PERM = true, AFTER_DRAIN = false, MIDK = true;
    bf16* P; const LAS float* RS; const bf16* XN; mutable int ui;
    __device__ __forceinline__ void midk(pg8::f32x4 (&acc)[2][2][4][2], const pg8::Unit& u, int wr, int fr) const {
#pragma unroll
        for (int ai = 0; ai < 2; ++ai)
#pragma unroll
            for (int m = 0; m < 4; ++m) { const LAS float* q = RS + (ui * 256 + ai * 128 + wr * 64 + m * 16 + fr) * 2; const float ratio = q[0] / q[1];
#pragma unroll
                for (int bj = 0; bj < 2; ++bj)
#pragma unroll
                    for (int n = 0; n < 2; ++n) acc[ai][bj][m][n] *= ratio; }
    }
    __device__ __forceinline__ void operator()(const pg8::f32x4 (&acc)[2][2][4][2], const pg8::Unit& u, int wr, int wc, int fr, int fq) const {
        const int col0 = u.pn * 256 + wc * 32 + 8 * fq;
        v4u xr[2][4][2];
#pragma unroll
        for (int ai = 0; ai < 2; ++ai)
#pragma unroll
            for (int m = 0; m < 4; ++m) { const int rl = ai * 128 + wr * 64 + m * 16 + fr; const bf16* xp = XN + (size_t)(u.pm * 256 + rl) * DM + col0;
#pragma unroll
                for (int bj = 0; bj < 2; ++bj) xr[ai][m][bj] = *(const v4u*)(xp + bj * 128); }
#pragma unroll
        for (int ai = 0; ai < 2; ++ai)
#pragma unroll
            for (int m = 0; m < 4; ++m) { const int rl = ai * 128 + wr * 64 + m * 16 + fr; bf16* rowp = P + (size_t)(u.pm * 256 + rl) * DM + col0; const float rw = RS[(ui * 256 + rl) * 2 + 1], ri = RS[2048 + ui * 256 + rl];
#pragma unroll
                for (int bj = 0; bj < 2; ++bj) { const pg8::f32x4 v0 = acc[ai][bj][m][0] * rw, v1 = acc[ai][bj][m][1] * rw; const v4u x = xr[ai][m][bj];
                    v4u w; w.x = pk2(bf_lo(x.x) * ri + v0[0], bf_hi(x.x) * ri + v0[1]); w.y = pk2(bf_lo(x.y) * ri + v0[2], bf_hi(x.y) * ri + v0[3]);
                    w.z = pk2(bf_lo(x.z) * ri + v1[0], bf_hi(x.z) * ri + v1[1]); w.w = pk2(bf_lo(x.w) * ri + v1[2], bf_hi(x.w) * ri + v1[3]); *(v4u*)(rowp + bj * 128) = w; } }
        ++ui;
    }
};

__device__ __forceinline__ void p4_router(Frame& F) {
    using namespace att;
    const int lane = F.lane, r = lane & 31, h = lane >> 5, w = F.wave;
    const bf16* HB = (const bf16*)(F.ws + WS_HB);
    const bf16* WRH = (const bf16*)(F.ws + WS_WR); const bf16* WRL = WRH + 96 * DM;
    const float* b_rg = F.in[13]; const float* b_re = F.in[15];
    unsigned* CNT = F.ctl + CW_CNT;
    int* LIST = (int*)(F.ws + WS_LIST); float* GATEW = (float*)(F.ws + WS_GATEW); int* TOKINFO = (int*)(F.ws + WS_TOKINFO); float* RSTD = (float*)(F.ws + WS_RSTD); float* RSTDW = (float*)(F.ws + WS_RSTDW);
    LAS float* part = (LAS float*)(F.lds + RING_OFF);
    LAS float* ssp = (LAS float*)(F.lds + RING_OFF + 98304);
    LAS float* lg = (LAS float*)(F.lds + RING_OFF + 98304 + 2048);
    LAS float* rsl = (LAS float*)(F.lds + RING_OFF + 98304 + 2048 + 18432);
    const bool stager = __builtin_amdgcn_readfirstlane(w) < 4; const int mw = w & 3;
    const int crot = F.vcu & 3, krot = (F.vcu >> 2) & 7;
    for (int unit = F.vcu; unit < NTOK / 64; unit += F.G) {
        if (stager) {
#pragma unroll 1
            for (int c = 0; c < 5; ++c) {
                if (c < 4) {
                    const int cn = (c + crot) & 3;
                    LAS unsigned char* sh = F.lds + RING_OFF + (c & 1) * 65536;
#pragma unroll 1
                    for (int hb = 0; hb < 2; ++hb) {
                        v4u xr[8];
#pragma unroll
                        for (int i = 0; i < 8; ++i) { const int id = (hb * 8 + i) * 256 + F.tid, row = id >> 6, g = id & 63; xr[i] = *(const v4u*)(HB + ((size_t)unit * 64 + row) * DM + 512 * cn + 8 * g); }
#pragma unroll
                        for (int i = 0; i < 8; ++i) { const int id = (hb * 8 + i) * 256 + F.tid, row = id >> 6, g = id & 63; *(LAS v4u*)(sh + row * 1024 + ((g ^ (row & 15)) << 4)) = xr[i]; }
                    }
                }
                __syncthreads();
            }
        } else {
            f32x16 acc[2][3];
#pragma unroll
            for (int t = 0; t < 2; ++t)
#pragma unroll
                for (int nt = 0; nt < 3; ++nt)
#pragma unroll
                    for (int g = 0; g < 16; ++g) acc[t][nt][g] = 0.f;
            float ss0 = 0.f, ss1 = 0.f;
            bf16x8 wah[3], wal[3], wbh[3], wbl[3];
#define P4_WLOAD(WH, WL, C_, S8_) { const int ksg_ = 32 * (((C_) + crot) & 3) + mw + 4 * (((S8_) + krot) & 7); \
                _Pragma("unroll") for (int nt = 0; nt < 3; ++nt) { const int fo = (((ksg_ * 3 + nt) * 64 + lane) << 3); WH[nt] = ld8(WRH + fo); WL[nt] = ld8(WRL + fo); } }
#define P4_SS(SS, HV) { const float e0 = bf_lo(HV.x), e1 = bf_hi(HV.x), e2 = bf_lo(HV.y), e3 = bf_hi(HV.y), e4 = bf_lo(HV.z), e5 = bf_hi(HV.z), e6 = bf_lo(HV.w), e7 = bf_hi(HV.w); \
                SS += ((e0 * e0 + e1 * e1) + (e2 * e2 + e3 * e3)) + ((e4 * e4 + e5 * e5) + (e6 * e6 + e7 * e7)); }
#define P4_KSTEP(WH, WL, S8_) { const int ks = mw + 4 * (((S8_) + krot) & 7); \
                const int fo0 = r * 1024 + ((((2 * ks + h) ^ (r & 15))) << 4), fo1 = fo0 + 32 * 1024; \
                const v4u h0 = *(const LAS v4u*)(sh + fo0), h1 = *(const LAS v4u*)(sh + fo1); \
                P4_SS(ss0, h0) P4_SS(ss1, h1) \
                const bf16x8 ahi0 = __builtin_bit_cast(bf16x8, h0), ahi1 = __builtin_bit_cast(bf16x8, h1); \
                _Pragma("unroll") for (int nt = 0; nt < 3; ++nt) { \
                    acc[0][nt] = mfma_bf(ahi0, WH[nt], acc[0][nt]); acc[1][nt] = mfma_bf(ahi1, WH[nt], acc[1][nt]); \
                    acc[0][nt] = mfma_bf(ahi0, WL[nt], acc[0][nt]); acc[1][nt] = mfma_bf(ahi1, WL[nt], acc[1][nt]); } }
            P4_WLOAD(wah, wal, 0, 0)
            __syncthreads();
#pragma unroll 1
            for (int c = 0; c < 4; ++c) {
                const LAS unsigned char* sh = F.lds + RING_OFF + (c & 1) * 65536;
#pragma unroll 1
                for (int s8 = 0; s8 < 8; s8 += 2) {
                    P4_WLOAD(wbh, wbl, c, s8 + 1)
                    P4_KSTEP(wah, wal, s8)
                    { const int j = c * 8 + s8 + 2; P4_WLOAD(wah, wal, j >> 3, j & 7) }
                    P4_KSTEP(wbh, wbl, s8 + 1)
                }
                __syncthreads();
            }
#undef P4_SS
#undef P4_KSTEP
#undef P4_WLOAD
            ss0 += __shfl_xor(ss0, 32); ss1 += __shfl_xor(ss1, 32);
            if (h == 0) { ssp[mw * 32 + r] = ss0; ssp[128 + mw * 32 + r] = ss1; }
#pragma unroll
            for (int t = 0; t < 2; ++t)
#pragma unroll
                for (int nt = 0; nt < 3; ++nt)
#pragma unroll
                    for (int g = 0; g < 16; ++g) part[((t * 4 + mw) * 32 + crow(g, h)) * 96 + nt * 32 + r] = acc[t][nt][g];
        }
        __syncthreads();
        for (int idx = F.tid; idx < 64 * 72; idx += NWAVES * 64) { const int tkk = idx / 72, cc = idx % 72, t = tkk >> 5, tk = tkk & 31; float v = 0.f;
#pragma unroll
            for (int i = 0; i < 4; ++i) v += part[((t * 4 + i) * 32 + tk) * 96 + cc];
            lg[idx] = v; }
        __syncthreads();
        LAS unsigned* hist = (LAS unsigned*)rsl + 64;
        if (F.tid < 128) hist[F.tid] = 0u;
        __syncthreads();
        int tok = 0, e0 = 0, e1 = 0; unsigned r0 = 0, r1 = 0; float g0 = 0.f, g1 = 0.f, rs = 0.f;
        if (F.tid < 64) {
            tok = unit * 64 + F.tid; float tsum = 0.f;
#pragma unroll
            for (int i = 0; i < 4; ++i) tsum += ssp[(F.tid >> 5) * 128 + i * 32 + (F.tid & 31)];
            rs = 1.0f / sqrtf(tsum * (1.0f / DM) + RMS_EPS); RSTD[tok] = rs;
            const LAS float* l = lg + F.tid * 72;
            float gl[8]; int gi = 0; float gm = -3.0e38f;
#pragma unroll
            for (int i = 0; i < 8; ++i) { gl[i] = l[i] * rs + b_rg[i]; if (gl[i] > gm) { gm = gl[i]; gi = i; } }
            float gs = 0.f;
#pragma unroll
            for (int i = 0; i < 8; ++i) gs += expf(gl[i] - gm);
            const float gval = 1.0f / gs;
            float el[8]; int i0 = 0; float m0 = -3.0e38f;
#pragma unroll
            for (int i = 0; i < 8; ++i) { el[i] = l[8 + gi * 8 + i] * rs + b_re[gi * 8 + i]; if (el[i] > m0) { m0 = el[i]; i0 = i; } }
            int i1 = 0; float m1 = -3.0e38f;
#pragma unroll
            for (int i = 0; i < 8; ++i) if (i != i0 && el[i] > m1) { m1 = el[i]; i1 = i; }
            const float p1 = expf(m1 - m0); g0 = gval / (1.0f + p1); g1 = gval * p1 / (1.0f + p1);
            e0 = gi * 8 + i0; e1 = gi * 8 + i1;
            r0 = atomicAdd((unsigned*)(hist + e0), 1u); r1 = atomicAdd((unsigned*)(hist + e1), 1u);
        }
        __syncthreads();
        if (F.tid < 64) { const unsigned n = hist[F.tid]; if (n) hist[64 + F.tid] = atomicAdd(CNT + F.tid, n); }
        __syncthreads();
        if (F.tid < 64) {
            const int pos0 = (int)(hist[64 + e0] + r0), pos1 = (int)(hist[64 + e1] + r1);
            LIST[e0 * NTOK + pos0] = tok; LIST[e1 * NTOK + pos1] = tok; GATEW[e0 * NTOK + pos0] = g0; GATEW[e1 * NTOK + pos1] = g1; RSTDW[e0 * NTOK + pos0] = rs; RSTDW[e1 * NTOK + pos1] = rs;
            *(int4*)(TOKINFO + 4 * tok) = make_int4(e0, pos0, e1, pos1);
        }
        __syncthreads();
    }
}

__device__ __forceinline__ void build_tables(Frame& F) {
    LAS int* T = (LAS int*)(F.lds + TBL_OFF);
    __syncthreads();
    if (F.tid < NEXP) {
        const int c = (int)__hip_atomic_load(F.ctl + CW_CNT + F.tid, __ATOMIC_RELAXED, __HIP_MEMORY_SCOPE_AGENT); const int mt = (c + 255) >> 8;
        int incl = mt;
#pragma unroll
        for (int o = 1; o < 64; o <<= 1) { const int v = __shfl_up(incl, o); if (F.tid >= o) incl += v; }
        const int st = incl - mt;
        T[TBL_TSTART + F.tid] = st; T[TBL_CNTS + F.tid] = c;
        for (int i = 0; i < mt; ++i) T[TBL_TE + st + i] = F.tid;
        if (F.tid == NEXP - 1) { T[TBL_TSTART + NEXP] = incl; T[TBL_NT] = incl; }
    }
    __syncthreads();
}
struct MoeGather {
    const int* list; const LAS int* T; LAS int* tokbuf; int NT; const float* rstdw; const float* gatew;
    __device__ __forceinline__ void info(const pg8::Unit& u, int& e, int& base, int& cnt) const { e = u.pn / NT; base = (u.pm - T[TBL_TSTART + e]) * 256; cnt = T[TBL_CNTS + e]; }
    __device__ __forceinline__ unsigned tok_direct(const pg8::Unit& u, int row) const { int e, base, cnt; info(u, e, base, cnt); const int idx = base + row; return idx < cnt ? (unsigned)list[e * NTOK + idx] : 0u; }
    __device__ __forceinline__ void issue(const pg8::Unit& u, int par, int lane) const { int e, base, cnt; info(u, e, base, cnt);
        __builtin_amdgcn_global_load_lds((const unsigned*)(list + e * NTOK + base + 4 * lane), (LAS unsigned*)(tokbuf + par * 256), 16, 0, 0);
        __builtin_amdgcn_global_load_lds((const unsigned*)(rstdw + e * NTOK + base + 4 * lane), (LAS unsigned*)(tokbuf + 512 + par * 256), 16, 0, 0);
        __builtin_amdgcn_global_load_lds((const unsigned*)(gatew + e * NTOK + base + 4 * lane), (LAS unsigned*)(tokbuf + 1024 + par * 256), 16, 0, 0); }
    __device__ __forceinline__ void direct_rg(const pg8::Unit& u, int row, float& rs, float& gw) const { int e, base, cnt; info(u, e, base, cnt); rs = rstdw[e * NTOK + base + row]; gw = gatew[e * NTOK + base + row]; }
    __device__ __forceinline__ unsigned tok_lds(const pg8::Unit& u, int par, int row) const { int e, base, cnt; info(u, e, base, cnt); const unsigned t = (unsigned)tokbuf[par * 256 + row]; return (base + row) < cnt ? t : 0u; }
};
namespace pg8 {
template <class Epi, class Sched>
__device__ __forceinline__ void gemm_phase_g(PG8_LAS unsigned char* lds, const Gemm g, const Sched& S, const Epi& E, const MoeGather& GA) {
    const int tid = threadIdx.x, wid = __builtin_amdgcn_readfirstlane(tid >> 6), lane = tid & 63, wr = wid >> 2, wc = wid & 3, fr = lane & 15, fq = lane >> 4;
    const int K = g.K, nt = K / BK;
    unsigned voffB[2], cofA[2]; int rowA[2];
#pragma unroll
    for (int i = 0; i < 2; ++i) { int R, C; stage_rc(tid * 16 + i * 8192, R, C); const int Rb = Epi::PERM ? ((R & ~31) + perm32(R & 31)) : R;
        rowA[i] = R; cofA[i] = (unsigned)C * 2u; voffB[i] = (unsigned)(Rb * K + C) * 2u; }
    const unsigned rowbytes = (unsigned)K * 2u;
    const size_t kstep = (size_t)(BK * 2);
    const size_t hstep = (size_t)HALF * K * 2;
    const size_t tstep = 2 * hstep;
    const unsigned ldsw = (unsigned)wid * 1024u;
    const int aoff = lds_byte(wr * 64 + fr, fq * 8), boff = lds_byte(wc * 32 + fr, fq * 8);
#define PG8_SA(b, h) (((b) * 2 + (h)) * HTB)
#define PG8_SB(b, h) ((4 + (b) * 2 + (h)) * HTB)
#define PG8_STAGE(bufoff, gbase, voff) do { _Pragma("unroll") for (int _i = 0; _i < 2; ++_i) \
        __builtin_amdgcn_global_load_lds((const unsigned*)((const char*)(gbase) + (voff)[_i]), (PG8_LAS unsigned*)(lds + (bufoff) + ldsw + _i * 8192), 16, 0, 0); } while (0)
#define PG8_LDA(dst, b, h) do { _Pragma("unroll") for (int m = 0; m < 4; ++m) _Pragma("unroll") for (int k = 0; k < 2; ++k) dst[m][k] = *(const PG8_LAS bf16x8*)(lds + PG8_SA(b, h) + aoff + m * 2048 + k * 1024); } while (0)
#define PG8_LDB(dst, b, h) do { _Pragma("unroll") for (int n = 0; n < 2; ++n) _Pragma("unroll") for (int k = 0; k < 2; ++k) dst[n][k] = *(const PG8_LAS bf16x8*)(lds + PG8_SB(b, h) + boff + n * 2048 + k * 1024); } while (0)
#define PG8_MMA(ai, bj, At, Bt) do { __builtin_amdgcn_s_setprio(1); _Pragma("unroll") for (int m = 0; m < 4; ++m) _Pragma("unroll") for (int n = 0; n < 2; ++n) _Pragma("unroll") for (int k = 0; k < 2; ++k) \
        acc[ai][bj][m][n] = __builtin_amdgcn_mfma_f32_16x16x32_bf16(Bt[n][k], At[m][k], acc[ai][bj][m][n], 0, 0, 0); __builtin_amdgcn_s_setprio(0); } while (0)
#define PG8_WAIT_V(n) asm volatile("s_waitcnt vmcnt(" #n ")" ::: "memory")
#define PG8_WAIT_L(n) asm volatile("s_waitcnt lgkmcnt(" #n ")" ::: "memory")
#define PG8_BAR __builtin_amdgcn_s_barrier()
#define PG8_SCHED __builtin_amdgcn_sched_barrier(0)
    Unit cur, nxt; int ui = 0;
    if (!S.next(0, cur)) return;
    f32x4 acc[2][2][4][2];
#pragma unroll
    for (int a = 0; a < 2; ++a)
#pragma unroll
        for (int b = 0; b < 2; ++b)
#pragma unroll
            for (int m = 0; m < 4; ++m)
#pragma unroll
                for (int n = 0; n < 2; ++n) acc[a][b][m][n] = (f32x4){0.f, 0.f, 0.f, 0.f};
    bf16x8 At[4][2], B0[2][2], B1[2][2];
    const char* A0 = (const char*)g.A; const char* cB = (const char*)g.Bt + (size_t)cur.pn * tstep;
    PG8_LAS int* tb = GA.tokbuf;
    if (tid < 256) { tb[tid] = (int)GA.tok_direct(cur, tid); float rs_, gw_; GA.direct_rg(cur, tid, rs_, gw_); ((PG8_LAS float*)tb)[512 + tid] = rs_; ((PG8_LAS float*)tb)[1024 + tid] = gw_; }
    PG8_WAIT_L(0); PG8_BAR;
#define PG8_OFFS(dst, par, half) do { _Pragma("unroll") for (int _i = 0; _i < 2; ++_i) dst[_i] = (unsigned)tb[(par) * 256 + (half) * HALF + rowA[_i]] * rowbytes + cofA[_i]; } while (0)
    {
        unsigned c0[2], c1[2]; PG8_OFFS(c0, 0, 0); PG8_OFFS(c1, 0, 1);
        PG8_STAGE(PG8_SB(0, 0), cB, voffB); PG8_STAGE(PG8_SB(0, 1), cB + hstep, voffB); PG8_STAGE(PG8_SA(0, 0), A0, c0); PG8_STAGE(PG8_SA(0, 1), A0, c1);
        if (wr == 1) PG8_BAR;
        PG8_WAIT_V(2); PG8_BAR;
        PG8_STAGE(PG8_SB(1, 0), cB + kstep, voffB); PG8_STAGE(PG8_SA(1, 0), A0 + kstep, c0); PG8_STAGE(PG8_SB(1, 1), cB + hstep + kstep, voffB);
        PG8_WAIT_V(6); PG8_BAR;
    }
    int t_issue = 2, t_fix = 6; asm volatile("" : "+s"(t_issue), "+s"(t_fix));
    for (;;) {
        const bool has_next = S.next(ui + 1, nxt);
        const char* nB = has_next ? (const char*)g.Bt + (size_t)nxt.pn * tstep : cB;
        const int pc = ui & 1, pnx = (ui + 1) & 1;
        for (int t = 0; t < nt; t += 2) {
            const bool last = (t == nt - 2);
            const char* a1 = A0 + (size_t)(t + 1) * kstep;
            const char* a2 = last ? A0 : A0 + (size_t)(t + 2) * kstep; const char* b2 = last ? nB : cB + (size_t)(t + 2) * kstep;
            const char* a3 = a2 + kstep; const char* b3 = b2 + kstep;
            if (t == t_fix && has_next && tid < 256) { int e_, base_, cnt_; GA.info(nxt, e_, base_, cnt_); if (base_ + tid >= cnt_) tb[pnx * 256 + tid] = 0; }
            const int ps = (last && has_next) ? pnx : pc;
            unsigned c1[2], s0[2], s1[2]; PG8_OFFS(c1, pc, 1); PG8_OFFS(s0, ps, 0); PG8_OFFS(s1, ps, 1);
            PG8_LDB(B0, 0, 0); PG8_LDB(B1, 0, 1); PG8_SCHED; PG8_LDA(At, 0, 0); PG8_STAGE(PG8_SA(1, 1), a1, c1);
            if (t == t_issue && has_next && wid == 0) GA.issue(nxt, pnx, lane);
            PG8_WAIT_V(8); PG8_WAIT_L(0); PG8_BAR; PG8_MMA(0, 0, At, B0); PG8_MMA(0, 1, At, B1); PG8_BAR; PG8_SCHED;
            PG8_LDA(At, 0, 1); PG8_STAGE(PG8_SB(0, 0), b2, voffB); PG8_STAGE(PG8_SB(0, 1), b2 + hstep, voffB); PG8_STAGE(PG8_SA(0, 0), a2, s0);
            PG8_WAIT_V(8); PG8_WAIT_L(0); PG8_BAR; PG8_MMA(1, 0, At, B0); PG8_MMA(1, 1, At, B1); PG8_BAR; PG8_SCHED;
            PG8_LDB(B0, 1, 0); PG8_LDB(B1, 1, 1); PG8_SCHED; PG8_LDA(At, 1, 0); PG8_STAGE(PG8_SA(0, 1), a2, s1);
            PG8_WAIT_V(8); PG8_WAIT_L(0); PG8_BAR; PG8_MMA(0, 0, At, B0); PG8_MMA(0, 1, At, B1); PG8_BAR; PG8_SCHED;
            PG8_LDA(At, 1, 1); PG8_STAGE(PG8_SB(1, 0), b3, voffB); PG8_STAGE(PG8_SB(1, 1), b3 + hstep, voffB); PG8_STAGE(PG8_SA(1, 0), a3, s0);
            PG8_WAIT_V(8); PG8_WAIT_L(0); PG8_BAR; PG8_MMA(1, 0, At, B0); PG8_MMA(1, 1, At, B1); PG8_BAR; PG8_SCHED;
        }
        if (wr == 0) PG8_BAR;
        E.par = pc; E(acc, cur, wr, wc, fr, fq); S.done(cur);
        if (!has_next) break;
#pragma unroll
        for (int a = 0; a < 2; ++a)
#pragma unroll
            for (int b = 0; b < 2; ++b)
#pragma unroll
                for (int m = 0; m < 4; ++m)
#pragma unroll
                    for (int n = 0; n < 2; ++n) acc[a][b][m][n] = (f32x4){0.f, 0.f, 0.f, 0.f};
        cur = nxt; cB = nB; ++ui;
        if (wr == 1) PG8_BAR;
    }
    PG8_WAIT_V(0);
    PG8_BAR;
#undef PG8_SA
#undef PG8_SB
#undef PG8_STAGE
#undef PG8_LDA
#undef PG8_LDB
#undef PG8_MMA
#undef PG8_WAIT_V
#undef PG8_WAIT_L
#undef PG8_BAR
#undef PG8_SCHED
#undef PG8_OFFS
}
}
struct MoeOrder {
    const LAS int* T; int NT, G, c;
    __device__ bool next(int i, pg8::Unit& u) const {
        const int L = i * G + c; if (L >= T[TBL_NT] * NT) return false;
        const int mt = L / NT; u.pm = mt; u.pn = T[TBL_TE + mt] * NT + (L % NT); return true;
    }
    __device__ __forceinline__ void a_ready(const pg8::Unit&) const {}
    __device__ __forceinline__ void done(const pg8::Unit&) const {}
};
struct EpiSwiGLU {
    static constexpr bool PERM = true, AFTER_DRAIN = false, MIDK = false;
    bf16* HDN; const LAS float* RG; const LAS int* T; mutable int par;
    __device__ __forceinline__ void operator()(const pg8::f32x4 (&acc)[2][2][4][2], const pg8::Unit& u, int wr, int wc, int fr, int fq) const {
        const int col0 = (u.pn & 3) * 128 + wc * 32 + 8 * fq; const int e = u.pn >> 2; const int base = (u.pm - T[TBL_TSTART + e]) * 256, cnt = T[TBL_CNTS + e];
#pragma unroll
        for (int ai = 0; ai < 2; ++ai)
#pragma unroll
            for (int m = 0; m < 4; ++m) { const int rl = ai * 128 + wr * 64 + m * 16 + fr; const int row = u.pm * 256 + rl; const bool ok = (base + rl) < cnt;
                const float rsr = RG[par * 256 + rl], gwr = RG[512 + par * 256 + rl];
                const float rs = ok ? rsr : 0.f, gw = ok ? gwr : 0.f;
                float o[8];
#pragma unroll
                for (int n = 0; n < 2; ++n)
#pragma unroll
                    for (int q = 0; q < 4; ++q) { const float g = acc[ai][0][m][n][q] * rs, up = acc[ai][1][m][n][q] * rs;
                        const float sg = g * __builtin_amdgcn_rcpf(1.0f + __builtin_amdgcn_exp2f(-g * LOG2E)); o[4 * n + q] = sg * up * gw; }
                v4u wv; wv.x = pk2(o[0], o[1]); wv.y = pk2(o[2], o[3]); wv.z = pk2(o[4], o[5]); wv.w = pk2(o[6], o[7]);
                *(v4u*)(HDN + (size_t)row * DEXP + col0) = wv; }
    }
};
struct EpiY {
    static constexpr bool PERM = true, AFTER_DRAIN = false, MIDK = false;
    bf16* Y; const LAS int* T;
    __device__ __forceinline__ void operator()(const pg8::f32x4 (&acc)[2][2][4][2], const pg8::Unit& u, int wr, int wc, int fr, int fq) const {
        const int col0 = (u.pn & 7) * 256 + wc * 32 + 8 * fq; const int e = u.pn >> 3; const int nvalid = T[TBL_CNTS + e] - (u.pm - T[TBL_TSTART + e]) * 256;
#pragma unroll
        for (int ai = 0; ai < 2; ++ai)
#pragma unroll
            for (int m = 0; m < 4; ++m) { const int rl = ai * 128 + wr * 64 + m * 16 + fr; bf16* rowp = Y + (size_t)(u.pm * 256 + rl) * DM + col0;
                if (rl < nvalid) {
#pragma unroll
                    for (int bj = 0; bj < 2; ++bj) { const pg8::f32x4 v0 = acc[ai][bj][m][0], v1 = acc[ai][bj][m][1];
                        v4u w; w.x = pk2(v0[0], v0[1]); w.y = pk2(v0[2], v0[3]); w.z = pk2(v1[0], v1[1]); w.w = pk2(v1[2], v1[3]); *(v4u*)(rowp + bj * 128) = w; } } }
    }
};
struct P8Row { v4u h[4], a[4], b[4]; };
__device__ __forceinline__ void p8_load(P8Row& r, const bf16* HB, const bf16* Y, const LAS int* T, int4 ti, int t, int lane) {
    const size_t s0 = (size_t)T[TBL_TSTART + ti.x] * 256 + ti.y, s1 = (size_t)T[TBL_TSTART + ti.z] * 256 + ti.w;
    const v4u* hp = (const v4u*)(HB + (size_t)t * DM) + lane; const v4u* y0 = (const v4u*)(Y + s0 * DM) + lane; const v4u* y1 = (const v4u*)(Y + s1 * DM) + lane;
#pragma unroll
    for (int j = 0; j < 4; ++j) { r.h[j] = __builtin_nontemporal_load(hp + 64 * j); r.a[j] = __builtin_nontemporal_load(y0 + 64 * j); r.b[j] = __builtin_nontemporal_load(y1 + 64 * j); }
}
__device__ __forceinline__ void p8_combine(Frame& F) {
    const LAS int* T = (const LAS int*)(F.lds + TBL_OFF);
    const int gw = F.vcu * NWAVES + F.wave, NGW = F.G * NWAVES;
    const bf16* Y = (const bf16*)(F.ws + WS_Y); const bf16* HB = (const bf16*)(F.ws + WS_HB); const int* TOKINFO = (const int*)(F.ws + WS_TOKINFO);
    constexpr int RPW = 8;
    int4 ti[RPW];
#pragma unroll
    for (int k = 0; k < RPW; ++k) { const int t = gw + k * NGW; ti[k] = (t < NTOK) ? *(const int4*)(TOKINFO + 4 * t) : make_int4(0, 0, 0, 0); }
    P8Row cur; if (gw < NTOK) p8_load(cur, HB, Y, T, ti[0], gw, F.lane);
#pragma unroll
    for (int k = 0; k < RPW; ++k) {
        const int t = gw + k * NGW; if (t >= NTOK) break;
        P8Row nxt; const int tn = t + NGW;
        if (k + 1 < RPW && tn < NTOK) p8_load(nxt, HB, Y, T, ti[k + 1 < RPW ? k + 1 : k], tn, F.lane);
        f32x4* od = (f32x4*)(F.out + (size_t)t * DM) + 2 * F.lane;
#pragma unroll
        for (int j = 0; j < 4; ++j) {
            const v4u h = cur.h[j], a = cur.a[j], b = cur.b[j]; f32x4 v0, v1;
            v0[0] = bf_lo(h.x) + bf_lo(a.x) + bf_lo(b.x); v0[1] = bf_hi(h.x) + bf_hi(a.x) + bf_hi(b.x); v0[2] = bf_lo(h.y) + bf_lo(a.y) + bf_lo(b.y); v0[3] = bf_hi(h.y) + bf_hi(a.y) + bf_hi(b.y);
            v1[0] = bf_lo(h.z) + bf_lo(a.z) + bf_lo(b.z); v1[1] = bf_hi(h.z) + bf_hi(a.z) + bf_hi(b.z); v1[2] = bf_lo(h.w) + bf_lo(a.w) + bf_lo(b.w); v1[3] = bf_hi(h.w) + bf_hi(a.w) + bf_hi(b.w);
            od[128 * j] = v0; od[128 * j + 1] = v1;
        }
        cur = nxt;
    }
    for (int t = gw + RPW * NGW; t < NTOK; t += NGW) {
        const int4 tj = *(const int4*)(TOKINFO + 4 * t); P8Row r; p8_load(r, HB, Y, T, tj, t, F.lane);
        f32x4* od = (f32x4*)(F.out + (size_t)t * DM) + 2 * F.lane;
#pragma unroll
        for (int j = 0; j < 4; ++j) {
            const v4u h = r.h[j], a = r.a[j], b = r.b[j]; f32x4 v0, v1;
            v0[0] = bf_lo(h.x) + bf_lo(a.x) + bf_lo(b.x); v0[1] = bf_hi(h.x) + bf_hi(a.x) + bf_hi(b.x); v0[2] = bf_lo(h.y) + bf_lo(a.y) + bf_lo(b.y); v0[3] = bf_hi(h.y) + bf_hi(a.y) + bf_hi(b.y);
            v1[0] = bf_lo(h.z) + bf_lo(a.z) + bf_lo(b.z); v1[1] = bf_hi(h.z) + bf_hi(a.z) + bf_hi(b.z); v1[2] = bf_lo(h.w) + bf_lo(a.w) + bf_lo(b.w); v1[3] = bf_hi(h.w) + bf_hi(a.w) + bf_hi(b.w);
            od[128 * j] = v0; od[128 * j + 1] = v1;
        }
    }
}

__global__ void __launch_bounds__(NWAVES * 64, 2) mk_fwd(Args args) {
    extern __shared__ __attribute__((aligned(16))) unsigned char lds[];
    Frame F;
    F.lds = (LAS unsigned char*)lds; F.ws = args.ws; F.ctl = (unsigned*)(args.ws + WS_CTL);
    F.tid = threadIdx.x; F.lane = F.tid & 63; F.wave = __builtin_amdgcn_readfirstlane(F.tid >> 6);
    F.G = gridDim.x; { const int bx = blockIdx.x; F.vcu = (F.G % 8 == 0) ? (bx % 8) * (F.G / 8) + bx / 8 : bx; }
    F.in = args.in; F.out = args.out;
    volatile LAS unsigned* MISC = (volatile LAS unsigned*)(F.lds + MISC_OFF);
    if (F.tid < 64) MISC[F.tid] = 0u;
    __syncthreads();
    const int lo = args.ph_lo, hi = args.ph_hi;
    const bool use_bar = (hi - lo) > 1;
    XcdBarrier bar; bar.bar = F.ctl + CW_BAR + args.li * XCD_BAR_WORDS; bar.x = 0; bar.st = nullptr;
    if (use_bar) bar = xcd_barrier_post(F.ctl + CW_BAR + args.li * XCD_BAR_WORDS, MISC + 8);
#define IN(k) (lo <= (k) && (k) < hi)
#define SEAM(k) do { if (IN(k) && (IN((k) + 1) || ((k) == 4 && IN(6)))) xcd_barrier(bar); } while (0)
    bf16* BIG = (bf16*)(F.ws + WS_BIG);

    if (IN(0)) { p0_prologue(F); SEAM(0); }
    if (IN(1)) {
        const CuSplit cs = split_cus(F.G, F.vcu, P1_UNITS);
        if (!cs.conv) {
            pg8::Gemm g{BIG, BIG, 0, 0, DM}; P1Order S{cs.Gg, cs.cg};
            EpiQKV E{(bf16*)(F.ws + WS_QS), (bf16*)(F.ws + WS_KS), (bf16*)(F.ws + WS_QW), (bf16*)(F.ws + WS_KW), (bf16*)(F.ws + WS_VT), F.in[5], F.in[6]};
            pg8::gemm_phase<EpiQKV, P1Order, true, true>(F.lds + RING_OFF, g, S, E);
        } else {
            const int base = NITEMS - TAIL6_ITEMS - tail1_items(F.G);
            conv_range3(F, base + cs.cc * NWAVES + F.wave, cs.nconv * NWAVES, NITEMS - TAIL6_ITEMS);
        }
        SEAM(1);
    }
    if (IN(2)) { p2_attention(F); SEAM(2); }
    if (IN(3)) {
        pg8::Gemm g{(const bf16*)(F.ws + WS_MIXED), (const bf16*)(F.ws + WS_WOUT), NTOK, DM, DM}; pg8::StaticOrder S; S.init(NTOK, DM, F.G, (int)blockIdx.x);
        LAS float* RS = (LAS float*)(F.lds + ATT_TBR_OFF);
        {   const float* SSQ = (const float*)(F.ws + WS_SSQ);
            for (int i = 0; i < 4; ++i) { pg8::Unit u; if (!S.next(i, u)) break;
                if (F.tid < 256) { const pg8::f32x4* q = (const pg8::f32x4*)(SSQ + (size_t)(u.pm * 256 + F.tid) * 16); const pg8::f32x4 a = q[0], b = q[1], c = q[2], d = q[3];
                    float sb = 0.f, sw = 0.f;
#pragma unroll
                    for (int q_ = 0; q_ < ATT_WAVES; ++q_) { sb += (q_ < 4 ? a[q_ & 3] : b[q_ & 3]); sw += (q_ < 4 ? c[q_ & 3] : d[q_ & 3]); }
                    RS[(i * 256 + F.tid) * 2] = 1.0f / sqrtf(sb * (1.0f / 1024.0f) + RMS_EPS); RS[(i * 256 + F.tid) * 2 + 1] = 1.0f / sqrtf(sw * (1.0f / 1024.0f) + RMS_EPS);
                    RS[2048 + i * 256 + F.tid] = ((const float*)(F.ws + WS_RINV))[u.pm * 256 + F.tid]; } }
            __syncthreads(); }
        EpiRes E{(bf16*)(F.ws + WS_HB), RS, (const bf16*)(F.ws + WS_BIG), 0};
        pg8::gemm_phase<EpiRes, pg8::StaticOrder, true, true>(F.lds + RING_OFF, g, S, E);
        SEAM(3);
    }
    if (IN(4)) { p4_router(F); SEAM(4); }
    if (IN(5) || IN(6) || IN(7) || IN(8)) build_tables(F);
    if (IN(6)) {
        const LAS int* T6 = (const LAS int*)(F.lds + TBL_OFF); const CuSplit cs = split_cus(F.G, F.vcu, T6[TBL_NT] * 4);
        const int base = NITEMS - TAIL6_ITEMS; int mid = base + cs.nconv * NWAVES * TAIL6_PER_WAVE; if (mid > NITEMS) mid = NITEMS;
        if (!cs.conv) {
            pg8::Gemm g{(const bf16*)(F.ws + WS_HB), (const bf16*)(F.ws + WS_WGU), 0, 0, DM}; MoeOrder S{T6, 4, cs.Gg, cs.cg};
            MoeGather GA{(const int*)(F.ws + WS_LIST), T6, (LAS int*)(F.lds + TOKBUF_OFF), 4, (const float*)(F.ws + WS_RSTDW), (const float*)(F.ws + WS_GATEW)};
            EpiSwiGLU E{(bf16*)(F.ws + WS_HDN), (const LAS float*)(F.lds + TOKBUF_OFF + 2048), T6, 0};
            pg8::gemm_phase_g<EpiSwiGLU, MoeOrder>(F.lds + RING_OFF, g, S, E, GA);
        } else conv_range3(F, base + cs.cc * NWAVES + F.wave, cs.nconv * NWAVES, mid);
        conv_range(F, mid + F.vcu * NWAVES + F.wave, F.G * NWAVES, NITEMS);
        SEAM(6);
    }
    if (IN(7)) {
        pg8::Gemm g{(const bf16*)(F.ws + WS_HDN), (const bf16*)(F.ws + WS_WD), 0, 0, DEXP}; MoeOrder S{(const LAS int*)(F.lds + TBL_OFF), 8, F.G, F.vcu};
        EpiY E{(bf16*)(F.ws + WS_Y), (const LAS int*)(F.lds + TBL_OFF)};
        pg8::gemm_phase<EpiY, MoeOrder, true, true>(F.lds + RING_OFF, g, S, E);
        SEAM(7);
    }
    if (IN(8)) p8_combine(F);
#undef IN
#undef SEAM
}

extern "C" void kernel_launch(void* const* d_in, const int* in_sizes, int n_in, void* d_out, int out_size, void* d_ws, size_t ws_size, hipStream_t stream) {
    static int grid = 0;
    if (grid == 0) {
        if (n_in != 19 || out_size != NTOK * DM || ws_size < WS_END) { fprintf(stderr, "kernel_launch: unexpected shapes (n_in %d out %d ws %zu)\n", n_in, out_size, ws_size); grid = -1; return; }
        int dev = 0, cus = 0, per_cu = 0;
        if (hipGetDevice(&dev) != hipSuccess || hipDeviceGetAttribute(&cus, hipDeviceAttributeMultiprocessorCount, dev) != hipSuccess) { grid = -1; return; }
        if (hipFuncSetAttribute((const void*)mk_fwd, hipFuncAttributeMaxDynamicSharedMemorySize, LDS_BYTES) != hipSuccess) { fprintf(stderr, "kernel_launch: hipFuncSetAttribute failed\n"); grid = -1; return; }
        if (hipOccupancyMaxActiveBlocksPerMultiprocessor(&per_cu, (const void*)mk_fwd, NWAVES * 64, LDS_BYTES) != hipSuccess || per_cu < 1) { fprintf(stderr, "kernel_launch: occupancy query reports %d\n", per_cu); }
        (void)hipGetLastError();
        grid = cus;
    }
    if (grid < 0) return;
    (void)hipMemsetAsync((char*)d_ws + WS_CTL, 0, CTL_ZERO_BYTES, stream);
    Args a{};
    for (int i = 0; i < 19; ++i) a.in[i] = (const float*)d_in[i];
    a.out = (float*)d_out; a.ws = (unsigned char*)d_ws;
#if MK_N_LAUNCHES == 1
    a.ph_lo = 0; a.ph_hi = N_PHASES; a.li = 0;
    hipLaunchKernelGGL(mk_fwd, dim3(grid), dim3(NWAVES * 64), LDS_BYTES, stream, a);
#else
    a.li = 0;
    for (int p = 0; p < N_PHASES; ++p) { a.ph_lo = p; a.ph_hi = p + 1; hipLaunchKernelGGL(mk_fwd, dim3(grid), dim3(NWAVES * 64), LDS_BYTES, stream, a); }
#endif
}
```

```cpp
#include <hip/hip_runtime.h>
#include <cstdio>
#include <cstdint>
#define TAIL1_PW 44
#define TAIL6_PW 30
#define TAIL6_N 10080
#define P1_EXTRA 1
#define W_LO 0
namespace pg8 {
#define PG8_LAS __attribute__((address_space(3)))
typedef unsigned short bf16_t;
typedef short bf16x8 __attribute__((ext_vector_type(8)));
typedef float f32x4 __attribute__((ext_vector_type(4)));
typedef unsigned u32x4 __attribute__((ext_vector_type(4)));
constexpr int BM = 256, BK = 64, HALF = 128, HTB = HALF * BK * 2  , STAGE_BYTES = 8 * HTB, NXCD = 8, WGM = 8;

__host__ __device__ __forceinline__ int lds_byte(int r, int c) { const int st = (r >> 4) * 2 + (c >> 5), rr = r & 15, cc = c & 31, ob = rr * 64 + cc * 2; return st * 1024 + (ob ^ (((ob >> 9) & 1) << 5)); }
__host__ __device__ __forceinline__ void stage_rc(int b, int& R, int& C) { const int st = b / 1024, sb = b % 1024, swz = sb ^ (((sb >> 9) & 1) << 5); R = (st >> 1) * 16 + swz / 64; C = (st & 1) * 32 + (swz % 64) / 2; }
__host__ __device__ __forceinline__ int perm32(int rho) { const int n = rho >> 4, i = rho & 15; return 8 * (i >> 2) + 4 * n + (i & 3); }

struct Unit { int pm, pn; };
struct Gemm { const bf16_t* A; const bf16_t* Bt; int M, N, K; };

struct StaticOrder {
    int nM, nN, nwg, G, c;
    __host__ __device__ void init(int M, int N, int G_, int c_) { nM = M / BM; nN = N / BM; nwg = nM * nN; G = G_; c = c_; }
    __host__ __device__ bool next(int i, Unit& u) const {
        const long L = (long)i * G + c; if (L >= nwg) return false;
        int wgid = (int)L; { const int q = nwg / NXCD, r = nwg % NXCD, xcd = wgid % NXCD, off = wgid / NXCD; wgid = (xcd < r ? xcd * (q + 1) : r * (q + 1) + (xcd - r) * q) + off; }
        const int nig = WGM * nN, gid = wgid / nig, fm = gid * WGM, gsz = (nM - fm) < WGM ? (nM - fm) : WGM;
        u.pm = fm + ((wgid % nig) % gsz); u.pn = (wgid % nig) / gsz; return true;
    }
    __device__ __forceinline__ void a_ready(const Unit&) const {}
    __device__ __forceinline__ void done(const Unit&) const {}
};

__device__ __forceinline__ unsigned cvt_pk_bf16(float lo, float hi) { unsigned r; asm volatile("v_cvt_pk_bf16_f32 %0, %1, %2" : "=v"(r) : "v"(lo), "v"(hi)); return r; }
typedef float f32x2 __attribute__((ext_vector_type(2)));
__device__ __forceinline__ f32x2 gelu_pk(f32x2 v) {
    const f32x2 av = __builtin_elementwise_abs(v), d = av * 0.2316418882f + 1.0f;
    f32x2 t; t.x = __builtin_amdgcn_rcpf(d.x); t.y = __builtin_amdgcn_rcpf(d.y);
    f32x2 q = t * 0.5307027145f + (-0.7265760135f); q = q * t + 0.7107068705f; q = q * t + (-0.142248368f); q = q * t + 0.127414796f; q = q * t;
    const f32x2 s = (v * v) * (-0.72134752044f);
    f32x2 e; e.x = __builtin_amdgcn_exp2f(s.x); e.y = __builtin_amdgcn_exp2f(s.y);
    const f32x2 m = v * (q * e), r = v - m;
    f32x2 o; o.x = v.x < 0.f ? m.x : r.x; o.y = v.y < 0.f ? m.y : r.y; return o;
}

template <int ACT  > struct EpiBf16 {
    static constexpr bool PERM = true, AFTER_DRAIN = false; static_assert(ACT == 0 || ACT == 1, "EpiBf16: ACT is 0 (none) or 1 (gelu_pk)");
    bf16_t* O; int ldc; const float* bias; int split_cols; size_t split_stride; float scale0;
    __device__ __forceinline__ void operator()(const f32x4 (&acc)[2][2][4][2], const Unit& u, int wr, int wc, int fr, int fq) const {
        const int row0 = u.pm * BM + wr * 64 + fr; int colt = u.pn * BM; bf16_t* base = O;
        float sc = 1.f; if (split_cols) { const int t = colt / split_cols; base += (size_t)t * split_stride; colt -= t * split_cols; if (t == 0) sc = scale0; }
        const int col0 = colt + wc * 32 + 8 * fq, bcol0 = u.pn * BM + wc * 32 + 8 * fq;
        f32x4 bv[2][2];
#pragma unroll
        for (int bj = 0; bj < 2; ++bj)
#pragma unroll
            for (int n = 0; n < 2; ++n) bv[bj][n] = bias ? *(const f32x4*)(bias + bcol0 + bj * HALF + 4 * n) : (f32x4){0.f, 0.f, 0.f, 0.f};
#pragma unroll
        for (int ai = 0; ai < 2; ++ai)
#pragma unroll
            for (int m = 0; m < 4; ++m) { bf16_t* rowp = base + (size_t)(row0 + ai * HALF + m * 16) * ldc + col0;
#pragma unroll
                for (int bj = 0; bj < 2; ++bj) { f32x4 v0 = acc[ai][bj][m][0] + bv[bj][0], v1 = acc[ai][bj][m][1] + bv[bj][1];
                    if (ACT == 1) { f32x2 a = gelu_pk((f32x2){v0[0], v0[1]}), b = gelu_pk((f32x2){v0[2], v0[3]}), c = gelu_pk((f32x2){v1[0], v1[1]}), d = gelu_pk((f32x2){v1[2], v1[3]});
                        v0 = (f32x4){a.x, a.y, b.x, b.y}; v1 = (f32x4){c.x, c.y, d.x, d.y}; }
                    v0 = v0 * sc; v1 = v1 * sc; u32x4 w; w.x = cvt_pk_bf16(v0[0], v0[1]); w.y = cvt_pk_bf16(v0[2], v0[3]); w.z = cvt_pk_bf16(v1[0], v1[1]); w.w = cvt_pk_bf16(v1[2], v1[3]);
                    *(u32x4*)(rowp + bj * HALF) = w; } }
    }
};

struct PanelStats {
    unsigned* xbuf;
    unsigned* cnt;
    unsigned* tmo;
    int ntn; float eps;
    unsigned code;
    __device__ __forceinline__ bool run(const f32x4 (&v)[2][2][4][2], const Unit& u, int wr, int wc, int fr, int fq, PG8_LAS unsigned char* lds, int wid, int lane) const {
        typedef float f32x2v __attribute__((ext_vector_type(2)));
        PG8_LAS f32x2v* P = (PG8_LAS f32x2v*)lds;
        PG8_LAS f32x2v* S = (PG8_LAS f32x2v*)(lds + 8192);
        PG8_LAS unsigned* flag = (PG8_LAS unsigned*)(lds + 8192 + 2048);
#pragma unroll
        for (int ai = 0; ai < 2; ++ai)
#pragma unroll
            for (int m = 0; m < 4; ++m) {
                float s = 0.f;
#pragma unroll
                for (int bj = 0; bj < 2; ++bj)
#pragma unroll
                    for (int n = 0; n < 2; ++n) { const f32x4 x = v[ai][bj][m][n]; s += (x[0] + x[1]) + (x[2] + x[3]); }
                s += __shfl_xor(s, 16); s += __shfl_xor(s, 32);
                const float mw = s * (1.0f / 64.0f); float q = 0.f;
#pragma unroll
                for (int bj = 0; bj < 2; ++bj)
#pragma unroll
                    for (int n = 0; n < 2; ++n) { const f32x4 d = v[ai][bj][m][n] - mw; q += (d[0] * d[0] + d[1] * d[1]) + (d[2] * d[2] + d[3] * d[3]); }
                q += __shfl_xor(q, 16); q += __shfl_xor(q, 32);
                if (fq == 0) P[(ai * HALF + wr * 64 + m * 16 + fr) * 4 + wc] = (f32x2v){mw, q};
            }
        asm volatile("s_waitcnt lgkmcnt(0)" ::: "memory"); __builtin_amdgcn_s_barrier(); asm volatile("" ::: "memory");
#if defined(BROKEN_EXCHANGE_NO_WAIT)
#warning BROKEN CONTROL BUILD: the row-statistics exchange does not wait; results are wrong by design
        if (blockIdx.x >= 64) { const long long t0_ = clock64(); while (clock64() - t0_ < 60000) __builtin_amdgcn_s_sleep(8); }
#endif
        const int row = wid * 32 + (lane & 31);
        if (lane < 32) {
            const f32x2v a = P[row * 4 + 0], b = P[row * 4 + 1], c = P[row * 4 + 2], d = P[row * 4 + 3];
            const float mt = (a.x + b.x + c.x + d.x) * 0.25f;
            const float da = a.x - mt, db = b.x - mt, dc = c.x - mt, dd = d.x - mt;
            const float m2 = (a.y + b.y) + (c.y + d.y) + 64.0f * ((da * da + db * db) + (dc * dc + dd * dd));
            unsigned long long* slot = (unsigned long long*)xbuf + ((size_t)(u.pm * BM + row) * 4 + u.pn);
            __hip_atomic_store(slot, ((unsigned long long)__float_as_uint(m2) << 32) | __float_as_uint(mt), __ATOMIC_RELAXED, __HIP_MEMORY_SCOPE_AGENT);
        }
        asm volatile("s_waitcnt vmcnt(0)" ::: "memory");
        if (lane == 0) __hip_atomic_fetch_add(cnt + 64 * u.pm, 1u, __ATOMIC_RELAXED, __HIP_MEMORY_SCOPE_AGENT);
        if (wid == 0) {
            bool dead = false; const unsigned long long t0 = __builtin_amdgcn_s_memrealtime(); const unsigned want = 8u * (unsigned)ntn;
            for (;;) {
#if defined(BROKEN_EXCHANGE_NO_WAIT)
                break;
#endif
                if ((unsigned)__builtin_amdgcn_readfirstlane(__hip_atomic_load(cnt + 64 * u.pm, __ATOMIC_RELAXED, __HIP_MEMORY_SCOPE_AGENT)) >= want) break;
                if (__builtin_amdgcn_s_memrealtime() - t0 > 2000000ull) {
                    if (lane == 0) { unsigned expect = 0u; __hip_atomic_compare_exchange_strong(tmo + 1, &expect, code | (unsigned)(u.pm & 0xff), __ATOMIC_RELAXED, __ATOMIC_RELAXED, __HIP_MEMORY_SCOPE_AGENT);
                                     __hip_atomic_store(tmo, 1u, __ATOMIC_RELAXED, __HIP_MEMORY_SCOPE_AGENT); }
                    dead = true; break; }
                __builtin_amdgcn_s_sleep(2);
            }
            __builtin_amdgcn_fence(__ATOMIC_ACQUIRE, "agent");
            if (lane == 0) flag[0] = dead ? 1u : 0u;
        }
        asm volatile("s_waitcnt vmcnt(0) lgkmcnt(0)" ::: "memory"); __builtin_amdgcn_s_barrier(); asm volatile("" ::: "memory");
        const bool bad = flag[0] != 0u;
        if (lane < 32) {
            const unsigned long long* slot = (const unsigned long long*)xbuf + (size_t)(u.pm * BM + row) * 4; float mt[4], m2[4]; float ms = 0.f;
#pragma unroll
            for (int t = 0; t < 4; ++t) { if (t < ntn) { const unsigned long long w = __hip_atomic_load(slot + t, __ATOMIC_RELAXED, __HIP_MEMORY_SCOPE_AGENT); mt[t] = __uint_as_float((unsigned)w); m2[t] = __uint_as_float((unsigned)(w >> 32)); } else { mt[t] = 0.f; m2[t] = 0.f; } ms += mt[t]; }
            const float mean = ms / (float)ntn; float q = 0.f;
#pragma unroll
            for (int t = 0; t < 4; ++t) if (t < ntn) { const float dm = mt[t] - mean; q += m2[t] + 256.0f * dm * dm; }
            S[row] = (f32x2v){mean, 1.0f / sqrtf(q / (256.0f * (float)ntn) + eps)};
        }
        asm volatile("s_waitcnt lgkmcnt(0)" ::: "memory"); __builtin_amdgcn_s_barrier(); asm volatile("" ::: "memory");
        return bad;
    }
};
struct EpiLnRes {
    static constexpr bool PERM = false, AFTER_DRAIN = true;
    const float* base; float* out; int ldc; const float* bias; PanelStats st; unsigned poison;
    __device__ __forceinline__ void fused(f32x4 (&acc)[2][2][4][2], const Unit& u, int wr, int wc, int fr, int fq, PG8_LAS unsigned char* lds, int wid, int lane) const {
        typedef float f32x2v __attribute__((ext_vector_type(2)));
        const PG8_LAS f32x2v* S = (const PG8_LAS f32x2v*)(lds + 8192);
        const int col0 = u.pn * BM + wc * 32 + 4 * fq;
#pragma unroll
        for (int bj = 0; bj < 2; ++bj)
#pragma unroll
            for (int n = 0; n < 2; ++n) { const f32x4 bv = bias ? *(const f32x4*)(bias + col0 + bj * HALF + n * 16) : (f32x4){0.f, 0.f, 0.f, 0.f};
#pragma unroll
                for (int ai = 0; ai < 2; ++ai)
#pragma unroll
                    for (int m = 0; m < 4; ++m) acc[ai][bj][m][n] += bv; }
        f32x4 pre[4][2][2];
#pragma unroll
        for (int m = 0; m < 4; ++m) { const size_t off = (size_t)(u.pm * BM + wr * 64 + m * 16 + fr) * ldc + col0;
#pragma unroll
            for (int bj = 0; bj < 2; ++bj)
#pragma unroll
                for (int n = 0; n < 2; ++n) pre[m][bj][n] = *(const f32x4*)(base + off + bj * HALF + n * 16); }
        const bool bad = st.run(acc, u, wr, wc, fr, fq, lds, wid, lane) || poison != 0u;
        const float qnan = __builtin_nanf("");
#pragma unroll
        for (int ai = 0; ai < 2; ++ai)
#pragma unroll
            for (int m = 0; m < 4; ++m) { const int r = ai * HALF + wr * 64 + m * 16 + fr; const f32x2v sr = S[r]; const size_t off = (size_t)(u.pm * BM + r) * ldc + col0;
#pragma unroll
                for (int bj = 0; bj < 2; ++bj)
#pragma unroll
                    for (int n = 0; n < 2; ++n) { const f32x4 bs = ai == 0 ? pre[m][bj][n] : *(const f32x4*)(base + off + bj * HALF + n * 16); f32x4 o = bs + (acc[ai][bj][m][n] - sr.x) * sr.y;
                        if (bad) o = (f32x4){qnan, qnan, qnan, qnan}; *(f32x4*)(out + off + bj * HALF + n * 16) = o; }
                if (m & 1) asm volatile("" ::: "memory"); }
    }
};
struct EpiLnResLn {
    static constexpr bool PERM = false, AFTER_DRAIN = true;
    const float* base; float* out; bf16_t* xn; int ldc; const float* bias; PanelStats st1, st2; unsigned poison;
    __device__ __forceinline__ void fused(f32x4 (&acc)[2][2][4][2], const Unit& u, int wr, int wc, int fr, int fq, PG8_LAS unsigned char* lds, int wid, int lane) const {
        typedef float f32x2v __attribute__((ext_vector_type(2))); typedef unsigned u32x2v __attribute__((ext_vector_type(2)));
        const PG8_LAS f32x2v* S = (const PG8_LAS f32x2v*)(lds + 8192);
        const int col0 = u.pn * BM + wc * 32 + 4 * fq;
#pragma unroll
        for (int bj = 0; bj < 2; ++bj)
#pragma unroll
            for (int n = 0; n < 2; ++n) { const f32x4 bv = bias ? *(const f32x4*)(bias + col0 + bj * HALF + n * 16) : (f32x4){0.f, 0.f, 0.f, 0.f};
#pragma unroll
                for (int ai = 0; ai < 2; ++ai)
#pragma unroll
                    for (int m = 0; m < 4; ++m) acc[ai][bj][m][n] += bv; }
        bool bad = st1.run(acc, u, wr, wc, fr, fq, lds, wid, lane) || poison != 0u;
        const float qnan = __builtin_nanf("");
#pragma unroll
        for (int ai = 0; ai < 2; ++ai)
#pragma unroll
            for (int m = 0; m < 4; ++m) { const int r = ai * HALF + wr * 64 + m * 16 + fr; const f32x2v sr = S[r]; const size_t off = (size_t)(u.pm * BM + r) * ldc + col0;
#pragma unroll
                for (int bj = 0; bj < 2; ++bj)
#pragma unroll
                    for (int n = 0; n < 2; ++n) { const f32x4 bs = *(const f32x4*)(base + off + bj * HALF + n * 16); acc[ai][bj][m][n] = bs + (acc[ai][bj][m][n] - sr.x) * sr.y; }
                asm volatile("" : "+v"(acc[ai][0][m][0]), "+v"(acc[ai][0][m][1]), "+v"(acc[ai][1][m][0]), "+v"(acc[ai][1][m][1]));
                if (m & 1) asm volatile("" ::: "memory"); }
        const bool bad1 = bad;
        bad = st2.run(acc, u, wr, wc, fr, fq, lds, wid, lane) || bad;
#pragma unroll
        for (int ai = 0; ai < 2; ++ai)
#pragma unroll
            for (int m = 0; m < 4; ++m) { const int r = ai * HALF + wr * 64 + m * 16 + fr; const f32x2v sr = S[r]; const size_t off = (size_t)(u.pm * BM + r) * ldc + col0;
#pragma unroll
                for (int bj = 0; bj < 2; ++bj)
#pragma unroll
                    for (int n = 0; n < 2; ++n) { const f32x4 x1 = acc[ai][bj][m][n]; *(f32x4*)(out + off + bj * HALF + n * 16) = bad1 ? (f32x4){qnan, qnan, qnan, qnan} : x1;
                        const f32x4 o = (x1 - sr.x) * sr.y; u32x2v w; w.x = cvt_pk_bf16(o[0], o[1]); w.y = cvt_pk_bf16(o[2], o[3]);
                        if (bad) { w.x = 0x7fc07fc0u; w.y = 0x7fc07fc0u; } *(u32x2v*)(xn + off + bj * HALF + n * 16) = w; }
                asm volatile("" ::: "memory"); }
    }
};

template <class Epi, class Sched, bool ALIGN_EPI = false, bool SP2 = false>
__device__ __forceinline__ void gemm_phase(PG8_LAS unsigned char* lds, const Gemm g, const Sched& S, const Epi& E) {
    const int tid = threadIdx.x, wid = __builtin_amdgcn_readfirstlane(tid >> 6), lane = tid & 63, wr = wid >> 2, wc = wid & 3, fr = lane & 15, fq = lane >> 4;
    const int K = g.K, nt = K / BK;
    unsigned voffA[2], voffB[2];
#pragma unroll
    for (int i = 0; i < 2; ++i) { int R, C; stage_rc(tid * 16 + i * 8192, R, C); const int Rb = Epi::PERM ? ((R & ~31) + perm32(R & 31)) : R;
        voffA[i] = (unsigned)(R * K + C) * 2u; voffB[i] = (unsigned)(Rb * K + C) * 2u; }
    const size_t kstep = (size_t)(BK * 2);
    const size_t hstep = (size_t)HALF * K * 2;
    const size_t tstep = 2 * hstep;
    const unsigned ldsw = (unsigned)wid * 1024u;
    const int aoff = lds_byte(wr * 64 + fr, fq * 8), boff = lds_byte(wc * 32 + fr, fq * 8);
#define PG8_SA(b, h) (((b) * 2 + (h)) * HTB)
#define PG8_SB(b, h) ((4 + (b) * 2 + (h)) * HTB)
#define PG8_STAGE(bufoff, gbase, voff) do { _Pragma("unroll") for (int _i = 0; _i < 2; ++_i) \
        __builtin_amdgcn_global_load_lds((const unsigned*)((const char*)(gbase) + (voff)[_i]), (PG8_LAS unsigned*)(lds + (bufoff) + ldsw + _i * 8192), 16, 0, 0); } while (0)
#define PG8_LDA(dst, b, h) do { _Pragma("unroll") for (int m = 0; m < 4; ++m) _Pragma("unroll") for (int k = 0; k < 2; ++k) dst[m][k] = *(const PG8_LAS bf16x8*)(lds + PG8_SA(b, h) + aoff + m * 2048 + k * 1024); } while (0)
#define PG8_LDB(dst, b, h) do { _Pragma("unroll") for (int n = 0; n < 2; ++n) _Pragma("unroll") for (int k = 0; k < 2; ++k) dst[n][k] = *(const PG8_LAS bf16x8*)(lds + PG8_SB(b, h) + boff + n * 2048 + k * 1024); } while (0)
#define PG8_MMA(ai, bj, At, Bt) do { __builtin_amdgcn_s_setprio(1); _Pragma("unroll") for (int m = 0; m < 4; ++m) _Pragma("unroll") for (int n = 0; n < 2; ++n) _Pragma("unroll") for (int k = 0; k < 2; ++k) \
        acc[ai][bj][m][n] = __builtin_amdgcn_mfma_f32_16x16x32_bf16(Bt[n][k], At[m][k], acc[ai][bj][m][n], 0, 0, 0); __builtin_amdgcn_s_setprio(0); } while (0)
#define PG8_WAIT_V(n) asm volatile("s_waitcnt vmcnt(" #n ")" ::: "memory")
#define PG8_WAIT_L(n) asm volatile("s_waitcnt lgkmcnt(" #n ")" ::: "memory")
#define PG8_BAR __builtin_amdgcn_s_barrier()
#define PG8_SCHED __builtin_amdgcn_sched_barrier(0)
    Unit cur, nxt; int ui = 0;
    if (!S.next(0, cur)) return;
    f32x4 acc[2][2][4][2];
#pragma unroll
    for (int a = 0; a < 2; ++a)
#pragma unroll
        for (int b = 0; b < 2; ++b)
#pragma unroll
            for (int m = 0; m < 4; ++m)
#pragma unroll
                for (int n = 0; n < 2; ++n) acc[a][b][m][n] = (f32x4){0.f, 0.f, 0.f, 0.f};
    bf16x8 At[4][2], B0[2][2], B1[2][2];
    const char* cA = (const char*)g.A + (size_t)cur.pm * tstep; const char* cB = (const char*)g.Bt + (size_t)cur.pn * tstep;
    S.a_ready(cur);
    if constexpr (SP2) {
        PG8_STAGE(PG8_SB(0, 0), cB, voffB); PG8_STAGE(PG8_SB(0, 1), cB + hstep, voffB); PG8_STAGE(PG8_SA(0, 0), cA, voffA); PG8_STAGE(PG8_SA(0, 1), cA + hstep, voffA);
        if (wr == 1) PG8_BAR;
        PG8_WAIT_V(2); PG8_BAR;
        PG8_STAGE(PG8_SB(1, 0), cB + kstep, voffB); PG8_STAGE(PG8_SA(1, 0), cA + kstep, voffA); PG8_STAGE(PG8_SB(1, 1), cB + hstep + kstep, voffB);
        PG8_WAIT_V(6); PG8_BAR;
    } else {
        PG8_STAGE(PG8_SB(0, 0), cB, voffB); PG8_STAGE(PG8_SA(0, 0), cA, voffA); PG8_STAGE(PG8_SB(0, 1), cB + hstep, voffB); PG8_STAGE(PG8_SA(0, 1), cA + hstep, voffA);
        if (wr == 1) PG8_BAR;
        PG8_WAIT_V(4); PG8_BAR;
        PG8_STAGE(PG8_SB(1, 0), cB + kstep, voffB); PG8_STAGE(PG8_SA(1, 0), cA + kstep, voffA); PG8_STAGE(PG8_SB(1, 1), cB + hstep + kstep, voffB);
        PG8_WAIT_V(6); PG8_BAR;
    }
    int t_mid = nt >> 1; if constexpr (Epi::MIDK) asm volatile("" : "+s"(t_mid));
    for (;;) {
        const bool has_next = S.next(ui + 1, nxt);
        const char* nA = has_next ? (const char*)g.A + (size_t)nxt.pm * tstep : cA; const char* nB = has_next ? (const char*)g.Bt + (size_t)nxt.pn * tstep : cB;
        for (int t = 0; t < nt; t += 2) {
            const bool last = (t == nt - 2);
            if constexpr (Epi::MIDK) { if (t == t_mid) E.midk(acc, cur, wr, fr); }
            const char* a1 = cA + (size_t)(t + 1) * kstep;
            const char* a2 = last ? nA : cA + (size_t)(t + 2) * kstep; const char* b2 = last ? nB : cB + (size_t)(t + 2) * kstep;
            const char* a3 = a2 + kstep; const char* b3 = b2 + kstep;
            if (last && has_next) S.a_ready(nxt);
            if constexpr (SP2) {
            PG8_LDB(B0, 0, 0); PG8_LDB(B1, 0, 1); PG8_SCHED; PG8_LDA(At, 0, 0); PG8_STAGE(PG8_SA(1, 1), a1 + hstep, voffA);
            PG8_WAIT_V(8); PG8_WAIT_L(0); PG8_BAR; PG8_MMA(0, 0, At, B0); PG8_MMA(0, 1, At, B1); PG8_BAR; PG8_SCHED;
            PG8_LDA(At, 0, 1); PG8_STAGE(PG8_SB(0, 0), b2, voffB); PG8_STAGE(PG8_SB(0, 1), b2 + hstep, voffB); PG8_STAGE(PG8_SA(0, 0), a2, voffA);
            PG8_WAIT_V(8); PG8_WAIT_L(0); PG8_BAR; PG8_MMA(1, 0, At, B0); PG8_MMA(1, 1, At, B1); PG8_BAR; PG8_SCHED;
            PG8_LDB(B0, 1, 0); PG8_LDB(B1, 1, 1); PG8_SCHED; PG8_LDA(At, 1, 0); PG8_STAGE(PG8_SA(0, 1), a2 + hstep, voffA);
            PG8_WAIT_V(8); PG8_WAIT_L(0); PG8_BAR; PG8_MMA(0, 0, At, B0); PG8_MMA(0, 1, At, B1); PG8_BAR; PG8_SCHED;
            PG8_LDA(At, 1, 1); PG8_STAGE(PG8_SB(1, 0), b3, voffB); PG8_STAGE(PG8_SB(1, 1), b3 + hstep, voffB); PG8_STAGE(PG8_SA(1, 0), a3, voffA);
            PG8_WAIT_V(8); PG8_WAIT_L(0); PG8_BAR; PG8_MMA(1, 0, At, B0); PG8_MMA(1, 1, At, B1); PG8_BAR; PG8_SCHED;
            } else {
            PG8_LDB(B0, 0, 0); PG8_SCHED; PG8_LDA(At, 0, 0); PG8_STAGE(PG8_SA(1, 1), a1 + hstep, voffA);
            PG8_WAIT_L(8); PG8_BAR; PG8_WAIT_L(0); PG8_MMA(0, 0, At, B0); PG8_BAR; PG8_SCHED;
            PG8_LDB(B1, 0, 1); PG8_STAGE(PG8_SB(0, 0), b2, voffB);
            PG8_BAR; PG8_WAIT_L(0); PG8_MMA(0, 1, At, B1); PG8_BAR;
            PG8_LDA(At, 0, 1); PG8_STAGE(PG8_SA(0, 0), a2, voffA);
            PG8_BAR; PG8_WAIT_L(0); PG8_MMA(1, 0, At, B0); PG8_BAR; PG8_SCHED;
            PG8_STAGE(PG8_SB(0, 1), b2 + hstep, voffB);
            PG8_WAIT_V(6); PG8_BAR; PG8_MMA(1, 1, At, B1); PG8_BAR;
            PG8_LDB(B0, 1, 0); PG8_SCHED; PG8_LDA(At, 1, 0); PG8_STAGE(PG8_SA(0, 1), a2 + hstep, voffA);
            PG8_WAIT_L(8); PG8_BAR; PG8_WAIT_L(0); PG8_MMA(0, 0, At, B0); PG8_BAR; PG8_SCHED;
            PG8_LDB(B1, 1, 1); PG8_STAGE(PG8_SB(1, 0), b3, voffB);
            PG8_BAR; PG8_WAIT_L(0); PG8_MMA(0, 1, At, B1); PG8_BAR;
            PG8_LDA(At, 1, 1); PG8_STAGE(PG8_SA(1, 0), a3, voffA);
            PG8_BAR; PG8_WAIT_L(0); PG8_MMA(1, 0, At, B0); PG8_BAR; PG8_SCHED;
            PG8_STAGE(PG8_SB(1, 1), b3 + hstep, voffB);
            PG8_WAIT_V(6); PG8_BAR; PG8_MMA(1, 1, At, B1); PG8_BAR;
            }
        }
        if constexpr (ALIGN_EPI) { if (wr == 0) PG8_BAR; }
        if constexpr (!Epi::AFTER_DRAIN) { E(acc, cur, wr, wc, fr, fq); S.done(cur); }
        if (!has_next) break;
#pragma unroll
        for (int a = 0; a < 2; ++a)
#pragma unroll
            for (int b = 0; b < 2; ++b)
#pragma unroll
                for (int m = 0; m < 4; ++m)
#pragma unroll
                    for (int n = 0; n < 2; ++n) acc[a][b][m][n] = (f32x4){0.f, 0.f, 0.f, 0.f};
        cur = nxt; cA = nA; cB = nB; ++ui;
        if constexpr (ALIGN_EPI) { if (wr == 1) PG8_BAR; }
    }
    PG8_WAIT_V(0);
    if constexpr (!ALIGN_EPI) { if (wr == 0) PG8_BAR; }
    PG8_BAR;
    if constexpr (Epi::AFTER_DRAIN) { E.fused(acc, cur, wr, wc, fr, fq, lds, wid, lane); S.done(cur); }
#undef PG8_SA
#undef PG8_SB
#undef PG8_STAGE
#undef PG8_LDA
#undef PG8_LDB
#undef PG8_MMA
#undef PG8_WAIT_V
#undef PG8_WAIT_L
#undef PG8_BAR
#undef PG8_SCHED
}
}


#ifndef MK_N_LAUNCHES
#define MK_N_LAUNCHES 1
#endif
constexpr int N_PHASES = 9;
constexpr int NWAVES = 8;

constexpr int DM = 2048, BATCH = 4, SEQ = 4096, NTOK = BATCH * SEQ, NMETA = 16;
constexpr int MPAD = 16640, NTILE_X = MPAD / 256;
constexpr int N_QK = 3328, NT_QK = N_QK / 256;
constexpr int N_V = 1280, NT_V = N_V / 256;
constexpr int NT_W = NT_QK + NT_V;
constexpr int P1_UNITS_A = NTILE_X * NT_QK, P1_UNITS = P1_UNITS_A + NT_V * NTILE_X;
constexpr int NEXP = 64, DEXP = 512, MAXTILES = 192, SPAD = MAXTILES * 256;
constexpr float RMS_EPS = 1e-6f;
constexpr float LOG2E = 1.4426950408889634f;
constexpr float C2 = 0.125f * LOG2E;
constexpr float SB_EXIT = -60.0f;

constexpr size_t MiB = 1u << 20;
constexpr size_t WS_CTL = 0, CTL_ZERO_BYTES = 128 * 1024;
constexpr size_t WS_BIG = 1 * MiB;
constexpr size_t WS_QS = 84 * MiB, WS_KS = WS_QS + (size_t)MPAD * 1024 * 2, WS_QW = WS_KS + (size_t)MPAD * 1024 * 2, WS_KW = WS_QW + (size_t)MPAD * 1024 * 2;
constexpr size_t WS_VT = 190 * MiB;
constexpr size_t WS_MIXED = 231 * MiB, WS_HB = 295 * MiB;
constexpr size_t WS_Y = 1 * MiB;
constexpr size_t WS_PROJ = 359 * MiB;
constexpr size_t WS_HDN = 423 * MiB;
constexpr size_t WS_WOUT = 471 * MiB, WS_WR = 479 * MiB;
constexpr size_t WS_WGU = 480 * MiB, WS_WD = 736 * MiB;
constexpr size_t WS_LIST = 864 * MiB, WS_GATEW = 868 * MiB, WS_TOKINFO = 872 * MiB, WS_RSTD = 873 * MiB, WS_RSTDW = 874 * MiB;
constexpr size_t WS_RINV = 877 * MiB;
constexpr size_t WS_SSQ = 878 * MiB;
constexpr size_t WS_END = 880 * MiB;
static_assert(WS_RSTDW + (size_t)NEXP * NTOK * 4 <= WS_END, "ws map 4");
static_assert(WS_KW + (size_t)MPAD * 256 * 2 <= WS_VT && WS_VT + (size_t)N_V * MPAD * 2 <= WS_MIXED , "ws map 1");
static_assert(WS_Y + (size_t)SPAD * 2048 * 2 <= WS_MIXED && WS_HDN + (size_t)SPAD * 512 * 2 <= WS_WOUT && WS_HB + (size_t)NTOK * 2048 * 2 <= WS_HDN, "ws map 2");
static_assert(WS_BIG + (size_t)(NTILE_X + NT_W) * 256 * 2048 * 2 <= WS_QS, "ws map 3");
constexpr int CW_TMO = 0, CW_BAR = 4096, CW_CNT = 16384;

constexpr int RING_OFF = 0, RING_BYTES = 131072;
constexpr int MISC_OFF = RING_BYTES;
constexpr int TBL_OFF = MISC_OFF + 256;
constexpr int TBL_TSTART = 0, TBL_NT = 65, TBL_TE = 66, TBL_CNTS = 66 + MAXTILES, TBL_WORDS = 66 + MAXTILES + 64;
constexpr int TOKBUF_OFF = MISC_OFF + 4096;
constexpr int ATT_TBR_OFF = TOKBUF_OFF + 6144;
constexpr int LDS_BYTES = 163840;
static_assert(TBL_OFF + TBL_WORDS * 4 <= TOKBUF_OFF && TOKBUF_OFF + 6144 <= LDS_BYTES && ATT_TBR_OFF + 16 * 192 * 4 <= LDS_BYTES, "LDS map");

#define LAS __attribute__((address_space(3)))
typedef unsigned short bf16;
typedef unsigned v4u __attribute__((ext_vector_type(4)));
typedef unsigned v2u __attribute__((ext_vector_type(2)));
typedef float f32x4 __attribute__((ext_vector_type(4)));
typedef float f32x16 __attribute__((ext_vector_type(16)));
typedef short bf16x8 __attribute__((ext_vector_type(8)));
typedef _Float16 f16x8 __attribute__((ext_vector_type(8)));
typedef _Float16 f16x2 __attribute__((ext_vector_type(2)));
typedef float f32x2 __attribute__((ext_vector_type(2)));
typedef __bf16 bf16x2_t __attribute__((ext_vector_type(2)));
#define LDS_WAIT() asm volatile("s_waitcnt lgkmcnt(0)" ::: "memory")
#define VM_WAIT() asm volatile("s_waitcnt vmcnt(0)" ::: "memory")
__device__ __forceinline__ unsigned pk2(float lo, float hi) { f32x2 v = {lo, hi}; bf16x2_t b = __builtin_convertvector(v, bf16x2_t); return __builtin_bit_cast(unsigned, b); }
__device__ __forceinline__ float bf_lo(unsigned u) { return __uint_as_float(u << 16); }
__device__ __forceinline__ float bf_hi(unsigned u) { return __uint_as_float(u & 0xffff0000u); }
__device__ __forceinline__ float wave_sum(float v) {
#pragma unroll
    for (int o = 1; o < 64; o <<= 1) v += __shfl_xor(v, o);
    return v;
}
__device__ __forceinline__ int crow(int reg, int h) { return (reg & 3) + 8 * (reg >> 2) + 4 * h; }

#define XB_TMO      128
#define XB_XCNT(j)  (256  + 64 * (j))
#define XB_XSUB(j)  (1280 + 64 * (j))
#define XB_XGEN(j)  (2304 + 64 * (j))
#define XB_TOP      3328
#define XB_TOPGEN   3392
#define XCD_BAR_WORDS 3456
#define XB_SPIN_CAP (1u << 18)

__device__ __forceinline__ unsigned xb_ld(unsigned* p)              { return __hip_atomic_load(p, __ATOMIC_RELAXED, __HIP_MEMORY_SCOPE_AGENT); }
__device__ __forceinline__ unsigned xb_add(unsigned* p, unsigned v) { return __hip_atomic_fetch_add(p, v, __ATOMIC_RELAXED, __HIP_MEMORY_SCOPE_AGENT); }
__device__ __forceinline__ unsigned xb_xcc_id() { return (unsigned)__builtin_amdgcn_s_getreg((3 << 11) | 20) & 0xFu; }
#define XB_SPIN(cond, bar) do { unsigned _sp = 0; while (cond) { __builtin_amdgcn_s_sleep(1); \
    if ((++_sp & 255u) == 0u) { if (xb_ld(&(bar)[XB_TMO])) break; if (_sp > XB_SPIN_CAP) { atomicAdd(&(bar)[XB_TMO], 1u); break; } } } } while (0)

struct XcdBarrier {
    unsigned* bar; unsigned x;
    volatile LAS unsigned* st;
};

__device__ __forceinline__ XcdBarrier xcd_barrier_post(unsigned* bar, volatile LAS unsigned* st) {
    XcdBarrier b; b.bar = bar; b.x = xb_xcc_id(); b.st = st;
    if (threadIdx.x == 0) (void)xb_add(&bar[XB_XCNT(b.x)], 1u);
    return b;
}
__device__ __forceinline__ void xcd_barrier_complete(unsigned* bar, unsigned x, unsigned& nloc, unsigned& nx) {
    const unsigned G = gridDim.x * gridDim.y * gridDim.z;
    unsigned sum, cnt, mine, sp = 0u;
    for (;;) {
        sum = 0u; cnt = 0u; mine = 0u;
#pragma unroll
        for (unsigned j = 0; j < 16; ++j) { const unsigned c = xb_ld(&bar[XB_XCNT(j)]); sum += c; cnt += (c > 0u) ? 1u : 0u; mine = (j == x) ? c : mine; }
        if (sum == G) break;
        __builtin_amdgcn_s_sleep(1);
        if ((++sp & 255u) == 0u) { if (xb_ld(&bar[XB_TMO])) break; if (sp > XB_SPIN_CAP) { atomicAdd(&bar[XB_TMO], 1u); break; } }
    }
    nloc = mine > 0u ? mine : 1u; nx = cnt > 0u ? cnt : 1u;
}

__device__ __forceinline__ void xcd_barrier(const XcdBarrier& b) {
    asm volatile("s_waitcnt vmcnt(0)" ::: "memory");
    __syncthreads();
    if (threadIdx.x == 0) {
        unsigned* bar = b.bar;
        __builtin_amdgcn_s_waitcnt(0);
        unsigned nloc = b.st[0], nx = b.st[1];
        if (nloc == 0u) { xcd_barrier_complete(bar, b.x, nloc, nx); b.st[0] = nloc; b.st[1] = nx; }
        const unsigned old = xb_add(&bar[XB_XSUB(b.x)], 1u);
        const unsigned gen = old / nloc;
        if (old + 1u == (gen + 1u) * nloc) {
            __builtin_amdgcn_fence(__ATOMIC_RELEASE, "agent");
            asm volatile("s_waitcnt vmcnt(0)" ::: "memory");
            const unsigned og = xb_add(&bar[XB_TOP], 1u);
            const unsigned tg = og / nx;
            if (og + 1u == (tg + 1u) * nx) xb_add(&bar[XB_TOPGEN], 1u);
            else XB_SPIN(xb_ld(&bar[XB_TOPGEN]) == tg, bar);
            __builtin_amdgcn_fence(__ATOMIC_ACQUIRE, "agent");
            xb_add(&bar[XB_XGEN(b.x)], 1u);
            asm volatile("s_waitcnt vmcnt(0)" ::: "memory");
        } else {
            XB_SPIN(xb_ld(&bar[XB_XGEN(b.x)]) == gen, bar);
            __builtin_amdgcn_fence(__ATOMIC_ACQUIRE, "agent");
            asm volatile("s_waitcnt vmcnt(0)" ::: "memory");
        }
    }
    __syncthreads();
}


struct Args { const float* in[19]; float* out; unsigned char* ws; int ph_lo, ph_hi, li, pad; };
struct Frame {
    LAS unsigned char* lds; unsigned* ctl; unsigned char* ws;
    int tid, lane, wave, vcu, G;
    const float* const* in; float* out;
};

struct TrItem { f32x4 v[16]; f32x4 g[4]; };
__device__ __forceinline__ void tr_load(TrItem& t, const float* srcp, int ldsrc, const float* gp) {
#pragma unroll
    for (int i = 0; i < 16; ++i) t.v[i] = __builtin_nontemporal_load((const f32x4*)(srcp + (size_t)i * ldsrc));
    if (gp) {
#pragma unroll
        for (int i = 0; i < 4; ++i) t.g[i] = *(const f32x4*)(gp + 4 * i);
    } else {
#pragma unroll
        for (int i = 0; i < 4; ++i) t.g[i] = (f32x4){1.f, 1.f, 1.f, 1.f};
    }
}
__device__ __forceinline__ void tr_store(const TrItem& t, bf16* dstp, int ldd) {
#pragma unroll
    for (int j = 0; j < 4; ++j)
#pragma unroll
        for (int c = 0; c < 2; ++c) {
            v4u o;
            o.x = pk2(t.v[8 * c + 0][j] * t.g[2 * c][0], t.v[8 * c + 1][j] * t.g[2 * c][1]); o.y = pk2(t.v[8 * c + 2][j] * t.g[2 * c][2], t.v[8 * c + 3][j] * t.g[2 * c][3]);
            o.z = pk2(t.v[8 * c + 4][j] * t.g[2 * c + 1][0], t.v[8 * c + 5][j] * t.g[2 * c + 1][1]); o.w = pk2(t.v[8 * c + 6][j] * t.g[2 * c + 1][2], t.v[8 * c + 7][j] * t.g[2 * c + 1][3]);
            *(v4u*)(dstp + (size_t)j * ldd + 8 * c) = o;
        }
}
__device__ __forceinline__ int win_src_col(int P) {
    if (P < 2048) return P;
    if (P < 3328) { const int p = P - 2048, t = p >> 8, pp = p & 255, bj = pp >> 7, wc = (pp & 127) >> 5, i = pp & 31; return (t < 4 ? 3072 + t * 256 : 4096) + 64 * wc + 32 * bj + i; }
    if (P < 4352) return 2048 + (P - 3328);
    return P;
}
__device__ __forceinline__ float rms_row_to_bf16(const float* xrow, bf16* orow, int lane) {
    const f32x4* xr = (const f32x4*)xrow + lane;
    f32x4 v[8]; float s = 0.f;
#pragma unroll
    for (int j = 0; j < 8; ++j) { v[j] = __builtin_nontemporal_load(xr + 64 * j); s += (v[j].x * v[j].x + v[j].y * v[j].y) + (v[j].z * v[j].z + v[j].w * v[j].w); }
    const float rinv = sqrtf(wave_sum(s) * (1.f / DM) + RMS_EPS), rstd = 1.0f / rinv;
    v2u* o8 = (v2u*)orow + lane;
#pragma unroll
    for (int j = 0; j < 8; ++j) { v2u w; w.x = pk2(v[j].x * rstd, v[j].y * rstd); w.y = pk2(v[j].z * rstd, v[j].w * rstd); o8[64 * j] = w; }
    return rinv;
}
constexpr int I_IN = 32 * 72, I_OUT = 32 * 32, I_GU = NEXP * 32 * 16, I_D = NEXP * 8 * 32;
constexpr int NITEMS = I_IN + I_OUT + I_GU + I_D;
#ifndef TAIL1_PW
#define TAIL1_PW 64
#endif
#ifndef TAIL6_PW
#define TAIL6_PW 48
#endif
#ifndef W_LO
#define W_LO 1
#endif
#ifndef P1_EXTRA
#define P1_EXTRA 1
#endif
#ifndef TAIL6_N
#define TAIL6_N 11264
#endif
constexpr int TAIL1_PER_WAVE = TAIL1_PW, TAIL6_PER_WAVE = TAIL6_PW, TAIL6_ITEMS = TAIL6_N;
#ifndef ATT_WAVES_DEF
#define ATT_WAVES_DEF 4
#endif
constexpr int ATT_WAVES = ATT_WAVES_DEF;
__device__ __forceinline__ void conv_range(Frame& F, int it0, int step, int end) {
    bf16* WIN = (bf16*)(F.ws + WS_BIG) + (size_t)MPAD * DM;
    const float* ln_mix = F.in[3]; const float* w_in = F.in[4];
    const float* on_sb = F.in[8]; const float* on_sw = F.in[9]; const float* w_out = F.in[10]; const float* ln_ffn = F.in[11];
    const float* w_gate = F.in[16]; const float* w_up = F.in[17]; const float* w_down = F.in[18];
    bf16* WOUT = (bf16*)(F.ws + WS_WOUT); bf16* WGU = (bf16*)(F.ws + WS_WGU); bf16* WD = (bf16*)(F.ws + WS_WD);
    const int kr = F.lane >> 4, nq = F.lane & 15;
#define P0_ITEM(it, SRCP, LDS_, GP, DSTP, LDD) do { int r_ = (it); \
        if (r_ < I_IN) { const int kb = r_ / 72, nb = r_ % 72, k0 = 64 * kb + 16 * kr; SRCP = w_in + (size_t)k0 * 4608 + win_src_col(64 * nb + 4 * nq); LDS_ = 4608; GP = ln_mix + k0; DSTP = WIN + (size_t)(64 * nb + 4 * nq) * DM + k0; LDD = DM; } \
        else if ((r_ -= I_IN) < I_OUT) { const int kb = r_ >> 5, nb = r_ & 31, k0 = 64 * kb + 16 * kr; SRCP = w_out + (size_t)k0 * DM + 64 * nb + 4 * nq; LDS_ = DM; GP = (k0 < 1024 ? on_sb + k0 : on_sw + (k0 - 1024)); DSTP = WOUT + (size_t)(64 * nb + 4 * nq) * DM + k0; LDD = DM; } \
        else if ((r_ -= I_OUT) < I_GU) { const int e = r_ >> 9, q = r_ & 511, kb = q >> 4, nb = q & 15, k0 = 64 * kb + 16 * kr, nt = nb >> 2, bj = (nb >> 1) & 1, j0 = (nb & 1) * 64; \
            SRCP = (bj ? w_up : w_gate) + (size_t)e * DM * DEXP + (size_t)k0 * DEXP + nt * 128 + j0 + 4 * nq; LDS_ = DEXP; GP = ln_ffn + k0; DSTP = WGU + ((size_t)e * 1024 + 64 * nb + 4 * nq) * DM + k0; LDD = DM; } \
        else { r_ -= I_GU; const int e = r_ >> 8, q = r_ & 255, kb = q >> 5, nb = q & 31, k0 = 64 * kb + 16 * kr; \
            SRCP = w_down + (size_t)e * DEXP * DM + (size_t)k0 * DM + 64 * nb + 4 * nq; LDS_ = DM; GP = nullptr; DSTP = WD + ((size_t)e * 2048 + 64 * nb + 4 * nq) * DEXP + k0; LDD = DEXP; } } while (0)
    {
        TrItem cur; const float* sp; const float* gp; bf16* dp; int lds_, ldd; bf16* dpn; int lddn;
        int it = it0;
        if (it < end) { P0_ITEM(it, sp, lds_, gp, dp, ldd); tr_load(cur, sp, lds_, gp); }
        while (it < end) {
            const int itn = it + step; TrItem nxt;
            if (itn < end) { P0_ITEM(itn, sp, lds_, gp, dpn, lddn); tr_load(nxt, sp, lds_, gp); }
            tr_store(cur, dp, ldd);
            if (itn < end) { cur = nxt; dp = dpn; ldd = lddn; }
            it = itn;
        }
    }
#undef P0_ITEM
}
__device__ __forceinline__ void conv_range3(Frame& F, int it0, int step, int end) {
    bf16* WIN = (bf16*)(F.ws + WS_BIG) + (size_t)MPAD * DM;
    const float* ln_mix = F.in[3]; const float* w_in = F.in[4];
    const float* on_sb = F.in[8]; const float* on_sw = F.in[9]; const float* w_out = F.in[10]; const float* ln_ffn = F.in[11];
    const float* w_gate = F.in[16]; const float* w_up = F.in[17]; const float* w_down = F.in[18];
    bf16* WOUT = (bf16*)(F.ws + WS_WOUT); bf16* WGU = (bf16*)(F.ws + WS_WGU); bf16* WD = (bf16*)(F.ws + WS_WD);
    const int kr = F.lane >> 3, nq = F.lane & 7;
#define P0_ITEM(it, SRCP, LDS_, GP, DSTP, LDD) do { int r_ = (it); \
        if (r_ < I_IN) { const int kb = r_ / 72, nb = r_ % 72, k0 = 64 * kb + 8 * kr; SRCP = w_in + (size_t)k0 * 4608 + win_src_col(64 * nb + 4 * nq); LDS_ = 4608; GP = ln_mix + k0; DSTP = WIN + (size_t)(64 * nb + 4 * nq) * DM + k0; LDD = DM; } \
        else if ((r_ -= I_IN) < I_OUT) { const int kb = r_ >> 5, nb = r_ & 31, k0 = 64 * kb + 8 * kr; SRCP = w_out + (size_t)k0 * DM + 64 * nb + 4 * nq; LDS_ = DM; GP = (k0 < 1024 ? on_sb + k0 : on_sw + (k0 - 1024)); DSTP = WOUT + (size_t)(64 * nb + 4 * nq) * DM + k0; LDD = DM; } \
        else if ((r_ -= I_OUT) < I_GU) { const int e = r_ >> 9, q = r_ & 511, kb = q >> 4, nb = q & 15, k0 = 64 * kb + 8 * kr, nt = nb >> 2, bj = (nb >> 1) & 1, j0 = (nb & 1) * 64; \
            SRCP = (bj ? w_up : w_gate) + (size_t)e * DM * DEXP + (size_t)k0 * DEXP + nt * 128 + j0 + 4 * nq; LDS_ = DEXP; GP = ln_ffn + k0; DSTP = WGU + ((size_t)e * 1024 + 64 * nb + 4 * nq) * DM + k0; LDD = DM; } \
        else { r_ -= I_GU; const int e = r_ >> 8, q = r_ & 255, kb = q >> 5, nb = q & 31, k0 = 64 * kb + 8 * kr; \
            SRCP = w_down + (size_t)e * DEXP * DM + (size_t)k0 * DM + 64 * nb + 4 * nq; LDS_ = DM; GP = nullptr; DSTP = WD + ((size_t)e * 2048 + 64 * nb + 4 * nq) * DEXP + k0; LDD = DEXP; } } while (0)
    struct V16 { f32x4 v[16]; };
#define C3_LOAD(B, it) do { if ((it) < end) { const float* sp_; const float* gp_; bf16* dp_; int ls_, ld_; P0_ITEM((it), sp_, ls_, gp_, dp_, ld_); (void)gp_; (void)dp_; (void)ld_; \
        _Pragma("unroll") for (int i_ = 0; i_ < 16; ++i_) B.v[i_] = __builtin_nontemporal_load((const f32x4*)(sp_ + (size_t)(i_ & 7) * ls_ + 32 * (i_ >> 3))); } } while (0)
#define C3_GAIN(G, it) do { if ((it) < end) { const float* sp_; const float* gp_; bf16* dp_; int ls_, ld_; P0_ITEM((it), sp_, ls_, gp_, dp_, ld_); (void)sp_; (void)ls_; (void)dp_; (void)ld_; \
        G[0] = gp_ ? *(const f32x4*)gp_ : (f32x4){1.f, 1.f, 1.f, 1.f}; G[1] = gp_ ? *(const f32x4*)(gp_ + 4) : (f32x4){1.f, 1.f, 1.f, 1.f}; } } while (0)
#define C3_STORE(B, G, it) do { if ((it) < end) { const float* sp_; const float* gp_; bf16* dp_; int ls_, ld_; P0_ITEM((it), sp_, ls_, gp_, dp_, ld_); (void)sp_; (void)ls_; (void)gp_; \
        _Pragma("unroll") for (int h_ = 0; h_ < 2; ++h_) _Pragma("unroll") for (int j_ = 0; j_ < 4; ++j_) { v4u o_; \
            o_.x = pk2(B.v[8 * h_ + 0][j_] * G[0][0], B.v[8 * h_ + 1][j_] * G[0][1]); o_.y = pk2(B.v[8 * h_ + 2][j_] * G[0][2], B.v[8 * h_ + 3][j_] * G[0][3]); \
            o_.z = pk2(B.v[8 * h_ + 4][j_] * G[1][0], B.v[8 * h_ + 5][j_] * G[1][1]); o_.w = pk2(B.v[8 * h_ + 6][j_] * G[1][2], B.v[8 * h_ + 7][j_] * G[1][3]); \
            __builtin_nontemporal_store(o_, (v4u*)(dp_ + (size_t)(32 * h_ + j_) * ld_)); } } } while (0)
    {
        V16 A, B, C; f32x4 gA[2], gB[2], gC[2]; int it = it0;
        C3_LOAD(A, it); C3_LOAD(B, it + step);
        while (it < end) {
            C3_GAIN(gA, it); C3_LOAD(C, it + 2 * step); C3_STORE(A, gA, it);
            C3_GAIN(gB, it + step); C3_LOAD(A, it + 3 * step); C3_STORE(B, gB, it + step);
            C3_GAIN(gC, it + 2 * step); C3_LOAD(B, it + 4 * step); C3_STORE(C, gC, it + 2 * step);
            it += 3 * step;
        }
    }
#undef C3_LOAD
#undef C3_GAIN
#undef C3_STORE
#undef P0_ITEM
}
struct CuSplit { int Gg, cg, nconv, cc; bool conv; };
__device__ __forceinline__ CuSplit split_cus(int G, int vcu, int units, int extra = 0) {
    CuSplit s; const int rounds = (units + G - 1) / G + extra; s.Gg = (rounds > 0) ? (units + rounds - 1) / rounds : G; s.nconv = G - s.Gg;
    if (G % 8 == 0) { const int xs = G / 8, x = vcu / xs, l = vcu % xs, q = s.nconv / 8, rm = s.nconv % 8;
        const int nx = q + (x < rm ? 1 : 0), before = x * q + (x < rm ? x : rm);
        s.conv = l >= xs - nx; s.cg = vcu - before; s.cc = before + (l - (xs - nx)); }
    else { s.conv = vcu >= s.Gg; s.cg = vcu; s.cc = vcu - s.Gg; }
    return s;
}
__device__ __forceinline__ int tail1_items(int G) { const int rounds = (P1_UNITS + G - 1) / G + P1_EXTRA, nconv = G - (P1_UNITS + rounds - 1) / rounds; const int n = nconv * NWAVES * TAIL1_PER_WAVE, cap = NITEMS - TAIL6_ITEMS - I_IN - I_OUT; return n < cap ? n : cap; }
__device__ __forceinline__ void p0_prologue(Frame& F) {
    const int gw = F.vcu * NWAVES + F.wave, NGW = F.G * NWAVES;
    if (blockIdx.x == 0 && F.tid < NEXP) __hip_atomic_store(F.ctl + CW_CNT + F.tid, 0u, __ATOMIC_RELAXED, __HIP_MEMORY_SCOPE_AGENT);
    bf16* BIG = (bf16*)(F.ws + WS_BIG);
    bf16* WIN = BIG + (size_t)MPAD * DM;
    const float* x = F.in[0]; const float* meta = F.in[1]; const float* ln_mix = F.in[3]; const float* w_in = F.in[4];
    const float* on_sb = F.in[8]; const float* on_sw = F.in[9]; const float* w_out = F.in[10]; const float* ln_ffn = F.in[11];
    const float* w_rg = F.in[12]; const float* w_re = F.in[14]; const float* w_gate = F.in[16]; const float* w_up = F.in[17]; const float* w_down = F.in[18];
    for (int m = gw; m < MPAD; m += NGW) {
        bf16* orow = BIG + (size_t)m * DM;
        if (m < NTOK) { const float ri = rms_row_to_bf16(x + (size_t)m * DM, orow, F.lane); if (F.lane == 0) ((float*)(F.ws + WS_RINV))[m] = ri; }
        else if (m < NTOK + NMETA) (void)rms_row_to_bf16(meta + (size_t)(m - NTOK) * DM, orow, F.lane);
        else { v4u z = {0u, 0u, 0u, 0u}; v4u* o = (v4u*)orow + F.lane;
#pragma unroll
            for (int j = 0; j < 4; ++j) o[64 * j] = z; }
    }
    conv_range(F, gw, NGW, I_IN + I_OUT);
    bf16* WRH = (bf16*)(F.ws + WS_WR); bf16* WRL = WRH + 96 * DM;
    for (int idx = (F.vcu * NWAVES * 64 + F.tid); idx < 96 * DM; idx += F.G * NWAVES * 64) {
        const int c = idx / DM, k = idx % DM;
        float v = 0.f; if (c < 8) v = w_rg[k * 8 + c]; else if (c < 72) v = w_re[k * 64 + (c - 8)];
        v *= ln_ffn[k];
        const unsigned hi = pk2(v, 0.f) & 0xffffu; const float lo = v - __uint_as_float(hi << 16);
        const int fidx = ((((k >> 4) * 3 + (c >> 5)) * 64 + (((k >> 3) & 1) * 32 + (c & 31))) << 3) + (k & 7);
        WRH[fidx] = (bf16)hi; WRL[fidx] = (bf16)(pk2(lo, 0.f) & 0xffffu);
    }
}

struct P1Order {
    int G, c;
    __device__ bool next(int i, pg8::Unit& u) const {
        const int L = i * G + c; if (L >= P1_UNITS) return false;
        if (L < P1_UNITS_A) { u.pm = L / NT_QK; u.pn = NTILE_X + (L % NT_QK); }
        else { const int l = L - P1_UNITS_A; u.pm = NTILE_X + NT_QK + l / NTILE_X; u.pn = l % NTILE_X; }
        return true;
    }
    __device__ __forceinline__ void a_ready(const pg8::Unit&) const {}
    __device__ __forceinline__ void done(const pg8::Unit&) const {}
};
struct EpiQKV {
    static constexpr bool PERM = true, AFTER_DRAIN = false, MIDK = false;
    bf16 *QS, *KS, *QW, *KW, *VT; const float *q_norm, *k_norm;
    __device__ __forceinline__ void operator()(const pg8::f32x4 (&acc)[2][2][4][2], const pg8::Unit& u, int wr, int wc, int fr, int fq) const {
        using pg8::HALF;
        if (u.pm < NTILE_X) {
            const int t = u.pn - NTILE_X; const int row0 = u.pm * 256 + wr * 64 + fr;
            if (t < 8) {
                bf16* base = (t < 4) ? QS : KS; const float sc = (t < 4) ? C2 : 1.0f; const int col0 = (t & 3) * 256 + wc * 32 + 8 * fq;
#pragma unroll
                for (int ai = 0; ai < 2; ++ai)
#pragma unroll
                    for (int m = 0; m < 4; ++m) { bf16* rowp = base + (size_t)(row0 + ai * HALF + m * 16) * 1024 + col0;
#pragma unroll
                        for (int bj = 0; bj < 2; ++bj) { const pg8::f32x4 v0 = acc[ai][bj][m][0] * sc, v1 = acc[ai][bj][m][1] * sc;
                            v4u w; w.x = pk2(v0[0], v0[1]); w.y = pk2(v0[2], v0[3]); w.z = pk2(v1[0], v1[1]); w.w = pk2(v1[2], v1[3]); *(v4u*)(rowp + bj * HALF) = w; } }
            } else {
                const bool isq = t < 12; const float* gain = isq ? q_norm : k_norm; const float sc = isq ? C2 : 1.0f;
                bf16* base = isq ? (QW + (t - 8) * 256 + wc * 64) : (KW + wc * 64); const int ld = isq ? 1024 : 256;
                pg8::f32x4 g[2][2];
#pragma unroll
                for (int bj = 0; bj < 2; ++bj)
#pragma unroll
                    for (int n = 0; n < 2; ++n) g[bj][n] = *(const pg8::f32x4*)(gain + 32 * bj + 8 * fq + 4 * n) * sc;
#pragma unroll
                for (int ai = 0; ai < 2; ++ai)
#pragma unroll
                    for (int m = 0; m < 4; ++m) {
                        float ss = 0.f;
#pragma unroll
                        for (int bj = 0; bj < 2; ++bj)
#pragma unroll
                            for (int n = 0; n < 2; ++n) { const pg8::f32x4 v = acc[ai][bj][m][n]; ss += (v[0] * v[0] + v[1] * v[1]) + (v[2] * v[2] + v[3] * v[3]); }
                        ss += __shfl_xor(ss, 16); ss += __shfl_xor(ss, 32);
                        const float rstd = 1.0f / sqrtf(ss * (1.0f / 64.0f) + RMS_EPS);
                        bf16* rowp = base + (size_t)(row0 + ai * HALF + m * 16) * ld + 8 * fq;
#pragma unroll
                        for (int bj = 0; bj < 2; ++bj) { const pg8::f32x4 v0 = acc[ai][bj][m][0] * rstd * g[bj][0], v1 = acc[ai][bj][m][1] * rstd * g[bj][1];
                            v4u w; w.x = pk2(v0[0], v0[1]); w.y = pk2(v0[2], v0[3]); w.z = pk2(v1[0], v1[1]); w.w = pk2(v1[2], v1[3]); *(v4u*)(rowp + 32 * bj) = w; } }
            }
        } else {
            const int vrow0 = (u.pm - NTILE_X - NT_QK) * 256 + wr * 64 + fr;
#pragma unroll
            for (int ai = 0; ai < 2; ++ai)
#pragma unroll
                for (int m = 0; m < 4; ++m) { const int vrow = vrow0 + ai * HALF + m * 16;
                    bf16* rowp = VT + ((size_t)(vrow >> 6) * (MPAD / 32) * 64 + (vrow & 63)) * 32 + 16 * (fq >> 1) + 4 * (fq & 1);
#pragma unroll
                    for (int bj = 0; bj < 2; ++bj)
#pragma unroll
                        for (int n = 0; n < 2; ++n) { const pg8::f32x4 v = acc[ai][bj][m][n]; v2u w; w.x = pk2(v[0], v[1]); w.y = pk2(v[2], v[3]);
                            *(v2u*)(rowp + (size_t)(u.pn * 8 + bj * 4 + wc) * 2048 + 8 * n) = w; } }
        }
    }
};

namespace att {
__device__ __forceinline__ f32x16 mfma_bf(bf16x8 a, bf16x8 b, f32x16 c) { return __builtin_amdgcn_mfma_f32_32x32x16_bf16(a, b, c, 0, 0, 0); }
__device__ __forceinline__ f32x16 mfma_h(f16x8 a, f16x8 b, f32x16 c) { return __builtin_amdgcn_mfma_f32_32x32x16_f16(a, b, c, 0, 0, 0); }
__device__ __forceinline__ bf16x8 ld8(const bf16* p) { return *(const bf16x8*)p; }
__device__ __forceinline__ bf16x8 pack8(const float* w) { v4u o; o.x = pk2(w[0], w[1]); o.y = pk2(w[2], w[3]); o.z = pk2(w[4], w[5]); o.w = pk2(w[6], w[7]); return __builtin_bit_cast(bf16x8, o); }

struct KT { bf16x8 k[4]; bf16x8 v[4]; };
__device__ __forceinline__ void glds16(const void* gsrc, unsigned lds_dst) { unsigned keep;
    asm volatile("s_mov_b32 %0, m0\n\ts_mov_b32 m0, %2\n\ts_nop 0\n\tglobal_load_lds_dwordx4 %1, off\n\ts_mov_b32 m0, %0" : "=&s"(keep) : "v"(gsrc), "s"(lds_dst) : "memory"); }
__device__ __forceinline__ void glds16s(const void* sbase, unsigned voff, unsigned lds_dst) { unsigned keep;
    asm volatile("s_mov_b32 %0, m0\n\ts_mov_b32 m0, %3\n\ts_nop 0\n\tglobal_load_lds_dwordx4 %1, %2\n\ts_mov_b32 m0, %0" : "=&s"(keep) : "v"(voff), "s"(sbase), "s"(lds_dst) : "memory"); }
__device__ __forceinline__ void dma_tile(unsigned slot, const bf16* Kb, int ldk, const bf16* Vt, int b, int j, unsigned koff, unsigned voff, unsigned voffm) {
    const size_t row0 = (j >= 0) ? (size_t)(b * SEQ + 32 * j) : (size_t)NTOK;
#pragma unroll
    for (int i = 0; i < 4; ++i) { const int rb = (j >= 0) ? 8 * i : 8 * (i & 1);
        glds16s(Kb + (row0 + rb) * ldk, koff, (unsigned)__builtin_amdgcn_readfirstlane(slot + i * 1024)); }
    const bf16* vb = Vt + (row0 >> 5) * 2048;
#pragma unroll
    for (int i = 0; i < 4; ++i) glds16s(vb + 16 * i * 32, (j >= 0) ? voff : voffm, (unsigned)__builtin_amdgcn_readfirstlane(slot + 4096 + i * 1024));
}
__device__ __forceinline__ void lds_frags(KT& t, const LAS unsigned char* slot, int r, int h) {
#pragma unroll
    for (int s = 0; s < 4; ++s) { const int c = 2 * s + h; t.k[s] = *(const LAS bf16x8*)(slot + (r >> 3) * 1024 + ((r & 7) * 8 + (c ^ (r & 7))) * 16); }
#pragma unroll
    for (int dh = 0; dh < 2; ++dh)
#pragma unroll
        for (int s = 0; s < 2; ++s) { const int row = 32 * dh + r, c = 2 * s + h; t.v[dh * 2 + s] = *(const LAS bf16x8*)(slot + 4096 + row * 64 + (c ^ ((row >> 2) & 3)) * 16); }
}
#define ATT_WAITV(n) asm volatile("s_waitcnt vmcnt(" #n ")" ::: "memory")
__device__ __forceinline__ void glds16s_nt(const void* sbase, unsigned voff, unsigned lds_dst) { unsigned keep;
    asm volatile("s_mov_b32 %0, m0\n\ts_mov_b32 m0, %3\n\ts_nop 0\n\tglobal_load_lds_dwordx4 %1, %2 nt\n\ts_mov_b32 m0, %0" : "=&s"(keep) : "v"(voff), "s"(sbase), "s"(lds_dst) : "memory"); }
__device__ __forceinline__ void dma_q(unsigned slot, const bf16* Qh, size_t qrow0, unsigned qoff) {
#pragma unroll
    for (int i = 0; i < 4; ++i) glds16s_nt(Qh + (qrow0 + 8 * i) * 1024, qoff, (unsigned)__builtin_amdgcn_readfirstlane(slot + i * 1024));
}
__device__ __forceinline__ void lds_qfrags(bf16x8 (&q)[4], const LAS unsigned char* slot, int r, int h) {
#pragma unroll
    for (int s = 0; s < 4; ++s) { const int c = 2 * s + h; q[s] = *(const LAS bf16x8*)(slot + (r >> 3) * 1024 + ((r & 7) * 8 + (c ^ (r & 7))) * 16); }
}

struct SbState { f32x16 o0, o1; float R; };
template <int KIND>
__device__ __forceinline__ void sb_tile(SbState& S, const KT& t, const bf16x8 (&qf)[4], const f16x8& U0, const f16x8& U1, int r, int h) {
    f32x16 z = {0.f, 0.f, 0.f, 0.f, 0.f, 0.f, 0.f, 0.f, 0.f, 0.f, 0.f, 0.f, 0.f, 0.f, 0.f, 0.f};
#pragma unroll
    for (int s = 0; s < 4; ++s) z = mfma_bf(t.k[s], qf[s], z);
    f32x16 init; float L[16];
#pragma unroll
    for (int g = 0; g < 16; ++g) {
        const float zz = z[g];
        const float e = __builtin_amdgcn_exp2f(-__builtin_fabsf(zz));
        const float zp = __builtin_amdgcn_fmed3f(zz, 0.f, 3.0e38f);
        const float sp = zp + __builtin_amdgcn_logf(1.0f + e);
        float Lv = -sp;
        if (KIND == 1) Lv = (crow(g, h) < r) ? Lv : 0.f;
        if (KIND == 2) Lv = (crow(g, h) < 16) ? Lv : 0.f;
        L[g] = Lv; init[g] = zz + Lv + S.R;
    }
    f16x8 lb0, lb1;
#pragma unroll
    for (int j = 0; j < 8; ++j) { lb0[j] = (_Float16)L[j]; lb1[j] = (_Float16)L[8 + j]; }
    f32x16 lw = mfma_h(U0, lb0, init); lw = mfma_h(U1, lb1, lw);
    float Rn = lw[0] - z[0];
    Rn = __shfl(Rn, r);
    float w[16];
#pragma unroll
    for (int g = 0; g < 16; ++g) {
        float wv = __builtin_amdgcn_exp2f(lw[g]);
        if (KIND == 1) wv = (crow(g, h) < r) ? wv : 0.f;
        if (KIND == 2) wv = (crow(g, h) < 16) ? wv : 0.f;
        w[g] = wv;
    }
    const bf16x8 wb0 = pack8(w), wb1 = pack8(w + 8);
    S.o0 = mfma_bf(t.v[0], wb0, S.o0); S.o0 = mfma_bf(t.v[1], wb1, S.o0);
    S.o1 = mfma_bf(t.v[2], wb0, S.o1); S.o1 = mfma_bf(t.v[3], wb1, S.o1);
    S.R = Rn;
}

struct SwState { f32x16 o0, o1; float m, l; };
template <int KIND>
__device__ __forceinline__ void sw_tile(SwState& S, const KT& t, const bf16x8 (&qf)[4], const LAS float* tb, int r, int h) {
    f32x16 z = {0.f, 0.f, 0.f, 0.f, 0.f, 0.f, 0.f, 0.f, 0.f, 0.f, 0.f, 0.f, 0.f, 0.f, 0.f, 0.f};
#pragma unroll
    for (int s = 0; s < 4; ++s) z = mfma_bf(t.k[s], qf[s], z);
    float sc[16]; float mx = -1e30f;
#pragma unroll
    for (int g = 0; g < 16; ++g) {
        float v = z[g] + tb[(g & 3) + 8 * (g >> 2)];
        if (KIND == 1) v = (crow(g, h) <= r) ? v : -1e30f;
        if (KIND == 2) v = (crow(g, h) < 16) ? v : -1e30f;
        if (KIND == 3) v = (crow(g, h) > r) ? v : -1e30f;
        sc[g] = v; mx = __builtin_fmaxf(mx, v);
    }
    mx = __builtin_fmaxf(mx, __shfl_xor(mx, 32));
    const float mn = __builtin_fmaxf(S.m, mx);
    const float alpha = __builtin_amdgcn_exp2f(S.m - mn);
    S.l *= alpha; S.o0 *= alpha; S.o1 *= alpha;
    float p[16]; float ls = 0.f;
#pragma unroll
    for (int g = 0; g < 16; ++g) { p[g] = __builtin_amdgcn_exp2f(sc[g] - mn); ls += p[g]; }
    S.l += ls; S.m = mn;
    const bf16x8 wb0 = pack8(p), wb1 = pack8(p + 8);
    S.o0 = mfma_bf(t.v[0], wb0, S.o0); S.o0 = mfma_bf(t.v[1], wb1, S.o0);
    S.o1 = mfma_bf(t.v[2], wb0, S.o1); S.o1 = mfma_bf(t.v[3], wb1, S.o1);
}
__device__ __forceinline__ float store_o(LAS unsigned char* stg, const bf16* obase, const f32x16& o0, const f32x16& o1, float scale, unsigned wofs, unsigned rofs, unsigned gofs) {
    float ss = 0.f;
    LAS unsigned char* wp = stg + wofs;
#pragma unroll
    for (int q = 0; q < 4; ++q) {
        const float a0 = o0[4 * q] * scale, a1 = o0[4 * q + 1] * scale, a2 = o0[4 * q + 2] * scale, a3 = o0[4 * q + 3] * scale;
        const float b0 = o1[4 * q] * scale, b1 = o1[4 * q + 1] * scale, b2 = o1[4 * q + 2] * scale, b3 = o1[4 * q + 3] * scale;
        ss += ((a0 * a0 + a1 * a1) + (a2 * a2 + a3 * a3)) + ((b0 * b0 + b1 * b1) + (b2 * b2 + b3 * b3));
        v2u w; w.x = pk2(a0, a1); w.y = pk2(a2, a3); *(LAS v2u*)(wp + 16 * q) = w;
        v2u x; x.x = pk2(b0, b1); x.y = pk2(b2, b3); *(LAS v2u*)(wp + 64 + 16 * q) = x;
    }
    const LAS unsigned char* rp = stg + rofs;
#pragma unroll
    for (int k = 0; k < 4; ++k) { const v4u v = *(const LAS v4u*)(rp + k * (8 * 144)); const bf16* gb = obase + (size_t)(8 * k) * DM;
        *(v4u*)((char*)const_cast<bf16*>(gb) + gofs) = v; }
    return ss;
}
}

__device__ __forceinline__ void p2_attention(Frame& F) {
    using namespace att;
    const int lane = F.lane, r = lane & 31, h = lane >> 5, w = F.wave;
    const bf16* VT = (const bf16*)(F.ws + WS_VT); bf16* MIX = (bf16*)(F.ws + WS_MIXED); float* SSQ = (float*)(F.ws + WS_SSQ);
    LAS float* tbr = (LAS float*)(F.lds + ATT_TBR_OFF);
    const LAS unsigned char* area = F.lds + RING_OFF + w * 16384;
    const unsigned slot0 = (unsigned)(uintptr_t)area;
    static_assert(ATT_WAVES == 4, "the Q slots live in the upper half of the ring");
    const LAS unsigned char* qarea = F.lds + RING_OFF + 65536 + (w & 3) * 4096; const unsigned qslot0 = (unsigned)(uintptr_t)qarea;
    const unsigned qoff = (unsigned)(((lane >> 3) * 1024 + ((lane & 7) ^ ((lane >> 3) & 7)) * 8) * 2);
    const unsigned koffw = (unsigned)(((lane >> 3) * 256 + ((lane & 7) ^ ((lane >> 3) & 7)) * 8) * 2);
    const unsigned voff = (unsigned)(((lane >> 2) * 32 + ((lane & 3) ^ ((lane >> 4) & 3)) * 8) * 2), voffm = (unsigned)(((lane >> 2) * 32 + (((lane & 3) ^ ((lane >> 4) & 3)) & 1) * 8) * 2);
    const unsigned o_wofs = (unsigned)(r * 144 + 8 * h), o_rofs = (unsigned)((lane >> 3) * 144 + (lane & 7) * 16), o_gofs = (unsigned)(((lane >> 3) * DM + 8 * (lane & 7)) * 2);
    { const float* rel_bias = F.in[2];
      for (int idx = F.tid; idx < 16 * 192; idx += NWAVES * 64) {
        const int hq = idx / 192, x = idx % 192, d = 159 - x; float v = 0.f;
        if (d >= 0) { int bkt = d; if (d >= 16) { bkt = 16 + (int)(logf((float)d / 16.0f) / logf(8.0f) * 16.0f); bkt = bkt > 31 ? 31 : bkt; } v = rel_bias[bkt * 16 + hq] * LOG2E; }
        tbr[idx] = v;
      } }
    __syncthreads();
    if (w >= ATT_WAVES) {
        const int p2_end = NITEMS - TAIL6_ITEMS - tail1_items(F.G);
        conv_range3(F, I_IN + I_OUT + F.vcu * (NWAVES - ATT_WAVES) + (w - ATT_WAVES), F.G * (NWAVES - ATT_WAVES), p2_end);
        return;
    }
    __builtin_amdgcn_s_setprio(3);
    constexpr int NQG = 128 / ATT_WAVES, NUNIT = 16 * NQG;
    for (int unit = F.vcu; unit < NUNIT; unit += F.G) {
        const int b = unit / (4 * NQG), hg = unit & 3; int qa = (unit >> 2) % NQG; if (unit >= F.G) qa = NQG - 1 - qa;
        const int a = ATT_WAVES * qa + w;
        const size_t qrow = (size_t)b * SEQ + 32 * a + r;
#pragma unroll 1
        for (int bi = 0; bi < 2; ++bi) {
            const int branch = bi;
            if (branch == 0) {
            const bf16* KS = (const bf16*)(F.ws + WS_KS); const bf16* QS = (const bf16*)(F.ws + WS_QS);
            f16x8 U0, U1;
#pragma unroll
            for (int j = 0; j < 8; ++j) { const int c0 = 8 * (j >> 2) + 4 * h + (j & 3); U0[j] = (c0 > r) ? (_Float16)1.0f : (_Float16)0.0f; U1[j] = (16 + c0 > r) ? (_Float16)1.0f : (_Float16)0.0f; }
            float ssl = 0.f;
#pragma unroll 1
            for (int hh = 0; hh < 4; ++hh) {
                const int head = 4 * hg + hh;
                ATT_WAITV(0);
                const bf16* Kb = KS + head * 64;
                bf16x8 ql[4];
                dma_q(qslot0, QS + head * 64, (size_t)b * SEQ + 32 * a, qoff);
                SbState S; S.R = 0.f;
#pragma unroll
                for (int g = 0; g < 16; ++g) { S.o0[g] = 0.f; S.o1[g] = 0.f; }
                const bf16* Vt = VT + (size_t)(head * 64) * MPAD;
                unsigned sl_cur = slot0, sl_nxt = slot0 + 8192;
                int jt = a;
                dma_tile(sl_cur, Kb, 1024, Vt, b, jt, qoff, voff, voffm); dma_tile(sl_nxt, Kb, 1024, Vt, b, jt - 1, qoff, voff, voffm);
                ATT_WAITV(8);
                lds_qfrags(ql, qarea, r, h);
                KT T; lds_frags(T, area + (sl_cur - slot0), r, h);
                sb_tile<1>(S, T, ql, U0, U1, r, h);
                if (!__all(S.R < SB_EXIT)) {
                    --jt;
                    for (;;) {
                        { const unsigned t_ = sl_cur; sl_cur = sl_nxt; sl_nxt = t_; }
                        const bool has_next = jt >= 0;
                        if (has_next) { dma_tile(sl_nxt, Kb, 1024, Vt, b, jt - 1, qoff, voff, voffm); ATT_WAITV(8); } else ATT_WAITV(0);
                        lds_frags(T, area + (sl_cur - slot0), r, h);
                        if (jt >= 0) sb_tile<0>(S, T, ql, U0, U1, r, h); else sb_tile<2>(S, T, ql, U0, U1, r, h);
                        if (!has_next || __all(S.R < SB_EXIT)) break;
                        --jt;
                    }
                }
                ssl += store_o((LAS unsigned char*)area + (sl_cur - slot0), MIX + ((size_t)b * SEQ + 32 * a) * DM + head * 64, S.o0, S.o1, 1.0f, o_wofs, o_rofs, o_gofs);
            }
            ssl += __shfl_xor(ssl, 32);
            if (h == 0) SSQ[qrow * 16 + hg] = ssl;
        }
            else {
            const bf16* KW = (const bf16*)(F.ws + WS_KW); const bf16* QW = (const bf16*)(F.ws + WS_QW);
            float ssl = 0.f;
#pragma unroll 1
            for (int hh = 0; hh < 4; ++hh) {
                const int hq = 4 * hg + hh, kvh = hq >> 2;
                ATT_WAITV(0);
                const bf16* Kb = KW + kvh * 64;
                bf16x8 ql[4];
                dma_q(qslot0, QW + hq * 64, (size_t)b * SEQ + 32 * a, qoff);
                const float sink2 = F.in[7][hq] * LOG2E;
                SwState S; S.m = sink2; S.l = 0.f;
#pragma unroll
                for (int g = 0; g < 16; ++g) { S.o0[g] = 0.f; S.o1[g] = 0.f; }
                const LAS float* tbh = tbr + hq * 192 + 4 * h;
                const int jlo = (a >= 4) ? a - 4 : 0;
                const bf16* Vt = VT + (size_t)(1024 + kvh * 64) * MPAD;
                unsigned sl_cur = slot0, sl_nxt = slot0 + 8192;
                int jt = a;
#define SW_NEXT(j) (((j) > jlo) ? (j) - 1 : -1)
                dma_tile(sl_cur, Kb, 256, Vt, b, jt, koffw, voff, voffm); dma_tile(sl_nxt, Kb, 256, Vt, b, SW_NEXT(jt), koffw, voff, voffm);
                ATT_WAITV(8);
                lds_qfrags(ql, qarea, r, h);
                KT T; lds_frags(T, area + (sl_cur - slot0), r, h);
                sw_tile<1>(S, T, ql, tbh + (159 - r), r, h);
                jt = SW_NEXT(jt);
                for (;;) {
                    { const unsigned t_ = sl_cur; sl_cur = sl_nxt; sl_nxt = t_; }
                    if (jt >= 0) { dma_tile(sl_nxt, Kb, 256, Vt, b, SW_NEXT(jt), koffw, voff, voffm); ATT_WAITV(8); } else ATT_WAITV(0);
                    lds_frags(T, area + (sl_cur - slot0), r, h);
                    if (jt < 0) { const int dq = 32 * a + r + 16; sw_tile<2>(S, T, ql, tbh + (159 - (dq < 159 ? dq : 159)), r, h); break; }
                    const LAS float* tb = tbh + (159 - (32 * (a - jt) + r));
                    if (jt == a - 4) sw_tile<3>(S, T, ql, tb, r, h); else sw_tile<0>(S, T, ql, tb, r, h);
                    jt = SW_NEXT(jt);
                }
#undef SW_NEXT
                const float lt = S.l + __shfl_xor(S.l, 32) + __builtin_amdgcn_exp2f(sink2 - S.m);
                ssl += store_o((LAS unsigned char*)area + (sl_cur - slot0), MIX + ((size_t)b * SEQ + 32 * a) * DM + 1024 + hq * 64, S.o0, S.o1, 1.0f / lt, o_wofs, o_rofs, o_gofs);
            }
            ssl += __shfl_xor(ssl, 32);
            if (h == 0) SSQ[qrow * 16 + 8 + hg] = ssl;
        }
        }
    }
    ATT_WAITV(0);
    __builtin_amdgcn_s_setprio(0);
    if (ATT_WAVES == NWAVES) {
        const int p2_end = NITEMS - TAIL6_ITEMS - tail1_items(F.G);
        conv_range3(F, I_IN + I_OUT + F.vcu * NWAVES + w, F.G * NWAVES, p2_end);
    }
}

struct EpiRes {
    static constexpr bool PERM = true, AFTER_DRAIN = false, MIDK = true;
    bf16* P; const LAS float* RS; const bf16* XN; mutable int ui;
    __device__ __forceinline__ void midk(pg8::f32x4 (&acc)[2][2][4][2], const pg8::Unit& u, int wr, int fr) const {
#pragma unroll
        for (int ai = 0; ai < 2; ++ai)
#pragma unroll
            for (int m = 0; m < 4; ++m) { const LAS float* q = RS + (ui * 256 + ai * 128 + wr * 64 + m * 16 + fr) * 2; const float ratio = q[0] / q[1];
#pragma unroll
                for (int bj = 0; bj < 2; ++bj)
#pragma unroll
                    for (int n = 0; n < 2; ++n) acc[ai][bj][m][n] *= ratio; }
    }
    __device__ __forceinline__ void operator()(const pg8::f32x4 (&acc)[2][2][4][2], const pg8::Unit& u, int wr, int wc, int fr, int fq) const {
        const int col0 = u.pn * 256 + wc * 32 + 8 * fq;
        v4u xr[2][4][2];
#pragma unroll
        for (int ai = 0; ai < 2; ++ai)
#pragma unroll
            for (int m = 0; m < 4; ++m) { const int rl = ai * 128 + wr * 64 + m * 16 + fr; const bf16* xp = XN + (size_t)(u.pm * 256 + rl) * DM + col0;
#pragma unroll
                for (int bj = 0; bj < 2; ++bj) xr[ai][m][bj] = *(const v4u*)(xp + bj * 128); }
#pragma unroll
        for (int ai = 0; ai < 2; ++ai)
#pragma unroll
            for (int m = 0; m < 4; ++m) { const int rl = ai * 128 + wr * 64 + m * 16 + fr; bf16* rowp = P + (size_t)(u.pm * 256 + rl) * DM + col0; const float rw = RS[(ui * 256 + rl) * 2 + 1], ri = RS[2048 + ui * 256 + rl];
#pragma unroll
                for (int bj = 0; bj < 2; ++bj) { const pg8::f32x4 v0 = acc[ai][bj][m][0] * rw, v1 = acc[ai][bj][m][1] * rw; const v4u x = xr[ai][m][bj];
                    v4u w; w.x = pk2(bf_lo(x.x) * ri + v0[0], bf_hi(x.x) * ri + v0[1]); w.y = pk2(bf_lo(x.y) * ri + v0[2], bf_hi(x.y) * ri + v0[3]);
                    w.z = pk2(bf_lo(x.z) * ri + v1[0], bf_hi(x.z) * ri + v1[1]); w.w = pk2(bf_lo(x.w) * ri + v1[2], bf_hi(x.w) * ri + v1[3]); *(v4u*)(rowp + bj * 128) = w; } }
        ++ui;
    }
};

__device__ __forceinline__ void p4_router(Frame& F) {
    using namespace att;
    const int lane = F.lane, r = lane & 31, h = lane >> 5, w = F.wave;
    const bf16* HB = (const bf16*)(F.ws + WS_HB);
    const bf16* WRH = (const bf16*)(F.ws + WS_WR); const bf16* WRL = WRH + 96 * DM;
    const float* b_rg = F.in[13]; const float* b_re = F.in[15];
    unsigned* CNT = F.ctl + CW_CNT;
    int* LIST = (int*)(F.ws + WS_LIST); float* GATEW = (float*)(F.ws + WS_GATEW); int* TOKINFO = (int*)(F.ws + WS_TOKINFO); float* RSTD = (float*)(F.ws + WS_RSTD); float* RSTDW = (float*)(F.ws + WS_RSTDW);
    LAS float* part = (LAS float*)(F.lds + RING_OFF);
    LAS float* ssp = (LAS float*)(F.lds + RING_OFF + 98304);
    LAS float* lg = (LAS float*)(F.lds + RING_OFF + 98304 + 2048);
    LAS float* rsl = (LAS float*)(F.lds + RING_OFF + 98304 + 2048 + 18432);
    const bool stager = __builtin_amdgcn_readfirstlane(w) < 4; const int mw = w & 3;
    const int crot = F.vcu & 3, krot = (F.vcu >> 2) & 7;
    for (int unit = F.vcu; unit < NTOK / 64; unit += F.G) {
        if (stager) {
#pragma unroll 1
            for (int c = 0; c < 5; ++c) {
                if (c < 4) {
                    const int cn = (c + crot) & 3;
                    LAS unsigned char* sh = F.lds + RING_OFF + (c & 1) * 65536;
#pragma unroll 1
                    for (int hb = 0; hb < 2; ++hb) {
                        v4u xr[8];
#pragma unroll
                        for (int i = 0; i < 8; ++i) { const int id = (hb * 8 + i) * 256 + F.tid, row = id >> 6, g = id & 63; xr[i] = *(const v4u*)(HB + ((size_t)unit * 64 + row) * DM + 512 * cn + 8 * g); }
#pragma unroll
                        for (int i = 0; i < 8; ++i) { const int id = (hb * 8 + i) * 256 + F.tid, row = id >> 6, g = id & 63; *(LAS v4u*)(sh + row * 1024 + ((g ^ (row & 15)) << 4)) = xr[i]; }
                    }
                }
                __syncthreads();
            }
        } else {
            f32x16 acc[2][3];
#pragma unroll
            for (int t = 0; t < 2; ++t)
#pragma unroll
                for (int nt = 0; nt < 3; ++nt)
#pragma unroll
                    for (int g = 0; g < 16; ++g) acc[t][nt][g] = 0.f;
            float ss0 = 0.f, ss1 = 0.f;
            bf16x8 wah[3], wal[3], wbh[3], wbl[3];
#define P4_WLOAD(WH, WL, C_, S8_) { const int ksg_ = 32 * (((C_) + crot) & 3) + mw + 4 * (((S8_) + krot) & 7); \
                _Pragma("unroll") for (int nt = 0; nt < 3; ++nt) { const int fo = (((ksg_ * 3 + nt) * 64 + lane) << 3); WH[nt] = ld8(WRH + fo); if (W_LO) WL[nt] = ld8(WRL + fo); } }
#define P4_SS(SS, HV) { const float e0 = bf_lo(HV.x), e1 = bf_hi(HV.x), e2 = bf_lo(HV.y), e3 = bf_hi(HV.y), e4 = bf_lo(HV.z), e5 = bf_hi(HV.z), e6 = bf_lo(HV.w), e7 = bf_hi(HV.w); \
                SS += ((e0 * e0 + e1 * e1) + (e2 * e2 + e3 * e3)) + ((e4 * e4 + e5 * e5) + (e6 * e6 + e7 * e7)); }
#define P4_KSTEP(WH, WL, S8_) { const int ks = mw + 4 * (((S8_) + krot) & 7); \
                const int fo0 = r * 1024 + ((((2 * ks + h) ^ (r & 15))) << 4), fo1 = fo0 + 32 * 1024; \
                const v4u h0 = *(const LAS v4u*)(sh + fo0), h1 = *(const LAS v4u*)(sh + fo1); \
                P4_SS(ss0, h0) P4_SS(ss1, h1) \
                const bf16x8 ahi0 = __builtin_bit_cast(bf16x8, h0), ahi1 = __builtin_bit_cast(bf16x8, h1); \
                _Pragma("unroll") for (int nt = 0; nt < 3; ++nt) { \
                    acc[0][nt] = mfma_bf(ahi0, WH[nt], acc[0][nt]); acc[1][nt] = mfma_bf(ahi1, WH[nt], acc[1][nt]); \
                    if (W_LO) { acc[0][nt] = mfma_bf(ahi0, WL[nt], acc[0][nt]); acc[1][nt] = mfma_bf(ahi1, WL[nt], acc[1][nt]); } } }
            P4_WLOAD(wah, wal, 0, 0)
            __syncthreads();
#pragma unroll 1
            for (int c = 0; c < 4; ++c) {
                const LAS unsigned char* sh = F.lds + RING_OFF + (c & 1) * 65536;
#pragma unroll 1
                for (int s8 = 0; s8 < 8; s8 += 2) {
                    P4_WLOAD(wbh, wbl, c, s8 + 1)
                    P4_KSTEP(wah, wal, s8)
                    { const int j = c * 8 + s8 + 2; P4_WLOAD(wah, wal, j >> 3, j & 7) }
                    P4_KSTEP(wbh, wbl, s8 + 1)
                }
                __syncthreads();
            }
#undef P4_SS
#undef P4_KSTEP
#undef P4_WLOAD
            ss0 += __shfl_xor(ss0, 32); ss1 += __shfl_xor(ss1, 32);
            if (h == 0) { ssp[mw * 32 + r] = ss0; ssp[128 + mw * 32 + r] = ss1; }
#pragma unroll
            for (int t = 0; t < 2; ++t)
#pragma unroll
                for (int nt = 0; nt < 3; ++nt)
#pragma unroll
                    for (int g = 0; g < 16; ++g) part[((t * 4 + mw) * 32 + crow(g, h)) * 96 + nt * 32 + r] = acc[t][nt][g];
        }
        __syncthreads();
        for (int idx = F.tid; idx < 64 * 72; idx += NWAVES * 64) { const int tkk = idx / 72, cc = idx % 72, t = tkk >> 5, tk = tkk & 31; float v = 0.f;
#pragma unroll
            for (int i = 0; i < 4; ++i) v += part[((t * 4 + i) * 32 + tk) * 96 + cc];
            lg[idx] = v; }
        __syncthreads();
        LAS unsigned* hist = (LAS unsigned*)rsl + 64;
        if (F.tid < 128) hist[F.tid] = 0u;
        __syncthreads();
        int tok = 0, e0 = 0, e1 = 0; unsigned r0 = 0, r1 = 0; float g0 = 0.f, g1 = 0.f, rs = 0.f;
        if (F.tid < 64) {
            tok = unit * 64 + F.tid; float tsum = 0.f;
#pragma unroll
            for (int i = 0; i < 4; ++i) tsum += ssp[(F.tid >> 5) * 128 + i * 32 + (F.tid & 31)];
            rs = 1.0f / sqrtf(tsum * (1.0f / DM) + RMS_EPS); RSTD[tok] = rs;
            const LAS float* l = lg + F.tid * 72;
            float gl[8]; int gi = 0; float gm = -3.0e38f;
#pragma unroll
            for (int i = 0; i < 8; ++i) { gl[i] = l[i] * rs + b_rg[i]; if (gl[i] > gm) { gm = gl[i]; gi = i; } }
            float gs = 0.f;
#pragma unroll
            for (int i = 0; i < 8; ++i) gs += expf(gl[i] - gm);
            const float gval = 1.0f / gs;
            float el[8]; int i0 = 0; float m0 = -3.0e38f;
#pragma unroll
            for (int i = 0; i < 8; ++i) { el[i] = l[8 + gi * 8 + i] * rs + b_re[gi * 8 + i]; if (el[i] > m0) { m0 = el[i]; i0 = i; } }
            int i1 = 0; float m1 = -3.0e38f;
#pragma unroll
            for (int i = 0; i < 8; ++i) if (i != i0 && el[i] > m1) { m1 = el[i]; i1 = i; }
            const float p1 = expf(m1 - m0); g0 = gval / (1.0f + p1); g1 = gval * p1 / (1.0f + p1);
            e0 = gi * 8 + i0; e1 = gi * 8 + i1;
            r0 = atomicAdd((unsigned*)(hist + e0), 1u); r1 = atomicAdd((unsigned*)(hist + e1), 1u);
        }
        __syncthreads();
        if (F.tid < 64) { const unsigned n = hist[F.tid]; if (n) hist[64 + F.tid] = atomicAdd(CNT + F.tid, n); }
        __syncthreads();
        if (F.tid < 64) {
            const int pos0 = (int)(hist[64 + e0] + r0), pos1 = (int)(hist[64 + e1] + r1);
            LIST[e0 * NTOK + pos0] = tok; LIST[e1 * NTOK + pos1] = tok; GATEW[e0 * NTOK + pos0] = g0; GATEW[e1 * NTOK + pos1] = g1; RSTDW[e0 * NTOK + pos0] = rs; RSTDW[e1 * NTOK + pos1] = rs;
            *(int4*)(TOKINFO + 4 * tok) = make_int4(e0, pos0, e1, pos1);
        }
        __syncthreads();
    }
}

__device__ __forceinline__ void build_tables(Frame& F) {
    LAS int* T = (LAS int*)(F.lds + TBL_OFF);
    __syncthreads();
    if (F.tid < NEXP) {
        const int c = (int)__hip_atomic_load(F.ctl + CW_CNT + F.tid, __ATOMIC_RELAXED, __HIP_MEMORY_SCOPE_AGENT); const int mt = (c + 255) >> 8;
        int incl = mt;
#pragma unroll
        for (int o = 1; o < 64; o <<= 1) { const int v = __shfl_up(incl, o); if (F.tid >= o) incl += v; }
        const int st = incl - mt;
        T[TBL_TSTART + F.tid] = st; T[TBL_CNTS + F.tid] = c;
        for (int i = 0; i < mt; ++i) T[TBL_TE + st + i] = F.tid;
        if (F.tid == NEXP - 1) { T[TBL_TSTART + NEXP] = incl; T[TBL_NT] = incl; }
    }
    __syncthreads();
}
struct MoeGather {
    const int* list; const LAS int* T; LAS int* tokbuf; int NT; const float* rstdw; const float* gatew;
    __device__ __forceinline__ void info(const pg8::Unit& u, int& e, int& base, int& cnt) const { e = u.pn / NT; base = (u.pm - T[TBL_TSTART + e]) * 256; cnt = T[TBL_CNTS + e]; }
    __device__ __forceinline__ unsigned tok_direct(const pg8::Unit& u, int row) const { int e, base, cnt; info(u, e, base, cnt); const int idx = base + row; return idx < cnt ? (unsigned)list[e * NTOK + idx] : 0u; }
    __device__ __forceinline__ void issue(const pg8::Unit& u, int par, int lane) const { int e, base, cnt; info(u, e, base, cnt);
        __builtin_amdgcn_global_load_lds((const unsigned*)(list + e * NTOK + base + 4 * lane), (LAS unsigned*)(tokbuf + par * 256), 16, 0, 0);
        __builtin_amdgcn_global_load_lds((const unsigned*)(rstdw + e * NTOK + base + 4 * lane), (LAS unsigned*)(tokbuf + 512 + par * 256), 16, 0, 0);
        __builtin_amdgcn_global_load_lds((const unsigned*)(gatew + e * NTOK + base + 4 * lane), (LAS unsigned*)(tokbuf + 1024 + par * 256), 16, 0, 0); }
    __device__ __forceinline__ void direct_rg(const pg8::Unit& u, int row, float& rs, float& gw) const { int e, base, cnt; info(u, e, base, cnt); rs = rstdw[e * NTOK + base + row]; gw = gatew[e * NTOK + base + row]; }
    __device__ __forceinline__ unsigned tok_lds(const pg8::Unit& u, int par, int row) const { int e, base, cnt; info(u, e, base, cnt); const unsigned t = (unsigned)tokbuf[par * 256 + row]; return (base + row) < cnt ? t : 0u; }
};
namespace pg8 {
template <class Epi, class Sched>
__device__ __forceinline__ void gemm_phase_g(PG8_LAS unsigned char* lds, const Gemm g, const Sched& S, const Epi& E, const MoeGather& GA) {
    const int tid = threadIdx.x, wid = __builtin_amdgcn_readfirstlane(tid >> 6), lane = tid & 63, wr = wid >> 2, wc = wid & 3, fr = lane & 15, fq = lane >> 4;
    const int K = g.K, nt = K / BK;
    unsigned voffB[2], cofA[2]; int rowA[2];
#pragma unroll
    for (int i = 0; i < 2; ++i) { int R, C; stage_rc(tid * 16 + i * 8192, R, C); const int Rb = Epi::PERM ? ((R & ~31) + perm32(R & 31)) : R;
        rowA[i] = R; cofA[i] = (unsigned)C * 2u; voffB[i] = (unsigned)(Rb * K + C) * 2u; }
    const unsigned rowbytes = (unsigned)K * 2u;
    const size_t kstep = (size_t)(BK * 2);
    const size_t hstep = (size_t)HALF * K * 2;
    const size_t tstep = 2 * hstep;
    const unsigned ldsw = (unsigned)wid * 1024u;
    const int aoff = lds_byte(wr * 64 + fr, fq * 8), boff = lds_byte(wc * 32 + fr, fq * 8);
#define PG8_SA(b, h) (((b) * 2 + (h)) * HTB)
#define PG8_SB(b, h) ((4 + (b) * 2 + (h)) * HTB)
#define PG8_STAGE(bufoff, gbase, voff) do { _Pragma("unroll") for (int _i = 0; _i < 2; ++_i) \
        __builtin_amdgcn_global_load_lds((const unsigned*)((const char*)(gbase) + (voff)[_i]), (PG8_LAS unsigned*)(lds + (bufoff) + ldsw + _i * 8192), 16, 0, 0); } while (0)
#define PG8_LDA(dst, b, h) do { _Pragma("unroll") for (int m = 0; m < 4; ++m) _Pragma("unroll") for (int k = 0; k < 2; ++k) dst[m][k] = *(const PG8_LAS bf16x8*)(lds + PG8_SA(b, h) + aoff + m * 2048 + k * 1024); } while (0)
#define PG8_LDB(dst, b, h) do { _Pragma("unroll") for (int n = 0; n < 2; ++n) _Pragma("unroll") for (int k = 0; k < 2; ++k) dst[n][k] = *(const PG8_LAS bf16x8*)(lds + PG8_SB(b, h) + boff + n * 2048 + k * 1024); } while (0)
#define PG8_MMA(ai, bj, At, Bt) do { __builtin_amdgcn_s_setprio(1); _Pragma("unroll") for (int m = 0; m < 4; ++m) _Pragma("unroll") for (int n = 0; n < 2; ++n) _Pragma("unroll") for (int k = 0; k < 2; ++k) \
        acc[ai][bj][m][n] = __builtin_amdgcn_mfma_f32_16x16x32_bf16(Bt[n][k], At[m][k], acc[ai][bj][m][n], 0, 0, 0); __builtin_amdgcn_s_setprio(0); } while (0)
#define PG8_WAIT_V(n) asm volatile("s_waitcnt vmcnt(" #n ")" ::: "memory")
#define PG8_WAIT_L(n) asm volatile("s_waitcnt lgkmcnt(" #n ")" ::: "memory")
#define PG8_BAR __builtin_amdgcn_s_barrier()
#define PG8_SCHED __builtin_amdgcn_sched_barrier(0)
    Unit cur, nxt; int ui = 0;
    if (!S.next(0, cur)) return;
    f32x4 acc[2][2][4][2];
#pragma unroll
    for (int a = 0; a < 2; ++a)
#pragma unroll
        for (int b = 0; b < 2; ++b)
#pragma unroll
            for (int m = 0; m < 4; ++m)
#pragma unroll
                for (int n = 0; n < 2; ++n) acc[a][b][m][n] = (f32x4){0.f, 0.f, 0.f, 0.f};
    bf16x8 At[4][2], B0[2][2], B1[2][2];
    const char* A0 = (const char*)g.A; const char* cB = (const char*)g.Bt + (size_t)cur.pn * tstep;
    PG8_LAS int* tb = GA.tokbuf;
    if (tid < 256) { tb[tid] = (int)GA.tok_direct(cur, tid); float rs_, gw_; GA.direct_rg(cur, tid, rs_, gw_); ((PG8_LAS float*)tb)[512 + tid] = rs_; ((PG8_LAS float*)tb)[1024 + tid] = gw_; }
    PG8_WAIT_L(0); PG8_BAR;
#define PG8_OFFS(dst, par, half) do { _Pragma("unroll") for (int _i = 0; _i < 2; ++_i) dst[_i] = (unsigned)tb[(par) * 256 + (half) * HALF + rowA[_i]] * rowbytes + cofA[_i]; } while (0)
    {
        unsigned c0[2], c1[2]; PG8_OFFS(c0, 0, 0); PG8_OFFS(c1, 0, 1);
        PG8_STAGE(PG8_SB(0, 0), cB, voffB); PG8_STAGE(PG8_SB(0, 1), cB + hstep, voffB); PG8_STAGE(PG8_SA(0, 0), A0, c0); PG8_STAGE(PG8_SA(0, 1), A0, c1);
        if (wr == 1) PG8_BAR;
        PG8_WAIT_V(2); PG8_BAR;
        PG8_STAGE(PG8_SB(1, 0), cB + kstep, voffB); PG8_STAGE(PG8_SA(1, 0), A0 + kstep, c0); PG8_STAGE(PG8_SB(1, 1), cB + hstep + kstep, voffB);
        PG8_WAIT_V(6); PG8_BAR;
    }
    int t_issue = 2, t_fix = 6; asm volatile("" : "+s"(t_issue), "+s"(t_fix));
    for (;;) {
        const bool has_next = S.next(ui + 1, nxt);
        const char* nB = has_next ? (const char*)g.Bt + (size_t)nxt.pn * tstep : cB;
        const int pc = ui & 1, pnx = (ui + 1) & 1;
        for (int t = 0; t < nt; t += 2) {
            const bool last = (t == nt - 2);
            const char* a1 = A0 + (size_t)(t + 1) * kstep;
            const char* a2 = last ? A0 : A0 + (size_t)(t + 2) * kstep; const char* b2 = last ? nB : cB + (size_t)(t + 2) * kstep;
            const char* a3 = a2 + kstep; const char* b3 = b2 + kstep;
            if (t == t_fix && has_next && tid < 256) { int e_, base_, cnt_; GA.info(nxt, e_, base_, cnt_); if (base_ + tid >= cnt_) tb[pnx * 256 + tid] = 0; }
            const int ps = (last && has_next) ? pnx : pc;
            unsigned c1[2], s0[2], s1[2]; PG8_OFFS(c1, pc, 1); PG8_OFFS(s0, ps, 0); PG8_OFFS(s1, ps, 1);
            PG8_LDB(B0, 0, 0); PG8_LDB(B1, 0, 1); PG8_SCHED; PG8_LDA(At, 0, 0); PG8_STAGE(PG8_SA(1, 1), a1, c1);
            if (t == t_issue && has_next && wid == 0) GA.issue(nxt, pnx, lane);
            PG8_WAIT_V(8); PG8_WAIT_L(0); PG8_BAR; PG8_MMA(0, 0, At, B0); PG8_MMA(0, 1, At, B1); PG8_BAR; PG8_SCHED;
            PG8_LDA(At, 0, 1); PG8_STAGE(PG8_SB(0, 0), b2, voffB); PG8_STAGE(PG8_SB(0, 1), b2 + hstep, voffB); PG8_STAGE(PG8_SA(0, 0), a2, s0);
            PG8_WAIT_V(8); PG8_WAIT_L(0); PG8_BAR; PG8_MMA(1, 0, At, B0); PG8_MMA(1, 1, At, B1); PG8_BAR; PG8_SCHED;
            PG8_LDB(B0, 1, 0); PG8_LDB(B1, 1, 1); PG8_SCHED; PG8_LDA(At, 1, 0); PG8_STAGE(PG8_SA(0, 1), a2, s1);
            PG8_WAIT_V(8); PG8_WAIT_L(0); PG8_BAR; PG8_MMA(0, 0, At, B0); PG8_MMA(0, 1, At, B1); PG8_BAR; PG8_SCHED;
            PG8_LDA(At, 1, 1); PG8_STAGE(PG8_SB(1, 0), b3, voffB); PG8_STAGE(PG8_SB(1, 1), b3 + hstep, voffB); PG8_STAGE(PG8_SA(1, 0), a3, s0);
            PG8_WAIT_V(8); PG8_WAIT_L(0); PG8_BAR; PG8_MMA(1, 0, At, B0); PG8_MMA(1, 1, At, B1); PG8_BAR; PG8_SCHED;
        }
        if (wr == 0) PG8_BAR;
        E.par = pc; E(acc, cur, wr, wc, fr, fq); S.done(cur);
        if (!has_next) break;
#pragma unroll
        for (int a = 0; a < 2; ++a)
#pragma unroll
            for (int b = 0; b < 2; ++b)
#pragma unroll
                for (int m = 0; m < 4; ++m)
#pragma unroll
                    for (int n = 0; n < 2; ++n) acc[a][b][m][n] = (f32x4){0.f, 0.f, 0.f, 0.f};
        cur = nxt; cB = nB; ++ui;
        if (wr == 1) PG8_BAR;
    }
    PG8_WAIT_V(0);
    PG8_BAR;
#undef PG8_SA
#undef PG8_SB
#undef PG8_STAGE
#undef PG8_LDA
#undef PG8_LDB
#undef PG8_MMA
#undef PG8_WAIT_V
#undef PG8_WAIT_L
#undef PG8_BAR
#undef PG8_SCHED
#undef PG8_OFFS
}
}
struct MoeOrder {
    const LAS int* T; int NT, G, c;
    __device__ bool next(int i, pg8::Unit& u) const {
        const int L = i * G + c; if (L >= T[TBL_NT] * NT) return false;
        const int mt = L / NT; u.pm = mt; u.pn = T[TBL_TE + mt] * NT + (L % NT); return true;
    }
    __device__ __forceinline__ void a_ready(const pg8::Unit&) const {}
    __device__ __forceinline__ void done(const pg8::Unit&) const {}
};
struct EpiSwiGLU {
    static constexpr bool PERM = true, AFTER_DRAIN = false, MIDK = false;
    bf16* HDN; const LAS float* RG; const LAS int* T; mutable int par;
    __device__ __forceinline__ void operator()(const pg8::f32x4 (&acc)[2][2][4][2], const pg8::Unit& u, int wr, int wc, int fr, int fq) const {
        const int col0 = (u.pn & 3) * 128 + wc * 32 + 8 * fq; const int e = u.pn >> 2; const int base = (u.pm - T[TBL_TSTART + e]) * 256, cnt = T[TBL_CNTS + e];
#pragma unroll
        for (int ai = 0; ai < 2; ++ai)
#pragma unroll
            for (int m = 0; m < 4; ++m) { const int rl = ai * 128 + wr * 64 + m * 16 + fr; const int row = u.pm * 256 + rl; const bool ok = (base + rl) < cnt;
                const float rsr = RG[par * 256 + rl], gwr = RG[512 + par * 256 + rl];
                const float rs = ok ? rsr : 0.f, gw = ok ? gwr : 0.f;
                float o[8];
#pragma unroll
                for (int n = 0; n < 2; ++n)
#pragma unroll
                    for (int q = 0; q < 4; ++q) { const float g = acc[ai][0][m][n][q] * rs, up = acc[ai][1][m][n][q] * rs;
                        const float sg = g * __builtin_amdgcn_rcpf(1.0f + __builtin_amdgcn_exp2f(-g * LOG2E)); o[4 * n + q] = sg * up * gw; }
                v4u wv; wv.x = pk2(o[0], o[1]); wv.y = pk2(o[2], o[3]); wv.z = pk2(o[4], o[5]); wv.w = pk2(o[6], o[7]);
                *(v4u*)(HDN + (size_t)row * DEXP + col0) = wv; }
    }
};
struct EpiY {
    static constexpr bool PERM = true, AFTER_DRAIN = false, MIDK = false;
    bf16* Y; const LAS int* T;
    __device__ __forceinline__ void operator()(const pg8::f32x4 (&acc)[2][2][4][2], const pg8::Unit& u, int wr, int wc, int fr, int fq) const {
        const int col0 = (u.pn & 7) * 256 + wc * 32 + 8 * fq; const int e = u.pn >> 3; const int nvalid = T[TBL_CNTS + e] - (u.pm - T[TBL_TSTART + e]) * 256;
#pragma unroll
        for (int ai = 0; ai < 2; ++ai)
#pragma unroll
            for (int m = 0; m < 4; ++m) { const int rl = ai * 128 + wr * 64 + m * 16 + fr; bf16* rowp = Y + (size_t)(u.pm * 256 + rl) * DM + col0;
                if (rl < nvalid) {
#pragma unroll
                    for (int bj = 0; bj < 2; ++bj) { const pg8::f32x4 v0 = acc[ai][bj][m][0], v1 = acc[ai][bj][m][1];
                        v4u w; w.x = pk2(v0[0], v0[1]); w.y = pk2(v0[2], v0[3]); w.z = pk2(v1[0], v1[1]); w.w = pk2(v1[2], v1[3]); *(v4u*)(rowp + bj * 128) = w; } } }
    }
};
struct P8Row { v4u h[4], a[4], b[4]; };
__device__ __forceinline__ void p8_load(P8Row& r, const bf16* HB, const bf16* Y, const LAS int* T, int4 ti, int t, int lane) {
    const size_t s0 = (size_t)T[TBL_TSTART + ti.x] * 256 + ti.y, s1 = (size_t)T[TBL_TSTART + ti.z] * 256 + ti.w;
    const v4u* hp = (const v4u*)(HB + (size_t)t * DM) + lane; const v4u* y0 = (const v4u*)(Y + s0 * DM) + lane; const v4u* y1 = (const v4u*)(Y + s1 * DM) + lane;
#pragma unroll
    for (int j = 0; j < 4; ++j) { r.h[j] = __builtin_nontemporal_load(hp + 64 * j); r.a[j] = __builtin_nontemporal_load(y0 + 64 * j); r.b[j] = __builtin_nontemporal_load(y1 + 64 * j); }
}
__device__ __forceinline__ void p8_combine(Frame& F) {
    const LAS int* T = (const LAS int*)(F.lds + TBL_OFF);
    const int gw = F.vcu * NWAVES + F.wave, NGW = F.G * NWAVES;
    const bf16* Y = (const bf16*)(F.ws + WS_Y); const bf16* HB = (const bf16*)(F.ws + WS_HB); const int* TOKINFO = (const int*)(F.ws + WS_TOKINFO);
    constexpr int RPW = 8;
    int4 ti[RPW];
#pragma unroll
    for (int k = 0; k < RPW; ++k) { const int t = gw + k * NGW; ti[k] = (t < NTOK) ? *(const int4*)(TOKINFO + 4 * t) : make_int4(0, 0, 0, 0); }
    P8Row cur; if (gw < NTOK) p8_load(cur, HB, Y, T, ti[0], gw, F.lane);
#pragma unroll
    for (int k = 0; k < RPW; ++k) {
        const int t = gw + k * NGW; if (t >= NTOK) break;
        P8Row nxt; const int tn = t + NGW;
        if (k + 1 < RPW && tn < NTOK) p8_load(nxt, HB, Y, T, ti[k + 1 < RPW ? k + 1 : k], tn, F.lane);
        f32x4* od = (f32x4*)(F.out + (size_t)t * DM) + 2 * F.lane;
#pragma unroll
        for (int j = 0; j < 4; ++j) {
            const v4u h = cur.h[j], a = cur.a[j], b = cur.b[j]; f32x4 v0, v1;
            v0[0] = bf_lo(h.x) + bf_lo(a.x) + bf_lo(b.x); v0[1] = bf_hi(h.x) + bf_hi(a.x) + bf_hi(b.x); v0[2] = bf_lo(h.y) + bf_lo(a.y) + bf_lo(b.y); v0[3] = bf_hi(h.y) + bf_hi(a.y) + bf_hi(b.y);
            v1[0] = bf_lo(h.z) + bf_lo(a.z) + bf_lo(b.z); v1[1] = bf_hi(h.z) + bf_hi(a.z) + bf_hi(b.z); v1[2] = bf_lo(h.w) + bf_lo(a.w) + bf_lo(b.w); v1[3] = bf_hi(h.w) + bf_hi(a.w) + bf_hi(b.w);
            od[128 * j] = v0; od[128 * j + 1] = v1;
        }
        cur = nxt;
    }
    for (int t = gw + RPW * NGW; t < NTOK; t += NGW) {
        const int4 tj = *(const int4*)(TOKINFO + 4 * t); P8Row r; p8_load(r, HB, Y, T, tj, t, F.lane);
        f32x4* od = (f32x4*)(F.out + (size_t)t * DM) + 2 * F.lane;
#pragma unroll
        for (int j = 0; j < 4; ++j) {
            const v4u h = r.h[j], a = r.a[j], b = r.b[j]; f32x4 v0, v1;
            v0[0] = bf_lo(h.x) + bf_lo(a.x) + bf_lo(b.x); v0[1] = bf_hi(h.x) + bf_hi(a.x) + bf_hi(b.x); v0[2] = bf_lo(h.y) + bf_lo(a.y) + bf_lo(b.y); v0[3] = bf_hi(h.y) + bf_hi(a.y) + bf_hi(b.y);
            v1[0] = bf_lo(h.z) + bf_lo(a.z) + bf_lo(b.z); v1[1] = bf_hi(h.z) + bf_hi(a.z) + bf_hi(b.z); v1[2] = bf_lo(h.w) + bf_lo(a.w) + bf_lo(b.w); v1[3] = bf_hi(h.w) + bf_hi(a.w) + bf_hi(b.w);
            od[128 * j] = v0; od[128 * j + 1] = v1;
        }
    }
}

__global__ void __launch_bounds__(NWAVES * 64, 2) mk_fwd(Args args) {
    extern __shared__ __attribute__((aligned(16))) unsigned char lds[];
    Frame F;
    F.lds = (LAS unsigned char*)lds; F.ws = args.ws; F.ctl = (unsigned*)(args.ws + WS_CTL);
    F.tid = threadIdx.x; F.lane = F.tid & 63; F.wave = __builtin_amdgcn_readfirstlane(F.tid >> 6);
    F.G = gridDim.x; { const int bx = blockIdx.x; F.vcu = (F.G % 8 == 0) ? (bx % 8) * (F.G / 8) + bx / 8 : bx; }
    F.in = args.in; F.out = args.out;
    volatile LAS unsigned* MISC = (volatile LAS unsigned*)(F.lds + MISC_OFF);
    if (F.tid < 64) MISC[F.tid] = 0u;
    __syncthreads();
    const int lo = args.ph_lo, hi = args.ph_hi;
    const bool use_bar = (hi - lo) > 1;
    XcdBarrier bar; bar.bar = F.ctl + CW_BAR + args.li * XCD_BAR_WORDS; bar.x = 0; bar.st = nullptr;
    if (use_bar) bar = xcd_barrier_post(F.ctl + CW_BAR + args.li * XCD_BAR_WORDS, MISC + 8);
#define IN(k) (lo <= (k) && (k) < hi)
#define SEAM(k) do { if (IN(k) && (IN((k) + 1) || ((k) == 4 && IN(6)))) xcd_barrier(bar); } while (0)
    bf16* BIG = (bf16*)(F.ws + WS_BIG);

    if (IN(0)) { p0_prologue(F); SEAM(0); }
    if (IN(1)) {
        const CuSplit cs = split_cus(F.G, F.vcu, P1_UNITS, P1_EXTRA);
        if (!cs.conv) {
            pg8::Gemm g{BIG, BIG, 0, 0, DM}; P1Order S{cs.Gg, cs.cg};
            EpiQKV E{(bf16*)(F.ws + WS_QS), (bf16*)(F.ws + WS_KS), (bf16*)(F.ws + WS_QW), (bf16*)(F.ws + WS_KW), (bf16*)(F.ws + WS_VT), F.in[5], F.in[6]};
            pg8::gemm_phase<EpiQKV, P1Order, true, true>(F.lds + RING_OFF, g, S, E);
        } else {
            const int base = NITEMS - TAIL6_ITEMS - tail1_items(F.G);
            conv_range3(F, base + cs.cc * NWAVES + F.wave, cs.nconv * NWAVES, NITEMS - TAIL6_ITEMS);
        }
        SEAM(1);
    }
    if (IN(2)) { p2_attention(F); SEAM(2); }
    if (IN(3)) {
        pg8::Gemm g{(const bf16*)(F.ws + WS_MIXED), (const bf16*)(F.ws + WS_WOUT), NTOK, DM, DM}; pg8::StaticOrder S; S.init(NTOK, DM, F.G, (int)blockIdx.x);
        LAS float* RS = (LAS float*)(F.lds + ATT_TBR_OFF);
        {   const float* SSQ = (const float*)(F.ws + WS_SSQ);
            for (int i = 0; i < 4; ++i) { pg8::Unit u; if (!S.next(i, u)) break;
                if (F.tid < 256) { const pg8::f32x4* q = (const pg8::f32x4*)(SSQ + (size_t)(u.pm * 256 + F.tid) * 16); const pg8::f32x4 a = q[0], b = q[1], c = q[2], d = q[3];
                    float sb = 0.f, sw = 0.f;
#pragma unroll
                    for (int q_ = 0; q_ < 4; ++q_) { sb += (q_ < 4 ? a[q_ & 3] : b[q_ & 3]); sw += (q_ < 4 ? c[q_ & 3] : d[q_ & 3]); }
                    RS[(i * 256 + F.tid) * 2] = 1.0f / sqrtf(sb * (1.0f / 1024.0f) + RMS_EPS); RS[(i * 256 + F.tid) * 2 + 1] = 1.0f / sqrtf(sw * (1.0f / 1024.0f) + RMS_EPS);
                    RS[2048 + i * 256 + F.tid] = ((const float*)(F.ws + WS_RINV))[u.pm * 256 + F.tid]; } }
            __syncthreads(); }
        EpiRes E{(bf16*)(F.ws + WS_HB), RS, (const bf16*)(F.ws + WS_BIG), 0};
        pg8::gemm_phase<EpiRes, pg8::StaticOrder, true, true>(F.lds + RING_OFF, g, S, E);
        SEAM(3);
    }
    if (IN(4)) { p4_router(F); SEAM(4); }
    if (IN(5) || IN(6) || IN(7) || IN(8)) build_tables(F);
    if (IN(6)) {
        const LAS int* T6 = (const LAS int*)(F.lds + TBL_OFF); const CuSplit cs = split_cus(F.G, F.vcu, T6[TBL_NT] * 4);
        const int base = NITEMS - TAIL6_ITEMS; int mid = base + cs.nconv * NWAVES * TAIL6_PER_WAVE; if (mid > NITEMS) mid = NITEMS;
        if (!cs.conv) {
            pg8::Gemm g{(const bf16*)(F.ws + WS_HB), (const bf16*)(F.ws + WS_WGU), 0, 0, DM}; MoeOrder S{T6, 4, cs.Gg, cs.cg};
            MoeGather GA{(const int*)(F.ws + WS_LIST), T6, (LAS int*)(F.lds + TOKBUF_OFF), 4, (const float*)(F.ws + WS_RSTDW), (const float*)(F.ws + WS_GATEW)};
            EpiSwiGLU E{(bf16*)(F.ws + WS_HDN), (const LAS float*)(F.lds + TOKBUF_OFF + 2048), T6, 0};
            pg8::gemm_phase_g<EpiSwiGLU, MoeOrder>(F.lds + RING_OFF, g, S, E, GA);
        } else conv_range3(F, base + cs.cc * NWAVES + F.wave, cs.nconv * NWAVES, mid);
        conv_range(F, mid + F.vcu * NWAVES + F.wave, F.G * NWAVES, NITEMS);
        SEAM(6);
    }
    if (IN(7)) {
        pg8::Gemm g{(const bf16*)(F.ws + WS_HDN), (const bf16*)(F.ws + WS_WD), 0, 0, DEXP}; MoeOrder S{(const LAS int*)(F.lds + TBL_OFF), 8, F.G, F.vcu};
        EpiY E{(bf16*)(F.ws + WS_Y), (const LAS int*)(F.lds + TBL_OFF)};
        pg8::gemm_phase<EpiY, MoeOrder, true, true>(F.lds + RING_OFF, g, S, E);
        SEAM(7);
    }
    if (IN(8)) p8_combine(F);
#undef IN
#undef SEAM
}

extern "C" void kernel_launch(void* const* d_in, const int* in_sizes, int n_in, void* d_out, int out_size, void* d_ws, size_t ws_size, hipStream_t stream) {
    static int grid = 0;
    if (grid == 0) {
        if (n_in != 19 || out_size != NTOK * DM || ws_size < WS_END) { fprintf(stderr, "kernel_launch: unexpected shapes (n_in %d out %d ws %zu)\n", n_in, out_size, ws_size); grid = -1; return; }
        int dev = 0, cus = 0, per_cu = 0;
        if (hipGetDevice(&dev) != hipSuccess || hipDeviceGetAttribute(&cus, hipDeviceAttributeMultiprocessorCount, dev) != hipSuccess) { grid = -1; return; }
        if (hipFuncSetAttribute((const void*)mk_fwd, hipFuncAttributeMaxDynamicSharedMemorySize, LDS_BYTES) != hipSuccess) { fprintf(stderr, "kernel_launch: hipFuncSetAttribute failed\n"); grid = -1; return; }
        if (hipOccupancyMaxActiveBlocksPerMultiprocessor(&per_cu, (const void*)mk_fwd, NWAVES * 64, LDS_BYTES) != hipSuccess || per_cu < 1) { fprintf(stderr, "kernel_launch: occupancy query reports %d\n", per_cu); }
        (void)hipGetLastError();
        grid = cus;
    }
    if (grid < 0) return;
    (void)hipMemsetAsync((char*)d_ws + WS_CTL, 0, CTL_ZERO_BYTES, stream);
    Args a{};
    for (int i = 0; i < 19; ++i) a.in[i] = (const float*)d_in[i];
    a.out = (float*)d_out; a.ws = (unsigned char*)d_ws;
#if MK_N_LAUNCHES == 1
#ifdef PROBE_K
    a.ph_lo = 0; a.ph_hi = PROBE_K; a.li = 1;
    hipLaunchKernelGGL(mk_fwd, dim3(grid), dim3(NWAVES * 64), LDS_BYTES, stream, a);
#endif
    a.ph_lo = 0; a.ph_hi = N_PHASES; a.li = 0;
    hipLaunchKernelGGL(mk_fwd, dim3(grid), dim3(NWAVES * 64), LDS_BYTES, stream, a);
#else
    a.li = 0;
    for (int p = 0; p < N_PHASES; ++p) { a.ph_lo = p; a.ph_hi = p + 1; hipLaunchKernelGGL(mk_fwd, dim3(grid), dim3(NWAVES * 64), LDS_BYTES, stream, a); }
#endif
}
```
